# Optimizing an MI355X kernel written in HIP

```python
import math
import jax
import jax.numpy as jnp
from jax import lax
import numpy as np

D_MODEL = 1024
BATCH = 16
SEQ = 2048
DEPTH = 1

CHUNK = 64
Q_BLOCK = 128

DIFF_HEADS = 4
DIFF_DH = 64
DIFF_QK_W = DIFF_HEADS * 2 * DIFF_DH
DIFF_V_W = DIFF_HEADS * 2 * DIFF_DH

GLA_HEADS = 4
GLA_DK = 64
GLA_DV = 128
GLA_QK_W = GLA_HEADS * GLA_DK
GLA_V_W = GLA_HEADS * GLA_DV
GLA_RANK = 16
GLA_GATE_NORM = 16.0

IN_WIDTHS = (DIFF_QK_W, DIFF_QK_W, DIFF_V_W,
             GLA_QK_W, GLA_QK_W, GLA_V_W, GLA_V_W, GLA_RANK,
             D_MODEL, D_MODEL)
IN_WIDTH = sum(IN_WIDTHS)

N_EXPERTS = 32
TOP_K = 4
D_FF = D_MODEL
SWIGLU_LIMIT = 7.0
SWIGLU_ALPHA = 1.702
MOE_BLOCK = 128

N_MOD = 6
EPS = 1e-6

kernel_name = 'hybrid_diffattn_gla_moe_block'


def rmsnorm(x, g):
    xf = x.astype(jnp.float32)
    y = xf * lax.rsqrt(jnp.mean(xf * xf, axis=-1, keepdims=True) + EPS)
    return (y * g.astype(jnp.float32)).astype(x.dtype)


def alibi_slopes(n_heads):
    return jnp.asarray(2.0 ** (-8.0 * np.arange(1, n_heads + 1) / n_heads), dtype=jnp.float32)


def diff_attention(q, k, v, lam):
    S = q.shape[1]
    slopes = alibi_slopes(DIFF_HEADS)
    pos = jnp.arange(S)
    scale = DIFF_DH ** -0.5
    outs = []
    for i in range(S // Q_BLOCK):
        q0 = i * Q_BLOCK
        kv_len = q0 + Q_BLOCK
        qb = q[:, q0:kv_len]
        kb = k[:, :kv_len]
        vb = v[:, :kv_len]
        s = jnp.einsum('bqhpd,bkhpd->bhpqk', qb, kb).astype(jnp.float32) * scale
        qpos = pos[q0:kv_len]
        kpos = pos[:kv_len]
        allowed = (qpos[:, None] // CHUNK) >= (kpos[None, :] // CHUNK)
        dist = jnp.abs(qpos[:, None] - kpos[None, :]).astype(jnp.float32)
        bias = -slopes[:, None, None] * dist
        s = jnp.where(allowed, s + bias[None, :, None], -jnp.inf)
        p = jax.nn.softmax(s, axis=-1)
        a = p[:, :, 0] - lam * p[:, :, 1]
        outs.append(jnp.einsum('bhqk,bkhe->bqhe', a.astype(vb.dtype), vb))
    return jnp.concatenate(outs, axis=1)


def chunked_gla(q, k, v, g):
    B, S, H, DK = q.shape
    DV = v.shape[-1]
    n = S // CHUNK
    f32 = jnp.float32
    q = q.astype(f32).reshape(B, n, CHUNK, H, DK) * (DK ** -0.5)
    k = k.astype(f32).reshape(B, n, CHUNK, H, DK)
    v = v.astype(f32).reshape(B, n, CHUNK, H, DV)
    G = jnp.cumsum(g.astype(f32).reshape(B, n, CHUNK, H, DK), axis=2)
    G_last = G[:, :, -1:]
    q_s = q * jnp.exp(G)
    k_s = k * jnp.exp(-G)
    k_dec = k * jnp.exp(G_last - G)
    causal = jnp.tril(jnp.ones((CHUNK, CHUNK), dtype=bool))
    A = jnp.einsum('bnchk,bnshk->bnhcs', q_s, k_s)
    A = jnp.where(causal, A, 0.0)
    o_intra = jnp.einsum('bnhcs,bnshv->bnchv', A, v)
    dS = jnp.einsum('bnshk,bnshv->bnhkv', k_dec, v)
    decay = jnp.exp(G_last[:, :, 0])

    def step(state, inp):
        d, ds = inp
        return d[..., None] * state + ds, state

    _, S_prev = lax.scan(step, jnp.zeros((B, H, DK, DV), f32),
                         (jnp.moveaxis(decay, 1, 0), jnp.moveaxis(dS, 1, 0)))
    S_prev = jnp.moveaxis(S_prev, 0, 1)
    o_inter = jnp.einsum('bnchk,bnhkv->bnchv', q_s, S_prev)
    return (o_intra + o_inter).reshape(B, S, H, DV)


def moe_ffn(h, w_router, b_router, w_gate_up, b_gate_up, w_down, b_down):
    B, S, D = h.shape
    N = B * S
    hf = h.reshape(N, D)
    logits = (hf @ w_router + b_router).astype(jnp.float32)
    top_vals, top_idx = lax.top_k(logits, TOP_K)
    weights = jax.nn.softmax(top_vals, axis=-1)
    A = N * TOP_K
    e_flat = top_idx.reshape(A)
    w_flat = weights.reshape(A)
    tok_flat = jnp.arange(A, dtype=jnp.int32) // TOP_K
    order = jnp.argsort(e_flat)
    e_sorted = e_flat[order]
    counts = jnp.bincount(e_flat, length=N_EXPERTS)
    starts = jnp.cumsum(counts) - counts
    padded = ((counts + MOE_BLOCK - 1) // MOE_BLOCK) * MOE_BLOCK
    pad_ends = jnp.cumsum(padded)
    pad_starts = pad_ends - padded
    dest = pad_starts[e_sorted] + (jnp.arange(A) - starts[e_sorted])
    NB = -(-A // MOE_BLOCK) + N_EXPERTS
    P = NB * MOE_BLOCK
    tok_buf = jnp.full((P,), N, dtype=jnp.int32).at[dest].set(tok_flat[order])
    w_buf = jnp.zeros((P,), dtype=jnp.float32).at[dest].set(w_flat[order])
    blk_expert = jnp.minimum(
        jnp.searchsorted(pad_ends, jnp.arange(NB) * MOE_BLOCK, side='right'), N_EXPERTS - 1)
    h_pad = jnp.concatenate([hf, jnp.zeros((1, D), hf.dtype)], axis=0)
    xb = h_pad[tok_buf].reshape(NB, MOE_BLOCK, D)

    def expert_block(args):
        x_i, e = args
        gu = x_i @ w_gate_up[e] + b_gate_up[e]
        gate, up = jnp.split(gu, 2, axis=-1)
        gate = jnp.minimum(gate, SWIGLU_LIMIT)
        up = jnp.clip(up, -SWIGLU_LIMIT, SWIGLU_LIMIT)
        act = (up + 1.0) * (gate * jax.nn.sigmoid(SWIGLU_ALPHA * gate))
        return act @ w_down[e] + b_down[e]

    yb = lax.map(expert_block, (xb, blk_expert)).reshape(P, D)
    y = jax.ops.segment_sum(yb * w_buf[:, None].astype(yb.dtype), tok_buf, num_segments=N + 1)[:N]
    return y.reshape(B, S, D)


def hybrid_layer(x, c, layer_idx, w_ada, b_ada, norm1_g, w_in,
                 lambda_q1, lambda_k1, lambda_q2, lambda_k2, diff_norm_g,
                 w_alpha_up, b_alpha, gla_norm_g, w_branch_diff, w_branch_gla, w_out,
                 norm2_g, w_router, b_router, w_gate_up, b_gate_up, w_down, b_down):
    B, S, D = x.shape
    mod = jax.nn.silu(c) @ w_ada + b_ada
    sh1, sc1, gt1, sh2, sc2, gt2 = jnp.split(mod[:, None, :], N_MOD, axis=-1)

    h = rmsnorm(x, norm1_g) * (1.0 + sc1) + sh1
    proj = h @ w_in
    split_at = list(np.cumsum(IN_WIDTHS)[:-1])
    dq, dk, dv, gq, gk, gv, gr, g_lr, gate_a, gate_b = jnp.split(proj, split_at, axis=-1)

    lambda_init = 0.8 - 0.6 * math.exp(-0.3 * layer_idx)
    lam = (jnp.exp(jnp.sum(lambda_q1 * lambda_k1)) - jnp.exp(jnp.sum(lambda_q2 * lambda_k2))
           + lambda_init).astype(jnp.float32)
    o_a = diff_attention(dq.reshape(B, S, DIFF_HEADS, 2, DIFF_DH),
                         dk.reshape(B, S, DIFF_HEADS, 2, DIFF_DH),
                         dv.reshape(B, S, DIFF_HEADS, 2 * DIFF_DH), lam)
    o_a = (rmsnorm(o_a, diff_norm_g) * (1.0 - lambda_init)).reshape(B, S, DIFF_V_W)

    log_alpha = jax.nn.log_sigmoid((g_lr @ w_alpha_up + b_alpha).astype(jnp.float32)) / GLA_GATE_NORM
    o_b = chunked_gla(gq.reshape(B, S, GLA_HEADS, GLA_DK),
                      gk.reshape(B, S, GLA_HEADS, GLA_DK),
                      gv.reshape(B, S, GLA_HEADS, GLA_DV),
                      log_alpha.reshape(B, S, GLA_HEADS, GLA_DK)).astype(x.dtype)
    o_b = rmsnorm(o_b, gla_norm_g).reshape(B, S, GLA_V_W) * jax.nn.silu(gr)

    merged = (jax.nn.sigmoid(gate_a) * (o_a @ w_branch_diff)
              + jax.nn.sigmoid(gate_b) * (o_b @ w_branch_gla))
    x = x + gt1 * (merged @ w_out)

    h2 = rmsnorm(x, norm2_g) * (1.0 + sc2) + sh2
    x = x + gt2 * moe_ffn(h2, w_router, b_router, w_gate_up, b_gate_up, w_down, b_down)
    return x


def setup_inputs(seed: int = 0) -> dict:
    key = jax.random.key(seed)
    ks = jax.random.split(key, 26)
    f32 = jnp.float32
    L, D, E, F = DEPTH, D_MODEL, N_EXPERTS, D_FF

    def nrm(k, shape, scale):
        return jax.random.normal(k, shape, f32) * scale

    return {
        'x': nrm(ks[0], (BATCH, SEQ, D), 1.0),
        'c': nrm(ks[1], (BATCH, D), 1.0),
        'w_ada': nrm(ks[2], (L, D, N_MOD * D), D ** -0.5),
        'b_ada': nrm(ks[3], (L, N_MOD * D), 0.02),
        'norm1_g': 1.0 + nrm(ks[4], (L, D), 0.1),
        'w_in': nrm(ks[5], (L, D, IN_WIDTH), D ** -0.5),
        'lambda_q1': nrm(ks[6], (L, DIFF_DH), 0.1),
        'lambda_k1': nrm(ks[7], (L, DIFF_DH), 0.1),
        'lambda_q2': nrm(ks[8], (L, DIFF_DH), 0.1),
        'lambda_k2': nrm(ks[9], (L, DIFF_DH), 0.1),
        'diff_norm_g': 1.0 + nrm(ks[10], (L, 2 * DIFF_DH), 0.1),
        'w_alpha_up': nrm(ks[11], (L, GLA_RANK, GLA_QK_W), GLA_RANK ** -0.5),
        'b_alpha': nrm(ks[12], (L, GLA_QK_W), 0.1),
        'gla_norm_g': 1.0 + nrm(ks[13], (L, GLA_DV), 0.1),
        'w_branch_diff': nrm(ks[14], (L, DIFF_V_W, D), DIFF_V_W ** -0.5),
        'w_branch_gla': nrm(ks[15], (L, GLA_V_W, D), GLA_V_W ** -0.5),
        'w_out': nrm(ks[16], (L, D, D), D ** -0.5),
        'norm2_g': 1.0 + nrm(ks[17], (L, D), 0.1),
        'w_router': nrm(ks[18], (L, D, E), D ** -0.5),
        'b_router': nrm(ks[19], (L, E), 0.01),
        'w_gate_up': nrm(ks[20], (L, E, D, 2 * F), D ** -0.5),
        'b_gate_up': nrm(ks[21], (L, E, 2 * F), 0.01),
        'w_down': nrm(ks[22], (L, E, F, D), F ** -0.5),
        'b_down': nrm(ks[23], (L, E, D), 0.01),
        'final_norm_g': 1.0 + nrm(ks[24], (D,), 0.1),
    }


def reference(x, c, w_ada, b_ada, norm1_g, w_in, lambda_q1, lambda_k1, lambda_q2, lambda_k2,
              diff_norm_g, w_alpha_up, b_alpha, gla_norm_g, w_branch_diff, w_branch_gla, w_out,
              norm2_g, w_router, b_router, w_gate_up, b_gate_up, w_down, b_down, final_norm_g):
    for l in range(DEPTH):
        x = hybrid_layer(x, c, l, w_ada[l], b_ada[l], norm1_g[l], w_in[l],
                         lambda_q1[l], lambda_k1[l], lambda_q2[l], lambda_k2[l], diff_norm_g[l],
                         w_alpha_up[l], b_alpha[l], gla_norm_g[l], w_branch_diff[l], w_branch_gla[l],
                         w_out[l], norm2_g[l], w_router[l], b_router[l], w_gate_up[l],
                         b_gate_up[l], w_down[l], b_down[l])
    return rmsnorm(x, final_norm_g)
```

```cpp
#include <hip/hip_runtime.h>
#include <cstdio>
#include <cstdint>

#define GAS __attribute__((address_space(1)))
#define LAS __attribute__((address_space(3)))
typedef unsigned short bf16;
typedef short bf16x8 __attribute__((ext_vector_type(8)));
typedef float f32x4 __attribute__((ext_vector_type(4)));
typedef unsigned u32x4 __attribute__((ext_vector_type(4)));
typedef unsigned u32x2 __attribute__((ext_vector_type(2)));
typedef int i32x4 __attribute__((ext_vector_type(4)));
typedef GAS unsigned gu32;

constexpr int NB = 16, SEQ = 2048, DM = 1024, NTOK = NB * SEQ, NE = 32, FF = 1024;
constexpr int NPROJ = 5376;
constexpr int C_DQ = 0, C_DK = 512, C_DV = 1024, C_GQ = 1536, C_GK = 1792, C_GV = 2048, C_GR = 2560, C_GA = 3072, C_GB = 4096, C_AL = 5120;
constexpr int W_IN_N = 5136;
constexpr float LOG2E = 1.4426950408889634f;
constexpr float QSCALE = 0.125f * LOG2E;
constexpr float EPS = 1e-6f;
constexpr int NWAVES = 8, NTHREADS = 512;

constexpr size_t MiB = 1u << 20;
constexpr size_t WS_CTL = 0, CTL_ZERO_BYTES = 1 * MiB;
constexpr size_t WS_MOD = 1 * MiB;
constexpr size_t WS_TOPE = 2 * MiB;
constexpr size_t WS_TOPW = 3 * MiB;
constexpr size_t WS_LIST = 4 * MiB;
constexpr size_t WS_WIN = 8 * MiB;
constexpr size_t WS_WBD = 19 * MiB;
constexpr size_t WS_WBG = 20 * MiB;
constexpr size_t WS_WOUT = 21 * MiB;
constexpr size_t WS_WGU = 24 * MiB;
constexpr size_t WS_WD = 152 * MiB;
constexpr size_t WS_H2 = 216 * MiB;
constexpr size_t WS_RB = 280 * MiB;
constexpr size_t WS_H = WS_RB, WS_OA = WS_RB + 64 * MiB, WS_OB = WS_RB + 96 * MiB, WS_MG = WS_RB + 128 * MiB, WS_YB = WS_RB;
constexpr size_t WS_RA = 536 * MiB;
constexpr size_t WS_PROJ = WS_RA, WS_ACT = WS_RA;
constexpr size_t WS_END = 872 * MiB;
constexpr int MAX_TILES = 544;
static_assert((size_t)MAX_TILES * 256 * 1024 * 2 <= 336 * MiB, "act fits region A");
constexpr int CW_CNT = 64;
constexpr int CW_BAR = 4096;

constexpr int SCR_BYTES = 147456;
constexpr int LDSCTL_OFF = SCR_BYTES, MISC_OFF = LDSCTL_OFF + 320;
constexpr int LDS_BYTES = SCR_BYTES + 1024;

#define RLX_AGENT __ATOMIC_RELAXED, __HIP_MEMORY_SCOPE_AGENT
#define LDS_WAIT() asm volatile("s_waitcnt lgkmcnt(0)" ::: "memory")

__device__ __forceinline__ unsigned f2bf(float f) { unsigned u = __builtin_bit_cast(unsigned, f); return (u + 0x7fffu + ((u >> 16) & 1u)) >> 16; }
__device__ __forceinline__ unsigned pk2(float lo, float hi) { return f2bf(lo) | (f2bf(hi) << 16); }
__device__ __forceinline__ float bf2f(unsigned b) { return __uint_as_float(b << 16); }
__device__ __forceinline__ float bflo(unsigned w) { return __uint_as_float(w << 16); }
__device__ __forceinline__ float bfhi(unsigned w) { return __uint_as_float(w & 0xffff0000u); }
__device__ __forceinline__ float wave_sum(float v) {
#pragma unroll
    for (int o = 1; o < 64; o <<= 1) v += __shfl_xor(v, o);
    return v;
}
__device__ __forceinline__ float sigmoidf_(float x) { return 1.f / (1.f + __expf(-x)); }

#define XB_TMO      128
#define XB_XCNT(j)  (256  + 64 * (j))
#define XB_XSUB(j)  (1280 + 64 * (j))
#define XB_XGEN(j)  (2304 + 64 * (j))
#define XB_TOP      3328
#define XB_TOPGEN   3392
#define XCD_BAR_WORDS 3456
#define XB_SPIN_CAP (1u << 22)
__device__ __forceinline__ unsigned xb_ld(unsigned* p)              { return __hip_atomic_load(p, __ATOMIC_RELAXED, __HIP_MEMORY_SCOPE_AGENT); }
__device__ __forceinline__ unsigned xb_add(unsigned* p, unsigned v) { return __hip_atomic_fetch_add(p, v, __ATOMIC_RELAXED, __HIP_MEMORY_SCOPE_AGENT); }
__device__ __forceinline__ unsigned xb_xcc_id() { return (unsigned)__builtin_amdgcn_s_getreg((3 << 11) | 20) & 0xFu; }
#define XB_SPIN(cond, bar) do { unsigned _sp = 0; while (cond) { __builtin_amdgcn_s_sleep(1); \
    if ((++_sp & 255u) == 0u) { if (xb_ld(&(bar)[XB_TMO])) break; if (_sp > XB_SPIN_CAP) { atomicAdd(&(bar)[XB_TMO], 1u); break; } } } } while (0)
struct XcdBarrier { unsigned* bar; unsigned x; volatile LAS unsigned* st; };
__device__ __forceinline__ XcdBarrier xcd_barrier_post(unsigned* bar, volatile LAS unsigned* st) {
    XcdBarrier b; b.bar = bar; b.x = xb_xcc_id(); b.st = st;
    if (threadIdx.x == 0) (void)xb_add(&bar[XB_XCNT(b.x)], 1u);
    return b;
}
__device__ __forceinline__ void xcd_barrier_complete(unsigned* bar, unsigned x, unsigned& nloc, unsigned& nx) {
    const unsigned G = gridDim.x * gridDim.y * gridDim.z;
    unsigned sum, cnt, mine, sp = 0u;
    for (;;) {
        sum = 0u; cnt = 0u; mine = 0u;
#pragma unroll
        for (unsigned j = 0; j < 16; ++j) { const unsigned c = xb_ld(&bar[XB_XCNT(j)]); sum += c; cnt += (c > 0u) ? 1u : 0u; mine = (j == x) ? c : mine; }
        if (sum == G) break;
        __builtin_amdgcn_s_sleep(1);
        if ((++sp & 255u) == 0u) { if (xb_ld(&bar[XB_TMO])) break; if (sp > XB_SPIN_CAP) { atomicAdd(&bar[XB_TMO], 1u); break; } }
    }
    nloc = mine > 0u ? mine : 1u; nx = cnt > 0u ? cnt : 1u;
}
__device__ __forceinline__ void xcd_barrier(const XcdBarrier& b) {
    asm volatile("s_waitcnt vmcnt(0)" ::: "memory");
    __syncthreads();
    if (threadIdx.x == 0) {
        unsigned* bar = b.bar;
        __builtin_amdgcn_s_waitcnt(0);
        unsigned nloc = b.st[0], nx = b.st[1];
        if (nloc == 0u) { xcd_barrier_complete(bar, b.x, nloc, nx); b.st[0] = nloc; b.st[1] = nx; }
        const unsigned old = xb_add(&bar[XB_XSUB(b.x)], 1u);
        const unsigned gen = old / nloc;
        if (old + 1u == (gen + 1u) * nloc) {
            __builtin_amdgcn_fence(__ATOMIC_RELEASE, "agent");
            asm volatile("s_waitcnt vmcnt(0)" ::: "memory");
            const unsigned og = xb_add(&bar[XB_TOP], 1u);
            const unsigned tg = og / nx;
            if (og + 1u == (tg + 1u) * nx) xb_add(&bar[XB_TOPGEN], 1u);
            else XB_SPIN(xb_ld(&bar[XB_TOPGEN]) == tg, bar);
            __builtin_amdgcn_fence(__ATOMIC_ACQUIRE, "agent");
            xb_add(&bar[XB_XGEN(b.x)], 1u);
            asm volatile("s_waitcnt vmcnt(0)" ::: "memory");
        } else {
            XB_SPIN(xb_ld(&bar[XB_XGEN(b.x)]) == gen, bar);
            __builtin_amdgcn_fence(__ATOMIC_ACQUIRE, "agent");
            asm volatile("s_waitcnt vmcnt(0)" ::: "memory");
        }
    }
    __syncthreads();
}

struct Ctx {
    LAS unsigned char* lds;
    int tid, lane, wid, G, bid;
    const float *x, *c, *w_ada, *b_ada, *norm1_g, *w_in, *lq1, *lk1, *lq2, *lk2, *diff_g, *w_alpha_up, *b_alpha, *gla_g,
                *w_bd, *w_bg, *w_out, *norm2_g, *w_router, *b_router, *w_gu, *b_gu, *w_dn, *b_dn, *final_g;
    float* out;
    unsigned* ctl; float* mod; int* tope; float* topw; int* list;
    bf16 *WinT, *WbdT, *WbgT, *WoutT, *WguT, *WdT, *H, *H2, *OA, *OB, *MG, *YB, *PROJ, *ACT;
};

constexpr int NXCD = 8, WGM = 8;
__host__ __device__ __forceinline__ int perm32(int rho) { const int n = rho >> 4, i = rho & 15; return 8 * (i >> 2) + 4 * n + (i & 3); }
struct Unit { int pm, pn, e, row0, cnt; };
struct TileOrder {
    int nM, nN, nwg, G, c;
    __device__ __forceinline__ void init(int nM_, int nN_, int G_, int c_) { nM = nM_; nN = nN_; nwg = nM * nN; G = G_; c = c_; }
    __device__ __forceinline__ bool next(int i, Unit& u) const {
        const long L = (long)i * G + c; if (L >= nwg) return false;
        int wgid = (int)L; { const int q = nwg / NXCD, r = nwg % NXCD, xcd = wgid % NXCD, off = wgid / NXCD; wgid = (xcd < r ? xcd * (q + 1) : r * (q + 1) + (xcd - r) * q) + off; }
        const int nig = WGM * nN, gid = wgid / nig, fm = gid * WGM, gsz = (nM - fm) < WGM ? (nM - fm) : WGM;
        u.pm = fm + ((wgid % nig) % gsz); u.pn = (wgid % nig) / gsz; u.e = 0; u.row0 = 0; u.cnt = 0; return true;
    }
};
struct MoeOrder {
    TileOrder t; LAS const int* tab;
    __device__ __forceinline__ bool next(int i, Unit& u) const {
        if (!t.next(i, u)) return false;
        int e = 0;
#pragma unroll 1
        for (int k = 1; k < NE; ++k) if (tab[32 + k] <= u.pm) e = k;
        u.e = e; u.row0 = (u.pm - tab[32 + e]) * 256; u.cnt = tab[e]; return true;
    }
};
struct DenseDesc {
    const bf16* A; int lda; const bf16* Bt; int K;
    __device__ __forceinline__ unsigned a_off(const Unit& u, int r) const { return (unsigned)((u.pm * 256 + r) * lda) * 2u; }
    __device__ __forceinline__ const char* a_base(const Unit&) const { return (const char*)A; }
    __device__ __forceinline__ const char* b_base(const Unit& u) const { return (const char*)Bt + (size_t)u.pn * 256 * K * 2; }
};
struct MoeUpDesc {
    const bf16* H2; const int* list; const bf16* WguT; int K;
    __device__ __forceinline__ unsigned a_off(const Unit& u, int r) const { const int slot = u.row0 + r; int tok = 0; if (slot < u.cnt) tok = list[u.e * NTOK + slot] >> 2; return (unsigned)tok * 2048u; }
    __device__ __forceinline__ const char* a_base(const Unit&) const { return (const char*)H2; }
    __device__ __forceinline__ const char* b_base(const Unit& u) const { return (const char*)WguT + ((size_t)u.e * 2048 + (size_t)u.pn * 256) * 1024 * 2; }
};
struct MoeDownDesc {
    const bf16* ACT; const bf16* WdT; int K;
    __device__ __forceinline__ unsigned a_off(const Unit& u, int r) const { return (unsigned)(u.pm * 256 + r) * 2048u; }
    __device__ __forceinline__ const char* a_base(const Unit&) const { return (const char*)ACT; }
    __device__ __forceinline__ const char* b_base(const Unit& u) const { return (const char*)WdT + ((size_t)u.e * 1024 + (size_t)u.pn * 256) * 1024 * 2; }
};

template <class Desc, class Order, class Epi>
__device__ __forceinline__ void gemm_simple(const Desc& g, const Order& S, const Epi& E) {
    const int tid = threadIdx.x, wid = __builtin_amdgcn_readfirstlane(tid >> 6), lane = tid & 63, wr = wid >> 2, wc = wid & 3, fr = lane & 15, fq = lane >> 4;
    const int K = g.K;
    Unit u;
    for (int i = 0; S.next(i, u); ++i) {
        f32x4 acc[2][2][4][2];
#pragma unroll
        for (int a = 0; a < 2; ++a)
#pragma unroll
            for (int b = 0; b < 2; ++b)
#pragma unroll
                for (int m = 0; m < 4; ++m)
#pragma unroll
                    for (int n = 0; n < 2; ++n) acc[a][b][m][n] = (f32x4){0.f, 0.f, 0.f, 0.f};
        unsigned aoff[2][4], boff[2][2];
#pragma unroll
        for (int a = 0; a < 2; ++a)
#pragma unroll
            for (int m = 0; m < 4; ++m) aoff[a][m] = g.a_off(u, a * 128 + wr * 64 + m * 16 + fr) + fq * 16;
#pragma unroll
        for (int b = 0; b < 2; ++b)
#pragma unroll
            for (int n = 0; n < 2; ++n) { const int nc = b * 128 + wc * 32 + (Epi::PERM ? perm32(n * 16 + fr) : (n * 16 + fr)); boff[b][n] = (unsigned)(nc * K) * 2u + fq * 16; }
        const char* ab = g.a_base(u); const char* bb = g.b_base(u);
#pragma unroll 1
        for (int ks = 0; ks < K / 32; ++ks) {
            bf16x8 af[2][4], bfr[2][2];
#pragma unroll
            for (int a = 0; a < 2; ++a)
#pragma unroll
                for (int m = 0; m < 4; ++m) af[a][m] = *(const bf16x8*)(ab + aoff[a][m] + ks * 64);
#pragma unroll
            for (int b = 0; b < 2; ++b)
#pragma unroll
                for (int n = 0; n < 2; ++n) bfr[b][n] = *(const bf16x8*)(bb + boff[b][n] + ks * 64);
#pragma unroll
            for (int a = 0; a < 2; ++a)
#pragma unroll
                for (int b = 0; b < 2; ++b)
#pragma unroll
                    for (int m = 0; m < 4; ++m)
#pragma unroll
                        for (int n = 0; n < 2; ++n) acc[a][b][m][n] = __builtin_amdgcn_mfma_f32_16x16x32_bf16(bfr[b][n], af[a][m], acc[a][b][m][n], 0, 0, 0);
        }
        E(acc, u, wr, wc, fr, fq);
    }
}

__device__ __forceinline__ u32x4 pack8(const f32x4& v0, const f32x4& v1) { u32x4 w; w.x = pk2(v0[0], v0[1]); w.y = pk2(v0[2], v0[3]); w.z = pk2(v1[0], v1[1]); w.w = pk2(v1[2], v1[3]); return w; }
__device__ __forceinline__ void unpack8(const u32x4& w, f32x4& v0, f32x4& v1) { v0 = (f32x4){bflo(w.x), bfhi(w.x), bflo(w.y), bfhi(w.y)}; v1 = (f32x4){bflo(w.z), bfhi(w.z), bflo(w.w), bfhi(w.w)}; }
__device__ __forceinline__ float logsig16(float x) { return (fminf(x, 0.f) - log1pf(__expf(-fabsf(x)))) * (1.f / 16.f); }

struct EpiProj {
    static constexpr bool PERM = true;
    bf16* P; const float* b_alpha;
    __device__ __forceinline__ void operator()(const f32x4 (&acc)[2][2][4][2], const Unit& u, int wr, int wc, int fr, int fq) const {
        const int pn = u.pn; const int mode = (pn < 2) ? 1 : (pn == 6 ? 2 : (pn == 20 ? 3 : 0));
#pragma unroll
        for (int bj = 0; bj < 2; ++bj) {
            const int c0 = pn * 256 + bj * 128 + wc * 32 + 8 * fq;
            f32x4 b0 = (f32x4){0.f, 0.f, 0.f, 0.f}, b1 = b0;
            if (mode == 3) { b0 = *(const f32x4*)(b_alpha + (c0 - C_AL)); b1 = *(const f32x4*)(b_alpha + (c0 - C_AL) + 4); }
#pragma unroll
            for (int ai = 0; ai < 2; ++ai)
#pragma unroll
                for (int m = 0; m < 4; ++m) {
                    const int row = u.pm * 256 + ai * 128 + wr * 64 + m * 16 + fr;
                    f32x4 v0 = acc[ai][bj][m][0], v1 = acc[ai][bj][m][1];
                    if (mode == 1) { v0 = v0 * QSCALE; v1 = v1 * QSCALE; }
                    else if (mode == 2) { v0 = v0 * 0.125f; v1 = v1 * 0.125f; }
                    else if (mode == 3) {
#pragma unroll
                        for (int j = 0; j < 4; ++j) { v0[j] = logsig16(v0[j] + b0[j]); v1[j] = logsig16(v1[j] + b1[j]); } }
                    *(u32x4*)(P + (size_t)row * NPROJ + c0) = pack8(v0, v1);
                }
        }
    }
};
struct EpiBranch {
    static constexpr bool PERM = true;
    bf16* MG; const bf16* P; int gcol; int add;
    __device__ __forceinline__ void operator()(const f32x4 (&acc)[2][2][4][2], const Unit& u, int wr, int wc, int fr, int fq) const {
#pragma unroll
        for (int ai = 0; ai < 2; ++ai)
#pragma unroll
            for (int m = 0; m < 4; ++m) {
                const int row = u.pm * 256 + ai * 128 + wr * 64 + m * 16 + fr;
#pragma unroll
                for (int bj = 0; bj < 2; ++bj) {
                    const int c0 = u.pn * 256 + bj * 128 + wc * 32 + 8 * fq;
                    const u32x4 gw = *(const u32x4*)(P + (size_t)row * NPROJ + gcol + c0);
                    f32x4 g0, g1; unpack8(gw, g0, g1);
                    f32x4 v0 = acc[ai][bj][m][0], v1 = acc[ai][bj][m][1];
#pragma unroll
                    for (int j = 0; j < 4; ++j) { v0[j] *= sigmoidf_(g0[j]); v1[j] *= sigmoidf_(g1[j]); }
                    bf16* dst = MG + (size_t)row * DM + c0;
                    if (add) { const u32x4 ow = *(const u32x4*)dst; f32x4 o0, o1; unpack8(ow, o0, o1); v0 = v0 + o0; v1 = v1 + o1; }
                    *(u32x4*)dst = pack8(v0, v1);
                }
            }
    }
};
struct EpiOut {
    static constexpr bool PERM = false;
    const float* x; float* x1; const float* mod;
    __device__ __forceinline__ void operator()(const f32x4 (&acc)[2][2][4][2], const Unit& u, int wr, int wc, int fr, int fq) const {
        const int b = u.pm >> 3; const float* gt1 = mod + b * 6144 + 2048;
#pragma unroll
        for (int bj = 0; bj < 2; ++bj)
#pragma unroll
            for (int n = 0; n < 2; ++n) {
                const int c0 = u.pn * 256 + bj * 128 + wc * 32 + 16 * n + 4 * fq;
                const f32x4 gt = *(const f32x4*)(gt1 + c0);
#pragma unroll
                for (int ai = 0; ai < 2; ++ai)
#pragma unroll
                    for (int m = 0; m < 4; ++m) {
                        const size_t off = (size_t)(u.pm * 256 + ai * 128 + wr * 64 + m * 16 + fr) * DM + c0;
                        const f32x4 xv = *(const f32x4*)(x + off);
                        *(f32x4*)(x1 + off) = xv + gt * acc[ai][bj][m][n];
                    }
            }
    }
};
struct EpiUp {
    static constexpr bool PERM = true;
    bf16* ACT; const float* b_gu;
    __device__ __forceinline__ void operator()(const f32x4 (&acc)[2][2][4][2], const Unit& u, int wr, int wc, int fr, int fq) const {
        const int f0 = u.pn * 128 + wc * 32 + 8 * fq;
        const float* bg = b_gu + (size_t)u.e * 2048 + f0; const float* bu = bg + 1024;
        const f32x4 bg0 = *(const f32x4*)bg, bg1 = *(const f32x4*)(bg + 4), bu0 = *(const f32x4*)bu, bu1 = *(const f32x4*)(bu + 4);
#pragma unroll
        for (int ai = 0; ai < 2; ++ai)
#pragma unroll
            for (int m = 0; m < 4; ++m) {
                const int r = ai * 128 + wr * 64 + m * 16 + fr;
                f32x4 g0 = acc[ai][0][m][0] + bg0, g1 = acc[ai][0][m][1] + bg1, u0 = acc[ai][1][m][0] + bu0, u1 = acc[ai][1][m][1] + bu1, a0, a1;
#pragma unroll
                for (int j = 0; j < 4; ++j) {
                    float gg = fminf(g0[j], 7.f), uu = fminf(fmaxf(u0[j], -7.f), 7.f); a0[j] = (uu + 1.f) * gg * sigmoidf_(1.702f * gg);
                    gg = fminf(g1[j], 7.f); uu = fminf(fmaxf(u1[j], -7.f), 7.f); a1[j] = (uu + 1.f) * gg * sigmoidf_(1.702f * gg); }
                *(u32x4*)(ACT + (size_t)(u.pm * 256 + r) * FF + f0) = pack8(a0, a1);
            }
    }
};
struct EpiDown {
    static constexpr bool PERM = true;
    bf16* YB; const float* b_dn; const int* list;
    __device__ __forceinline__ void operator()(const f32x4 (&acc)[2][2][4][2], const Unit& u, int wr, int wc, int fr, int fq) const {
#pragma unroll
        for (int ai = 0; ai < 2; ++ai)
#pragma unroll
            for (int m = 0; m < 4; ++m) {
                const int slot = u.row0 + ai * 128 + wr * 64 + m * 16 + fr;
                if (slot < u.cnt) {
                    const int aid = list[u.e * NTOK + slot];
#pragma unroll
                    for (int bj = 0; bj < 2; ++bj) {
                        const int c0 = u.pn * 256 + bj * 128 + wc * 32 + 8 * fq;
                        const float* bp = b_dn + (size_t)u.e * DM + c0;
                        const f32x4 v0 = acc[ai][bj][m][0] + *(const f32x4*)bp, v1 = acc[ai][bj][m][1] + *(const f32x4*)(bp + 4);
                        *(u32x4*)(YB + (size_t)aid * DM + c0) = pack8(v0, v1);
                    }
                }
            }
    }
};

__device__ __forceinline__ void phase_mod(const Ctx& C) {
    LAS float* sc = (LAS float*)C.lds;
    LAS float* red = sc + 16 * 1024;
    for (int cb = C.bid; cb < 96; cb += C.G) {
        __syncthreads();
        for (int i = C.tid; i < 16 * 1024; i += NTHREADS) { const float v = C.c[i]; sc[i] = v / (1.f + __expf(-v)); }
        __syncthreads();
        const int cl = C.tid & 63, ks = C.tid >> 6, col = cb * 64 + cl;
        float acc[16];
#pragma unroll
        for (int b = 0; b < 16; ++b) acc[b] = 0.f;
#pragma unroll 4
        for (int k = ks * 128; k < ks * 128 + 128; ++k) {
            const float w = C.w_ada[(size_t)k * 6144 + col];
#pragma unroll
            for (int b = 0; b < 16; ++b) acc[b] += sc[b * 1024 + k] * w;
        }
#pragma unroll
        for (int b = 0; b < 16; ++b) red[(ks * 16 + b) * 64 + cl] = acc[b];
        __syncthreads();
        for (int o = C.tid; o < 1024; o += NTHREADS) {
            const int b = o >> 6, c2 = o & 63; float s = 0.f;
#pragma unroll
            for (int k2 = 0; k2 < 8; ++k2) s += red[(k2 * 16 + b) * 64 + c2];
            C.mod[b * 6144 + cb * 64 + c2] = s + C.b_ada[cb * 64 + c2];
        }
    }
    for (int gt = C.bid * NTHREADS + C.tid; gt < 256 * 512; gt += C.G * NTHREADS) {
        const int j = gt >> 9, k = (gt & 511) * 2;
        float s0 = 0.f, s1 = 0.f;
#pragma unroll
        for (int r = 0; r < 16; ++r) { const float wa = C.w_alpha_up[r * 256 + j]; s0 += C.w_in[(size_t)k * W_IN_N + 3072 + r] * wa; s1 += C.w_in[(size_t)(k + 1) * W_IN_N + 3072 + r] * wa; }
        *(unsigned*)(C.WinT + (size_t)(C_AL + j) * DM + k) = pk2(s0, s1);
    }
}

__device__ __forceinline__ void transpose_item(const float* W, int srcN, bf16* WT, int Kp, int dst_row0, int src_col0, int k0, LAS float* scr, int lane) {
#pragma unroll 8
    for (int i = 0; i < 32; ++i) { const int kk = 2 * i + (lane >> 5); scr[kk * 33 + (lane & 31)] = W[(size_t)(k0 + kk) * srcN + src_col0 + (lane & 31)]; }
    LDS_WAIT(); asm volatile("" ::: "memory");
    const int c = lane & 7;
#pragma unroll
    for (int j = 0; j < 4; ++j) { const int n = (lane >> 3) + 8 * j; const LAS float* s = scr + (8 * c) * 33 + n;
        u32x4 o; o.x = pk2(s[0 * 33], s[1 * 33]); o.y = pk2(s[2 * 33], s[3 * 33]); o.z = pk2(s[4 * 33], s[5 * 33]); o.w = pk2(s[6 * 33], s[7 * 33]);
        *(u32x4*)(WT + (size_t)(dst_row0 + n) * Kp + k0 + 8 * c) = o; }
    LDS_WAIT(); asm volatile("" ::: "memory");
}
__device__ __forceinline__ void phase_prep(const Ctx& C) {
    LAS float* scr = (LAS float*)(C.lds + C.wid * 16384);
    const int gw = C.bid * NWAVES + C.wid, NGW = C.G * NWAVES;
    constexpr int I_IN = 16 * 160, I_BD = 8 * 32, I_OUT = 16 * 32, I_GU = 32 * 16 * 64, I_DN = 32 * 16 * 32;
    constexpr int NITEMS = I_IN + 2 * I_BD + I_OUT + I_GU + I_DN;
    for (int it = gw; it < NITEMS; it += NGW) {
        int r = it;
        if (r < I_IN) { const int kb = r / 160, n0 = (r % 160) * 32; transpose_item(C.w_in, W_IN_N, C.WinT, DM, n0, n0 < 3072 ? n0 : n0 + 16, kb * 64, scr, C.lane); continue; } r -= I_IN;
        if (r < I_BD) { transpose_item(C.w_bd, DM, C.WbdT, 512, (r & 31) * 32, (r & 31) * 32, (r >> 5) * 64, scr, C.lane); continue; } r -= I_BD;
        if (r < I_BD) { transpose_item(C.w_bg, DM, C.WbgT, 512, (r & 31) * 32, (r & 31) * 32, (r >> 5) * 64, scr, C.lane); continue; } r -= I_BD;
        if (r < I_OUT) { transpose_item(C.w_out, DM, C.WoutT, DM, (r & 31) * 32, (r & 31) * 32, (r >> 5) * 64, scr, C.lane); continue; } r -= I_OUT;
        if (r < I_GU) { const int e = r >> 10, rr = r & 1023, kb = rr >> 6, n0 = (rr & 63) * 32; const int pn = n0 >> 8, bj = (n0 >> 7) & 1, j0 = n0 & 127;
            transpose_item(C.w_gu + (size_t)e * DM * 2048, 2048, C.WguT + (size_t)e * 2048 * DM, DM, n0, bj * 1024 + pn * 128 + j0, kb * 64, scr, C.lane); continue; } r -= I_GU;
        { const int e = r >> 9, rr = r & 511, kb = rr >> 5, n0 = (rr & 31) * 32;
            transpose_item(C.w_dn + (size_t)e * FF * DM, DM, C.WdT + (size_t)e * DM * FF, FF, n0, n0, kb * 64, scr, C.lane); }
    }
    for (int row = gw; row < NTOK; row += NGW) {
        const int b = row >> 11; const float* md = C.mod + b * 6144;
        f32x4 v[4]; float ss = 0.f;
#pragma unroll
        for (int j = 0; j < 4; ++j) { v[j] = *(const f32x4*)(C.x + (size_t)row * DM + 4 * C.lane + 256 * j); ss += (v[j][0] * v[j][0] + v[j][1] * v[j][1]) + (v[j][2] * v[j][2] + v[j][3] * v[j][3]); }
        const float rstd = rsqrtf(wave_sum(ss) * (1.f / DM) + EPS);
#pragma unroll
        for (int j = 0; j < 4; ++j) { const int c0 = 4 * C.lane + 256 * j;
            const f32x4 g = *(const f32x4*)(C.norm1_g + c0), sc = *(const f32x4*)(md + 1024 + c0), sh = *(const f32x4*)(md + c0);
            const f32x4 y = v[j] * rstd * g * (sc + 1.f) + sh;
            u32x2 o; o.x = pk2(y[0], y[1]); o.y = pk2(y[2], y[3]);
            *(u32x2*)(C.H + (size_t)row * DM + c0) = o; }
    }
}

__device__ __forceinline__ void gla_scan(const Ctx& C, int b, int h) {
    LAS float* qs = (LAS float*)C.lds;
    LAS float* ks = qs + 2048;
    LAS float* al = ks + 2048;
    LAS float* vs = al + 2048;
    LAS float* part = vs + 4096;
    const int dv = C.tid & 127, dkg = C.tid >> 7;
    float S[16];
#pragma unroll
    for (int j = 0; j < 16; ++j) S[j] = 0.f;
    const float gdv0 = C.gla_g[2 * C.lane], gdv1 = C.gla_g[2 * C.lane + 1];
    for (int ch = 0; ch < SEQ / 32; ++ch) {
        const int row0 = b * SEQ + ch * 32;
        __syncthreads();
        for (int i = C.tid; i < 32 * 64; i += NTHREADS) { const int t = i >> 6, d = i & 63; const bf16* pr = C.PROJ + (size_t)(row0 + t) * NPROJ;
            qs[i] = bf2f(pr[C_GQ + h * 64 + d]); ks[i] = bf2f(pr[C_GK + h * 64 + d]); al[i] = __expf(bf2f(pr[C_AL + h * 64 + d])); }
        for (int i = C.tid; i < 32 * 128; i += NTHREADS) { const int t = i >> 7, d = i & 127; vs[i] = bf2f(C.PROJ[(size_t)(row0 + t) * NPROJ + C_GV + h * 128 + d]); }
        __syncthreads();
#pragma unroll 2
        for (int t = 0; t < 32; ++t) {
            const float v = vs[t * 128 + dv]; float o = 0.f;
#pragma unroll
            for (int j4 = 0; j4 < 4; ++j4) {
                const f32x4 a4 = *(const LAS f32x4*)(al + t * 64 + dkg * 16 + j4 * 4), k4 = *(const LAS f32x4*)(ks + t * 64 + dkg * 16 + j4 * 4), q4 = *(const LAS f32x4*)(qs + t * 64 + dkg * 16 + j4 * 4);
#pragma unroll
                for (int jj = 0; jj < 4; ++jj) { const int j = j4 * 4 + jj; S[j] = a4[jj] * S[j] + k4[jj] * v; o += q4[jj] * S[j]; }
            }
            part[(dkg * 32 + t) * 128 + dv] = o;
        }
        __syncthreads();
#pragma unroll
        for (int tt = 0; tt < 4; ++tt) {
            const int t = 4 * C.wid + tt; float o0 = 0.f, o1 = 0.f;
#pragma unroll
            for (int g = 0; g < 4; ++g) { o0 += part[(g * 32 + t) * 128 + 2 * C.lane]; o1 += part[(g * 32 + t) * 128 + 2 * C.lane + 1]; }
            const float rstd = rsqrtf(wave_sum(o0 * o0 + o1 * o1) * (1.f / 128.f) + EPS);
            const unsigned grw = *(const unsigned*)(C.PROJ + (size_t)(row0 + t) * NPROJ + C_GR + h * 128 + 2 * C.lane);
            const float g0 = bflo(grw), g1 = bfhi(grw);
            const float y0 = o0 * rstd * gdv0 * (g0 * sigmoidf_(g0)), y1 = o1 * rstd * gdv1 * (g1 * sigmoidf_(g1));
            *(unsigned*)(C.OB + (size_t)(row0 + t) * 512 + h * 128 + 2 * C.lane) = pk2(y0, y1);
        }
    }
}

__device__ __forceinline__ void attn_simple(const Ctx& C) {
    LAS float* Kt = (LAS float*)C.lds;
    LAS float* Vt = Kt + 8192;
    LAS float* Ss = Vt + 8192;
    LAS float* ssq = Ss + 2 * 64 * 68;
    LAS float* lamp = ssq + 256;
    if (C.tid < 64) {
        const float a = wave_sum(C.lq1[C.lane] * C.lk1[C.lane]), b2 = wave_sum(C.lq2[C.lane] * C.lk2[C.lane]);
        if (C.tid == 0) lamp[0] = __expf(a) - __expf(b2) + 0.2f;
    }
    __syncthreads();
    const float lam = lamp[0];
    const int q = C.tid & 63, p = (C.tid >> 6) & 1, dq = C.tid >> 7;
    for (int uix = C.bid; uix < 2048; uix += C.G) {
        const int bh = uix & 63, g = (uix >> 6) & 3, i2 = uix >> 8; const int b = bh >> 2, h = bh & 3;
        const int qc = (i2 & 1) ? (31 - (4 * g + (i2 >> 1))) : (4 * g + (i2 >> 1));
        const float sl2 = exp2f(-2.f * (float)(h + 1)) * LOG2E;
        const int qrow = b * SEQ + qc * 64 + q;
        float qv[64];
#pragma unroll
        for (int d8 = 0; d8 < 8; ++d8) { const u32x4 w = *(const u32x4*)(C.PROJ + (size_t)qrow * NPROJ + C_DQ + h * 128 + p * 64 + d8 * 8);
            qv[d8 * 8 + 0] = bflo(w.x); qv[d8 * 8 + 1] = bfhi(w.x); qv[d8 * 8 + 2] = bflo(w.y); qv[d8 * 8 + 3] = bfhi(w.y);
            qv[d8 * 8 + 4] = bflo(w.z); qv[d8 * 8 + 5] = bfhi(w.z); qv[d8 * 8 + 6] = bflo(w.w); qv[d8 * 8 + 7] = bfhi(w.w); }
        float m = -1e30f, l = 0.f, acc[32];
#pragma unroll
        for (int d = 0; d < 32; ++d) acc[d] = 0.f;
        for (int kc = 0; kc <= qc; ++kc) {
            __syncthreads();
            for (int pi = C.tid; pi < 1024; pi += NTHREADS) { const int r = pi >> 4, cc = pi & 15; const bf16* pr = C.PROJ + (size_t)(b * SEQ + kc * 64 + r) * NPROJ + h * 128 + cc * 8;
                const u32x4 kw = *(const u32x4*)(pr + C_DK), vw = *(const u32x4*)(pr + C_DV); f32x4 a0, a1;
                unpack8(kw, a0, a1); *(LAS f32x4*)(Kt + r * 128 + cc * 8) = a0; *(LAS f32x4*)(Kt + r * 128 + cc * 8 + 4) = a1;
                unpack8(vw, a0, a1); *(LAS f32x4*)(Vt + r * 128 + cc * 8) = a0; *(LAS f32x4*)(Vt + r * 128 + cc * 8 + 4) = a1; }
            __syncthreads();
#pragma unroll 1
            for (int kk = 0; kk < 16; ++kk) {
                const int key = dq * 16 + kk; float s = 0.f;
#pragma unroll
                for (int d4 = 0; d4 < 16; ++d4) { const f32x4 kv = *(const LAS f32x4*)(Kt + key * 128 + p * 64 + d4 * 4);
                    s += qv[d4 * 4] * kv[0]; s += qv[d4 * 4 + 1] * kv[1]; s += qv[d4 * 4 + 2] * kv[2]; s += qv[d4 * 4 + 3] * kv[3]; }
                const int kpos = kc * 64 + key, qpos = qc * 64 + q; const int mn = kpos < 2 * qpos - kpos ? kpos : 2 * qpos - kpos;
                Ss[(p * 64 + q) * 68 + key] = s + sl2 * (float)mn;
            }
            __syncthreads();
            const LAS float* srow = Ss + (p * 64 + q) * 68;
            float cm = -1e30f;
#pragma unroll
            for (int k4 = 0; k4 < 16; ++k4) { const f32x4 sv = *(const LAS f32x4*)(srow + k4 * 4); cm = fmaxf(cm, fmaxf(fmaxf(sv[0], sv[1]), fmaxf(sv[2], sv[3]))); }
            const float mnew = fmaxf(m, cm), alpha = exp2f(m - mnew); m = mnew; l *= alpha;
#pragma unroll
            for (int d = 0; d < 32; ++d) acc[d] *= alpha;
#pragma unroll 2
            for (int key = 0; key < 64; ++key) {
                const float pk = exp2f(srow[key] - m); l += pk;
#pragma unroll
                for (int d4 = 0; d4 < 8; ++d4) { const f32x4 vv = *(const LAS f32x4*)(Vt + key * 128 + dq * 32 + d4 * 4);
                    acc[d4 * 4] += pk * vv[0]; acc[d4 * 4 + 1] += pk * vv[1]; acc[d4 * 4 + 2] += pk * vv[2]; acc[d4 * 4 + 3] += pk * vv[3]; }
            }
        }
        const float inv = 1.f / l;
        __syncthreads();
        LAS float* O2 = Ss;
        if (p == 1) {
#pragma unroll
            for (int d = 0; d < 32; ++d) O2[q * 128 + dq * 32 + d] = lam * acc[d] * inv;
        }
        __syncthreads();
        float ss = 0.f;
        if (p == 0) {
#pragma unroll
            for (int d = 0; d < 32; ++d) { acc[d] = acc[d] * inv - O2[q * 128 + dq * 32 + d]; ss += acc[d] * acc[d]; }
            ssq[q * 4 + dq] = ss;
        }
        __syncthreads();
        if (p == 0) {
            const float tot = (ssq[q * 4] + ssq[q * 4 + 1]) + (ssq[q * 4 + 2] + ssq[q * 4 + 3]);
            const float rstd = rsqrtf(tot * (1.f / 128.f) + EPS) * 0.8f;
            bf16* dst = C.OA + (size_t)qrow * 512 + h * 128 + dq * 32;
#pragma unroll
            for (int d8 = 0; d8 < 4; ++d8) { u32x4 w; const float* gg = C.diff_g + dq * 32 + d8 * 8;
                w.x = pk2(acc[d8 * 8] * rstd * gg[0], acc[d8 * 8 + 1] * rstd * gg[1]); w.y = pk2(acc[d8 * 8 + 2] * rstd * gg[2], acc[d8 * 8 + 3] * rstd * gg[3]);
                w.z = pk2(acc[d8 * 8 + 4] * rstd * gg[4], acc[d8 * 8 + 5] * rstd * gg[5]); w.w = pk2(acc[d8 * 8 + 6] * rstd * gg[6], acc[d8 * 8 + 7] * rstd * gg[7]);
                *(u32x4*)(dst + d8 * 8) = w; }
        }
    }
}

__device__ __forceinline__ void phase_router(const Ctx& C) {
    constexpr int WP = 1028;
    LAS float* WrT = (LAS float*)C.lds;
    LAS int* lcnt = (LAS int*)(WrT + 32 * WP);
    LAS int* lbase = lcnt + 32;
    LAS int* pend = lbase + 32;
    for (int i = C.tid; i < DM * NE; i += NTHREADS) { const int k = i >> 5, e = i & 31; WrT[e * WP + k] = C.w_router[i]; }
    if (C.tid < 32) lcnt[C.tid] = 0;
    for (int i = C.tid; i < 512; i += NTHREADS) pend[i] = -1;
    __syncthreads();
    const int gw = C.bid * NWAVES + C.wid, NGW = C.G * NWAVES;
    const float myb = C.b_router[C.lane >> 1];
    int it = 0;
    for (int row = gw; row < NTOK; row += NGW, ++it) {
        const int b = row >> 11; const float* md = C.mod + b * 6144;
        f32x4 v[4]; float ss = 0.f;
#pragma unroll
        for (int j = 0; j < 4; ++j) { v[j] = *(const f32x4*)(C.out + (size_t)row * DM + 4 * C.lane + 256 * j); ss += (v[j][0] * v[j][0] + v[j][1] * v[j][1]) + (v[j][2] * v[j][2] + v[j][3] * v[j][3]); }
        const float rstd = rsqrtf(wave_sum(ss) * (1.f / DM) + EPS);
#pragma unroll
        for (int j = 0; j < 4; ++j) { const int c0 = 4 * C.lane + 256 * j;
            const f32x4 g = *(const f32x4*)(C.norm2_g + c0), sc = *(const f32x4*)(md + 4096 + c0), sh = *(const f32x4*)(md + 3072 + c0);
            v[j] = v[j] * rstd * g * (sc + 1.f) + sh;
            u32x2 o; o.x = pk2(v[j][0], v[j][1]); o.y = pk2(v[j][2], v[j][3]);
            *(u32x2*)(C.H2 + (size_t)row * DM + c0) = o; }
        float a[32];
#pragma unroll
        for (int e = 0; e < 32; ++e) { float s = 0.f;
#pragma unroll
            for (int j = 0; j < 4; ++j) { const f32x4 w = *(const LAS f32x4*)(WrT + e * WP + 4 * C.lane + 256 * j); s += (v[j][0] * w[0] + v[j][1] * w[1]) + (v[j][2] * w[2] + v[j][3] * w[3]); }
            a[e] = s; }
#pragma unroll
        for (int i = 0; i < 16; ++i) { const bool hi = (C.lane & 32) != 0; const float send = hi ? a[i] : a[i + 16], keep = hi ? a[i + 16] : a[i]; a[i] = keep + __shfl_xor(send, 32); }
#pragma unroll
        for (int i = 0; i < 8; ++i) { const bool hi = (C.lane & 16) != 0; const float send = hi ? a[i] : a[i + 8], keep = hi ? a[i + 8] : a[i]; a[i] = keep + __shfl_xor(send, 16); }
#pragma unroll
        for (int i = 0; i < 4; ++i) { const bool hi = (C.lane & 8) != 0; const float send = hi ? a[i] : a[i + 4], keep = hi ? a[i + 4] : a[i]; a[i] = keep + __shfl_xor(send, 8); }
#pragma unroll
        for (int i = 0; i < 2; ++i) { const bool hi = (C.lane & 4) != 0; const float send = hi ? a[i] : a[i + 2], keep = hi ? a[i + 2] : a[i]; a[i] = keep + __shfl_xor(send, 4); }
        { const bool hi = (C.lane & 2) != 0; const float send = hi ? a[0] : a[1], keep = hi ? a[1] : a[0]; a[0] = keep + __shfl_xor(send, 2); }
        float val = a[0] + __shfl_xor(a[0], 1) + myb; const int idx = C.lane >> 1;
        float tv[4]; int ti[4];
#pragma unroll
        for (int r = 0; r < 4; ++r) {
            float bv = val; int bi = idx;
#pragma unroll
            for (int o = 32; o >= 1; o >>= 1) { const float ov = __shfl_xor(bv, o); const int oi = __shfl_xor(bi, o); if (ov > bv || (ov == bv && oi < bi)) { bv = ov; bi = oi; } }
            tv[r] = bv; ti[r] = bi; if (idx == bi) val = -3.0e38f;
        }
        const float e1 = __expf(tv[1] - tv[0]), e2 = __expf(tv[2] - tv[0]), e3 = __expf(tv[3] - tv[0]); const float inv = 1.f / (1.f + e1 + e2 + e3);
        if (C.lane == 0) { *(f32x4*)(C.topw + (size_t)row * 4) = (f32x4){inv, e1 * inv, e2 * inv, e3 * inv}; *(i32x4*)(C.tope + (size_t)row * 4) = (i32x4){ti[0], ti[1], ti[2], ti[3]}; }
        if (C.lane < 4) { const int e = C.lane == 0 ? ti[0] : (C.lane == 1 ? ti[1] : (C.lane == 2 ? ti[2] : ti[3]));
            const int slot = atomicAdd((int*)(lcnt + e), 1); pend[(it * 8 + C.wid) * 4 + C.lane] = (e << 16) | slot; }
    }
    __syncthreads();
    if (C.tid < 32) lbase[C.tid] = (int)__hip_atomic_fetch_add(C.ctl + CW_CNT + 64 * C.tid, (unsigned)lcnt[C.tid], RLX_AGENT);
    __syncthreads();
    for (int i = C.tid; i < 512; i += NTHREADS) { const int pv = pend[i]; if (pv >= 0) { const int e = pv >> 16, slot = pv & 0xffff; const int it2 = i >> 5, w = (i >> 2) & 7, r = i & 3;
        const int row = C.bid * NWAVES + w + it2 * NGW; C.list[e * NTOK + lbase[e] + slot] = row * 4 + r; } }
}

__device__ __forceinline__ void phase_final(const Ctx& C) {
    const int gw = C.bid * NWAVES + C.wid, NGW = C.G * NWAVES;
    for (int row = gw; row < NTOK; row += NGW) {
        const int b = row >> 11; const float* gt2 = C.mod + b * 6144 + 5120;
        const f32x4 w = *(const f32x4*)(C.topw + (size_t)row * 4);
        f32x4 v[4]; float ss = 0.f;
#pragma unroll
        for (int j = 0; j < 4; ++j) { const int c0 = 4 * C.lane + 256 * j;
            f32x4 y = (f32x4){0.f, 0.f, 0.f, 0.f};
#pragma unroll
            for (int k = 0; k < 4; ++k) { const u32x2 yw = *(const u32x2*)(C.YB + (size_t)(row * 4 + k) * DM + c0); y = y + (f32x4){bflo(yw.x), bfhi(yw.x), bflo(yw.y), bfhi(yw.y)} * w[k]; }
            v[j] = *(const f32x4*)(C.out + (size_t)row * DM + c0) + *(const f32x4*)(gt2 + c0) * y;
            ss += (v[j][0] * v[j][0] + v[j][1] * v[j][1]) + (v[j][2] * v[j][2] + v[j][3] * v[j][3]); }
        const float rstd = rsqrtf(wave_sum(ss) * (1.f / DM) + EPS);
#pragma unroll
        for (int j = 0; j < 4; ++j) { const int c0 = 4 * C.lane + 256 * j; *(f32x4*)(C.out + (size_t)row * DM + c0) = v[j] * rstd * *(const f32x4*)(C.final_g + c0); }
    }
}

struct Args { const float* in[25]; float* out; unsigned char* ws; };
__global__ void __launch_bounds__(NTHREADS, 2) fwd_kernel(Args args) {
    extern __shared__ __attribute__((aligned(16))) unsigned char lds[];
    Ctx C;
    C.lds = (LAS unsigned char*)lds;
    C.tid = threadIdx.x; C.lane = C.tid & 63; C.wid = __builtin_amdgcn_readfirstlane(C.tid >> 6); C.G = gridDim.x; C.bid = blockIdx.x;
    C.x = args.in[0]; C.c = args.in[1]; C.w_ada = args.in[2]; C.b_ada = args.in[3]; C.norm1_g = args.in[4]; C.w_in = args.in[5];
    C.lq1 = args.in[6]; C.lk1 = args.in[7]; C.lq2 = args.in[8]; C.lk2 = args.in[9]; C.diff_g = args.in[10]; C.w_alpha_up = args.in[11]; C.b_alpha = args.in[12];
    C.gla_g = args.in[13]; C.w_bd = args.in[14]; C.w_bg = args.in[15]; C.w_out = args.in[16]; C.norm2_g = args.in[17]; C.w_router = args.in[18]; C.b_router = args.in[19];
    C.w_gu = args.in[20]; C.b_gu = args.in[21]; C.w_dn = args.in[22]; C.b_dn = args.in[23]; C.final_g = args.in[24];
    C.out = args.out;
    unsigned char* ws = args.ws;
    C.ctl = (unsigned*)(ws + WS_CTL); C.mod = (float*)(ws + WS_MOD); C.tope = (int*)(ws + WS_TOPE); C.topw = (float*)(ws + WS_TOPW); C.list = (int*)(ws + WS_LIST);
    C.WinT = (bf16*)(ws + WS_WIN); C.WbdT = (bf16*)(ws + WS_WBD); C.WbgT = (bf16*)(ws + WS_WBG); C.WoutT = (bf16*)(ws + WS_WOUT); C.WguT = (bf16*)(ws + WS_WGU); C.WdT = (bf16*)(ws + WS_WD);
    C.H = (bf16*)(ws + WS_H); C.H2 = (bf16*)(ws + WS_H2); C.OA = (bf16*)(ws + WS_OA); C.OB = (bf16*)(ws + WS_OB); C.MG = (bf16*)(ws + WS_MG); C.YB = (bf16*)(ws + WS_YB);
    C.PROJ = (bf16*)(ws + WS_PROJ); C.ACT = (bf16*)(ws + WS_ACT);

    for (int u = C.tid; u < (LDS_BYTES - LDSCTL_OFF) / 4; u += NTHREADS) ((LAS unsigned*)(C.lds + LDSCTL_OFF))[u] = 0u;
    __syncthreads();
    volatile LAS unsigned* MISC = (volatile LAS unsigned*)(C.lds + MISC_OFF);
    XcdBarrier bar = xcd_barrier_post(C.ctl + CW_BAR, MISC + 8);
#define GRID_BAR() xcd_barrier(bar)

    phase_mod(C);
    GRID_BAR();
    phase_prep(C);
    GRID_BAR();
    { DenseDesc g{C.H, DM, C.WinT, DM}; TileOrder S; S.init(NTOK / 256, NPROJ / 256, C.G, C.bid); EpiProj E{C.PROJ, C.b_alpha}; gemm_simple(g, S, E); }
    GRID_BAR();
    for (int s = C.bid; s < 64; s += C.G) gla_scan(C, s >> 2, s & 3);
    __syncthreads();
    attn_simple(C);
    GRID_BAR();
    { DenseDesc g{C.OA, 512, C.WbdT, 512}; TileOrder S; S.init(NTOK / 256, DM / 256, C.G, C.bid); EpiBranch E{C.MG, C.PROJ, C_GA, 0}; gemm_simple(g, S, E); }
    GRID_BAR();
    { DenseDesc g{C.OB, 512, C.WbgT, 512}; TileOrder S; S.init(NTOK / 256, DM / 256, C.G, C.bid); EpiBranch E{C.MG, C.PROJ, C_GB, 1}; gemm_simple(g, S, E); }
    GRID_BAR();
    { DenseDesc g{C.MG, DM, C.WoutT, DM}; TileOrder S; S.init(NTOK / 256, DM / 256, C.G, C.bid); EpiOut E{C.x, C.out, C.mod}; gemm_simple(g, S, E); }
    GRID_BAR();
    phase_router(C);
    GRID_BAR();
    LAS int* tab = (LAS int*)C.lds;
    __syncthreads();
    if (C.tid == 0) { int ts = 0; for (int e = 0; e < NE; ++e) { const int cnt = (int)__hip_atomic_load(C.ctl + CW_CNT + 64 * e, RLX_AGENT); tab[e] = cnt; tab[32 + e] = ts; ts += (cnt + 255) >> 8; } tab[64] = ts; }
    __syncthreads();
    const int T = tab[64];
    { MoeUpDesc g{C.H2, C.list, C.WguT, DM}; MoeOrder S; S.t.init(T, 8, C.G, C.bid); S.tab = tab; EpiUp E{C.ACT, C.b_gu}; gemm_simple(g, S, E); }
    GRID_BAR();
    { MoeDownDesc g{C.ACT, C.WdT, FF}; MoeOrder S; S.t.init(T, 4, C.G, C.bid); S.tab = tab; EpiDown E{C.YB, C.b_dn, C.list}; gemm_simple(g, S, E); }
    GRID_BAR();
    phase_final(C);
}

extern "C" void kernel_launch(void* const* d_in, const int* in_sizes, int n_in, void* d_out, int out_size, void* d_ws, size_t ws_size, hipStream_t stream) {
    static int grid = 0;
    if (grid == 0) {
        if (n_in != 25 || in_sizes[0] != NTOK * DM || out_size != NTOK * DM || ws_size < WS_END) {
            fprintf(stderr, "kernel_launch: unexpected shapes (n_in %d, in0 %d, out %d, ws %zu < %zu)\n", n_in, n_in > 0 ? in_sizes[0] : -1, out_size, ws_size, (size_t)WS_END); grid = -1; return; }
        int dev = 0, cus = 0;
        if (hipGetDevice(&dev) != hipSuccess || hipDeviceGetAttribute(&cus, hipDeviceAttributeMultiprocessorCount, dev) != hipSuccess) { grid = -1; return; }
        if (hipFuncSetAttribute((const void*)fwd_kernel, hipFuncAttributeMaxDynamicSharedMemorySize, LDS_BYTES) != hipSuccess) { fprintf(stderr, "kernel_launch: hipFuncSetAttribute failed\n"); grid = -1; return; }
        (void)hipGetLastError();
        grid = cus;
    }
    if (grid < 0) return;
    if (hipMemsetAsync((char*)d_ws + WS_CTL, 0, CTL_ZERO_BYTES, stream) != hipSuccess) { fprintf(stderr, "kernel_launch: memset failed\n"); return; }
    Args a{};
    for (int i = 0; i < 25; ++i) a.in[i] = (const float*)d_in[i];
    a.out = (float*)d_out; a.ws = (unsigned char*)d_ws;
    hipLaunchKernelGGL(fwd_kernel, dim3(grid), dim3(NTHREADS), LDS_BYTES, stream, a);
}
```

```cpp
#include <hip/hip_runtime.h>
#include <cstdio>
#include <cstdint>

#define GAS __attribute__((address_space(1)))
#define LAS __attribute__((address_space(3)))
typedef unsigned short bf16;
typedef short bf16x8 __attribute__((ext_vector_type(8)));
typedef float f32x4 __attribute__((ext_vector_type(4)));
typedef unsigned u32x4 __attribute__((ext_vector_type(4)));
typedef unsigned u32x2 __attribute__((ext_vector_type(2)));
typedef int i32x4 __attribute__((ext_vector_type(4)));
typedef GAS unsigned gu32;

constexpr int NB = 16, SEQ = 2048, DM = 1024, NTOK = NB * SEQ, NE = 32, FF = 1024;
constexpr int NPROJ = 5376;
constexpr int C_DQ = 0, C_DK = 512, C_DV = 1024, C_GQ = 1536, C_GK = 1792, C_GV = 2048, C_GR = 2560, C_GA = 3072, C_GB = 4096, C_AL = 5120;
constexpr int W_IN_N = 5136;
constexpr float LOG2E = 1.4426950408889634f;
constexpr float QSCALE = 0.125f * LOG2E;
constexpr float EPS = 1e-6f;
constexpr int NWAVES = 8, NTHREADS = 512;

constexpr size_t MiB = 1u << 20;
constexpr size_t WS_CTL = 0, CTL_ZERO_BYTES = 1 * MiB;
constexpr size_t WS_MOD = 1 * MiB;
constexpr size_t WS_TOPE = 2 * MiB;
constexpr size_t WS_TOPW = 3 * MiB;
constexpr size_t WS_LIST = 4 * MiB;
constexpr size_t WS_WIN = 8 * MiB;
constexpr size_t WS_WBD = 19 * MiB;
constexpr size_t WS_WBG = 20 * MiB;
constexpr size_t WS_WOUT = 21 * MiB;
constexpr size_t WS_WGU = 24 * MiB;
constexpr size_t WS_WD = 152 * MiB;
constexpr size_t WS_H2 = 216 * MiB;
constexpr size_t WS_RB = 280 * MiB;
constexpr size_t WS_H = WS_RB, WS_OA = WS_RB + 64 * MiB, WS_OB = WS_RB + 96 * MiB, WS_MG = WS_RB + 128 * MiB, WS_YB = WS_RB;
constexpr size_t WS_RA = 536 * MiB;
constexpr size_t WS_PROJ = WS_RA, WS_ACT = WS_RA;
constexpr size_t WS_END = 872 * MiB;
constexpr int MAX_TILES = 544;
static_assert((size_t)MAX_TILES * 256 * 1024 * 2 <= 336 * MiB, "act fits region A");
constexpr int CW_CNT = 64;
constexpr int CW_BAR = 4096;

constexpr int SCR_BYTES = 147456;
constexpr int LDSCTL_OFF = SCR_BYTES, MISC_OFF = LDSCTL_OFF + 320;
constexpr int LDS_BYTES = SCR_BYTES + 1024;

#define RLX_AGENT __ATOMIC_RELAXED, __HIP_MEMORY_SCOPE_AGENT
#define LDS_WAIT() asm volatile("s_waitcnt lgkmcnt(0)" ::: "memory")

__device__ __forceinline__ unsigned f2bf(float f) { unsigned u = __builtin_bit_cast(unsigned, f); return (u + 0x7fffu + ((u >> 16) & 1u)) >> 16; }
__device__ __forceinline__ unsigned pk2(float lo, float hi) { return f2bf(lo) | (f2bf(hi) << 16); }
__device__ __forceinline__ float bf2f(unsigned b) { return __uint_as_float(b << 16); }
__device__ __forceinline__ float bflo(unsigned w) { return __uint_as_float(w << 16); }
__device__ __forceinline__ float bfhi(unsigned w) { return __uint_as_float(w & 0xffff0000u); }
__device__ __forceinline__ float wave_sum(float v) {
#pragma unroll
    for (int o = 1; o < 64; o <<= 1) v += __shfl_xor(v, o);
    return v;
}
__device__ __forceinline__ float sigmoidf_(float x) { return 1.f / (1.f + __expf(-x)); }

#define XB_TMO      128
#define XB_XCNT(j)  (256  + 64 * (j))
#define XB_XSUB(j)  (1280 + 64 * (j))
#define XB_XGEN(j)  (2304 + 64 * (j))
#define XB_TOP      3328
#define XB_TOPGEN   3392
#define XCD_BAR_WORDS 3456
#define XB_SPIN_CAP (1u << 22)
__device__ __forceinline__ unsigned xb_ld(unsigned* p)              { return __hip_atomic_load(p, __ATOMIC_RELAXED, __HIP_MEMORY_SCOPE_AGENT); }
__device__ __forceinline__ unsigned xb_add(unsigned* p, unsigned v) { return __hip_atomic_fetch_add(p, v, __ATOMIC_RELAXED, __HIP_MEMORY_SCOPE_AGENT); }
__device__ __forceinline__ unsigned xb_xcc_id() { return (unsigned)__builtin_amdgcn_s_getreg((3 << 11) | 20) & 0xFu; }
#define XB_SPIN(cond, bar) do { unsigned _sp = 0; while (cond) { __builtin_amdgcn_s_sleep(1); \
    if ((++_sp & 255u) == 0u) { if (xb_ld(&(bar)[XB_TMO])) break; if (_sp > XB_SPIN_CAP) { atomicAdd(&(bar)[XB_TMO], 1u); break; } } } } while (0)
struct XcdBarrier { unsigned* bar; unsigned x; volatile LAS unsigned* st; };
__device__ __forceinline__ XcdBarrier xcd_barrier_post(unsigned* bar, volatile LAS unsigned* st) {
    XcdBarrier b; b.bar = bar; b.x = xb_xcc_id(); b.st = st;
    if (threadIdx.x == 0) (void)xb_add(&bar[XB_XCNT(b.x)], 1u);
    return b;
}
__device__ __forceinline__ void xcd_barrier_complete(unsigned* bar, unsigned x, unsigned& nloc, unsigned& nx) {
    const unsigned G = gridDim.x * gridDim.y * gridDim.z;
    unsigned sum, cnt, mine, sp = 0u;
    for (;;) {
        sum = 0u; cnt = 0u; mine = 0u;
#pragma unroll
        for (unsigned j = 0; j < 16; ++j) { const unsigned c = xb_ld(&bar[XB_XCNT(j)]); sum += c; cnt += (c > 0u) ? 1u : 0u; mine = (j == x) ? c : mine; }
        if (sum == G) break;
        __builtin_amdgcn_s_sleep(1);
        if ((++sp & 255u) == 0u) { if (xb_ld(&bar[XB_TMO])) break; if (sp > XB_SPIN_CAP) { atomicAdd(&bar[XB_TMO], 1u); break; } }
    }
    nloc = mine > 0u ? mine : 1u; nx = cnt > 0u ? cnt : 1u;
}
__device__ __forceinline__ void xcd_barrier(const XcdBarrier& b) {
    asm volatile("s_waitcnt vmcnt(0)" ::: "memory");
    __syncthreads();
    if (threadIdx.x == 0) {
        unsigned* bar = b.bar;
        __builtin_amdgcn_s_waitcnt(0);
        unsigned nloc = b.st[0], nx = b.st[1];
        if (nloc == 0u) { xcd_barrier_complete(bar, b.x, nloc, nx); b.st[0] = nloc; b.st[1] = nx; }
        const unsigned old = xb_add(&bar[XB_XSUB(b.x)], 1u);
        const unsigned gen = old / nloc;
        if (old + 1u == (gen + 1u) * nloc) {
            __builtin_amdgcn_fence(__ATOMIC_RELEASE, "agent");
            asm volatile("s_waitcnt vmcnt(0)" ::: "memory");
            const unsigned og = xb_add(&bar[XB_TOP], 1u);
            const unsigned tg = og / nx;
            if (og + 1u == (tg + 1u) * nx) xb_add(&bar[XB_TOPGEN], 1u);
            else XB_SPIN(xb_ld(&bar[XB_TOPGEN]) == tg, bar);
            __builtin_amdgcn_fence(__ATOMIC_ACQUIRE, "agent");
            xb_add(&bar[XB_XGEN(b.x)], 1u);
            asm volatile("s_waitcnt vmcnt(0)" ::: "memory");
        } else {
            XB_SPIN(xb_ld(&bar[XB_XGEN(b.x)]) == gen, bar);
            __builtin_amdgcn_fence(__ATOMIC_ACQUIRE, "agent");
            asm volatile("s_waitcnt vmcnt(0)" ::: "memory");
        }
    }
    __syncthreads();
}

struct Ctx {
    LAS unsigned char* lds;
    int tid, lane, wid, G, bid;
    const float *x, *c, *w_ada, *b_ada, *norm1_g, *w_in, *lq1, *lk1, *lq2, *lk2, *diff_g, *w_alpha_up, *b_alpha, *gla_g,
                *w_bd, *w_bg, *w_out, *norm2_g, *w_router, *b_router, *w_gu, *b_gu, *w_dn, *b_dn, *final_g;
    float* out;
    unsigned* ctl; float* mod; int* tope; float* topw; int* list;
    bf16 *WinT, *WbdT, *WbgT, *WoutT, *WguT, *WdT, *H, *H2, *OA, *OB, *MG, *YB, *PROJ, *ACT;
};

constexpr int NXCD = 8, WGM = 8;
__host__ __device__ __forceinline__ int perm32(int rho) { const int n = rho >> 4, i = rho & 15; return 8 * (i >> 2) + 4 * n + (i & 3); }
struct Unit { int pm, pn, e, row0, cnt; };
struct TileOrder {
    int nM, nN, nwg, G, c;
    __device__ __forceinline__ void init(int nM_, int nN_, int G_, int c_) { nM = nM_; nN = nN_; nwg = nM * nN; G = G_; c = c_; }
    __device__ __forceinline__ bool next(int i, Unit& u) const {
        const long L = (long)i * G + c; if (L >= nwg) return false;
        int wgid = (int)L; { const int q = nwg / NXCD, r = nwg % NXCD, xcd = wgid % NXCD, off = wgid / NXCD; wgid = (xcd < r ? xcd * (q + 1) : r * (q + 1) + (xcd - r) * q) + off; }
        const int nig = WGM * nN, gid = wgid / nig, fm = gid * WGM, gsz = (nM - fm) < WGM ? (nM - fm) : WGM;
        u.pm = fm + ((wgid % nig) % gsz); u.pn = (wgid % nig) / gsz; u.e = 0; u.row0 = 0; u.cnt = 0; return true;
    }
};
struct MoeOrder {
    TileOrder t; LAS const int* tab;
    __device__ __forceinline__ bool next(int i, Unit& u) const {
        if (!t.next(i, u)) return false;
        int e = 0;
#pragma unroll 1
        for (int k = 1; k < NE; ++k) if (tab[32 + k] <= u.pm) e = k;
        u.e = e; u.row0 = (u.pm - tab[32 + e]) * 256; u.cnt = tab[e]; return true;
    }
};
struct DenseDesc {
    const bf16* A; int lda; const bf16* Bt; int K;
    __device__ __forceinline__ unsigned a_off(const Unit& u, int r) const { return (unsigned)((u.pm * 256 + r) * lda) * 2u; }
    __device__ __forceinline__ const char* a_base(const Unit&) const { return (const char*)A; }
    __device__ __forceinline__ const char* b_base(const Unit& u) const { return (const char*)Bt + (size_t)u.pn * 256 * K * 2; }
};
struct MoeUpDesc {
    const bf16* H2; const int* list; const bf16* WguT; int K;
    __device__ __forceinline__ unsigned a_off(const Unit& u, int r) const { const int slot = u.row0 + r; int tok = 0; if (slot < u.cnt) tok = list[u.e * NTOK + slot] >> 2; return (unsigned)tok * 2048u; }
    __device__ __forceinline__ const char* a_base(const Unit&) const { return (const char*)H2; }
    __device__ __forceinline__ const char* b_base(const Unit& u) const { return (const char*)WguT + ((size_t)u.e * 2048 + (size_t)u.pn * 256) * 1024 * 2; }
};
struct MoeDownDesc {
    const bf16* ACT; const bf16* WdT; int K;
    __device__ __forceinline__ unsigned a_off(const Unit& u, int r) const { return (unsigned)(u.pm * 256 + r) * 2048u; }
    __device__ __forceinline__ const char* a_base(const Unit&) const { return (const char*)ACT; }
    __device__ __forceinline__ const char* b_base(const Unit& u) const { return (const char*)WdT + ((size_t)u.e * 1024 + (size_t)u.pn * 256) * 1024 * 2; }
};

template <class Desc, class Order, class Epi>
__device__ __forceinline__ void gemm_simple(const Desc& g, const Order& S, const Epi& E) {
    const int tid = threadIdx.x, wid = __builtin_amdgcn_readfirstlane(tid >> 6), lane = tid & 63, wr = wid >> 2, wc = wid & 3, fr = lane & 15, fq = lane >> 4;
    const int K = g.K;
    Unit u;
    for (int i = 0; S.next(i, u); ++i) {
        f32x4 acc[2][2][4][2];
#pragma unroll
        for (int a = 0; a < 2; ++a)
#pragma unroll
            for (int b = 0; b < 2; ++b)
#pragma unroll
                for (int m = 0; m < 4; ++m)
#pragma unroll
                    for (int n = 0; n < 2; ++n) acc[a][b][m][n] = (f32x4){0.f, 0.f, 0.f, 0.f};
        unsigned aoff[2][4], boff[2][2];
#pragma unroll
        for (int a = 0; a < 2; ++a)
#pragma unroll
            for (int m = 0; m < 4; ++m) aoff[a][m] = g.a_off(u, a * 128 + wr * 64 + m * 16 + fr) + fq * 16;
#pragma unroll
        for (int b = 0; b < 2; ++b)
#pragma unroll
            for (int n = 0; n < 2; ++n) { const int nc = b * 128 + wc * 32 + (Epi::PERM ? perm32(n * 16 + fr) : (n * 16 + fr)); boff[b][n] = (unsigned)(nc * K) * 2u + fq * 16; }
        const char* ab = g.a_base(u); const char* bb = g.b_base(u);
#pragma unroll 1
        for (int ks = 0; ks < K / 32; ++ks) {
            bf16x8 af[2][4], bfr[2][2];
#pragma unroll
            for (int a = 0; a < 2; ++a)
#pragma unroll
                for (int m = 0; m < 4; ++m) af[a][m] = *(const bf16x8*)(ab + aoff[a][m] + ks * 64);
#pragma unroll
            for (int b = 0; b < 2; ++b)
#pragma unroll
                for (int n = 0; n < 2; ++n) bfr[b][n] = *(const bf16x8*)(bb + boff[b][n] + ks * 64);
#pragma unroll
            for (int a = 0; a < 2; ++a)
#pragma unroll
                for (int b = 0; b < 2; ++b)
#pragma unroll
                    for (int m = 0; m < 4; ++m)
#pragma unroll
                        for (int n = 0; n < 2; ++n) acc[a][b][m][n] = __builtin_amdgcn_mfma_f32_16x16x32_bf16(bfr[b][n], af[a][m], acc[a][b][m][n], 0, 0, 0);
        }
        E(acc, u, wr, wc, fr, fq);
    }
}


constexpr int BK = 64, HALF = 128, HTB = HALF * BK * 2, STAGE_BYTES = 8 * HTB;
__host__ __device__ __forceinline__ int lds_byte(int r, int c) { const int st = (r >> 4) * 2 + (c >> 5), rr = r & 15, cc = c & 31, ob = rr * 64 + cc * 2; return st * 1024 + (ob ^ (((ob >> 9) & 1) << 5)); }
__host__ __device__ __forceinline__ void stage_rc(int b, int& R, int& C) { const int st = b / 1024, sb = b % 1024, swz = sb ^ (((sb >> 9) & 1) << 5); R = (st >> 1) * 16 + swz / 64; C = (st & 1) * 32 + (swz % 64) / 2; }

template <class Desc, class Order, class Epi, bool ALIGN_EPI>
__device__ __forceinline__ void gemm_phase(LAS unsigned char* lds, const Desc& g, const Order& S, const Epi& E) {
    const int tid = threadIdx.x, wid = __builtin_amdgcn_readfirstlane(tid >> 6), lane = tid & 63, wr = wid >> 2, wc = wid & 3, fr = lane & 15, fq = lane >> 4;
    const int K = g.K, nt = K / BK;
    int Rs[2], Cs[2]; unsigned voffB[2];
#pragma unroll
    for (int i = 0; i < 2; ++i) { stage_rc(tid * 16 + i * 8192, Rs[i], Cs[i]); const int Rb = Epi::PERM ? ((Rs[i] & ~31) + perm32(Rs[i] & 31)) : Rs[i]; voffB[i] = (unsigned)(Rb * K + Cs[i]) * 2u; }
    unsigned vA[2][2], vAn[2][2];
    const size_t kstep = (size_t)(BK * 2);
    const size_t hstepB = (size_t)HALF * K * 2;
    const unsigned ldsw = (unsigned)wid * 1024u;
    const int aoff = lds_byte(wr * 64 + fr, fq * 8), boff = lds_byte(wc * 32 + fr, fq * 8);
#define PG8_SA(b, h) (((b) * 2 + (h)) * HTB)
#define PG8_SB(b, h) ((4 + (b) * 2 + (h)) * HTB)
#define PG8_STAGE(bufoff, gbase, voff) do { _Pragma("unroll") for (int _i = 0; _i < 2; ++_i) \
        __builtin_amdgcn_global_load_lds((const unsigned*)((const char*)(gbase) + (voff)[_i]), (LAS unsigned*)(lds + (bufoff) + ldsw + _i * 8192), 16, 0, 0); } while (0)
#define PG8_STAGE_A(bufoff, gbase, h, nx) do { _Pragma("unroll") for (int _i = 0; _i < 2; ++_i) \
        __builtin_amdgcn_global_load_lds((const unsigned*)((const char*)(gbase) + ((nx) ? vAn[h][_i] : vA[h][_i])), (LAS unsigned*)(lds + (bufoff) + ldsw + _i * 8192), 16, 0, 0); } while (0)
#define PG8_LDA(dst, b, h) do { _Pragma("unroll") for (int m = 0; m < 4; ++m) _Pragma("unroll") for (int k = 0; k < 2; ++k) dst[m][k] = *(const LAS bf16x8*)(lds + PG8_SA(b, h) + aoff + m * 2048 + k * 1024); } while (0)
#define PG8_LDB(dst, b, h) do { _Pragma("unroll") for (int n = 0; n < 2; ++n) _Pragma("unroll") for (int k = 0; k < 2; ++k) dst[n][k] = *(const LAS bf16x8*)(lds + PG8_SB(b, h) + boff + n * 2048 + k * 1024); } while (0)
#define PG8_MMA(ai, bj, At, Bt) do { __builtin_amdgcn_s_setprio(1); _Pragma("unroll") for (int m = 0; m < 4; ++m) _Pragma("unroll") for (int n = 0; n < 2; ++n) _Pragma("unroll") for (int k = 0; k < 2; ++k) \
        acc[ai][bj][m][n] = __builtin_amdgcn_mfma_f32_16x16x32_bf16(Bt[n][k], At[m][k], acc[ai][bj][m][n], 0, 0, 0); __builtin_amdgcn_s_setprio(0); } while (0)
#define PG8_WAIT_V(n) asm volatile("s_waitcnt vmcnt(" #n ")" ::: "memory")
#define PG8_WAIT_L(n) asm volatile("s_waitcnt lgkmcnt(" #n ")" ::: "memory")
#define PG8_BAR __builtin_amdgcn_s_barrier()
#define PG8_SCHED __builtin_amdgcn_sched_barrier(0)
#define PG8_AOFFS(dst, un) do { _Pragma("unroll") for (int _h = 0; _h < 2; ++_h) _Pragma("unroll") for (int _i = 0; _i < 2; ++_i) dst[_h][_i] = g.a_off(un, _h * HALF + Rs[_i]) + (unsigned)Cs[_i] * 2u; } while (0)
    Unit cur, nxt; int ui = 0;
    if (!S.next(0, cur)) return;
    f32x4 acc[2][2][4][2];
#pragma unroll
    for (int a = 0; a < 2; ++a)
#pragma unroll
        for (int b = 0; b < 2; ++b)
#pragma unroll
            for (int m = 0; m < 4; ++m)
#pragma unroll
                for (int n = 0; n < 2; ++n) acc[a][b][m][n] = (f32x4){0.f, 0.f, 0.f, 0.f};
    bf16x8 At[4][2], B0[2][2], B1[2][2];
    const char* const Ab = g.a_base(cur);
    const char* cB = g.b_base(cur);
    PG8_AOFFS(vA, cur);
    PG8_STAGE(PG8_SB(0, 0), cB, voffB); PG8_STAGE(PG8_SB(0, 1), cB + hstepB, voffB); PG8_STAGE_A(PG8_SA(0, 0), Ab, 0, false); PG8_STAGE_A(PG8_SA(0, 1), Ab, 1, false);
    if (wr == 1) PG8_BAR;
    PG8_WAIT_V(2); PG8_BAR;
    PG8_STAGE(PG8_SB(1, 0), cB + kstep, voffB); PG8_STAGE_A(PG8_SA(1, 0), Ab + kstep, 0, false); PG8_STAGE(PG8_SB(1, 1), cB + hstepB + kstep, voffB);
    PG8_WAIT_V(6); PG8_BAR;
    for (;;) {
        const bool has_next = S.next(ui + 1, nxt);
        const char* nB = has_next ? g.b_base(nxt) : cB;
        if (has_next) { PG8_AOFFS(vAn, nxt); } else {
#pragma unroll
            for (int _h = 0; _h < 2; ++_h)
#pragma unroll
                for (int _i = 0; _i < 2; ++_i) vAn[_h][_i] = vA[_h][_i]; }
        for (int t = 0; t < nt; t += 2) {
            const bool last = (t == nt - 2);
            const char* a1 = Ab + (size_t)(t + 1) * kstep;
            const char* a2 = last ? Ab : Ab + (size_t)(t + 2) * kstep; const char* b2 = last ? nB : cB + (size_t)(t + 2) * kstep;
            const char* a3 = a2 + kstep; const char* b3 = b2 + kstep;
            PG8_LDB(B0, 0, 0); PG8_LDB(B1, 0, 1); PG8_SCHED; PG8_LDA(At, 0, 0); PG8_STAGE_A(PG8_SA(1, 1), a1, 1, false);
            PG8_WAIT_V(8); PG8_WAIT_L(0); PG8_BAR; PG8_MMA(0, 0, At, B0); PG8_MMA(0, 1, At, B1); PG8_BAR; PG8_SCHED;
            PG8_LDA(At, 0, 1); PG8_STAGE(PG8_SB(0, 0), b2, voffB); PG8_STAGE(PG8_SB(0, 1), b2 + hstepB, voffB); PG8_STAGE_A(PG8_SA(0, 0), a2, 0, last);
            PG8_WAIT_V(8); PG8_WAIT_L(0); PG8_BAR; PG8_MMA(1, 0, At, B0); PG8_MMA(1, 1, At, B1); PG8_BAR; PG8_SCHED;
            PG8_LDB(B0, 1, 0); PG8_LDB(B1, 1, 1); PG8_SCHED; PG8_LDA(At, 1, 0); PG8_STAGE_A(PG8_SA(0, 1), a2, 1, last);
            PG8_WAIT_V(8); PG8_WAIT_L(0); PG8_BAR; PG8_MMA(0, 0, At, B0); PG8_MMA(0, 1, At, B1); PG8_BAR; PG8_SCHED;
            PG8_LDA(At, 1, 1); PG8_STAGE(PG8_SB(1, 0), b3, voffB); PG8_STAGE(PG8_SB(1, 1), b3 + hstepB, voffB); PG8_STAGE_A(PG8_SA(1, 0), a3, 0, last);
            PG8_WAIT_V(8); PG8_WAIT_L(0); PG8_BAR; PG8_MMA(1, 0, At, B0); PG8_MMA(1, 1, At, B1); PG8_BAR; PG8_SCHED;
        }
        if constexpr (ALIGN_EPI) { if (wr == 0) PG8_BAR; }
        E(acc, cur, wr, wc, fr, fq);
        if (!has_next) break;
#pragma unroll
        for (int a = 0; a < 2; ++a)
#pragma unroll
            for (int b = 0; b < 2; ++b)
#pragma unroll
                for (int m = 0; m < 4; ++m)
#pragma unroll
                    for (int n = 0; n < 2; ++n) acc[a][b][m][n] = (f32x4){0.f, 0.f, 0.f, 0.f};
        cur = nxt; cB = nB; ++ui;
#pragma unroll
        for (int _h = 0; _h < 2; ++_h)
#pragma unroll
            for (int _i = 0; _i < 2; ++_i) vA[_h][_i] = vAn[_h][_i];
        if constexpr (ALIGN_EPI) { if (wr == 1) PG8_BAR; }
    }
    PG8_WAIT_V(0);
    if constexpr (!ALIGN_EPI) { if (wr == 0) PG8_BAR; }
    PG8_BAR;
#undef PG8_SA
#undef PG8_SB
#undef PG8_STAGE
#undef PG8_STAGE_A
#undef PG8_LDA
#undef PG8_LDB
#undef PG8_MMA
#undef PG8_WAIT_V
#undef PG8_WAIT_L
#undef PG8_BAR
#undef PG8_SCHED
#undef PG8_AOFFS
}

__device__ __forceinline__ u32x4 pack8(const f32x4& v0, const f32x4& v1) { u32x4 w; w.x = pk2(v0[0], v0[1]); w.y = pk2(v0[2], v0[3]); w.z = pk2(v1[0], v1[1]); w.w = pk2(v1[2], v1[3]); return w; }
__device__ __forceinline__ void unpack8(const u32x4& w, f32x4& v0, f32x4& v1) { v0 = (f32x4){bflo(w.x), bfhi(w.x), bflo(w.y), bfhi(w.y)}; v1 = (f32x4){bflo(w.z), bfhi(w.z), bflo(w.w), bfhi(w.w)}; }
__device__ __forceinline__ float logsig16(float x) { return (fminf(x, 0.f) - log1pf(__expf(-fabsf(x)))) * (1.f / 16.f); }

struct EpiProj {
    static constexpr bool PERM = true;
    bf16* P; const float* b_alpha;
    __device__ __forceinline__ void operator()(const f32x4 (&acc)[2][2][4][2], const Unit& u, int wr, int wc, int fr, int fq) const {
        const int pn = u.pn; const int mode = (pn < 2) ? 1 : (pn == 6 ? 2 : (pn == 20 ? 3 : 0));
#pragma unroll
        for (int bj = 0; bj < 2; ++bj) {
            const int c0 = pn * 256 + bj * 128 + wc * 32 + 8 * fq;
            f32x4 b0 = (f32x4){0.f, 0.f, 0.f, 0.f}, b1 = b0;
            if (mode == 3) { b0 = *(const f32x4*)(b_alpha + (c0 - C_AL)); b1 = *(const f32x4*)(b_alpha + (c0 - C_AL) + 4); }
#pragma unroll
            for (int ai = 0; ai < 2; ++ai)
#pragma unroll
                for (int m = 0; m < 4; ++m) {
                    const int row = u.pm * 256 + ai * 128 + wr * 64 + m * 16 + fr;
                    f32x4 v0 = acc[ai][bj][m][0], v1 = acc[ai][bj][m][1];
                    if (mode == 1) { v0 = v0 * QSCALE; v1 = v1 * QSCALE; }
                    else if (mode == 2) { v0 = v0 * 0.125f; v1 = v1 * 0.125f; }
                    else if (mode == 3) {
#pragma unroll
                        for (int j = 0; j < 4; ++j) { v0[j] = logsig16(v0[j] + b0[j]); v1[j] = logsig16(v1[j] + b1[j]); } }
                    *(u32x4*)(P + (size_t)row * NPROJ + c0) = pack8(v0, v1);
                }
        }
    }
};
struct EpiBranch {
    static constexpr bool PERM = true;
    bf16* MG; const bf16* P; int gcol; int add;
    __device__ __forceinline__ void operator()(const f32x4 (&acc)[2][2][4][2], const Unit& u, int wr, int wc, int fr, int fq) const {
#pragma unroll
        for (int ai = 0; ai < 2; ++ai)
#pragma unroll
            for (int m = 0; m < 4; ++m) {
                const int row = u.pm * 256 + ai * 128 + wr * 64 + m * 16 + fr;
#pragma unroll
                for (int bj = 0; bj < 2; ++bj) {
                    const int c0 = u.pn * 256 + bj * 128 + wc * 32 + 8 * fq;
                    const u32x4 gw = *(const u32x4*)(P + (size_t)row * NPROJ + gcol + c0);
                    f32x4 g0, g1; unpack8(gw, g0, g1);
                    f32x4 v0 = acc[ai][bj][m][0], v1 = acc[ai][bj][m][1];
#pragma unroll
                    for (int j = 0; j < 4; ++j) { v0[j] *= sigmoidf_(g0[j]); v1[j] *= sigmoidf_(g1[j]); }
                    bf16* dst = MG + (size_t)row * DM + c0;
                    if (add) { const u32x4 ow = *(const u32x4*)dst; f32x4 o0, o1; unpack8(ow, o0, o1); v0 = v0 + o0; v1 = v1 + o1; }
                    *(u32x4*)dst = pack8(v0, v1);
                }
            }
    }
};
struct EpiOut {
    static constexpr bool PERM = false;
    const float* x; float* x1; const float* mod;
    __device__ __forceinline__ void operator()(const f32x4 (&acc)[2][2][4][2], const Unit& u, int wr, int wc, int fr, int fq) const {
        const int b = u.pm >> 3; const float* gt1 = mod + b * 6144 + 2048;
#pragma unroll
        for (int bj = 0; bj < 2; ++bj)
#pragma unroll
            for (int n = 0; n < 2; ++n) {
                const int c0 = u.pn * 256 + bj * 128 + wc * 32 + 16 * n + 4 * fq;
                const f32x4 gt = *(const f32x4*)(gt1 + c0);
#pragma unroll
                for (int ai = 0; ai < 2; ++ai)
#pragma unroll
                    for (int m = 0; m < 4; ++m) {
                        const size_t off = (size_t)(u.pm * 256 + ai * 128 + wr * 64 + m * 16 + fr) * DM + c0;
                        const f32x4 xv = *(const f32x4*)(x + off);
                        *(f32x4*)(x1 + off) = xv + gt * acc[ai][bj][m][n];
                    }
            }
    }
};
struct EpiUp {
    static constexpr bool PERM = true;
    bf16* ACT; const float* b_gu;
    __device__ __forceinline__ void operator()(const f32x4 (&acc)[2][2][4][2], const Unit& u, int wr, int wc, int fr, int fq) const {
        const int f0 = u.pn * 128 + wc * 32 + 8 * fq;
        const float* bg = b_gu + (size_t)u.e * 2048 + f0; const float* bu = bg + 1024;
        const f32x4 bg0 = *(const f32x4*)bg, bg1 = *(const f32x4*)(bg + 4), bu0 = *(const f32x4*)bu, bu1 = *(const f32x4*)(bu + 4);
#pragma unroll
        for (int ai = 0; ai < 2; ++ai)
#pragma unroll
            for (int m = 0; m < 4; ++m) {
                const int r = ai * 128 + wr * 64 + m * 16 + fr;
                f32x4 g0 = acc[ai][0][m][0] + bg0, g1 = acc[ai][0][m][1] + bg1, u0 = acc[ai][1][m][0] + bu0, u1 = acc[ai][1][m][1] + bu1, a0, a1;
#pragma unroll
                for (int j = 0; j < 4; ++j) {
                    float gg = fminf(g0[j], 7.f), uu = fminf(fmaxf(u0[j], -7.f), 7.f); a0[j] = (uu + 1.f) * gg * sigmoidf_(1.702f * gg);
                    gg = fminf(g1[j], 7.f); uu = fminf(fmaxf(u1[j], -7.f), 7.f); a1[j] = (uu + 1.f) * gg * sigmoidf_(1.702f * gg); }
                *(u32x4*)(ACT + (size_t)(u.pm * 256 + r) * FF + f0) = pack8(a0, a1);
            }
    }
};
struct EpiDown {
    static constexpr bool PERM = true;
    bf16* YB; const float* b_dn; const int* list;
    __device__ __forceinline__ void operator()(const f32x4 (&acc)[2][2][4][2], const Unit& u, int wr, int wc, int fr, int fq) const {
#pragma unroll
        for (int ai = 0; ai < 2; ++ai)
#pragma unroll
            for (int m = 0; m < 4; ++m) {
                const int slot = u.row0 + ai * 128 + wr * 64 + m * 16 + fr;
                if (slot < u.cnt) {
                    const int aid = list[u.e * NTOK + slot];
#pragma unroll
                    for (int bj = 0; bj < 2; ++bj) {
                        const int c0 = u.pn * 256 + bj * 128 + wc * 32 + 8 * fq;
                        const float* bp = b_dn + (size_t)u.e * DM + c0;
                        const f32x4 v0 = acc[ai][bj][m][0] + *(const f32x4*)bp, v1 = acc[ai][bj][m][1] + *(const f32x4*)(bp + 4);
                        *(u32x4*)(YB + (size_t)aid * DM + c0) = pack8(v0, v1);
                    }
                }
            }
    }
};

__device__ __forceinline__ void phase_mod(const Ctx& C) {
    LAS float* sc = (LAS float*)C.lds;
    LAS float* red = sc + 16 * 1024;
    for (int cb = C.bid; cb < 96; cb += C.G) {
        __syncthreads();
        for (int i = C.tid; i < 16 * 1024; i += NTHREADS) { const float v = C.c[i]; sc[i] = v / (1.f + __expf(-v)); }
        __syncthreads();
        const int cl = C.tid & 63, ks = C.tid >> 6, col = cb * 64 + cl;
        float acc[16];
#pragma unroll
        for (int b = 0; b < 16; ++b) acc[b] = 0.f;
#pragma unroll 4
        for (int k = ks * 128; k < ks * 128 + 128; ++k) {
            const float w = C.w_ada[(size_t)k * 6144 + col];
#pragma unroll
            for (int b = 0; b < 16; ++b) acc[b] += sc[b * 1024 + k] * w;
        }
#pragma unroll
        for (int b = 0; b < 16; ++b) red[(ks * 16 + b) * 64 + cl] = acc[b];
        __syncthreads();
        for (int o = C.tid; o < 1024; o += NTHREADS) {
            const int b = o >> 6, c2 = o & 63; float s = 0.f;
#pragma unroll
            for (int k2 = 0; k2 < 8; ++k2) s += red[(k2 * 16 + b) * 64 + c2];
            C.mod[b * 6144 + cb * 64 + c2] = s + C.b_ada[cb * 64 + c2];
        }
    }
    for (int gt = C.bid * NTHREADS + C.tid; gt < 256 * 512; gt += C.G * NTHREADS) {
        const int j = gt >> 9, k = (gt & 511) * 2;
        float s0 = 0.f, s1 = 0.f;
#pragma unroll
        for (int r = 0; r < 16; ++r) { const float wa = C.w_alpha_up[r * 256 + j]; s0 += C.w_in[(size_t)k * W_IN_N + 3072 + r] * wa; s1 += C.w_in[(size_t)(k + 1) * W_IN_N + 3072 + r] * wa; }
        *(unsigned*)(C.WinT + (size_t)(C_AL + j) * DM + k) = pk2(s0, s1);
    }
}

__device__ __forceinline__ void transpose_item(const float* W, int srcN, bf16* WT, int Kp, int dst_row0, int src_col0, int k0, LAS float* scr, int lane) {
#pragma unroll 8
    for (int i = 0; i < 32; ++i) { const int kk = 2 * i + (lane >> 5); scr[kk * 33 + (lane & 31)] = W[(size_t)(k0 + kk) * srcN + src_col0 + (lane & 31)]; }
    LDS_WAIT(); asm volatile("" ::: "memory");
    const int c = lane & 7;
#pragma unroll
    for (int j = 0; j < 4; ++j) { const int n = (lane >> 3) + 8 * j; const LAS float* s = scr + (8 * c) * 33 + n;
        u32x4 o; o.x = pk2(s[0 * 33], s[1 * 33]); o.y = pk2(s[2 * 33], s[3 * 33]); o.z = pk2(s[4 * 33], s[5 * 33]); o.w = pk2(s[6 * 33], s[7 * 33]);
        *(u32x4*)(WT + (size_t)(dst_row0 + n) * Kp + k0 + 8 * c) = o; }
    LDS_WAIT(); asm volatile("" ::: "memory");
}
__device__ __forceinline__ void phase_prep(const Ctx& C) {
    LAS float* scr = (LAS float*)(C.lds + C.wid * 16384);
    const int gw = C.bid * NWAVES + C.wid, NGW = C.G * NWAVES;
    constexpr int I_IN = 16 * 160, I_BD = 8 * 32, I_OUT = 16 * 32, I_GU = 32 * 16 * 64, I_DN = 32 * 16 * 32;
    constexpr int NITEMS = I_IN + 2 * I_BD + I_OUT + I_GU + I_DN;
    for (int it = gw; it < NITEMS; it += NGW) {
        int r = it;
        if (r < I_IN) { const int kb = r / 160, n0 = (r % 160) * 32; transpose_item(C.w_in, W_IN_N, C.WinT, DM, n0, n0 < 3072 ? n0 : n0 + 16, kb * 64, scr, C.lane); continue; } r -= I_IN;
        if (r < I_BD) { transpose_item(C.w_bd, DM, C.WbdT, 512, (r & 31) * 32, (r & 31) * 32, (r >> 5) * 64, scr, C.lane); continue; } r -= I_BD;
        if (r < I_BD) { transpose_item(C.w_bg, DM, C.WbgT, 512, (r & 31) * 32, (r & 31) * 32, (r >> 5) * 64, scr, C.lane); continue; } r -= I_BD;
        if (r < I_OUT) { transpose_item(C.w_out, DM, C.WoutT, DM, (r & 31) * 32, (r & 31) * 32, (r >> 5) * 64, scr, C.lane); continue; } r -= I_OUT;
        if (r < I_GU) { const int e = r >> 10, rr = r & 1023, kb = rr >> 6, n0 = (rr & 63) * 32; const int pn = n0 >> 8, bj = (n0 >> 7) & 1, j0 = n0 & 127;
            transpose_item(C.w_gu + (size_t)e * DM * 2048, 2048, C.WguT + (size_t)e * 2048 * DM, DM, n0, bj * 1024 + pn * 128 + j0, kb * 64, scr, C.lane); continue; } r -= I_GU;
        { const int e = r >> 9, rr = r & 511, kb = rr >> 5, n0 = (rr & 31) * 32;
            transpose_item(C.w_dn + (size_t)e * FF * DM, DM, C.WdT + (size_t)e * DM * FF, FF, n0, n0, kb * 64, scr, C.lane); }
    }
    for (int row = gw; row < NTOK; row += NGW) {
        const int b = row >> 11; const float* md = C.mod + b * 6144;
        f32x4 v[4]; float ss = 0.f;
#pragma unroll
        for (int j = 0; j < 4; ++j) { v[j] = *(const f32x4*)(C.x + (size_t)row * DM + 4 * C.lane + 256 * j); ss += (v[j][0] * v[j][0] + v[j][1] * v[j][1]) + (v[j][2] * v[j][2] + v[j][3] * v[j][3]); }
        const float rstd = rsqrtf(wave_sum(ss) * (1.f / DM) + EPS);
#pragma unroll
        for (int j = 0; j < 4; ++j) { const int c0 = 4 * C.lane + 256 * j;
            const f32x4 g = *(const f32x4*)(C.norm1_g + c0), sc = *(const f32x4*)(md + 1024 + c0), sh = *(const f32x4*)(md + c0);
            const f32x4 y = v[j] * rstd * g * (sc + 1.f) + sh;
            u32x2 o; o.x = pk2(y[0], y[1]); o.y = pk2(y[2], y[3]);
            *(u32x2*)(C.H + (size_t)row * DM + c0) = o; }
    }
}

__device__ __forceinline__ void gla_scan(const Ctx& C, int b, int h) {
    LAS float* qs = (LAS float*)C.lds;
    LAS float* ks = qs + 2048;
    LAS float* al = ks + 2048;
    LAS float* vs = al + 2048;
    LAS float* part = vs + 4096;
    const int dv = C.tid & 127, dkg = C.tid >> 7;
    float S[16];
#pragma unroll
    for (int j = 0; j < 16; ++j) S[j] = 0.f;
    const float gdv0 = C.gla_g[2 * C.lane], gdv1 = C.gla_g[2 * C.lane + 1];
    for (int ch = 0; ch < SEQ / 32; ++ch) {
        const int row0 = b * SEQ + ch * 32;
        __syncthreads();
        for (int i = C.tid; i < 32 * 64; i += NTHREADS) { const int t = i >> 6, d = i & 63; const bf16* pr = C.PROJ + (size_t)(row0 + t) * NPROJ;
            qs[i] = bf2f(pr[C_GQ + h * 64 + d]); ks[i] = bf2f(pr[C_GK + h * 64 + d]); al[i] = __expf(bf2f(pr[C_AL + h * 64 + d])); }
        for (int i = C.tid; i < 32 * 128; i += NTHREADS) { const int t = i >> 7, d = i & 127; vs[i] = bf2f(C.PROJ[(size_t)(row0 + t) * NPROJ + C_GV + h * 128 + d]); }
        __syncthreads();
#pragma unroll 2
        for (int t = 0; t < 32; ++t) {
            const float v = vs[t * 128 + dv]; float o = 0.f;
#pragma unroll
            for (int j4 = 0; j4 < 4; ++j4) {
                const f32x4 a4 = *(const LAS f32x4*)(al + t * 64 + dkg * 16 + j4 * 4), k4 = *(const LAS f32x4*)(ks + t * 64 + dkg * 16 + j4 * 4), q4 = *(const LAS f32x4*)(qs + t * 64 + dkg * 16 + j4 * 4);
#pragma unroll
                for (int jj = 0; jj < 4; ++jj) { const int j = j4 * 4 + jj; S[j] = a4[jj] * S[j] + k4[jj] * v; o += q4[jj] * S[j]; }
            }
            part[(dkg * 32 + t) * 128 + dv] = o;
        }
        __syncthreads();
#pragma unroll
        for (int tt = 0; tt < 4; ++tt) {
            const int t = 4 * C.wid + tt; float o0 = 0.f, o1 = 0.f;
#pragma unroll
            for (int g = 0; g < 4; ++g) { o0 += part[(g * 32 + t) * 128 + 2 * C.lane]; o1 += part[(g * 32 + t) * 128 + 2 * C.lane + 1]; }
            const float rstd = rsqrtf(wave_sum(o0 * o0 + o1 * o1) * (1.f / 128.f) + EPS);
            const unsigned grw = *(const unsigned*)(C.PROJ + (size_t)(row0 + t) * NPROJ + C_GR + h * 128 + 2 * C.lane);
            const float g0 = bflo(grw), g1 = bfhi(grw);
            const float y0 = o0 * rstd * gdv0 * (g0 * sigmoidf_(g0)), y1 = o1 * rstd * gdv1 * (g1 * sigmoidf_(g1));
            *(unsigned*)(C.OB + (size_t)(row0 + t) * 512 + h * 128 + 2 * C.lane) = pk2(y0, y1);
        }
    }
}

__device__ __forceinline__ void attn_simple(const Ctx& C) {
    LAS float* Kt = (LAS float*)C.lds;
    LAS float* Vt = Kt + 8192;
    LAS float* Ss = Vt + 8192;
    LAS float* ssq = Ss + 2 * 64 * 68;
    LAS float* lamp = ssq + 256;
    if (C.tid < 64) {
        const float a = wave_sum(C.lq1[C.lane] * C.lk1[C.lane]), b2 = wave_sum(C.lq2[C.lane] * C.lk2[C.lane]);
        if (C.tid == 0) lamp[0] = __expf(a) - __expf(b2) + 0.2f;
    }
    __syncthreads();
    const float lam = lamp[0];
    const int q = C.tid & 63, p = (C.tid >> 6) & 1, dq = C.tid >> 7;
    for (int uix = C.bid; uix < 2048; uix += C.G) {
        const int bh = uix & 63, g = (uix >> 6) & 3, i2 = uix >> 8; const int b = bh >> 2, h = bh & 3;
        const int qc = (i2 & 1) ? (31 - (4 * g + (i2 >> 1))) : (4 * g + (i2 >> 1));
        const float sl2 = exp2f(-2.f * (float)(h + 1)) * LOG2E;
        const int qrow = b * SEQ + qc * 64 + q;
        float qv[64];
#pragma unroll
        for (int d8 = 0; d8 < 8; ++d8) { const u32x4 w = *(const u32x4*)(C.PROJ + (size_t)qrow * NPROJ + C_DQ + h * 128 + p * 64 + d8 * 8);
            qv[d8 * 8 + 0] = bflo(w.x); qv[d8 * 8 + 1] = bfhi(w.x); qv[d8 * 8 + 2] = bflo(w.y); qv[d8 * 8 + 3] = bfhi(w.y);
            qv[d8 * 8 + 4] = bflo(w.z); qv[d8 * 8 + 5] = bfhi(w.z); qv[d8 * 8 + 6] = bflo(w.w); qv[d8 * 8 + 7] = bfhi(w.w); }
        float m = -1e30f, l = 0.f, acc[32];
#pragma unroll
        for (int d = 0; d < 32; ++d) acc[d] = 0.f;
        for (int kc = 0; kc <= qc; ++kc) {
            __syncthreads();
            for (int pi = C.tid; pi < 1024; pi += NTHREADS) { const int r = pi >> 4, cc = pi & 15; const bf16* pr = C.PROJ + (size_t)(b * SEQ + kc * 64 + r) * NPROJ + h * 128 + cc * 8;
                const u32x4 kw = *(const u32x4*)(pr + C_DK), vw = *(const u32x4*)(pr + C_DV); f32x4 a0, a1;
                unpack8(kw, a0, a1); *(LAS f32x4*)(Kt + r * 128 + cc * 8) = a0; *(LAS f32x4*)(Kt + r * 128 + cc * 8 + 4) = a1;
                unpack8(vw, a0, a1); *(LAS f32x4*)(Vt + r * 128 + cc * 8) = a0; *(LAS f32x4*)(Vt + r * 128 + cc * 8 + 4) = a1; }
            __syncthreads();
#pragma unroll 1
            for (int kk = 0; kk < 16; ++kk) {
                const int key = dq * 16 + kk; float s = 0.f;
#pragma unroll
                for (int d4 = 0; d4 < 16; ++d4) { const f32x4 kv = *(const LAS f32x4*)(Kt + key * 128 + p * 64 + d4 * 4);
                    s += qv[d4 * 4] * kv[0]; s += qv[d4 * 4 + 1] * kv[1]; s += qv[d4 * 4 + 2] * kv[2]; s += qv[d4 * 4 + 3] * kv[3]; }
                const int kpos = kc * 64 + key, qpos = qc * 64 + q; const int mn = kpos < 2 * qpos - kpos ? kpos : 2 * qpos - kpos;
                Ss[(p * 64 + q) * 68 + key] = s + sl2 * (float)mn;
            }
            __syncthreads();
            const LAS float* srow = Ss + (p * 64 + q) * 68;
            float cm = -1e30f;
#pragma unroll
            for (int k4 = 0; k4 < 16; ++k4) { const f32x4 sv = *(const LAS f32x4*)(srow + k4 * 4); cm = fmaxf(cm, fmaxf(fmaxf(sv[0], sv[1]), fmaxf(sv[2], sv[3]))); }
            const float mnew = fmaxf(m, cm), alpha = exp2f(m - mnew); m = mnew; l *= alpha;
#pragma unroll
            for (int d = 0; d < 32; ++d) acc[d] *= alpha;
#pragma unroll 2
            for (int key = 0; key < 64; ++key) {
                const float pk = exp2f(srow[key] - m); l += pk;
#pragma unroll
                for (int d4 = 0; d4 < 8; ++d4) { const f32x4 vv = *(const LAS f32x4*)(Vt + key * 128 + dq * 32 + d4 * 4);
                    acc[d4 * 4] += pk * vv[0]; acc[d4 * 4 + 1] += pk * vv[1]; acc[d4 * 4 + 2] += pk * vv[2]; acc[d4 * 4 + 3] += pk * vv[3]; }
            }
        }
        const float inv = 1.f / l;
        __syncthreads();
        LAS float* O2 = Ss;
        if (p == 1) {
#pragma unroll
            for (int d = 0; d < 32; ++d) O2[q * 128 + dq * 32 + d] = lam * acc[d] * inv;
        }
        __syncthreads();
        float ss = 0.f;
        if (p == 0) {
#pragma unroll
            for (int d = 0; d < 32; ++d) { acc[d] = acc[d] * inv - O2[q * 128 + dq * 32 + d]; ss += acc[d] * acc[d]; }
            ssq[q * 4 + dq] = ss;
        }
        __syncthreads();
        if (p == 0) {
            const float tot = (ssq[q * 4] + ssq[q * 4 + 1]) + (ssq[q * 4 + 2] + ssq[q * 4 + 3]);
            const float rstd = rsqrtf(tot * (1.f / 128.f) + EPS) * 0.8f;
            bf16* dst = C.OA + (size_t)qrow * 512 + h * 128 + dq * 32;
#pragma unroll
            for (int d8 = 0; d8 < 4; ++d8) { u32x4 w; const float* gg = C.diff_g + dq * 32 + d8 * 8;
                w.x = pk2(acc[d8 * 8] * rstd * gg[0], acc[d8 * 8 + 1] * rstd * gg[1]); w.y = pk2(acc[d8 * 8 + 2] * rstd * gg[2], acc[d8 * 8 + 3] * rstd * gg[3]);
                w.z = pk2(acc[d8 * 8 + 4] * rstd * gg[4], acc[d8 * 8 + 5] * rstd * gg[5]); w.w = pk2(acc[d8 * 8 + 6] * rstd * gg[6], acc[d8 * 8 + 7] * rstd * gg[7]);
                *(u32x4*)(dst + d8 * 8) = w; }
        }
    }
}

__device__ __forceinline__ void phase_router(const Ctx& C) {
    constexpr int WP = 1028;
    LAS float* WrT = (LAS float*)C.lds;
    LAS int* lcnt = (LAS int*)(WrT + 32 * WP);
    LAS int* lbase = lcnt + 32;
    LAS int* pend = lbase + 32;
    for (int i = C.tid; i < DM * NE; i += NTHREADS) { const int k = i >> 5, e = i & 31; WrT[e * WP + k] = C.w_router[i]; }
    if (C.tid < 32) lcnt[C.tid] = 0;
    for (int i = C.tid; i < 512; i += NTHREADS) pend[i] = -1;
    __syncthreads();
    const int gw = C.bid * NWAVES + C.wid, NGW = C.G * NWAVES;
    const float myb = C.b_router[C.lane >> 1];
    int it = 0;
    for (int row = gw; row < NTOK; row += NGW, ++it) {
        const int b = row >> 11; const float* md = C.mod + b * 6144;
        f32x4 v[4]; float ss = 0.f;
#pragma unroll
        for (int j = 0; j < 4; ++j) { v[j] = *(const f32x4*)(C.out + (size_t)row * DM + 4 * C.lane + 256 * j); ss += (v[j][0] * v[j][0] + v[j][1] * v[j][1]) + (v[j][2] * v[j][2] + v[j][3] * v[j][3]); }
        const float rstd = rsqrtf(wave_sum(ss) * (1.f / DM) + EPS);
#pragma unroll
        for (int j = 0; j < 4; ++j) { const int c0 = 4 * C.lane + 256 * j;
            const f32x4 g = *(const f32x4*)(C.norm2_g + c0), sc = *(const f32x4*)(md + 4096 + c0), sh = *(const f32x4*)(md + 3072 + c0);
            v[j] = v[j] * rstd * g * (sc + 1.f) + sh;
            u32x2 o; o.x = pk2(v[j][0], v[j][1]); o.y = pk2(v[j][2], v[j][3]);
            *(u32x2*)(C.H2 + (size_t)row * DM + c0) = o; }
        float a[32];
#pragma unroll
        for (int e = 0; e < 32; ++e) { float s = 0.f;
#pragma unroll
            for (int j = 0; j < 4; ++j) { const f32x4 w = *(const LAS f32x4*)(WrT + e * WP + 4 * C.lane + 256 * j); s += (v[j][0] * w[0] + v[j][1] * w[1]) + (v[j][2] * w[2] + v[j][3] * w[3]); }
            a[e] = s; }
#pragma unroll
        for (int i = 0; i < 16; ++i) { const bool hi = (C.lane & 32) != 0; const float send = hi ? a[i] : a[i + 16], keep = hi ? a[i + 16] : a[i]; a[i] = keep + __shfl_xor(send, 32); }
#pragma unroll
        for (int i = 0; i < 8; ++i) { const bool hi = (C.lane & 16) != 0; const float send = hi ? a[i] : a[i + 8], keep = hi ? a[i + 8] : a[i]; a[i] = keep + __shfl_xor(send, 16); }
#pragma unroll
        for (int i = 0; i < 4; ++i) { const bool hi = (C.lane & 8) != 0; const float send = hi ? a[i] : a[i + 4], keep = hi ? a[i + 4] : a[i]; a[i] = keep + __shfl_xor(send, 8); }
#pragma unroll
        for (int i = 0; i < 2; ++i) { const bool hi = (C.lane & 4) != 0; const float send = hi ? a[i] : a[i + 2], keep = hi ? a[i + 2] : a[i]; a[i] = keep + __shfl_xor(send, 4); }
        { const bool hi = (C.lane & 2) != 0; const float send = hi ? a[0] : a[1], keep = hi ? a[1] : a[0]; a[0] = keep + __shfl_xor(send, 2); }
        float val = a[0] + __shfl_xor(a[0], 1) + myb; const int idx = C.lane >> 1;
        float tv[4]; int ti[4];
#pragma unroll
        for (int r = 0; r < 4; ++r) {
            float bv = val; int bi = idx;
#pragma unroll
            for (int o = 32; o >= 1; o >>= 1) { const float ov = __shfl_xor(bv, o); const int oi = __shfl_xor(bi, o); if (ov > bv || (ov == bv && oi < bi)) { bv = ov; bi = oi; } }
            tv[r] = bv; ti[r] = bi; if (idx == bi) val = -3.0e38f;
        }
        const float e1 = __expf(tv[1] - tv[0]), e2 = __expf(tv[2] - tv[0]), e3 = __expf(tv[3] - tv[0]); const float inv = 1.f / (1.f + e1 + e2 + e3);
        if (C.lane == 0) { *(f32x4*)(C.topw + (size_t)row * 4) = (f32x4){inv, e1 * inv, e2 * inv, e3 * inv}; *(i32x4*)(C.tope + (size_t)row * 4) = (i32x4){ti[0], ti[1], ti[2], ti[3]}; }
        if (C.lane < 4) { const int e = C.lane == 0 ? ti[0] : (C.lane == 1 ? ti[1] : (C.lane == 2 ? ti[2] : ti[3]));
            const int slot = atomicAdd((int*)(lcnt + e), 1); pend[(it * 8 + C.wid) * 4 + C.lane] = (e << 16) | slot; }
    }
    __syncthreads();
    if (C.tid < 32) lbase[C.tid] = (int)__hip_atomic_fetch_add(C.ctl + CW_CNT + 64 * C.tid, (unsigned)lcnt[C.tid], RLX_AGENT);
    __syncthreads();
    for (int i = C.tid; i < 512; i += NTHREADS) { const int pv = pend[i]; if (pv >= 0) { const int e = pv >> 16, slot = pv & 0xffff; const int it2 = i >> 5, w = (i >> 2) & 7, r = i & 3;
        const int row = C.bid * NWAVES + w + it2 * NGW; C.list[e * NTOK + lbase[e] + slot] = row * 4 + r; } }
}

__device__ __forceinline__ void phase_final(const Ctx& C) {
    const int gw = C.bid * NWAVES + C.wid, NGW = C.G * NWAVES;
    for (int row = gw; row < NTOK; row += NGW) {
        const int b = row >> 11; const float* gt2 = C.mod + b * 6144 + 5120;
        const f32x4 w = *(const f32x4*)(C.topw + (size_t)row * 4);
        f32x4 v[4]; float ss = 0.f;
#pragma unroll
        for (int j = 0; j < 4; ++j) { const int c0 = 4 * C.lane + 256 * j;
            f32x4 y = (f32x4){0.f, 0.f, 0.f, 0.f};
#pragma unroll
            for (int k = 0; k < 4; ++k) { const u32x2 yw = *(const u32x2*)(C.YB + (size_t)(row * 4 + k) * DM + c0); y = y + (f32x4){bflo(yw.x), bfhi(yw.x), bflo(yw.y), bfhi(yw.y)} * w[k]; }
            v[j] = *(const f32x4*)(C.out + (size_t)row * DM + c0) + *(const f32x4*)(gt2 + c0) * y;
            ss += (v[j][0] * v[j][0] + v[j][1] * v[j][1]) + (v[j][2] * v[j][2] + v[j][3] * v[j][3]); }
        const float rstd = rsqrtf(wave_sum(ss) * (1.f / DM) + EPS);
#pragma unroll
        for (int j = 0; j < 4; ++j) { const int c0 = 4 * C.lane + 256 * j; *(f32x4*)(C.out + (size_t)row * DM + c0) = v[j] * rstd * *(const f32x4*)(C.final_g + c0); }
    }
}

struct Args { const float* in[25]; float* out; unsigned char* ws; };
__global__ void __launch_bounds__(NTHREADS, 2) fwd_kernel(Args args) {
    extern __shared__ __attribute__((aligned(16))) unsigned char lds[];
    Ctx C;
    C.lds = (LAS unsigned char*)lds;
    C.tid = threadIdx.x; C.lane = C.tid & 63; C.wid = __builtin_amdgcn_readfirstlane(C.tid >> 6); C.G = gridDim.x; C.bid = blockIdx.x;
    C.x = args.in[0]; C.c = args.in[1]; C.w_ada = args.in[2]; C.b_ada = args.in[3]; C.norm1_g = args.in[4]; C.w_in = args.in[5];
    C.lq1 = args.in[6]; C.lk1 = args.in[7]; C.lq2 = args.in[8]; C.lk2 = args.in[9]; C.diff_g = args.in[10]; C.w_alpha_up = args.in[11]; C.b_alpha = args.in[12];
    C.gla_g = args.in[13]; C.w_bd = args.in[14]; C.w_bg = args.in[15]; C.w_out = args.in[16]; C.norm2_g = args.in[17]; C.w_router = args.in[18]; C.b_router = args.in[19];
    C.w_gu = args.in[20]; C.b_gu = args.in[21]; C.w_dn = args.in[22]; C.b_dn = args.in[23]; C.final_g = args.in[24];
    C.out = args.out;
    unsigned char* ws = args.ws;
    C.ctl = (unsigned*)(ws + WS_CTL); C.mod = (float*)(ws + WS_MOD); C.tope = (int*)(ws + WS_TOPE); C.topw = (float*)(ws + WS_TOPW); C.list = (int*)(ws + WS_LIST);
    C.WinT = (bf16*)(ws + WS_WIN); C.WbdT = (bf16*)(ws + WS_WBD); C.WbgT = (bf16*)(ws + WS_WBG); C.WoutT = (bf16*)(ws + WS_WOUT); C.WguT = (bf16*)(ws + WS_WGU); C.WdT = (bf16*)(ws + WS_WD);
    C.H = (bf16*)(ws + WS_H); C.H2 = (bf16*)(ws + WS_H2); C.OA = (bf16*)(ws + WS_OA); C.OB = (bf16*)(ws + WS_OB); C.MG = (bf16*)(ws + WS_MG); C.YB = (bf16*)(ws + WS_YB);
    C.PROJ = (bf16*)(ws + WS_PROJ); C.ACT = (bf16*)(ws + WS_ACT);

    for (int u = C.tid; u < (LDS_BYTES - LDSCTL_OFF) / 4; u += NTHREADS) ((LAS unsigned*)(C.lds + LDSCTL_OFF))[u] = 0u;
    __syncthreads();
    volatile LAS unsigned* MISC = (volatile LAS unsigned*)(C.lds + MISC_OFF);
    XcdBarrier bar = xcd_barrier_post(C.ctl + CW_BAR, MISC + 8);
#define GRID_BAR() xcd_barrier(bar)

    phase_mod(C);
    GRID_BAR();
    phase_prep(C);
    GRID_BAR();
    { DenseDesc g{C.H, DM, C.WinT, DM}; TileOrder S; S.init(NTOK / 256, NPROJ / 256, C.G, C.bid); EpiProj E{C.PROJ, C.b_alpha}; gemm_phase<DenseDesc, TileOrder, EpiProj, true>(C.lds, g, S, E); }
    GRID_BAR();
    for (int s = C.bid; s < 64; s += C.G) gla_scan(C, s >> 2, s & 3);
    __syncthreads();
    attn_simple(C);
    GRID_BAR();
    { DenseDesc g{C.OA, 512, C.WbdT, 512}; TileOrder S; S.init(NTOK / 256, DM / 256, C.G, C.bid); EpiBranch E{C.MG, C.PROJ, C_GA, 0}; gemm_phase<DenseDesc, TileOrder, EpiBranch, true>(C.lds, g, S, E); }
    GRID_BAR();
    { DenseDesc g{C.OB, 512, C.WbgT, 512}; TileOrder S; S.init(NTOK / 256, DM / 256, C.G, C.bid); EpiBranch E{C.MG, C.PROJ, C_GB, 1}; gemm_phase<DenseDesc, TileOrder, EpiBranch, true>(C.lds, g, S, E); }
    GRID_BAR();
    { DenseDesc g{C.MG, DM, C.WoutT, DM}; TileOrder S; S.init(NTOK / 256, DM / 256, C.G, C.bid); EpiOut E{C.x, C.out, C.mod}; gemm_phase<DenseDesc, TileOrder, EpiOut, true>(C.lds, g, S, E); }
    GRID_BAR();
    phase_router(C);
    GRID_BAR();
    LAS int* tab = (LAS int*)(C.lds + STAGE_BYTES);
    __syncthreads();
    if (C.tid == 0) { int ts = 0; for (int e = 0; e < NE; ++e) { const int cnt = (int)__hip_atomic_load(C.ctl + CW_CNT + 64 * e, RLX_AGENT); tab[e] = cnt; tab[32 + e] = ts; ts += (cnt + 255) >> 8; } tab[64] = ts; }
    __syncthreads();
    const int T = tab[64];
    { MoeUpDesc g{C.H2, C.list, C.WguT, DM}; MoeOrder S; S.t.init(T, 8, C.G, C.bid); S.tab = tab; EpiUp E{C.ACT, C.b_gu}; gemm_phase<MoeUpDesc, MoeOrder, EpiUp, true>(C.lds, g, S, E); }
    GRID_BAR();
    { MoeDownDesc g{C.ACT, C.WdT, FF}; MoeOrder S; S.t.init(T, 4, C.G, C.bid); S.tab = tab; EpiDown E{C.YB, C.b_dn, C.list}; gemm_phase<MoeDownDesc, MoeOrder, EpiDown, true>(C.lds, g, S, E); }
    GRID_BAR();
    phase_final(C);
}

extern "C" void kernel_launch(void* const* d_in, const int* in_sizes, int n_in, void* d_out, int out_size, void* d_ws, size_t ws_size, hipStream_t stream) {
    static int grid = 0;
    if (grid == 0) {
        if (n_in != 25 || in_sizes[0] != NTOK * DM || out_size != NTOK * DM || ws_size < WS_END) {
            fprintf(stderr, "kernel_launch: unexpected shapes (n_in %d, in0 %d, out %d, ws %zu < %zu)\n", n_in, n_in > 0 ? in_sizes[0] : -1, out_size, ws_size, (size_t)WS_END); grid = -1; return; }
        int dev = 0, cus = 0;
        if (hipGetDevice(&dev) != hipSuccess || hipDeviceGetAttribute(&cus, hipDeviceAttributeMultiprocessorCount, dev) != hipSuccess) { grid = -1; return; }
        if (hipFuncSetAttribute((const void*)fwd_kernel, hipFuncAttributeMaxDynamicSharedMemorySize, LDS_BYTES) != hipSuccess) { fprintf(stderr, "kernel_launch: hipFuncSetAttribute failed\n"); grid = -1; return; }
        (void)hipGetLastError();
        grid = cus;
    }
    if (grid < 0) return;
    if (hipMemsetAsync((char*)d_ws + WS_CTL, 0, CTL_ZERO_BYTES, stream) != hipSuccess) { fprintf(stderr, "kernel_launch: memset failed\n"); return; }
    Args a{};
    for (int i = 0; i < 25; ++i) a.in[i] = (const float*)d_in[i];
    a.out = (float*)d_out; a.ws = (unsigned char*)d_ws;
    hipLaunchKernelGGL(fwd_kernel, dim3(grid), dim3(NTHREADS), LDS_BYTES, stream, a);
}
```

```cpp
#include <hip/hip_runtime.h>
#include <cstdio>
#include <cstdint>

#define GAS __attribute__((address_space(1)))
#define LAS __attribute__((address_space(3)))
typedef unsigned short bf16;
typedef short bf16x8 __attribute__((ext_vector_type(8)));
typedef float f32x4 __attribute__((ext_vector_type(4)));
typedef unsigned u32x4 __attribute__((ext_vector_type(4)));
typedef unsigned u32x2 __attribute__((ext_vector_type(2)));
typedef int i32x4 __attribute__((ext_vector_type(4)));
typedef GAS unsigned gu32;

constexpr int NB = 16, SEQ = 2048, DM = 1024, NTOK = NB * SEQ, NE = 32, FF = 1024;
constexpr int NPROJ = 5376;
constexpr int C_DQ = 0, C_DK = 512, C_DV = 1024, C_GQ = 1536, C_GK = 1792, C_GV = 2048, C_GR = 2560, C_GA = 3072, C_GB = 4096, C_AL = 5120;
constexpr int W_IN_N = 5136;
constexpr float LOG2E = 1.4426950408889634f;
constexpr float QSCALE = 0.125f * LOG2E;
constexpr float EPS = 1e-6f;
constexpr int NWAVES = 8, NTHREADS = 512;

constexpr size_t MiB = 1u << 20;
constexpr size_t WS_CTL = 0, CTL_ZERO_BYTES = 1 * MiB;
constexpr size_t WS_MOD = 1 * MiB;
constexpr size_t WS_TOPE = 2 * MiB;
constexpr size_t WS_TOPW = 3 * MiB;
constexpr size_t WS_LIST = 4 * MiB;
constexpr size_t WS_WIN = 8 * MiB;
constexpr size_t WS_WBD = 19 * MiB;
constexpr size_t WS_WBG = 20 * MiB;
constexpr size_t WS_WOUT = 21 * MiB;
constexpr size_t WS_WGU = 24 * MiB;
constexpr size_t WS_WD = 152 * MiB;
constexpr size_t WS_H2 = 216 * MiB;
constexpr size_t WS_RB = 280 * MiB;
constexpr size_t WS_H = WS_RB, WS_OA = WS_RB + 64 * MiB, WS_OB = WS_RB + 96 * MiB, WS_MG = WS_RB + 128 * MiB, WS_YB = WS_RB;
constexpr size_t WS_RA = 536 * MiB;
constexpr size_t WS_PROJ = WS_RA, WS_ACT = WS_RA;
constexpr size_t WS_END = 872 * MiB;
constexpr int MAX_TILES = 544;
static_assert((size_t)MAX_TILES * 256 * 1024 * 2 <= 336 * MiB, "act fits region A");
constexpr int CW_CNT = 64;
constexpr int CW_BAR = 4096;
constexpr int CW_QUEUE = 2304;

constexpr int SCR_BYTES = 147456;
constexpr int LDSCTL_OFF = SCR_BYTES, MISC_OFF = LDSCTL_OFF + 320;
constexpr int LDS_BYTES = SCR_BYTES + 1024;

#define RLX_AGENT __ATOMIC_RELAXED, __HIP_MEMORY_SCOPE_AGENT
#define LDS_WAIT() asm volatile("s_waitcnt lgkmcnt(0)" ::: "memory")

__device__ __forceinline__ unsigned f2bf(float f) { unsigned u = __builtin_bit_cast(unsigned, f); return (u + 0x7fffu + ((u >> 16) & 1u)) >> 16; }
__device__ __forceinline__ unsigned pk2(float lo, float hi) { return f2bf(lo) | (f2bf(hi) << 16); }
__device__ __forceinline__ float bf2f(unsigned b) { return __uint_as_float(b << 16); }
__device__ __forceinline__ float bflo(unsigned w) { return __uint_as_float(w << 16); }
__device__ __forceinline__ float bfhi(unsigned w) { return __uint_as_float(w & 0xffff0000u); }
__device__ __forceinline__ float wave_sum(float v) {
#pragma unroll
    for (int o = 1; o < 64; o <<= 1) v += __shfl_xor(v, o);
    return v;
}
__device__ __forceinline__ int tid_fresh() { int t = threadIdx.x; asm volatile("" : "+v"(t)); return t; }
__device__ __forceinline__ float sigmoidf_(float x) { return 1.f / (1.f + __expf(-x)); }

#define XB_TMO      128
#define XB_XCNT(j)  (256  + 64 * (j))
#define XB_XSUB(j)  (1280 + 64 * (j))
#define XB_XGEN(j)  (2304 + 64 * (j))
#define XB_TOP      3328
#define XB_TOPGEN   3392
#define XCD_BAR_WORDS 3456
#define XB_SPIN_CAP (1u << 22)
__device__ __forceinline__ unsigned xb_ld(unsigned* p)              { return __hip_atomic_load(p, __ATOMIC_RELAXED, __HIP_MEMORY_SCOPE_AGENT); }
__device__ __forceinline__ unsigned xb_add(unsigned* p, unsigned v) { return __hip_atomic_fetch_add(p, v, __ATOMIC_RELAXED, __HIP_MEMORY_SCOPE_AGENT); }
__device__ __forceinline__ unsigned xb_xcc_id() { return (unsigned)__builtin_amdgcn_s_getreg((3 << 11) | 20) & 0xFu; }
#define XB_SPIN(cond, bar) do { unsigned _sp = 0; while (cond) { __builtin_amdgcn_s_sleep(1); \
    if ((++_sp & 255u) == 0u) { if (xb_ld(&(bar)[XB_TMO])) break; if (_sp > XB_SPIN_CAP) { atomicAdd(&(bar)[XB_TMO], 1u); break; } } } } while (0)
struct XcdBarrier { unsigned* bar; unsigned x; volatile LAS unsigned* st; };
__device__ __forceinline__ XcdBarrier xcd_barrier_post(unsigned* bar, volatile LAS unsigned* st) {
    XcdBarrier b; b.bar = bar; b.x = xb_xcc_id(); b.st = st;
    if (threadIdx.x == 0) (void)xb_add(&bar[XB_XCNT(b.x)], 1u);
    return b;
}
__device__ __forceinline__ void xcd_barrier_complete(unsigned* bar, unsigned x, unsigned& nloc, unsigned& nx) {
    const unsigned G = gridDim.x * gridDim.y * gridDim.z;
    unsigned sum, cnt, mine, sp = 0u;
    for (;;) {
        sum = 0u; cnt = 0u; mine = 0u;
#pragma unroll
        for (unsigned j = 0; j < 16; ++j) { const unsigned c = xb_ld(&bar[XB_XCNT(j)]); sum += c; cnt += (c > 0u) ? 1u : 0u; mine = (j == x) ? c : mine; }
        if (sum == G) break;
        __builtin_amdgcn_s_sleep(1);
        if ((++sp & 255u) == 0u) { if (xb_ld(&bar[XB_TMO])) break; if (sp > XB_SPIN_CAP) { atomicAdd(&bar[XB_TMO], 1u); break; } }
    }
    nloc = mine > 0u ? mine : 1u; nx = cnt > 0u ? cnt : 1u;
}
__device__ __forceinline__ void xcd_barrier(const XcdBarrier& b) {
    asm volatile("s_waitcnt vmcnt(0)" ::: "memory");
    __syncthreads();
    if (threadIdx.x == 0) {
        unsigned* bar = b.bar;
        __builtin_amdgcn_s_waitcnt(0);
        unsigned nloc = b.st[0], nx = b.st[1];
        if (nloc == 0u) { xcd_barrier_complete(bar, b.x, nloc, nx); b.st[0] = nloc; b.st[1] = nx; }
        const unsigned old = xb_add(&bar[XB_XSUB(b.x)], 1u);
        const unsigned gen = old / nloc;
        if (old + 1u == (gen + 1u) * nloc) {
            __builtin_amdgcn_fence(__ATOMIC_RELEASE, "agent");
            asm volatile("s_waitcnt vmcnt(0)" ::: "memory");
            const unsigned og = xb_add(&bar[XB_TOP], 1u);
            const unsigned tg = og / nx;
            if (og + 1u == (tg + 1u) * nx) xb_add(&bar[XB_TOPGEN], 1u);
            else XB_SPIN(xb_ld(&bar[XB_TOPGEN]) == tg, bar);
            __builtin_amdgcn_fence(__ATOMIC_ACQUIRE, "agent");
            xb_add(&bar[XB_XGEN(b.x)], 1u);
            asm volatile("s_waitcnt vmcnt(0)" ::: "memory");
        } else {
            XB_SPIN(xb_ld(&bar[XB_XGEN(b.x)]) == gen, bar);
            __builtin_amdgcn_fence(__ATOMIC_ACQUIRE, "agent");
            asm volatile("s_waitcnt vmcnt(0)" ::: "memory");
        }
    }
    __syncthreads();
}

struct Ctx {
    LAS unsigned char* lds;
    int tid, lane, wid, G, bid;
    const float *x, *c, *w_ada, *b_ada, *norm1_g, *w_in, *lq1, *lk1, *lq2, *lk2, *diff_g, *w_alpha_up, *b_alpha, *gla_g,
                *w_bd, *w_bg, *w_out, *norm2_g, *w_router, *b_router, *w_gu, *b_gu, *w_dn, *b_dn, *final_g;
    float* out;
    unsigned* ctl; float* mod; int* tope; float* topw; int* list;
    bf16 *WinT, *WbdT, *WbgT, *WoutT, *WguT, *WdT, *H, *H2, *OA, *OB, *MG, *YB, *PROJ, *ACT;
};

constexpr int NXCD = 8, WGM = 8;
__host__ __device__ __forceinline__ int perm32(int rho) { const int n = rho >> 4, i = rho & 15; return 8 * (i >> 2) + 4 * n + (i & 3); }
struct Unit { int pm, pn, e, row0, cnt; };
struct TileOrder {
    int nM, nN, nwg, G, c;
    __device__ __forceinline__ void init(int nM_, int nN_, int G_, int c_) { nM = nM_; nN = nN_; nwg = nM * nN; G = G_; c = c_; }
    __device__ __forceinline__ bool next(int i, Unit& u) const {
        const long L = (long)i * G + c; if (L >= nwg) return false;
        int wgid = (int)L; { const int q = nwg / NXCD, r = nwg % NXCD, xcd = wgid % NXCD, off = wgid / NXCD; wgid = (xcd < r ? xcd * (q + 1) : r * (q + 1) + (xcd - r) * q) + off; }
        const int nig = WGM * nN, gid = wgid / nig, fm = gid * WGM, gsz = (nM - fm) < WGM ? (nM - fm) : WGM;
        u.pm = fm + ((wgid % nig) % gsz); u.pn = (wgid % nig) / gsz; u.e = 0; u.row0 = 0; u.cnt = 0; return true;
    }
};
struct MoeOrder {
    TileOrder t; LAS const int* tab;
    __device__ __forceinline__ bool next(int i, Unit& u) const {
        if (!t.next(i, u)) return false;
        int e = 0;
#pragma unroll 1
        for (int k = 1; k < NE; ++k) if (tab[32 + k] <= u.pm) e = k;
        u.e = e; u.row0 = (u.pm - tab[32 + e]) * 256; u.cnt = tab[e]; return true;
    }
};
struct DenseDesc {
    const bf16* A; int lda; const bf16* Bt; int K;
    __device__ __forceinline__ unsigned a_off(const Unit& u, int r) const { return (unsigned)((u.pm * 256 + r) * lda) * 2u; }
    __device__ __forceinline__ const char* a_base(const Unit&) const { return (const char*)A; }
    __device__ __forceinline__ const char* b_base(const Unit& u) const { return (const char*)Bt + (size_t)u.pn * 256 * K * 2; }
};
struct MoeUpDesc {
    const bf16* H2; const int* list; const bf16* WguT; int K;
    __device__ __forceinline__ unsigned a_off(const Unit& u, int r) const { const int slot = u.row0 + r; int tok = 0; if (slot < u.cnt) tok = list[u.e * NTOK + slot] >> 2; return (unsigned)tok * 2048u; }
    __device__ __forceinline__ const char* a_base(const Unit&) const { return (const char*)H2; }
    __device__ __forceinline__ const char* b_base(const Unit& u) const { return (const char*)WguT + ((size_t)u.e * 2048 + (size_t)u.pn * 256) * 1024 * 2; }
};
struct MoeDownDesc {
    const bf16* ACT; const bf16* WdT; int K;
    __device__ __forceinline__ unsigned a_off(const Unit& u, int r) const { return (unsigned)(u.pm * 256 + r) * 2048u; }
    __device__ __forceinline__ const char* a_base(const Unit&) const { return (const char*)ACT; }
    __device__ __forceinline__ const char* b_base(const Unit& u) const { return (const char*)WdT + ((size_t)u.e * 1024 + (size_t)u.pn * 256) * 1024 * 2; }
};

template <class Desc, class Order, class Epi>
__device__ __forceinline__ void gemm_simple(const Desc& g, const Order& S, const Epi& E) {
    const int tid = threadIdx.x, wid = __builtin_amdgcn_readfirstlane(tid >> 6), lane = tid & 63, wr = wid >> 2, wc = wid & 3, fr = lane & 15, fq = lane >> 4;
    const int K = g.K;
    Unit u;
    for (int i = 0; S.next(i, u); ++i) {
        f32x4 acc[2][2][4][2];
#pragma unroll
        for (int a = 0; a < 2; ++a)
#pragma unroll
            for (int b = 0; b < 2; ++b)
#pragma unroll
                for (int m = 0; m < 4; ++m)
#pragma unroll
                    for (int n = 0; n < 2; ++n) acc[a][b][m][n] = (f32x4){0.f, 0.f, 0.f, 0.f};
        unsigned aoff[2][4], boff[2][2];
#pragma unroll
        for (int a = 0; a < 2; ++a)
#pragma unroll
            for (int m = 0; m < 4; ++m) aoff[a][m] = g.a_off(u, a * 128 + wr * 64 + m * 16 + fr) + fq * 16;
#pragma unroll
        for (int b = 0; b < 2; ++b)
#pragma unroll
            for (int n = 0; n < 2; ++n) { const int nc = b * 128 + wc * 32 + (Epi::PERM ? perm32(n * 16 + fr) : (n * 16 + fr)); boff[b][n] = (unsigned)(nc * K) * 2u + fq * 16; }
        const char* ab = g.a_base(u); const char* bb = g.b_base(u);
#pragma unroll 1
        for (int ks = 0; ks < K / 32; ++ks) {
            bf16x8 af[2][4], bfr[2][2];
#pragma unroll
            for (int a = 0; a < 2; ++a)
#pragma unroll
                for (int m = 0; m < 4; ++m) af[a][m] = *(const bf16x8*)(ab + aoff[a][m] + ks * 64);
#pragma unroll
            for (int b = 0; b < 2; ++b)
#pragma unroll
                for (int n = 0; n < 2; ++n) bfr[b][n] = *(const bf16x8*)(bb + boff[b][n] + ks * 64);
#pragma unroll
            for (int a = 0; a < 2; ++a)
#pragma unroll
                for (int b = 0; b < 2; ++b)
#pragma unroll
                    for (int m = 0; m < 4; ++m)
#pragma unroll
                        for (int n = 0; n < 2; ++n) acc[a][b][m][n] = __builtin_amdgcn_mfma_f32_16x16x32_bf16(bfr[b][n], af[a][m], acc[a][b][m][n], 0, 0, 0);
        }
        E(acc, u, wr, wc, fr, fq);
    }
}


constexpr int BK = 64, HALF = 128, HTB = HALF * BK * 2, STAGE_BYTES = 8 * HTB;
__host__ __device__ __forceinline__ int lds_byte(int r, int c) { const int st = (r >> 4) * 2 + (c >> 5), rr = r & 15, cc = c & 31, ob = rr * 64 + cc * 2; return st * 1024 + (ob ^ (((ob >> 9) & 1) << 5)); }
__host__ __device__ __forceinline__ void stage_rc(int b, int& R, int& C) { const int st = b / 1024, sb = b % 1024, swz = sb ^ (((sb >> 9) & 1) << 5); R = (st >> 1) * 16 + swz / 64; C = (st & 1) * 32 + (swz % 64) / 2; }

template <class Desc, class Order, class Epi, bool ALIGN_EPI>
__device__ __forceinline__ void gemm_phase(LAS unsigned char* lds, const Desc& g, const Order& S, const Epi& E) {
    const int tid = tid_fresh(), wid = __builtin_amdgcn_readfirstlane(tid >> 6), lane = tid & 63, wr = wid >> 2, wc = wid & 3, fr = lane & 15, fq = lane >> 4;
    const int K = g.K, nt = K / BK;
    int Rs[2], Cs[2]; unsigned voffB[2];
#pragma unroll
    for (int i = 0; i < 2; ++i) { stage_rc(tid * 16 + i * 8192, Rs[i], Cs[i]); const int Rb = Epi::PERM ? ((Rs[i] & ~31) + perm32(Rs[i] & 31)) : Rs[i]; voffB[i] = (unsigned)(Rb * K + Cs[i]) * 2u; }
    unsigned vA[2][2];
    LAS u32x4* const vslot = (LAS u32x4*)(lds + STAGE_BYTES + 1024) + tid;
    const size_t kstep = (size_t)(BK * 2);
    const size_t hstepB = (size_t)HALF * K * 2;
    const unsigned ldsw = (unsigned)wid * 1024u;
    const int aoff = lds_byte(wr * 64 + fr, fq * 8), boff = lds_byte(wc * 32 + fr, fq * 8);
#define PG8_SA(b, h) (((b) * 2 + (h)) * HTB)
#define PG8_SB(b, h) ((4 + (b) * 2 + (h)) * HTB)
#define PG8_STAGE(bufoff, gbase, voff) do { _Pragma("unroll") for (int _i = 0; _i < 2; ++_i) \
        __builtin_amdgcn_global_load_lds((const unsigned*)((const char*)(gbase) + (voff)[_i]), (LAS unsigned*)(lds + (bufoff) + ldsw + _i * 8192), 16, 0, 0); } while (0)
#define PG8_STAGE_A(bufoff, gbase, h) do { _Pragma("unroll") for (int _i = 0; _i < 2; ++_i) \
        __builtin_amdgcn_global_load_lds((const unsigned*)((const char*)(gbase) + vA[h][_i]), (LAS unsigned*)(lds + (bufoff) + ldsw + _i * 8192), 16, 0, 0); } while (0)
#define PG8_LDA(dst, b, h) do { _Pragma("unroll") for (int m = 0; m < 4; ++m) _Pragma("unroll") for (int k = 0; k < 2; ++k) dst[m][k] = *(const LAS bf16x8*)(lds + PG8_SA(b, h) + aoff + m * 2048 + k * 1024); } while (0)
#define PG8_LDB(dst, b, h) do { _Pragma("unroll") for (int n = 0; n < 2; ++n) _Pragma("unroll") for (int k = 0; k < 2; ++k) dst[n][k] = *(const LAS bf16x8*)(lds + PG8_SB(b, h) + boff + n * 2048 + k * 1024); } while (0)
#define PG8_MMA(ai, bj, At, Bt) do { __builtin_amdgcn_s_setprio(1); _Pragma("unroll") for (int m = 0; m < 4; ++m) _Pragma("unroll") for (int n = 0; n < 2; ++n) _Pragma("unroll") for (int k = 0; k < 2; ++k) \
        acc[ai][bj][m][n] = __builtin_amdgcn_mfma_f32_16x16x32_bf16(Bt[n][k], At[m][k], acc[ai][bj][m][n], 0, 0, 0); __builtin_amdgcn_s_setprio(0); } while (0)
#define PG8_WAIT_V(n) asm volatile("s_waitcnt vmcnt(" #n ")" ::: "memory")
#define PG8_WAIT_L(n) asm volatile("s_waitcnt lgkmcnt(" #n ")" ::: "memory")
#define PG8_BAR __builtin_amdgcn_s_barrier()
#define PG8_SCHED __builtin_amdgcn_sched_barrier(0)
#define PG8_AOFFS(dst, un) do { _Pragma("unroll") for (int _h = 0; _h < 2; ++_h) _Pragma("unroll") for (int _i = 0; _i < 2; ++_i) dst[_h][_i] = g.a_off(un, _h * HALF + Rs[_i]) + (unsigned)Cs[_i] * 2u; } while (0)
    Unit cur, nxt; int ui = 0;
    if (!S.next(0, cur)) return;
    f32x4 acc[2][2][4][2];
#pragma unroll
    for (int a = 0; a < 2; ++a)
#pragma unroll
        for (int b = 0; b < 2; ++b)
#pragma unroll
            for (int m = 0; m < 4; ++m)
#pragma unroll
                for (int n = 0; n < 2; ++n) acc[a][b][m][n] = (f32x4){0.f, 0.f, 0.f, 0.f};
    bf16x8 At[4][2], B0[2][2], B1[2][2];
    const char* const Ab = g.a_base(cur);
    const char* cB = g.b_base(cur);
    PG8_AOFFS(vA, cur);
    PG8_STAGE(PG8_SB(0, 0), cB, voffB); PG8_STAGE(PG8_SB(0, 1), cB + hstepB, voffB); PG8_STAGE_A(PG8_SA(0, 0), Ab, 0); PG8_STAGE_A(PG8_SA(0, 1), Ab, 1);
    if (wr == 1) PG8_BAR;
    PG8_WAIT_V(2); PG8_BAR;
    PG8_STAGE(PG8_SB(1, 0), cB + kstep, voffB); PG8_STAGE_A(PG8_SA(1, 0), Ab + kstep, 0); PG8_STAGE(PG8_SB(1, 1), cB + hstepB + kstep, voffB);
    PG8_WAIT_V(6); PG8_BAR;
    for (;;) {
        const bool has_next = S.next(ui + 1, nxt);
        const char* nB = has_next ? g.b_base(nxt) : cB;
        if (has_next) { unsigned vn[2][2]; PG8_AOFFS(vn, nxt); *vslot = (u32x4){vn[0][0], vn[0][1], vn[1][0], vn[1][1]}; }
        for (int t = 0; t < nt; t += 2) {
            const bool last = (t == nt - 2);
            const char* a1 = Ab + (size_t)(t + 1) * kstep;
            const char* a2 = last ? Ab : Ab + (size_t)(t + 2) * kstep; const char* b2 = last ? nB : cB + (size_t)(t + 2) * kstep;
            const char* a3 = a2 + kstep; const char* b3 = b2 + kstep;
            PG8_LDB(B0, 0, 0); PG8_LDB(B1, 0, 1); PG8_SCHED; PG8_LDA(At, 0, 0); PG8_STAGE_A(PG8_SA(1, 1), a1, 1);
            if (last && has_next) { const u32x4 vn = *vslot; vA[0][0] = vn.x; vA[0][1] = vn.y; vA[1][0] = vn.z; vA[1][1] = vn.w; }
            PG8_WAIT_V(8); PG8_WAIT_L(0); PG8_BAR; PG8_MMA(0, 0, At, B0); PG8_MMA(0, 1, At, B1); PG8_BAR; PG8_SCHED;
            PG8_LDA(At, 0, 1); PG8_STAGE(PG8_SB(0, 0), b2, voffB); PG8_STAGE(PG8_SB(0, 1), b2 + hstepB, voffB); PG8_STAGE_A(PG8_SA(0, 0), a2, 0);
            PG8_WAIT_V(8); PG8_WAIT_L(0); PG8_BAR; PG8_MMA(1, 0, At, B0); PG8_MMA(1, 1, At, B1); PG8_BAR; PG8_SCHED;
            PG8_LDB(B0, 1, 0); PG8_LDB(B1, 1, 1); PG8_SCHED; PG8_LDA(At, 1, 0); PG8_STAGE_A(PG8_SA(0, 1), a2, 1);
            PG8_WAIT_V(8); PG8_WAIT_L(0); PG8_BAR; PG8_MMA(0, 0, At, B0); PG8_MMA(0, 1, At, B1); PG8_BAR; PG8_SCHED;
            PG8_LDA(At, 1, 1); PG8_STAGE(PG8_SB(1, 0), b3, voffB); PG8_STAGE(PG8_SB(1, 1), b3 + hstepB, voffB); PG8_STAGE_A(PG8_SA(1, 0), a3, 0);
            PG8_WAIT_V(8); PG8_WAIT_L(0); PG8_BAR; PG8_MMA(1, 0, At, B0); PG8_MMA(1, 1, At, B1); PG8_BAR; PG8_SCHED;
        }
        if constexpr (ALIGN_EPI) { if (wr == 0) PG8_BAR; }
        E(acc, cur, wr, wc, fr, fq);
        if (!has_next) break;
#pragma unroll
        for (int a = 0; a < 2; ++a)
#pragma unroll
            for (int b = 0; b < 2; ++b)
#pragma unroll
                for (int m = 0; m < 4; ++m)
#pragma unroll
                    for (int n = 0; n < 2; ++n) acc[a][b][m][n] = (f32x4){0.f, 0.f, 0.f, 0.f};
        cur = nxt; cB = nB; ++ui;
        if constexpr (ALIGN_EPI) { if (wr == 1) PG8_BAR; }
    }
    PG8_WAIT_V(0);
    if constexpr (!ALIGN_EPI) { if (wr == 0) PG8_BAR; }
    PG8_BAR;
#undef PG8_SA
#undef PG8_SB
#undef PG8_STAGE
#undef PG8_STAGE_A
#undef PG8_LDA
#undef PG8_LDB
#undef PG8_MMA
#undef PG8_WAIT_V
#undef PG8_WAIT_L
#undef PG8_BAR
#undef PG8_SCHED
#undef PG8_AOFFS
}

__device__ __forceinline__ u32x4 pack8(const f32x4& v0, const f32x4& v1) { u32x4 w; w.x = pk2(v0[0], v0[1]); w.y = pk2(v0[2], v0[3]); w.z = pk2(v1[0], v1[1]); w.w = pk2(v1[2], v1[3]); return w; }
__device__ __forceinline__ void unpack8(const u32x4& w, f32x4& v0, f32x4& v1) { v0 = (f32x4){bflo(w.x), bfhi(w.x), bflo(w.y), bfhi(w.y)}; v1 = (f32x4){bflo(w.z), bfhi(w.z), bflo(w.w), bfhi(w.w)}; }
__device__ __forceinline__ float logsig16(float x) { return (fminf(x, 0.f) - log1pf(__expf(-fabsf(x)))) * (1.f / 16.f); }

struct EpiProj {
    static constexpr bool PERM = true;
    bf16* P; const float* b_alpha;
    __device__ __forceinline__ void operator()(const f32x4 (&acc)[2][2][4][2], const Unit& u, int wr, int wc, int fr, int fq) const {
        const int pn = u.pn; const int mode = (pn < 2) ? 1 : (pn == 6 ? 2 : (pn == 20 ? 3 : 0));
#pragma unroll
        for (int bj = 0; bj < 2; ++bj) {
            const int c0 = pn * 256 + bj * 128 + wc * 32 + 8 * fq;
            f32x4 b0 = (f32x4){0.f, 0.f, 0.f, 0.f}, b1 = b0;
            if (mode == 3) { b0 = *(const f32x4*)(b_alpha + (c0 - C_AL)); b1 = *(const f32x4*)(b_alpha + (c0 - C_AL) + 4); }
#pragma unroll
            for (int ai = 0; ai < 2; ++ai)
#pragma unroll
                for (int m = 0; m < 4; ++m) {
                    const int row = u.pm * 256 + ai * 128 + wr * 64 + m * 16 + fr;
                    f32x4 v0 = acc[ai][bj][m][0], v1 = acc[ai][bj][m][1];
                    if (mode == 1) { v0 = v0 * QSCALE; v1 = v1 * QSCALE; }
                    else if (mode == 2) { v0 = v0 * 0.125f; v1 = v1 * 0.125f; }
                    else if (mode == 3) {
#pragma unroll
                        for (int j = 0; j < 4; ++j) { v0[j] = logsig16(v0[j] + b0[j]); v1[j] = logsig16(v1[j] + b1[j]); } }
                    *(u32x4*)(P + (size_t)row * NPROJ + c0) = pack8(v0, v1);
                }
        }
    }
};
struct EpiBranch {
    static constexpr bool PERM = true;
    bf16* MG; const bf16* P; int gcol; int add;
    __device__ __forceinline__ void operator()(const f32x4 (&acc)[2][2][4][2], const Unit& u, int wr, int wc, int fr, int fq) const {
#pragma unroll
        for (int ai = 0; ai < 2; ++ai)
#pragma unroll
            for (int m = 0; m < 4; ++m) {
                const int row = u.pm * 256 + ai * 128 + wr * 64 + m * 16 + fr;
#pragma unroll
                for (int bj = 0; bj < 2; ++bj) {
                    const int c0 = u.pn * 256 + bj * 128 + wc * 32 + 8 * fq;
                    const u32x4 gw = *(const u32x4*)(P + (size_t)row * NPROJ + gcol + c0);
                    f32x4 g0, g1; unpack8(gw, g0, g1);
                    f32x4 v0 = acc[ai][bj][m][0], v1 = acc[ai][bj][m][1];
#pragma unroll
                    for (int j = 0; j < 4; ++j) { v0[j] *= sigmoidf_(g0[j]); v1[j] *= sigmoidf_(g1[j]); }
                    bf16* dst = MG + (size_t)row * DM + c0;
                    if (add) { const u32x4 ow = *(const u32x4*)dst; f32x4 o0, o1; unpack8(ow, o0, o1); v0 = v0 + o0; v1 = v1 + o1; }
                    *(u32x4*)dst = pack8(v0, v1);
                }
            }
    }
};
struct EpiOut {
    static constexpr bool PERM = false;
    const float* x; float* x1; const float* mod;
    __device__ __forceinline__ void operator()(const f32x4 (&acc)[2][2][4][2], const Unit& u, int wr, int wc, int fr, int fq) const {
        const int b = u.pm >> 3; const float* gt1 = mod + b * 6144 + 2048;
#pragma unroll
        for (int bj = 0; bj < 2; ++bj)
#pragma unroll
            for (int n = 0; n < 2; ++n) {
                const int c0 = u.pn * 256 + bj * 128 + wc * 32 + 16 * n + 4 * fq;
                const f32x4 gt = *(const f32x4*)(gt1 + c0);
#pragma unroll
                for (int ai = 0; ai < 2; ++ai)
#pragma unroll
                    for (int m = 0; m < 4; ++m) {
                        const size_t off = (size_t)(u.pm * 256 + ai * 128 + wr * 64 + m * 16 + fr) * DM + c0;
                        const f32x4 xv = *(const f32x4*)(x + off);
                        *(f32x4*)(x1 + off) = xv + gt * acc[ai][bj][m][n];
                    }
            }
    }
};
struct EpiUp {
    static constexpr bool PERM = true;
    bf16* ACT; const float* b_gu;
    __device__ __forceinline__ void operator()(const f32x4 (&acc)[2][2][4][2], const Unit& u, int wr, int wc, int fr, int fq) const {
        const int f0 = u.pn * 128 + wc * 32 + 8 * fq;
        const float* bg = b_gu + (size_t)u.e * 2048 + f0; const float* bu = bg + 1024;
        const f32x4 bg0 = *(const f32x4*)bg, bg1 = *(const f32x4*)(bg + 4), bu0 = *(const f32x4*)bu, bu1 = *(const f32x4*)(bu + 4);
#pragma unroll
        for (int ai = 0; ai < 2; ++ai)
#pragma unroll
            for (int m = 0; m < 4; ++m) {
                const int r = ai * 128 + wr * 64 + m * 16 + fr;
                f32x4 g0 = acc[ai][0][m][0] + bg0, g1 = acc[ai][0][m][1] + bg1, u0 = acc[ai][1][m][0] + bu0, u1 = acc[ai][1][m][1] + bu1, a0, a1;
#pragma unroll
                for (int j = 0; j < 4; ++j) {
                    float gg = fminf(g0[j], 7.f), uu = fminf(fmaxf(u0[j], -7.f), 7.f); a0[j] = (uu + 1.f) * gg * sigmoidf_(1.702f * gg);
                    gg = fminf(g1[j], 7.f); uu = fminf(fmaxf(u1[j], -7.f), 7.f); a1[j] = (uu + 1.f) * gg * sigmoidf_(1.702f * gg); }
                *(u32x4*)(ACT + (size_t)(u.pm * 256 + r) * FF + f0) = pack8(a0, a1);
            }
    }
};
struct EpiDown {
    static constexpr bool PERM = true;
    bf16* YB; const float* b_dn; const int* list;
    __device__ __forceinline__ void operator()(const f32x4 (&acc)[2][2][4][2], const Unit& u, int wr, int wc, int fr, int fq) const {
#pragma unroll
        for (int ai = 0; ai < 2; ++ai)
#pragma unroll
            for (int m = 0; m < 4; ++m) {
                const int slot = u.row0 + ai * 128 + wr * 64 + m * 16 + fr;
                if (slot < u.cnt) {
                    const int aid = list[u.e * NTOK + slot];
#pragma unroll
                    for (int bj = 0; bj < 2; ++bj) {
                        const int c0 = u.pn * 256 + bj * 128 + wc * 32 + 8 * fq;
                        const float* bp = b_dn + (size_t)u.e * DM + c0;
                        const f32x4 v0 = acc[ai][bj][m][0] + *(const f32x4*)bp, v1 = acc[ai][bj][m][1] + *(const f32x4*)(bp + 4);
                        *(u32x4*)(YB + (size_t)aid * DM + c0) = pack8(v0, v1);
                    }
                }
            }
    }
};

__device__ __forceinline__ void phase_mod(const Ctx& C) {
    LAS float* sc = (LAS float*)C.lds;
    LAS float* red = sc + 16 * 1024;
    for (int cb = C.bid; cb < 96; cb += C.G) {
        __syncthreads();
        for (int i = C.tid; i < 16 * 1024; i += NTHREADS) { const float v = C.c[i]; sc[i] = v / (1.f + __expf(-v)); }
        __syncthreads();
        const int cl = C.tid & 63, ks = C.tid >> 6, col = cb * 64 + cl;
        float acc[16];
#pragma unroll
        for (int b = 0; b < 16; ++b) acc[b] = 0.f;
#pragma unroll 4
        for (int k = ks * 128; k < ks * 128 + 128; ++k) {
            const float w = C.w_ada[(size_t)k * 6144 + col];
#pragma unroll
            for (int b = 0; b < 16; ++b) acc[b] += sc[b * 1024 + k] * w;
        }
#pragma unroll
        for (int b = 0; b < 16; ++b) red[(ks * 16 + b) * 64 + cl] = acc[b];
        __syncthreads();
        for (int o = C.tid; o < 1024; o += NTHREADS) {
            const int b = o >> 6, c2 = o & 63; float s = 0.f;
#pragma unroll
            for (int k2 = 0; k2 < 8; ++k2) s += red[(k2 * 16 + b) * 64 + c2];
            C.mod[b * 6144 + cb * 64 + c2] = s + C.b_ada[cb * 64 + c2];
        }
    }
    for (int gt = C.bid * NTHREADS + C.tid; gt < 256 * 512; gt += C.G * NTHREADS) {
        const int j = gt >> 9, k = (gt & 511) * 2;
        float s0 = 0.f, s1 = 0.f;
#pragma unroll
        for (int r = 0; r < 16; ++r) { const float wa = C.w_alpha_up[r * 256 + j]; s0 += C.w_in[(size_t)k * W_IN_N + 3072 + r] * wa; s1 += C.w_in[(size_t)(k + 1) * W_IN_N + 3072 + r] * wa; }
        *(unsigned*)(C.WinT + (size_t)(C_AL + j) * DM + k) = pk2(s0, s1);
    }
}

__device__ __forceinline__ void transpose_item(const float* W, int srcN, bf16* WT, int Kp, int dst_row0, int src_col0, int k0, LAS float* scr, int lane) {
#pragma unroll 8
    for (int i = 0; i < 32; ++i) { const int kk = 2 * i + (lane >> 5); scr[kk * 33 + (lane & 31)] = W[(size_t)(k0 + kk) * srcN + src_col0 + (lane & 31)]; }
    LDS_WAIT(); asm volatile("" ::: "memory");
    const int c = lane & 7;
#pragma unroll
    for (int j = 0; j < 4; ++j) { const int n = (lane >> 3) + 8 * j; const LAS float* s = scr + (8 * c) * 33 + n;
        u32x4 o; o.x = pk2(s[0 * 33], s[1 * 33]); o.y = pk2(s[2 * 33], s[3 * 33]); o.z = pk2(s[4 * 33], s[5 * 33]); o.w = pk2(s[6 * 33], s[7 * 33]);
        *(u32x4*)(WT + (size_t)(dst_row0 + n) * Kp + k0 + 8 * c) = o; }
    LDS_WAIT(); asm volatile("" ::: "memory");
}
__device__ __forceinline__ void phase_prep(const Ctx& C) {
    LAS float* scr = (LAS float*)(C.lds + C.wid * 16384);
    const int gw = C.bid * NWAVES + C.wid, NGW = C.G * NWAVES;
    constexpr int I_IN = 16 * 160, I_BD = 8 * 32, I_OUT = 16 * 32, I_GU = 32 * 16 * 64, I_DN = 32 * 16 * 32;
    constexpr int NITEMS = I_IN + 2 * I_BD + I_OUT + I_GU + I_DN;
    for (int it = gw; it < NITEMS; it += NGW) {
        int r = it;
        if (r < I_IN) { const int kb = r / 160, n0 = (r % 160) * 32; transpose_item(C.w_in, W_IN_N, C.WinT, DM, n0, n0 < 3072 ? n0 : n0 + 16, kb * 64, scr, C.lane); continue; } r -= I_IN;
        if (r < I_BD) { transpose_item(C.w_bd, DM, C.WbdT, 512, (r & 31) * 32, (r & 31) * 32, (r >> 5) * 64, scr, C.lane); continue; } r -= I_BD;
        if (r < I_BD) { transpose_item(C.w_bg, DM, C.WbgT, 512, (r & 31) * 32, (r & 31) * 32, (r >> 5) * 64, scr, C.lane); continue; } r -= I_BD;
        if (r < I_OUT) { transpose_item(C.w_out, DM, C.WoutT, DM, (r & 31) * 32, (r & 31) * 32, (r >> 5) * 64, scr, C.lane); continue; } r -= I_OUT;
        if (r < I_GU) { const int e = r >> 10, rr = r & 1023, kb = rr >> 6, n0 = (rr & 63) * 32; const int pn = n0 >> 8, bj = (n0 >> 7) & 1, j0 = n0 & 127;
            transpose_item(C.w_gu + (size_t)e * DM * 2048, 2048, C.WguT + (size_t)e * 2048 * DM, DM, n0, bj * 1024 + pn * 128 + j0, kb * 64, scr, C.lane); continue; } r -= I_GU;
        { const int e = r >> 9, rr = r & 511, kb = rr >> 5, n0 = (rr & 31) * 32;
            transpose_item(C.w_dn + (size_t)e * FF * DM, DM, C.WdT + (size_t)e * DM * FF, FF, n0, n0, kb * 64, scr, C.lane); }
    }
    for (int row = gw; row < NTOK; row += NGW) {
        const int b = row >> 11; const float* md = C.mod + b * 6144;
        f32x4 v[4]; float ss = 0.f;
#pragma unroll
        for (int j = 0; j < 4; ++j) { v[j] = *(const f32x4*)(C.x + (size_t)row * DM + 4 * C.lane + 256 * j); ss += (v[j][0] * v[j][0] + v[j][1] * v[j][1]) + (v[j][2] * v[j][2] + v[j][3] * v[j][3]); }
        const float rstd = rsqrtf(wave_sum(ss) * (1.f / DM) + EPS);
#pragma unroll
        for (int j = 0; j < 4; ++j) { const int c0 = 4 * C.lane + 256 * j;
            const f32x4 g = *(const f32x4*)(C.norm1_g + c0), sc = *(const f32x4*)(md + 1024 + c0), sh = *(const f32x4*)(md + c0);
            const f32x4 y = v[j] * rstd * g * (sc + 1.f) + sh;
            u32x2 o; o.x = pk2(y[0], y[1]); o.y = pk2(y[2], y[3]);
            *(u32x2*)(C.H + (size_t)row * DM + c0) = o; }
    }
}

__device__ __forceinline__ void gla_scan(const Ctx& C, int b, int h) {
    LAS float* qs = (LAS float*)C.lds;
    LAS float* ks = qs + 2048;
    LAS float* al = ks + 2048;
    LAS float* vs = al + 2048;
    LAS float* part = vs + 4096;
    const int dv = C.tid & 127, dkg = C.tid >> 7;
    float S[16];
#pragma unroll
    for (int j = 0; j < 16; ++j) S[j] = 0.f;
    const float gdv0 = C.gla_g[2 * C.lane], gdv1 = C.gla_g[2 * C.lane + 1];
    for (int ch = 0; ch < SEQ / 32; ++ch) {
        const int row0 = b * SEQ + ch * 32;
        __syncthreads();
        for (int i = C.tid; i < 32 * 64; i += NTHREADS) { const int t = i >> 6, d = i & 63; const bf16* pr = C.PROJ + (size_t)(row0 + t) * NPROJ;
            qs[i] = bf2f(pr[C_GQ + h * 64 + d]); ks[i] = bf2f(pr[C_GK + h * 64 + d]); al[i] = __expf(bf2f(pr[C_AL + h * 64 + d])); }
        for (int i = C.tid; i < 32 * 128; i += NTHREADS) { const int t = i >> 7, d = i & 127; vs[i] = bf2f(C.PROJ[(size_t)(row0 + t) * NPROJ + C_GV + h * 128 + d]); }
        __syncthreads();
#pragma unroll 2
        for (int t = 0; t < 32; ++t) {
            const float v = vs[t * 128 + dv]; float o = 0.f;
#pragma unroll
            for (int j4 = 0; j4 < 4; ++j4) {
                const f32x4 a4 = *(const LAS f32x4*)(al + t * 64 + dkg * 16 + j4 * 4), k4 = *(const LAS f32x4*)(ks + t * 64 + dkg * 16 + j4 * 4), q4 = *(const LAS f32x4*)(qs + t * 64 + dkg * 16 + j4 * 4);
#pragma unroll
                for (int jj = 0; jj < 4; ++jj) { const int j = j4 * 4 + jj; S[j] = a4[jj] * S[j] + k4[jj] * v; o += q4[jj] * S[j]; }
            }
            part[(dkg * 32 + t) * 128 + dv] = o;
        }
        __syncthreads();
#pragma unroll
        for (int tt = 0; tt < 4; ++tt) {
            const int t = 4 * C.wid + tt; float o0 = 0.f, o1 = 0.f;
#pragma unroll
            for (int g = 0; g < 4; ++g) { o0 += part[(g * 32 + t) * 128 + 2 * C.lane]; o1 += part[(g * 32 + t) * 128 + 2 * C.lane + 1]; }
            const float rstd = rsqrtf(wave_sum(o0 * o0 + o1 * o1) * (1.f / 128.f) + EPS);
            const unsigned grw = *(const unsigned*)(C.PROJ + (size_t)(row0 + t) * NPROJ + C_GR + h * 128 + 2 * C.lane);
            const float g0 = bflo(grw), g1 = bfhi(grw);
            const float y0 = o0 * rstd * gdv0 * (g0 * sigmoidf_(g0)), y1 = o1 * rstd * gdv1 * (g1 * sigmoidf_(g1));
            *(unsigned*)(C.OB + (size_t)(row0 + t) * 512 + h * 128 + 2 * C.lane) = pk2(y0, y1);
        }
    }
}

__device__ __forceinline__ void attn_simple(const Ctx& C) {
    LAS float* Kt = (LAS float*)C.lds;
    LAS float* Vt = Kt + 8192;
    LAS float* Ss = Vt + 8192;
    LAS float* ssq = Ss + 2 * 64 * 68;
    LAS float* lamp = ssq + 256;
    if (C.tid < 64) {
        const float a = wave_sum(C.lq1[C.lane] * C.lk1[C.lane]), b2 = wave_sum(C.lq2[C.lane] * C.lk2[C.lane]);
        if (C.tid == 0) lamp[0] = __expf(a) - __expf(b2) + 0.2f;
    }
    __syncthreads();
    const float lam = lamp[0];
    const int q = C.tid & 63, p = (C.tid >> 6) & 1, dq = C.tid >> 7;
    for (int uix = C.bid; uix < 2048; uix += C.G) {
        const int bh = uix & 63, g = (uix >> 6) & 3, i2 = uix >> 8; const int b = bh >> 2, h = bh & 3;
        const int qc = (i2 & 1) ? (31 - (4 * g + (i2 >> 1))) : (4 * g + (i2 >> 1));
        const float sl2 = exp2f(-2.f * (float)(h + 1)) * LOG2E;
        const int qrow = b * SEQ + qc * 64 + q;
        float qv[64];
#pragma unroll
        for (int d8 = 0; d8 < 8; ++d8) { const u32x4 w = *(const u32x4*)(C.PROJ + (size_t)qrow * NPROJ + C_DQ + h * 128 + p * 64 + d8 * 8);
            qv[d8 * 8 + 0] = bflo(w.x); qv[d8 * 8 + 1] = bfhi(w.x); qv[d8 * 8 + 2] = bflo(w.y); qv[d8 * 8 + 3] = bfhi(w.y);
            qv[d8 * 8 + 4] = bflo(w.z); qv[d8 * 8 + 5] = bfhi(w.z); qv[d8 * 8 + 6] = bflo(w.w); qv[d8 * 8 + 7] = bfhi(w.w); }
        float m = -1e30f, l = 0.f, acc[32];
#pragma unroll
        for (int d = 0; d < 32; ++d) acc[d] = 0.f;
        for (int kc = 0; kc <= qc; ++kc) {
            __syncthreads();
            for (int pi = C.tid; pi < 1024; pi += NTHREADS) { const int r = pi >> 4, cc = pi & 15; const bf16* pr = C.PROJ + (size_t)(b * SEQ + kc * 64 + r) * NPROJ + h * 128 + cc * 8;
                const u32x4 kw = *(const u32x4*)(pr + C_DK), vw = *(const u32x4*)(pr + C_DV); f32x4 a0, a1;
                unpack8(kw, a0, a1); *(LAS f32x4*)(Kt + r * 128 + cc * 8) = a0; *(LAS f32x4*)(Kt + r * 128 + cc * 8 + 4) = a1;
                unpack8(vw, a0, a1); *(LAS f32x4*)(Vt + r * 128 + cc * 8) = a0; *(LAS f32x4*)(Vt + r * 128 + cc * 8 + 4) = a1; }
            __syncthreads();
#pragma unroll 1
            for (int kk = 0; kk < 16; ++kk) {
                const int key = dq * 16 + kk; float s = 0.f;
#pragma unroll
                for (int d4 = 0; d4 < 16; ++d4) { const f32x4 kv = *(const LAS f32x4*)(Kt + key * 128 + p * 64 + d4 * 4);
                    s += qv[d4 * 4] * kv[0]; s += qv[d4 * 4 + 1] * kv[1]; s += qv[d4 * 4 + 2] * kv[2]; s += qv[d4 * 4 + 3] * kv[3]; }
                const int kpos = kc * 64 + key, qpos = qc * 64 + q; const int mn = kpos < 2 * qpos - kpos ? kpos : 2 * qpos - kpos;
                Ss[(p * 64 + q) * 68 + key] = s + sl2 * (float)mn;
            }
            __syncthreads();
            const LAS float* srow = Ss + (p * 64 + q) * 68;
            float cm = -1e30f;
#pragma unroll
            for (int k4 = 0; k4 < 16; ++k4) { const f32x4 sv = *(const LAS f32x4*)(srow + k4 * 4); cm = fmaxf(cm, fmaxf(fmaxf(sv[0], sv[1]), fmaxf(sv[2], sv[3]))); }
            const float mnew = fmaxf(m, cm), alpha = exp2f(m - mnew); m = mnew; l *= alpha;
#pragma unroll
            for (int d = 0; d < 32; ++d) acc[d] *= alpha;
#pragma unroll 2
            for (int key = 0; key < 64; ++key) {
                const float pk = exp2f(srow[key] - m); l += pk;
#pragma unroll
                for (int d4 = 0; d4 < 8; ++d4) { const f32x4 vv = *(const LAS f32x4*)(Vt + key * 128 + dq * 32 + d4 * 4);
                    acc[d4 * 4] += pk * vv[0]; acc[d4 * 4 + 1] += pk * vv[1]; acc[d4 * 4 + 2] += pk * vv[2]; acc[d4 * 4 + 3] += pk * vv[3]; }
            }
        }
        const float inv = 1.f / l;
        __syncthreads();
        LAS float* O2 = Ss;
        if (p == 1) {
#pragma unroll
            for (int d = 0; d < 32; ++d) O2[q * 128 + dq * 32 + d] = lam * acc[d] * inv;
        }
        __syncthreads();
        float ss = 0.f;
        if (p == 0) {
#pragma unroll
            for (int d = 0; d < 32; ++d) { acc[d] = acc[d] * inv - O2[q * 128 + dq * 32 + d]; ss += acc[d] * acc[d]; }
            ssq[q * 4 + dq] = ss;
        }
        __syncthreads();
        if (p == 0) {
            const float tot = (ssq[q * 4] + ssq[q * 4 + 1]) + (ssq[q * 4 + 2] + ssq[q * 4 + 3]);
            const float rstd = rsqrtf(tot * (1.f / 128.f) + EPS) * 0.8f;
            bf16* dst = C.OA + (size_t)qrow * 512 + h * 128 + dq * 32;
#pragma unroll
            for (int d8 = 0; d8 < 4; ++d8) { u32x4 w; const float* gg = C.diff_g + dq * 32 + d8 * 8;
                w.x = pk2(acc[d8 * 8] * rstd * gg[0], acc[d8 * 8 + 1] * rstd * gg[1]); w.y = pk2(acc[d8 * 8 + 2] * rstd * gg[2], acc[d8 * 8 + 3] * rstd * gg[3]);
                w.z = pk2(acc[d8 * 8 + 4] * rstd * gg[4], acc[d8 * 8 + 5] * rstd * gg[5]); w.w = pk2(acc[d8 * 8 + 6] * rstd * gg[6], acc[d8 * 8 + 7] * rstd * gg[7]);
                *(u32x4*)(dst + d8 * 8) = w; }
        }
    }
}


typedef float f32x16 __attribute__((ext_vector_type(16)));
typedef short s16x4 __attribute__((ext_vector_type(4)));
typedef short v4i16_t __attribute__((ext_vector_type(4)));
__device__ __forceinline__ int crow(int r, int hi) { return (r & 3) + 8 * (r >> 2) + 4 * hi; }
#define MFMA32(a, b, c) __builtin_amdgcn_mfma_f32_32x32x16_bf16(a, b, c, 0, 0, 0)
constexpr int AT_BUF = 32768, AT_WSF = 65536, AT_Q = 65536 + 2048;
constexpr float AT_THR = 8.f;
__device__ __forceinline__ s16x4 vtr(const LAS unsigned char* p) { return __builtin_bit_cast(s16x4, __builtin_amdgcn_ds_read_tr16_b64_v4i16((LAS v4i16_t*)p)); }

__device__ __forceinline__ void attn_unit(const Ctx& C, int b, int h, int cp, float lam) {
    const int lane = C.lane, r32 = lane & 31, hi = lane >> 5, wid = C.wid, p = wid >> 2, sub = wid & 3;
    const int NT = 2 * cp + 2, qch = 2 * cp + (sub >> 1), my_nt = qch + 1;
    const int row0 = b * SEQ + cp * 128;
    const int qpos = cp * 128 + sub * 32 + r32;
    const float sl2 = exp2f(-2.f * (float)(h + 1)) * LOG2E;
    LAS unsigned char* lds = C.lds;
    LAS float* wsf = (LAS float*)(lds + AT_WSF) + wid * 64;
    const char* kbase = (const char*)(C.PROJ + (size_t)(b * SEQ) * NPROJ + h * 128);
    const unsigned koff = (unsigned)((lane * NPROJ + C_DK + wid * 8) * 2);
    const unsigned voff = (unsigned)(((16 * (wid & 3) + (lane >> 2)) * NPROJ + C_DV + (wid >> 2) * 32 + (lane & 3) * 8) * 2);
#define AT_DMA(t, bufo) do { const char* _tb = kbase + (size_t)(t) * 64 * NPROJ * 2; \
        __builtin_amdgcn_global_load_lds((const unsigned*)(_tb + koff), (LAS unsigned*)(lds + (bufo) + wid * 1024), 16, 0, 0); \
        __builtin_amdgcn_global_load_lds((const unsigned*)(_tb + koff + 128), (LAS unsigned*)(lds + (bufo) + 8192 + wid * 1024), 16, 0, 0); \
        __builtin_amdgcn_global_load_lds((const unsigned*)(_tb + voff), (LAS unsigned*)(lds + (bufo) + 16384 + (wid >> 2) * 4096 + (wid & 3) * 1024), 16, 0, 0); \
        __builtin_amdgcn_global_load_lds((const unsigned*)(_tb + voff + 128), (LAS unsigned*)(lds + (bufo) + 16384 + ((wid >> 2) + 2) * 4096 + (wid & 3) * 1024), 16, 0, 0); } while (0)
    AT_DMA(0, 0);
    bf16x8 qr[4];
    { const bf16* qp = C.PROJ + (size_t)(row0 + sub * 32 + r32) * NPROJ + C_DQ + h * 128 + p * 64 + hi * 8;
#pragma unroll
      for (int d0 = 0; d0 < 4; ++d0) qr[d0] = *(const bf16x8*)(qp + d0 * 16); }
    f32x16 o[4];
#pragma unroll
    for (int d0 = 0; d0 < 4; ++d0)
#pragma unroll
        for (int i = 0; i < 16; ++i) o[d0][i] = 0.f;
    float mhat = 0.f, lsum = 0.f;
    const unsigned kofs = (unsigned)(p * 8192 + hi * 1024 + r32 * 16);
    const unsigned vofs = (unsigned)(16384 + ((lane >> 4) & 1) * 32 + (lane & 3) * 8 + (4 * hi + ((lane & 15) >> 2)) * 64);
    asm volatile("s_waitcnt vmcnt(0)" ::: "memory"); __syncthreads();
#pragma unroll 1
    for (int t = 0; t < NT; ++t) {
        const unsigned bufo = (unsigned)(t & 1) * AT_BUF;
        if (t + 1 < NT) AT_DMA(t + 1, ((t + 1) & 1) * AT_BUF);
        if (t < my_nt) {
            const LAS unsigned char* kp = lds + bufo + kofs;
            const LAS unsigned char* vp = lds + bufo + vofs;
            f32x16 s0, s1;
#pragma unroll
            for (int i = 0; i < 16; ++i) { s0[i] = 0.f; s1[i] = 0.f; }
#pragma unroll
            for (int d0 = 0; d0 < 4; ++d0) {
                const bf16x8 k0 = *(const LAS bf16x8*)(kp + d0 * 2048), k1 = *(const LAS bf16x8*)(kp + d0 * 2048 + 512);
                s0 = MFMA32(k0, qr[d0], s0); s1 = MFMA32(k1, qr[d0], s1);
            }
            if (t == qch) {
#pragma unroll
                for (int i = 0; i < 16; ++i) { const int k0p = 64 * t + crow(i, hi), k1p = k0p + 32;
                    s0[i] += sl2 * (float)min(k0p, 2 * qpos - k0p); s1[i] += sl2 * (float)min(k1p, 2 * qpos - k1p); }
            } else {
                const float bs = sl2 * (float)(64 * t + 4 * hi);
#pragma unroll
                for (int i = 0; i < 16; ++i) { const float ci = (float)((i & 3) + 8 * (i >> 2)); s0[i] += fmaf(sl2, ci, bs); s1[i] += fmaf(sl2, ci + 32.f, bs); }
            }
            float rm = fmaxf(s0[0], s1[0]);
#pragma unroll
            for (int i = 1; i < 16; ++i) rm = fmaxf(rm, fmaxf(s0[i], s1[i]));
            rm = fmaxf(rm, __shfl_xor(rm, 32));
            if (t == 0) { mhat = rm; }
            else {
                const float gr = rm - mhat;
                if (__any(gr > AT_THR)) {
                    const float dl = fmaxf(gr, 0.f); mhat += dl; const float f = __builtin_amdgcn_exp2f(-dl); lsum *= f;
                    if (hi == 0) wsf[r32] = f;
                    LDS_WAIT();
#pragma unroll
                    for (int i = 0; i < 16; ++i) { const float fi = wsf[crow(i, hi)];
#pragma unroll
                        for (int d0 = 0; d0 < 4; ++d0) o[d0][i] *= fi; }
                }
            }
            float ps = 0.f;
#pragma unroll
            for (int i = 0; i < 16; ++i) { s0[i] = __builtin_amdgcn_exp2f(s0[i] - mhat); s1[i] = __builtin_amdgcn_exp2f(s1[i] - mhat); ps += s0[i] + s1[i]; }
            lsum += ps;
            u32x4 pw[4];
            pw[0] = (u32x4){pk2(s0[0], s0[1]), pk2(s0[2], s0[3]), pk2(s0[4], s0[5]), pk2(s0[6], s0[7])};
            pw[1] = (u32x4){pk2(s0[8], s0[9]), pk2(s0[10], s0[11]), pk2(s0[12], s0[13]), pk2(s0[14], s0[15])};
            pw[2] = (u32x4){pk2(s1[0], s1[1]), pk2(s1[2], s1[3]), pk2(s1[4], s1[5]), pk2(s1[6], s1[7])};
            pw[3] = (u32x4){pk2(s1[8], s1[9]), pk2(s1[10], s1[11]), pk2(s1[12], s1[13]), pk2(s1[14], s1[15])};
#pragma unroll
            for (int k = 0; k < 4; ++k) {
                const bf16x8 pa = __builtin_bit_cast(bf16x8, pw[k]);
#pragma unroll
                for (int d0 = 0; d0 < 4; ++d0) {
                    const s16x4 lo = vtr(vp + d0 * 4096 + k * 1024), hi4 = vtr(vp + d0 * 4096 + k * 1024 + 512);
                    const bf16x8 vf = (bf16x8){lo[0], lo[1], lo[2], lo[3], hi4[0], hi4[1], hi4[2], hi4[3]};
                    o[d0] = MFMA32(pa, vf, o[d0]);
                }
                __builtin_amdgcn_sched_barrier(0);
            }
        }
        asm volatile("s_waitcnt vmcnt(0) lgkmcnt(0)" ::: "memory"); __syncthreads();
    }
#undef AT_DMA
    lsum += __shfl_xor(lsum, 32);
    if (hi == 0) wsf[32 + r32] = lsum;
    LDS_WAIT();
    LAS float* X = (LAS float*)lds;
    if (p == 1) {
#pragma unroll
        for (int i = 0; i < 16; ++i) { const float sc = lam / wsf[32 + crow(i, hi)];
#pragma unroll
            for (int d0 = 0; d0 < 4; ++d0) X[(sub * 32 + crow(i, hi)) * 128 + d0 * 32 + r32] = o[d0][i] * sc; }
    }
    __syncthreads();
    if (p == 0) {
#pragma unroll
        for (int i = 0; i < 16; ++i) { const float sc = 1.f / wsf[32 + crow(i, hi)];
#pragma unroll
            for (int d0 = 0; d0 < 4; ++d0) { LAS float* xp = X + (sub * 32 + crow(i, hi)) * 128 + d0 * 32 + r32; *xp = o[d0][i] * sc - *xp; } }
    }
    __syncthreads();
    { const float g0 = C.diff_g[2 * lane], g1 = C.diff_g[2 * lane + 1];
#pragma unroll 4
      for (int qq = 0; qq < 16; ++qq) { const int q = wid * 16 + qq; const float y0 = X[q * 128 + 2 * lane], y1 = X[q * 128 + 2 * lane + 1];
          const float rstd = rsqrtf(wave_sum(y0 * y0 + y1 * y1) * (1.f / 128.f) + EPS) * 0.8f;
          *(unsigned*)(C.OA + (size_t)(row0 + q) * 512 + h * 128 + 2 * lane) = pk2(y0 * rstd * g0, y1 * rstd * g1); } }
    __syncthreads();
}

__device__ __forceinline__ void attn_phase(const Ctx& C) {
    LAS float* lamp = (LAS float*)(C.lds + AT_Q) + 4;
    LAS int* qw = (LAS int*)(C.lds + AT_Q);
    if (C.tid < 64) {
        const float a = wave_sum(C.lq1[C.lane] * C.lk1[C.lane]), b2 = wave_sum(C.lq2[C.lane] * C.lk2[C.lane]);
        if (C.tid == 0) lamp[0] = __expf(a) - __expf(b2) + 0.2f;
    }
    __syncthreads();
    const float lam = lamp[0];
    for (;;) {
        if (C.tid == 0) qw[0] = (int)__hip_atomic_fetch_add(C.ctl + CW_QUEUE, 1u, RLX_AGENT);
        __syncthreads();
        const int item = qw[0];
        __syncthreads();
        if (item >= 512) break;
        const int bh = item >> 3, pr = item & 7;
#pragma unroll 1
        for (int k = 0; k < 2; ++k) attn_unit(C, bh >> 2, bh & 3, k ? pr : 15 - pr, lam);
    }
}

__device__ __forceinline__ void phase_router(const Ctx& C) {
    constexpr int WP = 1028;
    LAS float* WrT = (LAS float*)C.lds;
    LAS int* lcnt = (LAS int*)(WrT + 32 * WP);
    LAS int* lbase = lcnt + 32;
    LAS int* pend = lbase + 32;
    for (int i = C.tid; i < DM * NE; i += NTHREADS) { const int k = i >> 5, e = i & 31; WrT[e * WP + k] = C.w_router[i]; }
    if (C.tid < 32) lcnt[C.tid] = 0;
    for (int i = C.tid; i < 512; i += NTHREADS) pend[i] = -1;
    __syncthreads();
    const int gw = C.bid * NWAVES + C.wid, NGW = C.G * NWAVES;
    const float myb = C.b_router[C.lane >> 1];
    int it = 0;
    for (int row = gw; row < NTOK; row += NGW, ++it) {
        const int b = row >> 11; const float* md = C.mod + b * 6144;
        f32x4 v[4]; float ss = 0.f;
#pragma unroll
        for (int j = 0; j < 4; ++j) { v[j] = *(const f32x4*)(C.out + (size_t)row * DM + 4 * C.lane + 256 * j); ss += (v[j][0] * v[j][0] + v[j][1] * v[j][1]) + (v[j][2] * v[j][2] + v[j][3] * v[j][3]); }
        const float rstd = rsqrtf(wave_sum(ss) * (1.f / DM) + EPS);
#pragma unroll
        for (int j = 0; j < 4; ++j) { const int c0 = 4 * C.lane + 256 * j;
            const f32x4 g = *(const f32x4*)(C.norm2_g + c0), sc = *(const f32x4*)(md + 4096 + c0), sh = *(const f32x4*)(md + 3072 + c0);
            v[j] = v[j] * rstd * g * (sc + 1.f) + sh;
            u32x2 o; o.x = pk2(v[j][0], v[j][1]); o.y = pk2(v[j][2], v[j][3]);
            *(u32x2*)(C.H2 + (size_t)row * DM + c0) = o; }
        float a[32];
#pragma unroll
        for (int e = 0; e < 32; ++e) { float s = 0.f;
#pragma unroll
            for (int j = 0; j < 4; ++j) { const f32x4 w = *(const LAS f32x4*)(WrT + e * WP + 4 * C.lane + 256 * j); s += (v[j][0] * w[0] + v[j][1] * w[1]) + (v[j][2] * w[2] + v[j][3] * w[3]); }
            a[e] = s; }
#pragma unroll
        for (int i = 0; i < 16; ++i) { const bool hi = (C.lane & 32) != 0; const float send = hi ? a[i] : a[i + 16], keep = hi ? a[i + 16] : a[i]; a[i] = keep + __shfl_xor(send, 32); }
#pragma unroll
        for (int i = 0; i < 8; ++i) { const bool hi = (C.lane & 16) != 0; const float send = hi ? a[i] : a[i + 8], keep = hi ? a[i + 8] : a[i]; a[i] = keep + __shfl_xor(send, 16); }
#pragma unroll
        for (int i = 0; i < 4; ++i) { const bool hi = (C.lane & 8) != 0; const float send = hi ? a[i] : a[i + 4], keep = hi ? a[i + 4] : a[i]; a[i] = keep + __shfl_xor(send, 8); }
#pragma unroll
        for (int i = 0; i < 2; ++i) { const bool hi = (C.lane & 4) != 0; const float send = hi ? a[i] : a[i + 2], keep = hi ? a[i + 2] : a[i]; a[i] = keep + __shfl_xor(send, 4); }
        { const bool hi = (C.lane & 2) != 0; const float send = hi ? a[0] : a[1], keep = hi ? a[1] : a[0]; a[0] = keep + __shfl_xor(send, 2); }
        float val = a[0] + __shfl_xor(a[0], 1) + myb; const int idx = C.lane >> 1;
        float tv[4]; int ti[4];
#pragma unroll
        for (int r = 0; r < 4; ++r) {
            float bv = val; int bi = idx;
#pragma unroll
            for (int o = 32; o >= 1; o >>= 1) { const float ov = __shfl_xor(bv, o); const int oi = __shfl_xor(bi, o); if (ov > bv || (ov == bv && oi < bi)) { bv = ov; bi = oi; } }
            tv[r] = bv; ti[r] = bi; if (idx == bi) val = -3.0e38f;
        }
        const float e1 = __expf(tv[1] - tv[0]), e2 = __expf(tv[2] - tv[0]), e3 = __expf(tv[3] - tv[0]); const float inv = 1.f / (1.f + e1 + e2 + e3);
        if (C.lane == 0) { *(f32x4*)(C.topw + (size_t)row * 4) = (f32x4){inv, e1 * inv, e2 * inv, e3 * inv}; *(i32x4*)(C.tope + (size_t)row * 4) = (i32x4){ti[0], ti[1], ti[2], ti[3]}; }
        if (C.lane < 4) { const int e = C.lane == 0 ? ti[0] : (C.lane == 1 ? ti[1] : (C.lane == 2 ? ti[2] : ti[3]));
            const int slot = atomicAdd((int*)(lcnt + e), 1); pend[(it * 8 + C.wid) * 4 + C.lane] = (e << 16) | slot; }
    }
    __syncthreads();
    if (C.tid < 32) lbase[C.tid] = (int)__hip_atomic_fetch_add(C.ctl + CW_CNT + 64 * C.tid, (unsigned)lcnt[C.tid], RLX_AGENT);
    __syncthreads();
    for (int i = C.tid; i < 512; i += NTHREADS) { const int pv = pend[i]; if (pv >= 0) { const int e = pv >> 16, slot = pv & 0xffff; const int it2 = i >> 5, w = (i >> 2) & 7, r = i & 3;
        const int row = C.bid * NWAVES + w + it2 * NGW; C.list[e * NTOK + lbase[e] + slot] = row * 4 + r; } }
}

__device__ __forceinline__ void phase_final(const Ctx& C) {
    const int gw = C.bid * NWAVES + C.wid, NGW = C.G * NWAVES;
    for (int row = gw; row < NTOK; row += NGW) {
        const int b = row >> 11; const float* gt2 = C.mod + b * 6144 + 5120;
        const f32x4 w = *(const f32x4*)(C.topw + (size_t)row * 4);
        f32x4 v[4]; float ss = 0.f;
#pragma unroll
        for (int j = 0; j < 4; ++j) { const int c0 = 4 * C.lane + 256 * j;
            f32x4 y = (f32x4){0.f, 0.f, 0.f, 0.f};
#pragma unroll
            for (int k = 0; k < 4; ++k) { const u32x2 yw = *(const u32x2*)(C.YB + (size_t)(row * 4 + k) * DM + c0); y = y + (f32x4){bflo(yw.x), bfhi(yw.x), bflo(yw.y), bfhi(yw.y)} * w[k]; }
            v[j] = *(const f32x4*)(C.out + (size_t)row * DM + c0) + *(const f32x4*)(gt2 + c0) * y;
            ss += (v[j][0] * v[j][0] + v[j][1] * v[j][1]) + (v[j][2] * v[j][2] + v[j][3] * v[j][3]); }
        const float rstd = rsqrtf(wave_sum(ss) * (1.f / DM) + EPS);
#pragma unroll
        for (int j = 0; j < 4; ++j) { const int c0 = 4 * C.lane + 256 * j; *(f32x4*)(C.out + (size_t)row * DM + c0) = v[j] * rstd * *(const f32x4*)(C.final_g + c0); }
    }
}

struct Args { const float* in[25]; float* out; unsigned char* ws; };
typedef const Args __attribute__((address_space(4)))* KArgs;
__device__ __forceinline__ Ctx make_ctx(LAS unsigned char* lds) {
    KArgs a = (KArgs)__builtin_amdgcn_kernarg_segment_ptr();
    asm volatile("" : "+s"(a));
    Ctx C;
    C.lds = lds;
    C.tid = tid_fresh(); C.lane = C.tid & 63; C.wid = __builtin_amdgcn_readfirstlane(C.tid >> 6); C.G = gridDim.x; C.bid = blockIdx.x;
    C.x = a->in[0]; C.c = a->in[1]; C.w_ada = a->in[2]; C.b_ada = a->in[3]; C.norm1_g = a->in[4]; C.w_in = a->in[5];
    C.lq1 = a->in[6]; C.lk1 = a->in[7]; C.lq2 = a->in[8]; C.lk2 = a->in[9]; C.diff_g = a->in[10]; C.w_alpha_up = a->in[11]; C.b_alpha = a->in[12];
    C.gla_g = a->in[13]; C.w_bd = a->in[14]; C.w_bg = a->in[15]; C.w_out = a->in[16]; C.norm2_g = a->in[17]; C.w_router = a->in[18]; C.b_router = a->in[19];
    C.w_gu = a->in[20]; C.b_gu = a->in[21]; C.w_dn = a->in[22]; C.b_dn = a->in[23]; C.final_g = a->in[24];
    C.out = a->out;
    unsigned char* ws = a->ws;
    C.ctl = (unsigned*)(ws + WS_CTL); C.mod = (float*)(ws + WS_MOD); C.tope = (int*)(ws + WS_TOPE); C.topw = (float*)(ws + WS_TOPW); C.list = (int*)(ws + WS_LIST);
    C.WinT = (bf16*)(ws + WS_WIN); C.WbdT = (bf16*)(ws + WS_WBD); C.WbgT = (bf16*)(ws + WS_WBG); C.WoutT = (bf16*)(ws + WS_WOUT); C.WguT = (bf16*)(ws + WS_WGU); C.WdT = (bf16*)(ws + WS_WD);
    C.H = (bf16*)(ws + WS_H); C.H2 = (bf16*)(ws + WS_H2); C.OA = (bf16*)(ws + WS_OA); C.OB = (bf16*)(ws + WS_OB); C.MG = (bf16*)(ws + WS_MG); C.YB = (bf16*)(ws + WS_YB);
    C.PROJ = (bf16*)(ws + WS_PROJ); C.ACT = (bf16*)(ws + WS_ACT);
    return C;
}
__global__ void __launch_bounds__(NTHREADS, 2) fwd_kernel(Args args) {
    extern __shared__ __attribute__((aligned(16))) unsigned char lds_raw[];
    LAS unsigned char* lds = (LAS unsigned char*)lds_raw;
    for (int u = threadIdx.x; u < (LDS_BYTES - LDSCTL_OFF) / 4; u += NTHREADS) ((LAS unsigned*)(lds + LDSCTL_OFF))[u] = 0u;
    __syncthreads();
    volatile LAS unsigned* MISC = (volatile LAS unsigned*)(lds + MISC_OFF);
    XcdBarrier bar;
    { const Ctx C = make_ctx(lds); bar = xcd_barrier_post(C.ctl + CW_BAR, MISC + 8); }
#define GRID_BAR() xcd_barrier(bar)

    { const Ctx C = make_ctx(lds); phase_mod(C); }
    GRID_BAR();
    { const Ctx C = make_ctx(lds); phase_prep(C); }
    GRID_BAR();
    { const Ctx C = make_ctx(lds); DenseDesc g{C.H, DM, C.WinT, DM}; TileOrder S; S.init(NTOK / 256, NPROJ / 256, C.G, C.bid); EpiProj E{C.PROJ, C.b_alpha}; gemm_phase<DenseDesc, TileOrder, EpiProj, true>(C.lds, g, S, E); }
    GRID_BAR();
    { const Ctx C = make_ctx(lds); for (int s = C.bid; s < 64; s += C.G) gla_scan(C, s >> 2, s & 3); }
    __syncthreads();
    { const Ctx C = make_ctx(lds); attn_phase(C); }
    GRID_BAR();
    { const Ctx C = make_ctx(lds); DenseDesc g{C.OA, 512, C.WbdT, 512}; TileOrder S; S.init(NTOK / 256, DM / 256, C.G, C.bid); EpiBranch E{C.MG, C.PROJ, C_GA, 0}; gemm_phase<DenseDesc, TileOrder, EpiBranch, true>(C.lds, g, S, E); }
    GRID_BAR();
    { const Ctx C = make_ctx(lds); DenseDesc g{C.OB, 512, C.WbgT, 512}; TileOrder S; S.init(NTOK / 256, DM / 256, C.G, C.bid); EpiBranch E{C.MG, C.PROJ, C_GB, 1}; gemm_phase<DenseDesc, TileOrder, EpiBranch, true>(C.lds, g, S, E); }
    GRID_BAR();
    { const Ctx C = make_ctx(lds); DenseDesc g{C.MG, DM, C.WoutT, DM}; TileOrder S; S.init(NTOK / 256, DM / 256, C.G, C.bid); EpiOut E{C.x, C.out, C.mod}; gemm_phase<DenseDesc, TileOrder, EpiOut, true>(C.lds, g, S, E); }
    GRID_BAR();
    { const Ctx C = make_ctx(lds); phase_router(C); }
    GRID_BAR();
    LAS int* tab = (LAS int*)(lds + STAGE_BYTES);
    __syncthreads();
    if (threadIdx.x == 0) { const Ctx C = make_ctx(lds); int ts = 0; for (int e = 0; e < NE; ++e) { const int cnt = (int)__hip_atomic_load(C.ctl + CW_CNT + 64 * e, RLX_AGENT); tab[e] = cnt; tab[32 + e] = ts; ts += (cnt + 255) >> 8; } tab[64] = ts; }
    __syncthreads();
    { const Ctx C = make_ctx(lds); const int T = tab[64]; MoeUpDesc g{C.H2, C.list, C.WguT, DM}; MoeOrder S; S.t.init(T, 8, C.G, C.bid); S.tab = tab; EpiUp E{C.ACT, C.b_gu}; gemm_phase<MoeUpDesc, MoeOrder, EpiUp, true>(C.lds, g, S, E); }
    GRID_BAR();
    { const Ctx C = make_ctx(lds); const int T = tab[64]; MoeDownDesc g{C.ACT, C.WdT, FF}; MoeOrder S; S.t.init(T, 4, C.G, C.bid); S.tab = tab; EpiDown E{C.YB, C.b_dn, C.list}; gemm_phase<MoeDownDesc, MoeOrder, EpiDown, true>(C.lds, g, S, E); }
    GRID_BAR();
    { const Ctx C = make_ctx(lds); phase_final(C); }
}

extern "C" void kernel_launch(void* const* d_in, const int* in_sizes, int n_in, void* d_out, int out_size, void* d_ws, size_t ws_size, hipStream_t stream) {
    static int grid = 0;
    if (grid == 0) {
        if (n_in != 25 || in_sizes[0] != NTOK * DM || out_size != NTOK * DM || ws_size < WS_END) {
            fprintf(stderr, "kernel_launch: unexpected shapes (n_in %d, in0 %d, out %d, ws %zu < %zu)\n", n_in, n_in > 0 ? in_sizes[0] : -1, out_size, ws_size, (size_t)WS_END); grid = -1; return; }
        int dev = 0, cus = 0;
        if (hipGetDevice(&dev) != hipSuccess || hipDeviceGetAttribute(&cus, hipDeviceAttributeMultiprocessorCount, dev) != hipSuccess) { grid = -1; return; }
        if (hipFuncSetAttribute((const void*)fwd_kernel, hipFuncAttributeMaxDynamicSharedMemorySize, LDS_BYTES) != hipSuccess) { fprintf(stderr, "kernel_launch: hipFuncSetAttribute failed\n"); grid = -1; return; }
        (void)hipGetLastError();
        grid = cus;
    }
    if (grid < 0) return;
    if (hipMemsetAsync((char*)d_ws + WS_CTL, 0, CTL_ZERO_BYTES, stream) != hipSuccess) { fprintf(stderr, "kernel_launch: memset failed\n"); return; }
    Args a{};
    for (int i = 0; i < 25; ++i) a.in[i] = (const float*)d_in[i];
    a.out = (float*)d_out; a.ws = (unsigned char*)d_ws;
    hipLaunchKernelGGL(fwd_kernel, dim3(grid), dim3(NTHREADS), LDS_BYTES, stream, a);
}
```

```cpp
#include <hip/hip_runtime.h>
#include <cstdio>
#include <cstdint>

#define GAS __attribute__((address_space(1)))
#define LAS __attribute__((address_space(3)))
typedef unsigned short bf16;
typedef short bf16x8 __attribute__((ext_vector_type(8)));
typedef float f32x4 __attribute__((ext_vector_type(4)));
typedef unsigned u32x4 __attribute__((ext_vector_type(4)));
typedef unsigned u32x2 __attribute__((ext_vector_type(2)));
typedef int i32x4 __attribute__((ext_vector_type(4)));
typedef GAS unsigned gu32;

constexpr int NB = 16, SEQ = 2048, DM = 1024, NTOK = NB * SEQ, NE = 32, FF = 1024;
constexpr int NPROJ = 5376;
constexpr int C_DQ = 0, C_DK = 512, C_DV = 1024, C_GQ = 1536, C_GK = 1792, C_GV = 2048, C_GR = 2560, C_GA = 3072, C_GB = 4096, C_AL = 5120;
constexpr int W_IN_N = 5136;
constexpr float LOG2E = 1.4426950408889634f;
constexpr float QSCALE = 0.125f * LOG2E;
constexpr float EPS = 1e-6f;
constexpr int NWAVES = 8, NTHREADS = 512;

constexpr size_t MiB = 1u << 20;
constexpr size_t WS_CTL = 0, CTL_ZERO_BYTES = 1 * MiB;
constexpr size_t WS_MOD = 1 * MiB;
constexpr size_t WS_TOPE = 2 * MiB;
constexpr size_t WS_TOPW = 3 * MiB;
constexpr size_t WS_LIST = 4 * MiB;
constexpr size_t WS_WIN = 8 * MiB;
constexpr size_t WS_WBD = 19 * MiB;
constexpr size_t WS_WBG = 20 * MiB;
constexpr size_t WS_WOUT = 21 * MiB;
constexpr size_t WS_WGU = 24 * MiB;
constexpr size_t WS_WD = 152 * MiB;
constexpr size_t WS_H2 = 216 * MiB;
constexpr size_t WS_RB = 280 * MiB;
constexpr size_t WS_H = WS_RB, WS_OA = WS_RB + 64 * MiB, WS_OB = WS_RB + 96 * MiB, WS_MG = WS_RB + 128 * MiB, WS_YB = WS_RB;
constexpr size_t WS_RA = 536 * MiB;
constexpr size_t WS_PROJ = WS_RA, WS_ACT = WS_RA;
constexpr size_t WS_END = 872 * MiB;
constexpr int MAX_TILES = 544;
static_assert((size_t)MAX_TILES * 256 * 1024 * 2 <= 336 * MiB, "act fits region A");
constexpr int CW_CNT = 64;
constexpr int CW_BAR = 4096;
constexpr int CW_QUEUE = 2304;

constexpr int SCR_BYTES = 147456;
constexpr int LDSCTL_OFF = SCR_BYTES, MISC_OFF = LDSCTL_OFF + 320;
constexpr int LDS_BYTES = SCR_BYTES + 1024;

#define RLX_AGENT __ATOMIC_RELAXED, __HIP_MEMORY_SCOPE_AGENT
#define LDS_WAIT() asm volatile("s_waitcnt lgkmcnt(0)" ::: "memory")

__device__ __forceinline__ unsigned f2bf(float f) { unsigned u = __builtin_bit_cast(unsigned, f); return (u + 0x7fffu + ((u >> 16) & 1u)) >> 16; }
__device__ __forceinline__ unsigned pk2(float lo, float hi) { return f2bf(lo) | (f2bf(hi) << 16); }
__device__ __forceinline__ float bf2f(unsigned b) { return __uint_as_float(b << 16); }
__device__ __forceinline__ float bflo(unsigned w) { return __uint_as_float(w << 16); }
__device__ __forceinline__ float bfhi(unsigned w) { return __uint_as_float(w & 0xffff0000u); }
__device__ __forceinline__ float wave_sum(float v) {
#pragma unroll
    for (int o = 1; o < 64; o <<= 1) v += __shfl_xor(v, o);
    return v;
}
__device__ __forceinline__ int tid_fresh() { int t = threadIdx.x; asm volatile("" : "+v"(t)); return t; }
__device__ __forceinline__ float sigmoidf_(float x) { return 1.f / (1.f + __expf(-x)); }

#define XB_TMO      128
#define XB_XCNT(j)  (256  + 64 * (j))
#define XB_XSUB(j)  (1280 + 64 * (j))
#define XB_XGEN(j)  (2304 + 64 * (j))
#define XB_TOP      3328
#define XB_TOPGEN   3392
#define XCD_BAR_WORDS 3456
#define XB_SPIN_CAP (1u << 22)
__device__ __forceinline__ unsigned xb_ld(unsigned* p)              { return __hip_atomic_load(p, __ATOMIC_RELAXED, __HIP_MEMORY_SCOPE_AGENT); }
__device__ __forceinline__ unsigned xb_add(unsigned* p, unsigned v) { return __hip_atomic_fetch_add(p, v, __ATOMIC_RELAXED, __HIP_MEMORY_SCOPE_AGENT); }
__device__ __forceinline__ unsigned xb_xcc_id() { return (unsigned)__builtin_amdgcn_s_getreg((3 << 11) | 20) & 0xFu; }
#define XB_SPIN(cond, bar) do { unsigned _sp = 0; while (cond) { __builtin_amdgcn_s_sleep(1); \
    if ((++_sp & 255u) == 0u) { if (xb_ld(&(bar)[XB_TMO])) break; if (_sp > XB_SPIN_CAP) { atomicAdd(&(bar)[XB_TMO], 1u); break; } } } } while (0)
struct XcdBarrier { unsigned* bar; unsigned x; volatile LAS unsigned* st; };
__device__ __forceinline__ XcdBarrier xcd_barrier_post(unsigned* bar, volatile LAS unsigned* st) {
    XcdBarrier b; b.bar = bar; b.x = xb_xcc_id(); b.st = st;
    if (threadIdx.x == 0) (void)xb_add(&bar[XB_XCNT(b.x)], 1u);
    return b;
}
__device__ __forceinline__ void xcd_barrier_complete(unsigned* bar, unsigned x, unsigned& nloc, unsigned& nx) {
    const unsigned G = gridDim.x * gridDim.y * gridDim.z;
    unsigned sum, cnt, mine, sp = 0u;
    for (;;) {
        sum = 0u; cnt = 0u; mine = 0u;
#pragma unroll
        for (unsigned j = 0; j < 16; ++j) { const unsigned c = xb_ld(&bar[XB_XCNT(j)]); sum += c; cnt += (c > 0u) ? 1u : 0u; mine = (j == x) ? c : mine; }
        if (sum == G) break;
        __builtin_amdgcn_s_sleep(1);
        if ((++sp & 255u) == 0u) { if (xb_ld(&bar[XB_TMO])) break; if (sp > XB_SPIN_CAP) { atomicAdd(&bar[XB_TMO], 1u); break; } }
    }
    nloc = mine > 0u ? mine : 1u; nx = cnt > 0u ? cnt : 1u;
}
__device__ __forceinline__ void xcd_barrier(const XcdBarrier& b) {
    asm volatile("s_waitcnt vmcnt(0)" ::: "memory");
    __syncthreads();
    if (threadIdx.x == 0) {
        unsigned* bar = b.bar;
        __builtin_amdgcn_s_waitcnt(0);
        unsigned nloc = b.st[0], nx = b.st[1];
        if (nloc == 0u) { xcd_barrier_complete(bar, b.x, nloc, nx); b.st[0] = nloc; b.st[1] = nx; }
        const unsigned old = xb_add(&bar[XB_XSUB(b.x)], 1u);
        const unsigned gen = old / nloc;
        if (old + 1u == (gen + 1u) * nloc) {
            __builtin_amdgcn_fence(__ATOMIC_RELEASE, "agent");
            asm volatile("s_waitcnt vmcnt(0)" ::: "memory");
            const unsigned og = xb_add(&bar[XB_TOP], 1u);
            const unsigned tg = og / nx;
            if (og + 1u == (tg + 1u) * nx) xb_add(&bar[XB_TOPGEN], 1u);
            else XB_SPIN(xb_ld(&bar[XB_TOPGEN]) == tg, bar);
            __builtin_amdgcn_fence(__ATOMIC_ACQUIRE, "agent");
            xb_add(&bar[XB_XGEN(b.x)], 1u);
            asm volatile("s_waitcnt vmcnt(0)" ::: "memory");
        } else {
            XB_SPIN(xb_ld(&bar[XB_XGEN(b.x)]) == gen, bar);
            __builtin_amdgcn_fence(__ATOMIC_ACQUIRE, "agent");
            asm volatile("s_waitcnt vmcnt(0)" ::: "memory");
        }
    }
    __syncthreads();
}

struct Ctx {
    LAS unsigned char* lds;
    int tid, lane, wid, G, bid;
    const float *x, *c, *w_ada, *b_ada, *norm1_g, *w_in, *lq1, *lk1, *lq2, *lk2, *diff_g, *w_alpha_up, *b_alpha, *gla_g,
                *w_bd, *w_bg, *w_out, *norm2_g, *w_router, *b_router, *w_gu, *b_gu, *w_dn, *b_dn, *final_g;
    float* out;
    unsigned* ctl; float* mod; int* tope; float* topw; int* list;
    bf16 *WinT, *WbdT, *WbgT, *WoutT, *WguT, *WdT, *H, *H2, *OA, *OB, *MG, *YB, *PROJ, *ACT;
};

constexpr int NXCD = 8, WGM = 8;
__host__ __device__ __forceinline__ int perm32(int rho) { const int n = rho >> 4, i = rho & 15; return 8 * (i >> 2) + 4 * n + (i & 3); }
struct Unit { int pm, pn, e, row0, cnt; };
struct TileOrder {
    int nM, nN, nwg, G, c;
    __device__ __forceinline__ void init(int nM_, int nN_, int G_, int c_) { nM = nM_; nN = nN_; nwg = nM * nN; G = G_; c = c_; }
    __device__ __forceinline__ bool next(int i, Unit& u) const {
        const long L = (long)i * G + c; if (L >= nwg) return false;
        int wgid = (int)L; { const int q = nwg / NXCD, r = nwg % NXCD, xcd = wgid % NXCD, off = wgid / NXCD; wgid = (xcd < r ? xcd * (q + 1) : r * (q + 1) + (xcd - r) * q) + off; }
        const int nig = WGM * nN, gid = wgid / nig, fm = gid * WGM, gsz = (nM - fm) < WGM ? (nM - fm) : WGM;
        u.pm = fm + ((wgid % nig) % gsz); u.pn = (wgid % nig) / gsz; u.e = 0; u.row0 = 0; u.cnt = 0; return true;
    }
};
struct MoeOrder {
    TileOrder t; LAS const int* tab;
    __device__ __forceinline__ bool next(int i, Unit& u) const {
        if (!t.next(i, u)) return false;
        int e = 0;
#pragma unroll 1
        for (int k = 1; k < NE; ++k) if (tab[32 + k] <= u.pm) e = k;
        u.e = e; u.row0 = (u.pm - tab[32 + e]) * 256; u.cnt = tab[e]; return true;
    }
};
struct DenseDesc {
    const bf16* A; int lda; const bf16* Bt; int K;
    __device__ __forceinline__ unsigned a_off(const Unit& u, int r) const { return (unsigned)((u.pm * 256 + r) * lda) * 2u; }
    __device__ __forceinline__ const char* a_base(const Unit&) const { return (const char*)A; }
    __device__ __forceinline__ const char* b_base(const Unit& u) const { return (const char*)Bt + (size_t)u.pn * 256 * K * 2; }
};
struct MoeUpDesc {
    const bf16* H2; const int* list; const bf16* WguT; int K;
    __device__ __forceinline__ unsigned a_off(const Unit& u, int r) const { const int slot = u.row0 + r; int tok = 0; if (slot < u.cnt) tok = list[u.e * NTOK + slot] >> 2; return (unsigned)tok * 2048u; }
    __device__ __forceinline__ const char* a_base(const Unit&) const { return (const char*)H2; }
    __device__ __forceinline__ const char* b_base(const Unit& u) const { return (const char*)WguT + ((size_t)u.e * 2048 + (size_t)u.pn * 256) * 1024 * 2; }
};
struct MoeDownDesc {
    const bf16* ACT; const bf16* WdT; int K;
    __device__ __forceinline__ unsigned a_off(const Unit& u, int r) const { return (unsigned)(u.pm * 256 + r) * 2048u; }
    __device__ __forceinline__ const char* a_base(const Unit&) const { return (const char*)ACT; }
    __device__ __forceinline__ const char* b_base(const Unit& u) const { return (const char*)WdT + ((size_t)u.e * 1024 + (size_t)u.pn * 256) * 1024 * 2; }
};

template <class Desc, class Order, class Epi>
__device__ __forceinline__ void gemm_simple(const Desc& g, const Order& S, const Epi& E) {
    const int tid = threadIdx.x, wid = __builtin_amdgcn_readfirstlane(tid >> 6), lane = tid & 63, wr = wid >> 2, wc = wid & 3, fr = lane & 15, fq = lane >> 4;
    const int K = g.K;
    Unit u;
    for (int i = 0; S.next(i, u); ++i) {
        f32x4 acc[2][2][4][2];
#pragma unroll
        for (int a = 0; a < 2; ++a)
#pragma unroll
            for (int b = 0; b < 2; ++b)
#pragma unroll
                for (int m = 0; m < 4; ++m)
#pragma unroll
                    for (int n = 0; n < 2; ++n) acc[a][b][m][n] = (f32x4){0.f, 0.f, 0.f, 0.f};
        unsigned aoff[2][4], boff[2][2];
#pragma unroll
        for (int a = 0; a < 2; ++a)
#pragma unroll
            for (int m = 0; m < 4; ++m) aoff[a][m] = g.a_off(u, a * 128 + wr * 64 + m * 16 + fr) + fq * 16;
#pragma unroll
        for (int b = 0; b < 2; ++b)
#pragma unroll
            for (int n = 0; n < 2; ++n) { const int nc = b * 128 + wc * 32 + (Epi::PERM ? perm32(n * 16 + fr) : (n * 16 + fr)); boff[b][n] = (unsigned)(nc * K) * 2u + fq * 16; }
        const char* ab = g.a_base(u); const char* bb = g.b_base(u);
#pragma unroll 1
        for (int ks = 0; ks < K / 32; ++ks) {
            bf16x8 af[2][4], bfr[2][2];
#pragma unroll
            for (int a = 0; a < 2; ++a)
#pragma unroll
                for (int m = 0; m < 4; ++m) af[a][m] = *(const bf16x8*)(ab + aoff[a][m] + ks * 64);
#pragma unroll
            for (int b = 0; b < 2; ++b)
#pragma unroll
                for (int n = 0; n < 2; ++n) bfr[b][n] = *(const bf16x8*)(bb + boff[b][n] + ks * 64);
#pragma unroll
            for (int a = 0; a < 2; ++a)
#pragma unroll
                for (int b = 0; b < 2; ++b)
#pragma unroll
                    for (int m = 0; m < 4; ++m)
#pragma unroll
                        for (int n = 0; n < 2; ++n) acc[a][b][m][n] = __builtin_amdgcn_mfma_f32_16x16x32_bf16(bfr[b][n], af[a][m], acc[a][b][m][n], 0, 0, 0);
        }
        E(acc, u, wr, wc, fr, fq);
    }
}


constexpr int BK = 64, HALF = 128, HTB = HALF * BK * 2, STAGE_BYTES = 8 * HTB;
__host__ __device__ __forceinline__ int lds_byte(int r, int c) { const int st = (r >> 4) * 2 + (c >> 5), rr = r & 15, cc = c & 31, ob = rr * 64 + cc * 2; return st * 1024 + (ob ^ (((ob >> 9) & 1) << 5)); }
__host__ __device__ __forceinline__ void stage_rc(int b, int& R, int& C) { const int st = b / 1024, sb = b % 1024, swz = sb ^ (((sb >> 9) & 1) << 5); R = (st >> 1) * 16 + swz / 64; C = (st & 1) * 32 + (swz % 64) / 2; }

template <class Desc, class Order, class Epi, bool ALIGN_EPI>
__device__ __forceinline__ void gemm_phase(LAS unsigned char* lds, const Desc& g, const Order& S, const Epi& E) {
    const int tid = tid_fresh(), wid = __builtin_amdgcn_readfirstlane(tid >> 6), lane = tid & 63, wr = wid >> 2, wc = wid & 3, fr = lane & 15, fq = lane >> 4;
    const int K = g.K, nt = K / BK;
    int Rs[2], Cs[2]; unsigned voffB[2];
#pragma unroll
    for (int i = 0; i < 2; ++i) { stage_rc(tid * 16 + i * 8192, Rs[i], Cs[i]); const int Rb = Epi::PERM ? ((Rs[i] & ~31) + perm32(Rs[i] & 31)) : Rs[i]; voffB[i] = (unsigned)(Rb * K + Cs[i]) * 2u; }
    unsigned vA[2][2];
    LAS u32x4* const vslot = (LAS u32x4*)(lds + STAGE_BYTES + 1024) + tid;
    const size_t kstep = (size_t)(BK * 2);
    const size_t hstepB = (size_t)HALF * K * 2;
    const unsigned ldsw = (unsigned)wid * 1024u;
    const int aoff = lds_byte(wr * 64 + fr, fq * 8), boff = lds_byte(wc * 32 + fr, fq * 8);
#define PG8_SA(b, h) (((b) * 2 + (h)) * HTB)
#define PG8_SB(b, h) ((4 + (b) * 2 + (h)) * HTB)
#define PG8_STAGE(bufoff, gbase, voff) do { _Pragma("unroll") for (int _i = 0; _i < 2; ++_i) \
        __builtin_amdgcn_global_load_lds((const unsigned*)((const char*)(gbase) + (voff)[_i]), (LAS unsigned*)(lds + (bufoff) + ldsw + _i * 8192), 16, 0, 0); } while (0)
#define PG8_STAGE_A(bufoff, gbase, h) do { _Pragma("unroll") for (int _i = 0; _i < 2; ++_i) \
        __builtin_amdgcn_global_load_lds((const unsigned*)((const char*)(gbase) + vA[h][_i]), (LAS unsigned*)(lds + (bufoff) + ldsw + _i * 8192), 16, 0, 0); } while (0)
#define PG8_LDA(dst, b, h) do { _Pragma("unroll") for (int m = 0; m < 4; ++m) _Pragma("unroll") for (int k = 0; k < 2; ++k) dst[m][k] = *(const LAS bf16x8*)(lds + PG8_SA(b, h) + aoff + m * 2048 + k * 1024); } while (0)
#define PG8_LDB(dst, b, h) do { _Pragma("unroll") for (int n = 0; n < 2; ++n) _Pragma("unroll") for (int k = 0; k < 2; ++k) dst[n][k] = *(const LAS bf16x8*)(lds + PG8_SB(b, h) + boff + n * 2048 + k * 1024); } while (0)
#define PG8_MMA(ai, bj, At, Bt) do { __builtin_amdgcn_s_setprio(1); _Pragma("unroll") for (int m = 0; m < 4; ++m) _Pragma("unroll") for (int n = 0; n < 2; ++n) _Pragma("unroll") for (int k = 0; k < 2; ++k) \
        acc[ai][bj][m][n] = __builtin_amdgcn_mfma_f32_16x16x32_bf16(Bt[n][k], At[m][k], acc[ai][bj][m][n], 0, 0, 0); __builtin_amdgcn_s_setprio(0); } while (0)
#define PG8_WAIT_V(n) asm volatile("s_waitcnt vmcnt(" #n ")" ::: "memory")
#define PG8_WAIT_L(n) asm volatile("s_waitcnt lgkmcnt(" #n ")" ::: "memory")
#define PG8_BAR __builtin_amdgcn_s_barrier()
#define PG8_SCHED __builtin_amdgcn_sched_barrier(0)
#define PG8_AOFFS(dst, un) do { _Pragma("unroll") for (int _h = 0; _h < 2; ++_h) _Pragma("unroll") for (int _i = 0; _i < 2; ++_i) dst[_h][_i] = g.a_off(un, _h * HALF + Rs[_i]) + (unsigned)Cs[_i] * 2u; } while (0)
    Unit cur, nxt; int ui = 0;
    if (!S.next(0, cur)) return;
    f32x4 acc[2][2][4][2];
#pragma unroll
    for (int a = 0; a < 2; ++a)
#pragma unroll
        for (int b = 0; b < 2; ++b)
#pragma unroll
            for (int m = 0; m < 4; ++m)
#pragma unroll
                for (int n = 0; n < 2; ++n) acc[a][b][m][n] = (f32x4){0.f, 0.f, 0.f, 0.f};
    bf16x8 At[4][2], B0[2][2], B1[2][2];
    const char* const Ab = g.a_base(cur);
    const char* cB = g.b_base(cur);
    PG8_AOFFS(vA, cur);
    PG8_STAGE(PG8_SB(0, 0), cB, voffB); PG8_STAGE(PG8_SB(0, 1), cB + hstepB, voffB); PG8_STAGE_A(PG8_SA(0, 0), Ab, 0); PG8_STAGE_A(PG8_SA(0, 1), Ab, 1);
    if (wr == 1) PG8_BAR;
    PG8_WAIT_V(2); PG8_BAR;
    PG8_STAGE(PG8_SB(1, 0), cB + kstep, voffB); PG8_STAGE_A(PG8_SA(1, 0), Ab + kstep, 0); PG8_STAGE(PG8_SB(1, 1), cB + hstepB + kstep, voffB);
    PG8_WAIT_V(6); PG8_BAR;
    for (;;) {
        const bool has_next = S.next(ui + 1, nxt);
        const char* nB = has_next ? g.b_base(nxt) : cB;
        if (has_next) { unsigned vn[2][2]; PG8_AOFFS(vn, nxt); *vslot = (u32x4){vn[0][0], vn[0][1], vn[1][0], vn[1][1]}; }
        for (int t = 0; t < nt; t += 2) {
            const bool last = (t == nt - 2);
            const char* a1 = Ab + (size_t)(t + 1) * kstep;
            const char* a2 = last ? Ab : Ab + (size_t)(t + 2) * kstep; const char* b2 = last ? nB : cB + (size_t)(t + 2) * kstep;
            const char* a3 = a2 + kstep; const char* b3 = b2 + kstep;
            PG8_LDB(B0, 0, 0); PG8_LDB(B1, 0, 1); PG8_SCHED; PG8_LDA(At, 0, 0); PG8_STAGE_A(PG8_SA(1, 1), a1, 1);
            if (last && has_next) { const u32x4 vn = *vslot; vA[0][0] = vn.x; vA[0][1] = vn.y; vA[1][0] = vn.z; vA[1][1] = vn.w; }
            PG8_WAIT_V(8); PG8_WAIT_L(0); PG8_BAR; PG8_MMA(0, 0, At, B0); PG8_MMA(0, 1, At, B1); PG8_BAR; PG8_SCHED;
            PG8_LDA(At, 0, 1); PG8_STAGE(PG8_SB(0, 0), b2, voffB); PG8_STAGE(PG8_SB(0, 1), b2 + hstepB, voffB); PG8_STAGE_A(PG8_SA(0, 0), a2, 0);
            PG8_WAIT_V(8); PG8_WAIT_L(0); PG8_BAR; PG8_MMA(1, 0, At, B0); PG8_MMA(1, 1, At, B1); PG8_BAR; PG8_SCHED;
            PG8_LDB(B0, 1, 0); PG8_LDB(B1, 1, 1); PG8_SCHED; PG8_LDA(At, 1, 0); PG8_STAGE_A(PG8_SA(0, 1), a2, 1);
            PG8_WAIT_V(8); PG8_WAIT_L(0); PG8_BAR; PG8_MMA(0, 0, At, B0); PG8_MMA(0, 1, At, B1); PG8_BAR; PG8_SCHED;
            PG8_LDA(At, 1, 1); PG8_STAGE(PG8_SB(1, 0), b3, voffB); PG8_STAGE(PG8_SB(1, 1), b3 + hstepB, voffB); PG8_STAGE_A(PG8_SA(1, 0), a3, 0);
            PG8_WAIT_V(8); PG8_WAIT_L(0); PG8_BAR; PG8_MMA(1, 0, At, B0); PG8_MMA(1, 1, At, B1); PG8_BAR; PG8_SCHED;
        }
        if constexpr (ALIGN_EPI) { if (wr == 0) PG8_BAR; }
        E(acc, cur, wr, wc, fr, fq);
        if (!has_next) break;
#pragma unroll
        for (int a = 0; a < 2; ++a)
#pragma unroll
            for (int b = 0; b < 2; ++b)
#pragma unroll
                for (int m = 0; m < 4; ++m)
#pragma unroll
                    for (int n = 0; n < 2; ++n) acc[a][b][m][n] = (f32x4){0.f, 0.f, 0.f, 0.f};
        cur = nxt; cB = nB; ++ui;
        if constexpr (ALIGN_EPI) { if (wr == 1) PG8_BAR; }
    }
    PG8_WAIT_V(0);
    if constexpr (!ALIGN_EPI) { if (wr == 0) PG8_BAR; }
    PG8_BAR;
#undef PG8_SA
#undef PG8_SB
#undef PG8_STAGE
#undef PG8_STAGE_A
#undef PG8_LDA
#undef PG8_LDB
#undef PG8_MMA
#undef PG8_WAIT_V
#undef PG8_WAIT_L
#undef PG8_BAR
#undef PG8_SCHED
#undef PG8_AOFFS
}

__device__ __forceinline__ u32x4 pack8(const f32x4& v0, const f32x4& v1) { u32x4 w; w.x = pk2(v0[0], v0[1]); w.y = pk2(v0[2], v0[3]); w.z = pk2(v1[0], v1[1]); w.w = pk2(v1[2], v1[3]); return w; }
__device__ __forceinline__ void unpack8(const u32x4& w, f32x4& v0, f32x4& v1) { v0 = (f32x4){bflo(w.x), bfhi(w.x), bflo(w.y), bfhi(w.y)}; v1 = (f32x4){bflo(w.z), bfhi(w.z), bflo(w.w), bfhi(w.w)}; }
__device__ __forceinline__ float logsig16(float x) { return (fminf(x, 0.f) - log1pf(__expf(-fabsf(x)))) * (1.f / 16.f); }

struct EpiProj {
    static constexpr bool PERM = true;
    bf16* P; const float* b_alpha;
    __device__ __forceinline__ void operator()(const f32x4 (&acc)[2][2][4][2], const Unit& u, int wr, int wc, int fr, int fq) const {
        const int pn = u.pn; const int mode = (pn < 2) ? 1 : (pn == 6 ? 2 : (pn == 20 ? 3 : 0));
#pragma unroll
        for (int bj = 0; bj < 2; ++bj) {
            const int c0 = pn * 256 + bj * 128 + wc * 32 + 8 * fq;
            f32x4 b0 = (f32x4){0.f, 0.f, 0.f, 0.f}, b1 = b0;
            if (mode == 3) { b0 = *(const f32x4*)(b_alpha + (c0 - C_AL)); b1 = *(const f32x4*)(b_alpha + (c0 - C_AL) + 4); }
#pragma unroll
            for (int ai = 0; ai < 2; ++ai)
#pragma unroll
                for (int m = 0; m < 4; ++m) {
                    const int row = u.pm * 256 + ai * 128 + wr * 64 + m * 16 + fr;
                    f32x4 v0 = acc[ai][bj][m][0], v1 = acc[ai][bj][m][1];
                    if (mode == 1) { v0 = v0 * QSCALE; v1 = v1 * QSCALE; }
                    else if (mode == 2) { v0 = v0 * 0.125f; v1 = v1 * 0.125f; }
                    else if (mode == 3) {
#pragma unroll
                        for (int j = 0; j < 4; ++j) { v0[j] = logsig16(v0[j] + b0[j]); v1[j] = logsig16(v1[j] + b1[j]); } }
                    *(u32x4*)(P + (size_t)row * NPROJ + c0) = pack8(v0, v1);
                }
        }
    }
};
struct EpiBranch {
    static constexpr bool PERM = true;
    bf16* MG; const bf16* P; int gcol; int add;
    __device__ __forceinline__ void operator()(const f32x4 (&acc)[2][2][4][2], const Unit& u, int wr, int wc, int fr, int fq) const {
#pragma unroll
        for (int ai = 0; ai < 2; ++ai)
#pragma unroll
            for (int m = 0; m < 4; ++m) {
                const int row = u.pm * 256 + ai * 128 + wr * 64 + m * 16 + fr;
#pragma unroll
                for (int bj = 0; bj < 2; ++bj) {
                    const int c0 = u.pn * 256 + bj * 128 + wc * 32 + 8 * fq;
                    const u32x4 gw = *(const u32x4*)(P + (size_t)row * NPROJ + gcol + c0);
                    f32x4 g0, g1; unpack8(gw, g0, g1);
                    f32x4 v0 = acc[ai][bj][m][0], v1 = acc[ai][bj][m][1];
#pragma unroll
                    for (int j = 0; j < 4; ++j) { v0[j] *= sigmoidf_(g0[j]); v1[j] *= sigmoidf_(g1[j]); }
                    bf16* dst = MG + (size_t)row * DM + c0;
                    if (add) { const u32x4 ow = *(const u32x4*)dst; f32x4 o0, o1; unpack8(ow, o0, o1); v0 = v0 + o0; v1 = v1 + o1; }
                    *(u32x4*)dst = pack8(v0, v1);
                }
            }
    }
};
struct EpiOut {
    static constexpr bool PERM = false;
    const float* x; float* x1; const float* mod;
    __device__ __forceinline__ void operator()(const f32x4 (&acc)[2][2][4][2], const Unit& u, int wr, int wc, int fr, int fq) const {
        const int b = u.pm >> 3; const float* gt1 = mod + b * 6144 + 2048;
#pragma unroll
        for (int bj = 0; bj < 2; ++bj)
#pragma unroll
            for (int n = 0; n < 2; ++n) {
                const int c0 = u.pn * 256 + bj * 128 + wc * 32 + 16 * n + 4 * fq;
                const f32x4 gt = *(const f32x4*)(gt1 + c0);
#pragma unroll
                for (int ai = 0; ai < 2; ++ai)
#pragma unroll
                    for (int m = 0; m < 4; ++m) {
                        const size_t off = (size_t)(u.pm * 256 + ai * 128 + wr * 64 + m * 16 + fr) * DM + c0;
                        const f32x4 xv = *(const f32x4*)(x + off);
                        *(f32x4*)(x1 + off) = xv + gt * acc[ai][bj][m][n];
                    }
            }
    }
};
struct EpiUp {
    static constexpr bool PERM = true;
    bf16* ACT; const float* b_gu;
    __device__ __forceinline__ void operator()(const f32x4 (&acc)[2][2][4][2], const Unit& u, int wr, int wc, int fr, int fq) const {
        const int f0 = u.pn * 128 + wc * 32 + 8 * fq;
        const float* bg = b_gu + (size_t)u.e * 2048 + f0; const float* bu = bg + 1024;
        const f32x4 bg0 = *(const f32x4*)bg, bg1 = *(const f32x4*)(bg + 4), bu0 = *(const f32x4*)bu, bu1 = *(const f32x4*)(bu + 4);
#pragma unroll
        for (int ai = 0; ai < 2; ++ai)
#pragma unroll
            for (int m = 0; m < 4; ++m) {
                const int r = ai * 128 + wr * 64 + m * 16 + fr;
                f32x4 g0 = acc[ai][0][m][0] + bg0, g1 = acc[ai][0][m][1] + bg1, u0 = acc[ai][1][m][0] + bu0, u1 = acc[ai][1][m][1] + bu1, a0, a1;
#pragma unroll
                for (int j = 0; j < 4; ++j) {
                    float gg = fminf(g0[j], 7.f), uu = fminf(fmaxf(u0[j], -7.f), 7.f); a0[j] = (uu + 1.f) * gg * sigmoidf_(1.702f * gg);
                    gg = fminf(g1[j], 7.f); uu = fminf(fmaxf(u1[j], -7.f), 7.f); a1[j] = (uu + 1.f) * gg * sigmoidf_(1.702f * gg); }
                *(u32x4*)(ACT + (size_t)(u.pm * 256 + r) * FF + f0) = pack8(a0, a1);
            }
    }
};
struct EpiDown {
    static constexpr bool PERM = true;
    bf16* YB; const float* b_dn; const int* list;
    __device__ __forceinline__ void operator()(const f32x4 (&acc)[2][2][4][2], const Unit& u, int wr, int wc, int fr, int fq) const {
#pragma unroll
        for (int ai = 0; ai < 2; ++ai)
#pragma unroll
            for (int m = 0; m < 4; ++m) {
                const int slot = u.row0 + ai * 128 + wr * 64 + m * 16 + fr;
                if (slot < u.cnt) {
                    const int aid = list[u.e * NTOK + slot];
#pragma unroll
                    for (int bj = 0; bj < 2; ++bj) {
                        const int c0 = u.pn * 256 + bj * 128 + wc * 32 + 8 * fq;
                        const float* bp = b_dn + (size_t)u.e * DM + c0;
                        const f32x4 v0 = acc[ai][bj][m][0] + *(const f32x4*)bp, v1 = acc[ai][bj][m][1] + *(const f32x4*)(bp + 4);
                        *(u32x4*)(YB + (size_t)aid * DM + c0) = pack8(v0, v1);
                    }
                }
            }
    }
};

__device__ __forceinline__ void phase_mod(const Ctx& C) {
    LAS float* sc = (LAS float*)C.lds;
    LAS float* red = sc + 16 * 1024;
    for (int cb = C.bid; cb < 96; cb += C.G) {
        __syncthreads();
        for (int i = C.tid; i < 16 * 1024; i += NTHREADS) { const float v = C.c[i]; sc[i] = v / (1.f + __expf(-v)); }
        __syncthreads();
        const int cl = C.tid & 63, ks = C.tid >> 6, col = cb * 64 + cl;
        float acc[16];
#pragma unroll
        for (int b = 0; b < 16; ++b) acc[b] = 0.f;
#pragma unroll 4
        for (int k = ks * 128; k < ks * 128 + 128; ++k) {
            const float w = C.w_ada[(size_t)k * 6144 + col];
#pragma unroll
            for (int b = 0; b < 16; ++b) acc[b] += sc[b * 1024 + k] * w;
        }
#pragma unroll
        for (int b = 0; b < 16; ++b) red[(ks * 16 + b) * 64 + cl] = acc[b];
        __syncthreads();
        for (int o = C.tid; o < 1024; o += NTHREADS) {
            const int b = o >> 6, c2 = o & 63; float s = 0.f;
#pragma unroll
            for (int k2 = 0; k2 < 8; ++k2) s += red[(k2 * 16 + b) * 64 + c2];
            C.mod[b * 6144 + cb * 64 + c2] = s + C.b_ada[cb * 64 + c2];
        }
    }
    for (int gt = C.bid * NTHREADS + C.tid; gt < 256 * 512; gt += C.G * NTHREADS) {
        const int j = gt >> 9, k = (gt & 511) * 2;
        float s0 = 0.f, s1 = 0.f;
#pragma unroll
        for (int r = 0; r < 16; ++r) { const float wa = C.w_alpha_up[r * 256 + j]; s0 += C.w_in[(size_t)k * W_IN_N + 3072 + r] * wa; s1 += C.w_in[(size_t)(k + 1) * W_IN_N + 3072 + r] * wa; }
        *(unsigned*)(C.WinT + (size_t)(C_AL + j) * DM + k) = pk2(s0, s1);
    }
}

__device__ __forceinline__ void transpose_item(const float* W, int srcN, bf16* WT, int Kp, int dst_row0, int src_col0, int k0, LAS float* scr, int lane) {
#pragma unroll 8
    for (int i = 0; i < 32; ++i) { const int kk = 2 * i + (lane >> 5); scr[kk * 33 + (lane & 31)] = W[(size_t)(k0 + kk) * srcN + src_col0 + (lane & 31)]; }
    LDS_WAIT(); asm volatile("" ::: "memory");
    const int c = lane & 7;
#pragma unroll
    for (int j = 0; j < 4; ++j) { const int n = (lane >> 3) + 8 * j; const LAS float* s = scr + (8 * c) * 33 + n;
        u32x4 o; o.x = pk2(s[0 * 33], s[1 * 33]); o.y = pk2(s[2 * 33], s[3 * 33]); o.z = pk2(s[4 * 33], s[5 * 33]); o.w = pk2(s[6 * 33], s[7 * 33]);
        *(u32x4*)(WT + (size_t)(dst_row0 + n) * Kp + k0 + 8 * c) = o; }
    LDS_WAIT(); asm volatile("" ::: "memory");
}
__device__ __forceinline__ void phase_prep(const Ctx& C) {
    LAS float* scr = (LAS float*)(C.lds + C.wid * 16384);
    const int gw = C.bid * NWAVES + C.wid, NGW = C.G * NWAVES;
    constexpr int I_IN = 16 * 160, I_BD = 8 * 32, I_OUT = 16 * 32, I_GU = 32 * 16 * 64, I_DN = 32 * 16 * 32;
    constexpr int NITEMS = I_IN + 2 * I_BD + I_OUT + I_GU + I_DN;
    for (int it = gw; it < NITEMS; it += NGW) {
        int r = it;
        if (r < I_IN) { const int kb = r / 160, n0 = (r % 160) * 32; transpose_item(C.w_in, W_IN_N, C.WinT, DM, n0, n0 < 3072 ? n0 : n0 + 16, kb * 64, scr, C.lane); continue; } r -= I_IN;
        if (r < I_BD) { transpose_item(C.w_bd, DM, C.WbdT, 512, (r & 31) * 32, (r & 31) * 32, (r >> 5) * 64, scr, C.lane); continue; } r -= I_BD;
        if (r < I_BD) { transpose_item(C.w_bg, DM, C.WbgT, 512, (r & 31) * 32, (r & 31) * 32, (r >> 5) * 64, scr, C.lane); continue; } r -= I_BD;
        if (r < I_OUT) { transpose_item(C.w_out, DM, C.WoutT, DM, (r & 31) * 32, (r & 31) * 32, (r >> 5) * 64, scr, C.lane); continue; } r -= I_OUT;
        if (r < I_GU) { const int e = r >> 10, rr = r & 1023, kb = rr >> 6, n0 = (rr & 63) * 32; const int pn = n0 >> 8, bj = (n0 >> 7) & 1, j0 = n0 & 127;
            transpose_item(C.w_gu + (size_t)e * DM * 2048, 2048, C.WguT + (size_t)e * 2048 * DM, DM, n0, bj * 1024 + pn * 128 + j0, kb * 64, scr, C.lane); continue; } r -= I_GU;
        { const int e = r >> 9, rr = r & 511, kb = rr >> 5, n0 = (rr & 31) * 32;
            transpose_item(C.w_dn + (size_t)e * FF * DM, DM, C.WdT + (size_t)e * DM * FF, FF, n0, n0, kb * 64, scr, C.lane); }
    }
    for (int row = gw; row < NTOK; row += NGW) {
        const int b = row >> 11; const float* md = C.mod + b * 6144;
        f32x4 v[4]; float ss = 0.f;
#pragma unroll
        for (int j = 0; j < 4; ++j) { v[j] = *(const f32x4*)(C.x + (size_t)row * DM + 4 * C.lane + 256 * j); ss += (v[j][0] * v[j][0] + v[j][1] * v[j][1]) + (v[j][2] * v[j][2] + v[j][3] * v[j][3]); }
        const float rstd = rsqrtf(wave_sum(ss) * (1.f / DM) + EPS);
#pragma unroll
        for (int j = 0; j < 4; ++j) { const int c0 = 4 * C.lane + 256 * j;
            const f32x4 g = *(const f32x4*)(C.norm1_g + c0), sc = *(const f32x4*)(md + 1024 + c0), sh = *(const f32x4*)(md + c0);
            const f32x4 y = v[j] * rstd * g * (sc + 1.f) + sh;
            u32x2 o; o.x = pk2(y[0], y[1]); o.y = pk2(y[2], y[3]);
            *(u32x2*)(C.H + (size_t)row * DM + c0) = o; }
    }
}

__device__ __forceinline__ void gla_scan(const Ctx& C, int b, int h) {
    LAS float* qs = (LAS float*)C.lds;
    LAS float* ks = qs + 2048;
    LAS float* al = ks + 2048;
    LAS float* vs = al + 2048;
    LAS float* part = vs + 4096;
    const int dv = C.tid & 127, dkg = C.tid >> 7;
    float S[16];
#pragma unroll
    for (int j = 0; j < 16; ++j) S[j] = 0.f;
    const float gdv0 = C.gla_g[2 * C.lane], gdv1 = C.gla_g[2 * C.lane + 1];
    for (int ch = 0; ch < SEQ / 32; ++ch) {
        const int row0 = b * SEQ + ch * 32;
        __syncthreads();
        for (int i = C.tid; i < 32 * 64; i += NTHREADS) { const int t = i >> 6, d = i & 63; const bf16* pr = C.PROJ + (size_t)(row0 + t) * NPROJ;
            qs[i] = bf2f(pr[C_GQ + h * 64 + d]); ks[i] = bf2f(pr[C_GK + h * 64 + d]); al[i] = __expf(bf2f(pr[C_AL + h * 64 + d])); }
        for (int i = C.tid; i < 32 * 128; i += NTHREADS) { const int t = i >> 7, d = i & 127; vs[i] = bf2f(C.PROJ[(size_t)(row0 + t) * NPROJ + C_GV + h * 128 + d]); }
        __syncthreads();
#pragma unroll 2
        for (int t = 0; t < 32; ++t) {
            const float v = vs[t * 128 + dv]; float o = 0.f;
#pragma unroll
            for (int j4 = 0; j4 < 4; ++j4) {
                const f32x4 a4 = *(const LAS f32x4*)(al + t * 64 + dkg * 16 + j4 * 4), k4 = *(const LAS f32x4*)(ks + t * 64 + dkg * 16 + j4 * 4), q4 = *(const LAS f32x4*)(qs + t * 64 + dkg * 16 + j4 * 4);
#pragma unroll
                for (int jj = 0; jj < 4; ++jj) { const int j = j4 * 4 + jj; S[j] = a4[jj] * S[j] + k4[jj] * v; o += q4[jj] * S[j]; }
            }
            part[(dkg * 32 + t) * 128 + dv] = o;
        }
        __syncthreads();
#pragma unroll
        for (int tt = 0; tt < 4; ++tt) {
            const int t = 4 * C.wid + tt; float o0 = 0.f, o1 = 0.f;
#pragma unroll
            for (int g = 0; g < 4; ++g) { o0 += part[(g * 32 + t) * 128 + 2 * C.lane]; o1 += part[(g * 32 + t) * 128 + 2 * C.lane + 1]; }
            const float rstd = rsqrtf(wave_sum(o0 * o0 + o1 * o1) * (1.f / 128.f) + EPS);
            const unsigned grw = *(const unsigned*)(C.PROJ + (size_t)(row0 + t) * NPROJ + C_GR + h * 128 + 2 * C.lane);
            const float g0 = bflo(grw), g1 = bfhi(grw);
            const float y0 = o0 * rstd * gdv0 * (g0 * sigmoidf_(g0)), y1 = o1 * rstd * gdv1 * (g1 * sigmoidf_(g1));
            *(unsigned*)(C.OB + (size_t)(row0 + t) * 512 + h * 128 + 2 * C.lane) = pk2(y0, y1);
        }
    }
}

__device__ __forceinline__ void attn_simple(const Ctx& C) {
    LAS float* Kt = (LAS float*)C.lds;
    LAS float* Vt = Kt + 8192;
    LAS float* Ss = Vt + 8192;
    LAS float* ssq = Ss + 2 * 64 * 68;
    LAS float* lamp = ssq + 256;
    if (C.tid < 64) {
        const float a = wave_sum(C.lq1[C.lane] * C.lk1[C.lane]), b2 = wave_sum(C.lq2[C.lane] * C.lk2[C.lane]);
        if (C.tid == 0) lamp[0] = __expf(a) - __expf(b2) + 0.2f;
    }
    __syncthreads();
    const float lam = lamp[0];
    const int q = C.tid & 63, p = (C.tid >> 6) & 1, dq = C.tid >> 7;
    for (int uix = C.bid; uix < 2048; uix += C.G) {
        const int bh = uix & 63, g = (uix >> 6) & 3, i2 = uix >> 8; const int b = bh >> 2, h = bh & 3;
        const int qc = (i2 & 1) ? (31 - (4 * g + (i2 >> 1))) : (4 * g + (i2 >> 1));
        const float sl2 = exp2f(-2.f * (float)(h + 1)) * LOG2E;
        const int qrow = b * SEQ + qc * 64 + q;
        float qv[64];
#pragma unroll
        for (int d8 = 0; d8 < 8; ++d8) { const u32x4 w = *(const u32x4*)(C.PROJ + (size_t)qrow * NPROJ + C_DQ + h * 128 + p * 64 + d8 * 8);
            qv[d8 * 8 + 0] = bflo(w.x); qv[d8 * 8 + 1] = bfhi(w.x); qv[d8 * 8 + 2] = bflo(w.y); qv[d8 * 8 + 3] = bfhi(w.y);
            qv[d8 * 8 + 4] = bflo(w.z); qv[d8 * 8 + 5] = bfhi(w.z); qv[d8 * 8 + 6] = bflo(w.w); qv[d8 * 8 + 7] = bfhi(w.w); }
        float m = -1e30f, l = 0.f, acc[32];
#pragma unroll
        for (int d = 0; d < 32; ++d) acc[d] = 0.f;
        for (int kc = 0; kc <= qc; ++kc) {
            __syncthreads();
            for (int pi = C.tid; pi < 1024; pi += NTHREADS) { const int r = pi >> 4, cc = pi & 15; const bf16* pr = C.PROJ + (size_t)(b * SEQ + kc * 64 + r) * NPROJ + h * 128 + cc * 8;
                const u32x4 kw = *(const u32x4*)(pr + C_DK), vw = *(const u32x4*)(pr + C_DV); f32x4 a0, a1;
                unpack8(kw, a0, a1); *(LAS f32x4*)(Kt + r * 128 + cc * 8) = a0; *(LAS f32x4*)(Kt + r * 128 + cc * 8 + 4) = a1;
                unpack8(vw, a0, a1); *(LAS f32x4*)(Vt + r * 128 + cc * 8) = a0; *(LAS f32x4*)(Vt + r * 128 + cc * 8 + 4) = a1; }
            __syncthreads();
#pragma unroll 1
            for (int kk = 0; kk < 16; ++kk) {
                const int key = dq * 16 + kk; float s = 0.f;
#pragma unroll
                for (int d4 = 0; d4 < 16; ++d4) { const f32x4 kv = *(const LAS f32x4*)(Kt + key * 128 + p * 64 + d4 * 4);
                    s += qv[d4 * 4] * kv[0]; s += qv[d4 * 4 + 1] * kv[1]; s += qv[d4 * 4 + 2] * kv[2]; s += qv[d4 * 4 + 3] * kv[3]; }
                const int kpos = kc * 64 + key, qpos = qc * 64 + q; const int mn = kpos < 2 * qpos - kpos ? kpos : 2 * qpos - kpos;
                Ss[(p * 64 + q) * 68 + key] = s + sl2 * (float)mn;
            }
            __syncthreads();
            const LAS float* srow = Ss + (p * 64 + q) * 68;
            float cm = -1e30f;
#pragma unroll
            for (int k4 = 0; k4 < 16; ++k4) { const f32x4 sv = *(const LAS f32x4*)(srow + k4 * 4); cm = fmaxf(cm, fmaxf(fmaxf(sv[0], sv[1]), fmaxf(sv[2], sv[3]))); }
            const float mnew = fmaxf(m, cm), alpha = exp2f(m - mnew); m = mnew; l *= alpha;
#pragma unroll
            for (int d = 0; d < 32; ++d) acc[d] *= alpha;
#pragma unroll 2
            for (int key = 0; key < 64; ++key) {
                const float pk = exp2f(srow[key] - m); l += pk;
#pragma unroll
                for (int d4 = 0; d4 < 8; ++d4) { const f32x4 vv = *(const LAS f32x4*)(Vt + key * 128 + dq * 32 + d4 * 4);
                    acc[d4 * 4] += pk * vv[0]; acc[d4 * 4 + 1] += pk * vv[1]; acc[d4 * 4 + 2] += pk * vv[2]; acc[d4 * 4 + 3] += pk * vv[3]; }
            }
        }
        const float inv = 1.f / l;
        __syncthreads();
        LAS float* O2 = Ss;
        if (p == 1) {
#pragma unroll
            for (int d = 0; d < 32; ++d) O2[q * 128 + dq * 32 + d] = lam * acc[d] * inv;
        }
        __syncthreads();
        float ss = 0.f;
        if (p == 0) {
#pragma unroll
            for (int d = 0; d < 32; ++d) { acc[d] = acc[d] * inv - O2[q * 128 + dq * 32 + d]; ss += acc[d] * acc[d]; }
            ssq[q * 4 + dq] = ss;
        }
        __syncthreads();
        if (p == 0) {
            const float tot = (ssq[q * 4] + ssq[q * 4 + 1]) + (ssq[q * 4 + 2] + ssq[q * 4 + 3]);
            const float rstd = rsqrtf(tot * (1.f / 128.f) + EPS) * 0.8f;
            bf16* dst = C.OA + (size_t)qrow * 512 + h * 128 + dq * 32;
#pragma unroll
            for (int d8 = 0; d8 < 4; ++d8) { u32x4 w; const float* gg = C.diff_g + dq * 32 + d8 * 8;
                w.x = pk2(acc[d8 * 8] * rstd * gg[0], acc[d8 * 8 + 1] * rstd * gg[1]); w.y = pk2(acc[d8 * 8 + 2] * rstd * gg[2], acc[d8 * 8 + 3] * rstd * gg[3]);
                w.z = pk2(acc[d8 * 8 + 4] * rstd * gg[4], acc[d8 * 8 + 5] * rstd * gg[5]); w.w = pk2(acc[d8 * 8 + 6] * rstd * gg[6], acc[d8 * 8 + 7] * rstd * gg[7]);
                *(u32x4*)(dst + d8 * 8) = w; }
        }
    }
}


typedef float f32x16 __attribute__((ext_vector_type(16)));
typedef short s16x4 __attribute__((ext_vector_type(4)));
typedef short v4i16_t __attribute__((ext_vector_type(4)));
__device__ __forceinline__ s16x4 vtr(const LAS unsigned char* p) { return __builtin_bit_cast(s16x4, __builtin_amdgcn_ds_read_tr16_b64_v4i16((LAS v4i16_t*)p)); }
template <int OFF> __device__ __forceinline__ void glds16(const void* sbase, unsigned voff, unsigned lds_dst) {
    unsigned sv; asm volatile("s_mov_b32 %0, m0\n\ts_mov_b32 m0, %3\n\ts_nop 0\n\tglobal_load_lds_dwordx4 %1, %2 offset:%4\n\ts_mov_b32 m0, %0" : "=&s"(sv) : "v"(voff), "s"(sbase), "s"(lds_dst), "i"(OFF) : "memory"); }
__device__ __forceinline__ unsigned lds_addr(const LAS unsigned char* p) { return (unsigned)__builtin_amdgcn_readfirstlane((int)(unsigned)(size_t)p); }
#define MFMA16(a, b, c) __builtin_amdgcn_mfma_f32_16x16x32_bf16(a, b, c, 0, 0, 0)
__device__ __forceinline__ bf16x8 cat44(s16x4 lo, s16x4 hi) { return (bf16x8){lo[0], lo[1], lo[2], lo[3], hi[0], hi[1], hi[2], hi[3]}; }
__device__ __forceinline__ void gla_chunked(const Ctx& C, int b, int h) {
    const int lane = C.lane, wid = C.wid, fr = lane & 15, fq = lane >> 4;
    LAS unsigned char* lds = C.lds;
    constexpr int RAW_Q = 0, RAW_K = 8192, RAW_LA = 16384, VB0 = 24576, QS = 57344, KS = 66560, KD = 75776, AM = 84992, ST = 94208, OO = 112640, GTL = 146432;
    constexpr int P = 144, PO = 528;
    const char* pbase = (const char*)(C.PROJ + (size_t)(b * SEQ) * NPROJ);
    const unsigned oq = (unsigned)(((8 * wid + (lane >> 3)) * NPROJ + C_GQ + h * 64 + (lane & 7) * 8) * 2);
    const unsigned okk = oq + (unsigned)((C_GK - C_GQ) * 2), ol = oq + (unsigned)((C_AL - C_GQ) * 2);
    const unsigned ov0 = (unsigned)(((4 * wid + (lane >> 4)) * NPROJ + C_GV + h * 128 + (lane & 15) * 8) * 2), ov1 = ov0 + (unsigned)(32 * NPROJ * 2);
#define GL_DMA(n) do { const char* _cb = pbase + (size_t)(n) * 64 * NPROJ * 2; const unsigned _vb = VB0 + ((n) & 1) * 16384; \
        glds16<0>(_cb, oq, lds_addr(lds + RAW_Q + wid * 1024)); glds16<0>(_cb, okk, lds_addr(lds + RAW_K + wid * 1024)); glds16<0>(_cb, ol, lds_addr(lds + RAW_LA + wid * 1024)); \
        glds16<0>(_cb, ov0, lds_addr(lds + _vb + wid * 1024)); glds16<0>(_cb, ov1, lds_addr(lds + _vb + (wid + 8) * 1024)); } while (0)
    __syncthreads();
    GL_DMA(0);
    for (int i = lane; i < 16 * P / 4; i += 64) ((LAS unsigned*)(lds + ST + wid * 16 * P))[i] = 0u;
    f32x4 accS[4];
#pragma unroll
    for (int t = 0; t < 4; ++t) accS[t] = (f32x4){0.f, 0.f, 0.f, 0.f};
    const int t1 = wid >> 1, ca = 2 * (wid & 1);
    bf16x8 ym[2][2];
#pragma unroll
    for (int ci = 0; ci < 2; ++ci)
#pragma unroll
        for (int ks = 0; ks < 2; ++ks)
#pragma unroll
            for (int jj = 0; jj < 8; ++jj) ym[ci][ks][jj] = (short)(((32 * ks + 8 * fq + jj) <= (16 * (ca + ci) + fr)) ? 0x3F80 : 0);
    const bf16x8 ones = (bf16x8){0x3F80, 0x3F80, 0x3F80, 0x3F80, 0x3F80, 0x3F80, 0x3F80, 0x3F80};
    const int qp = (lane & 15) >> 2, pp = lane & 3;
    const float g0 = C.gla_g[2 * lane], g1 = C.gla_g[2 * lane + 1];
    unsigned grw[8];
#pragma unroll
    for (int cc = 0; cc < 8; ++cc) grw[cc] = 0u;
#define GL_ROWPASS(n) do { _Pragma("unroll") for (int cc = 0; cc < 8; ++cc) { const int c_ = 8 * wid + cc; \
        const float o0 = *(const LAS float*)(lds + OO + c_ * PO + lane * 8), o1 = *(const LAS float*)(lds + OO + c_ * PO + lane * 8 + 4); \
        const float rstd = rsqrtf(wave_sum(o0 * o0 + o1 * o1) * (1.f / 128.f) + EPS); const float gr0 = bflo(grw[cc]), gr1 = bfhi(grw[cc]); \
        *(unsigned*)(C.OB + (size_t)(b * SEQ + (n) * 64 + c_) * 512 + h * 128 + 2 * lane) = pk2(o0 * rstd * g0 * (gr0 * sigmoidf_(gr0)), o1 * rstd * g1 * (gr1 * sigmoidf_(gr1))); } } while (0)
#pragma unroll 1
    for (int n = 0; n < SEQ / 64; ++n) {
        asm volatile("s_waitcnt vmcnt(0) lgkmcnt(0)" ::: "memory"); __syncthreads();
        if (n > 0) GL_ROWPASS(n - 1);
#pragma unroll
        for (int cc = 0; cc < 8; ++cc) grw[cc] = *(const unsigned*)(pbase + ((size_t)(n * 64 + 8 * wid + cc) * NPROJ + C_GR + h * 128 + 2 * lane) * 2);
        {
            bf16x8 xla[2];
#pragma unroll
            for (int ks = 0; ks < 2; ++ks) { const LAS unsigned char* a = lds + RAW_LA + (32 * ks + 8 * fq + qp) * 128 + (16 * t1 + 4 * pp) * 2; xla[ks] = cat44(vtr(a), vtr(a + 4 * 128)); }
            f32x4 Ga = (f32x4){0.f, 0.f, 0.f, 0.f}, Gb = Ga, GT = Ga;
#pragma unroll
            for (int ks = 0; ks < 2; ++ks) { Ga = MFMA16(xla[ks], ym[0][ks], Ga); Gb = MFMA16(xla[ks], ym[1][ks], Gb); GT = MFMA16(xla[ks], ones, GT); }
#pragma unroll
            for (int ci = 0; ci < 2; ++ci) {
                const int c_ = 16 * (ca + ci) + fr, dk0 = 16 * t1 + 4 * fq; const f32x4 G = ci ? Gb : Ga;
                const u32x2 qw = *(const LAS u32x2*)(lds + RAW_Q + c_ * 128 + dk0 * 2), kw = *(const LAS u32x2*)(lds + RAW_K + c_ * 128 + dk0 * 2);
                const float q4[4] = {bflo(qw.x), bfhi(qw.x), bflo(qw.y), bfhi(qw.y)}, k4[4] = {bflo(kw.x), bfhi(kw.x), bflo(kw.y), bfhi(kw.y)};
                float qs4[4], ks4[4], kd4[4];
#pragma unroll
                for (int r = 0; r < 4; ++r) { qs4[r] = q4[r] * __expf(G[r]); ks4[r] = k4[r] * __expf(-G[r]); kd4[r] = k4[r] * __expf(GT[r] - G[r]); }
                *(LAS u32x2*)(lds + QS + c_ * P + dk0 * 2) = (u32x2){pk2(qs4[0], qs4[1]), pk2(qs4[2], qs4[3])};
                *(LAS u32x2*)(lds + KS + c_ * P + dk0 * 2) = (u32x2){pk2(ks4[0], ks4[1]), pk2(ks4[2], ks4[3])};
                *(LAS u32x2*)(lds + KD + c_ * P + dk0 * 2) = (u32x2){pk2(kd4[0], kd4[1]), pk2(kd4[2], kd4[3])};
            }
            if (fr == 0 && (wid & 1) == 0) *(LAS f32x4*)(lds + GTL + (16 * t1 + 4 * fq) * 4) = GT;
        }
        LDS_WAIT(); __syncthreads();
        if (n + 1 < SEQ / 64) GL_DMA(n + 1);
        {
            const int ct = wid >> 1;
#pragma unroll
            for (int si = 0; si < 2; ++si) {
                const int st = 2 * (wid & 1) + si; f32x4 D = (f32x4){0.f, 0.f, 0.f, 0.f};
                if (st <= ct) {
#pragma unroll
                    for (int ks = 0; ks < 2; ++ks) { const bf16x8 X = *(const LAS bf16x8*)(lds + KS + (16 * st + fr) * P + (32 * ks + 8 * fq) * 2), Y = *(const LAS bf16x8*)(lds + QS + (16 * ct + fr) * P + (32 * ks + 8 * fq) * 2); D = MFMA16(X, Y, D); }
#pragma unroll
                    for (int r = 0; r < 4; ++r) if (16 * st + 4 * fq + r > 16 * ct + fr) D[r] = 0.f;
                }
                *(LAS u32x2*)(lds + AM + (16 * ct + fr) * P + (16 * st + 4 * fq) * 2) = (u32x2){pk2(D[0], D[1]), pk2(D[2], D[3])};
            }
        }
        LDS_WAIT(); __builtin_amdgcn_s_barrier(); asm volatile("" ::: "memory");
        {
            const unsigned vb = VB0 + (n & 1) * 16384;
            bf16x8 X1[2], X2[2];
#pragma unroll
            for (int ks = 0; ks < 2; ++ks) { X1[ks] = *(const LAS bf16x8*)(lds + ST + (16 * wid + fr) * P + (32 * ks + 8 * fq) * 2);
                const LAS unsigned char* a = lds + vb + (32 * ks + 8 * fq + qp) * 256 + (16 * wid + 4 * pp) * 2; X2[ks] = cat44(vtr(a), vtr(a + 4 * 256)); }
#pragma unroll
            for (int ct = 0; ct < 4; ++ct) { f32x4 o = (f32x4){0.f, 0.f, 0.f, 0.f};
#pragma unroll
                for (int ks = 0; ks < 2; ++ks) { const bf16x8 Y1 = *(const LAS bf16x8*)(lds + QS + (16 * ct + fr) * P + (32 * ks + 8 * fq) * 2), Y2 = *(const LAS bf16x8*)(lds + AM + (16 * ct + fr) * P + (32 * ks + 8 * fq) * 2);
                    o = MFMA16(X1[ks], Y1, o); o = MFMA16(X2[ks], Y2, o); }
                *(LAS f32x4*)(lds + OO + (16 * ct + fr) * PO + (16 * wid + 4 * fq) * 4) = o; }
#pragma unroll
            for (int tt = 0; tt < 4; ++tt) { const f32x4 dl = *(const LAS f32x4*)(lds + GTL + (16 * tt + 4 * fq) * 4);
#pragma unroll
                for (int r = 0; r < 4; ++r) accS[tt][r] *= __expf(dl[r]);
#pragma unroll
                for (int ks = 0; ks < 2; ++ks) { const LAS unsigned char* a = lds + KD + (32 * ks + 8 * fq + qp) * P + (16 * tt + 4 * pp) * 2; accS[tt] = MFMA16(cat44(vtr(a), vtr(a + 4 * P)), X2[ks], accS[tt]); }
                *(LAS u32x2*)(lds + ST + (16 * wid + fr) * P + (16 * tt + 4 * fq) * 2) = (u32x2){pk2(accS[tt][0], accS[tt][1]), pk2(accS[tt][2], accS[tt][3])}; }
        }
    }
    asm volatile("s_waitcnt vmcnt(0) lgkmcnt(0)" ::: "memory"); __syncthreads();
    GL_ROWPASS(SEQ / 64 - 1);
    __syncthreads();
#undef GL_DMA
#undef GL_ROWPASS
}

__device__ __forceinline__ int crow(int r, int hi) { return (r & 3) + 8 * (r >> 2) + 4 * hi; }
#define MFMA32(a, b, c) __builtin_amdgcn_mfma_f32_32x32x16_bf16(a, b, c, 0, 0, 0)
constexpr int AT_BUF = 32768, AT_WSF = 65536, AT_Q = 65536 + 2048;
constexpr float AT_THR = 8.f;

__device__ __forceinline__ void attn_unit(const Ctx& C, int b, int h, int cp, float lam) {
    const int lane = C.lane, r32 = lane & 31, hi = lane >> 5, wid = C.wid, p = wid >> 2, sub = wid & 3;
    const int NT = 2 * cp + 2, qch = 2 * cp + (sub >> 1), my_nt = qch + 1;
    const int row0 = b * SEQ + cp * 128;
    const int qpos = cp * 128 + sub * 32 + r32;
    const float sl2 = exp2f(-2.f * (float)(h + 1)) * LOG2E;
    LAS unsigned char* lds = C.lds;
    LAS float* wsf = (LAS float*)(lds + AT_WSF) + wid * 64;
    const char* kbase = (const char*)(C.PROJ + (size_t)(b * SEQ) * NPROJ + h * 128);
    const unsigned koff = (unsigned)((lane * NPROJ + C_DK + wid * 8) * 2);
    const unsigned voff = (unsigned)(((16 * (wid & 3) + (lane >> 2)) * NPROJ + C_DV + (wid >> 2) * 32 + (lane & 3) * 8) * 2);
#define AT_DMA(t, bufo) do { const char* _tb = kbase + (size_t)(t) * 64 * NPROJ * 2; \
        glds16<0>(_tb, koff, lds_addr(lds + (bufo) + wid * 1024)); glds16<0>(_tb, koff + 128u, lds_addr(lds + (bufo) + 8192 + wid * 1024)); \
        glds16<0>(_tb, voff, lds_addr(lds + (bufo) + 16384 + (wid >> 2) * 4096 + (wid & 3) * 1024)); glds16<0>(_tb, voff + 128u, lds_addr(lds + (bufo) + 16384 + ((wid >> 2) + 2) * 4096 + (wid & 3) * 1024)); } while (0)
    AT_DMA(0, 0);
    bf16x8 qr[4];
    { const bf16* qp = C.PROJ + (size_t)(row0 + sub * 32 + r32) * NPROJ + C_DQ + h * 128 + p * 64 + hi * 8;
#pragma unroll
      for (int d0 = 0; d0 < 4; ++d0) qr[d0] = *(const bf16x8*)(qp + d0 * 16); }
    f32x16 o[4];
#pragma unroll
    for (int d0 = 0; d0 < 4; ++d0)
#pragma unroll
        for (int i = 0; i < 16; ++i) o[d0][i] = 0.f;
    float mhat = 0.f, lsum = 0.f;
    const unsigned kofs = (unsigned)(p * 8192 + hi * 1024 + r32 * 16);
    const unsigned vofs = (unsigned)(16384 + ((lane >> 4) & 1) * 32 + (lane & 3) * 8 + (4 * hi + ((lane & 15) >> 2)) * 64);
    asm volatile("s_waitcnt vmcnt(0)" ::: "memory"); __syncthreads();
#pragma unroll 1
    for (int t = 0; t < NT; ++t) {
        const unsigned bufo = (unsigned)(t & 1) * AT_BUF;
        if (t + 1 < NT) AT_DMA(t + 1, ((t + 1) & 1) * AT_BUF);
        if (t < my_nt) {
            const LAS unsigned char* kp = lds + bufo + kofs;
            const LAS unsigned char* vp = lds + bufo + vofs;
            f32x16 s0, s1;
#pragma unroll
            for (int i = 0; i < 16; ++i) { s0[i] = 0.f; s1[i] = 0.f; }
#pragma unroll
            for (int d0 = 0; d0 < 4; ++d0) {
                const bf16x8 k0 = *(const LAS bf16x8*)(kp + d0 * 2048), k1 = *(const LAS bf16x8*)(kp + d0 * 2048 + 512);
                s0 = MFMA32(k0, qr[d0], s0); s1 = MFMA32(k1, qr[d0], s1);
            }
            if (t == qch) {
#pragma unroll
                for (int i = 0; i < 16; ++i) { const int k0p = 64 * t + crow(i, hi), k1p = k0p + 32;
                    s0[i] += sl2 * (float)min(k0p, 2 * qpos - k0p); s1[i] += sl2 * (float)min(k1p, 2 * qpos - k1p); }
            } else {
                const float bs = sl2 * (float)(64 * t + 4 * hi);
#pragma unroll
                for (int i = 0; i < 16; ++i) { const float ci = (float)((i & 3) + 8 * (i >> 2)); s0[i] += fmaf(sl2, ci, bs); s1[i] += fmaf(sl2, ci + 32.f, bs); }
            }
            float rm = fmaxf(s0[0], s1[0]);
#pragma unroll
            for (int i = 1; i < 16; ++i) rm = fmaxf(rm, fmaxf(s0[i], s1[i]));
            rm = fmaxf(rm, __shfl_xor(rm, 32));
            if (t == 0) { mhat = rm; }
            else {
                const float gr = rm - mhat;
                if (__any(gr > AT_THR)) {
                    const float dl = fmaxf(gr, 0.f); mhat += dl; const float f = __builtin_amdgcn_exp2f(-dl); lsum *= f;
                    if (hi == 0) wsf[r32] = f;
                    LDS_WAIT();
#pragma unroll
                    for (int i = 0; i < 16; ++i) { const float fi = wsf[crow(i, hi)];
#pragma unroll
                        for (int d0 = 0; d0 < 4; ++d0) o[d0][i] *= fi; }
                }
            }
            float ps = 0.f;
#pragma unroll
            for (int i = 0; i < 16; ++i) { s0[i] = __builtin_amdgcn_exp2f(s0[i] - mhat); s1[i] = __builtin_amdgcn_exp2f(s1[i] - mhat); ps += s0[i] + s1[i]; }
            lsum += ps;
            u32x4 pw[4];
            pw[0] = (u32x4){pk2(s0[0], s0[1]), pk2(s0[2], s0[3]), pk2(s0[4], s0[5]), pk2(s0[6], s0[7])};
            pw[1] = (u32x4){pk2(s0[8], s0[9]), pk2(s0[10], s0[11]), pk2(s0[12], s0[13]), pk2(s0[14], s0[15])};
            pw[2] = (u32x4){pk2(s1[0], s1[1]), pk2(s1[2], s1[3]), pk2(s1[4], s1[5]), pk2(s1[6], s1[7])};
            pw[3] = (u32x4){pk2(s1[8], s1[9]), pk2(s1[10], s1[11]), pk2(s1[12], s1[13]), pk2(s1[14], s1[15])};
#pragma unroll
            for (int k = 0; k < 4; ++k) {
                const bf16x8 pa = __builtin_bit_cast(bf16x8, pw[k]);
#pragma unroll
                for (int d0 = 0; d0 < 4; ++d0) {
                    const s16x4 lo = vtr(vp + d0 * 4096 + k * 1024), hi4 = vtr(vp + d0 * 4096 + k * 1024 + 512);
                    const bf16x8 vf = (bf16x8){lo[0], lo[1], lo[2], lo[3], hi4[0], hi4[1], hi4[2], hi4[3]};
                    o[d0] = MFMA32(pa, vf, o[d0]);
                }
                __builtin_amdgcn_sched_barrier(0);
            }
        }
        asm volatile("s_waitcnt vmcnt(0) lgkmcnt(0)" ::: "memory"); __syncthreads();
    }
#undef AT_DMA
    lsum += __shfl_xor(lsum, 32);
    if (hi == 0) wsf[32 + r32] = lsum;
    LDS_WAIT();
    LAS float* X = (LAS float*)lds;
    if (p == 1) {
#pragma unroll
        for (int i = 0; i < 16; ++i) { const float sc = lam / wsf[32 + crow(i, hi)];
#pragma unroll
            for (int d0 = 0; d0 < 4; ++d0) X[(sub * 32 + crow(i, hi)) * 128 + d0 * 32 + r32] = o[d0][i] * sc; }
    }
    __syncthreads();
    if (p == 0) {
#pragma unroll
        for (int i = 0; i < 16; ++i) { const float sc = 1.f / wsf[32 + crow(i, hi)];
#pragma unroll
            for (int d0 = 0; d0 < 4; ++d0) { LAS float* xp = X + (sub * 32 + crow(i, hi)) * 128 + d0 * 32 + r32; *xp = o[d0][i] * sc - *xp; } }
    }
    __syncthreads();
    { const float g0 = C.diff_g[2 * lane], g1 = C.diff_g[2 * lane + 1];
#pragma unroll 4
      for (int qq = 0; qq < 16; ++qq) { const int q = wid * 16 + qq; const float y0 = X[q * 128 + 2 * lane], y1 = X[q * 128 + 2 * lane + 1];
          const float rstd = rsqrtf(wave_sum(y0 * y0 + y1 * y1) * (1.f / 128.f) + EPS) * 0.8f;
          *(unsigned*)(C.OA + (size_t)(row0 + q) * 512 + h * 128 + 2 * lane) = pk2(y0 * rstd * g0, y1 * rstd * g1); } }
    __syncthreads();
}

__device__ __forceinline__ void attn_phase(const Ctx& C) {
    LAS float* lamp = (LAS float*)(C.lds + AT_Q) + 4;
    LAS int* qw = (LAS int*)(C.lds + AT_Q);
    if (C.tid < 64) {
        const float a = wave_sum(C.lq1[C.lane] * C.lk1[C.lane]), b2 = wave_sum(C.lq2[C.lane] * C.lk2[C.lane]);
        if (C.tid == 0) lamp[0] = __expf(a) - __expf(b2) + 0.2f;
    }
    __syncthreads();
    const float lam = lamp[0];
    for (;;) {
        if (C.tid == 0) qw[0] = (int)__hip_atomic_fetch_add(C.ctl + CW_QUEUE, 1u, RLX_AGENT);
        __syncthreads();
        const int item = __builtin_amdgcn_readfirstlane(qw[0]);
        __syncthreads();
        if (item >= 512) break;
        const int bh = item >> 3, pr = item & 7;
#pragma unroll 1
        for (int k = 0; k < 2; ++k) attn_unit(C, bh >> 2, bh & 3, k ? pr : 15 - pr, lam);
    }
}

__device__ __forceinline__ void phase_router(const Ctx& C) {
    constexpr int WP = 1028;
    LAS float* WrT = (LAS float*)C.lds;
    LAS int* lcnt = (LAS int*)(WrT + 32 * WP);
    LAS int* lbase = lcnt + 32;
    LAS int* pend = lbase + 32;
    for (int i = C.tid; i < DM * NE; i += NTHREADS) { const int k = i >> 5, e = i & 31; WrT[e * WP + k] = C.w_router[i]; }
    if (C.tid < 32) lcnt[C.tid] = 0;
    for (int i = C.tid; i < 512; i += NTHREADS) pend[i] = -1;
    __syncthreads();
    const int gw = C.bid * NWAVES + C.wid, NGW = C.G * NWAVES;
    const float myb = C.b_router[C.lane >> 1];
    int it = 0;
    for (int row = gw; row < NTOK; row += NGW, ++it) {
        const int b = row >> 11; const float* md = C.mod + b * 6144;
        f32x4 v[4]; float ss = 0.f;
#pragma unroll
        for (int j = 0; j < 4; ++j) { v[j] = *(const f32x4*)(C.out + (size_t)row * DM + 4 * C.lane + 256 * j); ss += (v[j][0] * v[j][0] + v[j][1] * v[j][1]) + (v[j][2] * v[j][2] + v[j][3] * v[j][3]); }
        const float rstd = rsqrtf(wave_sum(ss) * (1.f / DM) + EPS);
#pragma unroll
        for (int j = 0; j < 4; ++j) { const int c0 = 4 * C.lane + 256 * j;
            const f32x4 g = *(const f32x4*)(C.norm2_g + c0), sc = *(const f32x4*)(md + 4096 + c0), sh = *(const f32x4*)(md + 3072 + c0);
            v[j] = v[j] * rstd * g * (sc + 1.f) + sh;
            u32x2 o; o.x = pk2(v[j][0], v[j][1]); o.y = pk2(v[j][2], v[j][3]);
            *(u32x2*)(C.H2 + (size_t)row * DM + c0) = o; }
        float a[32];
#pragma unroll
        for (int e = 0; e < 32; ++e) { float s = 0.f;
#pragma unroll
            for (int j = 0; j < 4; ++j) { const f32x4 w = *(const LAS f32x4*)(WrT + e * WP + 4 * C.lane + 256 * j); s += (v[j][0] * w[0] + v[j][1] * w[1]) + (v[j][2] * w[2] + v[j][3] * w[3]); }
            a[e] = s; }
#pragma unroll
        for (int i = 0; i < 16; ++i) { const bool hi = (C.lane & 32) != 0; const float send = hi ? a[i] : a[i + 16], keep = hi ? a[i + 16] : a[i]; a[i] = keep + __shfl_xor(send, 32); }
#pragma unroll
        for (int i = 0; i < 8; ++i) { const bool hi = (C.lane & 16) != 0; const float send = hi ? a[i] : a[i + 8], keep = hi ? a[i + 8] : a[i]; a[i] = keep + __shfl_xor(send, 16); }
#pragma unroll
        for (int i = 0; i < 4; ++i) { const bool hi = (C.lane & 8) != 0; const float send = hi ? a[i] : a[i + 4], keep = hi ? a[i + 4] : a[i]; a[i] = keep + __shfl_xor(send, 8); }
#pragma unroll
        for (int i = 0; i < 2; ++i) { const bool hi = (C.lane & 4) != 0; const float send = hi ? a[i] : a[i + 2], keep = hi ? a[i + 2] : a[i]; a[i] = keep + __shfl_xor(send, 4); }
        { const bool hi = (C.lane & 2) != 0; const float send = hi ? a[0] : a[1], keep = hi ? a[1] : a[0]; a[0] = keep + __shfl_xor(send, 2); }
        float val = a[0] + __shfl_xor(a[0], 1) + myb; const int idx = C.lane >> 1;
        float tv[4]; int ti[4];
#pragma unroll
        for (int r = 0; r < 4; ++r) {
            float bv = val; int bi = idx;
#pragma unroll
            for (int o = 32; o >= 1; o >>= 1) { const float ov = __shfl_xor(bv, o); const int oi = __shfl_xor(bi, o); if (ov > bv || (ov == bv && oi < bi)) { bv = ov; bi = oi; } }
            tv[r] = bv; ti[r] = bi; if (idx == bi) val = -3.0e38f;
        }
        const float e1 = __expf(tv[1] - tv[0]), e2 = __expf(tv[2] - tv[0]), e3 = __expf(tv[3] - tv[0]); const float inv = 1.f / (1.f + e1 + e2 + e3);
        if (C.lane == 0) { *(f32x4*)(C.topw + (size_t)row * 4) = (f32x4){inv, e1 * inv, e2 * inv, e3 * inv}; *(i32x4*)(C.tope + (size_t)row * 4) = (i32x4){ti[0], ti[1], ti[2], ti[3]}; }
        if (C.lane < 4) { const int e = C.lane == 0 ? ti[0] : (C.lane == 1 ? ti[1] : (C.lane == 2 ? ti[2] : ti[3]));
            const int slot = atomicAdd((int*)(lcnt + e), 1); pend[(it * 8 + C.wid) * 4 + C.lane] = (e << 16) | slot; }
    }
    __syncthreads();
    if (C.tid < 32) lbase[C.tid] = (int)__hip_atomic_fetch_add(C.ctl + CW_CNT + 64 * C.tid, (unsigned)lcnt[C.tid], RLX_AGENT);
    __syncthreads();
    for (int i = C.tid; i < 512; i += NTHREADS) { const int pv = pend[i]; if (pv >= 0) { const int e = pv >> 16, slot = pv & 0xffff; const int it2 = i >> 5, w = (i >> 2) & 7, r = i & 3;
        const int row = C.bid * NWAVES + w + it2 * NGW; C.list[e * NTOK + lbase[e] + slot] = row * 4 + r; } }
}

__device__ __forceinline__ void phase_final(const Ctx& C) {
    const int gw = C.bid * NWAVES + C.wid, NGW = C.G * NWAVES;
    for (int row = gw; row < NTOK; row += NGW) {
        const int b = row >> 11; const float* gt2 = C.mod + b * 6144 + 5120;
        const f32x4 w = *(const f32x4*)(C.topw + (size_t)row * 4);
        f32x4 v[4]; float ss = 0.f;
#pragma unroll
        for (int j = 0; j < 4; ++j) { const int c0 = 4 * C.lane + 256 * j;
            f32x4 y = (f32x4){0.f, 0.f, 0.f, 0.f};
#pragma unroll
            for (int k = 0; k < 4; ++k) { const u32x2 yw = *(const u32x2*)(C.YB + (size_t)(row * 4 + k) * DM + c0); y = y + (f32x4){bflo(yw.x), bfhi(yw.x), bflo(yw.y), bfhi(yw.y)} * w[k]; }
            v[j] = *(const f32x4*)(C.out + (size_t)row * DM + c0) + *(const f32x4*)(gt2 + c0) * y;
            ss += (v[j][0] * v[j][0] + v[j][1] * v[j][1]) + (v[j][2] * v[j][2] + v[j][3] * v[j][3]); }
        const float rstd = rsqrtf(wave_sum(ss) * (1.f / DM) + EPS);
#pragma unroll
        for (int j = 0; j < 4; ++j) { const int c0 = 4 * C.lane + 256 * j; *(f32x4*)(C.out + (size_t)row * DM + c0) = v[j] * rstd * *(const f32x4*)(C.final_g + c0); }
    }
}

#ifndef PROBE_A
#define PROBE_A -1
#endif
#ifndef PROBE_B
#define PROBE_B -1
#endif
constexpr int CW_TS = 3072;
#define STAMP(k) do { if (PROBE_A >= 0 && blockIdx.x == 0 && threadIdx.x == 0) { const Ctx Cs = make_ctx(lds); ((unsigned long long*)(Cs.ctl + CW_TS))[k] = __builtin_amdgcn_s_memrealtime(); } } while (0)
struct Args { const float* in[25]; float* out; unsigned char* ws; };
typedef const Args __attribute__((address_space(4)))* KArgs;
__device__ __forceinline__ Ctx make_ctx(LAS unsigned char* lds) {
    KArgs a = (KArgs)__builtin_amdgcn_kernarg_segment_ptr();
    asm volatile("" : "+s"(a));
    Ctx C;
    C.lds = lds;
    C.tid = tid_fresh(); C.lane = C.tid & 63; C.wid = __builtin_amdgcn_readfirstlane(C.tid >> 6); C.G = gridDim.x; C.bid = blockIdx.x;
    C.x = a->in[0]; C.c = a->in[1]; C.w_ada = a->in[2]; C.b_ada = a->in[3]; C.norm1_g = a->in[4]; C.w_in = a->in[5];
    C.lq1 = a->in[6]; C.lk1 = a->in[7]; C.lq2 = a->in[8]; C.lk2 = a->in[9]; C.diff_g = a->in[10]; C.w_alpha_up = a->in[11]; C.b_alpha = a->in[12];
    C.gla_g = a->in[13]; C.w_bd = a->in[14]; C.w_bg = a->in[15]; C.w_out = a->in[16]; C.norm2_g = a->in[17]; C.w_router = a->in[18]; C.b_router = a->in[19];
    C.w_gu = a->in[20]; C.b_gu = a->in[21]; C.w_dn = a->in[22]; C.b_dn = a->in[23]; C.final_g = a->in[24];
    C.out = a->out;
    unsigned char* ws = a->ws;
    C.ctl = (unsigned*)(ws + WS_CTL); C.mod = (float*)(ws + WS_MOD); C.tope = (int*)(ws + WS_TOPE); C.topw = (float*)(ws + WS_TOPW); C.list = (int*)(ws + WS_LIST);
    C.WinT = (bf16*)(ws + WS_WIN); C.WbdT = (bf16*)(ws + WS_WBD); C.WbgT = (bf16*)(ws + WS_WBG); C.WoutT = (bf16*)(ws + WS_WOUT); C.WguT = (bf16*)(ws + WS_WGU); C.WdT = (bf16*)(ws + WS_WD);
    C.H = (bf16*)(ws + WS_H); C.H2 = (bf16*)(ws + WS_H2); C.OA = (bf16*)(ws + WS_OA); C.OB = (bf16*)(ws + WS_OB); C.MG = (bf16*)(ws + WS_MG); C.YB = (bf16*)(ws + WS_YB);
    C.PROJ = (bf16*)(ws + WS_PROJ); C.ACT = (bf16*)(ws + WS_ACT);
    return C;
}
__global__ void __launch_bounds__(NTHREADS, 2) fwd_kernel(Args args) {
    extern __shared__ __attribute__((aligned(16))) unsigned char lds_raw[];
    LAS unsigned char* lds = (LAS unsigned char*)lds_raw;
    for (int u = threadIdx.x; u < (LDS_BYTES - LDSCTL_OFF) / 4; u += NTHREADS) ((LAS unsigned*)(lds + LDSCTL_OFF))[u] = 0u;
    __syncthreads();
    volatile LAS unsigned* MISC = (volatile LAS unsigned*)(lds + MISC_OFF);
    XcdBarrier bar;
    { const Ctx C = make_ctx(lds); bar = xcd_barrier_post(C.ctl + CW_BAR, MISC + 8); }
#define GRID_BAR() xcd_barrier(bar)
    STAMP(0);

    { const Ctx C = make_ctx(lds); phase_mod(C); }
    GRID_BAR(); STAMP(1);
    { const Ctx C = make_ctx(lds); phase_prep(C); }
    GRID_BAR(); STAMP(2);
    { const Ctx C = make_ctx(lds); DenseDesc g{C.H, DM, C.WinT, DM}; TileOrder S; S.init(NTOK / 256, NPROJ / 256, C.G, C.bid); EpiProj E{C.PROJ, C.b_alpha}; gemm_phase<DenseDesc, TileOrder, EpiProj, true>(C.lds, g, S, E); }
    GRID_BAR(); STAMP(3);
    { const Ctx C = make_ctx(lds); for (int s = C.bid; s < 64; s += C.G) gla_chunked(C, s >> 2, s & 3); }
    __syncthreads(); STAMP(12);
    { const Ctx C = make_ctx(lds); attn_phase(C); }
    GRID_BAR(); STAMP(4);
    { const Ctx C = make_ctx(lds); DenseDesc g{C.OA, 512, C.WbdT, 512}; TileOrder S; S.init(NTOK / 256, DM / 256, C.G, C.bid); EpiBranch E{C.MG, C.PROJ, C_GA, 0}; gemm_phase<DenseDesc, TileOrder, EpiBranch, true>(C.lds, g, S, E); }
    GRID_BAR(); STAMP(5);
    { const Ctx C = make_ctx(lds); DenseDesc g{C.OB, 512, C.WbgT, 512}; TileOrder S; S.init(NTOK / 256, DM / 256, C.G, C.bid); EpiBranch E{C.MG, C.PROJ, C_GB, 1}; gemm_phase<DenseDesc, TileOrder, EpiBranch, true>(C.lds, g, S, E); }
    GRID_BAR(); STAMP(6);
    { const Ctx C = make_ctx(lds); DenseDesc g{C.MG, DM, C.WoutT, DM}; TileOrder S; S.init(NTOK / 256, DM / 256, C.G, C.bid); EpiOut E{C.x, C.out, C.mod}; gemm_phase<DenseDesc, TileOrder, EpiOut, true>(C.lds, g, S, E); }
    GRID_BAR(); STAMP(7);
    { const Ctx C = make_ctx(lds); phase_router(C); }
    GRID_BAR(); STAMP(8);
    LAS int* tab = (LAS int*)(lds + STAGE_BYTES);
    __syncthreads();
    if (threadIdx.x == 0) { const Ctx C = make_ctx(lds); int ts = 0; for (int e = 0; e < NE; ++e) { const int cnt = (int)__hip_atomic_load(C.ctl + CW_CNT + 64 * e, RLX_AGENT); tab[e] = cnt; tab[32 + e] = ts; ts += (cnt + 255) >> 8; } tab[64] = ts; }
    __syncthreads();
    { const Ctx C = make_ctx(lds); const int T = tab[64]; MoeUpDesc g{C.H2, C.list, C.WguT, DM}; MoeOrder S; S.t.init(T, 8, C.G, C.bid); S.tab = tab; EpiUp E{C.ACT, C.b_gu}; gemm_phase<MoeUpDesc, MoeOrder, EpiUp, true>(C.lds, g, S, E); }
    GRID_BAR(); STAMP(9);
    { const Ctx C = make_ctx(lds); const int T = tab[64]; MoeDownDesc g{C.ACT, C.WdT, FF}; MoeOrder S; S.t.init(T, 4, C.G, C.bid); S.tab = tab; EpiDown E{C.YB, C.b_dn, C.list}; gemm_phase<MoeDownDesc, MoeOrder, EpiDown, true>(C.lds, g, S, E); }
    GRID_BAR(); STAMP(10);
    { const Ctx C = make_ctx(lds); phase_final(C); }
#if PROBE_A >= 0
    GRID_BAR(); STAMP(11);
    if (blockIdx.x == 0 && threadIdx.x == 0) {
        const Ctx C = make_ctx(lds); const unsigned long long* ts = (const unsigned long long*)(C.ctl + CW_TS);
        asm volatile("s_waitcnt vmcnt(0)" ::: "memory");
        const unsigned long long dt = (PROBE_A == 12) ? ts[12] - ts[3] : ts[PROBE_A + 1] - ts[PROBE_A], t0 = __builtin_amdgcn_s_memrealtime();
        while (__builtin_amdgcn_s_memrealtime() - t0 < 4ull * dt) __builtin_amdgcn_s_sleep(8);
    }
#endif
}

extern "C" void kernel_launch(void* const* d_in, const int* in_sizes, int n_in, void* d_out, int out_size, void* d_ws, size_t ws_size, hipStream_t stream) {
    static int grid = 0;
    if (grid == 0) {
        if (n_in != 25 || in_sizes[0] != NTOK * DM || out_size != NTOK * DM || ws_size < WS_END) {
            fprintf(stderr, "kernel_launch: unexpected shapes (n_in %d, in0 %d, out %d, ws %zu < %zu)\n", n_in, n_in > 0 ? in_sizes[0] : -1, out_size, ws_size, (size_t)WS_END); grid = -1; return; }
        int dev = 0, cus = 0;
        if (hipGetDevice(&dev) != hipSuccess || hipDeviceGetAttribute(&cus, hipDeviceAttributeMultiprocessorCount, dev) != hipSuccess) { grid = -1; return; }
        if (hipFuncSetAttribute((const void*)fwd_kernel, hipFuncAttributeMaxDynamicSharedMemorySize, LDS_BYTES) != hipSuccess) { fprintf(stderr, "kernel_launch: hipFuncSetAttribute failed\n"); grid = -1; return; }
        (void)hipGetLastError();
        grid = cus;
    }
    if (grid < 0) return;
    if (hipMemsetAsync((char*)d_ws + WS_CTL, 0, CTL_ZERO_BYTES, stream) != hipSuccess) { fprintf(stderr, "kernel_launch: memset failed\n"); return; }
    Args a{};
    for (int i = 0; i < 25; ++i) a.in[i] = (const float*)d_in[i];
    a.out = (float*)d_out; a.ws = (unsigned char*)d_ws;
    hipLaunchKernelGGL(fwd_kernel, dim3(grid), dim3(NTHREADS), LDS_BYTES, stream, a);
}
```

```cpp
#include <hip/hip_runtime.h>
#include <cstdio>
#include <cstdint>

#define GAS __attribute__((address_space(1)))
#define LAS __attribute__((address_space(3)))
typedef unsigned short bf16;
typedef short bf16x8 __attribute__((ext_vector_type(8)));
typedef float f32x4 __attribute__((ext_vector_type(4)));
typedef unsigned u32x4 __attribute__((ext_vector_type(4)));
typedef unsigned u32x2 __attribute__((ext_vector_type(2)));
typedef int i32x4 __attribute__((ext_vector_type(4)));
typedef GAS unsigned gu32;

constexpr int NB = 16, SEQ = 2048, DM = 1024, NTOK = NB * SEQ, NE = 32, FF = 1024;
constexpr int NPROJ = 5376;
constexpr int C_DQ = 0, C_DK = 512, C_DV = 1024, C_GQ = 1536, C_GK = 1792, C_GV = 2048, C_GR = 2560, C_GA = 3072, C_GB = 4096, C_AL = 5120;
constexpr int W_IN_N = 5136;
constexpr float LOG2E = 1.4426950408889634f;
constexpr float QSCALE = 0.125f * LOG2E;
constexpr float EPS = 1e-6f;
constexpr int NWAVES = 8, NTHREADS = 512;

constexpr size_t MiB = 1u << 20;
constexpr size_t WS_CTL = 0, CTL_ZERO_BYTES = 1 * MiB;
constexpr size_t WS_MOD = 1 * MiB;
constexpr size_t WS_TOPE = 2 * MiB;
constexpr size_t WS_TOPW = 3 * MiB;
constexpr size_t WS_LIST = 4 * MiB;
constexpr size_t WS_WIN = 8 * MiB;
constexpr size_t WS_WBD = 19 * MiB;
constexpr size_t WS_WBG = 20 * MiB;
constexpr size_t WS_WOUT = 21 * MiB;
constexpr size_t WS_WGU = 24 * MiB;
constexpr size_t WS_WD = 152 * MiB;
constexpr size_t WS_H2 = 216 * MiB;
constexpr size_t WS_RB = 280 * MiB;
constexpr size_t WS_H = WS_RB, WS_OA = WS_RB + 64 * MiB, WS_OB = WS_RB + 96 * MiB, WS_MG = WS_RB + 128 * MiB, WS_YB = WS_RB;
constexpr size_t WS_RA = 536 * MiB;
constexpr size_t WS_PROJ = WS_RA, WS_ACT = WS_RA;
constexpr size_t WS_Y1 = WS_RA + 272 * MiB;
constexpr size_t WS_CB = WS_MOD + 512 * 1024;
constexpr size_t WS_END = 872 * MiB;
constexpr int MAX_TILES = 544;
static_assert((size_t)MAX_TILES * 256 * 1024 * 2 <= 336 * MiB, "act fits region A");
constexpr int CW_CNT = 64;
constexpr int CW_BAR = 4096;
constexpr int CW_QUEUE = 2304;

constexpr int SCR_BYTES = 159744;
constexpr int LDSCTL_OFF = SCR_BYTES, MISC_OFF = LDSCTL_OFF + 320;
constexpr int LDS_BYTES = SCR_BYTES + 1024;

#define RLX_AGENT __ATOMIC_RELAXED, __HIP_MEMORY_SCOPE_AGENT
#define LDS_WAIT() asm volatile("s_waitcnt lgkmcnt(0)" ::: "memory")

__device__ __forceinline__ unsigned f2bf(float f) { unsigned u = __builtin_bit_cast(unsigned, f); return (u + 0x7fffu + ((u >> 16) & 1u)) >> 16; }
typedef __bf16 bf16n2 __attribute__((ext_vector_type(2)));
typedef float f32x2 __attribute__((ext_vector_type(2)));
__device__ __forceinline__ unsigned pk2(float lo, float hi) { return __builtin_bit_cast(unsigned, __builtin_convertvector((f32x2){lo, hi}, bf16n2)); }
__device__ __forceinline__ float bf2f(unsigned b) { return __uint_as_float(b << 16); }
__device__ __forceinline__ float bflo(unsigned w) { return __uint_as_float(w << 16); }
__device__ __forceinline__ float bfhi(unsigned w) { return __uint_as_float(w & 0xffff0000u); }
__device__ __forceinline__ float wave_sum(float v) {
#pragma unroll
    for (int o = 1; o < 64; o <<= 1) v += __shfl_xor(v, o);
    return v;
}
__device__ __forceinline__ int tid_fresh() { int t = threadIdx.x; asm volatile("" : "+v"(t)); return t; }
__device__ __forceinline__ float sigmoidf_(float x) { return 1.f / (1.f + __expf(-x)); }

#define XB_TMO      128
#define XB_XCNT(j)  (256  + 64 * (j))
#define XB_XSUB(j)  (1280 + 64 * (j))
#define XB_XGEN(j)  (2304 + 64 * (j))
#define XB_TOP      3328
#define XB_TOPGEN   3392
#define XCD_BAR_WORDS 3456
#define XB_SPIN_CAP (1u << 22)
__device__ __forceinline__ unsigned xb_ld(unsigned* p)              { return __hip_atomic_load(p, __ATOMIC_RELAXED, __HIP_MEMORY_SCOPE_AGENT); }
__device__ __forceinline__ unsigned xb_add(unsigned* p, unsigned v) { return __hip_atomic_fetch_add(p, v, __ATOMIC_RELAXED, __HIP_MEMORY_SCOPE_AGENT); }
__device__ __forceinline__ unsigned xb_xcc_id() { return (unsigned)__builtin_amdgcn_s_getreg((3 << 11) | 20) & 0xFu; }
#define XB_SPIN(cond, bar) do { unsigned _sp = 0; while (cond) { __builtin_amdgcn_s_sleep(1); \
    if ((++_sp & 255u) == 0u) { if (xb_ld(&(bar)[XB_TMO])) break; if (_sp > XB_SPIN_CAP) { atomicAdd(&(bar)[XB_TMO], 1u); break; } } } } while (0)
struct XcdBarrier { unsigned* bar; unsigned x; volatile LAS unsigned* st; };
__device__ __forceinline__ XcdBarrier xcd_barrier_post(unsigned* bar, volatile LAS unsigned* st) {
    XcdBarrier b; b.bar = bar; b.x = xb_xcc_id(); b.st = st;
    if (threadIdx.x == 0) (void)xb_add(&bar[XB_XCNT(b.x)], 1u);
    return b;
}
__device__ __forceinline__ void xcd_barrier_complete(unsigned* bar, unsigned x, unsigned& nloc, unsigned& nx) {
    const unsigned G = gridDim.x * gridDim.y * gridDim.z;
    unsigned sum, cnt, mine, sp = 0u;
    for (;;) {
        sum = 0u; cnt = 0u; mine = 0u;
#pragma unroll
        for (unsigned j = 0; j < 16; ++j) { const unsigned c = xb_ld(&bar[XB_XCNT(j)]); sum += c; cnt += (c > 0u) ? 1u : 0u; mine = (j == x) ? c : mine; }
        if (sum == G) break;
        __builtin_amdgcn_s_sleep(1);
        if ((++sp & 255u) == 0u) { if (xb_ld(&bar[XB_TMO])) break; if (sp > XB_SPIN_CAP) { atomicAdd(&bar[XB_TMO], 1u); break; } }
    }
    nloc = mine > 0u ? mine : 1u; nx = cnt > 0u ? cnt : 1u;
}
__device__ __forceinline__ void xcd_barrier(const XcdBarrier& b) {
    asm volatile("s_waitcnt vmcnt(0)" ::: "memory");
    __syncthreads();
    if (threadIdx.x == 0) {
        unsigned* bar = b.bar;
        __builtin_amdgcn_s_waitcnt(0);
        unsigned nloc = b.st[0], nx = b.st[1];
        if (nloc == 0u) { xcd_barrier_complete(bar, b.x, nloc, nx); b.st[0] = nloc; b.st[1] = nx; }
        const unsigned old = xb_add(&bar[XB_XSUB(b.x)], 1u);
        const unsigned gen = old / nloc;
        if (old + 1u == (gen + 1u) * nloc) {
            __builtin_amdgcn_fence(__ATOMIC_RELEASE, "agent");
            asm volatile("s_waitcnt vmcnt(0)" ::: "memory");
            const unsigned og = xb_add(&bar[XB_TOP], 1u);
            const unsigned tg = og / nx;
            if (og + 1u == (tg + 1u) * nx) xb_add(&bar[XB_TOPGEN], 1u);
            else XB_SPIN(xb_ld(&bar[XB_TOPGEN]) == tg, bar);
            __builtin_amdgcn_fence(__ATOMIC_ACQUIRE, "agent");
            xb_add(&bar[XB_XGEN(b.x)], 1u);
            asm volatile("s_waitcnt vmcnt(0)" ::: "memory");
        } else {
            XB_SPIN(xb_ld(&bar[XB_XGEN(b.x)]) == gen, bar);
            __builtin_amdgcn_fence(__ATOMIC_ACQUIRE, "agent");
            asm volatile("s_waitcnt vmcnt(0)" ::: "memory");
        }
    }
    __syncthreads();
}

struct Ctx {
    LAS unsigned char* lds;
    int tid, lane, wid, G, bid;
    const float *x, *c, *w_ada, *b_ada, *norm1_g, *w_in, *lq1, *lk1, *lq2, *lk2, *diff_g, *w_alpha_up, *b_alpha, *gla_g,
                *w_bd, *w_bg, *w_out, *norm2_g, *w_router, *b_router, *w_gu, *b_gu, *w_dn, *b_dn, *final_g;
    float* out;
    unsigned* ctl; float* mod; int* tope; float* topw; int* list;
    bf16 *WinT, *WbdT, *WbgT, *WoutT, *WguT, *WdT, *H, *H2, *OA, *OB, *MG, *YB, *PROJ, *ACT, *Y1; float* cb;
};

constexpr int NXCD = 8, WGM = 8;
__host__ __device__ __forceinline__ int perm32(int rho) { const int n = rho >> 4, i = rho & 15; return 8 * (i >> 2) + 4 * n + (i & 3); }
struct Unit { int pm, pn, e, row0, cnt; };
struct TileOrder {
    int nM, nN, nwg, G, c;
    __device__ __forceinline__ void init(int nM_, int nN_, int G_, int c_) { nM = nM_; nN = nN_; nwg = nM * nN; G = G_; c = c_; }
    __device__ __forceinline__ bool next(int i, Unit& u) const {
        const long L = (long)i * G + c; if (L >= nwg) return false;
        int wgid = (int)L; { const int q = nwg / NXCD, r = nwg % NXCD, xcd = wgid % NXCD, off = wgid / NXCD; wgid = (xcd < r ? xcd * (q + 1) : r * (q + 1) + (xcd - r) * q) + off; }
        const int nig = WGM * nN, gid = wgid / nig, fm = gid * WGM, gsz = (nM - fm) < WGM ? (nM - fm) : WGM;
        u.pm = fm + ((wgid % nig) % gsz); u.pn = (wgid % nig) / gsz; u.e = 0; u.row0 = 0; u.cnt = 0; return true;
    }
};
struct MoeOrder {
    TileOrder t; LAS const int* tab;
    __device__ __forceinline__ bool next(int i, Unit& u) const {
        if (!t.next(i, u)) return false;
        int e = 0;
#pragma unroll 1
        for (int k = 1; k < NE; ++k) if (tab[32 + k] <= u.pm) e = k;
        u.e = e; u.row0 = (u.pm - tab[32 + e]) * 256; u.cnt = tab[e]; return true;
    }
};
struct DenseDesc {
    const bf16* A; int lda; const bf16* Bt; int K;
    __device__ __forceinline__ unsigned a_off(const Unit& u, int r) const { return (unsigned)((u.pm * 256 + r) * lda) * 2u; }
    __device__ __forceinline__ const char* a_base(const Unit&) const { return (const char*)A; }
    __device__ __forceinline__ const char* b_base(const Unit& u) const { return (const char*)Bt + (size_t)u.pn * 256 * K * 2; }
};
struct MoeUpDesc {
    const bf16* H2; const int* list; const bf16* WguT; int K;
    __device__ __forceinline__ unsigned a_off(const Unit& u, int r) const { const int slot = u.row0 + r; int tok = 0; if (slot < u.cnt) tok = list[u.e * NTOK + slot] >> 2; return (unsigned)tok * 2048u; }
    __device__ __forceinline__ const char* a_base(const Unit&) const { return (const char*)H2; }
    __device__ __forceinline__ const char* b_base(const Unit& u) const { return (const char*)WguT + ((size_t)u.e * 2048 + (size_t)u.pn * 256) * 1024 * 2; }
};
struct MoeDownDesc {
    const bf16* ACT; const bf16* WdT; int K;
    __device__ __forceinline__ unsigned a_off(const Unit& u, int r) const { return (unsigned)(u.pm * 256 + r) * 2048u; }
    __device__ __forceinline__ const char* a_base(const Unit&) const { return (const char*)ACT; }
    __device__ __forceinline__ const char* b_base(const Unit& u) const { return (const char*)WdT + ((size_t)u.e * 1024 + (size_t)u.pn * 256) * 1024 * 2; }
};

template <class Desc, class Order, class Epi>
__device__ __forceinline__ void gemm_simple(const Desc& g, const Order& S, const Epi& E) {
    const int tid = threadIdx.x, wid = __builtin_amdgcn_readfirstlane(tid >> 6), lane = tid & 63, wr = wid >> 2, wc = wid & 3, fr = lane & 15, fq = lane >> 4;
    const int K = g.K;
    Unit u;
    for (int i = 0; S.next(i, u); ++i) {
        f32x4 acc[2][2][4][2];
#pragma unroll
        for (int a = 0; a < 2; ++a)
#pragma unroll
            for (int b = 0; b < 2; ++b)
#pragma unroll
                for (int m = 0; m < 4; ++m)
#pragma unroll
                    for (int n = 0; n < 2; ++n) acc[a][b][m][n] = (f32x4){0.f, 0.f, 0.f, 0.f};
        unsigned aoff[2][4], boff[2][2];
#pragma unroll
        for (int a = 0; a < 2; ++a)
#pragma unroll
            for (int m = 0; m < 4; ++m) aoff[a][m] = g.a_off(u, a * 128 + wr * 64 + m * 16 + fr) + fq * 16;
#pragma unroll
        for (int b = 0; b < 2; ++b)
#pragma unroll
            for (int n = 0; n < 2; ++n) { const int nc = b * 128 + wc * 32 + (Epi::PERM ? perm32(n * 16 + fr) : (n * 16 + fr)); boff[b][n] = (unsigned)(nc * K) * 2u + fq * 16; }
        const char* ab = g.a_base(u); const char* bb = g.b_base(u);
#pragma unroll 1
        for (int ks = 0; ks < K / 32; ++ks) {
            bf16x8 af[2][4], bfr[2][2];
#pragma unroll
            for (int a = 0; a < 2; ++a)
#pragma unroll
                for (int m = 0; m < 4; ++m) af[a][m] = *(const bf16x8*)(ab + aoff[a][m] + ks * 64);
#pragma unroll
            for (int b = 0; b < 2; ++b)
#pragma unroll
                for (int n = 0; n < 2; ++n) bfr[b][n] = *(const bf16x8*)(bb + boff[b][n] + ks * 64);
#pragma unroll
            for (int a = 0; a < 2; ++a)
#pragma unroll
                for (int b = 0; b < 2; ++b)
#pragma unroll
                    for (int m = 0; m < 4; ++m)
#pragma unroll
                        for (int n = 0; n < 2; ++n) acc[a][b][m][n] = __builtin_amdgcn_mfma_f32_16x16x32_bf16(bfr[b][n], af[a][m], acc[a][b][m][n], 0, 0, 0);
        }
        E(acc, u, wr, wc, fr, fq);
    }
}


#ifndef PROBE_A
#define PROBE_A -1
#endif
#if PROBE_A >= 100
#define PSTAMP(ldsp, idx) do { if (blockIdx.x == 0 && threadIdx.x == 0) { volatile LAS unsigned* pm_ = (volatile LAS unsigned*)((ldsp) + MISC_OFF); const unsigned now_ = (unsigned)__builtin_amdgcn_s_memrealtime(); pm_[16 + (idx)] += now_ - pm_[15]; pm_[15] = now_; } } while (0)
#else
#define PSTAMP(ldsp, idx) do {} while (0)
#endif
constexpr int BK = 64, HALF = 128, HTB = HALF * BK * 2, STAGE_BYTES = 8 * HTB;
__host__ __device__ __forceinline__ int lds_byte(int r, int c) { const int st = (r >> 4) * 2 + (c >> 5), rr = r & 15, cc = c & 31, ob = rr * 64 + cc * 2; return st * 1024 + (ob ^ (((ob >> 9) & 1) << 5)); }
__host__ __device__ __forceinline__ void stage_rc(int b, int& R, int& C) { const int st = b / 1024, sb = b % 1024, swz = sb ^ (((sb >> 9) & 1) << 5); R = (st >> 1) * 16 + swz / 64; C = (st & 1) * 32 + (swz % 64) / 2; }

template <class Desc, class Order, class Epi, bool ALIGN_EPI>
__device__ __forceinline__ void gemm_phase(LAS unsigned char* lds, const Desc& g, const Order& S, const Epi& E) {
    const int tid = tid_fresh(), wid = __builtin_amdgcn_readfirstlane(tid >> 6), lane = tid & 63, wr = wid >> 2, wc = wid & 3, fr = lane & 15, fq = lane >> 4;
    const int K = g.K, nt = K / BK;
    int Rs[2], Cs[2]; unsigned voffB[2];
#pragma unroll
    for (int i = 0; i < 2; ++i) { stage_rc(tid * 16 + i * 8192, Rs[i], Cs[i]); const int Rb = Epi::PERM ? ((Rs[i] & ~31) + perm32(Rs[i] & 31)) : Rs[i]; voffB[i] = (unsigned)(Rb * K + Cs[i]) * 2u; }
    unsigned vA[2][2];
    LAS u32x4* const vslot = (LAS u32x4*)(lds + STAGE_BYTES + 1024) + tid;
    const size_t kstep = (size_t)(BK * 2);
    const size_t hstepB = (size_t)HALF * K * 2;
    const unsigned ldsw = (unsigned)wid * 1024u;
    const int aoff = lds_byte(wr * 64 + fr, fq * 8), boff = lds_byte(wc * 32 + fr, fq * 8);
#define PG8_SA(b, h) (((b) * 2 + (h)) * HTB)
#define PG8_SB(b, h) ((4 + (b) * 2 + (h)) * HTB)
#define PG8_STAGE(bufoff, gbase, voff) do { _Pragma("unroll") for (int _i = 0; _i < 2; ++_i) \
        __builtin_amdgcn_global_load_lds((const unsigned*)((const char*)(gbase) + (voff)[_i]), (LAS unsigned*)(lds + (bufoff) + ldsw + _i * 8192), 16, 0, 0); } while (0)
#define PG8_STAGE_A(bufoff, gbase, h) do { _Pragma("unroll") for (int _i = 0; _i < 2; ++_i) \
        __builtin_amdgcn_global_load_lds((const unsigned*)((const char*)(gbase) + vA[h][_i]), (LAS unsigned*)(lds + (bufoff) + ldsw + _i * 8192), 16, 0, 0); } while (0)
#define PG8_LDA(dst, b, h) do { _Pragma("unroll") for (int m = 0; m < 4; ++m) _Pragma("unroll") for (int k = 0; k < 2; ++k) dst[m][k] = *(const LAS bf16x8*)(lds + PG8_SA(b, h) + aoff + m * 2048 + k * 1024); } while (0)
#define PG8_LDB(dst, b, h) do { _Pragma("unroll") for (int n = 0; n < 2; ++n) _Pragma("unroll") for (int k = 0; k < 2; ++k) dst[n][k] = *(const LAS bf16x8*)(lds + PG8_SB(b, h) + boff + n * 2048 + k * 1024); } while (0)
#define PG8_MMA(ai, bj, At, Bt) do { __builtin_amdgcn_s_setprio(1); _Pragma("unroll") for (int m = 0; m < 4; ++m) _Pragma("unroll") for (int n = 0; n < 2; ++n) _Pragma("unroll") for (int k = 0; k < 2; ++k) \
        acc[ai][bj][m][n] = __builtin_amdgcn_mfma_f32_16x16x32_bf16(Bt[n][k], At[m][k], acc[ai][bj][m][n], 0, 0, 0); __builtin_amdgcn_s_setprio(0); } while (0)
#define PG8_WAIT_V(n) asm volatile("s_waitcnt vmcnt(" #n ")" ::: "memory")
#define PG8_WAIT_L(n) asm volatile("s_waitcnt lgkmcnt(" #n ")" ::: "memory")
#define PG8_BAR __builtin_amdgcn_s_barrier()
#define PG8_SCHED __builtin_amdgcn_sched_barrier(0)
#define PG8_AOFFS(dst, un) do { _Pragma("unroll") for (int _h = 0; _h < 2; ++_h) _Pragma("unroll") for (int _i = 0; _i < 2; ++_i) dst[_h][_i] = g.a_off(un, _h * HALF + Rs[_i]) + (unsigned)Cs[_i] * 2u; } while (0)
    Unit cur, nxt; int ui = 0;
    if (!S.next(0, cur)) return;
    f32x4 acc[2][2][4][2];
#pragma unroll
    for (int a = 0; a < 2; ++a)
#pragma unroll
        for (int b = 0; b < 2; ++b)
#pragma unroll
            for (int m = 0; m < 4; ++m)
#pragma unroll
                for (int n = 0; n < 2; ++n) acc[a][b][m][n] = (f32x4){0.f, 0.f, 0.f, 0.f};
    bf16x8 At[4][2], B0[2][2], B1[2][2];
    const char* const Ab = g.a_base(cur);
    const char* cB = g.b_base(cur);
    PG8_AOFFS(vA, cur);
    PG8_STAGE(PG8_SB(0, 0), cB, voffB); PG8_STAGE(PG8_SB(0, 1), cB + hstepB, voffB); PG8_STAGE_A(PG8_SA(0, 0), Ab, 0); PG8_STAGE_A(PG8_SA(0, 1), Ab, 1);
    if (wr == 1) PG8_BAR;
    PG8_WAIT_V(2); PG8_BAR;
    PG8_STAGE(PG8_SB(1, 0), cB + kstep, voffB); PG8_STAGE_A(PG8_SA(1, 0), Ab + kstep, 0); PG8_STAGE(PG8_SB(1, 1), cB + hstepB + kstep, voffB);
    PG8_WAIT_V(6); PG8_BAR;
    for (;;) {
        const bool has_next = S.next(ui + 1, nxt);
        const char* nB = has_next ? g.b_base(nxt) : cB;
        if (has_next) { unsigned vn[2][2]; PG8_AOFFS(vn, nxt); *vslot = (u32x4){vn[0][0], vn[0][1], vn[1][0], vn[1][1]}; }
        PSTAMP(lds, 8);
        for (int t = 0; t < nt; t += 2) {
            const bool last = (t == nt - 2);
            const char* a1 = Ab + (size_t)(t + 1) * kstep;
            const char* a2 = last ? Ab : Ab + (size_t)(t + 2) * kstep; const char* b2 = last ? nB : cB + (size_t)(t + 2) * kstep;
            const char* a3 = a2 + kstep; const char* b3 = b2 + kstep;
            PG8_LDB(B0, 0, 0); PG8_LDB(B1, 0, 1); PG8_SCHED; PG8_LDA(At, 0, 0); PG8_STAGE_A(PG8_SA(1, 1), a1, 1);
            if (last && has_next) { const u32x4 vn = *vslot; vA[0][0] = vn.x; vA[0][1] = vn.y; vA[1][0] = vn.z; vA[1][1] = vn.w; }
            PG8_WAIT_V(8); PG8_WAIT_L(0); PG8_BAR; PG8_MMA(0, 0, At, B0); PG8_MMA(0, 1, At, B1); PG8_BAR; PG8_SCHED;
            PG8_LDA(At, 0, 1); PG8_STAGE(PG8_SB(0, 0), b2, voffB); PG8_STAGE(PG8_SB(0, 1), b2 + hstepB, voffB); PG8_STAGE_A(PG8_SA(0, 0), a2, 0);
            PG8_WAIT_V(8); PG8_WAIT_L(0); PG8_BAR; PG8_MMA(1, 0, At, B0); PG8_MMA(1, 1, At, B1); PG8_BAR; PG8_SCHED;
            PG8_LDB(B0, 1, 0); PG8_LDB(B1, 1, 1); PG8_SCHED; PG8_LDA(At, 1, 0); PG8_STAGE_A(PG8_SA(0, 1), a2, 1);
            PG8_WAIT_V(8); PG8_WAIT_L(0); PG8_BAR; PG8_MMA(0, 0, At, B0); PG8_MMA(0, 1, At, B1); PG8_BAR; PG8_SCHED;
            PG8_LDA(At, 1, 1); PG8_STAGE(PG8_SB(1, 0), b3, voffB); PG8_STAGE(PG8_SB(1, 1), b3 + hstepB, voffB); PG8_STAGE_A(PG8_SA(1, 0), a3, 0);
            PG8_WAIT_V(8); PG8_WAIT_L(0); PG8_BAR; PG8_MMA(1, 0, At, B0); PG8_MMA(1, 1, At, B1); PG8_BAR; PG8_SCHED;
        }
        PSTAMP(lds, 6);
        if constexpr (ALIGN_EPI) { if (wr == 0) PG8_BAR; }
        E(acc, cur, wr, wc, fr, fq);
        PSTAMP(lds, 7);
        if (!has_next) break;
#pragma unroll
        for (int a = 0; a < 2; ++a)
#pragma unroll
            for (int b = 0; b < 2; ++b)
#pragma unroll
                for (int m = 0; m < 4; ++m)
#pragma unroll
                    for (int n = 0; n < 2; ++n) acc[a][b][m][n] = (f32x4){0.f, 0.f, 0.f, 0.f};
        cur = nxt; cB = nB; ++ui;
        if constexpr (ALIGN_EPI) { if (wr == 1) PG8_BAR; }
    }
    PG8_WAIT_V(0);
    if constexpr (!ALIGN_EPI) { if (wr == 0) PG8_BAR; }
    PG8_BAR;
#undef PG8_SA
#undef PG8_SB
#undef PG8_STAGE
#undef PG8_STAGE_A
#undef PG8_LDA
#undef PG8_LDB
#undef PG8_MMA
#undef PG8_WAIT_V
#undef PG8_WAIT_L
#undef PG8_BAR
#undef PG8_SCHED
#undef PG8_AOFFS
}

__device__ __forceinline__ u32x4 pack8(const f32x4& v0, const f32x4& v1) { u32x4 w; w.x = pk2(v0[0], v0[1]); w.y = pk2(v0[2], v0[3]); w.z = pk2(v1[0], v1[1]); w.w = pk2(v1[2], v1[3]); return w; }
__device__ __forceinline__ void unpack8(const u32x4& w, f32x4& v0, f32x4& v1) { v0 = (f32x4){bflo(w.x), bfhi(w.x), bflo(w.y), bfhi(w.y)}; v1 = (f32x4){bflo(w.z), bfhi(w.z), bflo(w.w), bfhi(w.w)}; }
__device__ __forceinline__ float logsig16(float x) { return (fminf(x, 0.f) - log1pf(__expf(-fabsf(x)))) * (1.f / 16.f); }

struct EpiProj {
    static constexpr bool PERM = true;
    bf16* P; const float* b_alpha;
    __device__ __forceinline__ void operator()(const f32x4 (&acc)[2][2][4][2], const Unit& u, int wr, int wc, int fr, int fq) const {
        const int pn = u.pn; const int mode = (pn < 2) ? 1 : (pn == 6 ? 2 : (pn == 20 ? 3 : 0));
#pragma unroll
        for (int bj = 0; bj < 2; ++bj) {
            const int c0 = pn * 256 + bj * 128 + wc * 32 + 8 * fq;
            f32x4 b0 = (f32x4){0.f, 0.f, 0.f, 0.f}, b1 = b0;
            if (mode == 3) { b0 = *(const f32x4*)(b_alpha + (c0 - C_AL)); b1 = *(const f32x4*)(b_alpha + (c0 - C_AL) + 4); }
#pragma unroll
            for (int ai = 0; ai < 2; ++ai)
#pragma unroll
                for (int m = 0; m < 4; ++m) {
                    const int row = u.pm * 256 + ai * 128 + wr * 64 + m * 16 + fr;
                    f32x4 v0 = acc[ai][bj][m][0], v1 = acc[ai][bj][m][1];
                    if (mode == 1) { v0 = v0 * QSCALE; v1 = v1 * QSCALE; }
                    else if (mode == 2) { v0 = v0 * 0.125f; v1 = v1 * 0.125f; }
                    else if (mode == 3) {
#pragma unroll
                        for (int j = 0; j < 4; ++j) { v0[j] = logsig16(v0[j] + b0[j]); v1[j] = logsig16(v1[j] + b1[j]); } }
                    *(u32x4*)(P + (size_t)row * NPROJ + c0) = pack8(v0, v1);
                }
        }
    }
};
struct EpiBranch {
    static constexpr bool PERM = true;
    bf16* MG; const bf16* P; int gcol; int add;
    __device__ __forceinline__ void operator()(const f32x4 (&acc)[2][2][4][2], const Unit& u, int wr, int wc, int fr, int fq) const {
#pragma unroll
        for (int ai = 0; ai < 2; ++ai)
#pragma unroll
            for (int m = 0; m < 4; ++m) {
                const int row = u.pm * 256 + ai * 128 + wr * 64 + m * 16 + fr;
#pragma unroll
                for (int bj = 0; bj < 2; ++bj) {
                    const int c0 = u.pn * 256 + bj * 128 + wc * 32 + 8 * fq;
                    const u32x4 gw = *(const u32x4*)(P + (size_t)row * NPROJ + gcol + c0);
                    f32x4 g0, g1; unpack8(gw, g0, g1);
                    f32x4 v0 = acc[ai][bj][m][0], v1 = acc[ai][bj][m][1];
#pragma unroll
                    for (int j = 0; j < 4; ++j) { v0[j] *= sigmoidf_(g0[j]); v1[j] *= sigmoidf_(g1[j]); }
                    bf16* dst = MG + (size_t)row * DM + c0;
                    if (add) { const u32x4 ow = *(const u32x4*)dst; f32x4 o0, o1; unpack8(ow, o0, o1); v0 = v0 + o0; v1 = v1 + o1; }
                    *(u32x4*)dst = pack8(v0, v1);
                }
            }
    }
};
struct EpiOut {
    static constexpr bool PERM = true;
    bf16* Y1; const float* mod;
    __device__ __forceinline__ void operator()(const f32x4 (&acc)[2][2][4][2], const Unit& u, int wr, int wc, int fr, int fq) const {
        const int b = u.pm >> 3; const float* gt1 = mod + b * 6144 + 2048;
#pragma unroll
        for (int bj = 0; bj < 2; ++bj) {
            const int c0 = u.pn * 256 + bj * 128 + wc * 32 + 8 * fq;
            const f32x4 g0 = *(const f32x4*)(gt1 + c0), g1 = *(const f32x4*)(gt1 + c0 + 4);
#pragma unroll
            for (int ai = 0; ai < 2; ++ai)
#pragma unroll
                for (int m = 0; m < 4; ++m) {
                    const int row = u.pm * 256 + ai * 128 + wr * 64 + m * 16 + fr;
                    *(u32x4*)(Y1 + (size_t)row * DM + c0) = pack8(acc[ai][bj][m][0] * g0, acc[ai][bj][m][1] * g1);
                }
        }
    }
};
struct EpiUp {
    static constexpr bool PERM = true;
    bf16* ACT; const float* b_gu;
    __device__ __forceinline__ void operator()(const f32x4 (&acc)[2][2][4][2], const Unit& u, int wr, int wc, int fr, int fq) const {
        const int f0 = u.pn * 128 + wc * 32 + 8 * fq;
        const float* bg = b_gu + (size_t)u.e * 2048 + f0; const float* bu = bg + 1024;
        const f32x4 bg0 = *(const f32x4*)bg, bg1 = *(const f32x4*)(bg + 4), bu0 = *(const f32x4*)bu, bu1 = *(const f32x4*)(bu + 4);
#pragma unroll
        for (int ai = 0; ai < 2; ++ai)
#pragma unroll
            for (int m = 0; m < 4; ++m) {
                const int r = ai * 128 + wr * 64 + m * 16 + fr;
                f32x4 g0 = acc[ai][0][m][0] + bg0, g1 = acc[ai][0][m][1] + bg1, u0 = acc[ai][1][m][0] + bu0, u1 = acc[ai][1][m][1] + bu1, a0, a1;
#pragma unroll
                for (int j = 0; j < 4; ++j) {
                    float gg = fminf(g0[j], 7.f), uu = fminf(fmaxf(u0[j], -7.f), 7.f); a0[j] = (uu + 1.f) * gg * sigmoidf_(1.702f * gg);
                    gg = fminf(g1[j], 7.f); uu = fminf(fmaxf(u1[j], -7.f), 7.f); a1[j] = (uu + 1.f) * gg * sigmoidf_(1.702f * gg); }
                *(u32x4*)(ACT + (size_t)(u.pm * 256 + r) * FF + f0) = pack8(a0, a1);
            }
    }
};
struct EpiDown {
    static constexpr bool PERM = true;
    bf16* YB; const float* b_dn; const int* list;
    __device__ __forceinline__ void operator()(const f32x4 (&acc)[2][2][4][2], const Unit& u, int wr, int wc, int fr, int fq) const {
#pragma unroll
        for (int ai = 0; ai < 2; ++ai)
#pragma unroll
            for (int m = 0; m < 4; ++m) {
                const int slot = u.row0 + ai * 128 + wr * 64 + m * 16 + fr;
                if (slot < u.cnt) {
                    const int aid = list[u.e * NTOK + slot];
#pragma unroll
                    for (int bj = 0; bj < 2; ++bj) {
                        const int c0 = u.pn * 256 + bj * 128 + wc * 32 + 8 * fq;
                        const float* bp = b_dn + (size_t)u.e * DM + c0;
                        const f32x4 v0 = acc[ai][bj][m][0] + *(const f32x4*)bp, v1 = acc[ai][bj][m][1] + *(const f32x4*)(bp + 4);
                        *(u32x4*)(YB + (size_t)aid * DM + c0) = pack8(v0, v1);
                    }
                }
            }
    }
};

constexpr int T_NITEMS = 16 * 80 + 2 * 8 * 16 + 16 * 16 + 32 * 16 * 32 + 32 * 16 * 16;
__device__ __forceinline__ void transposes(const Ctx& C, int i0, int i1, int w, int nw);
__device__ __forceinline__ void phase_mod(const Ctx& C) {
    LAS float* sc = (LAS float*)C.lds;
    LAS float* red = sc + 16 * 1024;
    for (int cb = C.bid; cb < 96; cb += C.G) {
        __syncthreads();
        for (int i = C.tid; i < 16 * 1024; i += NTHREADS) { const float v = C.c[i]; sc[i] = v / (1.f + __expf(-v)); }
        __syncthreads();
        const int cl = C.tid & 63, ks = C.tid >> 6, col = cb * 64 + cl;
        float acc[16];
#pragma unroll
        for (int b = 0; b < 16; ++b) acc[b] = 0.f;
#pragma unroll 2
        for (int k = ks * 128; k < ks * 128 + 128; k += 4) {
            const float w0 = C.w_ada[(size_t)k * 6144 + col], w1 = C.w_ada[(size_t)(k + 1) * 6144 + col], w2 = C.w_ada[(size_t)(k + 2) * 6144 + col], w3 = C.w_ada[(size_t)(k + 3) * 6144 + col];
#pragma unroll
            for (int b = 0; b < 16; ++b) { const f32x4 s4 = *(const LAS f32x4*)(sc + b * 1024 + k); acc[b] += (s4[0] * w0 + s4[1] * w1) + (s4[2] * w2 + s4[3] * w3); }
        }
#pragma unroll
        for (int b = 0; b < 16; ++b) red[(ks * 16 + b) * 64 + cl] = acc[b];
        __syncthreads();
        for (int o = C.tid; o < 1024; o += NTHREADS) {
            const int b = o >> 6, c2 = o & 63; float s = 0.f;
#pragma unroll
            for (int k2 = 0; k2 < 8; ++k2) s += red[(k2 * 16 + b) * 64 + c2];
            C.mod[b * 6144 + cb * 64 + c2] = s + C.b_ada[cb * 64 + c2];
        }
    }
    __syncthreads();
    { const int gw = C.bid * NWAVES + C.wid, NGW = C.G * NWAVES;
      if (C.G == 256) { constexpr int N1 = 11 * 2048; transposes(C, 0, N1, gw, NGW); if (C.bid >= 96) transposes(C, N1, T_NITEMS, gw - 96 * NWAVES, NGW - 96 * NWAVES); }
      else transposes(C, 0, T_NITEMS, gw, NGW); }
    for (int gt = C.bid * NTHREADS + C.tid; gt < 256 * 512; gt += C.G * NTHREADS) {
        const int j = gt >> 9, k = (gt & 511) * 2;
        float s0 = 0.f, s1 = 0.f;
#pragma unroll
        for (int r = 0; r < 16; ++r) { const float wa = C.w_alpha_up[r * 256 + j]; s0 += C.w_in[(size_t)k * W_IN_N + 3072 + r] * wa; s1 += C.w_in[(size_t)(k + 1) * W_IN_N + 3072 + r] * wa; }
        *(unsigned*)(C.WinT + (size_t)(C_AL + j) * DM + k) = pk2(s0, s1);
    }
}

struct TItem { const float* src; bf16* dst; int srcN, Kp; };
__device__ __forceinline__ TItem titem_decode(const Ctx& C, int it) {
    constexpr int I_IN = 16 * 80, I_BD = 8 * 16, I_OUT = 16 * 16, I_GU = 32 * 16 * 32;
    TItem t; int r = it;
    if (r < I_IN) { const int kb = r / 80, n0 = (r % 80) * 64; t.srcN = W_IN_N; t.Kp = DM; t.src = C.w_in + (size_t)(kb * 64) * W_IN_N + (n0 < 3072 ? n0 : n0 + 16); t.dst = C.WinT + (size_t)n0 * DM + kb * 64; return t; } r -= I_IN;
    if (r < I_BD) { t.srcN = DM; t.Kp = 512; t.src = C.w_bd + (size_t)((r >> 4) * 64) * DM + (r & 15) * 64; t.dst = C.WbdT + (size_t)((r & 15) * 64) * 512 + (r >> 4) * 64; return t; } r -= I_BD;
    if (r < I_BD) { t.srcN = DM; t.Kp = 512; t.src = C.w_bg + (size_t)((r >> 4) * 64) * DM + (r & 15) * 64; t.dst = C.WbgT + (size_t)((r & 15) * 64) * 512 + (r >> 4) * 64; return t; } r -= I_BD;
    if (r < I_OUT) { t.srcN = DM; t.Kp = DM; t.src = C.w_out + (size_t)((r >> 4) * 64) * DM + (r & 15) * 64; t.dst = C.WoutT + (size_t)((r & 15) * 64) * DM + (r >> 4) * 64; return t; } r -= I_OUT;
    if (r < I_GU) { const int e = r >> 9, rr = r & 511, kb = rr >> 5, n0 = (rr & 31) * 64; const int pn = n0 >> 8, bj = (n0 >> 7) & 1, j0 = n0 & 127;
        t.srcN = 2048; t.Kp = DM; t.src = C.w_gu + (size_t)e * DM * 2048 + (size_t)(kb * 64) * 2048 + bj * 1024 + pn * 128 + j0; t.dst = C.WguT + (size_t)e * 2048 * DM + (size_t)n0 * DM + kb * 64; return t; } r -= I_GU;
    { const int e = r >> 8, rr = r & 255, kb = rr >> 4, n0 = (rr & 15) * 64;
        t.srcN = DM; t.Kp = FF; t.src = C.w_dn + (size_t)e * FF * DM + (size_t)(kb * 64) * DM + n0; t.dst = C.WdT + (size_t)e * DM * FF + (size_t)n0 * FF + kb * 64; return t; }
}
__device__ __forceinline__ void titem_load(const TItem& t, int lane, f32x4 (&v)[16]) {
#pragma unroll
    for (int i = 0; i < 16; ++i) v[i] = *(const f32x4*)(t.src + (size_t)(4 * i + (lane >> 4)) * t.srcN + 4 * (lane & 15));
}
__device__ __forceinline__ void titem_store(const TItem& t, int lane, const f32x4 (&v)[16], LAS float* scr) {
#pragma unroll
    for (int i = 0; i < 16; ++i) { LAS float* p = scr + (4 * i + (lane >> 4)) * 65 + 4 * (lane & 15); p[0] = v[i][0]; p[1] = v[i][1]; p[2] = v[i][2]; p[3] = v[i][3]; }
    LDS_WAIT(); asm volatile("" ::: "memory");
    const int c = lane & 7;
#pragma unroll
    for (int j = 0; j < 8; ++j) { const int n = (lane >> 3) + 8 * j; const LAS float* s = scr + (8 * c) * 65 + n;
        u32x4 o; o.x = pk2(s[0 * 65], s[1 * 65]); o.y = pk2(s[2 * 65], s[3 * 65]); o.z = pk2(s[4 * 65], s[5 * 65]); o.w = pk2(s[6 * 65], s[7 * 65]);
        *(u32x4*)(t.dst + (size_t)n * t.Kp + 8 * c) = o; }
    LDS_WAIT(); asm volatile("" ::: "memory");
}
__device__ __forceinline__ void transposes(const Ctx& C, int i0, int i1, int w, int nw) {
    LAS float* scr = (LAS float*)(C.lds + C.wid * 16896);
    int it = i0 + w; if (it >= i1) return;
    TItem cur = titem_decode(C, it); f32x4 v[16]; titem_load(cur, C.lane, v);
    for (;;) {
        const int nit = it + nw; const bool more = nit < i1;
        TItem nxt = cur; f32x4 vn[16];
        if (more) { nxt = titem_decode(C, nit); titem_load(nxt, C.lane, vn); }
        titem_store(cur, C.lane, v, scr);
        if (!more) break;
        cur = nxt; it = nit;
#pragma unroll
        for (int i = 0; i < 16; ++i) v[i] = vn[i];
    }
}
__device__ __forceinline__ void phase_prep(const Ctx& C) {
    const int gw = C.bid * NWAVES + C.wid, NGW = C.G * NWAVES;
    for (int row = gw; row < NTOK; row += 2 * NGW) {
        const int row2 = row + NGW;
        const bool two = row2 < NTOK;
        f32x4 v[2][4]; float ss[2] = {0.f, 0.f};
#pragma unroll
        for (int j = 0; j < 4; ++j) { v[0][j] = *(const f32x4*)(C.x + (size_t)row * DM + 4 * C.lane + 256 * j); v[1][j] = two ? *(const f32x4*)(C.x + (size_t)row2 * DM + 4 * C.lane + 256 * j) : (f32x4){0.f, 0.f, 0.f, 0.f}; }
#pragma unroll
        for (int r = 0; r < 2; ++r)
#pragma unroll
            for (int j = 0; j < 4; ++j) ss[r] += (v[r][j][0] * v[r][j][0] + v[r][j][1] * v[r][j][1]) + (v[r][j][2] * v[r][j][2] + v[r][j][3] * v[r][j][3]);
#pragma unroll
        for (int r = 0; r < 2; ++r) { if (r == 1 && !two) break;
            const int rw = r ? row2 : row; const int b = rw >> 11; const float* md = C.mod + b * 6144;
            const float rstd = rsqrtf(wave_sum(ss[r]) * (1.f / DM) + EPS);
#pragma unroll
            for (int j = 0; j < 4; ++j) { const int c0 = 4 * C.lane + 256 * j;
                const f32x4 g = *(const f32x4*)(C.norm1_g + c0), sc = *(const f32x4*)(md + 1024 + c0), sh = *(const f32x4*)(md + c0);
                const f32x4 y = v[r][j] * rstd * g * (sc + 1.f) + sh;
                u32x2 o; o.x = pk2(y[0], y[1]); o.y = pk2(y[2], y[3]);
                *(u32x2*)(C.H + (size_t)rw * DM + c0) = o; } }
    }
}

__device__ __forceinline__ void gla_scan(const Ctx& C, int b, int h) {
    LAS float* qs = (LAS float*)C.lds;
    LAS float* ks = qs + 2048;
    LAS float* al = ks + 2048;
    LAS float* vs = al + 2048;
    LAS float* part = vs + 4096;
    const int dv = C.tid & 127, dkg = C.tid >> 7;
    float S[16];
#pragma unroll
    for (int j = 0; j < 16; ++j) S[j] = 0.f;
    const float gdv0 = C.gla_g[2 * C.lane], gdv1 = C.gla_g[2 * C.lane + 1];
    for (int ch = 0; ch < SEQ / 32; ++ch) {
        const int row0 = b * SEQ + ch * 32;
        __syncthreads();
        for (int i = C.tid; i < 32 * 64; i += NTHREADS) { const int t = i >> 6, d = i & 63; const bf16* pr = C.PROJ + (size_t)(row0 + t) * NPROJ;
            qs[i] = bf2f(pr[C_GQ + h * 64 + d]); ks[i] = bf2f(pr[C_GK + h * 64 + d]); al[i] = __expf(bf2f(pr[C_AL + h * 64 + d])); }
        for (int i = C.tid; i < 32 * 128; i += NTHREADS) { const int t = i >> 7, d = i & 127; vs[i] = bf2f(C.PROJ[(size_t)(row0 + t) * NPROJ + C_GV + h * 128 + d]); }
        __syncthreads();
#pragma unroll 2
        for (int t = 0; t < 32; ++t) {
            const float v = vs[t * 128 + dv]; float o = 0.f;
#pragma unroll
            for (int j4 = 0; j4 < 4; ++j4) {
                const f32x4 a4 = *(const LAS f32x4*)(al + t * 64 + dkg * 16 + j4 * 4), k4 = *(const LAS f32x4*)(ks + t * 64 + dkg * 16 + j4 * 4), q4 = *(const LAS f32x4*)(qs + t * 64 + dkg * 16 + j4 * 4);
#pragma unroll
                for (int jj = 0; jj < 4; ++jj) { const int j = j4 * 4 + jj; S[j] = a4[jj] * S[j] + k4[jj] * v; o += q4[jj] * S[j]; }
            }
            part[(dkg * 32 + t) * 128 + dv] = o;
        }
        __syncthreads();
#pragma unroll
        for (int tt = 0; tt < 4; ++tt) {
            const int t = 4 * C.wid + tt; float o0 = 0.f, o1 = 0.f;
#pragma unroll
            for (int g = 0; g < 4; ++g) { o0 += part[(g * 32 + t) * 128 + 2 * C.lane]; o1 += part[(g * 32 + t) * 128 + 2 * C.lane + 1]; }
            const float rstd = rsqrtf(wave_sum(o0 * o0 + o1 * o1) * (1.f / 128.f) + EPS);
            const unsigned grw = *(const unsigned*)(C.PROJ + (size_t)(row0 + t) * NPROJ + C_GR + h * 128 + 2 * C.lane);
            const float g0 = bflo(grw), g1 = bfhi(grw);
            const float y0 = o0 * rstd * gdv0 * (g0 * sigmoidf_(g0)), y1 = o1 * rstd * gdv1 * (g1 * sigmoidf_(g1));
            *(unsigned*)(C.OB + (size_t)(row0 + t) * 512 + h * 128 + 2 * C.lane) = pk2(y0, y1);
        }
    }
}

__device__ __forceinline__ void attn_simple(const Ctx& C) {
    LAS float* Kt = (LAS float*)C.lds;
    LAS float* Vt = Kt + 8192;
    LAS float* Ss = Vt + 8192;
    LAS float* ssq = Ss + 2 * 64 * 68;
    LAS float* lamp = ssq + 256;
    if (C.tid < 64) {
        const float a = wave_sum(C.lq1[C.lane] * C.lk1[C.lane]), b2 = wave_sum(C.lq2[C.lane] * C.lk2[C.lane]);
        if (C.tid == 0) lamp[0] = __expf(a) - __expf(b2) + 0.2f;
    }
    __syncthreads();
    const float lam = lamp[0];
    const int q = C.tid & 63, p = (C.tid >> 6) & 1, dq = C.tid >> 7;
    for (int uix = C.bid; uix < 2048; uix += C.G) {
        const int bh = uix & 63, g = (uix >> 6) & 3, i2 = uix >> 8; const int b = bh >> 2, h = bh & 3;
        const int qc = (i2 & 1) ? (31 - (4 * g + (i2 >> 1))) : (4 * g + (i2 >> 1));
        const float sl2 = exp2f(-2.f * (float)(h + 1)) * LOG2E;
        const int qrow = b * SEQ + qc * 64 + q;
        float qv[64];
#pragma unroll
        for (int d8 = 0; d8 < 8; ++d8) { const u32x4 w = *(const u32x4*)(C.PROJ + (size_t)qrow * NPROJ + C_DQ + h * 128 + p * 64 + d8 * 8);
            qv[d8 * 8 + 0] = bflo(w.x); qv[d8 * 8 + 1] = bfhi(w.x); qv[d8 * 8 + 2] = bflo(w.y); qv[d8 * 8 + 3] = bfhi(w.y);
            qv[d8 * 8 + 4] = bflo(w.z); qv[d8 * 8 + 5] = bfhi(w.z); qv[d8 * 8 + 6] = bflo(w.w); qv[d8 * 8 + 7] = bfhi(w.w); }
        float m = -1e30f, l = 0.f, acc[32];
#pragma unroll
        for (int d = 0; d < 32; ++d) acc[d] = 0.f;
        for (int kc = 0; kc <= qc; ++kc) {
            __syncthreads();
            for (int pi = C.tid; pi < 1024; pi += NTHREADS) { const int r = pi >> 4, cc = pi & 15; const bf16* pr = C.PROJ + (size_t)(b * SEQ + kc * 64 + r) * NPROJ + h * 128 + cc * 8;
                const u32x4 kw = *(const u32x4*)(pr + C_DK), vw = *(const u32x4*)(pr + C_DV); f32x4 a0, a1;
                unpack8(kw, a0, a1); *(LAS f32x4*)(Kt + r * 128 + cc * 8) = a0; *(LAS f32x4*)(Kt + r * 128 + cc * 8 + 4) = a1;
                unpack8(vw, a0, a1); *(LAS f32x4*)(Vt + r * 128 + cc * 8) = a0; *(LAS f32x4*)(Vt + r * 128 + cc * 8 + 4) = a1; }
            __syncthreads();
#pragma unroll 1
            for (int kk = 0; kk < 16; ++kk) {
                const int key = dq * 16 + kk; float s = 0.f;
#pragma unroll
                for (int d4 = 0; d4 < 16; ++d4) { const f32x4 kv = *(const LAS f32x4*)(Kt + key * 128 + p * 64 + d4 * 4);
                    s += qv[d4 * 4] * kv[0]; s += qv[d4 * 4 + 1] * kv[1]; s += qv[d4 * 4 + 2] * kv[2]; s += qv[d4 * 4 + 3] * kv[3]; }
                const int kpos = kc * 64 + key, qpos = qc * 64 + q; const int mn = kpos < 2 * qpos - kpos ? kpos : 2 * qpos - kpos;
                Ss[(p * 64 + q) * 68 + key] = s + sl2 * (float)mn;
            }
            __syncthreads();
            const LAS float* srow = Ss + (p * 64 + q) * 68;
            float cm = -1e30f;
#pragma unroll
            for (int k4 = 0; k4 < 16; ++k4) { const f32x4 sv = *(const LAS f32x4*)(srow + k4 * 4); cm = fmaxf(cm, fmaxf(fmaxf(sv[0], sv[1]), fmaxf(sv[2], sv[3]))); }
            const float mnew = fmaxf(m, cm), alpha = exp2f(m - mnew); m = mnew; l *= alpha;
#pragma unroll
            for (int d = 0; d < 32; ++d) acc[d] *= alpha;
#pragma unroll 2
            for (int key = 0; key < 64; ++key) {
                const float pk = exp2f(srow[key] - m); l += pk;
#pragma unroll
                for (int d4 = 0; d4 < 8; ++d4) { const f32x4 vv = *(const LAS f32x4*)(Vt + key * 128 + dq * 32 + d4 * 4);
                    acc[d4 * 4] += pk * vv[0]; acc[d4 * 4 + 1] += pk * vv[1]; acc[d4 * 4 + 2] += pk * vv[2]; acc[d4 * 4 + 3] += pk * vv[3]; }
            }
        }
        const float inv = 1.f / l;
        __syncthreads();
        LAS float* O2 = Ss;
        if (p == 1) {
#pragma unroll
            for (int d = 0; d < 32; ++d) O2[q * 128 + dq * 32 + d] = lam * acc[d] * inv;
        }
        __syncthreads();
        float ss = 0.f;
        if (p == 0) {
#pragma unroll
            for (int d = 0; d < 32; ++d) { acc[d] = acc[d] * inv - O2[q * 128 + dq * 32 + d]; ss += acc[d] * acc[d]; }
            ssq[q * 4 + dq] = ss;
        }
        __syncthreads();
        if (p == 0) {
            const float tot = (ssq[q * 4] + ssq[q * 4 + 1]) + (ssq[q * 4 + 2] + ssq[q * 4 + 3]);
            const float rstd = rsqrtf(tot * (1.f / 128.f) + EPS) * 0.8f;
            bf16* dst = C.OA + (size_t)qrow * 512 + h * 128 + dq * 32;
#pragma unroll
            for (int d8 = 0; d8 < 4; ++d8) { u32x4 w; const float* gg = C.diff_g + dq * 32 + d8 * 8;
                w.x = pk2(acc[d8 * 8] * rstd * gg[0], acc[d8 * 8 + 1] * rstd * gg[1]); w.y = pk2(acc[d8 * 8 + 2] * rstd * gg[2], acc[d8 * 8 + 3] * rstd * gg[3]);
                w.z = pk2(acc[d8 * 8 + 4] * rstd * gg[4], acc[d8 * 8 + 5] * rstd * gg[5]); w.w = pk2(acc[d8 * 8 + 6] * rstd * gg[6], acc[d8 * 8 + 7] * rstd * gg[7]);
                *(u32x4*)(dst + d8 * 8) = w; }
        }
    }
}


typedef float f32x16 __attribute__((ext_vector_type(16)));
typedef short s16x4 __attribute__((ext_vector_type(4)));
typedef short v4i16_t __attribute__((ext_vector_type(4)));
__device__ __forceinline__ s16x4 vtr(const LAS unsigned char* p) { return __builtin_bit_cast(s16x4, __builtin_amdgcn_ds_read_tr16_b64_v4i16((LAS v4i16_t*)p)); }
template <int OFF> __device__ __forceinline__ void glds16(const void* sbase, unsigned voff, unsigned lds_dst) {
    unsigned sv; asm volatile("s_mov_b32 %0, m0\n\ts_mov_b32 m0, %3\n\ts_nop 0\n\tglobal_load_lds_dwordx4 %1, %2 offset:%4\n\ts_mov_b32 m0, %0" : "=&s"(sv) : "v"(voff), "s"(sbase), "s"(lds_dst), "i"(OFF) : "memory"); }
__device__ __forceinline__ unsigned lds_addr(const LAS unsigned char* p) { return (unsigned)__builtin_amdgcn_readfirstlane((int)(unsigned)(size_t)p); }
#define MFMA16(a, b, c) __builtin_amdgcn_mfma_f32_16x16x32_bf16(a, b, c, 0, 0, 0)
__device__ __forceinline__ bf16x8 cat44(s16x4 lo, s16x4 hi) { return (bf16x8){lo[0], lo[1], lo[2], lo[3], hi[0], hi[1], hi[2], hi[3]}; }
__device__ __forceinline__ void gla_chunked(const Ctx& C, int b, int h) {
    const int lane = C.lane, wid = C.wid, fr = lane & 15, fq = lane >> 4;
    LAS unsigned char* lds = C.lds;
    constexpr int RAW_Q = 0, RAW_K = 8192, RAW_LA = 16384, VB0 = 24576, QS = 57344, KS = 66560, KD = 75776, AM = 84992, ST = 94208, OO = 112640, GTL = 146432, SSQ = 146688;
    constexpr int P = 144, PO = 528;
    const char* pbase = (const char*)(C.PROJ + (size_t)(b * SEQ) * NPROJ);
    const unsigned oq = (unsigned)(((8 * wid + (lane >> 3)) * NPROJ + C_GQ + h * 64 + (lane & 7) * 8) * 2);
    const unsigned okk = oq + (unsigned)((C_GK - C_GQ) * 2), ol = oq + (unsigned)((C_AL - C_GQ) * 2);
    const unsigned ov0 = (unsigned)(((4 * wid + (lane >> 4)) * NPROJ + C_GV + h * 128 + (lane & 15) * 8) * 2), ov1 = ov0 + (unsigned)(32 * NPROJ * 2);
#define GL_DMA(n) do { const char* _cb = pbase + (size_t)(n) * 64 * NPROJ * 2; const unsigned _vb = VB0 + ((n) & 1) * 16384; \
        glds16<0>(_cb, oq, lds_addr(lds + RAW_Q + wid * 1024)); glds16<0>(_cb, okk, lds_addr(lds + RAW_K + wid * 1024)); glds16<0>(_cb, ol, lds_addr(lds + RAW_LA + wid * 1024)); \
        glds16<0>(_cb, ov0, lds_addr(lds + _vb + wid * 1024)); glds16<0>(_cb, ov1, lds_addr(lds + _vb + (wid + 8) * 1024)); } while (0)
    __syncthreads();
    GL_DMA(0);
    for (int i = lane; i < 16 * P / 4; i += 64) ((LAS unsigned*)(lds + ST + wid * 16 * P))[i] = 0u;
    f32x4 accS[4];
#pragma unroll
    for (int t = 0; t < 4; ++t) accS[t] = (f32x4){0.f, 0.f, 0.f, 0.f};
    const int t1 = wid >> 1, ca = 2 * (wid & 1);
    bf16x8 ym[2][2];
#pragma unroll
    for (int ci = 0; ci < 2; ++ci)
#pragma unroll
        for (int ks = 0; ks < 2; ++ks)
#pragma unroll
            for (int jj = 0; jj < 8; ++jj) ym[ci][ks][jj] = (short)(((32 * ks + 8 * fq + jj) <= (16 * (ca + ci) + fr)) ? 0x3F80 : 0);
    const bf16x8 ones = (bf16x8){0x3F80, 0x3F80, 0x3F80, 0x3F80, 0x3F80, 0x3F80, 0x3F80, 0x3F80};
    const int qp = (lane & 15) >> 2, pp = lane & 3;
    const float g0 = C.gla_g[2 * lane], g1 = C.gla_g[2 * lane + 1];
    unsigned grw[8];
#pragma unroll
    for (int cc = 0; cc < 8; ++cc) grw[cc] = 0u;
#define GL_ROWPASS(n) do { _Pragma("unroll") for (int cc = 0; cc < 8; ++cc) { const int c_ = 8 * wid + cc; \
        const float o0 = *(const LAS float*)(lds + OO + c_ * PO + lane * 8), o1 = *(const LAS float*)(lds + OO + c_ * PO + lane * 8 + 4); \
        const f32x4 qa = *(const LAS f32x4*)(lds + SSQ + c_ * 32), qb = *(const LAS f32x4*)(lds + SSQ + c_ * 32 + 16); \
        const float rstd = rsqrtf((((qa[0] + qa[1]) + (qa[2] + qa[3])) + ((qb[0] + qb[1]) + (qb[2] + qb[3]))) * (1.f / 128.f) + EPS); const float gr0 = bflo(grw[cc]), gr1 = bfhi(grw[cc]); \
        *(unsigned*)(C.OB + (size_t)(b * SEQ + (n) * 64 + c_) * 512 + h * 128 + 2 * lane) = pk2(o0 * rstd * g0 * (gr0 * sigmoidf_(gr0)), o1 * rstd * g1 * (gr1 * sigmoidf_(gr1))); } } while (0)
#pragma unroll 1
    for (int n = 0; n < SEQ / 64; ++n) {
        asm volatile("s_waitcnt vmcnt(0) lgkmcnt(0)" ::: "memory"); __syncthreads();
        if (n > 0) GL_ROWPASS(n - 1);
#pragma unroll
        for (int cc = 0; cc < 8; ++cc) grw[cc] = *(const unsigned*)(pbase + ((size_t)(n * 64 + 8 * wid + cc) * NPROJ + C_GR + h * 128 + 2 * lane) * 2);
        {
            bf16x8 xla[2];
#pragma unroll
            for (int ks = 0; ks < 2; ++ks) { const LAS unsigned char* a = lds + RAW_LA + (32 * ks + 8 * fq + qp) * 128 + (16 * t1 + 4 * pp) * 2; xla[ks] = cat44(vtr(a), vtr(a + 4 * 128)); }
            f32x4 Ga = (f32x4){0.f, 0.f, 0.f, 0.f}, Gb = Ga, GT = Ga;
#pragma unroll
            for (int ks = 0; ks < 2; ++ks) { Ga = MFMA16(xla[ks], ym[0][ks], Ga); Gb = MFMA16(xla[ks], ym[1][ks], Gb); GT = MFMA16(xla[ks], ones, GT); }
#pragma unroll
            for (int ci = 0; ci < 2; ++ci) {
                const int c_ = 16 * (ca + ci) + fr, dk0 = 16 * t1 + 4 * fq; const f32x4 G = ci ? Gb : Ga;
                const u32x2 qw = *(const LAS u32x2*)(lds + RAW_Q + c_ * 128 + dk0 * 2), kw = *(const LAS u32x2*)(lds + RAW_K + c_ * 128 + dk0 * 2);
                const float q4[4] = {bflo(qw.x), bfhi(qw.x), bflo(qw.y), bfhi(qw.y)}, k4[4] = {bflo(kw.x), bfhi(kw.x), bflo(kw.y), bfhi(kw.y)};
                float qs4[4], ks4[4], kd4[4];
#pragma unroll
                for (int r = 0; r < 4; ++r) { qs4[r] = q4[r] * __expf(G[r]); ks4[r] = k4[r] * __expf(-G[r]); kd4[r] = k4[r] * __expf(GT[r] - G[r]); }
                *(LAS u32x2*)(lds + QS + c_ * P + dk0 * 2) = (u32x2){pk2(qs4[0], qs4[1]), pk2(qs4[2], qs4[3])};
                *(LAS u32x2*)(lds + KS + c_ * P + dk0 * 2) = (u32x2){pk2(ks4[0], ks4[1]), pk2(ks4[2], ks4[3])};
                *(LAS u32x2*)(lds + KD + c_ * P + dk0 * 2) = (u32x2){pk2(kd4[0], kd4[1]), pk2(kd4[2], kd4[3])};
            }
            if (fr == 0 && (wid & 1) == 0) *(LAS f32x4*)(lds + GTL + (16 * t1 + 4 * fq) * 4) = GT;
        }
        LDS_WAIT(); __syncthreads();
        if (n + 1 < SEQ / 64) GL_DMA(n + 1);
        {
            const int ct = wid >> 1;
#pragma unroll
            for (int si = 0; si < 2; ++si) {
                const int st = 2 * (wid & 1) + si; f32x4 D = (f32x4){0.f, 0.f, 0.f, 0.f};
                if (st <= ct) {
#pragma unroll
                    for (int ks = 0; ks < 2; ++ks) { const bf16x8 X = *(const LAS bf16x8*)(lds + KS + (16 * st + fr) * P + (32 * ks + 8 * fq) * 2), Y = *(const LAS bf16x8*)(lds + QS + (16 * ct + fr) * P + (32 * ks + 8 * fq) * 2); D = MFMA16(X, Y, D); }
#pragma unroll
                    for (int r = 0; r < 4; ++r) if (16 * st + 4 * fq + r > 16 * ct + fr) D[r] = 0.f;
                }
                *(LAS u32x2*)(lds + AM + (16 * ct + fr) * P + (16 * st + 4 * fq) * 2) = (u32x2){pk2(D[0], D[1]), pk2(D[2], D[3])};
            }
        }
        LDS_WAIT(); __builtin_amdgcn_s_barrier(); asm volatile("" ::: "memory");
        {
            const unsigned vb = VB0 + (n & 1) * 16384;
            bf16x8 X1[2], X2[2];
#pragma unroll
            for (int ks = 0; ks < 2; ++ks) { X1[ks] = *(const LAS bf16x8*)(lds + ST + (16 * wid + fr) * P + (32 * ks + 8 * fq) * 2);
                const LAS unsigned char* a = lds + vb + (32 * ks + 8 * fq + qp) * 256 + (16 * wid + 4 * pp) * 2; X2[ks] = cat44(vtr(a), vtr(a + 4 * 256)); }
#pragma unroll
            for (int ct = 0; ct < 4; ++ct) { f32x4 o = (f32x4){0.f, 0.f, 0.f, 0.f};
#pragma unroll
                for (int ks = 0; ks < 2; ++ks) { const bf16x8 Y1 = *(const LAS bf16x8*)(lds + QS + (16 * ct + fr) * P + (32 * ks + 8 * fq) * 2), Y2 = *(const LAS bf16x8*)(lds + AM + (16 * ct + fr) * P + (32 * ks + 8 * fq) * 2);
                    o = MFMA16(X1[ks], Y1, o); o = MFMA16(X2[ks], Y2, o); }
                *(LAS f32x4*)(lds + OO + (16 * ct + fr) * PO + (16 * wid + 4 * fq) * 4) = o;
                float ss = (o[0] * o[0] + o[1] * o[1]) + (o[2] * o[2] + o[3] * o[3]); ss += __shfl_xor(ss, 16); ss += __shfl_xor(ss, 32);
                if (fq == 0) *(LAS float*)(lds + SSQ + (16 * ct + fr) * 32 + wid * 4) = ss; }
#pragma unroll
            for (int tt = 0; tt < 4; ++tt) { const f32x4 dl = *(const LAS f32x4*)(lds + GTL + (16 * tt + 4 * fq) * 4);
#pragma unroll
                for (int r = 0; r < 4; ++r) accS[tt][r] *= __expf(dl[r]);
#pragma unroll
                for (int ks = 0; ks < 2; ++ks) { const LAS unsigned char* a = lds + KD + (32 * ks + 8 * fq + qp) * P + (16 * tt + 4 * pp) * 2; accS[tt] = MFMA16(cat44(vtr(a), vtr(a + 4 * P)), X2[ks], accS[tt]); }
                *(LAS u32x2*)(lds + ST + (16 * wid + fr) * P + (16 * tt + 4 * fq) * 2) = (u32x2){pk2(accS[tt][0], accS[tt][1]), pk2(accS[tt][2], accS[tt][3])}; }
        }
    }
    asm volatile("s_waitcnt vmcnt(0) lgkmcnt(0)" ::: "memory"); __syncthreads();
    GL_ROWPASS(SEQ / 64 - 1);
    __syncthreads();
#undef GL_DMA
#undef GL_ROWPASS
}

__device__ __forceinline__ int crow(int r, int hi) { return (r & 3) + 8 * (r >> 2) + 4 * hi; }
#define MFMA32(a, b, c) __builtin_amdgcn_mfma_f32_32x32x16_bf16(a, b, c, 0, 0, 0)
constexpr int AT_BUF = 32768, AT_WSF = 3 * 32768, AT_Q = 3 * 32768 + 2048;
constexpr float AT_THR = 8.f;

__device__ __forceinline__ void attn_unit(const Ctx& C, int b, int h, int cp, float lam) {
    const int lane = C.lane, r32 = lane & 31, hi = lane >> 5, wid = C.wid, p = wid >> 2, sub = wid & 3;
    const int NT = 2 * cp + 2, qch = 2 * cp + (sub >> 1), my_nt = qch + 1;
    const int row0 = b * SEQ + cp * 128;
    const int qpos = cp * 128 + sub * 32 + r32;
    const float sl2 = exp2f(-2.f * (float)(h + 1)) * LOG2E;
    LAS unsigned char* lds = C.lds;
    LAS float* wsf = (LAS float*)(lds + AT_WSF) + wid * 64;
    const char* kbase = (const char*)(C.PROJ + (size_t)(b * SEQ) * NPROJ + h * 128);
    const unsigned koff = (unsigned)((lane * NPROJ + C_DK + wid * 8) * 2);
    const unsigned voff = (unsigned)(((16 * (wid & 3) + (lane >> 2)) * NPROJ + C_DV + (wid >> 2) * 32 + (lane & 3) * 8) * 2);
#define AT_DMA(t, bufo) do { const char* _tb = kbase + (size_t)(t) * 64 * NPROJ * 2; \
        glds16<0>(_tb, koff, lds_addr(lds + (bufo) + wid * 1024)); glds16<0>(_tb, koff + 128u, lds_addr(lds + (bufo) + 8192 + wid * 1024)); \
        glds16<0>(_tb, voff, lds_addr(lds + (bufo) + 16384 + (wid >> 2) * 4096 + (wid & 3) * 1024)); glds16<0>(_tb, voff + 128u, lds_addr(lds + (bufo) + 16384 + ((wid >> 2) + 2) * 4096 + (wid & 3) * 1024)); } while (0)
    bf16x8 qr[4];
    { const bf16* qp = C.PROJ + (size_t)(row0 + sub * 32 + r32) * NPROJ + C_DQ + h * 128 + p * 64 + hi * 8;
#pragma unroll
      for (int d0 = 0; d0 < 4; ++d0) qr[d0] = *(const bf16x8*)(qp + d0 * 16); }
    AT_DMA(0, 0); AT_DMA(1, AT_BUF);
    f32x16 o[4];
#pragma unroll
    for (int d0 = 0; d0 < 4; ++d0)
#pragma unroll
        for (int i = 0; i < 16; ++i) o[d0][i] = 0.f;
    float mhat = 0.f, lsum = 0.f;
    const unsigned kofs = (unsigned)(p * 8192 + hi * 1024 + r32 * 16);
    const unsigned vofs = (unsigned)(16384 + ((lane >> 4) & 1) * 32 + (lane & 3) * 8 + (4 * hi + ((lane & 15) >> 2)) * 64);
    asm volatile("s_waitcnt vmcnt(4)" ::: "memory"); __syncthreads();
    unsigned bufo = 0, bufn1 = AT_BUF, bufn2 = 2 * AT_BUF;
#pragma unroll 1
    for (int t = 0; t < NT; ++t) {
        PSTAMP(lds, 0);
        if (t + 2 < NT) AT_DMA(t + 2, bufn2);
        PSTAMP(lds, 1);
        if (t < my_nt) {
            const LAS unsigned char* kp = lds + bufo + kofs;
            const LAS unsigned char* vp = lds + bufo + vofs;
            bf16x8 kf[8];
#pragma unroll
            for (int d0 = 0; d0 < 4; ++d0) { kf[2 * d0] = *(const LAS bf16x8*)(kp + d0 * 2048); kf[2 * d0 + 1] = *(const LAS bf16x8*)(kp + d0 * 2048 + 512); }
            s16x4 va[8], vb[8];
#define AT_VRD(dst, k) do { _Pragma("unroll") for (int d0 = 0; d0 < 4; ++d0) { dst[2 * d0] = vtr(vp + d0 * 4096 + (k) * 1024); dst[2 * d0 + 1] = vtr(vp + d0 * 4096 + (k) * 1024 + 512); } } while (0)
#define AT_PV(src_, k) do { const bf16x8 pa_ = __builtin_bit_cast(bf16x8, pw[k]); _Pragma("unroll") for (int d0 = 0; d0 < 4; ++d0) o[d0] = MFMA32(pa_, cat44(src_[2 * d0], src_[2 * d0 + 1]), o[d0]); } while (0)
            AT_VRD(va, 0);
            __builtin_amdgcn_sched_barrier(0);
            f32x16 s0, s1;
            if (t == qch) {
#pragma unroll
                for (int i = 0; i < 16; ++i) { const int k0p = 64 * t + crow(i, hi), k1p = k0p + 32;
                    s0[i] = fmaf(sl2, (float)min(k0p, 2 * qpos - k0p), -mhat); s1[i] = fmaf(sl2, (float)min(k1p, 2 * qpos - k1p), -mhat); }
            } else {
                const float bsm = sl2 * (float)(64 * t + 4 * hi) - mhat;
#pragma unroll
                for (int i = 0; i < 16; ++i) { const float ci = (float)((i & 3) + 8 * (i >> 2)); s0[i] = fmaf(sl2, ci, bsm); s1[i] = fmaf(sl2, ci + 32.f, bsm); }
            }
#pragma unroll
            for (int d0 = 0; d0 < 4; ++d0) { s0 = MFMA32(kf[2 * d0], qr[d0], s0); s1 = MFMA32(kf[2 * d0 + 1], qr[d0], s1); }
            __builtin_amdgcn_sched_barrier(0);
            float rm = fmaxf(s0[0], s1[0]);
#pragma unroll
            for (int i = 1; i < 16; ++i) rm = fmaxf(rm, fmaxf(s0[i], s1[i]));
            { auto rr = __builtin_amdgcn_permlane32_swap(__float_as_uint(rm), __float_as_uint(rm), false, false); rm = fmaxf(__uint_as_float(rr[0]), __uint_as_float(rr[1])); }
            if (t == 0 || __any(rm > AT_THR)) {
                const float dl = (t == 0) ? rm : fmaxf(rm, 0.f); mhat += dl;
                if (t != 0) {
                    const float f = __builtin_amdgcn_exp2f(-dl); lsum *= f;
                    if (hi == 0) wsf[r32] = f;
                    LDS_WAIT();
#pragma unroll
                    for (int i = 0; i < 16; ++i) { const float fi = wsf[crow(i, hi)];
#pragma unroll
                        for (int d0 = 0; d0 < 4; ++d0) o[d0][i] *= fi; }
                }
#pragma unroll
                for (int i = 0; i < 16; ++i) { s0[i] -= dl; s1[i] -= dl; }
            }
            float ps = 0.f;
#pragma unroll
            for (int i = 0; i < 16; ++i) { s0[i] = __builtin_amdgcn_exp2f(s0[i]); s1[i] = __builtin_amdgcn_exp2f(s1[i]); ps += s0[i] + s1[i]; }
            lsum += ps;
            PSTAMP(lds, 2);
            u32x4 pw[4];
            pw[0] = (u32x4){pk2(s0[0], s0[1]), pk2(s0[2], s0[3]), pk2(s0[4], s0[5]), pk2(s0[6], s0[7])};
            pw[1] = (u32x4){pk2(s0[8], s0[9]), pk2(s0[10], s0[11]), pk2(s0[12], s0[13]), pk2(s0[14], s0[15])};
            pw[2] = (u32x4){pk2(s1[0], s1[1]), pk2(s1[2], s1[3]), pk2(s1[4], s1[5]), pk2(s1[6], s1[7])};
            pw[3] = (u32x4){pk2(s1[8], s1[9]), pk2(s1[10], s1[11]), pk2(s1[12], s1[13]), pk2(s1[14], s1[15])};
            __builtin_amdgcn_sched_barrier(0);
            AT_VRD(vb, 1); AT_PV(va, 0); __builtin_amdgcn_sched_barrier(0);
            AT_VRD(va, 2); AT_PV(vb, 1); __builtin_amdgcn_sched_barrier(0);
            AT_VRD(vb, 3); AT_PV(va, 2); __builtin_amdgcn_sched_barrier(0);
            AT_PV(vb, 3);
#undef AT_VRD
#undef AT_PV
        }
        PSTAMP(lds, 3);
        if (t + 2 < NT) asm volatile("s_waitcnt vmcnt(4) lgkmcnt(0)" ::: "memory"); else asm volatile("s_waitcnt vmcnt(0) lgkmcnt(0)" ::: "memory");
        PSTAMP(lds, 4);
        __builtin_amdgcn_s_barrier(); asm volatile("" ::: "memory");
        PSTAMP(lds, 5);
        { const unsigned tb = bufo; bufo = bufn1; bufn1 = bufn2; bufn2 = tb; }
    }
#undef AT_DMA
    lsum += __shfl_xor(lsum, 32);
    if (hi == 0) wsf[32 + r32] = lsum;
    LDS_WAIT();
    LAS float* X = (LAS float*)lds;
    if (p == 1) {
#pragma unroll
        for (int i = 0; i < 16; ++i) { const float sc = lam / wsf[32 + crow(i, hi)];
#pragma unroll
            for (int d0 = 0; d0 < 4; ++d0) X[(sub * 32 + crow(i, hi)) * 128 + d0 * 32 + r32] = o[d0][i] * sc; }
    }
    __syncthreads();
    if (p == 0) {
#pragma unroll
        for (int i = 0; i < 16; ++i) { const float sc = 1.f / wsf[32 + crow(i, hi)];
#pragma unroll
            for (int d0 = 0; d0 < 4; ++d0) { LAS float* xp = X + (sub * 32 + crow(i, hi)) * 128 + d0 * 32 + r32; *xp = o[d0][i] * sc - *xp; } }
    }
    __syncthreads();
    { const float g0 = C.diff_g[2 * lane], g1 = C.diff_g[2 * lane + 1];
#pragma unroll 4
      for (int qq = 0; qq < 16; ++qq) { const int q = wid * 16 + qq; const float y0 = X[q * 128 + 2 * lane], y1 = X[q * 128 + 2 * lane + 1];
          const float rstd = rsqrtf(wave_sum(y0 * y0 + y1 * y1) * (1.f / 128.f) + EPS) * 0.8f;
          *(unsigned*)(C.OA + (size_t)(row0 + q) * 512 + h * 128 + 2 * lane) = pk2(y0 * rstd * g0, y1 * rstd * g1); } }
    __syncthreads();
}

__device__ __forceinline__ void attn_phase(const Ctx& C) {
    LAS float* lamp = (LAS float*)(C.lds + AT_Q) + 4;
    LAS int* qw = (LAS int*)(C.lds + AT_Q);
    if (C.tid < 64) {
        const float a = wave_sum(C.lq1[C.lane] * C.lk1[C.lane]), b2 = wave_sum(C.lq2[C.lane] * C.lk2[C.lane]);
        if (C.tid == 0) lamp[0] = __expf(a) - __expf(b2) + 0.2f;
    }
    __syncthreads();
    const float lam = lamp[0];
    for (;;) {
        if (C.tid == 0) qw[0] = (int)__hip_atomic_fetch_add(C.ctl + CW_QUEUE, 1u, RLX_AGENT);
        __syncthreads();
        const int item = __builtin_amdgcn_readfirstlane(qw[0]);
        __syncthreads();
        if (item >= 1024) break;
        const int bh = item & 63, cp = 15 - (item >> 6);
        attn_unit(C, bh >> 2, bh & 3, cp, lam);
    }
}

__device__ __forceinline__ void split_bf16(const float (&v)[8], bf16x8& hi, bf16x8& lo) {
    const unsigned h0 = pk2(v[0], v[1]), h1 = pk2(v[2], v[3]), h2 = pk2(v[4], v[5]), h3 = pk2(v[6], v[7]);
    const u32x4 h = (u32x4){h0, h1, h2, h3};
    const u32x4 l = (u32x4){pk2(v[0] - bflo(h0), v[1] - bfhi(h0)), pk2(v[2] - bflo(h1), v[3] - bfhi(h1)), pk2(v[4] - bflo(h2), v[5] - bfhi(h2)), pk2(v[6] - bflo(h3), v[7] - bfhi(h3))};
    hi = __builtin_bit_cast(bf16x8, h); lo = __builtin_bit_cast(bf16x8, l);
}
__device__ __forceinline__ void phase_router(const Ctx& C) {
    const int lane = C.lane, wid = C.wid, fr = lane & 15, fq = lane >> 4;
    LAS u32x4* WH = (LAS u32x4*)C.lds;
    LAS u32x4* WL = WH + 4096;
    LAS float* GS = (LAS float*)(C.lds + 131072);
    LAS float* SH = GS + 1024;
    LAS float* red = SH + 1024;
    LAS float* ssw = red + 8 * 16 * 32;
    LAS float* rs = ssw + 128;
    LAS int* lcnt = (LAS int*)(rs + 16);
    LAS int* lbase = lcnt + 32;
    LAS int* pend = lbase + 32;
    LAS float* cbl = (LAS float*)(pend + 512);
    for (int blk = C.bid; blk < NTOK / 128; blk += C.G) {
        const int b = blk >> 4; const float* md = C.mod + b * 6144;
        __syncthreads();
        for (int k = C.tid; k < DM; k += NTHREADS) { GS[k] = C.norm2_g[k] * (1.f + md[4096 + k]); SH[k] = md[3072 + k]; }
        if (C.tid < 32) lcnt[C.tid] = 0;
        pend[C.tid] = -1;
#pragma unroll 1
        for (int idx = C.tid; idx < 4096; idx += NTHREADS) {
            const int l2 = idx & 63, nt = (idx >> 6) & 1, ks = (idx >> 7) & 3, w2 = idx >> 9; float wv[8];
#pragma unroll
            for (int j = 0; j < 8; ++j) wv[j] = C.w_router[(size_t)(128 * w2 + 32 * ks + 8 * (l2 >> 4) + j) * NE + 16 * nt + (l2 & 15)];
            bf16x8 h8, l8; split_bf16(wv, h8, l8); WH[idx] = __builtin_bit_cast(u32x4, h8); WL[idx] = __builtin_bit_cast(u32x4, l8); }
        __syncthreads();
        {
            const int e = C.tid & 31, part = C.tid >> 5; float s = 0.f;
#pragma unroll 8
            for (int k = part * 64; k < part * 64 + 64; ++k) s += SH[k] * C.w_router[k * NE + e];
            red[part * 32 + e] = s;
            __syncthreads();
            if (C.tid < 32) { float t = C.b_router[C.tid];
#pragma unroll
                for (int p2 = 0; p2 < 16; ++p2) t += red[p2 * 32 + C.tid];
                cbl[C.tid] = t; }
            __syncthreads();
        }
        float x1[4][8];
#define RT_LOAD(dst, row) do { _Pragma("unroll") for (int ks = 0; ks < 4; ++ks) { const size_t o_ = (size_t)(row) * DM + 128 * wid + 32 * ks + 8 * fq; \
            const f32x4 xa = *(const f32x4*)(C.x + o_), xb = *(const f32x4*)(C.x + o_ + 4); const u32x4 yw = *(const u32x4*)(C.Y1 + o_); \
            dst[ks][0] = xa[0] + bflo(yw.x); dst[ks][1] = xa[1] + bfhi(yw.x); dst[ks][2] = xa[2] + bflo(yw.y); dst[ks][3] = xa[3] + bfhi(yw.y); \
            dst[ks][4] = xb[0] + bflo(yw.z); dst[ks][5] = xb[1] + bfhi(yw.z); dst[ks][6] = xb[2] + bflo(yw.w); dst[ks][7] = xb[3] + bfhi(yw.w); } } while (0)
        RT_LOAD(x1, blk * 128 + fr);
#pragma unroll 1
        for (int it = 0; it < 8; ++it) {
            const int row0 = blk * 128 + it * 16;
            f32x4 acc0 = (f32x4){0.f, 0.f, 0.f, 0.f}, acc1 = acc0; float ss = 0.f;
#pragma unroll
            for (int ks = 0; ks < 4; ++ks) {
                const f32x4 ga = *(const LAS f32x4*)(GS + 128 * wid + 32 * ks + 8 * fq), gb = *(const LAS f32x4*)(GS + 128 * wid + 32 * ks + 8 * fq + 4);
                float av[8];
#pragma unroll
                for (int j = 0; j < 8; ++j) { const float xv = x1[ks][j]; ss += xv * xv; av[j] = xv * (j < 4 ? ga[j] : gb[j - 4]); }
                bf16x8 ah, al; split_bf16(av, ah, al);
                const int fi = ((wid * 4 + ks) * 2) * 64 + lane;
                const bf16x8 wh0 = __builtin_bit_cast(bf16x8, WH[fi]), wh1 = __builtin_bit_cast(bf16x8, WH[fi + 64]), wl0 = __builtin_bit_cast(bf16x8, WL[fi]), wl1 = __builtin_bit_cast(bf16x8, WL[fi + 64]);
                acc0 = MFMA16(ah, wh0, acc0); acc0 = MFMA16(al, wh0, acc0); acc0 = MFMA16(ah, wl0, acc0);
                acc1 = MFMA16(ah, wh1, acc1); acc1 = MFMA16(al, wh1, acc1); acc1 = MFMA16(ah, wl1, acc1);
            }
            ss += __shfl_xor(ss, 16); ss += __shfl_xor(ss, 32);
            if (fq == 0) ssw[wid * 16 + fr] = ss;
#pragma unroll
            for (int r = 0; r < 4; ++r) { red[(wid * 16 + 4 * fq + r) * 32 + fr] = acc0[r]; red[(wid * 16 + 4 * fq + r) * 32 + 16 + fr] = acc1[r]; }
            LDS_WAIT(); __syncthreads();
            float xn[4][8];
            if (it < 7) RT_LOAD(xn, row0 + 16 + fr);
            {
                const int r = 2 * wid + (lane >> 5), e = lane & 31; float sum = 0.f, sq = 0.f;
#pragma unroll
                for (int w2 = 0; w2 < 8; ++w2) { sum += red[(w2 * 16 + r) * 32 + e]; sq += ssw[w2 * 16 + r]; }
                const float rstd = rsqrtf(sq * (1.f / DM) + EPS);
                if (e == 0) rs[r] = rstd;
                float val = rstd * sum + cbl[e];
                float tv[4]; int ti[4];
#pragma unroll
                for (int k = 0; k < 4; ++k) {
                    float bv = val; int bi = e;
#pragma unroll
                    for (int o = 16; o >= 1; o >>= 1) { const float ov = __shfl_xor(bv, o); const int oi = __shfl_xor(bi, o); if (ov > bv || (ov == bv && oi < bi)) { bv = ov; bi = oi; } }
                    tv[k] = bv; ti[k] = bi; if (e == bi) val = -3.0e38f;
                }
                const float e1 = __expf(tv[1] - tv[0]), e2 = __expf(tv[2] - tv[0]), e3 = __expf(tv[3] - tv[0]); const float inv = 1.f / (1.f + e1 + e2 + e3);
                const int row = row0 + r;
                if (e == 0) { *(f32x4*)(C.topw + (size_t)row * 4) = (f32x4){inv, e1 * inv, e2 * inv, e3 * inv}; *(i32x4*)(C.tope + (size_t)row * 4) = (i32x4){ti[0], ti[1], ti[2], ti[3]}; }
                if (e < 4) { const int ex = e == 0 ? ti[0] : (e == 1 ? ti[1] : (e == 2 ? ti[2] : ti[3]));
                    const int slot = atomicAdd((int*)(lcnt + ex), 1); pend[(it * 16 + r) * 4 + e] = (ex << 16) | slot; }
            }
            LDS_WAIT(); __syncthreads();
            {
                const float rstd = rs[fr];
#pragma unroll
                for (int ks = 0; ks < 4; ++ks) { const int k0 = 128 * wid + 32 * ks + 8 * fq;
                    const f32x4 ga = *(const LAS f32x4*)(GS + k0), gb = *(const LAS f32x4*)(GS + k0 + 4), sa = *(const LAS f32x4*)(SH + k0), sb = *(const LAS f32x4*)(SH + k0 + 4);
                    u32x4 w; w.x = pk2(x1[ks][0] * rstd * ga[0] + sa[0], x1[ks][1] * rstd * ga[1] + sa[1]); w.y = pk2(x1[ks][2] * rstd * ga[2] + sa[2], x1[ks][3] * rstd * ga[3] + sa[3]);
                    w.z = pk2(x1[ks][4] * rstd * gb[0] + sb[0], x1[ks][5] * rstd * gb[1] + sb[1]); w.w = pk2(x1[ks][6] * rstd * gb[2] + sb[2], x1[ks][7] * rstd * gb[3] + sb[3]);
                    *(u32x4*)(C.H2 + (size_t)(row0 + fr) * DM + k0) = w; }
            }
            if (it < 7) {
#pragma unroll
                for (int ks = 0; ks < 4; ++ks)
#pragma unroll
                    for (int j = 0; j < 8; ++j) x1[ks][j] = xn[ks][j]; }
        }
#undef RT_LOAD
        __syncthreads();
        if (C.tid < 32) lbase[C.tid] = (int)__hip_atomic_fetch_add(C.ctl + CW_CNT + 64 * C.tid, (unsigned)lcnt[C.tid], RLX_AGENT);
        __syncthreads();
        { const int pv = pend[C.tid]; if (pv >= 0) { const int e = pv >> 16, slot = pv & 0xffff; C.list[e * NTOK + lbase[e] + slot] = (blk * 128 + (C.tid >> 2)) * 4 + (C.tid & 3); } }
    }
}

__device__ __forceinline__ void phase_final(const Ctx& C) {
    const int gw = C.bid * NWAVES + C.wid, NGW = C.G * NWAVES;
    for (int row = gw; row < NTOK; row += NGW) {
        const int b = row >> 11; const float* gt2 = C.mod + b * 6144 + 5120;
        const f32x4 w = *(const f32x4*)(C.topw + (size_t)row * 4);
        f32x4 v[4]; float ss = 0.f;
#pragma unroll
        for (int j = 0; j < 4; ++j) { const int c0 = 4 * C.lane + 256 * j;
            f32x4 y = (f32x4){0.f, 0.f, 0.f, 0.f};
#pragma unroll
            for (int k = 0; k < 4; ++k) { const u32x2 yw = *(const u32x2*)(C.YB + (size_t)(row * 4 + k) * DM + c0); y = y + (f32x4){bflo(yw.x), bfhi(yw.x), bflo(yw.y), bfhi(yw.y)} * w[k]; }
            const u32x2 y1w = *(const u32x2*)(C.Y1 + (size_t)row * DM + c0);
            v[j] = *(const f32x4*)(C.x + (size_t)row * DM + c0) + (f32x4){bflo(y1w.x), bfhi(y1w.x), bflo(y1w.y), bfhi(y1w.y)} + *(const f32x4*)(gt2 + c0) * y;
            ss += (v[j][0] * v[j][0] + v[j][1] * v[j][1]) + (v[j][2] * v[j][2] + v[j][3] * v[j][3]); }
        const float rstd = rsqrtf(wave_sum(ss) * (1.f / DM) + EPS);
#pragma unroll
        for (int j = 0; j < 4; ++j) { const int c0 = 4 * C.lane + 256 * j; *(f32x4*)(C.out + (size_t)row * DM + c0) = v[j] * rstd * *(const f32x4*)(C.final_g + c0); }
    }
}

#ifndef PROBE_A
#define PROBE_A -1
#endif
#ifndef PROBE_B
#define PROBE_B -1
#endif
constexpr int CW_TS = 3072;
#define STAMP(k) do { if (PROBE_A >= 0 && blockIdx.x == 0 && threadIdx.x == 0) { const Ctx Cs = make_ctx(lds); ((unsigned long long*)(Cs.ctl + CW_TS))[k] = __builtin_amdgcn_s_memrealtime(); } } while (0)
struct Args { const float* in[25]; float* out; unsigned char* ws; };
typedef const Args __attribute__((address_space(4)))* KArgs;
__device__ __forceinline__ Ctx make_ctx(LAS unsigned char* lds) {
    KArgs a = (KArgs)__builtin_amdgcn_kernarg_segment_ptr();
    asm volatile("" : "+s"(a));
    Ctx C;
    C.lds = lds;
    C.tid = tid_fresh(); C.lane = C.tid & 63; C.wid = __builtin_amdgcn_readfirstlane(C.tid >> 6); C.G = gridDim.x; C.bid = blockIdx.x;
    C.x = a->in[0]; C.c = a->in[1]; C.w_ada = a->in[2]; C.b_ada = a->in[3]; C.norm1_g = a->in[4]; C.w_in = a->in[5];
    C.lq1 = a->in[6]; C.lk1 = a->in[7]; C.lq2 = a->in[8]; C.lk2 = a->in[9]; C.diff_g = a->in[10]; C.w_alpha_up = a->in[11]; C.b_alpha = a->in[12];
    C.gla_g = a->in[13]; C.w_bd = a->in[14]; C.w_bg = a->in[15]; C.w_out = a->in[16]; C.norm2_g = a->in[17]; C.w_router = a->in[18]; C.b_router = a->in[19];
    C.w_gu = a->in[20]; C.b_gu = a->in[21]; C.w_dn = a->in[22]; C.b_dn = a->in[23]; C.final_g = a->in[24];
    C.out = a->out;
    unsigned char* ws = a->ws;
    C.ctl = (unsigned*)(ws + WS_CTL); C.mod = (float*)(ws + WS_MOD); C.tope = (int*)(ws + WS_TOPE); C.topw = (float*)(ws + WS_TOPW); C.list = (int*)(ws + WS_LIST);
    C.WinT = (bf16*)(ws + WS_WIN); C.WbdT = (bf16*)(ws + WS_WBD); C.WbgT = (bf16*)(ws + WS_WBG); C.WoutT = (bf16*)(ws + WS_WOUT); C.WguT = (bf16*)(ws + WS_WGU); C.WdT = (bf16*)(ws + WS_WD);
    C.H = (bf16*)(ws + WS_H); C.H2 = (bf16*)(ws + WS_H2); C.OA = (bf16*)(ws + WS_OA); C.OB = (bf16*)(ws + WS_OB); C.MG = (bf16*)(ws + WS_MG); C.YB = (bf16*)(ws + WS_YB);
    C.PROJ = (bf16*)(ws + WS_PROJ); C.ACT = (bf16*)(ws + WS_ACT); C.Y1 = (bf16*)(ws + WS_Y1); C.cb = (float*)(ws + WS_CB);
    return C;
}
__global__ void __launch_bounds__(NTHREADS, 2) fwd_kernel(Args args) {
    extern __shared__ __attribute__((aligned(16))) unsigned char lds_raw[];
    LAS unsigned char* lds = (LAS unsigned char*)lds_raw;
    for (int u = threadIdx.x; u < (LDS_BYTES - LDSCTL_OFF) / 4; u += NTHREADS) ((LAS unsigned*)(lds + LDSCTL_OFF))[u] = 0u;
    __syncthreads();
    volatile LAS unsigned* MISC = (volatile LAS unsigned*)(lds + MISC_OFF);
    XcdBarrier bar;
    { const Ctx C = make_ctx(lds); bar = xcd_barrier_post(C.ctl + CW_BAR, MISC + 8); }
#define GRID_BAR() xcd_barrier(bar)
    STAMP(0);

    { const Ctx C = make_ctx(lds); phase_mod(C); }
    GRID_BAR(); STAMP(1);
    { const Ctx C = make_ctx(lds); phase_prep(C); }
    GRID_BAR(); STAMP(2);
    { const Ctx C = make_ctx(lds); DenseDesc g{C.H, DM, C.WinT, DM}; TileOrder S; S.init(NTOK / 256, NPROJ / 256, C.G, C.bid); EpiProj E{C.PROJ, C.b_alpha}; gemm_phase<DenseDesc, TileOrder, EpiProj, true>(C.lds, g, S, E); }
    GRID_BAR(); STAMP(3);
    { const Ctx C = make_ctx(lds); for (int s = C.bid; s < 64; s += C.G) gla_chunked(C, s >> 2, s & 3); }
    __syncthreads(); STAMP(12);
    { const Ctx C = make_ctx(lds); attn_phase(C); }
    GRID_BAR(); STAMP(4);
    { const Ctx C = make_ctx(lds); DenseDesc g{C.OA, 512, C.WbdT, 512}; TileOrder S; S.init(NTOK / 256, DM / 256, C.G, C.bid); EpiBranch E{C.MG, C.PROJ, C_GA, 0}; gemm_phase<DenseDesc, TileOrder, EpiBranch, true>(C.lds, g, S, E); }
    GRID_BAR(); STAMP(5);
    { const Ctx C = make_ctx(lds); DenseDesc g{C.OB, 512, C.WbgT, 512}; TileOrder S; S.init(NTOK / 256, DM / 256, C.G, C.bid); EpiBranch E{C.MG, C.PROJ, C_GB, 1}; gemm_phase<DenseDesc, TileOrder, EpiBranch, true>(C.lds, g, S, E); }
    GRID_BAR(); STAMP(6);
    { const Ctx C = make_ctx(lds); DenseDesc g{C.MG, DM, C.WoutT, DM}; TileOrder S; S.init(NTOK / 256, DM / 256, C.G, C.bid); EpiOut E{C.Y1, C.mod}; gemm_phase<DenseDesc, TileOrder, EpiOut, true>(C.lds, g, S, E); }
    GRID_BAR(); STAMP(7);
    { const Ctx C = make_ctx(lds); phase_router(C); }
    GRID_BAR(); STAMP(8);
    LAS int* tab = (LAS int*)(lds + STAGE_BYTES);
    __syncthreads();
    if (threadIdx.x == 0) { const Ctx C = make_ctx(lds); int ts = 0; for (int e = 0; e < NE; ++e) { const int cnt = (int)__hip_atomic_load(C.ctl + CW_CNT + 64 * e, RLX_AGENT); tab[e] = cnt; tab[32 + e] = ts; ts += (cnt + 255) >> 8; } tab[64] = ts; }
    __syncthreads();
    { const Ctx C = make_ctx(lds); const int T = tab[64]; MoeUpDesc g{C.H2, C.list, C.WguT, DM}; MoeOrder S; S.t.init(T, 8, C.G, C.bid); S.tab = tab; EpiUp E{C.ACT, C.b_gu}; gemm_phase<MoeUpDesc, MoeOrder, EpiUp, true>(C.lds, g, S, E); }
    GRID_BAR(); STAMP(9);
    { const Ctx C = make_ctx(lds); const int T = tab[64]; MoeDownDesc g{C.ACT, C.WdT, FF}; MoeOrder S; S.t.init(T, 4, C.G, C.bid); S.tab = tab; EpiDown E{C.YB, C.b_dn, C.list}; gemm_phase<MoeDownDesc, MoeOrder, EpiDown, true>(C.lds, g, S, E); }
    GRID_BAR(); STAMP(10);
    { const Ctx C = make_ctx(lds); phase_final(C); }
#if PROBE_A >= 0
    GRID_BAR(); STAMP(11);
    if (blockIdx.x == 0 && threadIdx.x == 0) {
        const Ctx C = make_ctx(lds); const unsigned long long* ts = (const unsigned long long*)(C.ctl + CW_TS);
        asm volatile("s_waitcnt vmcnt(0)" ::: "memory");
        const unsigned long long dt = (PROBE_A >= 100) ? (unsigned long long)((volatile LAS unsigned*)(lds + MISC_OFF))[16 + (PROBE_A >= 100 ? PROBE_A - 100 : 0)] : ((PROBE_A == 12) ? ts[12] - ts[3] : ts[(PROBE_A < 12 ? PROBE_A : 0) + 1] - ts[PROBE_A < 12 ? PROBE_A : 0]), t0 = __builtin_amdgcn_s_memrealtime();
        while (__builtin_amdgcn_s_memrealtime() - t0 < 4ull * dt) __builtin_amdgcn_s_sleep(8);
    }
#endif
}

extern "C" void kernel_launch(void* const* d_in, const int* in_sizes, int n_in, void* d_out, int out_size, void* d_ws, size_t ws_size, hipStream_t stream) {
    static int grid = 0;
    if (grid == 0) {
        if (n_in != 25 || in_sizes[0] != NTOK * DM || out_size != NTOK * DM || ws_size < WS_END) {
            fprintf(stderr, "kernel_launch: unexpected shapes (n_in %d, in0 %d, out %d, ws %zu < %zu)\n", n_in, n_in > 0 ? in_sizes[0] : -1, out_size, ws_size, (size_t)WS_END); grid = -1; return; }
        int dev = 0, cus = 0;
        if (hipGetDevice(&dev) != hipSuccess || hipDeviceGetAttribute(&cus, hipDeviceAttributeMultiprocessorCount, dev) != hipSuccess) { grid = -1; return; }
        if (hipFuncSetAttribute((const void*)fwd_kernel, hipFuncAttributeMaxDynamicSharedMemorySize, LDS_BYTES) != hipSuccess) { fprintf(stderr, "kernel_launch: hipFuncSetAttribute failed\n"); grid = -1; return; }
        (void)hipGetLastError();
        grid = cus;
    }
    if (grid < 0) return;
    if (hipMemsetAsync((char*)d_ws + WS_CTL, 0, CTL_ZERO_BYTES, stream) != hipSuccess) { fprintf(stderr, "kernel_launch: memset failed\n"); return; }
    Args a{};
    for (int i = 0; i < 25; ++i) a.in[i] = (const float*)d_in[i];
    a.out = (float*)d_out; a.ws = (unsigned char*)d_ws;
    hipLaunchKernelGGL(fwd_kernel, dim3(grid), dim3(NTHREADS), LDS_BYTES, stream, a);
}
```

```cpp
#include <hip/hip_runtime.h>
#include <cstdio>
#include <cstdint>

#define GAS __attribute__((address_space(1)))
#define LAS __attribute__((address_space(3)))
typedef unsigned short bf16;
typedef short bf16x8 __attribute__((ext_vector_type(8)));
typedef float f32x4 __attribute__((ext_vector_type(4)));
typedef unsigned u32x4 __attribute__((ext_vector_type(4)));
typedef unsigned u32x2 __attribute__((ext_vector_type(2)));
typedef int i32x4 __attribute__((ext_vector_type(4)));
typedef GAS unsigned gu32;

constexpr int NB = 16, SEQ = 2048, DM = 1024, NTOK = NB * SEQ, NE = 32, FF = 1024;
constexpr int NPROJ = 5376;
constexpr int C_DQ = 0, C_DK = 512, C_DV = 1024, C_GQ = 1536, C_GK = 1792, C_GV = 2048, C_GR = 2560, C_GA = 3072, C_GB = 4096, C_AL = 5120;
constexpr int W_IN_N = 5136;
constexpr float LOG2E = 1.4426950408889634f;
constexpr float QSCALE = 0.125f * LOG2E;
constexpr float EPS = 1e-6f;
constexpr int NWAVES = 8, NTHREADS = 512;

constexpr size_t MiB = 1u << 20;
constexpr size_t WS_CTL = 0, CTL_ZERO_BYTES = 1 * MiB;
constexpr size_t WS_MOD = 1 * MiB;
constexpr size_t WS_TOPE = 2 * MiB;
constexpr size_t WS_TOPW = 3 * MiB;
constexpr size_t WS_LIST = 4 * MiB;
constexpr size_t WS_WIN = 8 * MiB;
constexpr size_t WS_WBD = 19 * MiB;
constexpr size_t WS_WBG = 20 * MiB;
constexpr size_t WS_WOUT = 21 * MiB;
constexpr size_t WS_WGU = 24 * MiB;
constexpr size_t WS_WD = 152 * MiB;
constexpr size_t WS_H2 = 216 * MiB;
constexpr size_t WS_RB = 280 * MiB;
constexpr size_t WS_H = WS_RB, WS_OA = WS_RB + 64 * MiB, WS_OB = WS_RB + 96 * MiB, WS_MG = WS_RB + 128 * MiB, WS_YB = WS_RB;
constexpr size_t WS_RA = 536 * MiB;
constexpr size_t WS_PROJ = WS_RA, WS_ACT = WS_RA;
constexpr size_t WS_Y1 = WS_RA + 272 * MiB;
constexpr size_t WS_CB = WS_MOD + 512 * 1024;
constexpr size_t WS_END = 872 * MiB;
constexpr int MAX_TILES = 544;
static_assert((size_t)MAX_TILES * 256 * 1024 * 2 <= 336 * MiB, "act fits region A");
constexpr int CW_CNT = 64;
constexpr int CW_BAR = 4096;
constexpr int CW_QUEUE = 2304;

constexpr int SCR_BYTES = 159744;
constexpr int LDSCTL_OFF = SCR_BYTES, MISC_OFF = LDSCTL_OFF + 320;
constexpr int LDS_BYTES = SCR_BYTES + 1024;

#define RLX_AGENT __ATOMIC_RELAXED, __HIP_MEMORY_SCOPE_AGENT
#define LDS_WAIT() asm volatile("s_waitcnt lgkmcnt(0)" ::: "memory")

__device__ __forceinline__ unsigned f2bf(float f) { unsigned u = __builtin_bit_cast(unsigned, f); return (u + 0x7fffu + ((u >> 16) & 1u)) >> 16; }
typedef __bf16 bf16n2 __attribute__((ext_vector_type(2)));
typedef float f32x2 __attribute__((ext_vector_type(2)));
__device__ __forceinline__ unsigned pk2(float lo, float hi) { return __builtin_bit_cast(unsigned, __builtin_convertvector((f32x2){lo, hi}, bf16n2)); }
__device__ __forceinline__ unsigned pk4_fp8(float a, float b, float c, float d) { int w = 0; w = __builtin_amdgcn_cvt_pk_fp8_f32(a, b, w, false); w = __builtin_amdgcn_cvt_pk_fp8_f32(c, d, w, true); return (unsigned)w; }
constexpr float F8_ASCALE = 4.f, F8_WSCALE = 512.f;
constexpr int F8_SA = 0x7d7d7d7d, F8_SW = 0x76767676;
__device__ __forceinline__ float bf2f(unsigned b) { return __uint_as_float(b << 16); }
__device__ __forceinline__ float bflo(unsigned w) { return __uint_as_float(w << 16); }
__device__ __forceinline__ float bfhi(unsigned w) { return __uint_as_float(w & 0xffff0000u); }
__device__ __forceinline__ float wave_sum(float v) {
#pragma unroll
    for (int o = 1; o < 64; o <<= 1) v += __shfl_xor(v, o);
    return v;
}
__device__ __forceinline__ int tid_fresh() { int t = threadIdx.x; asm volatile("" : "+v"(t)); return t; }
__device__ __forceinline__ float sigmoidf_(float x) { return 1.f / (1.f + __expf(-x)); }

#define XB_TMO      128
#define XB_XCNT(j)  (256  + 64 * (j))
#define XB_XSUB(j)  (1280 + 64 * (j))
#define XB_XGEN(j)  (2304 + 64 * (j))
#define XB_TOP      3328
#define XB_TOPGEN   3392
#define XCD_BAR_WORDS 3456
#define XB_SPIN_CAP (1u << 22)
__device__ __forceinline__ unsigned xb_ld(unsigned* p)              { return __hip_atomic_load(p, __ATOMIC_RELAXED, __HIP_MEMORY_SCOPE_AGENT); }
__device__ __forceinline__ unsigned xb_add(unsigned* p, unsigned v) { return __hip_atomic_fetch_add(p, v, __ATOMIC_RELAXED, __HIP_MEMORY_SCOPE_AGENT); }
__device__ __forceinline__ unsigned xb_xcc_id() { return (unsigned)__builtin_amdgcn_s_getreg((3 << 11) | 20) & 0xFu; }
#define XB_SPIN(cond, bar) do { unsigned _sp = 0; while (cond) { __builtin_amdgcn_s_sleep(1); \
    if ((++_sp & 255u) == 0u) { if (xb_ld(&(bar)[XB_TMO])) break; if (_sp > XB_SPIN_CAP) { atomicAdd(&(bar)[XB_TMO], 1u); break; } } } } while (0)
struct XcdBarrier { unsigned* bar; unsigned x; volatile LAS unsigned* st; };
__device__ __forceinline__ XcdBarrier xcd_barrier_post(unsigned* bar, volatile LAS unsigned* st) {
    XcdBarrier b; b.bar = bar; b.x = xb_xcc_id(); b.st = st;
    if (threadIdx.x == 0) (void)xb_add(&bar[XB_XCNT(b.x)], 1u);
    return b;
}
__device__ __forceinline__ void xcd_barrier_complete(unsigned* bar, unsigned x, unsigned& nloc, unsigned& nx) {
    const unsigned G = gridDim.x * gridDim.y * gridDim.z;
    unsigned sum, cnt, mine, sp = 0u;
    for (;;) {
        sum = 0u; cnt = 0u; mine = 0u;
#pragma unroll
        for (unsigned j = 0; j < 16; ++j) { const unsigned c = xb_ld(&bar[XB_XCNT(j)]); sum += c; cnt += (c > 0u) ? 1u : 0u; mine = (j == x) ? c : mine; }
        if (sum == G) break;
        __builtin_amdgcn_s_sleep(1);
        if ((++sp & 255u) == 0u) { if (xb_ld(&bar[XB_TMO])) break; if (sp > XB_SPIN_CAP) { atomicAdd(&bar[XB_TMO], 1u); break; } }
    }
    nloc = mine > 0u ? mine : 1u; nx = cnt > 0u ? cnt : 1u;
}
__device__ __forceinline__ void xcd_barrier(const XcdBarrier& b) {
    asm volatile("s_waitcnt vmcnt(0)" ::: "memory");
    __syncthreads();
    if (threadIdx.x == 0) {
        unsigned* bar = b.bar;
        __builtin_amdgcn_s_waitcnt(0);
        unsigned nloc = b.st[0], nx = b.st[1];
        if (nloc == 0u) { xcd_barrier_complete(bar, b.x, nloc, nx); b.st[0] = nloc; b.st[1] = nx; }
        const unsigned old = xb_add(&bar[XB_XSUB(b.x)], 1u);
        const unsigned gen = old / nloc;
        if (old + 1u == (gen + 1u) * nloc) {
            __builtin_amdgcn_fence(__ATOMIC_RELEASE, "agent");
            asm volatile("s_waitcnt vmcnt(0)" ::: "memory");
            const unsigned og = xb_add(&bar[XB_TOP], 1u);
            const unsigned tg = og / nx;
            if (og + 1u == (tg + 1u) * nx) xb_add(&bar[XB_TOPGEN], 1u);
            else XB_SPIN(xb_ld(&bar[XB_TOPGEN]) == tg, bar);
            __builtin_amdgcn_fence(__ATOMIC_ACQUIRE, "agent");
            xb_add(&bar[XB_XGEN(b.x)], 1u);
            asm volatile("s_waitcnt vmcnt(0)" ::: "memory");
        } else {
            XB_SPIN(xb_ld(&bar[XB_XGEN(b.x)]) == gen, bar);
            __builtin_amdgcn_fence(__ATOMIC_ACQUIRE, "agent");
            asm volatile("s_waitcnt vmcnt(0)" ::: "memory");
        }
    }
    __syncthreads();
}

struct Ctx {
    LAS unsigned char* lds;
    int tid, lane, wid, G, bid;
    const float *x, *c, *w_ada, *b_ada, *norm1_g, *w_in, *lq1, *lk1, *lq2, *lk2, *diff_g, *w_alpha_up, *b_alpha, *gla_g,
                *w_bd, *w_bg, *w_out, *norm2_g, *w_router, *b_router, *w_gu, *b_gu, *w_dn, *b_dn, *final_g;
    float* out;
    unsigned* ctl; float* mod; int* tope; float* topw; int* list;
    bf16 *WinT, *WbdT, *WbgT, *WoutT, *WguT, *WdT, *H, *H2, *OA, *OB, *MG, *YB, *PROJ, *ACT, *Y1; float* cb;
};

constexpr int NXCD = 8, WGM = 8;
__host__ __device__ __forceinline__ int perm32(int rho) { const int n = rho >> 4, i = rho & 15; return 8 * (i >> 2) + 4 * n + (i & 3); }
struct Unit { int pm, pn, e, row0, cnt; };
struct TileOrder {
    int nM, nN, nwg, G, c;
    __device__ __forceinline__ void init(int nM_, int nN_, int G_, int c_) { nM = nM_; nN = nN_; nwg = nM * nN; G = G_; c = c_; }
    __device__ __forceinline__ bool next(int i, Unit& u) const {
        const long L = (long)i * G + c; if (L >= nwg) return false;
        int wgid = (int)L; { const int q = nwg / NXCD, r = nwg % NXCD, xcd = wgid % NXCD, off = wgid / NXCD; wgid = (xcd < r ? xcd * (q + 1) : r * (q + 1) + (xcd - r) * q) + off; }
        const int nig = WGM * nN, gid = wgid / nig, fm = gid * WGM, gsz = (nM - fm) < WGM ? (nM - fm) : WGM;
        u.pm = fm + ((wgid % nig) % gsz); u.pn = (wgid % nig) / gsz; u.e = 0; u.row0 = 0; u.cnt = 0; return true;
    }
};
struct MoeOrder {
    TileOrder t; LAS const int* tab;
    __device__ __forceinline__ bool next(int i, Unit& u) const {
        if (!t.next(i, u)) return false;
        int e = 0;
#pragma unroll 1
        for (int k = 1; k < NE; ++k) if (tab[32 + k] <= u.pm) e = k;
        u.e = e; u.row0 = (u.pm - tab[32 + e]) * 256; u.cnt = tab[e]; return true;
    }
};
struct DenseDesc {
    const bf16* A; int lda; const bf16* Bt; int K;
    __device__ __forceinline__ unsigned a_off(const Unit& u, int r) const { return (unsigned)((u.pm * 256 + r) * lda) * 2u; }
    __device__ __forceinline__ const char* a_base(const Unit&) const { return (const char*)A; }
    __device__ __forceinline__ const char* b_base(const Unit& u) const { return (const char*)Bt + (size_t)u.pn * 256 * K * 2; }
};
struct MoeUpDesc {
    const unsigned char* H2; const int* list; const unsigned char* WguT; int K;
    __device__ __forceinline__ unsigned a_off(const Unit& u, int r) const { const int slot = u.row0 + r; int tok = 0; if (slot < u.cnt) tok = list[u.e * NTOK + slot] >> 2; return (unsigned)tok * 1024u; }
    __device__ __forceinline__ const char* a_base(const Unit&) const { return (const char*)H2; }
    __device__ __forceinline__ const char* b_base(const Unit& u) const { return (const char*)WguT + ((size_t)u.e * 2048 + (size_t)u.pn * 256) * 1024; }
};
struct MoeDownDesc {
    const unsigned char* ACT; const unsigned char* WdT; int K;
    __device__ __forceinline__ unsigned a_off(const Unit& u, int r) const { return (unsigned)(u.pm * 256 + r) * 1024u; }
    __device__ __forceinline__ const char* a_base(const Unit&) const { return (const char*)ACT; }
    __device__ __forceinline__ const char* b_base(const Unit& u) const { return (const char*)WdT + ((size_t)u.e * 1024 + (size_t)u.pn * 256) * 1024; }
};

template <class Desc, class Order, class Epi>
__device__ __forceinline__ void gemm_simple(const Desc& g, const Order& S, const Epi& E) {
    const int tid = threadIdx.x, wid = __builtin_amdgcn_readfirstlane(tid >> 6), lane = tid & 63, wr = wid >> 2, wc = wid & 3, fr = lane & 15, fq = lane >> 4;
    const int K = g.K;
    Unit u;
    for (int i = 0; S.next(i, u); ++i) {
        f32x4 acc[2][2][4][2];
#pragma unroll
        for (int a = 0; a < 2; ++a)
#pragma unroll
            for (int b = 0; b < 2; ++b)
#pragma unroll
                for (int m = 0; m < 4; ++m)
#pragma unroll
                    for (int n = 0; n < 2; ++n) acc[a][b][m][n] = (f32x4){0.f, 0.f, 0.f, 0.f};
        unsigned aoff[2][4], boff[2][2];
#pragma unroll
        for (int a = 0; a < 2; ++a)
#pragma unroll
            for (int m = 0; m < 4; ++m) aoff[a][m] = g.a_off(u, a * 128 + wr * 64 + m * 16 + fr) + fq * 16;
#pragma unroll
        for (int b = 0; b < 2; ++b)
#pragma unroll
            for (int n = 0; n < 2; ++n) { const int nc = b * 128 + wc * 32 + (Epi::PERM ? perm32(n * 16 + fr) : (n * 16 + fr)); boff[b][n] = (unsigned)(nc * K) * 2u + fq * 16; }
        const char* ab = g.a_base(u); const char* bb = g.b_base(u);
#pragma unroll 1
        for (int ks = 0; ks < K / 32; ++ks) {
            bf16x8 af[2][4], bfr[2][2];
#pragma unroll
            for (int a = 0; a < 2; ++a)
#pragma unroll
                for (int m = 0; m < 4; ++m) af[a][m] = *(const bf16x8*)(ab + aoff[a][m] + ks * 64);
#pragma unroll
            for (int b = 0; b < 2; ++b)
#pragma unroll
                for (int n = 0; n < 2; ++n) bfr[b][n] = *(const bf16x8*)(bb + boff[b][n] + ks * 64);
#pragma unroll
            for (int a = 0; a < 2; ++a)
#pragma unroll
                for (int b = 0; b < 2; ++b)
#pragma unroll
                    for (int m = 0; m < 4; ++m)
#pragma unroll
                        for (int n = 0; n < 2; ++n) acc[a][b][m][n] = __builtin_amdgcn_mfma_f32_16x16x32_bf16(bfr[b][n], af[a][m], acc[a][b][m][n], 0, 0, 0);
        }
        E(acc, u, wr, wc, fr, fq);
    }
}


#ifndef PROBE_A
#define PROBE_A -1
#endif
#if PROBE_A >= 100
#define PSTAMP(ldsp, idx) do { if (blockIdx.x == 0 && threadIdx.x == 0) { volatile LAS unsigned* pm_ = (volatile LAS unsigned*)((ldsp) + MISC_OFF); const unsigned now_ = (unsigned)__builtin_amdgcn_s_memrealtime(); pm_[16 + (idx)] += now_ - pm_[15]; pm_[15] = now_; } } while (0)
#else
#define PSTAMP(ldsp, idx) do {} while (0)
#endif
constexpr int BK = 64, HALF = 128, HTB = HALF * BK * 2, STAGE_BYTES = 8 * HTB;
__host__ __device__ __forceinline__ int lds_byte(int r, int c) { const int st = (r >> 4) * 2 + (c >> 5), rr = r & 15, cc = c & 31, ob = rr * 64 + cc * 2; return st * 1024 + (ob ^ (((ob >> 9) & 1) << 5)); }
__host__ __device__ __forceinline__ void stage_rc(int b, int& R, int& C) { const int st = b / 1024, sb = b % 1024, swz = sb ^ (((sb >> 9) & 1) << 5); R = (st >> 1) * 16 + swz / 64; C = (st & 1) * 32 + (swz % 64) / 2; }

typedef int v8i32 __attribute__((ext_vector_type(8)));
__device__ __forceinline__ v8i32 cat88(bf16x8 lo, bf16x8 hi) { const i32x4 a = __builtin_bit_cast(i32x4, lo), b = __builtin_bit_cast(i32x4, hi); return (v8i32){a[0], a[1], a[2], a[3], b[0], b[1], b[2], b[3]}; }
template <class Desc, class Order, class Epi, bool ALIGN_EPI, bool FP8 = false>
__device__ __forceinline__ void gemm_phase(LAS unsigned char* lds, const Desc& g, const Order& S, const Epi& E) {
    const int tid = tid_fresh(), wid = __builtin_amdgcn_readfirstlane(tid >> 6), lane = tid & 63, wr = wid >> 2, wc = wid & 3, fr = lane & 15, fq = lane >> 4;
    const int KBy = FP8 ? g.K : 2 * g.K, nt = KBy / 128;
    int Rs[2], Cs[2]; unsigned voffB[2];
#pragma unroll
    for (int i = 0; i < 2; ++i) { stage_rc(tid * 16 + i * 8192, Rs[i], Cs[i]); const int Rb = 64 * (Rs[i] >> 5) + perm32(Rs[i] & 31); voffB[i] = (unsigned)(Rb * KBy + Cs[i] * 2); }
    unsigned vA[2][2];
    LAS u32x4* const vslot = (LAS u32x4*)(lds + STAGE_BYTES + 1024) + tid;
    const size_t kstep = (size_t)(BK * 2);
    const size_t hstepB = (size_t)32 * KBy;
    const unsigned ldsw = (unsigned)wid * 1024u;
    const int aoff = FP8 ? lds_byte(wr * 64 + fr, fq * 16) : lds_byte(wr * 64 + fr, fq * 8), boff = FP8 ? lds_byte(wc * 32 + fr, fq * 16) : lds_byte(wc * 32 + fr, fq * 8);
    constexpr int KSTR = FP8 ? 16 : 1024;
#define PG8_SA(b, h) (((b) * 2 + (h)) * HTB)
#define PG8_SB(b, h) ((4 + (b) * 2 + (h)) * HTB)
#define PG8_STAGE(bufoff, gbase, voff) do { _Pragma("unroll") for (int _i = 0; _i < 2; ++_i) \
        __builtin_amdgcn_global_load_lds((const unsigned*)((const char*)(gbase) + (voff)[_i]), (LAS unsigned*)(lds + (bufoff) + ldsw + _i * 8192), 16, 0, 0); } while (0)
#define PG8_STAGE_A(bufoff, gbase, h) do { _Pragma("unroll") for (int _i = 0; _i < 2; ++_i) \
        __builtin_amdgcn_global_load_lds((const unsigned*)((const char*)(gbase) + vA[h][_i]), (LAS unsigned*)(lds + (bufoff) + ldsw + _i * 8192), 16, 0, 0); } while (0)
#define PG8_LDA(dst, b, h) do { _Pragma("unroll") for (int m = 0; m < 4; ++m) _Pragma("unroll") for (int k = 0; k < 2; ++k) dst[m][k] = *(const LAS bf16x8*)(lds + PG8_SA(b, h) + aoff + m * 2048 + k * KSTR); } while (0)
#define PG8_LDB(dst, b, h) do { _Pragma("unroll") for (int n = 0; n < 2; ++n) _Pragma("unroll") for (int k = 0; k < 2; ++k) dst[n][k] = *(const LAS bf16x8*)(lds + PG8_SB(b, h) + boff + n * 2048 + k * KSTR); } while (0)
#define PG8_MMA(ai, bj, At, Bt) do { __builtin_amdgcn_s_setprio(1); _Pragma("unroll") for (int m = 0; m < 4; ++m) _Pragma("unroll") for (int n = 0; n < 2; ++n) { \
        if constexpr (FP8) { acc[ai][bj][m][n] = __builtin_amdgcn_mfma_scale_f32_16x16x128_f8f6f4(cat88(Bt[n][0], Bt[n][1]), cat88(At[m][0], At[m][1]), acc[ai][bj][m][n], 0, 0, 0, F8_SW, 0, F8_SA); } \
        else { _Pragma("unroll") for (int k = 0; k < 2; ++k) acc[ai][bj][m][n] = __builtin_amdgcn_mfma_f32_16x16x32_bf16(Bt[n][k], At[m][k], acc[ai][bj][m][n], 0, 0, 0); } } \
        __builtin_amdgcn_s_setprio(0); } while (0)
#define PG8_WAIT_V(n) asm volatile("s_waitcnt vmcnt(" #n ")" ::: "memory")
#define PG8_WAIT_L(n) asm volatile("s_waitcnt lgkmcnt(" #n ")" ::: "memory")
#define PG8_BAR __builtin_amdgcn_s_barrier()
#define PG8_SCHED __builtin_amdgcn_sched_barrier(0)
#define PG8_AOFFS(dst, un) do { _Pragma("unroll") for (int _h = 0; _h < 2; ++_h) _Pragma("unroll") for (int _i = 0; _i < 2; ++_i) dst[_h][_i] = g.a_off(un, _h * HALF + Rs[_i]) + (unsigned)Cs[_i] * 2u; } while (0)
    Unit cur, nxt; int ui = 0;
    if (!S.next(0, cur)) return;
    f32x4 acc[2][2][4][2];
#pragma unroll
    for (int a = 0; a < 2; ++a)
#pragma unroll
        for (int b = 0; b < 2; ++b)
#pragma unroll
            for (int m = 0; m < 4; ++m)
#pragma unroll
                for (int n = 0; n < 2; ++n) acc[a][b][m][n] = (f32x4){0.f, 0.f, 0.f, 0.f};
    bf16x8 At[4][2], B0[2][2], B1[2][2];
    const char* const Ab = g.a_base(cur);
    const char* cB = g.b_base(cur);
    PG8_AOFFS(vA, cur);
    PG8_STAGE(PG8_SB(0, 0), cB, voffB); PG8_STAGE(PG8_SB(0, 1), cB + hstepB, voffB); PG8_STAGE_A(PG8_SA(0, 0), Ab, 0); PG8_STAGE_A(PG8_SA(0, 1), Ab, 1);
    if (wr == 1) PG8_BAR;
    PG8_WAIT_V(2); PG8_BAR;
    PG8_STAGE(PG8_SB(1, 0), cB + kstep, voffB); PG8_STAGE_A(PG8_SA(1, 0), Ab + kstep, 0); PG8_STAGE(PG8_SB(1, 1), cB + hstepB + kstep, voffB);
    PG8_WAIT_V(6); PG8_BAR;
    for (;;) {
        const bool has_next = S.next(ui + 1, nxt);
        const char* nB = has_next ? g.b_base(nxt) : cB;
        if (has_next) { unsigned vn[2][2]; PG8_AOFFS(vn, nxt); *vslot = (u32x4){vn[0][0], vn[0][1], vn[1][0], vn[1][1]}; }
        PSTAMP(lds, 8);
        for (int t = 0; t < nt; t += 2) {
            const bool last = (t == nt - 2);
            const char* a1 = Ab + (size_t)(t + 1) * kstep;
            const char* a2 = last ? Ab : Ab + (size_t)(t + 2) * kstep; const char* b2 = last ? nB : cB + (size_t)(t + 2) * kstep;
            const char* a3 = a2 + kstep; const char* b3 = b2 + kstep;
            PG8_LDB(B0, 0, 0); PG8_LDB(B1, 0, 1); PG8_SCHED; PG8_LDA(At, 0, 0); PG8_STAGE_A(PG8_SA(1, 1), a1, 1);
            if (last && has_next) { const u32x4 vn = *vslot; vA[0][0] = vn.x; vA[0][1] = vn.y; vA[1][0] = vn.z; vA[1][1] = vn.w; }
            PG8_WAIT_V(8); PG8_WAIT_L(0); PG8_BAR; PG8_MMA(0, 0, At, B0); PG8_MMA(0, 1, At, B1); PG8_BAR; PG8_SCHED;
            PG8_LDA(At, 0, 1); PG8_STAGE(PG8_SB(0, 0), b2, voffB); PG8_STAGE(PG8_SB(0, 1), b2 + hstepB, voffB); PG8_STAGE_A(PG8_SA(0, 0), a2, 0);
            PG8_WAIT_V(8); PG8_WAIT_L(0); PG8_BAR; PG8_MMA(1, 0, At, B0); PG8_MMA(1, 1, At, B1); PG8_BAR; PG8_SCHED;
            PG8_LDB(B0, 1, 0); PG8_LDB(B1, 1, 1); PG8_SCHED; PG8_LDA(At, 1, 0); PG8_STAGE_A(PG8_SA(0, 1), a2, 1);
            PG8_WAIT_V(8); PG8_WAIT_L(0); PG8_BAR; PG8_MMA(0, 0, At, B0); PG8_MMA(0, 1, At, B1); PG8_BAR; PG8_SCHED;
            PG8_LDA(At, 1, 1); PG8_STAGE(PG8_SB(1, 0), b3, voffB); PG8_STAGE(PG8_SB(1, 1), b3 + hstepB, voffB); PG8_STAGE_A(PG8_SA(1, 0), a3, 0);
            PG8_WAIT_V(8); PG8_WAIT_L(0); PG8_BAR; PG8_MMA(1, 0, At, B0); PG8_MMA(1, 1, At, B1); PG8_BAR; PG8_SCHED;
        }
        PSTAMP(lds, 6);
        if constexpr (ALIGN_EPI) { if (wr == 0) PG8_BAR; }
        E(acc, cur, wr, wc, fr, fq);
        PSTAMP(lds, 7);
        if (!has_next) break;
#pragma unroll
        for (int a = 0; a < 2; ++a)
#pragma unroll
            for (int b = 0; b < 2; ++b)
#pragma unroll
                for (int m = 0; m < 4; ++m)
#pragma unroll
                    for (int n = 0; n < 2; ++n) acc[a][b][m][n] = (f32x4){0.f, 0.f, 0.f, 0.f};
        cur = nxt; cB = nB; ++ui;
        if constexpr (ALIGN_EPI) { if (wr == 1) PG8_BAR; }
    }
    PG8_WAIT_V(0);
    if constexpr (!ALIGN_EPI) { if (wr == 0) PG8_BAR; }
    PG8_BAR;
#undef PG8_SA
#undef PG8_SB
#undef PG8_STAGE
#undef PG8_STAGE_A
#undef PG8_LDA
#undef PG8_LDB
#undef PG8_MMA
#undef PG8_WAIT_V
#undef PG8_WAIT_L
#undef PG8_BAR
#undef PG8_SCHED
#undef PG8_AOFFS
}

__device__ __forceinline__ u32x4 pack8(const f32x4& v0, const f32x4& v1) { u32x4 w; w.x = pk2(v0[0], v0[1]); w.y = pk2(v0[2], v0[3]); w.z = pk2(v1[0], v1[1]); w.w = pk2(v1[2], v1[3]); return w; }
__device__ __forceinline__ void unpack8(const u32x4& w, f32x4& v0, f32x4& v1) { v0 = (f32x4){bflo(w.x), bfhi(w.x), bflo(w.y), bfhi(w.y)}; v1 = (f32x4){bflo(w.z), bfhi(w.z), bflo(w.w), bfhi(w.w)}; }
__device__ __forceinline__ float logsig16(float x) { return (fminf(x, 0.f) - log1pf(__expf(-fabsf(x)))) * (1.f / 16.f); }

__device__ __forceinline__ unsigned rot8(unsigned v) { return (unsigned)__builtin_amdgcn_update_dpp(0, (int)v, 0x128, 0xf, 0xf, false); }
__device__ __forceinline__ void pair_exchange(u32x4& a, u32x4& b, bool lo) {
    const u32x4 ra = (u32x4){rot8(a.x), rot8(a.y), rot8(a.z), rot8(a.w)}, rb = (u32x4){rot8(b.x), rot8(b.y), rot8(b.z), rot8(b.w)};
    const u32x4 na = lo ? a : rb, nb = lo ? ra : b; a = na; b = nb;
}
struct EpiProj {
    static constexpr bool PERM = true;
    bf16* P; const float* b_alpha;
    __device__ __forceinline__ void operator()(const f32x4 (&acc)[2][2][4][2], const Unit& u, int wr, int wc, int fr, int fq) const {
        const int pn = u.pn; const int mode = (pn < 2) ? 1 : (pn == 6 ? 2 : (pn == 20 ? 3 : 0));
        const int cw = pn * 256 + wc * 64 + 8 * fq; const bool lo = fr < 8;
        f32x4 bb[2][2];
#pragma unroll
        for (int bj = 0; bj < 2; ++bj) { bb[bj][0] = (f32x4){0.f, 0.f, 0.f, 0.f}; bb[bj][1] = bb[bj][0];
            if (mode == 3) { bb[bj][0] = *(const f32x4*)(b_alpha + (cw + 32 * bj - C_AL)); bb[bj][1] = *(const f32x4*)(b_alpha + (cw + 32 * bj - C_AL) + 4); } }
#pragma unroll
        for (int ai = 0; ai < 2; ++ai)
#pragma unroll
            for (int m = 0; m < 4; ++m) {
                u32x4 w[2];
#pragma unroll
                for (int bj = 0; bj < 2; ++bj) {
                    f32x4 v0 = acc[ai][bj][m][0], v1 = acc[ai][bj][m][1];
                    if (mode == 1) { v0 = v0 * QSCALE; v1 = v1 * QSCALE; }
                    else if (mode == 2) { v0 = v0 * 0.125f; v1 = v1 * 0.125f; }
                    else if (mode == 3) {
#pragma unroll
                        for (int j = 0; j < 4; ++j) { v0[j] = logsig16(v0[j] + bb[bj][0][j]); v1[j] = logsig16(v1[j] + bb[bj][1][j]); } }
                    w[bj] = pack8(v0, v1);
                }
                pair_exchange(w[0], w[1], lo);
                const int rowA = u.pm * 256 + ai * 128 + wr * 64 + m * 16 + (fr & 7); const int cc = cw + 32 * (fr >> 3);
                *(u32x4*)(P + (size_t)rowA * NPROJ + cc) = w[0];
                *(u32x4*)(P + (size_t)(rowA + 8) * NPROJ + cc) = w[1];
            }
    }
};
struct EpiBranch {
    static constexpr bool PERM = true;
    bf16* MG; const bf16* P; int gcol; int add;
    __device__ __forceinline__ void operator()(const f32x4 (&acc)[2][2][4][2], const Unit& u, int wr, int wc, int fr, int fq) const {
        const int cw = u.pn * 256 + wc * 64 + 8 * fq; const bool lo = fr < 8;
#pragma unroll
        for (int ai = 0; ai < 2; ++ai)
#pragma unroll
            for (int m = 0; m < 4; ++m) {
                const int row = u.pm * 256 + ai * 128 + wr * 64 + m * 16 + fr;
                f32x4 v[2][2];
#pragma unroll
                for (int bj = 0; bj < 2; ++bj) {
                    const u32x4 gw = *(const u32x4*)(P + (size_t)row * NPROJ + gcol + cw + 32 * bj);
                    f32x4 g0, g1; unpack8(gw, g0, g1);
                    v[bj][0] = acc[ai][bj][m][0]; v[bj][1] = acc[ai][bj][m][1];
#pragma unroll
                    for (int j = 0; j < 4; ++j) { v[bj][0][j] *= sigmoidf_(g0[j]); v[bj][1][j] *= sigmoidf_(g1[j]); }
                }
                const int rowA = u.pm * 256 + ai * 128 + wr * 64 + m * 16 + (fr & 7); const int cc = cw + 32 * (fr >> 3);
                bf16* dA = MG + (size_t)rowA * DM + cc; bf16* dB = MG + (size_t)(rowA + 8) * DM + cc;
                u32x4 wa, wb;
                if (add) {
                    u32x4 a0 = __builtin_bit_cast(u32x4, v[0][0]), a1 = __builtin_bit_cast(u32x4, v[0][1]), b0 = __builtin_bit_cast(u32x4, v[1][0]), b1 = __builtin_bit_cast(u32x4, v[1][1]);
                    pair_exchange(a0, b0, lo); pair_exchange(a1, b1, lo);
                    const u32x4 oa = *(const u32x4*)dA, ob = *(const u32x4*)dB; f32x4 o0, o1;
                    unpack8(oa, o0, o1); wa = pack8(__builtin_bit_cast(f32x4, a0) + o0, __builtin_bit_cast(f32x4, a1) + o1);
                    unpack8(ob, o0, o1); wb = pack8(__builtin_bit_cast(f32x4, b0) + o0, __builtin_bit_cast(f32x4, b1) + o1);
                } else { wa = pack8(v[0][0], v[0][1]); wb = pack8(v[1][0], v[1][1]); pair_exchange(wa, wb, lo); }
                *(u32x4*)dA = wa; *(u32x4*)dB = wb;
            }
    }
};
struct EpiOut {
    static constexpr bool PERM = true;
    bf16* Y1; const float* mod;
    __device__ __forceinline__ void operator()(const f32x4 (&acc)[2][2][4][2], const Unit& u, int wr, int wc, int fr, int fq) const {
        const int b = u.pm >> 3; const float* gt1 = mod + b * 6144 + 2048;
        const int cw = u.pn * 256 + wc * 64 + 8 * fq; const bool lo = fr < 8;
        f32x4 g[2][2];
#pragma unroll
        for (int bj = 0; bj < 2; ++bj) { g[bj][0] = *(const f32x4*)(gt1 + cw + 32 * bj); g[bj][1] = *(const f32x4*)(gt1 + cw + 32 * bj + 4); }
#pragma unroll
        for (int ai = 0; ai < 2; ++ai)
#pragma unroll
            for (int m = 0; m < 4; ++m) {
                u32x4 wa = pack8(acc[ai][0][m][0] * g[0][0], acc[ai][0][m][1] * g[0][1]), wb = pack8(acc[ai][1][m][0] * g[1][0], acc[ai][1][m][1] * g[1][1]);
                pair_exchange(wa, wb, lo);
                const int rowA = u.pm * 256 + ai * 128 + wr * 64 + m * 16 + (fr & 7); const int cc = cw + 32 * (fr >> 3);
                *(u32x4*)(Y1 + (size_t)rowA * DM + cc) = wa;
                *(u32x4*)(Y1 + (size_t)(rowA + 8) * DM + cc) = wb;
            }
    }
};
struct EpiUp {
    static constexpr bool PERM = true;
    unsigned char* ACT; const float* b_gu;
    __device__ __forceinline__ void operator()(const f32x4 (&acc)[2][2][4][2], const Unit& u, int wr, int wc, int fr, int fq) const {
        const int f0 = u.pn * 128 + wc * 32 + 8 * fq;
        const float* bg = b_gu + (size_t)u.e * 2048 + f0; const float* bu = bg + 1024;
        const f32x4 bg0 = *(const f32x4*)bg, bg1 = *(const f32x4*)(bg + 4), bu0 = *(const f32x4*)bu, bu1 = *(const f32x4*)(bu + 4);
#pragma unroll
        for (int ai = 0; ai < 2; ++ai)
#pragma unroll
            for (int m = 0; m < 4; ++m) {
                const int r = ai * 128 + wr * 64 + m * 16 + fr;
                f32x4 g0 = acc[ai][0][m][0] + bg0, g1 = acc[ai][0][m][1] + bg1, u0 = acc[ai][1][m][0] + bu0, u1 = acc[ai][1][m][1] + bu1, a0, a1;
#pragma unroll
                for (int j = 0; j < 4; ++j) {
                    float gg = fminf(g0[j], 7.f), uu = fminf(fmaxf(u0[j], -7.f), 7.f); a0[j] = (uu + 1.f) * gg * sigmoidf_(1.702f * gg);
                    gg = fminf(g1[j], 7.f); uu = fminf(fmaxf(u1[j], -7.f), 7.f); a1[j] = (uu + 1.f) * gg * sigmoidf_(1.702f * gg); }
                *(u32x2*)(ACT + (size_t)(u.pm * 256 + r) * FF + f0) = (u32x2){pk4_fp8(a0[0] * F8_ASCALE, a0[1] * F8_ASCALE, a0[2] * F8_ASCALE, a0[3] * F8_ASCALE), pk4_fp8(a1[0] * F8_ASCALE, a1[1] * F8_ASCALE, a1[2] * F8_ASCALE, a1[3] * F8_ASCALE)};
            }
    }
};
struct EpiDown {
    static constexpr bool PERM = true;
    bf16* YB; const float* b_dn; const int* list;
    __device__ __forceinline__ void operator()(const f32x4 (&acc)[2][2][4][2], const Unit& u, int wr, int wc, int fr, int fq) const {
        const int cw = u.pn * 256 + wc * 64 + 8 * fq; const bool lo = fr < 8;
        f32x4 bb[2][2];
#pragma unroll
        for (int bj = 0; bj < 2; ++bj) { const float* bp = b_dn + (size_t)u.e * DM + cw + 32 * bj; bb[bj][0] = *(const f32x4*)bp; bb[bj][1] = *(const f32x4*)(bp + 4); }
#pragma unroll
        for (int ai = 0; ai < 2; ++ai)
#pragma unroll
            for (int m = 0; m < 4; ++m) {
                const int slot = u.row0 + ai * 128 + wr * 64 + m * 16 + fr;
                const int aid = slot < u.cnt ? list[u.e * NTOK + slot] : -1;
                const int aidx = (int)rot8((unsigned)aid);
                u32x4 wa = pack8(acc[ai][0][m][0] + bb[0][0], acc[ai][0][m][1] + bb[0][1]), wb = pack8(acc[ai][1][m][0] + bb[1][0], acc[ai][1][m][1] + bb[1][1]);
                pair_exchange(wa, wb, lo);
                const int aidA = lo ? aid : aidx, aidB = lo ? aidx : aid;
                const int cc = cw + 32 * (fr >> 3);
                if (aidA >= 0) *(u32x4*)(YB + (size_t)aidA * DM + cc) = wa;
                if (aidB >= 0) *(u32x4*)(YB + (size_t)aidB * DM + cc) = wb;
            }
    }
};

constexpr int T_NITEMS = 16 * 80 + 2 * 8 * 16 + 16 * 16 + 32 * 16 * 32 + 32 * 16 * 16;
__device__ __forceinline__ void transposes(const Ctx& C, int i0, int i1, int w, int nw);
__device__ __forceinline__ void phase_mod(const Ctx& C) {
    LAS float* sc = (LAS float*)C.lds;
    LAS float* red = sc + 16 * 1024;
    for (int cb = C.bid; cb < 96; cb += C.G) {
        __syncthreads();
        for (int i = C.tid; i < 16 * 1024; i += NTHREADS) { const float v = C.c[i]; sc[i] = v / (1.f + __expf(-v)); }
        __syncthreads();
        const int cl = C.tid & 63, ks = C.tid >> 6, col = cb * 64 + cl;
        float acc[16];
#pragma unroll
        for (int b = 0; b < 16; ++b) acc[b] = 0.f;
#pragma unroll 2
        for (int k = ks * 128; k < ks * 128 + 128; k += 4) {
            const float w0 = C.w_ada[(size_t)k * 6144 + col], w1 = C.w_ada[(size_t)(k + 1) * 6144 + col], w2 = C.w_ada[(size_t)(k + 2) * 6144 + col], w3 = C.w_ada[(size_t)(k + 3) * 6144 + col];
#pragma unroll
            for (int b = 0; b < 16; ++b) { const f32x4 s4 = *(const LAS f32x4*)(sc + b * 1024 + k); acc[b] += (s4[0] * w0 + s4[1] * w1) + (s4[2] * w2 + s4[3] * w3); }
        }
#pragma unroll
        for (int b = 0; b < 16; ++b) red[(ks * 16 + b) * 64 + cl] = acc[b];
        __syncthreads();
        for (int o = C.tid; o < 1024; o += NTHREADS) {
            const int b = o >> 6, c2 = o & 63; float s = 0.f;
#pragma unroll
            for (int k2 = 0; k2 < 8; ++k2) s += red[(k2 * 16 + b) * 64 + c2];
            C.mod[b * 6144 + cb * 64 + c2] = s + C.b_ada[cb * 64 + c2];
        }
    }
    __syncthreads();
    { const int gw = C.bid * NWAVES + C.wid, NGW = C.G * NWAVES;
      if (C.G == 256) { constexpr int N1 = 11 * 2048; transposes(C, 0, N1, gw, NGW); if (C.bid >= 96) transposes(C, N1, T_NITEMS, gw - 96 * NWAVES, NGW - 96 * NWAVES); }
      else transposes(C, 0, T_NITEMS, gw, NGW); }
    for (int gt = C.bid * NTHREADS + C.tid; gt < 256 * 512; gt += C.G * NTHREADS) {
        const int j = gt >> 9, k = (gt & 511) * 2;
        float s0 = 0.f, s1 = 0.f;
#pragma unroll
        for (int r = 0; r < 16; ++r) { const float wa = C.w_alpha_up[r * 256 + j]; s0 += C.w_in[(size_t)k * W_IN_N + 3072 + r] * wa; s1 += C.w_in[(size_t)(k + 1) * W_IN_N + 3072 + r] * wa; }
        *(unsigned*)(C.WinT + (size_t)(C_AL + j) * DM + k) = pk2(s0, s1);
    }
}

struct TItem { const float* src; unsigned char* dst; int srcN, pitch, hop, fp8; };
__device__ __forceinline__ TItem titem_decode(const Ctx& C, int it) {
    constexpr int I_IN = 16 * 80, I_BD = 8 * 16, I_OUT = 16 * 16, I_GU = 32 * 16 * 32;
    TItem t; t.hop = 0; t.fp8 = 0; int r = it;
    if (r < I_IN) { const int kb = r / 80, n0 = (r % 80) * 64; t.srcN = W_IN_N; t.pitch = DM * 2; t.src = C.w_in + (size_t)(kb * 64) * W_IN_N + (n0 < 3072 ? n0 : n0 + 16); t.dst = (unsigned char*)(C.WinT + (size_t)n0 * DM + kb * 64); return t; } r -= I_IN;
    if (r < I_BD) { t.srcN = DM; t.pitch = 1024; t.src = C.w_bd + (size_t)((r >> 4) * 64) * DM + (r & 15) * 64; t.dst = (unsigned char*)(C.WbdT + (size_t)((r & 15) * 64) * 512 + (r >> 4) * 64); return t; } r -= I_BD;
    if (r < I_BD) { t.srcN = DM; t.pitch = 1024; t.src = C.w_bg + (size_t)((r >> 4) * 64) * DM + (r & 15) * 64; t.dst = (unsigned char*)(C.WbgT + (size_t)((r & 15) * 64) * 512 + (r >> 4) * 64); return t; } r -= I_BD;
    if (r < I_OUT) { t.srcN = DM; t.pitch = DM * 2; t.src = C.w_out + (size_t)((r >> 4) * 64) * DM + (r & 15) * 64; t.dst = (unsigned char*)(C.WoutT + (size_t)((r & 15) * 64) * DM + (r >> 4) * 64); return t; } r -= I_OUT;
    if (r < I_GU) { const int e = r >> 9, rr = r & 511, kb = rr >> 5, n0 = (rr & 31) * 64; const int pn = n0 >> 8, wc = (n0 >> 6) & 3;
        t.srcN = 2048; t.pitch = 1024; t.fp8 = 1; t.hop = 1024 - 32; t.src = C.w_gu + (size_t)e * DM * 2048 + (size_t)(kb * 64) * 2048 + pn * 128 + wc * 32; t.dst = (unsigned char*)C.WguT + (size_t)e * 2048 * 1024 + (size_t)n0 * 1024 + kb * 64; return t; } r -= I_GU;
    { const int e = r >> 8, rr = r & 255, kb = rr >> 4, n0 = (rr & 15) * 64;
        t.srcN = DM; t.pitch = 1024; t.fp8 = 1; t.src = C.w_dn + (size_t)e * FF * DM + (size_t)(kb * 64) * DM + n0; t.dst = (unsigned char*)C.WdT + (size_t)e * DM * 1024 + (size_t)n0 * 1024 + kb * 64; return t; }
}
__device__ __forceinline__ void titem_load(const TItem& t, int lane, f32x4 (&v)[16]) {
#pragma unroll
    for (int i = 0; i < 16; ++i) v[i] = *(const f32x4*)(t.src + (size_t)(4 * i + (lane >> 4)) * t.srcN + 4 * (lane & 15) + ((lane & 8) ? t.hop : 0));
}
__device__ __forceinline__ void titem_store(const TItem& t, int lane, const f32x4 (&v)[16], LAS float* scr) {
#pragma unroll
    for (int i = 0; i < 16; ++i) { LAS float* p = scr + (4 * i + (lane >> 4)) * 65 + 4 * (lane & 15); p[0] = v[i][0]; p[1] = v[i][1]; p[2] = v[i][2]; p[3] = v[i][3]; }
    LDS_WAIT(); asm volatile("" ::: "memory");
    const int c = lane & 7;
#pragma unroll
    for (int j = 0; j < 8; ++j) { const int n = (lane >> 3) + 8 * j; const LAS float* s = scr + (8 * c) * 65 + n;
        if (t.fp8) { float w[8];
#pragma unroll
            for (int q = 0; q < 8; ++q) w[q] = __builtin_amdgcn_fmed3f(s[q * 65] * F8_WSCALE, -440.f, 440.f);
            *(u32x2*)(t.dst + (size_t)n * t.pitch + 8 * c) = (u32x2){pk4_fp8(w[0], w[1], w[2], w[3]), pk4_fp8(w[4], w[5], w[6], w[7])}; }
        else { u32x4 o; o.x = pk2(s[0 * 65], s[1 * 65]); o.y = pk2(s[2 * 65], s[3 * 65]); o.z = pk2(s[4 * 65], s[5 * 65]); o.w = pk2(s[6 * 65], s[7 * 65]);
            *(u32x4*)(t.dst + (size_t)n * t.pitch + 16 * c) = o; } }
    LDS_WAIT(); asm volatile("" ::: "memory");
}
__device__ __forceinline__ void transposes(const Ctx& C, int i0, int i1, int w, int nw) {
    LAS float* scr = (LAS float*)(C.lds + C.wid * 16896);
    int it = i0 + w; if (it >= i1) return;
    TItem cur = titem_decode(C, it); f32x4 v[16]; titem_load(cur, C.lane, v);
    for (;;) {
        const int nit = it + nw; const bool more = nit < i1;
        TItem nxt = cur; f32x4 vn[16];
        if (more) { nxt = titem_decode(C, nit); titem_load(nxt, C.lane, vn); }
        titem_store(cur, C.lane, v, scr);
        if (!more) break;
        cur = nxt; it = nit;
#pragma unroll
        for (int i = 0; i < 16; ++i) v[i] = vn[i];
    }
}
__device__ __forceinline__ void phase_prep(const Ctx& C) {
    const int gw = C.bid * NWAVES + C.wid, NGW = C.G * NWAVES;
    for (int row = gw; row < NTOK; row += 2 * NGW) {
        const int row2 = row + NGW;
        const bool two = row2 < NTOK;
        f32x4 v[2][4]; float ss[2] = {0.f, 0.f};
#pragma unroll
        for (int j = 0; j < 4; ++j) { v[0][j] = *(const f32x4*)(C.x + (size_t)row * DM + 4 * C.lane + 256 * j); v[1][j] = two ? *(const f32x4*)(C.x + (size_t)row2 * DM + 4 * C.lane + 256 * j) : (f32x4){0.f, 0.f, 0.f, 0.f}; }
#pragma unroll
        for (int r = 0; r < 2; ++r)
#pragma unroll
            for (int j = 0; j < 4; ++j) ss[r] += (v[r][j][0] * v[r][j][0] + v[r][j][1] * v[r][j][1]) + (v[r][j][2] * v[r][j][2] + v[r][j][3] * v[r][j][3]);
#pragma unroll
        for (int r = 0; r < 2; ++r) { if (r == 1 && !two) break;
            const int rw = r ? row2 : row; const int b = rw >> 11; const float* md = C.mod + b * 6144;
            const float rstd = rsqrtf(wave_sum(ss[r]) * (1.f / DM) + EPS);
#pragma unroll
            for (int j = 0; j < 4; ++j) { const int c0 = 4 * C.lane + 256 * j;
                const f32x4 g = *(const f32x4*)(C.norm1_g + c0), sc = *(const f32x4*)(md + 1024 + c0), sh = *(const f32x4*)(md + c0);
                const f32x4 y = v[r][j] * rstd * g * (sc + 1.f) + sh;
                u32x2 o; o.x = pk2(y[0], y[1]); o.y = pk2(y[2], y[3]);
                *(u32x2*)(C.H + (size_t)rw * DM + c0) = o; } }
    }
}

__device__ __forceinline__ void gla_scan(const Ctx& C, int b, int h) {
    LAS float* qs = (LAS float*)C.lds;
    LAS float* ks = qs + 2048;
    LAS float* al = ks + 2048;
    LAS float* vs = al + 2048;
    LAS float* part = vs + 4096;
    const int dv = C.tid & 127, dkg = C.tid >> 7;
    float S[16];
#pragma unroll
    for (int j = 0; j < 16; ++j) S[j] = 0.f;
    const float gdv0 = C.gla_g[2 * C.lane], gdv1 = C.gla_g[2 * C.lane + 1];
    for (int ch = 0; ch < SEQ / 32; ++ch) {
        const int row0 = b * SEQ + ch * 32;
        __syncthreads();
        for (int i = C.tid; i < 32 * 64; i += NTHREADS) { const int t = i >> 6, d = i & 63; const bf16* pr = C.PROJ + (size_t)(row0 + t) * NPROJ;
            qs[i] = bf2f(pr[C_GQ + h * 64 + d]); ks[i] = bf2f(pr[C_GK + h * 64 + d]); al[i] = __expf(bf2f(pr[C_AL + h * 64 + d])); }
        for (int i = C.tid; i < 32 * 128; i += NTHREADS) { const int t = i >> 7, d = i & 127; vs[i] = bf2f(C.PROJ[(size_t)(row0 + t) * NPROJ + C_GV + h * 128 + d]); }
        __syncthreads();
#pragma unroll 2
        for (int t = 0; t < 32; ++t) {
            const float v = vs[t * 128 + dv]; float o = 0.f;
#pragma unroll
            for (int j4 = 0; j4 < 4; ++j4) {
                const f32x4 a4 = *(const LAS f32x4*)(al + t * 64 + dkg * 16 + j4 * 4), k4 = *(const LAS f32x4*)(ks + t * 64 + dkg * 16 + j4 * 4), q4 = *(const LAS f32x4*)(qs + t * 64 + dkg * 16 + j4 * 4);
#pragma unroll
                for (int jj = 0; jj < 4; ++jj) { const int j = j4 * 4 + jj; S[j] = a4[jj] * S[j] + k4[jj] * v; o += q4[jj] * S[j]; }
            }
            part[(dkg * 32 + t) * 128 + dv] = o;
        }
        __syncthreads();
#pragma unroll
        for (int tt = 0; tt < 4; ++tt) {
            const int t = 4 * C.wid + tt; float o0 = 0.f, o1 = 0.f;
#pragma unroll
            for (int g = 0; g < 4; ++g) { o0 += part[(g * 32 + t) * 128 + 2 * C.lane]; o1 += part[(g * 32 + t) * 128 + 2 * C.lane + 1]; }
            const float rstd = rsqrtf(wave_sum(o0 * o0 + o1 * o1) * (1.f / 128.f) + EPS);
            const unsigned grw = *(const unsigned*)(C.PROJ + (size_t)(row0 + t) * NPROJ + C_GR + h * 128 + 2 * C.lane);
            const float g0 = bflo(grw), g1 = bfhi(grw);
            const float y0 = o0 * rstd * gdv0 * (g0 * sigmoidf_(g0)), y1 = o1 * rstd * gdv1 * (g1 * sigmoidf_(g1));
            *(unsigned*)(C.OB + (size_t)(row0 + t) * 512 + h * 128 + 2 * C.lane) = pk2(y0, y1);
        }
    }
}

__device__ __forceinline__ void attn_simple(const Ctx& C) {
    LAS float* Kt = (LAS float*)C.lds;
    LAS float* Vt = Kt + 8192;
    LAS float* Ss = Vt + 8192;
    LAS float* ssq = Ss + 2 * 64 * 68;
    LAS float* lamp = ssq + 256;
    if (C.tid < 64) {
        const float a = wave_sum(C.lq1[C.lane] * C.lk1[C.lane]), b2 = wave_sum(C.lq2[C.lane] * C.lk2[C.lane]);
        if (C.tid == 0) lamp[0] = __expf(a) - __expf(b2) + 0.2f;
    }
    __syncthreads();
    const float lam = lamp[0];
    const int q = C.tid & 63, p = (C.tid >> 6) & 1, dq = C.tid >> 7;
    for (int uix = C.bid; uix < 2048; uix += C.G) {
        const int bh = uix & 63, g = (uix >> 6) & 3, i2 = uix >> 8; const int b = bh >> 2, h = bh & 3;
        const int qc = (i2 & 1) ? (31 - (4 * g + (i2 >> 1))) : (4 * g + (i2 >> 1));
        const float sl2 = exp2f(-2.f * (float)(h + 1)) * LOG2E;
        const int qrow = b * SEQ + qc * 64 + q;
        float qv[64];
#pragma unroll
        for (int d8 = 0; d8 < 8; ++d8) { const u32x4 w = *(const u32x4*)(C.PROJ + (size_t)qrow * NPROJ + C_DQ + h * 128 + p * 64 + d8 * 8);
            qv[d8 * 8 + 0] = bflo(w.x); qv[d8 * 8 + 1] = bfhi(w.x); qv[d8 * 8 + 2] = bflo(w.y); qv[d8 * 8 + 3] = bfhi(w.y);
            qv[d8 * 8 + 4] = bflo(w.z); qv[d8 * 8 + 5] = bfhi(w.z); qv[d8 * 8 + 6] = bflo(w.w); qv[d8 * 8 + 7] = bfhi(w.w); }
        float m = -1e30f, l = 0.f, acc[32];
#pragma unroll
        for (int d = 0; d < 32; ++d) acc[d] = 0.f;
        for (int kc = 0; kc <= qc; ++kc) {
            __syncthreads();
            for (int pi = C.tid; pi < 1024; pi += NTHREADS) { const int r = pi >> 4, cc = pi & 15; const bf16* pr = C.PROJ + (size_t)(b * SEQ + kc * 64 + r) * NPROJ + h * 128 + cc * 8;
                const u32x4 kw = *(const u32x4*)(pr + C_DK), vw = *(const u32x4*)(pr + C_DV); f32x4 a0, a1;
                unpack8(kw, a0, a1); *(LAS f32x4*)(Kt + r * 128 + cc * 8) = a0; *(LAS f32x4*)(Kt + r * 128 + cc * 8 + 4) = a1;
                unpack8(vw, a0, a1); *(LAS f32x4*)(Vt + r * 128 + cc * 8) = a0; *(LAS f32x4*)(Vt + r * 128 + cc * 8 + 4) = a1; }
            __syncthreads();
#pragma unroll 1
            for (int kk = 0; kk < 16; ++kk) {
                const int key = dq * 16 + kk; float s = 0.f;
#pragma unroll
                for (int d4 = 0; d4 < 16; ++d4) { const f32x4 kv = *(const LAS f32x4*)(Kt + key * 128 + p * 64 + d4 * 4);
                    s += qv[d4 * 4] * kv[0]; s += qv[d4 * 4 + 1] * kv[1]; s += qv[d4 * 4 + 2] * kv[2]; s += qv[d4 * 4 + 3] * kv[3]; }
                const int kpos = kc * 64 + key, qpos = qc * 64 + q; const int mn = kpos < 2 * qpos - kpos ? kpos : 2 * qpos - kpos;
                Ss[(p * 64 + q) * 68 + key] = s + sl2 * (float)mn;
            }
            __syncthreads();
            const LAS float* srow = Ss + (p * 64 + q) * 68;
            float cm = -1e30f;
#pragma unroll
            for (int k4 = 0; k4 < 16; ++k4) { const f32x4 sv = *(const LAS f32x4*)(srow + k4 * 4); cm = fmaxf(cm, fmaxf(fmaxf(sv[0], sv[1]), fmaxf(sv[2], sv[3]))); }
            const float mnew = fmaxf(m, cm), alpha = exp2f(m - mnew); m = mnew; l *= alpha;
#pragma unroll
            for (int d = 0; d < 32; ++d) acc[d] *= alpha;
#pragma unroll 2
            for (int key = 0; key < 64; ++key) {
                const float pk = exp2f(srow[key] - m); l += pk;
#pragma unroll
                for (int d4 = 0; d4 < 8; ++d4) { const f32x4 vv = *(const LAS f32x4*)(Vt + key * 128 + dq * 32 + d4 * 4);
                    acc[d4 * 4] += pk * vv[0]; acc[d4 * 4 + 1] += pk * vv[1]; acc[d4 * 4 + 2] += pk * vv[2]; acc[d4 * 4 + 3] += pk * vv[3]; }
            }
        }
        const float inv = 1.f / l;
        __syncthreads();
        LAS float* O2 = Ss;
        if (p == 1) {
#pragma unroll
            for (int d = 0; d < 32; ++d) O2[q * 128 + dq * 32 + d] = lam * acc[d] * inv;
        }
        __syncthreads();
        float ss = 0.f;
        if (p == 0) {
#pragma unroll
            for (int d = 0; d < 32; ++d) { acc[d] = acc[d] * inv - O2[q * 128 + dq * 32 + d]; ss += acc[d] * acc[d]; }
            ssq[q * 4 + dq] = ss;
        }
        __syncthreads();
        if (p == 0) {
            const float tot = (ssq[q * 4] + ssq[q * 4 + 1]) + (ssq[q * 4 + 2] + ssq[q * 4 + 3]);
            const float rstd = rsqrtf(tot * (1.f / 128.f) + EPS) * 0.8f;
            bf16* dst = C.OA + (size_t)qrow * 512 + h * 128 + dq * 32;
#pragma unroll
            for (int d8 = 0; d8 < 4; ++d8) { u32x4 w; const float* gg = C.diff_g + dq * 32 + d8 * 8;
                w.x = pk2(acc[d8 * 8] * rstd * gg[0], acc[d8 * 8 + 1] * rstd * gg[1]); w.y = pk2(acc[d8 * 8 + 2] * rstd * gg[2], acc[d8 * 8 + 3] * rstd * gg[3]);
                w.z = pk2(acc[d8 * 8 + 4] * rstd * gg[4], acc[d8 * 8 + 5] * rstd * gg[5]); w.w = pk2(acc[d8 * 8 + 6] * rstd * gg[6], acc[d8 * 8 + 7] * rstd * gg[7]);
                *(u32x4*)(dst + d8 * 8) = w; }
        }
    }
}


typedef float f32x16 __attribute__((ext_vector_type(16)));
typedef short s16x4 __attribute__((ext_vector_type(4)));
typedef short v4i16_t __attribute__((ext_vector_type(4)));
__device__ __forceinline__ s16x4 vtr(const LAS unsigned char* p) { return __builtin_bit_cast(s16x4, __builtin_amdgcn_ds_read_tr16_b64_v4i16((LAS v4i16_t*)p)); }
template <int OFF> __device__ __forceinline__ void glds16(const void* sbase, unsigned voff, unsigned lds_dst) {
    unsigned sv; asm volatile("s_mov_b32 %0, m0\n\ts_mov_b32 m0, %3\n\ts_nop 0\n\tglobal_load_lds_dwordx4 %1, %2 offset:%4\n\ts_mov_b32 m0, %0" : "=&s"(sv) : "v"(voff), "s"(sbase), "s"(lds_dst), "i"(OFF) : "memory"); }
__device__ __forceinline__ unsigned lds_addr(const LAS unsigned char* p) { return (unsigned)__builtin_amdgcn_readfirstlane((int)(unsigned)(size_t)p); }
#define MFMA16(a, b, c) __builtin_amdgcn_mfma_f32_16x16x32_bf16(a, b, c, 0, 0, 0)
__device__ __forceinline__ bf16x8 cat44(s16x4 lo, s16x4 hi) { return (bf16x8){lo[0], lo[1], lo[2], lo[3], hi[0], hi[1], hi[2], hi[3]}; }
__device__ __forceinline__ void gla_chunked(const Ctx& C, int b, int h) {
    const int lane = C.lane, wid = C.wid, fr = lane & 15, fq = lane >> 4;
    LAS unsigned char* lds = C.lds;
    constexpr int RAW_Q = 0, RAW_K = 8192, RAW_LA = 16384, VB0 = 24576, QS = 57344, KS = 66560, KD = 75776, AM = 84992, ST = 94208, OO = 112640, GTL = 146432, SSQ = 146688;
    constexpr int P = 144, PO = 528;
    const char* pbase = (const char*)(C.PROJ + (size_t)(b * SEQ) * NPROJ);
    const unsigned oq = (unsigned)(((8 * wid + (lane >> 3)) * NPROJ + C_GQ + h * 64 + (lane & 7) * 8) * 2);
    const unsigned okk = oq + (unsigned)((C_GK - C_GQ) * 2), ol = oq + (unsigned)((C_AL - C_GQ) * 2);
    const unsigned ov0 = (unsigned)(((4 * wid + (lane >> 4)) * NPROJ + C_GV + h * 128 + (lane & 15) * 8) * 2), ov1 = ov0 + (unsigned)(32 * NPROJ * 2);
#define GL_DMA(n) do { const char* _cb = pbase + (size_t)(n) * 64 * NPROJ * 2; const unsigned _vb = VB0 + ((n) & 1) * 16384; \
        glds16<0>(_cb, oq, lds_addr(lds + RAW_Q + wid * 1024)); glds16<0>(_cb, okk, lds_addr(lds + RAW_K + wid * 1024)); glds16<0>(_cb, ol, lds_addr(lds + RAW_LA + wid * 1024)); \
        glds16<0>(_cb, ov0, lds_addr(lds + _vb + wid * 1024)); glds16<0>(_cb, ov1, lds_addr(lds + _vb + (wid + 8) * 1024)); } while (0)
    __syncthreads();
    GL_DMA(0);
    for (int i = lane; i < 16 * P / 4; i += 64) ((LAS unsigned*)(lds + ST + wid * 16 * P))[i] = 0u;
    f32x4 accS[4];
#pragma unroll
    for (int t = 0; t < 4; ++t) accS[t] = (f32x4){0.f, 0.f, 0.f, 0.f};
    const int t1 = wid >> 1, ca = 2 * (wid & 1);
    bf16x8 ym[2][2];
#pragma unroll
    for (int ci = 0; ci < 2; ++ci)
#pragma unroll
        for (int ks = 0; ks < 2; ++ks)
#pragma unroll
            for (int jj = 0; jj < 8; ++jj) ym[ci][ks][jj] = (short)(((32 * ks + 8 * fq + jj) <= (16 * (ca + ci) + fr)) ? 0x3F80 : 0);
    const bf16x8 ones = (bf16x8){0x3F80, 0x3F80, 0x3F80, 0x3F80, 0x3F80, 0x3F80, 0x3F80, 0x3F80};
    const int qp = (lane & 15) >> 2, pp = lane & 3;
    const float g0 = C.gla_g[2 * lane], g1 = C.gla_g[2 * lane + 1];
    unsigned grw[8];
#pragma unroll
    for (int cc = 0; cc < 8; ++cc) grw[cc] = 0u;
#define GL_ROWPASS(n) do { _Pragma("unroll") for (int cc = 0; cc < 8; ++cc) { const int c_ = 8 * wid + cc; \
        const float o0 = *(const LAS float*)(lds + OO + c_ * PO + lane * 8), o1 = *(const LAS float*)(lds + OO + c_ * PO + lane * 8 + 4); \
        const f32x4 qa = *(const LAS f32x4*)(lds + SSQ + c_ * 32), qb = *(const LAS f32x4*)(lds + SSQ + c_ * 32 + 16); \
        const float rstd = rsqrtf((((qa[0] + qa[1]) + (qa[2] + qa[3])) + ((qb[0] + qb[1]) + (qb[2] + qb[3]))) * (1.f / 128.f) + EPS); const float gr0 = bflo(grw[cc]), gr1 = bfhi(grw[cc]); \
        *(unsigned*)(C.OB + (size_t)(b * SEQ + (n) * 64 + c_) * 512 + h * 128 + 2 * lane) = pk2(o0 * rstd * g0 * (gr0 * sigmoidf_(gr0)), o1 * rstd * g1 * (gr1 * sigmoidf_(gr1))); } } while (0)
#pragma unroll 1
    for (int n = 0; n < SEQ / 64; ++n) {
        asm volatile("s_waitcnt vmcnt(0) lgkmcnt(0)" ::: "memory"); __syncthreads();
        if (n > 0) GL_ROWPASS(n - 1);
#pragma unroll
        for (int cc = 0; cc < 8; ++cc) grw[cc] = *(const unsigned*)(pbase + ((size_t)(n * 64 + 8 * wid + cc) * NPROJ + C_GR + h * 128 + 2 * lane) * 2);
        {
            bf16x8 xla[2];
#pragma unroll
            for (int ks = 0; ks < 2; ++ks) { const LAS unsigned char* a = lds + RAW_LA + (32 * ks + 8 * fq + qp) * 128 + (16 * t1 + 4 * pp) * 2; xla[ks] = cat44(vtr(a), vtr(a + 4 * 128)); }
            f32x4 Ga = (f32x4){0.f, 0.f, 0.f, 0.f}, Gb = Ga, GT = Ga;
#pragma unroll
            for (int ks = 0; ks < 2; ++ks) { Ga = MFMA16(xla[ks], ym[0][ks], Ga); Gb = MFMA16(xla[ks], ym[1][ks], Gb); GT = MFMA16(xla[ks], ones, GT); }
#pragma unroll
            for (int ci = 0; ci < 2; ++ci) {
                const int c_ = 16 * (ca + ci) + fr, dk0 = 16 * t1 + 4 * fq; const f32x4 G = ci ? Gb : Ga;
                const u32x2 qw = *(const LAS u32x2*)(lds + RAW_Q + c_ * 128 + dk0 * 2), kw = *(const LAS u32x2*)(lds + RAW_K + c_ * 128 + dk0 * 2);
                const float q4[4] = {bflo(qw.x), bfhi(qw.x), bflo(qw.y), bfhi(qw.y)}, k4[4] = {bflo(kw.x), bfhi(kw.x), bflo(kw.y), bfhi(kw.y)};
                float qs4[4], ks4[4], kd4[4];
#pragma unroll
                for (int r = 0; r < 4; ++r) { qs4[r] = q4[r] * __expf(G[r]); ks4[r] = k4[r] * __expf(-G[r]); kd4[r] = k4[r] * __expf(GT[r] - G[r]); }
                *(LAS u32x2*)(lds + QS + c_ * P + dk0 * 2) = (u32x2){pk2(qs4[0], qs4[1]), pk2(qs4[2], qs4[3])};
                *(LAS u32x2*)(lds + KS + c_ * P + dk0 * 2) = (u32x2){pk2(ks4[0], ks4[1]), pk2(ks4[2], ks4[3])};
                *(LAS u32x2*)(lds + KD + c_ * P + dk0 * 2) = (u32x2){pk2(kd4[0], kd4[1]), pk2(kd4[2], kd4[3])};
            }
            if (fr == 0 && (wid & 1) == 0) *(LAS f32x4*)(lds + GTL + (16 * t1 + 4 * fq) * 4) = GT;
        }
        LDS_WAIT(); __syncthreads();
        if (n + 1 < SEQ / 64) GL_DMA(n + 1);
        {
            const int ct = wid >> 1;
#pragma unroll
            for (int si = 0; si < 2; ++si) {
                const int st = 2 * (wid & 1) + si; f32x4 D = (f32x4){0.f, 0.f, 0.f, 0.f};
                if (st <= ct) {
#pragma unroll
                    for (int ks = 0; ks < 2; ++ks) { const bf16x8 X = *(const LAS bf16x8*)(lds + KS + (16 * st + fr) * P + (32 * ks + 8 * fq) * 2), Y = *(const LAS bf16x8*)(lds + QS + (16 * ct + fr) * P + (32 * ks + 8 * fq) * 2); D = MFMA16(X, Y, D); }
#pragma unroll
                    for (int r = 0; r < 4; ++r) if (16 * st + 4 * fq + r > 16 * ct + fr) D[r] = 0.f;
                }
                *(LAS u32x2*)(lds + AM + (16 * ct + fr) * P + (16 * st + 4 * fq) * 2) = (u32x2){pk2(D[0], D[1]), pk2(D[2], D[3])};
            }
        }
        LDS_WAIT(); __builtin_amdgcn_s_barrier(); asm volatile("" ::: "memory");
        {
            const unsigned vb = VB0 + (n & 1) * 16384;
            bf16x8 X1[2], X2[2];
#pragma unroll
            for (int ks = 0; ks < 2; ++ks) { X1[ks] = *(const LAS bf16x8*)(lds + ST + (16 * wid + fr) * P + (32 * ks + 8 * fq) * 2);
                const LAS unsigned char* a = lds + vb + (32 * ks + 8 * fq + qp) * 256 + (16 * wid + 4 * pp) * 2; X2[ks] = cat44(vtr(a), vtr(a + 4 * 256)); }
#pragma unroll
            for (int ct = 0; ct < 4; ++ct) { f32x4 o = (f32x4){0.f, 0.f, 0.f, 0.f};
#pragma unroll
                for (int ks = 0; ks < 2; ++ks) { const bf16x8 Y1 = *(const LAS bf16x8*)(lds + QS + (16 * ct + fr) * P + (32 * ks + 8 * fq) * 2), Y2 = *(const LAS bf16x8*)(lds + AM + (16 * ct + fr) * P + (32 * ks + 8 * fq) * 2);
                    o = MFMA16(X1[ks], Y1, o); o = MFMA16(X2[ks], Y2, o); }
                *(LAS f32x4*)(lds + OO + (16 * ct + fr) * PO + (16 * wid + 4 * fq) * 4) = o;
                float ss = (o[0] * o[0] + o[1] * o[1]) + (o[2] * o[2] + o[3] * o[3]); ss += __shfl_xor(ss, 16); ss += __shfl_xor(ss, 32);
                if (fq == 0) *(LAS float*)(lds + SSQ + (16 * ct + fr) * 32 + wid * 4) = ss; }
#pragma unroll
            for (int tt = 0; tt < 4; ++tt) { const f32x4 dl = *(const LAS f32x4*)(lds + GTL + (16 * tt + 4 * fq) * 4);
#pragma unroll
                for (int r = 0; r < 4; ++r) accS[tt][r] *= __expf(dl[r]);
#pragma unroll
                for (int ks = 0; ks < 2; ++ks) { const LAS unsigned char* a = lds + KD + (32 * ks + 8 * fq + qp) * P + (16 * tt + 4 * pp) * 2; accS[tt] = MFMA16(cat44(vtr(a), vtr(a + 4 * P)), X2[ks], accS[tt]); }
                *(LAS u32x2*)(lds + ST + (16 * wid + fr) * P + (16 * tt + 4 * fq) * 2) = (u32x2){pk2(accS[tt][0], accS[tt][1]), pk2(accS[tt][2], accS[tt][3])}; }
        }
    }
    asm volatile("s_waitcnt vmcnt(0) lgkmcnt(0)" ::: "memory"); __syncthreads();
    GL_ROWPASS(SEQ / 64 - 1);
    __syncthreads();
#undef GL_DMA
#undef GL_ROWPASS
}

__device__ __forceinline__ int crow(int r, int hi) { return (r & 3) + 8 * (r >> 2) + 4 * hi; }
#define MFMA32(a, b, c) __builtin_amdgcn_mfma_f32_32x32x16_bf16(a, b, c, 0, 0, 0)
constexpr int AT_BUF = 32768, AT_WSF = 3 * 32768, AT_Q = 3 * 32768 + 2048;
constexpr float AT_THR = 8.f;

__device__ __forceinline__ void attn_unit(const Ctx& C, int b, int h, int cp, float lam) {
    const int lane = C.lane, r32 = lane & 31, hi = lane >> 5, wid = C.wid, p = wid >> 2, sub = wid & 3;
    const int NT = 2 * cp + 2, qch = 2 * cp + (sub >> 1), my_nt = qch + 1;
    const int row0 = b * SEQ + cp * 128;
    const int qpos = cp * 128 + sub * 32 + r32;
    const float sl2 = exp2f(-2.f * (float)(h + 1)) * LOG2E;
    LAS unsigned char* lds = C.lds;
    LAS float* wsf = (LAS float*)(lds + AT_WSF) + wid * 64;
    const char* kbase = (const char*)(C.PROJ + (size_t)(b * SEQ) * NPROJ + h * 128);
    const unsigned koff = (unsigned)((lane * NPROJ + C_DK + wid * 8) * 2);
    const unsigned voff = (unsigned)(((16 * (wid & 3) + (lane >> 2)) * NPROJ + C_DV + (wid >> 2) * 32 + (lane & 3) * 8) * 2);
#define AT_DMA(t, bufo) do { const char* _tb = kbase + (size_t)(t) * 64 * NPROJ * 2; \
        glds16<0>(_tb, koff, lds_addr(lds + (bufo) + wid * 1024)); glds16<0>(_tb, koff + 128u, lds_addr(lds + (bufo) + 8192 + wid * 1024)); \
        glds16<0>(_tb, voff, lds_addr(lds + (bufo) + 16384 + (wid >> 2) * 4096 + (wid & 3) * 1024)); glds16<0>(_tb, voff + 128u, lds_addr(lds + (bufo) + 16384 + ((wid >> 2) + 2) * 4096 + (wid & 3) * 1024)); } while (0)
    bf16x8 qr[4];
    { const bf16* qp = C.PROJ + (size_t)(row0 + sub * 32 + r32) * NPROJ + C_DQ + h * 128 + p * 64 + hi * 8;
#pragma unroll
      for (int d0 = 0; d0 < 4; ++d0) qr[d0] = *(const bf16x8*)(qp + d0 * 16); }
    AT_DMA(0, 0); AT_DMA(1, AT_BUF);
    f32x16 o[4];
#pragma unroll
    for (int d0 = 0; d0 < 4; ++d0)
#pragma unroll
        for (int i = 0; i < 16; ++i) o[d0][i] = 0.f;
    float mhat = 0.f, lsum = 0.f;
    const unsigned kofs = (unsigned)(p * 8192 + hi * 1024 + r32 * 16);
    const unsigned vofs = (unsigned)(16384 + ((lane >> 4) & 1) * 32 + (lane & 3) * 8 + (4 * hi + ((lane & 15) >> 2)) * 64);
    asm volatile("s_waitcnt vmcnt(4)" ::: "memory"); __syncthreads();
    unsigned bufo = 0, bufn1 = AT_BUF, bufn2 = 2 * AT_BUF;
#pragma unroll 1
    for (int t = 0; t < NT; ++t) {
        PSTAMP(lds, 0);
        if (t + 2 < NT) AT_DMA(t + 2, bufn2);
        PSTAMP(lds, 1);
        if (t < my_nt) {
            const LAS unsigned char* kp = lds + bufo + kofs;
            const LAS unsigned char* vp = lds + bufo + vofs;
            bf16x8 kf[8];
#pragma unroll
            for (int d0 = 0; d0 < 4; ++d0) { kf[2 * d0] = *(const LAS bf16x8*)(kp + d0 * 2048); kf[2 * d0 + 1] = *(const LAS bf16x8*)(kp + d0 * 2048 + 512); }
            s16x4 va[8], vb[8];
#define AT_VRD(dst, k) do { _Pragma("unroll") for (int d0 = 0; d0 < 4; ++d0) { dst[2 * d0] = vtr(vp + d0 * 4096 + (k) * 1024); dst[2 * d0 + 1] = vtr(vp + d0 * 4096 + (k) * 1024 + 512); } } while (0)
#define AT_PV(src_, k) do { const bf16x8 pa_ = __builtin_bit_cast(bf16x8, pw[k]); _Pragma("unroll") for (int d0 = 0; d0 < 4; ++d0) o[d0] = MFMA32(pa_, cat44(src_[2 * d0], src_[2 * d0 + 1]), o[d0]); } while (0)
            AT_VRD(va, 0);
            __builtin_amdgcn_sched_barrier(0);
            f32x16 s0, s1;
            if (t == qch) {
#pragma unroll
                for (int i = 0; i < 16; ++i) { const int k0p = 64 * t + crow(i, hi), k1p = k0p + 32;
                    s0[i] = fmaf(sl2, (float)min(k0p, 2 * qpos - k0p), -mhat); s1[i] = fmaf(sl2, (float)min(k1p, 2 * qpos - k1p), -mhat); }
            } else {
                const float bsm = sl2 * (float)(64 * t + 4 * hi) - mhat;
#pragma unroll
                for (int i = 0; i < 16; ++i) { const float ci = (float)((i & 3) + 8 * (i >> 2)); s0[i] = fmaf(sl2, ci, bsm); s1[i] = fmaf(sl2, ci + 32.f, bsm); }
            }
#pragma unroll
            for (int d0 = 0; d0 < 4; ++d0) { s0 = MFMA32(kf[2 * d0], qr[d0], s0); s1 = MFMA32(kf[2 * d0 + 1], qr[d0], s1); }
            __builtin_amdgcn_sched_barrier(0);
            float rm = fmaxf(s0[0], s1[0]);
#pragma unroll
            for (int i = 1; i < 16; ++i) rm = fmaxf(rm, fmaxf(s0[i], s1[i]));
            { auto rr = __builtin_amdgcn_permlane32_swap(__float_as_uint(rm), __float_as_uint(rm), false, false); rm = fmaxf(__uint_as_float(rr[0]), __uint_as_float(rr[1])); }
            if (t == 0 || __any(rm > AT_THR)) {
                const float dl = (t == 0) ? rm : fmaxf(rm, 0.f); mhat += dl;
                if (t != 0) {
                    const float f = __builtin_amdgcn_exp2f(-dl); lsum *= f;
                    if (hi == 0) wsf[r32] = f;
                    LDS_WAIT();
#pragma unroll
                    for (int i = 0; i < 16; ++i) { const float fi = wsf[crow(i, hi)];
#pragma unroll
                        for (int d0 = 0; d0 < 4; ++d0) o[d0][i] *= fi; }
                }
#pragma unroll
                for (int i = 0; i < 16; ++i) { s0[i] -= dl; s1[i] -= dl; }
            }
            float ps = 0.f;
#pragma unroll
            for (int i = 0; i < 16; ++i) { s0[i] = __builtin_amdgcn_exp2f(s0[i]); s1[i] = __builtin_amdgcn_exp2f(s1[i]); ps += s0[i] + s1[i]; }
            lsum += ps;
            PSTAMP(lds, 2);
            u32x4 pw[4];
            pw[0] = (u32x4){pk2(s0[0], s0[1]), pk2(s0[2], s0[3]), pk2(s0[4], s0[5]), pk2(s0[6], s0[7])};
            pw[1] = (u32x4){pk2(s0[8], s0[9]), pk2(s0[10], s0[11]), pk2(s0[12], s0[13]), pk2(s0[14], s0[15])};
            pw[2] = (u32x4){pk2(s1[0], s1[1]), pk2(s1[2], s1[3]), pk2(s1[4], s1[5]), pk2(s1[6], s1[7])};
            pw[3] = (u32x4){pk2(s1[8], s1[9]), pk2(s1[10], s1[11]), pk2(s1[12], s1[13]), pk2(s1[14], s1[15])};
            __builtin_amdgcn_sched_barrier(0);
            AT_VRD(vb, 1); AT_PV(va, 0); __builtin_amdgcn_sched_barrier(0);
            AT_VRD(va, 2); AT_PV(vb, 1); __builtin_amdgcn_sched_barrier(0);
            AT_VRD(vb, 3); AT_PV(va, 2); __builtin_amdgcn_sched_barrier(0);
            AT_PV(vb, 3);
#undef AT_VRD
#undef AT_PV
        }
        PSTAMP(lds, 3);
        if (t + 2 < NT) asm volatile("s_waitcnt vmcnt(4) lgkmcnt(0)" ::: "memory"); else asm volatile("s_waitcnt vmcnt(0) lgkmcnt(0)" ::: "memory");
        PSTAMP(lds, 4);
        __builtin_amdgcn_s_barrier(); asm volatile("" ::: "memory");
        PSTAMP(lds, 5);
        { const unsigned tb = bufo; bufo = bufn1; bufn1 = bufn2; bufn2 = tb; }
    }
#undef AT_DMA
    lsum += __shfl_xor(lsum, 32);
    if (hi == 0) wsf[32 + r32] = lsum;
    LDS_WAIT();
    LAS float* X = (LAS float*)lds;
    if (p == 1) {
#pragma unroll
        for (int i = 0; i < 16; ++i) { const float sc = lam / wsf[32 + crow(i, hi)];
#pragma unroll
            for (int d0 = 0; d0 < 4; ++d0) X[(sub * 32 + crow(i, hi)) * 128 + d0 * 32 + r32] = o[d0][i] * sc; }
    }
    __syncthreads();
    if (p == 0) {
#pragma unroll
        for (int i = 0; i < 16; ++i) { const float sc = 1.f / wsf[32 + crow(i, hi)];
#pragma unroll
            for (int d0 = 0; d0 < 4; ++d0) { LAS float* xp = X + (sub * 32 + crow(i, hi)) * 128 + d0 * 32 + r32; *xp = o[d0][i] * sc - *xp; } }
    }
    __syncthreads();
    { const float g0 = C.diff_g[2 * lane], g1 = C.diff_g[2 * lane + 1];
#pragma unroll 4
      for (int qq = 0; qq < 16; ++qq) { const int q = wid * 16 + qq; const float y0 = X[q * 128 + 2 * lane], y1 = X[q * 128 + 2 * lane + 1];
          const float rstd = rsqrtf(wave_sum(y0 * y0 + y1 * y1) * (1.f / 128.f) + EPS) * 0.8f;
          *(unsigned*)(C.OA + (size_t)(row0 + q) * 512 + h * 128 + 2 * lane) = pk2(y0 * rstd * g0, y1 * rstd * g1); } }
    __syncthreads();
}

__device__ __forceinline__ void attn_phase(const Ctx& C) {
    LAS float* lamp = (LAS float*)(C.lds + AT_Q) + 4;
    LAS int* qw = (LAS int*)(C.lds + AT_Q);
    if (C.tid < 64) {
        const float a = wave_sum(C.lq1[C.lane] * C.lk1[C.lane]), b2 = wave_sum(C.lq2[C.lane] * C.lk2[C.lane]);
        if (C.tid == 0) lamp[0] = __expf(a) - __expf(b2) + 0.2f;
    }
    __syncthreads();
    const float lam = lamp[0];
    for (;;) {
        if (C.tid == 0) qw[0] = (int)__hip_atomic_fetch_add(C.ctl + CW_QUEUE, 1u, RLX_AGENT);
        __syncthreads();
        const int item = __builtin_amdgcn_readfirstlane(qw[0]);
        __syncthreads();
        if (item >= 1024) break;
        const int bh = item & 63, cp = 15 - (item >> 6);
        attn_unit(C, bh >> 2, bh & 3, cp, lam);
    }
}

__device__ __forceinline__ void split_bf16(const float (&v)[8], bf16x8& hi, bf16x8& lo) {
    const unsigned h0 = pk2(v[0], v[1]), h1 = pk2(v[2], v[3]), h2 = pk2(v[4], v[5]), h3 = pk2(v[6], v[7]);
    const u32x4 h = (u32x4){h0, h1, h2, h3};
    const u32x4 l = (u32x4){pk2(v[0] - bflo(h0), v[1] - bfhi(h0)), pk2(v[2] - bflo(h1), v[3] - bfhi(h1)), pk2(v[4] - bflo(h2), v[5] - bfhi(h2)), pk2(v[6] - bflo(h3), v[7] - bfhi(h3))};
    hi = __builtin_bit_cast(bf16x8, h); lo = __builtin_bit_cast(bf16x8, l);
}
__device__ __forceinline__ void phase_router(const Ctx& C) {
    const int lane = C.lane, wid = C.wid, fr = lane & 15, fq = lane >> 4;
    LAS u32x4* WH = (LAS u32x4*)C.lds;
    LAS u32x4* WL = WH + 4096;
    LAS float* GS = (LAS float*)(C.lds + 131072);
    LAS float* SH = GS + 1024;
    LAS float* red = SH + 1024;
    LAS float* ssw = red + 8 * 16 * 32;
    LAS float* rs = ssw + 128;
    LAS int* lcnt = (LAS int*)(rs + 16);
    LAS int* lbase = lcnt + 32;
    LAS int* pend = lbase + 32;
    LAS float* cbl = (LAS float*)(pend + 512);
    for (int blk = C.bid; blk < NTOK / 128; blk += C.G) {
        const int b = blk >> 4; const float* md = C.mod + b * 6144;
        __syncthreads();
        for (int k = C.tid; k < DM; k += NTHREADS) { GS[k] = C.norm2_g[k] * (1.f + md[4096 + k]); SH[k] = md[3072 + k]; }
        if (C.tid < 32) lcnt[C.tid] = 0;
        pend[C.tid] = -1;
#pragma unroll 1
        for (int idx = C.tid; idx < 4096; idx += NTHREADS) {
            const int l2 = idx & 63, nt = (idx >> 6) & 1, ks = (idx >> 7) & 3, w2 = idx >> 9; float wv[8];
#pragma unroll
            for (int j = 0; j < 8; ++j) wv[j] = C.w_router[(size_t)(128 * w2 + 32 * ks + 8 * (l2 >> 4) + j) * NE + 16 * nt + (l2 & 15)];
            bf16x8 h8, l8; split_bf16(wv, h8, l8); WH[idx] = __builtin_bit_cast(u32x4, h8); WL[idx] = __builtin_bit_cast(u32x4, l8); }
        __syncthreads();
        {
            const int e = C.tid & 31, part = C.tid >> 5; float s = 0.f;
#pragma unroll 8
            for (int k = part * 64; k < part * 64 + 64; ++k) s += SH[k] * C.w_router[k * NE + e];
            red[part * 32 + e] = s;
            __syncthreads();
            if (C.tid < 32) { float t = C.b_router[C.tid];
#pragma unroll
                for (int p2 = 0; p2 < 16; ++p2) t += red[p2 * 32 + C.tid];
                cbl[C.tid] = t; }
            __syncthreads();
        }
        float x1[4][8];
#define RT_LOAD(dst, row) do { _Pragma("unroll") for (int ks = 0; ks < 4; ++ks) { const size_t o_ = (size_t)(row) * DM + 128 * wid + 32 * ks + 8 * fq; \
            const f32x4 xa = *(const f32x4*)(C.x + o_), xb = *(const f32x4*)(C.x + o_ + 4); const u32x4 yw = *(const u32x4*)(C.Y1 + o_); \
            dst[ks][0] = xa[0] + bflo(yw.x); dst[ks][1] = xa[1] + bfhi(yw.x); dst[ks][2] = xa[2] + bflo(yw.y); dst[ks][3] = xa[3] + bfhi(yw.y); \
            dst[ks][4] = xb[0] + bflo(yw.z); dst[ks][5] = xb[1] + bfhi(yw.z); dst[ks][6] = xb[2] + bflo(yw.w); dst[ks][7] = xb[3] + bfhi(yw.w); } } while (0)
        RT_LOAD(x1, blk * 128 + fr);
#pragma unroll 1
        for (int it = 0; it < 8; ++it) {
            const int row0 = blk * 128 + it * 16;
            f32x4 acc0 = (f32x4){0.f, 0.f, 0.f, 0.f}, acc1 = acc0; float ss = 0.f;
#pragma unroll
            for (int ks = 0; ks < 4; ++ks) {
                const f32x4 ga = *(const LAS f32x4*)(GS + 128 * wid + 32 * ks + 8 * fq), gb = *(const LAS f32x4*)(GS + 128 * wid + 32 * ks + 8 * fq + 4);
                float av[8];
#pragma unroll
                for (int j = 0; j < 8; ++j) { const float xv = x1[ks][j]; ss += xv * xv; av[j] = xv * (j < 4 ? ga[j] : gb[j - 4]); }
                bf16x8 ah, al; split_bf16(av, ah, al);
                const int fi = ((wid * 4 + ks) * 2) * 64 + lane;
                const bf16x8 wh0 = __builtin_bit_cast(bf16x8, WH[fi]), wh1 = __builtin_bit_cast(bf16x8, WH[fi + 64]), wl0 = __builtin_bit_cast(bf16x8, WL[fi]), wl1 = __builtin_bit_cast(bf16x8, WL[fi + 64]);
                acc0 = MFMA16(ah, wh0, acc0); acc0 = MFMA16(al, wh0, acc0); acc0 = MFMA16(ah, wl0, acc0);
                acc1 = MFMA16(ah, wh1, acc1); acc1 = MFMA16(al, wh1, acc1); acc1 = MFMA16(ah, wl1, acc1);
            }
            ss += __shfl_xor(ss, 16); ss += __shfl_xor(ss, 32);
            if (fq == 0) ssw[wid * 16 + fr] = ss;
#pragma unroll
            for (int r = 0; r < 4; ++r) { red[(wid * 16 + 4 * fq + r) * 32 + fr] = acc0[r]; red[(wid * 16 + 4 * fq + r) * 32 + 16 + fr] = acc1[r]; }
            LDS_WAIT(); __syncthreads();
            float xn[4][8];
            if (it < 7) RT_LOAD(xn, row0 + 16 + fr);
            {
                const int r = 2 * wid + (lane >> 5), e = lane & 31; float sum = 0.f, sq = 0.f;
#pragma unroll
                for (int w2 = 0; w2 < 8; ++w2) { sum += red[(w2 * 16 + r) * 32 + e]; sq += ssw[w2 * 16 + r]; }
                const float rstd = rsqrtf(sq * (1.f / DM) + EPS);
                if (e == 0) rs[r] = rstd;
                float val = rstd * sum + cbl[e];
                float tv[4]; int ti[4];
#pragma unroll
                for (int k = 0; k < 4; ++k) {
                    float bv = val; int bi = e;
#pragma unroll
                    for (int o = 16; o >= 1; o >>= 1) { const float ov = __shfl_xor(bv, o); const int oi = __shfl_xor(bi, o); if (ov > bv || (ov == bv && oi < bi)) { bv = ov; bi = oi; } }
                    tv[k] = bv; ti[k] = bi; if (e == bi) val = -3.0e38f;
                }
                const float e1 = __expf(tv[1] - tv[0]), e2 = __expf(tv[2] - tv[0]), e3 = __expf(tv[3] - tv[0]); const float inv = 1.f / (1.f + e1 + e2 + e3);
                const int row = row0 + r;
                if (e == 0) { *(f32x4*)(C.topw + (size_t)row * 4) = (f32x4){inv, e1 * inv, e2 * inv, e3 * inv}; *(i32x4*)(C.tope + (size_t)row * 4) = (i32x4){ti[0], ti[1], ti[2], ti[3]}; }
                if (e < 4) { const int ex = e == 0 ? ti[0] : (e == 1 ? ti[1] : (e == 2 ? ti[2] : ti[3]));
                    const int slot = atomicAdd((int*)(lcnt + ex), 1); pend[(it * 16 + r) * 4 + e] = (ex << 16) | slot; }
            }
            LDS_WAIT(); __syncthreads();
            {
                const float rstd = rs[fr];
#pragma unroll
                for (int ks = 0; ks < 4; ++ks) { const int k0 = 128 * wid + 32 * ks + 8 * fq;
                    const f32x4 ga = *(const LAS f32x4*)(GS + k0), gb = *(const LAS f32x4*)(GS + k0 + 4), sa = *(const LAS f32x4*)(SH + k0), sb = *(const LAS f32x4*)(SH + k0 + 4);
                    float hv[8];
#pragma unroll
                    for (int j = 0; j < 8; ++j) hv[j] = __builtin_amdgcn_fmed3f((x1[ks][j] * rstd * (j < 4 ? ga[j] : gb[j - 4]) + (j < 4 ? sa[j] : sb[j - 4])) * F8_ASCALE, -440.f, 440.f);
                    *(u32x2*)((unsigned char*)C.H2 + (size_t)(row0 + fr) * DM + k0) = (u32x2){pk4_fp8(hv[0], hv[1], hv[2], hv[3]), pk4_fp8(hv[4], hv[5], hv[6], hv[7])}; }
            }
            if (it < 7) {
#pragma unroll
                for (int ks = 0; ks < 4; ++ks)
#pragma unroll
                    for (int j = 0; j < 8; ++j) x1[ks][j] = xn[ks][j]; }
        }
#undef RT_LOAD
        __syncthreads();
        if (C.tid < 32) lbase[C.tid] = (int)__hip_atomic_fetch_add(C.ctl + CW_CNT + 64 * C.tid, (unsigned)lcnt[C.tid], RLX_AGENT);
        __syncthreads();
        { const int pv = pend[C.tid]; if (pv >= 0) { const int e = pv >> 16, slot = pv & 0xffff; C.list[e * NTOK + lbase[e] + slot] = (blk * 128 + (C.tid >> 2)) * 4 + (C.tid & 3); } }
    }
}

__device__ __forceinline__ void phase_final(const Ctx& C) {
    const int gw = C.bid * NWAVES + C.wid, NGW = C.G * NWAVES;
    for (int row = gw; row < NTOK; row += NGW) {
        const int b = row >> 11; const float* gt2 = C.mod + b * 6144 + 5120;
        const f32x4 w = *(const f32x4*)(C.topw + (size_t)row * 4);
        f32x4 v[4]; float ss = 0.f;
#pragma unroll
        for (int j = 0; j < 4; ++j) { const int c0 = 4 * C.lane + 256 * j;
            f32x4 y = (f32x4){0.f, 0.f, 0.f, 0.f};
#pragma unroll
            for (int k = 0; k < 4; ++k) { const u32x2 yw = *(const u32x2*)(C.YB + (size_t)(row * 4 + k) * DM + c0); y = y + (f32x4){bflo(yw.x), bfhi(yw.x), bflo(yw.y), bfhi(yw.y)} * w[k]; }
            const u32x2 y1w = *(const u32x2*)(C.Y1 + (size_t)row * DM + c0);
            v[j] = *(const f32x4*)(C.x + (size_t)row * DM + c0) + (f32x4){bflo(y1w.x), bfhi(y1w.x), bflo(y1w.y), bfhi(y1w.y)} + *(const f32x4*)(gt2 + c0) * y;
            ss += (v[j][0] * v[j][0] + v[j][1] * v[j][1]) + (v[j][2] * v[j][2] + v[j][3] * v[j][3]); }
        const float rstd = rsqrtf(wave_sum(ss) * (1.f / DM) + EPS);
#pragma unroll
        for (int j = 0; j < 4; ++j) { const int c0 = 4 * C.lane + 256 * j; *(f32x4*)(C.out + (size_t)row * DM + c0) = v[j] * rstd * *(const f32x4*)(C.final_g + c0); }
    }
}

#ifndef PROBE_A
#define PROBE_A -1
#endif
#ifndef PROBE_B
#define PROBE_B -1
#endif
constexpr int CW_TS = 3072;
#define STAMP(k) do { if (PROBE_A >= 0 && blockIdx.x == 0 && threadIdx.x == 0) { const Ctx Cs = make_ctx(lds); ((unsigned long long*)(Cs.ctl + CW_TS))[k] = __builtin_amdgcn_s_memrealtime(); } } while (0)
struct Args { const float* in[25]; float* out; unsigned char* ws; };
typedef const Args __attribute__((address_space(4)))* KArgs;
__device__ __forceinline__ Ctx make_ctx(LAS unsigned char* lds) {
    KArgs a = (KArgs)__builtin_amdgcn_kernarg_segment_ptr();
    asm volatile("" : "+s"(a));
    Ctx C;
    C.lds = lds;
    C.tid = tid_fresh(); C.lane = C.tid & 63; C.wid = __builtin_amdgcn_readfirstlane(C.tid >> 6); C.G = gridDim.x; C.bid = blockIdx.x;
    C.x = a->in[0]; C.c = a->in[1]; C.w_ada = a->in[2]; C.b_ada = a->in[3]; C.norm1_g = a->in[4]; C.w_in = a->in[5];
    C.lq1 = a->in[6]; C.lk1 = a->in[7]; C.lq2 = a->in[8]; C.lk2 = a->in[9]; C.diff_g = a->in[10]; C.w_alpha_up = a->in[11]; C.b_alpha = a->in[12];
    C.gla_g = a->in[13]; C.w_bd = a->in[14]; C.w_bg = a->in[15]; C.w_out = a->in[16]; C.norm2_g = a->in[17]; C.w_router = a->in[18]; C.b_router = a->in[19];
    C.w_gu = a->in[20]; C.b_gu = a->in[21]; C.w_dn = a->in[22]; C.b_dn = a->in[23]; C.final_g = a->in[24];
    C.out = a->out;
    unsigned char* ws = a->ws;
    C.ctl = (unsigned*)(ws + WS_CTL); C.mod = (float*)(ws + WS_MOD); C.tope = (int*)(ws + WS_TOPE); C.topw = (float*)(ws + WS_TOPW); C.list = (int*)(ws + WS_LIST);
    C.WinT = (bf16*)(ws + WS_WIN); C.WbdT = (bf16*)(ws + WS_WBD); C.WbgT = (bf16*)(ws + WS_WBG); C.WoutT = (bf16*)(ws + WS_WOUT); C.WguT = (bf16*)(ws + WS_WGU); C.WdT = (bf16*)(ws + WS_WD);
    C.H = (bf16*)(ws + WS_H); C.H2 = (bf16*)(ws + WS_H2); C.OA = (bf16*)(ws + WS_OA); C.OB = (bf16*)(ws + WS_OB); C.MG = (bf16*)(ws + WS_MG); C.YB = (bf16*)(ws + WS_YB);
    C.PROJ = (bf16*)(ws + WS_PROJ); C.ACT = (bf16*)(ws + WS_ACT); C.Y1 = (bf16*)(ws + WS_Y1); C.cb = (float*)(ws + WS_CB);
    return C;
}
__global__ void __launch_bounds__(NTHREADS, 2) fwd_kernel(Args args) {
    extern __shared__ __attribute__((aligned(16))) unsigned char lds_raw[];
    LAS unsigned char* lds = (LAS unsigned char*)lds_raw;
    for (int u = threadIdx.x; u < (LDS_BYTES - LDSCTL_OFF) / 4; u += NTHREADS) ((LAS unsigned*)(lds + LDSCTL_OFF))[u] = 0u;
    __syncthreads();
    volatile LAS unsigned* MISC = (volatile LAS unsigned*)(lds + MISC_OFF);
    XcdBarrier bar;
    { const Ctx C = make_ctx(lds); bar = xcd_barrier_post(C.ctl + CW_BAR, MISC + 8); }
#define GRID_BAR() xcd_barrier(bar)
    STAMP(0);

    { const Ctx C = make_ctx(lds); phase_mod(C); }
    GRID_BAR(); STAMP(1);
    { const Ctx C = make_ctx(lds); phase_prep(C); }
    GRID_BAR(); STAMP(2);
    { const Ctx C = make_ctx(lds); DenseDesc g{C.H, DM, C.WinT, DM}; TileOrder S; S.init(NTOK / 256, NPROJ / 256, C.G, C.bid); EpiProj E{C.PROJ, C.b_alpha}; gemm_phase<DenseDesc, TileOrder, EpiProj, true>(C.lds, g, S, E); }
    GRID_BAR(); STAMP(3);
    { const Ctx C = make_ctx(lds); for (int s = C.bid; s < 64; s += C.G) gla_chunked(C, s >> 2, s & 3); }
    __syncthreads(); STAMP(12);
    { const Ctx C = make_ctx(lds); attn_phase(C); }
    GRID_BAR(); STAMP(4);
    { const Ctx C = make_ctx(lds); DenseDesc g{C.OA, 512, C.WbdT, 512}; TileOrder S; S.init(NTOK / 256, DM / 256, C.G, C.bid); EpiBranch E{C.MG, C.PROJ, C_GA, 0}; gemm_phase<DenseDesc, TileOrder, EpiBranch, true>(C.lds, g, S, E); }
    GRID_BAR(); STAMP(5);
    { const Ctx C = make_ctx(lds); DenseDesc g{C.OB, 512, C.WbgT, 512}; TileOrder S; S.init(NTOK / 256, DM / 256, C.G, C.bid); EpiBranch E{C.MG, C.PROJ, C_GB, 1}; gemm_phase<DenseDesc, TileOrder, EpiBranch, true>(C.lds, g, S, E); }
    GRID_BAR(); STAMP(6);
    { const Ctx C = make_ctx(lds); DenseDesc g{C.MG, DM, C.WoutT, DM}; TileOrder S; S.init(NTOK / 256, DM / 256, C.G, C.bid); EpiOut E{C.Y1, C.mod}; gemm_phase<DenseDesc, TileOrder, EpiOut, true>(C.lds, g, S, E); }
    GRID_BAR(); STAMP(7);
    { const Ctx C = make_ctx(lds); phase_router(C); }
    GRID_BAR(); STAMP(8);
    LAS int* tab = (LAS int*)(lds + STAGE_BYTES);
    __syncthreads();
    if (threadIdx.x == 0) { const Ctx C = make_ctx(lds); int ts = 0; for (int e = 0; e < NE; ++e) { const int cnt = (int)__hip_atomic_load(C.ctl + CW_CNT + 64 * e, RLX_AGENT); tab[e] = cnt; tab[32 + e] = ts; ts += (cnt + 255) >> 8; } tab[64] = ts; }
    __syncthreads();
    { const Ctx C = make_ctx(lds); const int T = tab[64]; MoeUpDesc g{(const unsigned char*)C.H2, C.list, (const unsigned char*)C.WguT, DM}; MoeOrder S; S.t.init(T, 8, C.G, C.bid); S.tab = tab; EpiUp E{(unsigned char*)C.ACT, C.b_gu}; gemm_phase<MoeUpDesc, MoeOrder, EpiUp, true, true>(C.lds, g, S, E); }
    GRID_BAR(); STAMP(9);
    { const Ctx C = make_ctx(lds); const int T = tab[64]; MoeDownDesc g{(const unsigned char*)C.ACT, (const unsigned char*)C.WdT, FF}; MoeOrder S; S.t.init(T, 4, C.G, C.bid); S.tab = tab; EpiDown E{C.YB, C.b_dn, C.list}; gemm_phase<MoeDownDesc, MoeOrder, EpiDown, true, true>(C.lds, g, S, E); }
    GRID_BAR(); STAMP(10);
    { const Ctx C = make_ctx(lds); phase_final(C); }
#if PROBE_A >= 0
    GRID_BAR(); STAMP(11);
    if (blockIdx.x == 0 && threadIdx.x == 0) {
        const Ctx C = make_ctx(lds); const unsigned long long* ts = (const unsigned long long*)(C.ctl + CW_TS);
        asm volatile("s_waitcnt vmcnt(0)" ::: "memory");
        const unsigned long long dt = (PROBE_A >= 100) ? (unsigned long long)((volatile LAS unsigned*)(lds + MISC_OFF))[16 + (PROBE_A >= 100 ? PROBE_A - 100 : 0)] : ((PROBE_A == 12) ? ts[12] - ts[3] : ts[(PROBE_A < 12 ? PROBE_A : 0) + 1] - ts[PROBE_A < 12 ? PROBE_A : 0]), t0 = __builtin_amdgcn_s_memrealtime();
        while (__builtin_amdgcn_s_memrealtime() - t0 < 4ull * dt) __builtin_amdgcn_s_sleep(8);
    }
#endif
}

extern "C" void kernel_launch(void* const* d_in, const int* in_sizes, int n_in, void* d_out, int out_size, void* d_ws, size_t ws_size, hipStream_t stream) {
    static int grid = 0;
    if (grid == 0) {
        if (n_in != 25 || in_sizes[0] != NTOK * DM || out_size != NTOK * DM || ws_size < WS_END) {
            fprintf(stderr, "kernel_launch: unexpected shapes (n_in %d, in0 %d, out %d, ws %zu < %zu)\n", n_in, n_in > 0 ? in_sizes[0] : -1, out_size, ws_size, (size_t)WS_END); grid = -1; return; }
        int dev = 0, cus = 0;
        if (hipGetDevice(&dev) != hipSuccess || hipDeviceGetAttribute(&cus, hipDeviceAttributeMultiprocessorCount, dev) != hipSuccess) { grid = -1; return; }
        if (hipFuncSetAttribute((const void*)fwd_kernel, hipFuncAttributeMaxDynamicSharedMemorySize, LDS_BYTES) != hipSuccess) { fprintf(stderr, "kernel_launch: hipFuncSetAttribute failed\n"); grid = -1; return; }
        (void)hipGetLastError();
        grid = cus;
    }
    if (grid < 0) return;
    if (hipMemsetAsync((char*)d_ws + WS_CTL, 0, CTL_ZERO_BYTES, stream) != hipSuccess) { fprintf(stderr, "kernel_launch: memset failed\n"); return; }
    Args a{};
    for (int i = 0; i < 25; ++i) a.in[i] = (const float*)d_in[i];
    a.out = (float*)d_out; a.ws = (unsigned char*)d_ws;
    hipLaunchKernelGGL(fwd_kernel, dim3(grid), dim3(NTHREADS), LDS_BYTES, stream, a);
}
```

```cpp
#include <hip/hip_runtime.h>
#include <cstdio>
#include <cstdint>

#define GAS __attribute__((address_space(1)))
#define LAS __attribute__((address_space(3)))
typedef unsigned short bf16;
typedef short bf16x8 __attribute__((ext_vector_type(8)));
typedef float f32x4 __attribute__((ext_vector_type(4)));
typedef unsigned u32x4 __attribute__((ext_vector_type(4)));
typedef unsigned u32x2 __attribute__((ext_vector_type(2)));
typedef int i32x4 __attribute__((ext_vector_type(4)));
typedef GAS unsigned gu32;

constexpr int NB = 16, SEQ = 2048, DM = 1024, NTOK = NB * SEQ, NE = 32, FF = 1024;
constexpr int NPROJ = 5376;
constexpr int C_DQ = 0, C_DK = 512, C_DV = 1024, C_GQ = 1536, C_GK = 1792, C_GV = 2048, C_GR = 2560, C_GA = 3072, C_GB = 4096, C_AL = 5120;
constexpr int W_IN_N = 5136;
constexpr float LOG2E = 1.4426950408889634f;
constexpr float QSCALE = 0.125f * LOG2E;
constexpr float EPS = 1e-6f;
constexpr int NWAVES = 8, NTHREADS = 512;

constexpr size_t MiB = 1u << 20;
constexpr size_t WS_CTL = 0, CTL_ZERO_BYTES = 1 * MiB;
constexpr size_t WS_MOD = 1 * MiB;
constexpr size_t WS_TOPE = 2 * MiB;
constexpr size_t WS_TOPW = 3 * MiB;
constexpr size_t WS_LIST = 4 * MiB;
constexpr size_t WS_WIN = 8 * MiB;
constexpr size_t WS_WBD = 19 * MiB;
constexpr size_t WS_WBG = 20 * MiB;
constexpr size_t WS_WOUT = 21 * MiB;
constexpr size_t WS_WGU = 24 * MiB;
constexpr size_t WS_WD = 152 * MiB;
constexpr size_t WS_H2 = 216 * MiB;
constexpr size_t WS_RB = 280 * MiB;
constexpr size_t WS_H = WS_RB, WS_OA = WS_RB + 64 * MiB, WS_OB = WS_RB + 96 * MiB, WS_MG = WS_RB + 128 * MiB, WS_YB = WS_RB;
constexpr size_t WS_RA = 536 * MiB;
constexpr size_t WS_PROJ = WS_RA, WS_ACT = WS_RA;
constexpr size_t WS_Y1 = WS_RA + 272 * MiB;
constexpr size_t WS_CB = WS_MOD + 512 * 1024;
constexpr size_t WS_WRF = WS_MOD + 768 * 1024;
constexpr size_t WS_END = 872 * MiB;
constexpr int MAX_TILES = 544;
static_assert((size_t)MAX_TILES * 256 * 1024 * 2 <= 336 * MiB, "act fits region A");
constexpr int CW_CNT = 64;
constexpr int CW_BAR = 4096;
constexpr int CW_QUEUE = 2304;

constexpr int SCR_BYTES = 159744;
constexpr int LDSCTL_OFF = SCR_BYTES, MISC_OFF = LDSCTL_OFF + 320;
constexpr int LDS_BYTES = SCR_BYTES + 1024;

#define RLX_AGENT __ATOMIC_RELAXED, __HIP_MEMORY_SCOPE_AGENT
#define LDS_WAIT() asm volatile("s_waitcnt lgkmcnt(0)" ::: "memory")

__device__ __forceinline__ unsigned f2bf(float f) { unsigned u = __builtin_bit_cast(unsigned, f); return (u + 0x7fffu + ((u >> 16) & 1u)) >> 16; }
typedef __bf16 bf16n2 __attribute__((ext_vector_type(2)));
typedef float f32x2 __attribute__((ext_vector_type(2)));
__device__ __forceinline__ unsigned pk2(float lo, float hi) { return __builtin_bit_cast(unsigned, __builtin_convertvector((f32x2){lo, hi}, bf16n2)); }
__device__ __forceinline__ unsigned pk4_fp8(float a, float b, float c, float d) { int w = 0; w = __builtin_amdgcn_cvt_pk_fp8_f32(a, b, w, false); w = __builtin_amdgcn_cvt_pk_fp8_f32(c, d, w, true); return (unsigned)w; }
constexpr float F8_ASCALE = 4.f, F8_WSCALE = 512.f;
constexpr int F8_SA = 0x7d7d7d7d, F8_SW = 0x76767676;
__device__ __forceinline__ float bf2f(unsigned b) { return __uint_as_float(b << 16); }
__device__ __forceinline__ float bflo(unsigned w) { return __uint_as_float(w << 16); }
__device__ __forceinline__ float bfhi(unsigned w) { return __uint_as_float(w & 0xffff0000u); }
__device__ __forceinline__ float wave_sum(float v) {
#pragma unroll
    for (int o = 1; o < 64; o <<= 1) v += __shfl_xor(v, o);
    return v;
}
__device__ __forceinline__ int tid_fresh() { int t = threadIdx.x; asm volatile("" : "+v"(t)); return t; }
__device__ __forceinline__ float sigmoidf_(float x) { return 1.f / (1.f + __expf(-x)); }

#define XB_TMO      128
#define XB_XCNT(j)  (256  + 64 * (j))
#define XB_XSUB(j)  (1280 + 64 * (j))
#define XB_XGEN(j)  (2304 + 64 * (j))
#define XB_TOP      3328
#define XB_TOPGEN   3392
#define XCD_BAR_WORDS 3456
#define XB_SPIN_CAP (1u << 22)
__device__ __forceinline__ unsigned xb_ld(unsigned* p)              { return __hip_atomic_load(p, __ATOMIC_RELAXED, __HIP_MEMORY_SCOPE_AGENT); }
__device__ __forceinline__ unsigned xb_add(unsigned* p, unsigned v) { return __hip_atomic_fetch_add(p, v, __ATOMIC_RELAXED, __HIP_MEMORY_SCOPE_AGENT); }
__device__ __forceinline__ unsigned xb_xcc_id() { return (unsigned)__builtin_amdgcn_s_getreg((3 << 11) | 20) & 0xFu; }
#define XB_SPIN(cond, bar) do { unsigned _sp = 0; while (cond) { __builtin_amdgcn_s_sleep(1); \
    if ((++_sp & 255u) == 0u) { if (xb_ld(&(bar)[XB_TMO])) break; if (_sp > XB_SPIN_CAP) { atomicAdd(&(bar)[XB_TMO], 1u); break; } } } } while (0)
struct XcdBarrier { unsigned* bar; unsigned x; volatile LAS unsigned* st; };
__device__ __forceinline__ XcdBarrier xcd_barrier_post(unsigned* bar, volatile LAS unsigned* st) {
    XcdBarrier b; b.bar = bar; b.x = xb_xcc_id(); b.st = st;
    if (threadIdx.x == 0) (void)xb_add(&bar[XB_XCNT(b.x)], 1u);
    return b;
}
__device__ __forceinline__ void xcd_barrier_complete(unsigned* bar, unsigned x, unsigned& nloc, unsigned& nx) {
    const unsigned G = gridDim.x * gridDim.y * gridDim.z;
    unsigned sum, cnt, mine, sp = 0u;
    for (;;) {
        sum = 0u; cnt = 0u; mine = 0u;
#pragma unroll
        for (unsigned j = 0; j < 16; ++j) { const unsigned c = xb_ld(&bar[XB_XCNT(j)]); sum += c; cnt += (c > 0u) ? 1u : 0u; mine = (j == x) ? c : mine; }
        if (sum == G) break;
        __builtin_amdgcn_s_sleep(1);
        if ((++sp & 255u) == 0u) { if (xb_ld(&bar[XB_TMO])) break; if (sp > XB_SPIN_CAP) { atomicAdd(&bar[XB_TMO], 1u); break; } }
    }
    nloc = mine > 0u ? mine : 1u; nx = cnt > 0u ? cnt : 1u;
}
__device__ __forceinline__ void xcd_barrier(const XcdBarrier& b) {
    asm volatile("s_waitcnt vmcnt(0)" ::: "memory");
    __syncthreads();
    if (threadIdx.x == 0) {
        unsigned* bar = b.bar;
        __builtin_amdgcn_s_waitcnt(0);
        unsigned nloc = b.st[0], nx = b.st[1];
        if (nloc == 0u) { xcd_barrier_complete(bar, b.x, nloc, nx); b.st[0] = nloc; b.st[1] = nx; }
        const unsigned old = xb_add(&bar[XB_XSUB(b.x)], 1u);
        const unsigned gen = old / nloc;
        if (old + 1u == (gen + 1u) * nloc) {
            __builtin_amdgcn_fence(__ATOMIC_RELEASE, "agent");
            asm volatile("s_waitcnt vmcnt(0)" ::: "memory");
            const unsigned og = xb_add(&bar[XB_TOP], 1u);
            const unsigned tg = og / nx;
            if (og + 1u == (tg + 1u) * nx) xb_add(&bar[XB_TOPGEN], 1u);
            else XB_SPIN(xb_ld(&bar[XB_TOPGEN]) == tg, bar);
            __builtin_amdgcn_fence(__ATOMIC_ACQUIRE, "agent");
            xb_add(&bar[XB_XGEN(b.x)], 1u);
            asm volatile("s_waitcnt vmcnt(0)" ::: "memory");
        } else {
            XB_SPIN(xb_ld(&bar[XB_XGEN(b.x)]) == gen, bar);
            __builtin_amdgcn_fence(__ATOMIC_ACQUIRE, "agent");
            asm volatile("s_waitcnt vmcnt(0)" ::: "memory");
        }
    }
    __syncthreads();
}

struct Ctx {
    LAS unsigned char* lds;
    int tid, lane, wid, G, bid;
    const float *x, *c, *w_ada, *b_ada, *norm1_g, *w_in, *lq1, *lk1, *lq2, *lk2, *diff_g, *w_alpha_up, *b_alpha, *gla_g,
                *w_bd, *w_bg, *w_out, *norm2_g, *w_router, *b_router, *w_gu, *b_gu, *w_dn, *b_dn, *final_g;
    float* out;
    unsigned* ctl; float* mod; int* tope; float* topw; int* list;
    bf16 *WinT, *WbdT, *WbgT, *WoutT, *WguT, *WdT, *H, *H2, *OA, *OB, *MG, *YB, *PROJ, *ACT, *Y1; float* cb; u32x4* wrf;
};

constexpr int NXCD = 8, WGM = 8;
__host__ __device__ __forceinline__ int perm32(int rho) { const int n = rho >> 4, i = rho & 15; return 8 * (i >> 2) + 4 * n + (i & 3); }
struct Unit { int pm, pn, e, row0, cnt; };
struct TileOrder {
    int nM, nN, nwg, G, c, wgm;
    __device__ __forceinline__ void init(int nM_, int nN_, int G_, int c_, int wgm_ = WGM) { nM = nM_; nN = nN_; nwg = nM * nN; G = G_; c = c_; wgm = wgm_; }
    __device__ __forceinline__ bool next(int i, Unit& u) const {
        const long L = (long)i * G + c; if (L >= nwg) return false;
        int wgid = (int)L; { const int q = nwg / NXCD, r = nwg % NXCD, xcd = wgid % NXCD, off = wgid / NXCD; wgid = (xcd < r ? xcd * (q + 1) : r * (q + 1) + (xcd - r) * q) + off; }
        const int nig = wgm * nN, gid = wgid / nig, fm = gid * wgm, gsz = (nM - fm) < wgm ? (nM - fm) : wgm;
        u.pm = fm + ((wgid % nig) % gsz); u.pn = (wgid % nig) / gsz; u.e = 0; u.row0 = 0; u.cnt = 0; return true;
    }
};
struct MoeOrder {
    TileOrder t; LAS const int* tab;
    __device__ __forceinline__ bool next(int i, Unit& u) const {
        if (!t.next(i, u)) return false;
        const int e = tab[65 + u.pm];
        u.e = e; u.row0 = (u.pm - tab[32 + e]) * 256; u.cnt = tab[e]; return true;
    }
};
struct DenseDesc {
    static constexpr bool GATHER = false;
    const bf16* A; int lda; const bf16* Bt; int K;
    __device__ __forceinline__ unsigned a_off(const Unit& u, int r) const { return (unsigned)((u.pm * 256 + r) * lda) * 2u; }
    __device__ __forceinline__ const char* a_base(const Unit&) const { return (const char*)A; }
    __device__ __forceinline__ const char* b_base(const Unit& u) const { return (const char*)Bt + (size_t)u.pn * 256 * K * 2; }
};
struct MoeUpDesc {
    static constexpr bool GATHER = true;
    const unsigned char* H2; const int* list; const unsigned char* WguT; int K;
    __device__ __forceinline__ const int* id_src(const Unit& u, int j) const { const int s = u.row0 + j; return list + (size_t)u.e * NTOK + (s < NTOK ? s : NTOK - 1); }
    __device__ __forceinline__ unsigned a_off(const Unit& u, int r) const { const int slot = u.row0 + r; int tok = 0; if (slot < u.cnt) tok = list[u.e * NTOK + slot] >> 2; return (unsigned)tok * 1024u; }
    __device__ __forceinline__ const char* a_base(const Unit&) const { return (const char*)H2; }
    __device__ __forceinline__ const char* b_base(const Unit& u) const { return (const char*)WguT + ((size_t)u.e * 2048 + (size_t)u.pn * 256) * 1024; }
};
struct MoeDownDesc {
    static constexpr bool GATHER = false;
    const unsigned char* ACT; const unsigned char* WdT; int K;
    __device__ __forceinline__ unsigned a_off(const Unit& u, int r) const { return (unsigned)(u.pm * 256 + r) * 1024u; }
    __device__ __forceinline__ const char* a_base(const Unit&) const { return (const char*)ACT; }
    __device__ __forceinline__ const char* b_base(const Unit& u) const { return (const char*)WdT + ((size_t)u.e * 1024 + (size_t)u.pn * 256) * 1024; }
};

template <class Desc, class Order, class Epi>
__device__ __forceinline__ void gemm_simple(const Desc& g, const Order& S, const Epi& E) {
    const int tid = threadIdx.x, wid = __builtin_amdgcn_readfirstlane(tid >> 6), lane = tid & 63, wr = wid >> 2, wc = wid & 3, fr = lane & 15, fq = lane >> 4;
    const int K = g.K;
    Unit u;
    for (int i = 0; S.next(i, u); ++i) {
        f32x4 acc[2][2][4][2];
#pragma unroll
        for (int a = 0; a < 2; ++a)
#pragma unroll
            for (int b = 0; b < 2; ++b)
#pragma unroll
                for (int m = 0; m < 4; ++m)
#pragma unroll
                    for (int n = 0; n < 2; ++n) acc[a][b][m][n] = (f32x4){0.f, 0.f, 0.f, 0.f};
        unsigned aoff[2][4], boff[2][2];
#pragma unroll
        for (int a = 0; a < 2; ++a)
#pragma unroll
            for (int m = 0; m < 4; ++m) aoff[a][m] = g.a_off(u, a * 128 + wr * 64 + m * 16 + fr) + fq * 16;
#pragma unroll
        for (int b = 0; b < 2; ++b)
#pragma unroll
            for (int n = 0; n < 2; ++n) { const int nc = b * 128 + wc * 32 + (Epi::PERM ? perm32(n * 16 + fr) : (n * 16 + fr)); boff[b][n] = (unsigned)(nc * K) * 2u + fq * 16; }
        const char* ab = g.a_base(u); const char* bb = g.b_base(u);
#pragma unroll 1
        for (int ks = 0; ks < K / 32; ++ks) {
            bf16x8 af[2][4], bfr[2][2];
#pragma unroll
            for (int a = 0; a < 2; ++a)
#pragma unroll
                for (int m = 0; m < 4; ++m) af[a][m] = *(const bf16x8*)(ab + aoff[a][m] + ks * 64);
#pragma unroll
            for (int b = 0; b < 2; ++b)
#pragma unroll
                for (int n = 0; n < 2; ++n) bfr[b][n] = *(const bf16x8*)(bb + boff[b][n] + ks * 64);
#pragma unroll
            for (int a = 0; a < 2; ++a)
#pragma unroll
                for (int b = 0; b < 2; ++b)
#pragma unroll
                    for (int m = 0; m < 4; ++m)
#pragma unroll
                        for (int n = 0; n < 2; ++n) acc[a][b][m][n] = __builtin_amdgcn_mfma_f32_16x16x32_bf16(bfr[b][n], af[a][m], acc[a][b][m][n], 0, 0, 0);
        }
        E(acc, u, wr, wc, fr, fq);
    }
}


#ifndef PROBE_A
#define PROBE_A -1
#endif
#if PROBE_A >= 100
#define PSTAMP(ldsp, idx) do { if (blockIdx.x == 0 && threadIdx.x == 0) { volatile LAS unsigned* pm_ = (volatile LAS unsigned*)((ldsp) + MISC_OFF); const unsigned now_ = (unsigned)__builtin_amdgcn_s_memrealtime(); pm_[16 + (idx)] += now_ - pm_[15]; pm_[15] = now_; } } while (0)
#else
#define PSTAMP(ldsp, idx) do {} while (0)
#endif
constexpr int BK = 64, HALF = 128, HTB = HALF * BK * 2, STAGE_BYTES = 8 * HTB;
__host__ __device__ __forceinline__ int lds_byte(int r, int c) { const int st = (r >> 4) * 2 + (c >> 5), rr = r & 15, cc = c & 31, ob = rr * 64 + cc * 2; return st * 1024 + (ob ^ (((ob >> 9) & 1) << 5)); }
__host__ __device__ __forceinline__ void stage_rc(int b, int& R, int& C) { const int st = b / 1024, sb = b % 1024, swz = sb ^ (((sb >> 9) & 1) << 5); R = (st >> 1) * 16 + swz / 64; C = (st & 1) * 32 + (swz % 64) / 2; }

typedef int v8i32 __attribute__((ext_vector_type(8)));
__device__ __forceinline__ v8i32 cat88(bf16x8 lo, bf16x8 hi) { const i32x4 a = __builtin_bit_cast(i32x4, lo), b = __builtin_bit_cast(i32x4, hi); return (v8i32){a[0], a[1], a[2], a[3], b[0], b[1], b[2], b[3]}; }
template <class Desc, class Order, class Epi, bool ALIGN_EPI, bool FP8 = false, int PID = 0>
__device__ __forceinline__ void gemm_phase(LAS unsigned char* lds, const Desc& g, const Order& S, const Epi& E) {
    const int tid = tid_fresh(), wid = __builtin_amdgcn_readfirstlane(tid >> 6), lane = tid & 63, wr = wid >> 2, wc = wid & 3, fr = lane & 15, fq = lane >> 4;
    const int KBy = FP8 ? g.K : 2 * g.K, nt = KBy / 128;
    int Rs[2], Cs[2]; unsigned voffB[2];
#pragma unroll
    for (int i = 0; i < 2; ++i) { stage_rc(tid * 16 + i * 8192, Rs[i], Cs[i]); const int Rb = 64 * (Rs[i] >> 5) + perm32(Rs[i] & 31); voffB[i] = (unsigned)(Rb * KBy + Cs[i] * 2); }
    unsigned vA[2][2];
    LAS u32x4* const vslot = (LAS u32x4*)(lds + STAGE_BYTES + 4096) + tid;
    const size_t kstep = (size_t)(BK * 2);
    const size_t hstepB = (size_t)32 * KBy;
    const unsigned ldsw = (unsigned)wid * 1024u;
    const int aoff = FP8 ? lds_byte(wr * 64 + fr, fq * 16) : lds_byte(wr * 64 + fr, fq * 8), boff = FP8 ? lds_byte(wc * 32 + fr, fq * 16) : lds_byte(wc * 32 + fr, fq * 8);
    constexpr int KSTR = FP8 ? 16 : 1024;
#define PG8_SA(b, h) (((b) * 2 + (h)) * HTB)
#define PG8_SB(b, h) ((4 + (b) * 2 + (h)) * HTB)
#define PG8_STAGE(bufoff, gbase, voff) do { _Pragma("unroll") for (int _i = 0; _i < 2; ++_i) \
        __builtin_amdgcn_global_load_lds((const unsigned*)((const char*)(gbase) + (voff)[_i]), (LAS unsigned*)(lds + (bufoff) + ldsw + _i * 8192), 16, 0, 0); } while (0)
#define PG8_STAGE_A(bufoff, gbase, h) do { _Pragma("unroll") for (int _i = 0; _i < 2; ++_i) \
        __builtin_amdgcn_global_load_lds((const unsigned*)((const char*)(gbase) + vA[h][_i]), (LAS unsigned*)(lds + (bufoff) + ldsw + _i * 8192), 16, 0, 0); } while (0)
#define PG8_LDA(dst, b, h) do { _Pragma("unroll") for (int m = 0; m < 4; ++m) _Pragma("unroll") for (int k = 0; k < 2; ++k) dst[m][k] = *(const LAS bf16x8*)(lds + PG8_SA(b, h) + aoff + m * 2048 + k * KSTR); } while (0)
#define PG8_LDB(dst, b, h) do { _Pragma("unroll") for (int n = 0; n < 2; ++n) _Pragma("unroll") for (int k = 0; k < 2; ++k) dst[n][k] = *(const LAS bf16x8*)(lds + PG8_SB(b, h) + boff + n * 2048 + k * KSTR); } while (0)
#define PG8_MMA(ai, bj, At, Bt) do { __builtin_amdgcn_s_setprio(1); _Pragma("unroll") for (int m = 0; m < 4; ++m) _Pragma("unroll") for (int n = 0; n < 2; ++n) { \
        if constexpr (FP8) { acc[ai][bj][m][n] = __builtin_amdgcn_mfma_scale_f32_16x16x128_f8f6f4(cat88(Bt[n][0], Bt[n][1]), cat88(At[m][0], At[m][1]), acc[ai][bj][m][n], 0, 0, 0, F8_SW, 0, F8_SA); } \
        else { _Pragma("unroll") for (int k = 0; k < 2; ++k) acc[ai][bj][m][n] = __builtin_amdgcn_mfma_f32_16x16x32_bf16(Bt[n][k], At[m][k], acc[ai][bj][m][n], 0, 0, 0); } } \
        __builtin_amdgcn_s_setprio(0); } while (0)
#define PG8_WAIT_V(n) asm volatile("s_waitcnt vmcnt(" #n ")" ::: "memory")
#define PG8_WAIT_L(n) asm volatile("s_waitcnt lgkmcnt(" #n ")" ::: "memory")
#define PG8_BAR __builtin_amdgcn_s_barrier()
#define PG8_SCHED __builtin_amdgcn_sched_barrier(0)
#define PG8_KBODY(t) do { \
            const bool last = (t == nt - 2); \
            const char* a1 = Ab + (size_t)(t + 1) * kstep; \
            const char* a2 = last ? Ab : Ab + (size_t)(t + 2) * kstep; const char* b2 = last ? nB : cB + (size_t)(t + 2) * kstep; \
            const char* a3 = a2 + kstep; const char* b3 = b2 + kstep; \
              \
            PG8_LDB(B0, 0, 0); PG8_LDB(B1, 0, 1); PG8_SCHED; PG8_LDA(At, 0, 0); PG8_STAGE_A(PG8_SA(1, 1), a1, 1); \
            if (last && has_next) { if constexpr (Desc::GATHER) { _Pragma("unroll") for (int _h = 0; _h < 2; ++_h) _Pragma("unroll") for (int _i = 0; _i < 2; ++_i) { const int _j = _h * HALF + Rs[_i]; const int _id = idbuf[((ui + 1) & 1) * 256 + _j]; vA[_h][_i] = ((nxt.row0 + _j < nxt.cnt) ? (unsigned)(_id >> 2) * 1024u : 0u) + (unsigned)Cs[_i] * 2u; } } else { const u32x4 vn = *vslot; vA[0][0] = vn.x; vA[0][1] = vn.y; vA[1][0] = vn.z; vA[1][1] = vn.w; } }     \
            PG8_WAIT_V(8); PG8_WAIT_L(0); PG8_BAR; PG8_MMA(0, 0, At, B0); PG8_MMA(0, 1, At, B1); PG8_BAR; PG8_SCHED; \
              \
            PG8_LDA(At, 0, 1); PG8_STAGE(PG8_SB(0, 0), b2, voffB); PG8_STAGE(PG8_SB(0, 1), b2 + hstepB, voffB); PG8_STAGE_A(PG8_SA(0, 0), a2, 0); \
            PG8_WAIT_V(8); PG8_WAIT_L(0); PG8_BAR; PG8_MMA(1, 0, At, B0); PG8_MMA(1, 1, At, B1); PG8_BAR; PG8_SCHED; \
              \
            PG8_LDB(B0, 1, 0); PG8_LDB(B1, 1, 1); PG8_SCHED; PG8_LDA(At, 1, 0); PG8_STAGE_A(PG8_SA(0, 1), a2, 1); \
            PG8_WAIT_V(8); PG8_WAIT_L(0); PG8_BAR; PG8_MMA(0, 0, At, B0); PG8_MMA(0, 1, At, B1); PG8_BAR; PG8_SCHED; \
              \
            PG8_LDA(At, 1, 1); PG8_STAGE(PG8_SB(1, 0), b3, voffB); PG8_STAGE(PG8_SB(1, 1), b3 + hstepB, voffB); PG8_STAGE_A(PG8_SA(1, 0), a3, 0); \
            PG8_WAIT_V(8); PG8_WAIT_L(0); PG8_BAR; PG8_MMA(1, 0, At, B0); PG8_MMA(1, 1, At, B1); PG8_BAR; PG8_SCHED; \
        } while (0)
#define PG8_AOFFS(dst, un) do { _Pragma("unroll") for (int _h = 0; _h < 2; ++_h) _Pragma("unroll") for (int _i = 0; _i < 2; ++_i) dst[_h][_i] = g.a_off(un, _h * HALF + Rs[_i]) + (unsigned)Cs[_i] * 2u; } while (0)
    Unit cur, nxt; int ui = 0;
    if (!S.next(0, cur)) return;
    LAS int* const idbuf = (LAS int*)(lds + STAGE_BYTES + 4096);
#define PG8_IDDMA(un, b) do { if (wid < 4) __builtin_amdgcn_global_load_lds((const unsigned*)g.id_src(un, 64 * wid + lane), (LAS unsigned*)(idbuf + (b) * 256 + 64 * wid), 4, 0, 0); } while (0)
    if constexpr (Desc::GATHER) { Unit u1; if (S.next(1, u1)) PG8_IDDMA(u1, 1); }
    f32x4 acc[2][2][4][2];
#pragma unroll
    for (int a = 0; a < 2; ++a)
#pragma unroll
        for (int b = 0; b < 2; ++b)
#pragma unroll
            for (int m = 0; m < 4; ++m)
#pragma unroll
                for (int n = 0; n < 2; ++n) acc[a][b][m][n] = (f32x4){0.f, 0.f, 0.f, 0.f};
    bf16x8 At[4][2], B0[2][2], B1[2][2];
    const char* const Ab = g.a_base(cur);
    const char* cB = g.b_base(cur);
    PG8_AOFFS(vA, cur);
    PG8_STAGE(PG8_SB(0, 0), cB, voffB); PG8_STAGE(PG8_SB(0, 1), cB + hstepB, voffB); PG8_STAGE_A(PG8_SA(0, 0), Ab, 0); PG8_STAGE_A(PG8_SA(0, 1), Ab, 1);
    if (wr == 1) PG8_BAR;
    PG8_WAIT_V(2); PG8_BAR;
    PG8_STAGE(PG8_SB(1, 0), cB + kstep, voffB); PG8_STAGE_A(PG8_SA(1, 0), Ab + kstep, 0); PG8_STAGE(PG8_SB(1, 1), cB + hstepB + kstep, voffB);
    PG8_WAIT_V(6); PG8_BAR;
    for (;;) {
        const bool has_next = S.next(ui + 1, nxt);
        const char* nB = has_next ? g.b_base(nxt) : cB;
        if constexpr (Desc::GATHER) { Unit u2; if (S.next(ui + 2, u2)) PG8_IDDMA(u2, ui & 1); }
        else if (has_next) { unsigned vn[2][2]; PG8_AOFFS(vn, nxt); *vslot = (u32x4){vn[0][0], vn[0][1], vn[1][0], vn[1][1]}; }
        PSTAMP(lds, 40 + PID);
        if constexpr (Epi::MIDK) {
            for (int t = 0; t < nt / 2; t += 2) PG8_KBODY(t);
            E.mid(acc, cur, wr, wc, fr, fq);
            for (int t = nt / 2; t < nt; t += 2) PG8_KBODY(t);
        } else {
            for (int t = 0; t < nt; t += 2) PG8_KBODY(t);
        }
        PSTAMP(lds, 20 + PID);
        if constexpr (ALIGN_EPI) { if (wr == 0) PG8_BAR; }
        E(acc, cur, wr, wc, fr, fq);
        PSTAMP(lds, 30 + PID);
        if (!has_next) break;
#pragma unroll
        for (int a = 0; a < 2; ++a)
#pragma unroll
            for (int b = 0; b < 2; ++b)
#pragma unroll
                for (int m = 0; m < 4; ++m)
#pragma unroll
                    for (int n = 0; n < 2; ++n) acc[a][b][m][n] = (f32x4){0.f, 0.f, 0.f, 0.f};
        cur = nxt; cB = nB; ++ui;
        if constexpr (ALIGN_EPI) { if (wr == 1) PG8_BAR; }
    }
    PG8_WAIT_V(0);
    if constexpr (!ALIGN_EPI) { if (wr == 0) PG8_BAR; }
    PG8_BAR;
#undef PG8_SA
#undef PG8_SB
#undef PG8_STAGE
#undef PG8_STAGE_A
#undef PG8_LDA
#undef PG8_LDB
#undef PG8_MMA
#undef PG8_WAIT_V
#undef PG8_WAIT_L
#undef PG8_BAR
#undef PG8_SCHED
#undef PG8_AOFFS
#undef PG8_KBODY
#undef PG8_IDDMA
}

__device__ __forceinline__ u32x4 pack8(const f32x4& v0, const f32x4& v1) { u32x4 w; w.x = pk2(v0[0], v0[1]); w.y = pk2(v0[2], v0[3]); w.z = pk2(v1[0], v1[1]); w.w = pk2(v1[2], v1[3]); return w; }
__device__ __forceinline__ void unpack8(const u32x4& w, f32x4& v0, f32x4& v1) { v0 = (f32x4){bflo(w.x), bfhi(w.x), bflo(w.y), bfhi(w.y)}; v1 = (f32x4){bflo(w.z), bfhi(w.z), bflo(w.w), bfhi(w.w)}; }
__device__ __forceinline__ float logsig16(float x) { return (fminf(x, 0.f) - log1pf(__expf(-fabsf(x)))) * (1.f / 16.f); }

__device__ __forceinline__ unsigned rot8(unsigned v) { return (unsigned)__builtin_amdgcn_update_dpp(0, (int)v, 0x128, 0xf, 0xf, false); }
__device__ __forceinline__ void pair_exchange(u32x4& a, u32x4& b, bool lo) {
    const u32x4 ra = (u32x4){rot8(a.x), rot8(a.y), rot8(a.z), rot8(a.w)}, rb = (u32x4){rot8(b.x), rot8(b.y), rot8(b.z), rot8(b.w)};
    const u32x4 na = lo ? a : rb, nb = lo ? ra : b; a = na; b = nb;
}
struct EpiProj {
    static constexpr bool PERM = true, MIDK = false;
    bf16* P; const float* b_alpha;
    __device__ __forceinline__ void operator()(const f32x4 (&acc)[2][2][4][2], const Unit& u, int wr, int wc, int fr, int fq) const {
        const int pn = u.pn; const int mode = (pn < 2) ? 1 : (pn == 6 ? 2 : (pn == 20 ? 3 : 0));
        const int cw = pn * 256 + wc * 64 + 8 * fq; const bool lo = fr < 8;
        f32x4 bb[2][2];
#pragma unroll
        for (int bj = 0; bj < 2; ++bj) { bb[bj][0] = (f32x4){0.f, 0.f, 0.f, 0.f}; bb[bj][1] = bb[bj][0];
            if (mode == 3) { bb[bj][0] = *(const f32x4*)(b_alpha + (cw + 32 * bj - C_AL)); bb[bj][1] = *(const f32x4*)(b_alpha + (cw + 32 * bj - C_AL) + 4); } }
#pragma unroll
        for (int ai = 0; ai < 2; ++ai)
#pragma unroll
            for (int m = 0; m < 4; ++m) {
                u32x4 w[2];
#pragma unroll
                for (int bj = 0; bj < 2; ++bj) {
                    f32x4 v0 = acc[ai][bj][m][0], v1 = acc[ai][bj][m][1];
                    if (mode == 1) { v0 = v0 * QSCALE; v1 = v1 * QSCALE; }
                    else if (mode == 2) { v0 = v0 * 0.125f; v1 = v1 * 0.125f; }
                    else if (mode == 3) {
#pragma unroll
                        for (int j = 0; j < 4; ++j) { v0[j] = logsig16(v0[j] + bb[bj][0][j]); v1[j] = logsig16(v1[j] + bb[bj][1][j]); } }
                    w[bj] = pack8(v0, v1);
                }
                pair_exchange(w[0], w[1], lo);
                const int rowA = u.pm * 256 + ai * 128 + wr * 64 + m * 16 + (fr & 7); const int cc = cw + 32 * (fr >> 3);
                *(u32x4*)(P + (size_t)rowA * NPROJ + cc) = w[0];
                *(u32x4*)(P + (size_t)(rowA + 8) * NPROJ + cc) = w[1];
            }
    }
};
struct EpiBranch {
    static constexpr bool PERM = true, MIDK = true;
    bf16* MG; const bf16* P;
    __device__ __forceinline__ void mid(f32x4 (&acc)[2][2][4][2], const Unit& u, int wr, int wc, int fr, int fq) const {
        const int cw = u.pn * 256 + wc * 64 + 8 * fq;
#pragma unroll
        for (int ai = 0; ai < 2; ++ai)
#pragma unroll
            for (int m = 0; m < 4; ++m) {
                const bf16* pr = P + (size_t)(u.pm * 256 + ai * 128 + wr * 64 + m * 16 + fr) * NPROJ + cw;
#pragma unroll
                for (int bj = 0; bj < 2; ++bj) {
                    const u32x4 gaw = *(const u32x4*)(pr + C_GA + 32 * bj), gbw = *(const u32x4*)(pr + C_GB + 32 * bj);
                    f32x4 a0, a1, b0, b1; unpack8(gaw, a0, a1); unpack8(gbw, b0, b1);
#pragma unroll
                    for (int j = 0; j < 4; ++j) {
                        acc[ai][bj][m][0][j] *= (1.f + __expf(-__builtin_amdgcn_fmed3f(b0[j], -30.f, 30.f))) * __builtin_amdgcn_rcpf(1.f + __expf(-a0[j]));
                        acc[ai][bj][m][1][j] *= (1.f + __expf(-__builtin_amdgcn_fmed3f(b1[j], -30.f, 30.f))) * __builtin_amdgcn_rcpf(1.f + __expf(-a1[j])); }
                }
                if (m & 1) asm volatile("" ::: "memory");
            }
    }
    __device__ __forceinline__ void operator()(const f32x4 (&acc)[2][2][4][2], const Unit& u, int wr, int wc, int fr, int fq) const {
        const int cw = u.pn * 256 + wc * 64 + 8 * fq; const bool lo = fr < 8;
#pragma unroll
        for (int ai = 0; ai < 2; ++ai)
#pragma unroll
            for (int m = 0; m < 4; ++m) {
                const int row = u.pm * 256 + ai * 128 + wr * 64 + m * 16 + fr;
                u32x4 w[2];
#pragma unroll
                for (int bj = 0; bj < 2; ++bj) {
                    const u32x4 gbw = *(const u32x4*)(P + (size_t)row * NPROJ + C_GB + cw + 32 * bj);
                    f32x4 b0, b1; unpack8(gbw, b0, b1);
                    f32x4 v0 = acc[ai][bj][m][0], v1 = acc[ai][bj][m][1];
#pragma unroll
                    for (int j = 0; j < 4; ++j) { v0[j] *= __builtin_amdgcn_rcpf(1.f + __expf(-__builtin_amdgcn_fmed3f(b0[j], -30.f, 30.f))); v1[j] *= __builtin_amdgcn_rcpf(1.f + __expf(-__builtin_amdgcn_fmed3f(b1[j], -30.f, 30.f))); }
                    w[bj] = pack8(v0, v1);
                }
                pair_exchange(w[0], w[1], lo);
                const int rowA = u.pm * 256 + ai * 128 + wr * 64 + m * 16 + (fr & 7); const int cc = cw + 32 * (fr >> 3);
                *(u32x4*)(MG + (size_t)rowA * DM + cc) = w[0];
                *(u32x4*)(MG + (size_t)(rowA + 8) * DM + cc) = w[1];
            }
    }
};
struct EpiOut {
    static constexpr bool PERM = true, MIDK = false;
    bf16* Y1; const float* mod;
    __device__ __forceinline__ void operator()(const f32x4 (&acc)[2][2][4][2], const Unit& u, int wr, int wc, int fr, int fq) const {
        const int b = u.pm >> 3; const float* gt1 = mod + b * 6144 + 2048;
        const int cw = u.pn * 256 + wc * 64 + 8 * fq; const bool lo = fr < 8;
        f32x4 g[2][2];
#pragma unroll
        for (int bj = 0; bj < 2; ++bj) { g[bj][0] = *(const f32x4*)(gt1 + cw + 32 * bj); g[bj][1] = *(const f32x4*)(gt1 + cw + 32 * bj + 4); }
#pragma unroll
        for (int ai = 0; ai < 2; ++ai)
#pragma unroll
            for (int m = 0; m < 4; ++m) {
                u32x4 wa = pack8(acc[ai][0][m][0] * g[0][0], acc[ai][0][m][1] * g[0][1]), wb = pack8(acc[ai][1][m][0] * g[1][0], acc[ai][1][m][1] * g[1][1]);
                pair_exchange(wa, wb, lo);
                const int rowA = u.pm * 256 + ai * 128 + wr * 64 + m * 16 + (fr & 7); const int cc = cw + 32 * (fr >> 3);
                *(u32x4*)(Y1 + (size_t)rowA * DM + cc) = wa;
                *(u32x4*)(Y1 + (size_t)(rowA + 8) * DM + cc) = wb;
            }
    }
};
struct EpiUp {
    static constexpr bool PERM = true, MIDK = false;
    unsigned char* ACT; const float* b_gu;
    __device__ __forceinline__ void operator()(const f32x4 (&acc)[2][2][4][2], const Unit& u, int wr, int wc, int fr, int fq) const {
        const int f0 = u.pn * 128 + wc * 32 + 8 * fq;
        const float* bg = b_gu + (size_t)u.e * 2048 + f0; const float* bu = bg + 1024;
        const f32x4 bg0 = *(const f32x4*)bg, bg1 = *(const f32x4*)(bg + 4), bu0 = *(const f32x4*)bu, bu1 = *(const f32x4*)(bu + 4);
#pragma unroll
        for (int ai = 0; ai < 2; ++ai)
#pragma unroll
            for (int m = 0; m < 4; ++m) {
                const int r = ai * 128 + wr * 64 + m * 16 + fr;
                f32x4 g0 = acc[ai][0][m][0] + bg0, g1 = acc[ai][0][m][1] + bg1, u0 = acc[ai][1][m][0] + bu0, u1 = acc[ai][1][m][1] + bu1, a0, a1;
#pragma unroll
                for (int j = 0; j < 4; ++j) {
                    float gg = fminf(g0[j], 7.f), uu = fminf(fmaxf(u0[j], -7.f), 7.f); a0[j] = (uu + 1.f) * gg * sigmoidf_(1.702f * gg);
                    gg = fminf(g1[j], 7.f); uu = fminf(fmaxf(u1[j], -7.f), 7.f); a1[j] = (uu + 1.f) * gg * sigmoidf_(1.702f * gg); }
                *(u32x2*)(ACT + (size_t)(u.pm * 256 + r) * FF + f0) = (u32x2){pk4_fp8(a0[0] * F8_ASCALE, a0[1] * F8_ASCALE, a0[2] * F8_ASCALE, a0[3] * F8_ASCALE), pk4_fp8(a1[0] * F8_ASCALE, a1[1] * F8_ASCALE, a1[2] * F8_ASCALE, a1[3] * F8_ASCALE)};
            }
    }
};
struct EpiDown {
    static constexpr bool PERM = true, MIDK = false;
    bf16* YB; const float* b_dn; const int* list;
    __device__ __forceinline__ void operator()(const f32x4 (&acc)[2][2][4][2], const Unit& u, int wr, int wc, int fr, int fq) const {
        const int cw = u.pn * 256 + wc * 64 + 8 * fq; const bool lo = fr < 8;
        f32x4 bb[2][2];
#pragma unroll
        for (int bj = 0; bj < 2; ++bj) { const float* bp = b_dn + (size_t)u.e * DM + cw + 32 * bj; bb[bj][0] = *(const f32x4*)bp; bb[bj][1] = *(const f32x4*)(bp + 4); }
#pragma unroll
        for (int ai = 0; ai < 2; ++ai)
#pragma unroll
            for (int m = 0; m < 4; ++m) {
                const int slot = u.row0 + ai * 128 + wr * 64 + m * 16 + fr;
                const int aid = slot < u.cnt ? list[u.e * NTOK + slot] : -1;
                const int aidx = (int)rot8((unsigned)aid);
                u32x4 wa = pack8(acc[ai][0][m][0] + bb[0][0], acc[ai][0][m][1] + bb[0][1]), wb = pack8(acc[ai][1][m][0] + bb[1][0], acc[ai][1][m][1] + bb[1][1]);
                pair_exchange(wa, wb, lo);
                const int aidA = lo ? aid : aidx, aidB = lo ? aidx : aid;
                const int cc = cw + 32 * (fr >> 3);
                if (aidA >= 0) *(u32x4*)(YB + (size_t)aidA * DM + cc) = wa;
                if (aidB >= 0) *(u32x4*)(YB + (size_t)aidB * DM + cc) = wb;
            }
    }
};

__device__ __forceinline__ void split_bf16(const float (&v)[8], bf16x8& hi, bf16x8& lo) {
    const unsigned h0 = pk2(v[0], v[1]), h1 = pk2(v[2], v[3]), h2 = pk2(v[4], v[5]), h3 = pk2(v[6], v[7]);
    const u32x4 h = (u32x4){h0, h1, h2, h3};
    const u32x4 l = (u32x4){pk2(v[0] - bflo(h0), v[1] - bfhi(h0)), pk2(v[2] - bflo(h1), v[3] - bfhi(h1)), pk2(v[4] - bflo(h2), v[5] - bfhi(h2)), pk2(v[6] - bflo(h3), v[7] - bfhi(h3))};
    hi = __builtin_bit_cast(bf16x8, h); lo = __builtin_bit_cast(bf16x8, l);
}
constexpr int T_NITEMS = 16 * 80 + 2 * 8 * 16 + 16 * 16 + 32 * 16 * 32 + 32 * 16 * 16;
__device__ __forceinline__ void transposes(const Ctx& C, int i0, int i1, int w, int nw);
__device__ __forceinline__ void phase_mod(const Ctx& C) {
    LAS float* sc = (LAS float*)C.lds;
    LAS float* red = sc + 16 * 1024;
    for (int cb = C.bid; cb < 96; cb += C.G) {
        __syncthreads();
        for (int i = C.tid; i < 16 * 1024; i += NTHREADS) { const float v = C.c[i]; sc[i] = v / (1.f + __expf(-v)); }
        __syncthreads();
        const int cl = C.tid & 63, ks = C.tid >> 6, col = cb * 64 + cl;
        float acc[16];
#pragma unroll
        for (int b = 0; b < 16; ++b) acc[b] = 0.f;
#pragma unroll 2
        for (int k = ks * 128; k < ks * 128 + 128; k += 4) {
            const float w0 = C.w_ada[(size_t)k * 6144 + col], w1 = C.w_ada[(size_t)(k + 1) * 6144 + col], w2 = C.w_ada[(size_t)(k + 2) * 6144 + col], w3 = C.w_ada[(size_t)(k + 3) * 6144 + col];
#pragma unroll
            for (int b = 0; b < 16; ++b) { const f32x4 s4 = *(const LAS f32x4*)(sc + b * 1024 + k); acc[b] += (s4[0] * w0 + s4[1] * w1) + (s4[2] * w2 + s4[3] * w3); }
        }
#pragma unroll
        for (int b = 0; b < 16; ++b) red[(ks * 16 + b) * 64 + cl] = acc[b];
        __syncthreads();
        for (int o = C.tid; o < 1024; o += NTHREADS) {
            const int b = o >> 6, c2 = o & 63; float s = 0.f;
#pragma unroll
            for (int k2 = 0; k2 < 8; ++k2) s += red[(k2 * 16 + b) * 64 + c2];
            C.mod[b * 6144 + cb * 64 + c2] = s + C.b_ada[cb * 64 + c2];
        }
    }
    __syncthreads();
    { const int gw = C.bid * NWAVES + C.wid, NGW = C.G * NWAVES;
      if (C.G == 256) { constexpr int N1 = 11 * 2048; transposes(C, 0, N1, gw, NGW); if (C.bid >= 96) transposes(C, N1, T_NITEMS, gw - 96 * NWAVES, NGW - 96 * NWAVES); }
      else transposes(C, 0, T_NITEMS, gw, NGW); }
    for (int idx = C.bid * NTHREADS + C.tid; idx < 4096; idx += C.G * NTHREADS) {
        const int l2 = idx & 63, nt = (idx >> 6) & 1, ks = (idx >> 7) & 3, w2 = idx >> 9; float wv[8];
#pragma unroll
        for (int j = 0; j < 8; ++j) wv[j] = C.w_router[(size_t)(128 * w2 + 32 * ks + 8 * (l2 >> 4) + j) * NE + 16 * nt + (l2 & 15)];
        bf16x8 h8, l8; split_bf16(wv, h8, l8); C.wrf[idx] = __builtin_bit_cast(u32x4, h8); C.wrf[4096 + idx] = __builtin_bit_cast(u32x4, l8); }
    for (int gt = C.bid * NTHREADS + C.tid; gt < 256 * 512; gt += C.G * NTHREADS) {
        const int j = gt >> 9, k = (gt & 511) * 2;
        float s0 = 0.f, s1 = 0.f;
#pragma unroll
        for (int r = 0; r < 16; ++r) { const float wa = C.w_alpha_up[r * 256 + j]; s0 += C.w_in[(size_t)k * W_IN_N + 3072 + r] * wa; s1 += C.w_in[(size_t)(k + 1) * W_IN_N + 3072 + r] * wa; }
        *(unsigned*)(C.WinT + (size_t)(C_AL + j) * DM + k) = pk2(s0, s1);
    }
}

struct TItem { const float* src; unsigned char* dst; int srcN, pitch, hop, fp8; };
__device__ __forceinline__ TItem titem_decode(const Ctx& C, int it) {
    constexpr int I_IN = 16 * 80, I_BD = 8 * 16, I_OUT = 16 * 16, I_GU = 32 * 16 * 32;
    TItem t; t.hop = 0; t.fp8 = 0; int r = it;
    if (r < I_IN) { const int kb = r / 80, n0 = (r % 80) * 64; t.srcN = W_IN_N; t.pitch = DM * 2; t.src = C.w_in + (size_t)(kb * 64) * W_IN_N + (n0 < 3072 ? n0 : n0 + 16); t.dst = (unsigned char*)(C.WinT + (size_t)n0 * DM + kb * 64); return t; } r -= I_IN;
    if (r < I_BD) { t.srcN = DM; t.pitch = 2048; t.src = C.w_bd + (size_t)((r >> 4) * 64) * DM + (r & 15) * 64; t.dst = (unsigned char*)(C.WbdT + (size_t)((r & 15) * 64) * 1024 + (r >> 4) * 64); return t; } r -= I_BD;
    if (r < I_BD) { t.srcN = DM; t.pitch = 2048; t.src = C.w_bg + (size_t)((r >> 4) * 64) * DM + (r & 15) * 64; t.dst = (unsigned char*)(C.WbdT + (size_t)((r & 15) * 64) * 1024 + 512 + (r >> 4) * 64); return t; } r -= I_BD;
    if (r < I_OUT) { t.srcN = DM; t.pitch = DM * 2; t.src = C.w_out + (size_t)((r >> 4) * 64) * DM + (r & 15) * 64; t.dst = (unsigned char*)(C.WoutT + (size_t)((r & 15) * 64) * DM + (r >> 4) * 64); return t; } r -= I_OUT;
    if (r < I_GU) { const int e = r >> 9, rr = r & 511, kb = rr >> 5, n0 = (rr & 31) * 64; const int pn = n0 >> 8, wc = (n0 >> 6) & 3;
        t.srcN = 2048; t.pitch = 1024; t.fp8 = 1; t.hop = 1024 - 32; t.src = C.w_gu + (size_t)e * DM * 2048 + (size_t)(kb * 64) * 2048 + pn * 128 + wc * 32; t.dst = (unsigned char*)C.WguT + (size_t)e * 2048 * 1024 + (size_t)n0 * 1024 + kb * 64; return t; } r -= I_GU;
    { const int e = r >> 8, rr = r & 255, kb = rr >> 4, n0 = (rr & 15) * 64;
        t.srcN = DM; t.pitch = 1024; t.fp8 = 1; t.src = C.w_dn + (size_t)e * FF * DM + (size_t)(kb * 64) * DM + n0; t.dst = (unsigned char*)C.WdT + (size_t)e * DM * 1024 + (size_t)n0 * 1024 + kb * 64; return t; }
}
__device__ __forceinline__ void titem_load(const TItem& t, int lane, f32x4 (&v)[16]) {
#pragma unroll
    for (int i = 0; i < 16; ++i) v[i] = *(const f32x4*)(t.src + (size_t)(4 * i + (lane >> 4)) * t.srcN + 4 * (lane & 15) + ((lane & 8) ? t.hop : 0));
}
__device__ __forceinline__ void titem_store(const TItem& t, int lane, const f32x4 (&v)[16], LAS float* scr) {
#pragma unroll
    for (int i = 0; i < 16; ++i) { LAS float* p = scr + (4 * i + (lane >> 4)) * 65 + 4 * (lane & 15); p[0] = v[i][0]; p[1] = v[i][1]; p[2] = v[i][2]; p[3] = v[i][3]; }
    LDS_WAIT(); asm volatile("" ::: "memory");
    const int c = lane & 7;
#pragma unroll
    for (int j = 0; j < 8; ++j) { const int n = (lane >> 3) + 8 * j; const LAS float* s = scr + (8 * c) * 65 + n;
        if (t.fp8) { float w[8];
#pragma unroll
            for (int q = 0; q < 8; ++q) w[q] = __builtin_amdgcn_fmed3f(s[q * 65] * F8_WSCALE, -440.f, 440.f);
            *(u32x2*)(t.dst + (size_t)n * t.pitch + 8 * c) = (u32x2){pk4_fp8(w[0], w[1], w[2], w[3]), pk4_fp8(w[4], w[5], w[6], w[7])}; }
        else { u32x4 o; o.x = pk2(s[0 * 65], s[1 * 65]); o.y = pk2(s[2 * 65], s[3 * 65]); o.z = pk2(s[4 * 65], s[5 * 65]); o.w = pk2(s[6 * 65], s[7 * 65]);
            *(u32x4*)(t.dst + (size_t)n * t.pitch + 16 * c) = o; } }
    LDS_WAIT(); asm volatile("" ::: "memory");
}
__device__ __forceinline__ void transposes(const Ctx& C, int i0, int i1, int w, int nw) {
    LAS float* scr = (LAS float*)(C.lds + C.wid * 16896);
    int it = i0 + w; if (it >= i1) return;
    TItem cur = titem_decode(C, it); f32x4 v[16]; titem_load(cur, C.lane, v);
    for (;;) {
        const int nit = it + nw; const bool more = nit < i1;
        TItem nxt = cur; f32x4 vn[16];
        if (more) { nxt = titem_decode(C, nit); titem_load(nxt, C.lane, vn); }
        titem_store(cur, C.lane, v, scr);
        if (!more) break;
        cur = nxt; it = nit;
#pragma unroll
        for (int i = 0; i < 16; ++i) v[i] = vn[i];
    }
}
__device__ __forceinline__ void phase_prep(const Ctx& C) {
    const int gw = C.bid * NWAVES + C.wid, NGW = C.G * NWAVES;
    for (int row = gw; row < NTOK; row += 2 * NGW) {
        const int row2 = row + NGW;
        const bool two = row2 < NTOK;
        f32x4 v[2][4]; float ss[2] = {0.f, 0.f};
#pragma unroll
        for (int j = 0; j < 4; ++j) { v[0][j] = *(const f32x4*)(C.x + (size_t)row * DM + 4 * C.lane + 256 * j); v[1][j] = two ? *(const f32x4*)(C.x + (size_t)row2 * DM + 4 * C.lane + 256 * j) : (f32x4){0.f, 0.f, 0.f, 0.f}; }
#pragma unroll
        for (int r = 0; r < 2; ++r)
#pragma unroll
            for (int j = 0; j < 4; ++j) ss[r] += (v[r][j][0] * v[r][j][0] + v[r][j][1] * v[r][j][1]) + (v[r][j][2] * v[r][j][2] + v[r][j][3] * v[r][j][3]);
#pragma unroll
        for (int r = 0; r < 2; ++r) { if (r == 1 && !two) break;
            const int rw = r ? row2 : row; const int b = rw >> 11; const float* md = C.mod + b * 6144;
            const float rstd = rsqrtf(wave_sum(ss[r]) * (1.f / DM) + EPS);
#pragma unroll
            for (int j = 0; j < 4; ++j) { const int c0 = 4 * C.lane + 256 * j;
                const f32x4 g = *(const f32x4*)(C.norm1_g + c0), sc = *(const f32x4*)(md + 1024 + c0), sh = *(const f32x4*)(md + c0);
                const f32x4 y = v[r][j] * rstd * g * (sc + 1.f) + sh;
                u32x2 o; o.x = pk2(y[0], y[1]); o.y = pk2(y[2], y[3]);
                *(u32x2*)(C.H + (size_t)rw * DM + c0) = o; } }
    }
}

__device__ __forceinline__ void gla_scan(const Ctx& C, int b, int h) {
    LAS float* qs = (LAS float*)C.lds;
    LAS float* ks = qs + 2048;
    LAS float* al = ks + 2048;
    LAS float* vs = al + 2048;
    LAS float* part = vs + 4096;
    const int dv = C.tid & 127, dkg = C.tid >> 7;
    float S[16];
#pragma unroll
    for (int j = 0; j < 16; ++j) S[j] = 0.f;
    const float gdv0 = C.gla_g[2 * C.lane], gdv1 = C.gla_g[2 * C.lane + 1];
    for (int ch = 0; ch < SEQ / 32; ++ch) {
        const int row0 = b * SEQ + ch * 32;
        __syncthreads();
        for (int i = C.tid; i < 32 * 64; i += NTHREADS) { const int t = i >> 6, d = i & 63; const bf16* pr = C.PROJ + (size_t)(row0 + t) * NPROJ;
            qs[i] = bf2f(pr[C_GQ + h * 64 + d]); ks[i] = bf2f(pr[C_GK + h * 64 + d]); al[i] = __expf(bf2f(pr[C_AL + h * 64 + d])); }
        for (int i = C.tid; i < 32 * 128; i += NTHREADS) { const int t = i >> 7, d = i & 127; vs[i] = bf2f(C.PROJ[(size_t)(row0 + t) * NPROJ + C_GV + h * 128 + d]); }
        __syncthreads();
#pragma unroll 2
        for (int t = 0; t < 32; ++t) {
            const float v = vs[t * 128 + dv]; float o = 0.f;
#pragma unroll
            for (int j4 = 0; j4 < 4; ++j4) {
                const f32x4 a4 = *(const LAS f32x4*)(al + t * 64 + dkg * 16 + j4 * 4), k4 = *(const LAS f32x4*)(ks + t * 64 + dkg * 16 + j4 * 4), q4 = *(const LAS f32x4*)(qs + t * 64 + dkg * 16 + j4 * 4);
#pragma unroll
                for (int jj = 0; jj < 4; ++jj) { const int j = j4 * 4 + jj; S[j] = a4[jj] * S[j] + k4[jj] * v; o += q4[jj] * S[j]; }
            }
            part[(dkg * 32 + t) * 128 + dv] = o;
        }
        __syncthreads();
#pragma unroll
        for (int tt = 0; tt < 4; ++tt) {
            const int t = 4 * C.wid + tt; float o0 = 0.f, o1 = 0.f;
#pragma unroll
            for (int g = 0; g < 4; ++g) { o0 += part[(g * 32 + t) * 128 + 2 * C.lane]; o1 += part[(g * 32 + t) * 128 + 2 * C.lane + 1]; }
            const float rstd = rsqrtf(wave_sum(o0 * o0 + o1 * o1) * (1.f / 128.f) + EPS);
            const unsigned grw = *(const unsigned*)(C.PROJ + (size_t)(row0 + t) * NPROJ + C_GR + h * 128 + 2 * C.lane);
            const float g0 = bflo(grw), g1 = bfhi(grw);
            const float y0 = o0 * rstd * gdv0 * (g0 * sigmoidf_(g0)), y1 = o1 * rstd * gdv1 * (g1 * sigmoidf_(g1));
            *(unsigned*)(C.OB + (size_t)(row0 + t) * 512 + h * 128 + 2 * C.lane) = pk2(y0, y1);
        }
    }
}

__device__ __forceinline__ void attn_simple(const Ctx& C) {
    LAS float* Kt = (LAS float*)C.lds;
    LAS float* Vt = Kt + 8192;
    LAS float* Ss = Vt + 8192;
    LAS float* ssq = Ss + 2 * 64 * 68;
    LAS float* lamp = ssq + 256;
    if (C.tid < 64) {
        const float a = wave_sum(C.lq1[C.lane] * C.lk1[C.lane]), b2 = wave_sum(C.lq2[C.lane] * C.lk2[C.lane]);
        if (C.tid == 0) lamp[0] = __expf(a) - __expf(b2) + 0.2f;
    }
    __syncthreads();
    const float lam = lamp[0];
    const int q = C.tid & 63, p = (C.tid >> 6) & 1, dq = C.tid >> 7;
    for (int uix = C.bid; uix < 2048; uix += C.G) {
        const int bh = uix & 63, g = (uix >> 6) & 3, i2 = uix >> 8; const int b = bh >> 2, h = bh & 3;
        const int qc = (i2 & 1) ? (31 - (4 * g + (i2 >> 1))) : (4 * g + (i2 >> 1));
        const float sl2 = exp2f(-2.f * (float)(h + 1)) * LOG2E;
        const int qrow = b * SEQ + qc * 64 + q;
        float qv[64];
#pragma unroll
        for (int d8 = 0; d8 < 8; ++d8) { const u32x4 w = *(const u32x4*)(C.PROJ + (size_t)qrow * NPROJ + C_DQ + h * 128 + p * 64 + d8 * 8);
            qv[d8 * 8 + 0] = bflo(w.x); qv[d8 * 8 + 1] = bfhi(w.x); qv[d8 * 8 + 2] = bflo(w.y); qv[d8 * 8 + 3] = bfhi(w.y);
            qv[d8 * 8 + 4] = bflo(w.z); qv[d8 * 8 + 5] = bfhi(w.z); qv[d8 * 8 + 6] = bflo(w.w); qv[d8 * 8 + 7] = bfhi(w.w); }
        float m = -1e30f, l = 0.f, acc[32];
#pragma unroll
        for (int d = 0; d < 32; ++d) acc[d] = 0.f;
        for (int kc = 0; kc <= qc; ++kc) {
            __syncthreads();
            for (int pi = C.tid; pi < 1024; pi += NTHREADS) { const int r = pi >> 4, cc = pi & 15; const bf16* pr = C.PROJ + (size_t)(b * SEQ + kc * 64 + r) * NPROJ + h * 128 + cc * 8;
                const u32x4 kw = *(const u32x4*)(pr + C_DK), vw = *(const u32x4*)(pr + C_DV); f32x4 a0, a1;
                unpack8(kw, a0, a1); *(LAS f32x4*)(Kt + r * 128 + cc * 8) = a0; *(LAS f32x4*)(Kt + r * 128 + cc * 8 + 4) = a1;
                unpack8(vw, a0, a1); *(LAS f32x4*)(Vt + r * 128 + cc * 8) = a0; *(LAS f32x4*)(Vt + r * 128 + cc * 8 + 4) = a1; }
            __syncthreads();
#pragma unroll 1
            for (int kk = 0; kk < 16; ++kk) {
                const int key = dq * 16 + kk; float s = 0.f;
#pragma unroll
                for (int d4 = 0; d4 < 16; ++d4) { const f32x4 kv = *(const LAS f32x4*)(Kt + key * 128 + p * 64 + d4 * 4);
                    s += qv[d4 * 4] * kv[0]; s += qv[d4 * 4 + 1] * kv[1]; s += qv[d4 * 4 + 2] * kv[2]; s += qv[d4 * 4 + 3] * kv[3]; }
                const int kpos = kc * 64 + key, qpos = qc * 64 + q; const int mn = kpos < 2 * qpos - kpos ? kpos : 2 * qpos - kpos;
                Ss[(p * 64 + q) * 68 + key] = s + sl2 * (float)mn;
            }
            __syncthreads();
            const LAS float* srow = Ss + (p * 64 + q) * 68;
            float cm = -1e30f;
#pragma unroll
            for (int k4 = 0; k4 < 16; ++k4) { const f32x4 sv = *(const LAS f32x4*)(srow + k4 * 4); cm = fmaxf(cm, fmaxf(fmaxf(sv[0], sv[1]), fmaxf(sv[2], sv[3]))); }
            const float mnew = fmaxf(m, cm), alpha = exp2f(m - mnew); m = mnew; l *= alpha;
#pragma unroll
            for (int d = 0; d < 32; ++d) acc[d] *= alpha;
#pragma unroll 2
            for (int key = 0; key < 64; ++key) {
                const float pk = exp2f(srow[key] - m); l += pk;
#pragma unroll
                for (int d4 = 0; d4 < 8; ++d4) { const f32x4 vv = *(const LAS f32x4*)(Vt + key * 128 + dq * 32 + d4 * 4);
                    acc[d4 * 4] += pk * vv[0]; acc[d4 * 4 + 1] += pk * vv[1]; acc[d4 * 4 + 2] += pk * vv[2]; acc[d4 * 4 + 3] += pk * vv[3]; }
            }
        }
        const float inv = 1.f / l;
        __syncthreads();
        LAS float* O2 = Ss;
        if (p == 1) {
#pragma unroll
            for (int d = 0; d < 32; ++d) O2[q * 128 + dq * 32 + d] = lam * acc[d] * inv;
        }
        __syncthreads();
        float ss = 0.f;
        if (p == 0) {
#pragma unroll
            for (int d = 0; d < 32; ++d) { acc[d] = acc[d] * inv - O2[q * 128 + dq * 32 + d]; ss += acc[d] * acc[d]; }
            ssq[q * 4 + dq] = ss;
        }
        __syncthreads();
        if (p == 0) {
            const float tot = (ssq[q * 4] + ssq[q * 4 + 1]) + (ssq[q * 4 + 2] + ssq[q * 4 + 3]);
            const float rstd = rsqrtf(tot * (1.f / 128.f) + EPS) * 0.8f;
            bf16* dst = C.OA + (size_t)qrow * 512 + h * 128 + dq * 32;
#pragma unroll
            for (int d8 = 0; d8 < 4; ++d8) { u32x4 w; const float* gg = C.diff_g + dq * 32 + d8 * 8;
                w.x = pk2(acc[d8 * 8] * rstd * gg[0], acc[d8 * 8 + 1] * rstd * gg[1]); w.y = pk2(acc[d8 * 8 + 2] * rstd * gg[2], acc[d8 * 8 + 3] * rstd * gg[3]);
                w.z = pk2(acc[d8 * 8 + 4] * rstd * gg[4], acc[d8 * 8 + 5] * rstd * gg[5]); w.w = pk2(acc[d8 * 8 + 6] * rstd * gg[6], acc[d8 * 8 + 7] * rstd * gg[7]);
                *(u32x4*)(dst + d8 * 8) = w; }
        }
    }
}


typedef float f32x16 __attribute__((ext_vector_type(16)));
typedef short s16x4 __attribute__((ext_vector_type(4)));
typedef short v4i16_t __attribute__((ext_vector_type(4)));
__device__ __forceinline__ s16x4 vtr(const LAS unsigned char* p) { return __builtin_bit_cast(s16x4, __builtin_amdgcn_ds_read_tr16_b64_v4i16((LAS v4i16_t*)p)); }
template <int OFF> __device__ __forceinline__ void glds16(const void* sbase, unsigned voff, unsigned lds_dst) {
    unsigned sv; asm volatile("s_mov_b32 %0, m0\n\ts_mov_b32 m0, %3\n\ts_nop 0\n\tglobal_load_lds_dwordx4 %1, %2 offset:%4\n\ts_mov_b32 m0, %0" : "=&s"(sv) : "v"(voff), "s"(sbase), "s"(lds_dst), "i"(OFF) : "memory"); }
__device__ __forceinline__ unsigned lds_addr(const LAS unsigned char* p) { return (unsigned)__builtin_amdgcn_readfirstlane((int)(unsigned)(size_t)p); }
#define MFMA16(a, b, c) __builtin_amdgcn_mfma_f32_16x16x32_bf16(a, b, c, 0, 0, 0)
__device__ __forceinline__ bf16x8 cat44(s16x4 lo, s16x4 hi) { return (bf16x8){lo[0], lo[1], lo[2], lo[3], hi[0], hi[1], hi[2], hi[3]}; }
__device__ __forceinline__ void gla_chunked(const Ctx& C, int b, int h) {
    const int lane = C.lane, wid = C.wid, fr = lane & 15, fq = lane >> 4;
    LAS unsigned char* lds = C.lds;
    constexpr int RAW_Q = 0, RAW_K = 8192, RAW_LA = 16384, VB0 = 24576, QS = 57344, KS = 66560, KD = 75776, AM = 84992, ST = 94208, OO = 112640, GTL = 146432, SSQ = 146688;
    constexpr int P = 144, PO = 528;
    const char* pbase = (const char*)(C.PROJ + (size_t)(b * SEQ) * NPROJ);
    const unsigned oq = (unsigned)(((8 * wid + (lane >> 3)) * NPROJ + C_GQ + h * 64 + (lane & 7) * 8) * 2);
    const unsigned okk = oq + (unsigned)((C_GK - C_GQ) * 2), ol = oq + (unsigned)((C_AL - C_GQ) * 2);
    const unsigned ov0 = (unsigned)(((4 * wid + (lane >> 4)) * NPROJ + C_GV + h * 128 + (lane & 15) * 8) * 2), ov1 = ov0 + (unsigned)(32 * NPROJ * 2);
#define GL_DMA(n) do { const char* _cb = pbase + (size_t)(n) * 64 * NPROJ * 2; const unsigned _vb = VB0 + ((n) & 1) * 16384; \
        glds16<0>(_cb, oq, lds_addr(lds + RAW_Q + wid * 1024)); glds16<0>(_cb, okk, lds_addr(lds + RAW_K + wid * 1024)); glds16<0>(_cb, ol, lds_addr(lds + RAW_LA + wid * 1024)); \
        glds16<0>(_cb, ov0, lds_addr(lds + _vb + wid * 1024)); glds16<0>(_cb, ov1, lds_addr(lds + _vb + (wid + 8) * 1024)); } while (0)
    __syncthreads();
    GL_DMA(0);
    for (int i = lane; i < 16 * P / 4; i += 64) ((LAS unsigned*)(lds + ST + wid * 16 * P))[i] = 0u;
    f32x4 accS[4];
#pragma unroll
    for (int t = 0; t < 4; ++t) accS[t] = (f32x4){0.f, 0.f, 0.f, 0.f};
    const int t1 = wid >> 1, ca = 2 * (wid & 1);
    bf16x8 ym[2][2];
#pragma unroll
    for (int ci = 0; ci < 2; ++ci)
#pragma unroll
        for (int ks = 0; ks < 2; ++ks)
#pragma unroll
            for (int jj = 0; jj < 8; ++jj) ym[ci][ks][jj] = (short)(((32 * ks + 8 * fq + jj) <= (16 * (ca + ci) + fr)) ? 0x3F80 : 0);
    const bf16x8 ones = (bf16x8){0x3F80, 0x3F80, 0x3F80, 0x3F80, 0x3F80, 0x3F80, 0x3F80, 0x3F80};
    const int qp = (lane & 15) >> 2, pp = lane & 3;
    const float g0 = C.gla_g[2 * lane], g1 = C.gla_g[2 * lane + 1];
    unsigned grw[8];
#pragma unroll
    for (int cc = 0; cc < 8; ++cc) grw[cc] = 0u;
#define GL_ROWPASS(n) do { _Pragma("unroll") for (int cc = 0; cc < 8; ++cc) { const int c_ = 8 * wid + cc; \
        const float o0 = *(const LAS float*)(lds + OO + c_ * PO + lane * 8), o1 = *(const LAS float*)(lds + OO + c_ * PO + lane * 8 + 4); \
        const f32x4 qa = *(const LAS f32x4*)(lds + SSQ + c_ * 32), qb = *(const LAS f32x4*)(lds + SSQ + c_ * 32 + 16); \
        const float rstd = rsqrtf((((qa[0] + qa[1]) + (qa[2] + qa[3])) + ((qb[0] + qb[1]) + (qb[2] + qb[3]))) * (1.f / 128.f) + EPS); const float gr0 = bflo(grw[cc]), gr1 = bfhi(grw[cc]); \
        *(unsigned*)(C.OA + (size_t)(b * SEQ + (n) * 64 + c_) * 1024 + 512 + h * 128 + 2 * lane) = pk2(o0 * rstd * g0 * (gr0 * sigmoidf_(gr0)), o1 * rstd * g1 * (gr1 * sigmoidf_(gr1))); } } while (0)
#pragma unroll 1
    for (int n = 0; n < SEQ / 64; ++n) {
        asm volatile("s_waitcnt vmcnt(0) lgkmcnt(0)" ::: "memory"); __syncthreads();
        if (n > 0) GL_ROWPASS(n - 1);
#pragma unroll
        for (int cc = 0; cc < 8; ++cc) grw[cc] = *(const unsigned*)(pbase + ((size_t)(n * 64 + 8 * wid + cc) * NPROJ + C_GR + h * 128 + 2 * lane) * 2);
        {
            bf16x8 xla[2];
#pragma unroll
            for (int ks = 0; ks < 2; ++ks) { const LAS unsigned char* a = lds + RAW_LA + (32 * ks + 8 * fq + qp) * 128 + (16 * t1 + 4 * pp) * 2; xla[ks] = cat44(vtr(a), vtr(a + 4 * 128)); }
            f32x4 Ga = (f32x4){0.f, 0.f, 0.f, 0.f}, Gb = Ga, GT = Ga;
#pragma unroll
            for (int ks = 0; ks < 2; ++ks) { Ga = MFMA16(xla[ks], ym[0][ks], Ga); Gb = MFMA16(xla[ks], ym[1][ks], Gb); GT = MFMA16(xla[ks], ones, GT); }
#pragma unroll
            for (int ci = 0; ci < 2; ++ci) {
                const int c_ = 16 * (ca + ci) + fr, dk0 = 16 * t1 + 4 * fq; const f32x4 G = ci ? Gb : Ga;
                const u32x2 qw = *(const LAS u32x2*)(lds + RAW_Q + c_ * 128 + dk0 * 2), kw = *(const LAS u32x2*)(lds + RAW_K + c_ * 128 + dk0 * 2);
                const float q4[4] = {bflo(qw.x), bfhi(qw.x), bflo(qw.y), bfhi(qw.y)}, k4[4] = {bflo(kw.x), bfhi(kw.x), bflo(kw.y), bfhi(kw.y)};
                float qs4[4], ks4[4], kd4[4];
#pragma unroll
                for (int r = 0; r < 4; ++r) { qs4[r] = q4[r] * __expf(G[r]); ks4[r] = k4[r] * __expf(-G[r]); kd4[r] = k4[r] * __expf(GT[r] - G[r]); }
                *(LAS u32x2*)(lds + QS + c_ * P + dk0 * 2) = (u32x2){pk2(qs4[0], qs4[1]), pk2(qs4[2], qs4[3])};
                *(LAS u32x2*)(lds + KS + c_ * P + dk0 * 2) = (u32x2){pk2(ks4[0], ks4[1]), pk2(ks4[2], ks4[3])};
                *(LAS u32x2*)(lds + KD + c_ * P + dk0 * 2) = (u32x2){pk2(kd4[0], kd4[1]), pk2(kd4[2], kd4[3])};
            }
            if (fr == 0 && (wid & 1) == 0) *(LAS f32x4*)(lds + GTL + (16 * t1 + 4 * fq) * 4) = GT;
        }
        LDS_WAIT(); __syncthreads();
        if (n + 1 < SEQ / 64) GL_DMA(n + 1);
        {
            const int ct = wid >> 1;
#pragma unroll
            for (int si = 0; si < 2; ++si) {
                const int st = 2 * (wid & 1) + si; f32x4 D = (f32x4){0.f, 0.f, 0.f, 0.f};
                if (st <= ct) {
#pragma unroll
                    for (int ks = 0; ks < 2; ++ks) { const bf16x8 X = *(const LAS bf16x8*)(lds + KS + (16 * st + fr) * P + (32 * ks + 8 * fq) * 2), Y = *(const LAS bf16x8*)(lds + QS + (16 * ct + fr) * P + (32 * ks + 8 * fq) * 2); D = MFMA16(X, Y, D); }
#pragma unroll
                    for (int r = 0; r < 4; ++r) if (16 * st + 4 * fq + r > 16 * ct + fr) D[r] = 0.f;
                }
                *(LAS u32x2*)(lds + AM + (16 * ct + fr) * P + (16 * st + 4 * fq) * 2) = (u32x2){pk2(D[0], D[1]), pk2(D[2], D[3])};
            }
        }
        LDS_WAIT(); __builtin_amdgcn_s_barrier(); asm volatile("" ::: "memory");
        {
            const unsigned vb = VB0 + (n & 1) * 16384;
            bf16x8 X1[2], X2[2];
#pragma unroll
            for (int ks = 0; ks < 2; ++ks) { X1[ks] = *(const LAS bf16x8*)(lds + ST + (16 * wid + fr) * P + (32 * ks + 8 * fq) * 2);
                const LAS unsigned char* a = lds + vb + (32 * ks + 8 * fq + qp) * 256 + (16 * wid + 4 * pp) * 2; X2[ks] = cat44(vtr(a), vtr(a + 4 * 256)); }
#pragma unroll
            for (int ct = 0; ct < 4; ++ct) { f32x4 o = (f32x4){0.f, 0.f, 0.f, 0.f};
#pragma unroll
                for (int ks = 0; ks < 2; ++ks) { const bf16x8 Y1 = *(const LAS bf16x8*)(lds + QS + (16 * ct + fr) * P + (32 * ks + 8 * fq) * 2), Y2 = *(const LAS bf16x8*)(lds + AM + (16 * ct + fr) * P + (32 * ks + 8 * fq) * 2);
                    o = MFMA16(X1[ks], Y1, o); o = MFMA16(X2[ks], Y2, o); }
                *(LAS f32x4*)(lds + OO + (16 * ct + fr) * PO + (16 * wid + 4 * fq) * 4) = o;
                float ss = (o[0] * o[0] + o[1] * o[1]) + (o[2] * o[2] + o[3] * o[3]); ss += __shfl_xor(ss, 16); ss += __shfl_xor(ss, 32);
                if (fq == 0) *(LAS float*)(lds + SSQ + (16 * ct + fr) * 32 + wid * 4) = ss; }
#pragma unroll
            for (int tt = 0; tt < 4; ++tt) { const f32x4 dl = *(const LAS f32x4*)(lds + GTL + (16 * tt + 4 * fq) * 4);
#pragma unroll
                for (int r = 0; r < 4; ++r) accS[tt][r] *= __expf(dl[r]);
#pragma unroll
                for (int ks = 0; ks < 2; ++ks) { const LAS unsigned char* a = lds + KD + (32 * ks + 8 * fq + qp) * P + (16 * tt + 4 * pp) * 2; accS[tt] = MFMA16(cat44(vtr(a), vtr(a + 4 * P)), X2[ks], accS[tt]); }
                *(LAS u32x2*)(lds + ST + (16 * wid + fr) * P + (16 * tt + 4 * fq) * 2) = (u32x2){pk2(accS[tt][0], accS[tt][1]), pk2(accS[tt][2], accS[tt][3])}; }
        }
    }
    asm volatile("s_waitcnt vmcnt(0) lgkmcnt(0)" ::: "memory"); __syncthreads();
    GL_ROWPASS(SEQ / 64 - 1);
    __syncthreads();
#undef GL_DMA
#undef GL_ROWPASS
}

__device__ __forceinline__ int crow(int r, int hi) { return (r & 3) + 8 * (r >> 2) + 4 * hi; }
#define MFMA32(a, b, c) __builtin_amdgcn_mfma_f32_32x32x16_bf16(a, b, c, 0, 0, 0)
constexpr int AT_BUF = 32768, AT_WSF = 3 * 32768, AT_Q = 3 * 32768 + 2048;
constexpr float AT_THR = 8.f;

__device__ __forceinline__ void attn_unit(const Ctx& C, int b, int h, int cp, float lam) {
    const int lane = C.lane, r32 = lane & 31, hi = lane >> 5, wid = C.wid, p = wid >> 2, sub = wid & 3;
    const int NT = 2 * cp + 2, qch = 2 * cp + (sub >> 1), my_nt = qch + 1;
    const int row0 = b * SEQ + cp * 128;
    const int qpos = cp * 128 + sub * 32 + r32;
    const float sl2 = exp2f(-2.f * (float)(h + 1)) * LOG2E;
    LAS unsigned char* lds = C.lds;
    LAS float* wsf = (LAS float*)(lds + AT_WSF) + wid * 64;
    const char* kbase = (const char*)(C.PROJ + (size_t)(b * SEQ) * NPROJ + h * 128);
    const unsigned koff = (unsigned)((lane * NPROJ + C_DK + wid * 8) * 2);
    const unsigned voff = (unsigned)(((16 * (wid & 3) + (lane >> 2)) * NPROJ + C_DV + (wid >> 2) * 32 + (lane & 3) * 8) * 2);
#define AT_DMA(t, bufo) do { const char* _tb = kbase + (size_t)(t) * 64 * NPROJ * 2; \
        glds16<0>(_tb, koff, lds_addr(lds + (bufo) + wid * 1024)); glds16<0>(_tb, koff + 128u, lds_addr(lds + (bufo) + 8192 + wid * 1024)); \
        glds16<0>(_tb, voff, lds_addr(lds + (bufo) + 16384 + (wid >> 2) * 4096 + (wid & 3) * 1024)); glds16<0>(_tb, voff + 128u, lds_addr(lds + (bufo) + 16384 + ((wid >> 2) + 2) * 4096 + (wid & 3) * 1024)); } while (0)
    bf16x8 qr[4];
    { const bf16* qp = C.PROJ + (size_t)(row0 + sub * 32 + r32) * NPROJ + C_DQ + h * 128 + p * 64 + hi * 8;
#pragma unroll
      for (int d0 = 0; d0 < 4; ++d0) qr[d0] = *(const bf16x8*)(qp + d0 * 16); }
    AT_DMA(0, 0); AT_DMA(1, AT_BUF);
    f32x16 o[4];
#pragma unroll
    for (int d0 = 0; d0 < 4; ++d0)
#pragma unroll
        for (int i = 0; i < 16; ++i) o[d0][i] = 0.f;
    float mhat = 0.f, lsum = 0.f;
    const unsigned kofs = (unsigned)(p * 8192 + hi * 1024 + r32 * 16);
    const unsigned vofs = (unsigned)(16384 + ((lane >> 4) & 1) * 32 + (lane & 3) * 8 + (4 * hi + ((lane & 15) >> 2)) * 64);
    asm volatile("s_waitcnt vmcnt(4)" ::: "memory"); __syncthreads();
    unsigned bufo = 0, bufn1 = AT_BUF, bufn2 = 2 * AT_BUF;
#pragma unroll 1
    for (int t = 0; t < NT; ++t) {
        PSTAMP(lds, 0);
        if (t + 2 < NT) AT_DMA(t + 2, bufn2);
        PSTAMP(lds, 1);
        if (t < my_nt) {
            const LAS unsigned char* kp = lds + bufo + kofs;
            const LAS unsigned char* vp = lds + bufo + vofs;
            bf16x8 kf[8];
#pragma unroll
            for (int d0 = 0; d0 < 4; ++d0) { kf[2 * d0] = *(const LAS bf16x8*)(kp + d0 * 2048); kf[2 * d0 + 1] = *(const LAS bf16x8*)(kp + d0 * 2048 + 512); }
            s16x4 va[8], vb[8];
#define AT_VRD(dst, k) do { _Pragma("unroll") for (int d0 = 0; d0 < 4; ++d0) { dst[2 * d0] = vtr(vp + d0 * 4096 + (k) * 1024); dst[2 * d0 + 1] = vtr(vp + d0 * 4096 + (k) * 1024 + 512); } } while (0)
#define AT_PV(src_, k) do { const bf16x8 pa_ = __builtin_bit_cast(bf16x8, pw[k]); _Pragma("unroll") for (int d0 = 0; d0 < 4; ++d0) o[d0] = MFMA32(pa_, cat44(src_[2 * d0], src_[2 * d0 + 1]), o[d0]); } while (0)
            AT_VRD(va, 0);
            __builtin_amdgcn_sched_barrier(0);
            f32x16 s0, s1;
            if (t == qch) {
#pragma unroll
                for (int i = 0; i < 16; ++i) { const int k0p = 64 * t + crow(i, hi), k1p = k0p + 32;
                    s0[i] = fmaf(sl2, (float)min(k0p, 2 * qpos - k0p), -mhat); s1[i] = fmaf(sl2, (float)min(k1p, 2 * qpos - k1p), -mhat); }
            } else {
                const float bsm = sl2 * (float)(64 * t + 4 * hi) - mhat;
#pragma unroll
                for (int i = 0; i < 16; ++i) { const float ci = (float)((i & 3) + 8 * (i >> 2)); s0[i] = fmaf(sl2, ci, bsm); s1[i] = fmaf(sl2, ci + 32.f, bsm); }
            }
#pragma unroll
            for (int d0 = 0; d0 < 4; ++d0) { s0 = MFMA32(kf[2 * d0], qr[d0], s0); s1 = MFMA32(kf[2 * d0 + 1], qr[d0], s1); }
            __builtin_amdgcn_sched_barrier(0);
            float rm = fmaxf(s0[0], s1[0]);
#pragma unroll
            for (int i = 1; i < 16; ++i) rm = fmaxf(rm, fmaxf(s0[i], s1[i]));
            { auto rr = __builtin_amdgcn_permlane32_swap(__float_as_uint(rm), __float_as_uint(rm), false, false); rm = fmaxf(__uint_as_float(rr[0]), __uint_as_float(rr[1])); }
            if (t == 0 || __any(rm > AT_THR)) {
                const float dl = (t == 0) ? rm : fmaxf(rm, 0.f); mhat += dl;
                if (t != 0) {
                    const float f = __builtin_amdgcn_exp2f(-dl); lsum *= f;
                    if (hi == 0) wsf[r32] = f;
                    LDS_WAIT();
#pragma unroll
                    for (int i = 0; i < 16; ++i) { const float fi = wsf[crow(i, hi)];
#pragma unroll
                        for (int d0 = 0; d0 < 4; ++d0) o[d0][i] *= fi; }
                }
#pragma unroll
                for (int i = 0; i < 16; ++i) { s0[i] -= dl; s1[i] -= dl; }
            }
            float ps = 0.f;
#pragma unroll
            for (int i = 0; i < 16; ++i) { s0[i] = __builtin_amdgcn_exp2f(s0[i]); s1[i] = __builtin_amdgcn_exp2f(s1[i]); ps += s0[i] + s1[i]; }
            lsum += ps;
            PSTAMP(lds, 2);
            u32x4 pw[4];
            pw[0] = (u32x4){pk2(s0[0], s0[1]), pk2(s0[2], s0[3]), pk2(s0[4], s0[5]), pk2(s0[6], s0[7])};
            pw[1] = (u32x4){pk2(s0[8], s0[9]), pk2(s0[10], s0[11]), pk2(s0[12], s0[13]), pk2(s0[14], s0[15])};
            pw[2] = (u32x4){pk2(s1[0], s1[1]), pk2(s1[2], s1[3]), pk2(s1[4], s1[5]), pk2(s1[6], s1[7])};
            pw[3] = (u32x4){pk2(s1[8], s1[9]), pk2(s1[10], s1[11]), pk2(s1[12], s1[13]), pk2(s1[14], s1[15])};
            __builtin_amdgcn_sched_barrier(0);
            AT_VRD(vb, 1); AT_PV(va, 0); __builtin_amdgcn_sched_barrier(0);
            AT_VRD(va, 2); AT_PV(vb, 1); __builtin_amdgcn_sched_barrier(0);
            AT_VRD(vb, 3); AT_PV(va, 2); __builtin_amdgcn_sched_barrier(0);
            AT_PV(vb, 3);
#undef AT_VRD
#undef AT_PV
        }
        PSTAMP(lds, 3);
        if (t + 2 < NT) asm volatile("s_waitcnt vmcnt(4) lgkmcnt(0)" ::: "memory"); else asm volatile("s_waitcnt vmcnt(0) lgkmcnt(0)" ::: "memory");
        PSTAMP(lds, 4);
        __builtin_amdgcn_s_barrier(); asm volatile("" ::: "memory");
        PSTAMP(lds, 5);
        { const unsigned tb = bufo; bufo = bufn1; bufn1 = bufn2; bufn2 = tb; }
    }
#undef AT_DMA
    lsum += __shfl_xor(lsum, 32);
    if (hi == 0) wsf[32 + r32] = lsum;
    LDS_WAIT();
    LAS float* X = (LAS float*)lds;
    if (p == 1) {
#pragma unroll
        for (int i = 0; i < 16; ++i) { const float sc = lam / wsf[32 + crow(i, hi)];
#pragma unroll
            for (int d0 = 0; d0 < 4; ++d0) X[(sub * 32 + crow(i, hi)) * 128 + d0 * 32 + r32] = o[d0][i] * sc; }
    }
    __syncthreads();
    if (p == 0) {
#pragma unroll
        for (int i = 0; i < 16; ++i) { const float sc = 1.f / wsf[32 + crow(i, hi)];
#pragma unroll
            for (int d0 = 0; d0 < 4; ++d0) { LAS float* xp = X + (sub * 32 + crow(i, hi)) * 128 + d0 * 32 + r32; *xp = o[d0][i] * sc - *xp; } }
    }
    __syncthreads();
    { const float g0 = C.diff_g[2 * lane], g1 = C.diff_g[2 * lane + 1];
#pragma unroll 4
      for (int qq = 0; qq < 16; ++qq) { const int q = wid * 16 + qq; const float y0 = X[q * 128 + 2 * lane], y1 = X[q * 128 + 2 * lane + 1];
          const float rstd = rsqrtf(wave_sum(y0 * y0 + y1 * y1) * (1.f / 128.f) + EPS) * 0.8f;
          *(unsigned*)(C.OA + (size_t)(row0 + q) * 1024 + h * 128 + 2 * lane) = pk2(y0 * rstd * g0, y1 * rstd * g1); } }
    __syncthreads();
}

__device__ __forceinline__ void attn_phase(const Ctx& C) {
    LAS float* lamp = (LAS float*)(C.lds + AT_Q) + 4;
    LAS int* qw = (LAS int*)(C.lds + AT_Q);
    if (C.tid < 64) {
        const float a = wave_sum(C.lq1[C.lane] * C.lk1[C.lane]), b2 = wave_sum(C.lq2[C.lane] * C.lk2[C.lane]);
        if (C.tid == 0) lamp[0] = __expf(a) - __expf(b2) + 0.2f;
    }
    __syncthreads();
    const float lam = lamp[0];
    for (;;) {
        if (C.tid == 0) qw[0] = (int)__hip_atomic_fetch_add(C.ctl + CW_QUEUE, 1u, RLX_AGENT);
        __syncthreads();
        const int item = __builtin_amdgcn_readfirstlane(qw[0]);
        __syncthreads();
        if (item >= 1024) break;
        const int bh = item & 63, cp = 15 - (item >> 6);
        attn_unit(C, bh >> 2, bh & 3, cp, lam);
    }
}

__device__ __forceinline__ void phase_router(const Ctx& C) {
    const int lane = C.lane, wid = C.wid, fr = lane & 15, fq = lane >> 4;
    LAS u32x4* WH = (LAS u32x4*)C.lds;
    LAS u32x4* WL = WH + 4096;
    LAS float* GS = (LAS float*)(C.lds + 131072);
    LAS float* SH = GS + 1024;
    LAS float* red = SH + 1024;
    LAS float* ssw = red + 8 * 16 * 32;
    LAS float* rs = ssw + 128;
    LAS int* lcnt = (LAS int*)(rs + 16);
    LAS int* lbase = lcnt + 32;
    LAS int* pend = lbase + 32;
    LAS float* cbl = (LAS float*)(pend + 512);
    for (int blk = C.bid; blk < NTOK / 128; blk += C.G) {
        const int b = blk >> 4; const float* md = C.mod + b * 6144;
        __syncthreads();
        for (int k = C.tid; k < DM; k += NTHREADS) { GS[k] = C.norm2_g[k] * (1.f + md[4096 + k]); SH[k] = md[3072 + k]; }
        if (C.tid < 32) lcnt[C.tid] = 0;
        pend[C.tid] = -1;
#pragma unroll 4
        for (int idx = C.tid; idx < 4096; idx += NTHREADS) { WH[idx] = C.wrf[idx]; WL[idx] = C.wrf[4096 + idx]; }
        __syncthreads();
        {
            const int e = C.tid & 31, part = C.tid >> 5; float s = 0.f;
#pragma unroll 8
            for (int k = part * 64; k < part * 64 + 64; ++k) s += SH[k] * C.w_router[k * NE + e];
            red[part * 32 + e] = s;
            __syncthreads();
            if (C.tid < 32) { float t = C.b_router[C.tid];
#pragma unroll
                for (int p2 = 0; p2 < 16; ++p2) t += red[p2 * 32 + C.tid];
                cbl[C.tid] = t; }
            __syncthreads();
        }
        float x1[4][8];
#define RT_LOAD(dst, row) do { _Pragma("unroll") for (int ks = 0; ks < 4; ++ks) { const size_t o_ = (size_t)(row) * DM + 128 * wid + 32 * ks + 8 * fq; \
            const f32x4 xa = *(const f32x4*)(C.x + o_), xb = *(const f32x4*)(C.x + o_ + 4); const u32x4 yw = *(const u32x4*)(C.Y1 + o_); \
            dst[ks][0] = xa[0] + bflo(yw.x); dst[ks][1] = xa[1] + bfhi(yw.x); dst[ks][2] = xa[2] + bflo(yw.y); dst[ks][3] = xa[3] + bfhi(yw.y); \
            dst[ks][4] = xb[0] + bflo(yw.z); dst[ks][5] = xb[1] + bfhi(yw.z); dst[ks][6] = xb[2] + bflo(yw.w); dst[ks][7] = xb[3] + bfhi(yw.w); } } while (0)
        RT_LOAD(x1, blk * 128 + fr);
#pragma unroll 1
        for (int it = 0; it < 8; ++it) {
            const int row0 = blk * 128 + it * 16;
            f32x4 acc0 = (f32x4){0.f, 0.f, 0.f, 0.f}, acc1 = acc0; float ss = 0.f;
#pragma unroll
            for (int ks = 0; ks < 4; ++ks) {
                const f32x4 ga = *(const LAS f32x4*)(GS + 128 * wid + 32 * ks + 8 * fq), gb = *(const LAS f32x4*)(GS + 128 * wid + 32 * ks + 8 * fq + 4);
                float av[8];
#pragma unroll
                for (int j = 0; j < 8; ++j) { const float xv = x1[ks][j]; ss += xv * xv; av[j] = xv * (j < 4 ? ga[j] : gb[j - 4]); }
                bf16x8 ah, al; split_bf16(av, ah, al);
                const int fi = ((wid * 4 + ks) * 2) * 64 + lane;
                const bf16x8 wh0 = __builtin_bit_cast(bf16x8, WH[fi]), wh1 = __builtin_bit_cast(bf16x8, WH[fi + 64]), wl0 = __builtin_bit_cast(bf16x8, WL[fi]), wl1 = __builtin_bit_cast(bf16x8, WL[fi + 64]);
                acc0 = MFMA16(ah, wh0, acc0); acc0 = MFMA16(al, wh0, acc0); acc0 = MFMA16(ah, wl0, acc0);
                acc1 = MFMA16(ah, wh1, acc1); acc1 = MFMA16(al, wh1, acc1); acc1 = MFMA16(ah, wl1, acc1);
            }
            ss += __shfl_xor(ss, 16); ss += __shfl_xor(ss, 32);
            if (fq == 0) ssw[wid * 16 + fr] = ss;
#pragma unroll
            for (int r = 0; r < 4; ++r) { red[(wid * 16 + 4 * fq + r) * 32 + fr] = acc0[r]; red[(wid * 16 + 4 * fq + r) * 32 + 16 + fr] = acc1[r]; }
            LDS_WAIT(); __syncthreads();
            float xn[4][8];
            if (it < 7) RT_LOAD(xn, row0 + 16 + fr);
            {
                const int r = 2 * wid + (lane >> 5), e = lane & 31; float sum = 0.f, sq = 0.f;
#pragma unroll
                for (int w2 = 0; w2 < 8; ++w2) { sum += red[(w2 * 16 + r) * 32 + e]; sq += ssw[w2 * 16 + r]; }
                const float rstd = rsqrtf(sq * (1.f / DM) + EPS);
                if (e == 0) rs[r] = rstd;
                float val = rstd * sum + cbl[e];
                float tv[4]; int ti[4];
#pragma unroll
                for (int k = 0; k < 4; ++k) {
                    float bv = val; int bi = e;
#pragma unroll
                    for (int o = 16; o >= 1; o >>= 1) { const float ov = __shfl_xor(bv, o); const int oi = __shfl_xor(bi, o); if (ov > bv || (ov == bv && oi < bi)) { bv = ov; bi = oi; } }
                    tv[k] = bv; ti[k] = bi; if (e == bi) val = -3.0e38f;
                }
                const float e1 = __expf(tv[1] - tv[0]), e2 = __expf(tv[2] - tv[0]), e3 = __expf(tv[3] - tv[0]); const float inv = 1.f / (1.f + e1 + e2 + e3);
                const int row = row0 + r;
                if (e == 0) { *(f32x4*)(C.topw + (size_t)row * 4) = (f32x4){inv, e1 * inv, e2 * inv, e3 * inv}; *(i32x4*)(C.tope + (size_t)row * 4) = (i32x4){ti[0], ti[1], ti[2], ti[3]}; }
                if (e < 4) { const int ex = e == 0 ? ti[0] : (e == 1 ? ti[1] : (e == 2 ? ti[2] : ti[3]));
                    const int slot = atomicAdd((int*)(lcnt + ex), 1); pend[(it * 16 + r) * 4 + e] = (ex << 16) | slot; }
            }
            LDS_WAIT(); __syncthreads();
            {
                const float rstd = rs[fr];
#pragma unroll
                for (int ks = 0; ks < 4; ++ks) { const int k0 = 128 * wid + 32 * ks + 8 * fq;
                    const f32x4 ga = *(const LAS f32x4*)(GS + k0), gb = *(const LAS f32x4*)(GS + k0 + 4), sa = *(const LAS f32x4*)(SH + k0), sb = *(const LAS f32x4*)(SH + k0 + 4);
                    float hv[8];
#pragma unroll
                    for (int j = 0; j < 8; ++j) hv[j] = __builtin_amdgcn_fmed3f((x1[ks][j] * rstd * (j < 4 ? ga[j] : gb[j - 4]) + (j < 4 ? sa[j] : sb[j - 4])) * F8_ASCALE, -440.f, 440.f);
                    *(u32x2*)((unsigned char*)C.H2 + (size_t)(row0 + fr) * DM + k0) = (u32x2){pk4_fp8(hv[0], hv[1], hv[2], hv[3]), pk4_fp8(hv[4], hv[5], hv[6], hv[7])}; }
            }
            if (it < 7) {
#pragma unroll
                for (int ks = 0; ks < 4; ++ks)
#pragma unroll
                    for (int j = 0; j < 8; ++j) x1[ks][j] = xn[ks][j]; }
        }
#undef RT_LOAD
        __syncthreads();
        if (C.tid < 32) lbase[C.tid] = (int)__hip_atomic_fetch_add(C.ctl + CW_CNT + 64 * C.tid, (unsigned)lcnt[C.tid], RLX_AGENT);
        __syncthreads();
        { const int pv = pend[C.tid]; if (pv >= 0) { const int e = pv >> 16, slot = pv & 0xffff; C.list[e * NTOK + lbase[e] + slot] = (blk * 128 + (C.tid >> 2)) * 4 + (C.tid & 3); } }
    }
}

__device__ __forceinline__ void phase_final(const Ctx& C) {
    const int gw = C.bid * NWAVES + C.wid, NGW = C.G * NWAVES;
    for (int row = gw; row < NTOK; row += NGW) {
        const int b = row >> 11; const float* gt2 = C.mod + b * 6144 + 5120;
        const f32x4 w = *(const f32x4*)(C.topw + (size_t)row * 4);
        f32x4 v[4]; float ss = 0.f;
#pragma unroll
        for (int j = 0; j < 4; ++j) { const int c0 = 4 * C.lane + 256 * j;
            f32x4 y = (f32x4){0.f, 0.f, 0.f, 0.f};
#pragma unroll
            for (int k = 0; k < 4; ++k) { const u32x2 yw = *(const u32x2*)(C.YB + (size_t)(row * 4 + k) * DM + c0); y = y + (f32x4){bflo(yw.x), bfhi(yw.x), bflo(yw.y), bfhi(yw.y)} * w[k]; }
            const u32x2 y1w = *(const u32x2*)(C.Y1 + (size_t)row * DM + c0);
            v[j] = *(const f32x4*)(C.x + (size_t)row * DM + c0) + (f32x4){bflo(y1w.x), bfhi(y1w.x), bflo(y1w.y), bfhi(y1w.y)} + *(const f32x4*)(gt2 + c0) * y;
            ss += (v[j][0] * v[j][0] + v[j][1] * v[j][1]) + (v[j][2] * v[j][2] + v[j][3] * v[j][3]); }
        const float rstd = rsqrtf(wave_sum(ss) * (1.f / DM) + EPS);
#pragma unroll
        for (int j = 0; j < 4; ++j) { const int c0 = 4 * C.lane + 256 * j; *(f32x4*)(C.out + (size_t)row * DM + c0) = v[j] * rstd * *(const f32x4*)(C.final_g + c0); }
    }
}

#ifndef PROBE_A
#define PROBE_A -1
#endif
#ifndef PROBE_B
#define PROBE_B -1
#endif
constexpr int CW_TS = 3072;
#define STAMP(k) do { if (PROBE_A >= 0 && blockIdx.x == 0 && threadIdx.x == 0) { const Ctx Cs = make_ctx(lds); ((unsigned long long*)(Cs.ctl + CW_TS))[k] = __builtin_amdgcn_s_memrealtime(); } } while (0)
struct Args { const float* in[25]; float* out; unsigned char* ws; };
typedef const Args __attribute__((address_space(4)))* KArgs;
__device__ __forceinline__ Ctx make_ctx(LAS unsigned char* lds) {
    KArgs a = (KArgs)__builtin_amdgcn_kernarg_segment_ptr();
    asm volatile("" : "+s"(a));
    Ctx C;
    C.lds = lds;
    C.tid = tid_fresh(); C.lane = C.tid & 63; C.wid = __builtin_amdgcn_readfirstlane(C.tid >> 6); C.G = gridDim.x; C.bid = blockIdx.x;
    C.x = a->in[0]; C.c = a->in[1]; C.w_ada = a->in[2]; C.b_ada = a->in[3]; C.norm1_g = a->in[4]; C.w_in = a->in[5];
    C.lq1 = a->in[6]; C.lk1 = a->in[7]; C.lq2 = a->in[8]; C.lk2 = a->in[9]; C.diff_g = a->in[10]; C.w_alpha_up = a->in[11]; C.b_alpha = a->in[12];
    C.gla_g = a->in[13]; C.w_bd = a->in[14]; C.w_bg = a->in[15]; C.w_out = a->in[16]; C.norm2_g = a->in[17]; C.w_router = a->in[18]; C.b_router = a->in[19];
    C.w_gu = a->in[20]; C.b_gu = a->in[21]; C.w_dn = a->in[22]; C.b_dn = a->in[23]; C.final_g = a->in[24];
    C.out = a->out;
    unsigned char* ws = a->ws;
    C.ctl = (unsigned*)(ws + WS_CTL); C.mod = (float*)(ws + WS_MOD); C.tope = (int*)(ws + WS_TOPE); C.topw = (float*)(ws + WS_TOPW); C.list = (int*)(ws + WS_LIST);
    C.WinT = (bf16*)(ws + WS_WIN); C.WbdT = (bf16*)(ws + WS_WBD); C.WbgT = (bf16*)(ws + WS_WBG); C.WoutT = (bf16*)(ws + WS_WOUT); C.WguT = (bf16*)(ws + WS_WGU); C.WdT = (bf16*)(ws + WS_WD);
    C.H = (bf16*)(ws + WS_H); C.H2 = (bf16*)(ws + WS_H2); C.OA = (bf16*)(ws + WS_OA); C.OB = (bf16*)(ws + WS_OB); C.MG = (bf16*)(ws + WS_MG); C.YB = (bf16*)(ws + WS_YB);
    C.PROJ = (bf16*)(ws + WS_PROJ); C.ACT = (bf16*)(ws + WS_ACT); C.Y1 = (bf16*)(ws + WS_Y1); C.cb = (float*)(ws + WS_CB); C.wrf = (u32x4*)(ws + WS_WRF);
    return C;
}
__global__ void __launch_bounds__(NTHREADS, 2) fwd_kernel(Args args) {
    extern __shared__ __attribute__((aligned(16))) unsigned char lds_raw[];
    LAS unsigned char* lds = (LAS unsigned char*)lds_raw;
    for (int u = threadIdx.x; u < (LDS_BYTES - LDSCTL_OFF) / 4; u += NTHREADS) ((LAS unsigned*)(lds + LDSCTL_OFF))[u] = 0u;
    __syncthreads();
    volatile LAS unsigned* MISC = (volatile LAS unsigned*)(lds + MISC_OFF);
    XcdBarrier bar;
    { const Ctx C = make_ctx(lds); bar = xcd_barrier_post(C.ctl + CW_BAR, MISC + 8); }
#define GRID_BAR() xcd_barrier(bar)
    STAMP(0);
#if PROBE_A >= 100
    if (blockIdx.x == 0 && threadIdx.x == 0) ((volatile LAS unsigned*)(lds + MISC_OFF))[15] = (unsigned)__builtin_amdgcn_s_memrealtime();
#endif

    { const Ctx C = make_ctx(lds); phase_mod(C); }
    GRID_BAR(); STAMP(1);
    { const Ctx C = make_ctx(lds); phase_prep(C); }
    GRID_BAR(); STAMP(2);
    { const Ctx C = make_ctx(lds); DenseDesc g{C.H, DM, C.WinT, DM}; TileOrder S; S.init(NTOK / 256, NPROJ / 256, C.G, C.bid); EpiProj E{C.PROJ, C.b_alpha}; gemm_phase<DenseDesc, TileOrder, EpiProj, true, false, 1>(C.lds, g, S, E); }
    GRID_BAR(); STAMP(3);
    { const Ctx C = make_ctx(lds); for (int s = C.bid; s < 64; s += C.G) gla_chunked(C, s >> 2, s & 3); }
    __syncthreads(); STAMP(12);
    { const Ctx C = make_ctx(lds); attn_phase(C); }
    GRID_BAR(); STAMP(4);
    { const Ctx C = make_ctx(lds); DenseDesc g{C.OA, DM, C.WbdT, DM}; TileOrder S; S.init(NTOK / 256, DM / 256, C.G, C.bid); EpiBranch E{C.MG, C.PROJ}; gemm_phase<DenseDesc, TileOrder, EpiBranch, true>(C.lds, g, S, E); }
    GRID_BAR(); STAMP(5);
    STAMP(6);
    { const Ctx C = make_ctx(lds); DenseDesc g{C.MG, DM, C.WoutT, DM}; TileOrder S; S.init(NTOK / 256, DM / 256, C.G, C.bid); EpiOut E{C.Y1, C.mod}; gemm_phase<DenseDesc, TileOrder, EpiOut, true>(C.lds, g, S, E); }
    GRID_BAR(); STAMP(7);
    { const Ctx C = make_ctx(lds); phase_router(C); }
    GRID_BAR(); STAMP(8);
    LAS int* tab = (LAS int*)(lds + STAGE_BYTES);
    __syncthreads();
    if (threadIdx.x == 0) { const Ctx C = make_ctx(lds); int ts = 0; for (int e = 0; e < NE; ++e) { const int cnt = (int)__hip_atomic_load(C.ctl + CW_CNT + 64 * e, RLX_AGENT); tab[e] = cnt; tab[32 + e] = ts; ts += (cnt + 255) >> 8; } tab[64] = ts; }
    __syncthreads();
    for (int tr = threadIdx.x; tr < tab[64]; tr += NTHREADS) { int e = 0; for (int k = 1; k < NE; ++k) if (tab[32 + k] <= tr) e = k; tab[65 + tr] = e; }
    __syncthreads();
    { const Ctx C = make_ctx(lds); const int T = tab[64]; MoeUpDesc g{(const unsigned char*)C.H2, C.list, (const unsigned char*)C.WguT, DM}; MoeOrder S; S.t.init(T, 8, C.G, C.bid, 4); S.tab = tab; EpiUp E{(unsigned char*)C.ACT, C.b_gu}; gemm_phase<MoeUpDesc, MoeOrder, EpiUp, true, true, 4>(C.lds, g, S, E); }
    GRID_BAR(); STAMP(9);
    { const Ctx C = make_ctx(lds); const int T = tab[64]; MoeDownDesc g{(const unsigned char*)C.ACT, (const unsigned char*)C.WdT, FF}; MoeOrder S; S.t.init(T, 4, C.G, C.bid); S.tab = tab; EpiDown E{C.YB, C.b_dn, C.list}; gemm_phase<MoeDownDesc, MoeOrder, EpiDown, true, true, 5>(C.lds, g, S, E); }
    GRID_BAR(); STAMP(10);
    { const Ctx C = make_ctx(lds); phase_final(C); }
#if PROBE_A >= 0
    GRID_BAR(); STAMP(11);
    if (blockIdx.x == 0 && threadIdx.x == 0) {
        const Ctx C = make_ctx(lds); const unsigned long long* ts = (const unsigned long long*)(C.ctl + CW_TS);
        asm volatile("s_waitcnt vmcnt(0)" ::: "memory");
        const unsigned long long dt = (PROBE_A >= 100) ? (unsigned long long)((volatile LAS unsigned*)(lds + MISC_OFF))[16 + (PROBE_A >= 100 ? PROBE_A - 100 : 0)] : ((PROBE_A == 12) ? ts[12] - ts[3] : ts[(PROBE_A < 12 ? PROBE_A : 0) + 1] - ts[PROBE_A < 12 ? PROBE_A : 0]), t0 = __builtin_amdgcn_s_memrealtime();
        while (__builtin_amdgcn_s_memrealtime() - t0 < 4ull * dt) __builtin_amdgcn_s_sleep(8);
    }
#endif
}

extern "C" void kernel_launch(void* const* d_in, const int* in_sizes, int n_in, void* d_out, int out_size, void* d_ws, size_t ws_size, hipStream_t stream) {
    static int grid = 0;
    if (grid == 0) {
        if (n_in != 25 || in_sizes[0] != NTOK * DM || out_size != NTOK * DM || ws_size < WS_END) {
            fprintf(stderr, "kernel_launch: unexpected shapes (n_in %d, in0 %d, out %d, ws %zu < %zu)\n", n_in, n_in > 0 ? in_sizes[0] : -1, out_size, ws_size, (size_t)WS_END); grid = -1; return; }
        int dev = 0, cus = 0;
        if (hipGetDevice(&dev) != hipSuccess || hipDeviceGetAttribute(&cus, hipDeviceAttributeMultiprocessorCount, dev) != hipSuccess) { grid = -1; return; }
        if (hipFuncSetAttribute((const void*)fwd_kernel, hipFuncAttributeMaxDynamicSharedMemorySize, LDS_BYTES) != hipSuccess) { fprintf(stderr, "kernel_launch: hipFuncSetAttribute failed\n"); grid = -1; return; }
        (void)hipGetLastError();
        grid = cus;
    }
    if (grid < 0) return;
    if (hipMemsetAsync((char*)d_ws + WS_CTL, 0, CTL_ZERO_BYTES, stream) != hipSuccess) { fprintf(stderr, "kernel_launch: memset failed\n"); return; }
    Args a{};
    for (int i = 0; i < 25; ++i) a.in[i] = (const float*)d_in[i];
    a.out = (float*)d_out; a.ws = (unsigned char*)d_ws;
    hipLaunchKernelGGL(fwd_kernel, dim3(grid), dim3(NTHREADS), LDS_BYTES, stream, a);
}
```

```cpp
#include <hip/hip_runtime.h>
#include <cstdio>
#include <cstdint>

#define GAS __attribute__((address_space(1)))
#define LAS __attribute__((address_space(3)))
typedef unsigned short bf16;
typedef short bf16x8 __attribute__((ext_vector_type(8)));
typedef float f32x4 __attribute__((ext_vector_type(4)));
typedef unsigned u32x4 __attribute__((ext_vector_type(4)));
typedef unsigned u32x2 __attribute__((ext_vector_type(2)));
typedef int i32x4 __attribute__((ext_vector_type(4)));
typedef GAS unsigned gu32;

constexpr int NB = 16, SEQ = 2048, DM = 1024, NTOK = NB * SEQ, NE = 32, FF = 1024;
constexpr int NPROJ = 5376;
constexpr int C_DQ = 0, C_DK = 512, C_DV = 1024, C_GQ = 1536, C_GK = 1792, C_GV = 2048, C_GR = 2560, C_GA = 3072, C_GB = 4096, C_AL = 5120;
constexpr int W_IN_N = 5136;
constexpr float LOG2E = 1.4426950408889634f;
constexpr float QSCALE = 0.125f * LOG2E;
constexpr float EPS = 1e-6f;
constexpr int NWAVES = 8, NTHREADS = 512;

constexpr size_t MiB = 1u << 20;
constexpr size_t WS_CTL = 0, CTL_ZERO_BYTES = 1 * MiB;
constexpr size_t WS_MOD = 1 * MiB;
constexpr size_t WS_TOPE = 2 * MiB;
constexpr size_t WS_TOPW = 3 * MiB;
constexpr size_t WS_LIST = 4 * MiB;
constexpr size_t WS_WIN = 8 * MiB;
constexpr size_t WS_WBD = 19 * MiB;
constexpr size_t WS_WBG = 20 * MiB;
constexpr size_t WS_WOUT = 21 * MiB;
constexpr size_t WS_WGU = 24 * MiB;
constexpr size_t WS_WD = 152 * MiB;
constexpr size_t WS_H2 = 216 * MiB;
constexpr size_t WS_RB = 280 * MiB;
constexpr size_t WS_H = WS_RB, WS_OA = WS_RB + 64 * MiB, WS_OB = WS_RB + 96 * MiB, WS_MG = WS_RB + 128 * MiB, WS_YB = WS_RB;
constexpr size_t WS_RA = 536 * MiB;
constexpr size_t WS_PROJ = WS_RA, WS_ACT = WS_RA;
constexpr size_t WS_Y1 = WS_RA + 272 * MiB;
constexpr size_t WS_CB = WS_MOD + 512 * 1024;
constexpr size_t WS_WRF = WS_MOD + 768 * 1024;
constexpr size_t WS_END = 872 * MiB;
constexpr int MAX_TILES = 544;
static_assert((size_t)MAX_TILES * 256 * 1024 * 2 <= 336 * MiB, "act fits region A");
constexpr int CW_CNT = 64;
constexpr int CW_BAR = 4096;
constexpr int CW_QUEUE = 2304;

constexpr int SCR_BYTES = 159744;
constexpr int LDSCTL_OFF = SCR_BYTES, MISC_OFF = LDSCTL_OFF + 320;
constexpr int LDS_BYTES = SCR_BYTES + 1024;

#define RLX_AGENT __ATOMIC_RELAXED, __HIP_MEMORY_SCOPE_AGENT
#define LDS_WAIT() asm volatile("s_waitcnt lgkmcnt(0)" ::: "memory")

__device__ __forceinline__ unsigned f2bf(float f) { unsigned u = __builtin_bit_cast(unsigned, f); return (u + 0x7fffu + ((u >> 16) & 1u)) >> 16; }
typedef __bf16 bf16n2 __attribute__((ext_vector_type(2)));
typedef float f32x2 __attribute__((ext_vector_type(2)));
__device__ __forceinline__ unsigned pk2(float lo, float hi) { return __builtin_bit_cast(unsigned, __builtin_convertvector((f32x2){lo, hi}, bf16n2)); }
__device__ __forceinline__ unsigned pk4_fp8(float a, float b, float c, float d) { int w = 0; w = __builtin_amdgcn_cvt_pk_fp8_f32(a, b, w, false); w = __builtin_amdgcn_cvt_pk_fp8_f32(c, d, w, true); return (unsigned)w; }
constexpr float F8_ASCALE = 4.f, F8_WSCALE = 512.f;
constexpr int F8_SA = 0x7d7d7d7d, F8_SW = 0x76767676;
__device__ __forceinline__ float bf2f(unsigned b) { return __uint_as_float(b << 16); }
__device__ __forceinline__ float bflo(unsigned w) { return __uint_as_float(w << 16); }
__device__ __forceinline__ float bfhi(unsigned w) { return __uint_as_float(w & 0xffff0000u); }
__device__ __forceinline__ float wave_sum(float v) {
#pragma unroll
    for (int o = 1; o < 64; o <<= 1) v += __shfl_xor(v, o);
    return v;
}
__device__ __forceinline__ int tid_fresh() { int t = threadIdx.x; asm volatile("" : "+v"(t)); return t; }
__device__ __forceinline__ float sigmoidf_(float x) { return 1.f / (1.f + __expf(-x)); }

#define XB_TMO      128
#define XB_XCNT(j)  (256  + 64 * (j))
#define XB_XSUB(j)  (1280 + 64 * (j))
#define XB_XGEN(j)  (2304 + 64 * (j))
#define XB_TOP      3328
#define XB_TOPGEN   3392
#define XCD_BAR_WORDS 3456
#define XB_SPIN_CAP (1u << 22)
__device__ __forceinline__ unsigned xb_ld(unsigned* p)              { return __hip_atomic_load(p, __ATOMIC_RELAXED, __HIP_MEMORY_SCOPE_AGENT); }
__device__ __forceinline__ unsigned xb_add(unsigned* p, unsigned v) { return __hip_atomic_fetch_add(p, v, __ATOMIC_RELAXED, __HIP_MEMORY_SCOPE_AGENT); }
__device__ __forceinline__ unsigned xb_xcc_id() { return (unsigned)__builtin_amdgcn_s_getreg((3 << 11) | 20) & 0xFu; }
#define XB_SPIN(cond, bar) do { unsigned _sp = 0; while (cond) { __builtin_amdgcn_s_sleep(1); \
    if ((++_sp & 255u) == 0u) { if (xb_ld(&(bar)[XB_TMO])) break; if (_sp > XB_SPIN_CAP) { atomicAdd(&(bar)[XB_TMO], 1u); break; } } } } while (0)
struct XcdBarrier { unsigned* bar; unsigned x; volatile LAS unsigned* st; };
__device__ __forceinline__ XcdBarrier xcd_barrier_post(unsigned* bar, volatile LAS unsigned* st) {
    XcdBarrier b; b.bar = bar; b.x = xb_xcc_id(); b.st = st;
    if (threadIdx.x == 0) (void)xb_add(&bar[XB_XCNT(b.x)], 1u);
    return b;
}
__device__ __forceinline__ void xcd_barrier_complete(unsigned* bar, unsigned x, unsigned& nloc, unsigned& nx) {
    const unsigned G = gridDim.x * gridDim.y * gridDim.z;
    unsigned sum, cnt, mine, sp = 0u;
    for (;;) {
        sum = 0u; cnt = 0u; mine = 0u;
#pragma unroll
        for (unsigned j = 0; j < 16; ++j) { const unsigned c = xb_ld(&bar[XB_XCNT(j)]); sum += c; cnt += (c > 0u) ? 1u : 0u; mine = (j == x) ? c : mine; }
        if (sum == G) break;
        __builtin_amdgcn_s_sleep(1);
        if ((++sp & 255u) == 0u) { if (xb_ld(&bar[XB_TMO])) break; if (sp > XB_SPIN_CAP) { atomicAdd(&bar[XB_TMO], 1u); break; } }
    }
    nloc = mine > 0u ? mine : 1u; nx = cnt > 0u ? cnt : 1u;
}
__device__ __forceinline__ void xcd_barrier(const XcdBarrier& b) {
    asm volatile("s_waitcnt vmcnt(0)" ::: "memory");
    __syncthreads();
    if (threadIdx.x == 0) {
        unsigned* bar = b.bar;
        __builtin_amdgcn_s_waitcnt(0);
        unsigned nloc = b.st[0], nx = b.st[1];
        if (nloc == 0u) { xcd_barrier_complete(bar, b.x, nloc, nx); b.st[0] = nloc; b.st[1] = nx; }
        const unsigned old = xb_add(&bar[XB_XSUB(b.x)], 1u);
        const unsigned gen = old / nloc;
        if (old + 1u == (gen + 1u) * nloc) {
            __builtin_amdgcn_fence(__ATOMIC_RELEASE, "agent");
            asm volatile("s_waitcnt vmcnt(0)" ::: "memory");
            const unsigned og = xb_add(&bar[XB_TOP], 1u);
            const unsigned tg = og / nx;
            if (og + 1u == (tg + 1u) * nx) xb_add(&bar[XB_TOPGEN], 1u);
            else XB_SPIN(xb_ld(&bar[XB_TOPGEN]) == tg, bar);
            __builtin_amdgcn_fence(__ATOMIC_ACQUIRE, "agent");
            xb_add(&bar[XB_XGEN(b.x)], 1u);
            asm volatile("s_waitcnt vmcnt(0)" ::: "memory");
        } else {
            XB_SPIN(xb_ld(&bar[XB_XGEN(b.x)]) == gen, bar);
            __builtin_amdgcn_fence(__ATOMIC_ACQUIRE, "agent");
            asm volatile("s_waitcnt vmcnt(0)" ::: "memory");
        }
    }
    __syncthreads();
}

struct Ctx {
    LAS unsigned char* lds;
    int tid, lane, wid, G, bid;
    const float *x, *c, *w_ada, *b_ada, *norm1_g, *w_in, *lq1, *lk1, *lq2, *lk2, *diff_g, *w_alpha_up, *b_alpha, *gla_g,
                *w_bd, *w_bg, *w_out, *norm2_g, *w_router, *b_router, *w_gu, *b_gu, *w_dn, *b_dn, *final_g;
    float* out;
    unsigned* ctl; float* mod; int* tope; float* topw; int* list;
    bf16 *WinT, *WbdT, *WbgT, *WoutT, *WguT, *WdT, *H, *H2, *OA, *OB, *MG, *YB, *PROJ, *ACT, *Y1; float* cb; u32x4* wrf;
};

constexpr int NXCD = 8, WGM = 8;
__host__ __device__ __forceinline__ int perm32(int rho) { const int n = rho >> 4, i = rho & 15; return 8 * (i >> 2) + 4 * n + (i & 3); }
struct Unit { int pm, pn, e, row0, cnt; };
struct TileOrder {
    int nM, nN, nwg, G, c, wgm;
    __device__ __forceinline__ void init(int nM_, int nN_, int G_, int c_, int wgm_ = WGM) { nM = nM_; nN = nN_; nwg = nM * nN; G = G_; c = c_; wgm = wgm_; }
    __device__ __forceinline__ bool next(int i, Unit& u) const {
        const long L = (long)i * G + c; if (L >= nwg) return false;
        int wgid = (int)L; { const int q = nwg / NXCD, r = nwg % NXCD, xcd = wgid % NXCD, off = wgid / NXCD; wgid = (xcd < r ? xcd * (q + 1) : r * (q + 1) + (xcd - r) * q) + off; }
        const int nig = wgm * nN, gid = wgid / nig, fm = gid * wgm, gsz = (nM - fm) < wgm ? (nM - fm) : wgm;
        u.pm = fm + ((wgid % nig) % gsz); u.pn = (wgid % nig) / gsz; u.e = 0; u.row0 = 0; u.cnt = 0; return true;
    }
};
struct MoeOrder {
    TileOrder t; LAS const int* tab;
    __device__ __forceinline__ bool next(int i, Unit& u) const {
        if (!t.next(i, u)) return false;
        const int e = tab[65 + u.pm];
        u.e = e; u.row0 = (u.pm - tab[32 + e]) * 256; u.cnt = tab[e]; return true;
    }
};
struct DenseDesc {
    static constexpr bool GATHER = false;
    const bf16* A; int lda; const bf16* Bt; int K;
    __device__ __forceinline__ unsigned a_off(const Unit& u, int r) const { return (unsigned)((u.pm * 256 + r) * lda) * 2u; }
    __device__ __forceinline__ const char* a_base(const Unit&) const { return (const char*)A; }
    __device__ __forceinline__ const char* b_base(const Unit& u) const { return (const char*)Bt + (size_t)u.pn * 256 * K * 2; }
};
struct MoeUpDesc {
    static constexpr bool GATHER = true;
    const unsigned char* H2; const int* list; const unsigned char* WguT; int K;
    __device__ __forceinline__ const int* id_src(const Unit& u, int j) const { const int s = u.row0 + j; return list + (size_t)u.e * NTOK + (s < NTOK ? s : NTOK - 1); }
    __device__ __forceinline__ unsigned a_off(const Unit& u, int r) const { const int slot = u.row0 + r; int tok = 0; if (slot < u.cnt) tok = list[u.e * NTOK + slot] >> 2; return (unsigned)tok * 1024u; }
    __device__ __forceinline__ const char* a_base(const Unit&) const { return (const char*)H2; }
    __device__ __forceinline__ const char* b_base(const Unit& u) const { return (const char*)WguT + ((size_t)u.e * 2048 + (size_t)u.pn * 256) * 1024; }
};
struct MoeDownDesc {
    static constexpr bool GATHER = false;
    const unsigned char* ACT; const unsigned char* WdT; int K;
    __device__ __forceinline__ unsigned a_off(const Unit& u, int r) const { return (unsigned)(u.pm * 256 + r) * 1024u; }
    __device__ __forceinline__ const char* a_base(const Unit&) const { return (const char*)ACT; }
    __device__ __forceinline__ const char* b_base(const Unit& u) const { return (const char*)WdT + ((size_t)u.e * 1024 + (size_t)u.pn * 256) * 1024; }
};

template <class Desc, class Order, class Epi>
__device__ __forceinline__ void gemm_simple(const Desc& g, const Order& S, const Epi& E) {
    const int tid = threadIdx.x, wid = __builtin_amdgcn_readfirstlane(tid >> 6), lane = tid & 63, wr = wid >> 2, wc = wid & 3, fr = lane & 15, fq = lane >> 4;
    const int K = g.K;
    Unit u;
    for (int i = 0; S.next(i, u); ++i) {
        f32x4 acc[2][2][4][2];
#pragma unroll
        for (int a = 0; a < 2; ++a)
#pragma unroll
            for (int b = 0; b < 2; ++b)
#pragma unroll
                for (int m = 0; m < 4; ++m)
#pragma unroll
                    for (int n = 0; n < 2; ++n) acc[a][b][m][n] = (f32x4){0.f, 0.f, 0.f, 0.f};
        unsigned aoff[2][4], boff[2][2];
#pragma unroll
        for (int a = 0; a < 2; ++a)
#pragma unroll
            for (int m = 0; m < 4; ++m) aoff[a][m] = g.a_off(u, a * 128 + wr * 64 + m * 16 + fr) + fq * 16;
#pragma unroll
        for (int b = 0; b < 2; ++b)
#pragma unroll
            for (int n = 0; n < 2; ++n) { const int nc = b * 128 + wc * 32 + (Epi::PERM ? perm32(n * 16 + fr) : (n * 16 + fr)); boff[b][n] = (unsigned)(nc * K) * 2u + fq * 16; }
        const char* ab = g.a_base(u); const char* bb = g.b_base(u);
#pragma unroll 1
        for (int ks = 0; ks < K / 32; ++ks) {
            bf16x8 af[2][4], bfr[2][2];
#pragma unroll
            for (int a = 0; a < 2; ++a)
#pragma unroll
                for (int m = 0; m < 4; ++m) af[a][m] = *(const bf16x8*)(ab + aoff[a][m] + ks * 64);
#pragma unroll
            for (int b = 0; b < 2; ++b)
#pragma unroll
                for (int n = 0; n < 2; ++n) bfr[b][n] = *(const bf16x8*)(bb + boff[b][n] + ks * 64);
#pragma unroll
            for (int a = 0; a < 2; ++a)
#pragma unroll
                for (int b = 0; b < 2; ++b)
#pragma unroll
                    for (int m = 0; m < 4; ++m)
#pragma unroll
                        for (int n = 0; n < 2; ++n) acc[a][b][m][n] = __builtin_amdgcn_mfma_f32_16x16x32_bf16(bfr[b][n], af[a][m], acc[a][b][m][n], 0, 0, 0);
        }
        E(acc, u, wr, wc, fr, fq);
    }
}


#ifndef PROBE_A
#define PROBE_A -1
#endif
#if PROBE_A >= 100
#define PSTAMP(ldsp, idx) do { if (blockIdx.x == 0 && threadIdx.x == 0) { volatile LAS unsigned* pm_ = (volatile LAS unsigned*)((ldsp) + MISC_OFF); const unsigned now_ = (unsigned)__builtin_amdgcn_s_memrealtime(); pm_[16 + (idx)] += now_ - pm_[15]; pm_[15] = now_; } } while (0)
#else
#define PSTAMP(ldsp, idx) do {} while (0)
#endif
constexpr int BK = 64, HALF = 128, HTB = HALF * BK * 2, STAGE_BYTES = 8 * HTB;
__host__ __device__ __forceinline__ int lds_byte(int r, int c) { const int st = (r >> 4) * 2 + (c >> 5), rr = r & 15, cc = c & 31, ob = rr * 64 + cc * 2; return st * 1024 + (ob ^ (((ob >> 9) & 1) << 5)); }
__host__ __device__ __forceinline__ void stage_rc(int b, int& R, int& C) { const int st = b / 1024, sb = b % 1024, swz = sb ^ (((sb >> 9) & 1) << 5); R = (st >> 1) * 16 + swz / 64; C = (st & 1) * 32 + (swz % 64) / 2; }

typedef int v8i32 __attribute__((ext_vector_type(8)));
__device__ __forceinline__ v8i32 cat88(bf16x8 lo, bf16x8 hi) { const i32x4 a = __builtin_bit_cast(i32x4, lo), b = __builtin_bit_cast(i32x4, hi); return (v8i32){a[0], a[1], a[2], a[3], b[0], b[1], b[2], b[3]}; }
template <class Desc, class Order, class Epi, bool ALIGN_EPI, bool FP8 = false, int PID = 0>
__device__ __forceinline__ void gemm_phase(LAS unsigned char* lds, const Desc& g, const Order& S, const Epi& E) {
    const int tid = tid_fresh(), wid = __builtin_amdgcn_readfirstlane(tid >> 6), lane = tid & 63, wr = wid >> 2, wc = wid & 3, fr = lane & 15, fq = lane >> 4;
    const int KBy = FP8 ? g.K : 2 * g.K, nt = KBy / 128;
    int Rs[2], Cs[2]; unsigned voffB[2];
#pragma unroll
    for (int i = 0; i < 2; ++i) { stage_rc(tid * 16 + i * 8192, Rs[i], Cs[i]); const int Rb = 64 * (Rs[i] >> 5) + perm32(Rs[i] & 31); voffB[i] = (unsigned)(Rb * KBy + Cs[i] * 2); }
    unsigned vA[2][2];
    LAS u32x4* const vslot = (LAS u32x4*)(lds + STAGE_BYTES + 4096) + tid;
    const size_t kstep = (size_t)(BK * 2);
    const size_t hstepB = (size_t)32 * KBy;
    const unsigned ldsw = (unsigned)wid * 1024u;
    const int aoff = FP8 ? lds_byte(wr * 64 + fr, fq * 16) : lds_byte(wr * 64 + fr, fq * 8), boff = FP8 ? lds_byte(wc * 32 + fr, fq * 16) : lds_byte(wc * 32 + fr, fq * 8);
    constexpr int KSTR = FP8 ? 16 : 1024;
#define PG8_SA(b, h) (((b) * 2 + (h)) * HTB)
#define PG8_SB(b, h) ((4 + (b) * 2 + (h)) * HTB)
#define PG8_STAGE(bufoff, gbase, voff) do { _Pragma("unroll") for (int _i = 0; _i < 2; ++_i) \
        __builtin_amdgcn_global_load_lds((const unsigned*)((const char*)(gbase) + (voff)[_i]), (LAS unsigned*)(lds + (bufoff) + ldsw + _i * 8192), 16, 0, 0); } while (0)
#define PG8_STAGE_A(bufoff, gbase, h) do { _Pragma("unroll") for (int _i = 0; _i < 2; ++_i) \
        __builtin_amdgcn_global_load_lds((const unsigned*)((const char*)(gbase) + vA[h][_i]), (LAS unsigned*)(lds + (bufoff) + ldsw + _i * 8192), 16, 0, 0); } while (0)
#define PG8_LDA(dst, b, h) do { _Pragma("unroll") for (int m = 0; m < 4; ++m) _Pragma("unroll") for (int k = 0; k < 2; ++k) dst[m][k] = *(const LAS bf16x8*)(lds + PG8_SA(b, h) + aoff + m * 2048 + k * KSTR); } while (0)
#define PG8_LDB(dst, b, h) do { _Pragma("unroll") for (int n = 0; n < 2; ++n) _Pragma("unroll") for (int k = 0; k < 2; ++k) dst[n][k] = *(const LAS bf16x8*)(lds + PG8_SB(b, h) + boff + n * 2048 + k * KSTR); } while (0)
#define PG8_MMA(ai, bj, At, Bt) do { __builtin_amdgcn_s_setprio(1); _Pragma("unroll") for (int m = 0; m < 4; ++m) _Pragma("unroll") for (int n = 0; n < 2; ++n) { \
        if constexpr (FP8) { acc[ai][bj][m][n] = __builtin_amdgcn_mfma_scale_f32_16x16x128_f8f6f4(cat88(Bt[n][0], Bt[n][1]), cat88(At[m][0], At[m][1]), acc[ai][bj][m][n], 0, 0, 0, F8_SW, 0, F8_SA); } \
        else { _Pragma("unroll") for (int k = 0; k < 2; ++k) acc[ai][bj][m][n] = __builtin_amdgcn_mfma_f32_16x16x32_bf16(Bt[n][k], At[m][k], acc[ai][bj][m][n], 0, 0, 0); } } \
        __builtin_amdgcn_s_setprio(0); } while (0)
#define PG8_WAIT_V(n) asm volatile("s_waitcnt vmcnt(" #n ")" ::: "memory")
#define PG8_WAIT_L(n) asm volatile("s_waitcnt lgkmcnt(" #n ")" ::: "memory")
#define PG8_BAR __builtin_amdgcn_s_barrier()
#define PG8_SCHED __builtin_amdgcn_sched_barrier(0)
#define PG8_KBODY(t) do { \
            const bool last = (t == nt - 2); \
            const char* a1 = Ab + (size_t)(t + 1) * kstep; \
            const char* a2 = last ? Ab : Ab + (size_t)(t + 2) * kstep; const char* b2 = last ? nB : cB + (size_t)(t + 2) * kstep; \
            const char* a3 = a2 + kstep; const char* b3 = b2 + kstep; \
              \
            PG8_LDB(B0, 0, 0); PG8_LDB(B1, 0, 1); PG8_SCHED; PG8_LDA(At, 0, 0); PG8_STAGE_A(PG8_SA(1, 1), a1, 1); \
            if (last && has_next) { if constexpr (Desc::GATHER) { _Pragma("unroll") for (int _h = 0; _h < 2; ++_h) _Pragma("unroll") for (int _i = 0; _i < 2; ++_i) { const int _j = _h * HALF + Rs[_i]; const int _id = idbuf[((ui + 1) & 1) * 256 + _j]; vA[_h][_i] = ((nxt.row0 + _j < nxt.cnt) ? (unsigned)(_id >> 2) * 1024u : 0u) + (unsigned)Cs[_i] * 2u; } } else { const u32x4 vn = *vslot; vA[0][0] = vn.x; vA[0][1] = vn.y; vA[1][0] = vn.z; vA[1][1] = vn.w; } }     \
            PG8_WAIT_V(8); PG8_WAIT_L(0); PG8_BAR; PG8_MMA(0, 0, At, B0); PG8_MMA(0, 1, At, B1); PG8_BAR; PG8_SCHED; \
              \
            PG8_LDA(At, 0, 1); PG8_STAGE(PG8_SB(0, 0), b2, voffB); PG8_STAGE(PG8_SB(0, 1), b2 + hstepB, voffB); PG8_STAGE_A(PG8_SA(0, 0), a2, 0); \
            PG8_WAIT_V(8); PG8_WAIT_L(0); PG8_BAR; PG8_MMA(1, 0, At, B0); PG8_MMA(1, 1, At, B1); PG8_BAR; PG8_SCHED; \
              \
            PG8_LDB(B0, 1, 0); PG8_LDB(B1, 1, 1); PG8_SCHED; PG8_LDA(At, 1, 0); PG8_STAGE_A(PG8_SA(0, 1), a2, 1); \
            PG8_WAIT_V(8); PG8_WAIT_L(0); PG8_BAR; PG8_MMA(0, 0, At, B0); PG8_MMA(0, 1, At, B1); PG8_BAR; PG8_SCHED; \
              \
            PG8_LDA(At, 1, 1); PG8_STAGE(PG8_SB(1, 0), b3, voffB); PG8_STAGE(PG8_SB(1, 1), b3 + hstepB, voffB); PG8_STAGE_A(PG8_SA(1, 0), a3, 0); \
            PG8_WAIT_V(8); PG8_WAIT_L(0); PG8_BAR; PG8_MMA(1, 0, At, B0); PG8_MMA(1, 1, At, B1); PG8_BAR; PG8_SCHED; \
        } while (0)
#define PG8_AOFFS(dst, un) do { _Pragma("unroll") for (int _h = 0; _h < 2; ++_h) _Pragma("unroll") for (int _i = 0; _i < 2; ++_i) dst[_h][_i] = g.a_off(un, _h * HALF + Rs[_i]) + (unsigned)Cs[_i] * 2u; } while (0)
    Unit cur, nxt; int ui = 0;
    if (!S.next(0, cur)) return;
    LAS int* const idbuf = (LAS int*)(lds + STAGE_BYTES + 4096);
#define PG8_IDDMA(un, b) do { if (wid < 4) __builtin_amdgcn_global_load_lds((const unsigned*)g.id_src(un, 64 * wid + lane), (LAS unsigned*)(idbuf + (b) * 256 + 64 * wid), 4, 0, 0); } while (0)
    if constexpr (Desc::GATHER) { Unit u1; if (S.next(1, u1)) PG8_IDDMA(u1, 1); }
    f32x4 acc[2][2][4][2];
#pragma unroll
    for (int a = 0; a < 2; ++a)
#pragma unroll
        for (int b = 0; b < 2; ++b)
#pragma unroll
            for (int m = 0; m < 4; ++m)
#pragma unroll
                for (int n = 0; n < 2; ++n) acc[a][b][m][n] = (f32x4){0.f, 0.f, 0.f, 0.f};
    bf16x8 At[4][2], B0[2][2], B1[2][2];
    const char* const Ab = g.a_base(cur);
    const char* cB = g.b_base(cur);
    PG8_AOFFS(vA, cur);
    PG8_STAGE(PG8_SB(0, 0), cB, voffB); PG8_STAGE(PG8_SB(0, 1), cB + hstepB, voffB); PG8_STAGE_A(PG8_SA(0, 0), Ab, 0); PG8_STAGE_A(PG8_SA(0, 1), Ab, 1);
    if (wr == 1) PG8_BAR;
    PG8_WAIT_V(2); PG8_BAR;
    PG8_STAGE(PG8_SB(1, 0), cB + kstep, voffB); PG8_STAGE_A(PG8_SA(1, 0), Ab + kstep, 0); PG8_STAGE(PG8_SB(1, 1), cB + hstepB + kstep, voffB);
    PG8_WAIT_V(6); PG8_BAR;
    for (;;) {
        const bool has_next = S.next(ui + 1, nxt);
        const char* nB = has_next ? g.b_base(nxt) : cB;
        if constexpr (Desc::GATHER) { Unit u2; if (S.next(ui + 2, u2)) PG8_IDDMA(u2, ui & 1); }
        else if (has_next) { unsigned vn[2][2]; PG8_AOFFS(vn, nxt); *vslot = (u32x4){vn[0][0], vn[0][1], vn[1][0], vn[1][1]}; }
        PSTAMP(lds, 40 + PID);
        if constexpr (Epi::MIDK) {
            for (int t = 0; t < nt / 2; t += 2) PG8_KBODY(t);
            E.mid(acc, cur, wr, wc, fr, fq);
            for (int t = nt / 2; t < nt; t += 2) PG8_KBODY(t);
        } else {
            for (int t = 0; t < nt; t += 2) PG8_KBODY(t);
        }
        PSTAMP(lds, 20 + PID);
        if constexpr (ALIGN_EPI) { if (wr == 0) PG8_BAR; }
        E(acc, cur, wr, wc, fr, fq);
        PSTAMP(lds, 30 + PID);
        if (!has_next) break;
#pragma unroll
        for (int a = 0; a < 2; ++a)
#pragma unroll
            for (int b = 0; b < 2; ++b)
#pragma unroll
                for (int m = 0; m < 4; ++m)
#pragma unroll
                    for (int n = 0; n < 2; ++n) acc[a][b][m][n] = (f32x4){0.f, 0.f, 0.f, 0.f};
        cur = nxt; cB = nB; ++ui;
        if constexpr (ALIGN_EPI) { if (wr == 1) PG8_BAR; }
    }
    PG8_WAIT_V(0);
    if constexpr (!ALIGN_EPI) { if (wr == 0) PG8_BAR; }
    PG8_BAR;
#undef PG8_SA
#undef PG8_SB
#undef PG8_STAGE
#undef PG8_STAGE_A
#undef PG8_LDA
#undef PG8_LDB
#undef PG8_MMA
#undef PG8_WAIT_V
#undef PG8_WAIT_L
#undef PG8_BAR
#undef PG8_SCHED
#undef PG8_AOFFS
#undef PG8_KBODY
#undef PG8_IDDMA
}

__device__ __forceinline__ u32x4 pack8(const f32x4& v0, const f32x4& v1) { u32x4 w; w.x = pk2(v0[0], v0[1]); w.y = pk2(v0[2], v0[3]); w.z = pk2(v1[0], v1[1]); w.w = pk2(v1[2], v1[3]); return w; }
__device__ __forceinline__ void unpack8(const u32x4& w, f32x4& v0, f32x4& v1) { v0 = (f32x4){bflo(w.x), bfhi(w.x), bflo(w.y), bfhi(w.y)}; v1 = (f32x4){bflo(w.z), bfhi(w.z), bflo(w.w), bfhi(w.w)}; }
__device__ __forceinline__ float logsig16(float x) { return (fminf(x, 0.f) - log1pf(__expf(-fabsf(x)))) * (1.f / 16.f); }

__device__ __forceinline__ unsigned rot8(unsigned v) { return (unsigned)__builtin_amdgcn_update_dpp(0, (int)v, 0x128, 0xf, 0xf, false); }
__device__ __forceinline__ void pair_exchange(u32x4& a, u32x4& b, bool lo) {
    const u32x4 ra = (u32x4){rot8(a.x), rot8(a.y), rot8(a.z), rot8(a.w)}, rb = (u32x4){rot8(b.x), rot8(b.y), rot8(b.z), rot8(b.w)};
    const u32x4 na = lo ? a : rb, nb = lo ? ra : b; a = na; b = nb;
}
struct EpiProj {
    static constexpr bool PERM = true, MIDK = false;
    bf16* P; const float* b_alpha;
    __device__ __forceinline__ void operator()(const f32x4 (&acc)[2][2][4][2], const Unit& u, int wr, int wc, int fr, int fq) const {
        const int pn = u.pn; const int mode = (pn < 2) ? 1 : (pn == 6 ? 2 : (pn == 20 ? 3 : 0));
        const int cw = pn * 256 + wc * 64 + 8 * fq; const bool lo = fr < 8;
        f32x4 bb[2][2];
#pragma unroll
        for (int bj = 0; bj < 2; ++bj) { bb[bj][0] = (f32x4){0.f, 0.f, 0.f, 0.f}; bb[bj][1] = bb[bj][0];
            if (mode == 3) { bb[bj][0] = *(const f32x4*)(b_alpha + (cw + 32 * bj - C_AL)); bb[bj][1] = *(const f32x4*)(b_alpha + (cw + 32 * bj - C_AL) + 4); } }
#pragma unroll
        for (int ai = 0; ai < 2; ++ai)
#pragma unroll
            for (int m = 0; m < 4; ++m) {
                u32x4 w[2];
#pragma unroll
                for (int bj = 0; bj < 2; ++bj) {
                    f32x4 v0 = acc[ai][bj][m][0], v1 = acc[ai][bj][m][1];
                    if (mode == 1) { v0 = v0 * QSCALE; v1 = v1 * QSCALE; }
                    else if (mode == 2) { v0 = v0 * 0.125f; v1 = v1 * 0.125f; }
                    else if (mode == 3) {
#pragma unroll
                        for (int j = 0; j < 4; ++j) { v0[j] = logsig16(v0[j] + bb[bj][0][j]); v1[j] = logsig16(v1[j] + bb[bj][1][j]); } }
                    w[bj] = pack8(v0, v1);
                }
                pair_exchange(w[0], w[1], lo);
                const int rowA = u.pm * 256 + ai * 128 + wr * 64 + m * 16 + (fr & 7); const int cc = cw + 32 * (fr >> 3);
                *(u32x4*)(P + (size_t)rowA * NPROJ + cc) = w[0];
                *(u32x4*)(P + (size_t)(rowA + 8) * NPROJ + cc) = w[1];
            }
    }
};
struct EpiBranch {
    static constexpr bool PERM = true, MIDK = true;
    bf16* MG; const bf16* P;
    __device__ __forceinline__ void mid(f32x4 (&acc)[2][2][4][2], const Unit& u, int wr, int wc, int fr, int fq) const {
        const int cw = u.pn * 256 + wc * 64 + 8 * fq;
#pragma unroll
        for (int ai = 0; ai < 2; ++ai)
#pragma unroll
            for (int m = 0; m < 4; ++m) {
                const bf16* pr = P + (size_t)(u.pm * 256 + ai * 128 + wr * 64 + m * 16 + fr) * NPROJ + cw;
#pragma unroll
                for (int bj = 0; bj < 2; ++bj) {
                    const u32x4 gaw = *(const u32x4*)(pr + C_GA + 32 * bj), gbw = *(const u32x4*)(pr + C_GB + 32 * bj);
                    f32x4 a0, a1, b0, b1; unpack8(gaw, a0, a1); unpack8(gbw, b0, b1);
#pragma unroll
                    for (int j = 0; j < 4; ++j) {
                        acc[ai][bj][m][0][j] *= (1.f + __expf(-__builtin_amdgcn_fmed3f(b0[j], -30.f, 30.f))) * __builtin_amdgcn_rcpf(1.f + __expf(-a0[j]));
                        acc[ai][bj][m][1][j] *= (1.f + __expf(-__builtin_amdgcn_fmed3f(b1[j], -30.f, 30.f))) * __builtin_amdgcn_rcpf(1.f + __expf(-a1[j])); }
                }
                if (m & 1) asm volatile("" ::: "memory");
            }
    }
    __device__ __forceinline__ void operator()(const f32x4 (&acc)[2][2][4][2], const Unit& u, int wr, int wc, int fr, int fq) const {
        const int cw = u.pn * 256 + wc * 64 + 8 * fq; const bool lo = fr < 8;
#pragma unroll
        for (int ai = 0; ai < 2; ++ai)
#pragma unroll
            for (int m = 0; m < 4; ++m) {
                const int row = u.pm * 256 + ai * 128 + wr * 64 + m * 16 + fr;
                u32x4 w[2];
#pragma unroll
                for (int bj = 0; bj < 2; ++bj) {
                    const u32x4 gbw = *(const u32x4*)(P + (size_t)row * NPROJ + C_GB + cw + 32 * bj);
                    f32x4 b0, b1; unpack8(gbw, b0, b1);
                    f32x4 v0 = acc[ai][bj][m][0], v1 = acc[ai][bj][m][1];
#pragma unroll
                    for (int j = 0; j < 4; ++j) { v0[j] *= __builtin_amdgcn_rcpf(1.f + __expf(-__builtin_amdgcn_fmed3f(b0[j], -30.f, 30.f))); v1[j] *= __builtin_amdgcn_rcpf(1.f + __expf(-__builtin_amdgcn_fmed3f(b1[j], -30.f, 30.f))); }
                    w[bj] = pack8(v0, v1);
                }
                pair_exchange(w[0], w[1], lo);
                const int rowA = u.pm * 256 + ai * 128 + wr * 64 + m * 16 + (fr & 7); const int cc = cw + 32 * (fr >> 3);
                *(u32x4*)(MG + (size_t)rowA * DM + cc) = w[0];
                *(u32x4*)(MG + (size_t)(rowA + 8) * DM + cc) = w[1];
            }
    }
};
struct EpiOut {
    static constexpr bool PERM = true, MIDK = false;
    bf16* Y1; const float* mod;
    __device__ __forceinline__ void operator()(const f32x4 (&acc)[2][2][4][2], const Unit& u, int wr, int wc, int fr, int fq) const {
        const int b = u.pm >> 3; const float* gt1 = mod + b * 6144 + 2048;
        const int cw = u.pn * 256 + wc * 64 + 8 * fq; const bool lo = fr < 8;
        f32x4 g[2][2];
#pragma unroll
        for (int bj = 0; bj < 2; ++bj) { g[bj][0] = *(const f32x4*)(gt1 + cw + 32 * bj); g[bj][1] = *(const f32x4*)(gt1 + cw + 32 * bj + 4); }
#pragma unroll
        for (int ai = 0; ai < 2; ++ai)
#pragma unroll
            for (int m = 0; m < 4; ++m) {
                u32x4 wa = pack8(acc[ai][0][m][0] * g[0][0], acc[ai][0][m][1] * g[0][1]), wb = pack8(acc[ai][1][m][0] * g[1][0], acc[ai][1][m][1] * g[1][1]);
                pair_exchange(wa, wb, lo);
                const int rowA = u.pm * 256 + ai * 128 + wr * 64 + m * 16 + (fr & 7); const int cc = cw + 32 * (fr >> 3);
                *(u32x4*)(Y1 + (size_t)rowA * DM + cc) = wa;
                *(u32x4*)(Y1 + (size_t)(rowA + 8) * DM + cc) = wb;
            }
    }
};
struct EpiUp {
    static constexpr bool PERM = true, MIDK = false;
    unsigned char* ACT; const float* b_gu;
    __device__ __forceinline__ void operator()(const f32x4 (&acc)[2][2][4][2], const Unit& u, int wr, int wc, int fr, int fq) const {
        const int f0 = u.pn * 128 + wc * 32 + 8 * fq;
        const float* bg = b_gu + (size_t)u.e * 2048 + f0; const float* bu = bg + 1024;
        const f32x4 bg0 = *(const f32x4*)bg, bg1 = *(const f32x4*)(bg + 4), bu0 = *(const f32x4*)bu, bu1 = *(const f32x4*)(bu + 4);
#pragma unroll
        for (int ai = 0; ai < 2; ++ai)
#pragma unroll
            for (int m = 0; m < 4; ++m) {
                const int r = ai * 128 + wr * 64 + m * 16 + fr;
                f32x4 g0 = acc[ai][0][m][0] + bg0, g1 = acc[ai][0][m][1] + bg1, u0 = acc[ai][1][m][0] + bu0, u1 = acc[ai][1][m][1] + bu1, a0, a1;
#pragma unroll
                for (int j = 0; j < 4; ++j) {
                    float gg = fminf(g0[j], 7.f), uu = fminf(fmaxf(u0[j], -7.f), 7.f); a0[j] = (uu + 1.f) * gg * sigmoidf_(1.702f * gg);
                    gg = fminf(g1[j], 7.f); uu = fminf(fmaxf(u1[j], -7.f), 7.f); a1[j] = (uu + 1.f) * gg * sigmoidf_(1.702f * gg); }
                *(u32x2*)(ACT + (size_t)(u.pm * 256 + r) * FF + f0) = (u32x2){pk4_fp8(a0[0] * F8_ASCALE, a0[1] * F8_ASCALE, a0[2] * F8_ASCALE, a0[3] * F8_ASCALE), pk4_fp8(a1[0] * F8_ASCALE, a1[1] * F8_ASCALE, a1[2] * F8_ASCALE, a1[3] * F8_ASCALE)};
            }
    }
};
constexpr float F8_YSCALE = 16.f;
__device__ __forceinline__ void pair_exchange2(u32x2& a, u32x2& b, bool lo) {
    const u32x2 ra = (u32x2){rot8(a.x), rot8(a.y)}, rb = (u32x2){rot8(b.x), rot8(b.y)};
    const u32x2 na = lo ? a : rb, nb = lo ? ra : b; a = na; b = nb;
}
struct EpiDown {
    static constexpr bool PERM = true, MIDK = false;
    unsigned char* YB; const float* b_dn; const int* list;
    __device__ __forceinline__ void operator()(const f32x4 (&acc)[2][2][4][2], const Unit& u, int wr, int wc, int fr, int fq) const {
        const int cw = u.pn * 256 + wc * 64 + 8 * fq; const bool lo = fr < 8;
        f32x4 bb[2][2];
#pragma unroll
        for (int bj = 0; bj < 2; ++bj) { const float* bp = b_dn + (size_t)u.e * DM + cw + 32 * bj; bb[bj][0] = *(const f32x4*)bp; bb[bj][1] = *(const f32x4*)(bp + 4); }
#pragma unroll
        for (int ai = 0; ai < 2; ++ai)
#pragma unroll
            for (int m = 0; m < 4; ++m) {
                const int slot = u.row0 + ai * 128 + wr * 64 + m * 16 + fr;
                const int aid = slot < u.cnt ? list[u.e * NTOK + slot] : -1;
                const int aidx = (int)rot8((unsigned)aid);
                u32x2 w[2];
#pragma unroll
                for (int bj = 0; bj < 2; ++bj) { f32x4 v0 = (acc[ai][bj][m][0] + bb[bj][0]) * F8_YSCALE, v1 = (acc[ai][bj][m][1] + bb[bj][1]) * F8_YSCALE;
#pragma unroll
                    for (int j = 0; j < 4; ++j) { v0[j] = __builtin_amdgcn_fmed3f(v0[j], -440.f, 440.f); v1[j] = __builtin_amdgcn_fmed3f(v1[j], -440.f, 440.f); }
                    w[bj] = (u32x2){pk4_fp8(v0[0], v0[1], v0[2], v0[3]), pk4_fp8(v1[0], v1[1], v1[2], v1[3])}; }
                pair_exchange2(w[0], w[1], lo);
                const int aidA = lo ? aid : aidx, aidB = lo ? aidx : aid;
                const int cc = cw + 32 * (fr >> 3);
                if (aidA >= 0) *(u32x2*)(YB + (size_t)aidA * DM + cc) = w[0];
                if (aidB >= 0) *(u32x2*)(YB + (size_t)aidB * DM + cc) = w[1];
            }
    }
};

__device__ __forceinline__ void split_bf16(const float (&v)[8], bf16x8& hi, bf16x8& lo) {
    const unsigned h0 = pk2(v[0], v[1]), h1 = pk2(v[2], v[3]), h2 = pk2(v[4], v[5]), h3 = pk2(v[6], v[7]);
    const u32x4 h = (u32x4){h0, h1, h2, h3};
    const u32x4 l = (u32x4){pk2(v[0] - bflo(h0), v[1] - bfhi(h0)), pk2(v[2] - bflo(h1), v[3] - bfhi(h1)), pk2(v[4] - bflo(h2), v[5] - bfhi(h2)), pk2(v[6] - bflo(h3), v[7] - bfhi(h3))};
    hi = __builtin_bit_cast(bf16x8, h); lo = __builtin_bit_cast(bf16x8, l);
}
constexpr int T_NITEMS = 16 * 80 + 2 * 8 * 16 + 16 * 16 + 32 * 16 * 32 + 32 * 16 * 16;
__device__ __forceinline__ void transposes(const Ctx& C, int i0, int i1, int w, int nw);
__device__ __forceinline__ void phase_mod(const Ctx& C) {
    LAS float* sc = (LAS float*)C.lds;
    LAS float* red = sc + 16 * 1024;
    for (int cb = C.bid; cb < 96; cb += C.G) {
        __syncthreads();
        for (int i = C.tid; i < 16 * 1024; i += NTHREADS) { const float v = C.c[i]; sc[i] = v / (1.f + __expf(-v)); }
        __syncthreads();
        const int cl = C.tid & 63, ks = C.tid >> 6, col = cb * 64 + cl;
        float acc[16];
#pragma unroll
        for (int b = 0; b < 16; ++b) acc[b] = 0.f;
#pragma unroll 2
        for (int k = ks * 128; k < ks * 128 + 128; k += 4) {
            const float w0 = C.w_ada[(size_t)k * 6144 + col], w1 = C.w_ada[(size_t)(k + 1) * 6144 + col], w2 = C.w_ada[(size_t)(k + 2) * 6144 + col], w3 = C.w_ada[(size_t)(k + 3) * 6144 + col];
#pragma unroll
            for (int b = 0; b < 16; ++b) { const f32x4 s4 = *(const LAS f32x4*)(sc + b * 1024 + k); acc[b] += (s4[0] * w0 + s4[1] * w1) + (s4[2] * w2 + s4[3] * w3); }
        }
#pragma unroll
        for (int b = 0; b < 16; ++b) red[(ks * 16 + b) * 64 + cl] = acc[b];
        __syncthreads();
        for (int o = C.tid; o < 1024; o += NTHREADS) {
            const int b = o >> 6, c2 = o & 63; float s = 0.f;
#pragma unroll
            for (int k2 = 0; k2 < 8; ++k2) s += red[(k2 * 16 + b) * 64 + c2];
            C.mod[b * 6144 + cb * 64 + c2] = s + C.b_ada[cb * 64 + c2];
        }
    }
    __syncthreads();
    { const int gw = C.bid * NWAVES + C.wid, NGW = C.G * NWAVES;
      if (C.G == 256) { constexpr int N1 = 11 * 2048; transposes(C, 0, N1, gw, NGW); if (C.bid >= 96) transposes(C, N1, T_NITEMS, gw - 96 * NWAVES, NGW - 96 * NWAVES); }
      else transposes(C, 0, T_NITEMS, gw, NGW); }
    for (int idx = C.bid * NTHREADS + C.tid; idx < 4096; idx += C.G * NTHREADS) {
        const int l2 = idx & 63, nt = (idx >> 6) & 1, ks = (idx >> 7) & 3, w2 = idx >> 9; float wv[8];
#pragma unroll
        for (int j = 0; j < 8; ++j) wv[j] = C.w_router[(size_t)(128 * w2 + 32 * ks + 8 * (l2 >> 4) + j) * NE + 16 * nt + (l2 & 15)];
        bf16x8 h8, l8; split_bf16(wv, h8, l8); C.wrf[idx] = __builtin_bit_cast(u32x4, h8); C.wrf[4096 + idx] = __builtin_bit_cast(u32x4, l8); }
    for (int gt = C.bid * NTHREADS + C.tid; gt < 256 * 512; gt += C.G * NTHREADS) {
        const int j = gt >> 9, k = (gt & 511) * 2;
        float s0 = 0.f, s1 = 0.f;
#pragma unroll
        for (int r = 0; r < 16; ++r) { const float wa = C.w_alpha_up[r * 256 + j]; s0 += C.w_in[(size_t)k * W_IN_N + 3072 + r] * wa; s1 += C.w_in[(size_t)(k + 1) * W_IN_N + 3072 + r] * wa; }
        *(unsigned*)(C.WinT + (size_t)(C_AL + j) * DM + k) = pk2(s0, s1);
    }
}

struct TItem { const float* src; unsigned char* dst; int srcN, pitch, hop, fp8; };
__device__ __forceinline__ TItem titem_decode(const Ctx& C, int it) {
    constexpr int I_IN = 16 * 80, I_BD = 8 * 16, I_OUT = 16 * 16, I_GU = 32 * 16 * 32;
    TItem t; t.hop = 0; t.fp8 = 0; int r = it;
    if (r < I_IN) { const int kb = r / 80, n0 = (r % 80) * 64; t.srcN = W_IN_N; t.pitch = DM * 2; t.src = C.w_in + (size_t)(kb * 64) * W_IN_N + (n0 < 3072 ? n0 : n0 + 16); t.dst = (unsigned char*)(C.WinT + (size_t)n0 * DM + kb * 64); return t; } r -= I_IN;
    if (r < I_BD) { t.srcN = DM; t.pitch = 2048; t.src = C.w_bd + (size_t)((r >> 4) * 64) * DM + (r & 15) * 64; t.dst = (unsigned char*)(C.WbdT + (size_t)((r & 15) * 64) * 1024 + (r >> 4) * 64); return t; } r -= I_BD;
    if (r < I_BD) { t.srcN = DM; t.pitch = 2048; t.src = C.w_bg + (size_t)((r >> 4) * 64) * DM + (r & 15) * 64; t.dst = (unsigned char*)(C.WbdT + (size_t)((r & 15) * 64) * 1024 + 512 + (r >> 4) * 64); return t; } r -= I_BD;
    if (r < I_OUT) { t.srcN = DM; t.pitch = DM * 2; t.src = C.w_out + (size_t)((r >> 4) * 64) * DM + (r & 15) * 64; t.dst = (unsigned char*)(C.WoutT + (size_t)((r & 15) * 64) * DM + (r >> 4) * 64); return t; } r -= I_OUT;
    if (r < I_GU) { const int e = r >> 9, rr = r & 511, kb = rr >> 5, n0 = (rr & 31) * 64; const int pn = n0 >> 8, wc = (n0 >> 6) & 3;
        t.srcN = 2048; t.pitch = 1024; t.fp8 = 1; t.hop = 1024 - 32; t.src = C.w_gu + (size_t)e * DM * 2048 + (size_t)(kb * 64) * 2048 + pn * 128 + wc * 32; t.dst = (unsigned char*)C.WguT + (size_t)e * 2048 * 1024 + (size_t)n0 * 1024 + kb * 64; return t; } r -= I_GU;
    { const int e = r >> 8, rr = r & 255, kb = rr >> 4, n0 = (rr & 15) * 64;
        t.srcN = DM; t.pitch = 1024; t.fp8 = 1; t.src = C.w_dn + (size_t)e * FF * DM + (size_t)(kb * 64) * DM + n0; t.dst = (unsigned char*)C.WdT + (size_t)e * DM * 1024 + (size_t)n0 * 1024 + kb * 64; return t; }
}
__device__ __forceinline__ void titem_load(const TItem& t, int lane, f32x4 (&v)[16]) {
#pragma unroll
    for (int i = 0; i < 16; ++i) v[i] = *(const f32x4*)(t.src + (size_t)(4 * i + (lane >> 4)) * t.srcN + 4 * (lane & 15) + ((lane & 8) ? t.hop : 0));
}
__device__ __forceinline__ void titem_store(const TItem& t, int lane, const f32x4 (&v)[16], LAS float* scr) {
#pragma unroll
    for (int i = 0; i < 16; ++i) { LAS float* p = scr + (4 * i + (lane >> 4)) * 65 + 4 * (lane & 15); p[0] = v[i][0]; p[1] = v[i][1]; p[2] = v[i][2]; p[3] = v[i][3]; }
    LDS_WAIT(); asm volatile("" ::: "memory");
    const int c = lane & 7;
#pragma unroll
    for (int j = 0; j < 8; ++j) { const int n = (lane >> 3) + 8 * j; const LAS float* s = scr + (8 * c) * 65 + n;
        if (t.fp8) { float w[8];
#pragma unroll
            for (int q = 0; q < 8; ++q) w[q] = __builtin_amdgcn_fmed3f(s[q * 65] * F8_WSCALE, -440.f, 440.f);
            *(u32x2*)(t.dst + (size_t)n * t.pitch + 8 * c) = (u32x2){pk4_fp8(w[0], w[1], w[2], w[3]), pk4_fp8(w[4], w[5], w[6], w[7])}; }
        else { u32x4 o; o.x = pk2(s[0 * 65], s[1 * 65]); o.y = pk2(s[2 * 65], s[3 * 65]); o.z = pk2(s[4 * 65], s[5 * 65]); o.w = pk2(s[6 * 65], s[7 * 65]);
            *(u32x4*)(t.dst + (size_t)n * t.pitch + 16 * c) = o; } }
    LDS_WAIT(); asm volatile("" ::: "memory");
}
__device__ __forceinline__ void transposes(const Ctx& C, int i0, int i1, int w, int nw) {
    LAS float* scr = (LAS float*)(C.lds + C.wid * 16896);
    int it = i0 + w; if (it >= i1) return;
    TItem cur = titem_decode(C, it); f32x4 v[16]; titem_load(cur, C.lane, v);
    for (;;) {
        const int nit = it + nw; const bool more = nit < i1;
        TItem nxt = cur; f32x4 vn[16];
        if (more) { nxt = titem_decode(C, nit); titem_load(nxt, C.lane, vn); }
        titem_store(cur, C.lane, v, scr);
        if (!more) break;
        cur = nxt; it = nit;
#pragma unroll
        for (int i = 0; i < 16; ++i) v[i] = vn[i];
    }
}
__device__ __forceinline__ void phase_prep(const Ctx& C) {
    const int gw = C.bid * NWAVES + C.wid, NGW = C.G * NWAVES;
    for (int row = gw; row < NTOK; row += 2 * NGW) {
        const int row2 = row + NGW;
        const bool two = row2 < NTOK;
        f32x4 v[2][4]; float ss[2] = {0.f, 0.f};
#pragma unroll
        for (int j = 0; j < 4; ++j) { v[0][j] = *(const f32x4*)(C.x + (size_t)row * DM + 4 * C.lane + 256 * j); v[1][j] = two ? *(const f32x4*)(C.x + (size_t)row2 * DM + 4 * C.lane + 256 * j) : (f32x4){0.f, 0.f, 0.f, 0.f}; }
#pragma unroll
        for (int r = 0; r < 2; ++r)
#pragma unroll
            for (int j = 0; j < 4; ++j) ss[r] += (v[r][j][0] * v[r][j][0] + v[r][j][1] * v[r][j][1]) + (v[r][j][2] * v[r][j][2] + v[r][j][3] * v[r][j][3]);
#pragma unroll
        for (int r = 0; r < 2; ++r) { if (r == 1 && !two) break;
            const int rw = r ? row2 : row; const int b = rw >> 11; const float* md = C.mod + b * 6144;
            const float rstd = rsqrtf(wave_sum(ss[r]) * (1.f / DM) + EPS);
#pragma unroll
            for (int j = 0; j < 4; ++j) { const int c0 = 4 * C.lane + 256 * j;
                const f32x4 g = *(const f32x4*)(C.norm1_g + c0), sc = *(const f32x4*)(md + 1024 + c0), sh = *(const f32x4*)(md + c0);
                const f32x4 y = v[r][j] * rstd * g * (sc + 1.f) + sh;
                u32x2 o; o.x = pk2(y[0], y[1]); o.y = pk2(y[2], y[3]);
                *(u32x2*)(C.H + (size_t)rw * DM + c0) = o; } }
    }
}

__device__ __forceinline__ void gla_scan(const Ctx& C, int b, int h) {
    LAS float* qs = (LAS float*)C.lds;
    LAS float* ks = qs + 2048;
    LAS float* al = ks + 2048;
    LAS float* vs = al + 2048;
    LAS float* part = vs + 4096;
    const int dv = C.tid & 127, dkg = C.tid >> 7;
    float S[16];
#pragma unroll
    for (int j = 0; j < 16; ++j) S[j] = 0.f;
    const float gdv0 = C.gla_g[2 * C.lane], gdv1 = C.gla_g[2 * C.lane + 1];
    for (int ch = 0; ch < SEQ / 32; ++ch) {
        const int row0 = b * SEQ + ch * 32;
        __syncthreads();
        for (int i = C.tid; i < 32 * 64; i += NTHREADS) { const int t = i >> 6, d = i & 63; const bf16* pr = C.PROJ + (size_t)(row0 + t) * NPROJ;
            qs[i] = bf2f(pr[C_GQ + h * 64 + d]); ks[i] = bf2f(pr[C_GK + h * 64 + d]); al[i] = __expf(bf2f(pr[C_AL + h * 64 + d])); }
        for (int i = C.tid; i < 32 * 128; i += NTHREADS) { const int t = i >> 7, d = i & 127; vs[i] = bf2f(C.PROJ[(size_t)(row0 + t) * NPROJ + C_GV + h * 128 + d]); }
        __syncthreads();
#pragma unroll 2
        for (int t = 0; t < 32; ++t) {
            const float v = vs[t * 128 + dv]; float o = 0.f;
#pragma unroll
            for (int j4 = 0; j4 < 4; ++j4) {
                const f32x4 a4 = *(const LAS f32x4*)(al + t * 64 + dkg * 16 + j4 * 4), k4 = *(const LAS f32x4*)(ks + t * 64 + dkg * 16 + j4 * 4), q4 = *(const LAS f32x4*)(qs + t * 64 + dkg * 16 + j4 * 4);
#pragma unroll
                for (int jj = 0; jj < 4; ++jj) { const int j = j4 * 4 + jj; S[j] = a4[jj] * S[j] + k4[jj] * v; o += q4[jj] * S[j]; }
            }
            part[(dkg * 32 + t) * 128 + dv] = o;
        }
        __syncthreads();
#pragma unroll
        for (int tt = 0; tt < 4; ++tt) {
            const int t = 4 * C.wid + tt; float o0 = 0.f, o1 = 0.f;
#pragma unroll
            for (int g = 0; g < 4; ++g) { o0 += part[(g * 32 + t) * 128 + 2 * C.lane]; o1 += part[(g * 32 + t) * 128 + 2 * C.lane + 1]; }
            const float rstd = rsqrtf(wave_sum(o0 * o0 + o1 * o1) * (1.f / 128.f) + EPS);
            const unsigned grw = *(const unsigned*)(C.PROJ + (size_t)(row0 + t) * NPROJ + C_GR + h * 128 + 2 * C.lane);
            const float g0 = bflo(grw), g1 = bfhi(grw);
            const float y0 = o0 * rstd * gdv0 * (g0 * sigmoidf_(g0)), y1 = o1 * rstd * gdv1 * (g1 * sigmoidf_(g1));
            *(unsigned*)(C.OB + (size_t)(row0 + t) * 512 + h * 128 + 2 * C.lane) = pk2(y0, y1);
        }
    }
}

__device__ __forceinline__ void attn_simple(const Ctx& C) {
    LAS float* Kt = (LAS float*)C.lds;
    LAS float* Vt = Kt + 8192;
    LAS float* Ss = Vt + 8192;
    LAS float* ssq = Ss + 2 * 64 * 68;
    LAS float* lamp = ssq + 256;
    if (C.tid < 64) {
        const float a = wave_sum(C.lq1[C.lane] * C.lk1[C.lane]), b2 = wave_sum(C.lq2[C.lane] * C.lk2[C.lane]);
        if (C.tid == 0) lamp[0] = __expf(a) - __expf(b2) + 0.2f;
    }
    __syncthreads();
    const float lam = lamp[0];
    const int q = C.tid & 63, p = (C.tid >> 6) & 1, dq = C.tid >> 7;
    for (int uix = C.bid; uix < 2048; uix += C.G) {
        const int bh = uix & 63, g = (uix >> 6) & 3, i2 = uix >> 8; const int b = bh >> 2, h = bh & 3;
        const int qc = (i2 & 1) ? (31 - (4 * g + (i2 >> 1))) : (4 * g + (i2 >> 1));
        const float sl2 = exp2f(-2.f * (float)(h + 1)) * LOG2E;
        const int qrow = b * SEQ + qc * 64 + q;
        float qv[64];
#pragma unroll
        for (int d8 = 0; d8 < 8; ++d8) { const u32x4 w = *(const u32x4*)(C.PROJ + (size_t)qrow * NPROJ + C_DQ + h * 128 + p * 64 + d8 * 8);
            qv[d8 * 8 + 0] = bflo(w.x); qv[d8 * 8 + 1] = bfhi(w.x); qv[d8 * 8 + 2] = bflo(w.y); qv[d8 * 8 + 3] = bfhi(w.y);
            qv[d8 * 8 + 4] = bflo(w.z); qv[d8 * 8 + 5] = bfhi(w.z); qv[d8 * 8 + 6] = bflo(w.w); qv[d8 * 8 + 7] = bfhi(w.w); }
        float m = -1e30f, l = 0.f, acc[32];
#pragma unroll
        for (int d = 0; d < 32; ++d) acc[d] = 0.f;
        for (int kc = 0; kc <= qc; ++kc) {
            __syncthreads();
            for (int pi = C.tid; pi < 1024; pi += NTHREADS) { const int r = pi >> 4, cc = pi & 15; const bf16* pr = C.PROJ + (size_t)(b * SEQ + kc * 64 + r) * NPROJ + h * 128 + cc * 8;
                const u32x4 kw = *(const u32x4*)(pr + C_DK), vw = *(const u32x4*)(pr + C_DV); f32x4 a0, a1;
                unpack8(kw, a0, a1); *(LAS f32x4*)(Kt + r * 128 + cc * 8) = a0; *(LAS f32x4*)(Kt + r * 128 + cc * 8 + 4) = a1;
                unpack8(vw, a0, a1); *(LAS f32x4*)(Vt + r * 128 + cc * 8) = a0; *(LAS f32x4*)(Vt + r * 128 + cc * 8 + 4) = a1; }
            __syncthreads();
#pragma unroll 1
            for (int kk = 0; kk < 16; ++kk) {
                const int key = dq * 16 + kk; float s = 0.f;
#pragma unroll
                for (int d4 = 0; d4 < 16; ++d4) { const f32x4 kv = *(const LAS f32x4*)(Kt + key * 128 + p * 64 + d4 * 4);
                    s += qv[d4 * 4] * kv[0]; s += qv[d4 * 4 + 1] * kv[1]; s += qv[d4 * 4 + 2] * kv[2]; s += qv[d4 * 4 + 3] * kv[3]; }
                const int kpos = kc * 64 + key, qpos = qc * 64 + q; const int mn = kpos < 2 * qpos - kpos ? kpos : 2 * qpos - kpos;
                Ss[(p * 64 + q) * 68 + key] = s + sl2 * (float)mn;
            }
            __syncthreads();
            const LAS float* srow = Ss + (p * 64 + q) * 68;
            float cm = -1e30f;
#pragma unroll
            for (int k4 = 0; k4 < 16; ++k4) { const f32x4 sv = *(const LAS f32x4*)(srow + k4 * 4); cm = fmaxf(cm, fmaxf(fmaxf(sv[0], sv[1]), fmaxf(sv[2], sv[3]))); }
            const float mnew = fmaxf(m, cm), alpha = exp2f(m - mnew); m = mnew; l *= alpha;
#pragma unroll
            for (int d = 0; d < 32; ++d) acc[d] *= alpha;
#pragma unroll 2
            for (int key = 0; key < 64; ++key) {
                const float pk = exp2f(srow[key] - m); l += pk;
#pragma unroll
                for (int d4 = 0; d4 < 8; ++d4) { const f32x4 vv = *(const LAS f32x4*)(Vt + key * 128 + dq * 32 + d4 * 4);
                    acc[d4 * 4] += pk * vv[0]; acc[d4 * 4 + 1] += pk * vv[1]; acc[d4 * 4 + 2] += pk * vv[2]; acc[d4 * 4 + 3] += pk * vv[3]; }
            }
        }
        const float inv = 1.f / l;
        __syncthreads();
        LAS float* O2 = Ss;
        if (p == 1) {
#pragma unroll
            for (int d = 0; d < 32; ++d) O2[q * 128 + dq * 32 + d] = lam * acc[d] * inv;
        }
        __syncthreads();
        float ss = 0.f;
        if (p == 0) {
#pragma unroll
            for (int d = 0; d < 32; ++d) { acc[d] = acc[d] * inv - O2[q * 128 + dq * 32 + d]; ss += acc[d] * acc[d]; }
            ssq[q * 4 + dq] = ss;
        }
        __syncthreads();
        if (p == 0) {
            const float tot = (ssq[q * 4] + ssq[q * 4 + 1]) + (ssq[q * 4 + 2] + ssq[q * 4 + 3]);
            const float rstd = rsqrtf(tot * (1.f / 128.f) + EPS) * 0.8f;
            bf16* dst = C.OA + (size_t)qrow * 512 + h * 128 + dq * 32;
#pragma unroll
            for (int d8 = 0; d8 < 4; ++d8) { u32x4 w; const float* gg = C.diff_g + dq * 32 + d8 * 8;
                w.x = pk2(acc[d8 * 8] * rstd * gg[0], acc[d8 * 8 + 1] * rstd * gg[1]); w.y = pk2(acc[d8 * 8 + 2] * rstd * gg[2], acc[d8 * 8 + 3] * rstd * gg[3]);
                w.z = pk2(acc[d8 * 8 + 4] * rstd * gg[4], acc[d8 * 8 + 5] * rstd * gg[5]); w.w = pk2(acc[d8 * 8 + 6] * rstd * gg[6], acc[d8 * 8 + 7] * rstd * gg[7]);
                *(u32x4*)(dst + d8 * 8) = w; }
        }
    }
}


typedef float f32x16 __attribute__((ext_vector_type(16)));
typedef short s16x4 __attribute__((ext_vector_type(4)));
typedef short v4i16_t __attribute__((ext_vector_type(4)));
__device__ __forceinline__ s16x4 vtr(const LAS unsigned char* p) { return __builtin_bit_cast(s16x4, __builtin_amdgcn_ds_read_tr16_b64_v4i16((LAS v4i16_t*)p)); }
template <int OFF> __device__ __forceinline__ void glds16(const void* sbase, unsigned voff, unsigned lds_dst) {
    unsigned sv; asm volatile("s_mov_b32 %0, m0\n\ts_mov_b32 m0, %3\n\ts_nop 0\n\tglobal_load_lds_dwordx4 %1, %2 offset:%4\n\ts_mov_b32 m0, %0" : "=&s"(sv) : "v"(voff), "s"(sbase), "s"(lds_dst), "i"(OFF) : "memory"); }
__device__ __forceinline__ unsigned lds_addr(const LAS unsigned char* p) { return (unsigned)__builtin_amdgcn_readfirstlane((int)(unsigned)(size_t)p); }
#define MFMA16(a, b, c) __builtin_amdgcn_mfma_f32_16x16x32_bf16(a, b, c, 0, 0, 0)
__device__ __forceinline__ bf16x8 cat44(s16x4 lo, s16x4 hi) { return (bf16x8){lo[0], lo[1], lo[2], lo[3], hi[0], hi[1], hi[2], hi[3]}; }
__device__ __forceinline__ void gla_chunked(const Ctx& C, int b, int h) {
    const int lane = C.lane, wid = C.wid, fr = lane & 15, fq = lane >> 4;
    LAS unsigned char* lds = C.lds;
    constexpr int RAW_Q = 0, RAW_K = 8192, RAW_LA = 16384, VB0 = 24576, QS = 57344, KS = 66560, KD = 75776, AM = 84992, ST = 94208, OO = 112640, GTL = 146432, SSQ = 146688;
    constexpr int P = 144, PO = 528;
    const char* pbase = (const char*)(C.PROJ + (size_t)(b * SEQ) * NPROJ);
    const unsigned oq = (unsigned)(((8 * wid + (lane >> 3)) * NPROJ + C_GQ + h * 64 + (lane & 7) * 8) * 2);
    const unsigned okk = oq + (unsigned)((C_GK - C_GQ) * 2), ol = oq + (unsigned)((C_AL - C_GQ) * 2);
    const unsigned ov0 = (unsigned)(((4 * wid + (lane >> 4)) * NPROJ + C_GV + h * 128 + (lane & 15) * 8) * 2), ov1 = ov0 + (unsigned)(32 * NPROJ * 2);
#define GL_DMA(n) do { const char* _cb = pbase + (size_t)(n) * 64 * NPROJ * 2; const unsigned _vb = VB0 + ((n) & 1) * 16384; \
        glds16<0>(_cb, oq, lds_addr(lds + RAW_Q + wid * 1024)); glds16<0>(_cb, okk, lds_addr(lds + RAW_K + wid * 1024)); glds16<0>(_cb, ol, lds_addr(lds + RAW_LA + wid * 1024)); \
        glds16<0>(_cb, ov0, lds_addr(lds + _vb + wid * 1024)); glds16<0>(_cb, ov1, lds_addr(lds + _vb + (wid + 8) * 1024)); } while (0)
    __syncthreads();
    GL_DMA(0);
    for (int i = lane; i < 16 * P / 4; i += 64) ((LAS unsigned*)(lds + ST + wid * 16 * P))[i] = 0u;
    f32x4 accS[4];
#pragma unroll
    for (int t = 0; t < 4; ++t) accS[t] = (f32x4){0.f, 0.f, 0.f, 0.f};
    const int t1 = wid >> 1, ca = 2 * (wid & 1);
    bf16x8 ym[2][2];
#pragma unroll
    for (int ci = 0; ci < 2; ++ci)
#pragma unroll
        for (int ks = 0; ks < 2; ++ks)
#pragma unroll
            for (int jj = 0; jj < 8; ++jj) ym[ci][ks][jj] = (short)(((32 * ks + 8 * fq + jj) <= (16 * (ca + ci) + fr)) ? 0x3F80 : 0);
    const bf16x8 ones = (bf16x8){0x3F80, 0x3F80, 0x3F80, 0x3F80, 0x3F80, 0x3F80, 0x3F80, 0x3F80};
    const int qp = (lane & 15) >> 2, pp = lane & 3;
    const float g0 = C.gla_g[2 * lane], g1 = C.gla_g[2 * lane + 1];
    unsigned grw[8];
#pragma unroll
    for (int cc = 0; cc < 8; ++cc) grw[cc] = 0u;
#define GL_ROWPASS(n) do { _Pragma("unroll") for (int cc = 0; cc < 8; ++cc) { const int c_ = 8 * wid + cc; \
        const float o0 = *(const LAS float*)(lds + OO + c_ * PO + lane * 8), o1 = *(const LAS float*)(lds + OO + c_ * PO + lane * 8 + 4); \
        const f32x4 qa = *(const LAS f32x4*)(lds + SSQ + c_ * 32), qb = *(const LAS f32x4*)(lds + SSQ + c_ * 32 + 16); \
        const float rstd = rsqrtf((((qa[0] + qa[1]) + (qa[2] + qa[3])) + ((qb[0] + qb[1]) + (qb[2] + qb[3]))) * (1.f / 128.f) + EPS); const float gr0 = bflo(grw[cc]), gr1 = bfhi(grw[cc]); \
        *(unsigned*)(C.OA + (size_t)(b * SEQ + (n) * 64 + c_) * 1024 + 512 + h * 128 + 2 * lane) = pk2(o0 * rstd * g0 * (gr0 * sigmoidf_(gr0)), o1 * rstd * g1 * (gr1 * sigmoidf_(gr1))); } } while (0)
#pragma unroll 1
    for (int n = 0; n < SEQ / 64; ++n) {
        asm volatile("s_waitcnt vmcnt(0) lgkmcnt(0)" ::: "memory"); __syncthreads();
        if (n > 0) GL_ROWPASS(n - 1);
#pragma unroll
        for (int cc = 0; cc < 8; ++cc) grw[cc] = *(const unsigned*)(pbase + ((size_t)(n * 64 + 8 * wid + cc) * NPROJ + C_GR + h * 128 + 2 * lane) * 2);
        {
            bf16x8 xla[2];
#pragma unroll
            for (int ks = 0; ks < 2; ++ks) { const LAS unsigned char* a = lds + RAW_LA + (32 * ks + 8 * fq + qp) * 128 + (16 * t1 + 4 * pp) * 2; xla[ks] = cat44(vtr(a), vtr(a + 4 * 128)); }
            f32x4 Ga = (f32x4){0.f, 0.f, 0.f, 0.f}, Gb = Ga, GT = Ga;
#pragma unroll
            for (int ks = 0; ks < 2; ++ks) { Ga = MFMA16(xla[ks], ym[0][ks], Ga); Gb = MFMA16(xla[ks], ym[1][ks], Gb); GT = MFMA16(xla[ks], ones, GT); }
#pragma unroll
            for (int ci = 0; ci < 2; ++ci) {
                const int c_ = 16 * (ca + ci) + fr, dk0 = 16 * t1 + 4 * fq; const f32x4 G = ci ? Gb : Ga;
                const u32x2 qw = *(const LAS u32x2*)(lds + RAW_Q + c_ * 128 + dk0 * 2), kw = *(const LAS u32x2*)(lds + RAW_K + c_ * 128 + dk0 * 2);
                const float q4[4] = {bflo(qw.x), bfhi(qw.x), bflo(qw.y), bfhi(qw.y)}, k4[4] = {bflo(kw.x), bfhi(kw.x), bflo(kw.y), bfhi(kw.y)};
                float qs4[4], ks4[4], kd4[4];
#pragma unroll
                for (int r = 0; r < 4; ++r) { qs4[r] = q4[r] * __expf(G[r]); ks4[r] = k4[r] * __expf(-G[r]); kd4[r] = k4[r] * __expf(GT[r] - G[r]); }
                *(LAS u32x2*)(lds + QS + c_ * P + dk0 * 2) = (u32x2){pk2(qs4[0], qs4[1]), pk2(qs4[2], qs4[3])};
                *(LAS u32x2*)(lds + KS + c_ * P + dk0 * 2) = (u32x2){pk2(ks4[0], ks4[1]), pk2(ks4[2], ks4[3])};
                *(LAS u32x2*)(lds + KD + c_ * P + dk0 * 2) = (u32x2){pk2(kd4[0], kd4[1]), pk2(kd4[2], kd4[3])};
            }
            if (fr == 0 && (wid & 1) == 0) *(LAS f32x4*)(lds + GTL + (16 * t1 + 4 * fq) * 4) = GT;
        }
        LDS_WAIT(); __syncthreads();
        if (n + 1 < SEQ / 64) GL_DMA(n + 1);
        {
            const int ct = wid >> 1;
#pragma unroll
            for (int si = 0; si < 2; ++si) {
                const int st = 2 * (wid & 1) + si; f32x4 D = (f32x4){0.f, 0.f, 0.f, 0.f};
                if (st <= ct) {
#pragma unroll
                    for (int ks = 0; ks < 2; ++ks) { const bf16x8 X = *(const LAS bf16x8*)(lds + KS + (16 * st + fr) * P + (32 * ks + 8 * fq) * 2), Y = *(const LAS bf16x8*)(lds + QS + (16 * ct + fr) * P + (32 * ks + 8 * fq) * 2); D = MFMA16(X, Y, D); }
#pragma unroll
                    for (int r = 0; r < 4; ++r) if (16 * st + 4 * fq + r > 16 * ct + fr) D[r] = 0.f;
                }
                *(LAS u32x2*)(lds + AM + (16 * ct + fr) * P + (16 * st + 4 * fq) * 2) = (u32x2){pk2(D[0], D[1]), pk2(D[2], D[3])};
            }
        }
        LDS_WAIT(); __builtin_amdgcn_s_barrier(); asm volatile("" ::: "memory");
        {
            const unsigned vb = VB0 + (n & 1) * 16384;
            bf16x8 X1[2], X2[2];
#pragma unroll
            for (int ks = 0; ks < 2; ++ks) { X1[ks] = *(const LAS bf16x8*)(lds + ST + (16 * wid + fr) * P + (32 * ks + 8 * fq) * 2);
                const LAS unsigned char* a = lds + vb + (32 * ks + 8 * fq + qp) * 256 + (16 * wid + 4 * pp) * 2; X2[ks] = cat44(vtr(a), vtr(a + 4 * 256)); }
#pragma unroll
            for (int ct = 0; ct < 4; ++ct) { f32x4 o = (f32x4){0.f, 0.f, 0.f, 0.f};
#pragma unroll
                for (int ks = 0; ks < 2; ++ks) { const bf16x8 Y1 = *(const LAS bf16x8*)(lds + QS + (16 * ct + fr) * P + (32 * ks + 8 * fq) * 2), Y2 = *(const LAS bf16x8*)(lds + AM + (16 * ct + fr) * P + (32 * ks + 8 * fq) * 2);
                    o = MFMA16(X1[ks], Y1, o); o = MFMA16(X2[ks], Y2, o); }
                *(LAS f32x4*)(lds + OO + (16 * ct + fr) * PO + (16 * wid + 4 * fq) * 4) = o;
                float ss = (o[0] * o[0] + o[1] * o[1]) + (o[2] * o[2] + o[3] * o[3]); ss += __shfl_xor(ss, 16); ss += __shfl_xor(ss, 32);
                if (fq == 0) *(LAS float*)(lds + SSQ + (16 * ct + fr) * 32 + wid * 4) = ss; }
#pragma unroll
            for (int tt = 0; tt < 4; ++tt) { const f32x4 dl = *(const LAS f32x4*)(lds + GTL + (16 * tt + 4 * fq) * 4);
#pragma unroll
                for (int r = 0; r < 4; ++r) accS[tt][r] *= __expf(dl[r]);
#pragma unroll
                for (int ks = 0; ks < 2; ++ks) { const LAS unsigned char* a = lds + KD + (32 * ks + 8 * fq + qp) * P + (16 * tt + 4 * pp) * 2; accS[tt] = MFMA16(cat44(vtr(a), vtr(a + 4 * P)), X2[ks], accS[tt]); }
                *(LAS u32x2*)(lds + ST + (16 * wid + fr) * P + (16 * tt + 4 * fq) * 2) = (u32x2){pk2(accS[tt][0], accS[tt][1]), pk2(accS[tt][2], accS[tt][3])}; }
        }
    }
    asm volatile("s_waitcnt vmcnt(0) lgkmcnt(0)" ::: "memory"); __syncthreads();
    GL_ROWPASS(SEQ / 64 - 1);
    __syncthreads();
#undef GL_DMA
#undef GL_ROWPASS
}

__device__ __forceinline__ int crow(int r, int hi) { return (r & 3) + 8 * (r >> 2) + 4 * hi; }
#define MFMA32(a, b, c) __builtin_amdgcn_mfma_f32_32x32x16_bf16(a, b, c, 0, 0, 0)
constexpr int AT_BUF = 32768, AT_WSF = 3 * 32768, AT_Q = 3 * 32768 + 2048;
constexpr float AT_THR = 8.f;

__device__ __forceinline__ void attn_unit(const Ctx& C, int b, int h, int cp, float lam) {
    const int lane = C.lane, r32 = lane & 31, hi = lane >> 5, wid = C.wid, p = wid >> 2, sub = wid & 3;
    const int NT = 2 * cp + 2, qch = 2 * cp + (sub >> 1), my_nt = qch + 1;
    const int row0 = b * SEQ + cp * 128;
    const int qpos = cp * 128 + sub * 32 + r32;
    const float sl2 = exp2f(-2.f * (float)(h + 1)) * LOG2E;
    LAS unsigned char* lds = C.lds;
    LAS float* wsf = (LAS float*)(lds + AT_WSF) + wid * 64;
    const char* kbase = (const char*)(C.PROJ + (size_t)(b * SEQ) * NPROJ + h * 128);
    const unsigned koff = (unsigned)((lane * NPROJ + C_DK + wid * 8) * 2);
    const unsigned voff = (unsigned)(((16 * (wid & 3) + (lane >> 2)) * NPROJ + C_DV + (wid >> 2) * 32 + (lane & 3) * 8) * 2);
#define AT_DMA(t, bufo) do { const char* _tb = kbase + (size_t)(t) * 64 * NPROJ * 2; \
        glds16<0>(_tb, koff, lds_addr(lds + (bufo) + wid * 1024)); glds16<0>(_tb, koff + 128u, lds_addr(lds + (bufo) + 8192 + wid * 1024)); \
        glds16<0>(_tb, voff, lds_addr(lds + (bufo) + 16384 + (wid >> 2) * 4096 + (wid & 3) * 1024)); glds16<0>(_tb, voff + 128u, lds_addr(lds + (bufo) + 16384 + ((wid >> 2) + 2) * 4096 + (wid & 3) * 1024)); } while (0)
    bf16x8 qr[4];
    { const bf16* qp = C.PROJ + (size_t)(row0 + sub * 32 + r32) * NPROJ + C_DQ + h * 128 + p * 64 + hi * 8;
#pragma unroll
      for (int d0 = 0; d0 < 4; ++d0) qr[d0] = *(const bf16x8*)(qp + d0 * 16); }
    AT_DMA(0, 0); AT_DMA(1, AT_BUF);
    f32x16 o[4];
#pragma unroll
    for (int d0 = 0; d0 < 4; ++d0)
#pragma unroll
        for (int i = 0; i < 16; ++i) o[d0][i] = 0.f;
    float mhat = 0.f, lsum = 0.f;
    const unsigned kofs = (unsigned)(p * 8192 + hi * 1024 + r32 * 16);
    const unsigned vofs = (unsigned)(16384 + ((lane >> 4) & 1) * 32 + (lane & 3) * 8 + (4 * hi + ((lane & 15) >> 2)) * 64);
    asm volatile("s_waitcnt vmcnt(4)" ::: "memory"); __syncthreads();
    unsigned bufo = 0, bufn1 = AT_BUF, bufn2 = 2 * AT_BUF;
#pragma unroll 1
    for (int t = 0; t < NT; ++t) {
        PSTAMP(lds, 0);
        if (t + 2 < NT) AT_DMA(t + 2, bufn2);
        PSTAMP(lds, 1);
        if (t < my_nt) {
            const LAS unsigned char* kp = lds + bufo + kofs;
            const LAS unsigned char* vp = lds + bufo + vofs;
            bf16x8 kf[8];
#pragma unroll
            for (int d0 = 0; d0 < 4; ++d0) { kf[2 * d0] = *(const LAS bf16x8*)(kp + d0 * 2048); kf[2 * d0 + 1] = *(const LAS bf16x8*)(kp + d0 * 2048 + 512); }
            s16x4 va[8], vb[8];
#define AT_VRD(dst, k) do { _Pragma("unroll") for (int d0 = 0; d0 < 4; ++d0) { dst[2 * d0] = vtr(vp + d0 * 4096 + (k) * 1024); dst[2 * d0 + 1] = vtr(vp + d0 * 4096 + (k) * 1024 + 512); } } while (0)
#define AT_PV(src_, k) do { const bf16x8 pa_ = __builtin_bit_cast(bf16x8, pw[k]); _Pragma("unroll") for (int d0 = 0; d0 < 4; ++d0) o[d0] = MFMA32(pa_, cat44(src_[2 * d0], src_[2 * d0 + 1]), o[d0]); } while (0)
            AT_VRD(va, 0);
            __builtin_amdgcn_sched_barrier(0);
            f32x16 s0, s1;
            if (t == qch) {
#pragma unroll
                for (int i = 0; i < 16; ++i) { const int k0p = 64 * t + crow(i, hi), k1p = k0p + 32;
                    s0[i] = fmaf(sl2, (float)min(k0p, 2 * qpos - k0p), -mhat); s1[i] = fmaf(sl2, (float)min(k1p, 2 * qpos - k1p), -mhat); }
            } else {
                const float bsm = sl2 * (float)(64 * t + 4 * hi) - mhat;
#pragma unroll
                for (int i = 0; i < 16; ++i) { const float ci = (float)((i & 3) + 8 * (i >> 2)); s0[i] = fmaf(sl2, ci, bsm); s1[i] = fmaf(sl2, ci + 32.f, bsm); }
            }
#pragma unroll
            for (int d0 = 0; d0 < 4; ++d0) { s0 = MFMA32(kf[2 * d0], qr[d0], s0); s1 = MFMA32(kf[2 * d0 + 1], qr[d0], s1); }
            __builtin_amdgcn_sched_barrier(0);
            float rm = fmaxf(s0[0], s1[0]);
#pragma unroll
            for (int i = 1; i < 16; ++i) rm = fmaxf(rm, fmaxf(s0[i], s1[i]));
            { auto rr = __builtin_amdgcn_permlane32_swap(__float_as_uint(rm), __float_as_uint(rm), false, false); rm = fmaxf(__uint_as_float(rr[0]), __uint_as_float(rr[1])); }
            if (t == 0 || __any(rm > AT_THR)) {
                const float dl = (t == 0) ? rm : fmaxf(rm, 0.f); mhat += dl;
                if (t != 0) {
                    const float f = __builtin_amdgcn_exp2f(-dl); lsum *= f;
                    if (hi == 0) wsf[r32] = f;
                    LDS_WAIT();
#pragma unroll
                    for (int i = 0; i < 16; ++i) { const float fi = wsf[crow(i, hi)];
#pragma unroll
                        for (int d0 = 0; d0 < 4; ++d0) o[d0][i] *= fi; }
                }
#pragma unroll
                for (int i = 0; i < 16; ++i) { s0[i] -= dl; s1[i] -= dl; }
            }
            float ps = 0.f;
#pragma unroll
            for (int i = 0; i < 16; ++i) { s0[i] = __builtin_amdgcn_exp2f(s0[i]); s1[i] = __builtin_amdgcn_exp2f(s1[i]); ps += s0[i] + s1[i]; }
            lsum += ps;
            PSTAMP(lds, 2);
            u32x4 pw[4];
            pw[0] = (u32x4){pk2(s0[0], s0[1]), pk2(s0[2], s0[3]), pk2(s0[4], s0[5]), pk2(s0[6], s0[7])};
            pw[1] = (u32x4){pk2(s0[8], s0[9]), pk2(s0[10], s0[11]), pk2(s0[12], s0[13]), pk2(s0[14], s0[15])};
            pw[2] = (u32x4){pk2(s1[0], s1[1]), pk2(s1[2], s1[3]), pk2(s1[4], s1[5]), pk2(s1[6], s1[7])};
            pw[3] = (u32x4){pk2(s1[8], s1[9]), pk2(s1[10], s1[11]), pk2(s1[12], s1[13]), pk2(s1[14], s1[15])};
            __builtin_amdgcn_sched_barrier(0);
            AT_VRD(vb, 1); AT_PV(va, 0); __builtin_amdgcn_sched_barrier(0);
            AT_VRD(va, 2); AT_PV(vb, 1); __builtin_amdgcn_sched_barrier(0);
            AT_VRD(vb, 3); AT_PV(va, 2); __builtin_amdgcn_sched_barrier(0);
            AT_PV(vb, 3);
#undef AT_VRD
#undef AT_PV
        }
        PSTAMP(lds, 3);
        if (t + 2 < NT) asm volatile("s_waitcnt vmcnt(4) lgkmcnt(0)" ::: "memory"); else asm volatile("s_waitcnt vmcnt(0) lgkmcnt(0)" ::: "memory");
        PSTAMP(lds, 4);
        __builtin_amdgcn_s_barrier(); asm volatile("" ::: "memory");
        PSTAMP(lds, 5);
        { const unsigned tb = bufo; bufo = bufn1; bufn1 = bufn2; bufn2 = tb; }
    }
#undef AT_DMA
    lsum += __shfl_xor(lsum, 32);
    if (hi == 0) wsf[32 + r32] = lsum;
    LDS_WAIT();
    LAS float* X = (LAS float*)lds;
    if (p == 1) {
#pragma unroll
        for (int i = 0; i < 16; ++i) { const float sc = lam / wsf[32 + crow(i, hi)];
#pragma unroll
            for (int d0 = 0; d0 < 4; ++d0) X[(sub * 32 + crow(i, hi)) * 128 + d0 * 32 + r32] = o[d0][i] * sc; }
    }
    __syncthreads();
    if (p == 0) {
#pragma unroll
        for (int i = 0; i < 16; ++i) { const float sc = 1.f / wsf[32 + crow(i, hi)];
#pragma unroll
            for (int d0 = 0; d0 < 4; ++d0) { LAS float* xp = X + (sub * 32 + crow(i, hi)) * 128 + d0 * 32 + r32; *xp = o[d0][i] * sc - *xp; } }
    }
    __syncthreads();
    { const float g0 = C.diff_g[2 * lane], g1 = C.diff_g[2 * lane + 1];
#pragma unroll 4
      for (int qq = 0; qq < 16; ++qq) { const int q = wid * 16 + qq; const float y0 = X[q * 128 + 2 * lane], y1 = X[q * 128 + 2 * lane + 1];
          const float rstd = rsqrtf(wave_sum(y0 * y0 + y1 * y1) * (1.f / 128.f) + EPS) * 0.8f;
          *(unsigned*)(C.OA + (size_t)(row0 + q) * 1024 + h * 128 + 2 * lane) = pk2(y0 * rstd * g0, y1 * rstd * g1); } }
    __syncthreads();
}

__device__ __forceinline__ void attn_phase(const Ctx& C) {
    LAS float* lamp = (LAS float*)(C.lds + AT_Q) + 4;
    LAS int* qw = (LAS int*)(C.lds + AT_Q);
    if (C.tid < 64) {
        const float a = wave_sum(C.lq1[C.lane] * C.lk1[C.lane]), b2 = wave_sum(C.lq2[C.lane] * C.lk2[C.lane]);
        if (C.tid == 0) lamp[0] = __expf(a) - __expf(b2) + 0.2f;
    }
    __syncthreads();
    const float lam = lamp[0];
    for (;;) {
        if (C.tid == 0) qw[0] = (int)__hip_atomic_fetch_add(C.ctl + CW_QUEUE, 1u, RLX_AGENT);
        __syncthreads();
        const int item = __builtin_amdgcn_readfirstlane(qw[0]);
        __syncthreads();
        if (item >= 1024) break;
        const int bh = item & 63, cp = 15 - (item >> 6);
        attn_unit(C, bh >> 2, bh & 3, cp, lam);
    }
}

__device__ __forceinline__ void phase_router(const Ctx& C) {
    const int lane = C.lane, wid = C.wid, fr = lane & 15, fq = lane >> 4;
    LAS u32x4* WH = (LAS u32x4*)C.lds;
    LAS u32x4* WL = WH + 4096;
    LAS float* GS = (LAS float*)(C.lds + 131072);
    LAS float* SH = GS + 1024;
    LAS float* red = SH + 1024;
    LAS float* ssw = red + 8 * 16 * 32;
    LAS float* rs = ssw + 128;
    LAS int* lcnt = (LAS int*)(rs + 16);
    LAS int* lbase = lcnt + 32;
    LAS int* pend = lbase + 32;
    LAS float* cbl = (LAS float*)(pend + 512);
    for (int blk = C.bid; blk < NTOK / 128; blk += C.G) {
        const int b = blk >> 4; const float* md = C.mod + b * 6144;
        __syncthreads();
        for (int k = C.tid; k < DM; k += NTHREADS) { GS[k] = C.norm2_g[k] * (1.f + md[4096 + k]); SH[k] = md[3072 + k]; }
        if (C.tid < 32) lcnt[C.tid] = 0;
        pend[C.tid] = -1;
#pragma unroll 4
        for (int idx = C.tid; idx < 4096; idx += NTHREADS) { WH[idx] = C.wrf[idx]; WL[idx] = C.wrf[4096 + idx]; }
        __syncthreads();
        {
            const int e = C.tid & 31, part = C.tid >> 5; float s = 0.f;
#pragma unroll 8
            for (int k = part * 64; k < part * 64 + 64; ++k) s += SH[k] * C.w_router[k * NE + e];
            red[part * 32 + e] = s;
            __syncthreads();
            if (C.tid < 32) { float t = C.b_router[C.tid];
#pragma unroll
                for (int p2 = 0; p2 < 16; ++p2) t += red[p2 * 32 + C.tid];
                cbl[C.tid] = t; }
            __syncthreads();
        }
        float x1[4][8];
#define RT_LOAD(dst, row) do { _Pragma("unroll") for (int ks = 0; ks < 4; ++ks) { const size_t o_ = (size_t)(row) * DM + 128 * wid + 32 * ks + 8 * fq; \
            const f32x4 xa = *(const f32x4*)(C.x + o_), xb = *(const f32x4*)(C.x + o_ + 4); const u32x4 yw = *(const u32x4*)(C.Y1 + o_); \
            dst[ks][0] = xa[0] + bflo(yw.x); dst[ks][1] = xa[1] + bfhi(yw.x); dst[ks][2] = xa[2] + bflo(yw.y); dst[ks][3] = xa[3] + bfhi(yw.y); \
            dst[ks][4] = xb[0] + bflo(yw.z); dst[ks][5] = xb[1] + bfhi(yw.z); dst[ks][6] = xb[2] + bflo(yw.w); dst[ks][7] = xb[3] + bfhi(yw.w); } } while (0)
        RT_LOAD(x1, blk * 128 + fr);
#pragma unroll 1
        for (int it = 0; it < 8; ++it) {
            const int row0 = blk * 128 + it * 16;
            f32x4 acc0 = (f32x4){0.f, 0.f, 0.f, 0.f}, acc1 = acc0; float ss = 0.f;
#pragma unroll
            for (int ks = 0; ks < 4; ++ks) {
                const f32x4 ga = *(const LAS f32x4*)(GS + 128 * wid + 32 * ks + 8 * fq), gb = *(const LAS f32x4*)(GS + 128 * wid + 32 * ks + 8 * fq + 4);
                float av[8];
#pragma unroll
                for (int j = 0; j < 8; ++j) { const float xv = x1[ks][j]; ss += xv * xv; av[j] = xv * (j < 4 ? ga[j] : gb[j - 4]); }
                bf16x8 ah, al; split_bf16(av, ah, al);
                const int fi = ((wid * 4 + ks) * 2) * 64 + lane;
                const bf16x8 wh0 = __builtin_bit_cast(bf16x8, WH[fi]), wh1 = __builtin_bit_cast(bf16x8, WH[fi + 64]), wl0 = __builtin_bit_cast(bf16x8, WL[fi]), wl1 = __builtin_bit_cast(bf16x8, WL[fi + 64]);
                acc0 = MFMA16(ah, wh0, acc0); acc0 = MFMA16(al, wh0, acc0); acc0 = MFMA16(ah, wl0, acc0);
                acc1 = MFMA16(ah, wh1, acc1); acc1 = MFMA16(al, wh1, acc1); acc1 = MFMA16(ah, wl1, acc1);
            }
            ss += __shfl_xor(ss, 16); ss += __shfl_xor(ss, 32);
            if (fq == 0) ssw[wid * 16 + fr] = ss;
#pragma unroll
            for (int r = 0; r < 4; ++r) { red[(wid * 16 + 4 * fq + r) * 32 + fr] = acc0[r]; red[(wid * 16 + 4 * fq + r) * 32 + 16 + fr] = acc1[r]; }
            LDS_WAIT(); __syncthreads();
            float xn[4][8];
            if (it < 7) RT_LOAD(xn, row0 + 16 + fr);
            {
                const int r = 2 * wid + (lane >> 5), e = lane & 31; float sum = 0.f, sq = 0.f;
#pragma unroll
                for (int w2 = 0; w2 < 8; ++w2) { sum += red[(w2 * 16 + r) * 32 + e]; sq += ssw[w2 * 16 + r]; }
                const float rstd = rsqrtf(sq * (1.f / DM) + EPS);
                if (e == 0) rs[r] = rstd;
                float val = rstd * sum + cbl[e];
                float tv[4]; int ti[4];
#pragma unroll
                for (int k = 0; k < 4; ++k) {
                    float bv = val; int bi = e;
#pragma unroll
                    for (int o = 16; o >= 1; o >>= 1) { const float ov = __shfl_xor(bv, o); const int oi = __shfl_xor(bi, o); if (ov > bv || (ov == bv && oi < bi)) { bv = ov; bi = oi; } }
                    tv[k] = bv; ti[k] = bi; if (e == bi) val = -3.0e38f;
                }
                const float e1 = __expf(tv[1] - tv[0]), e2 = __expf(tv[2] - tv[0]), e3 = __expf(tv[3] - tv[0]); const float inv = 1.f / (1.f + e1 + e2 + e3);
                const int row = row0 + r;
                if (e == 0) { *(f32x4*)(C.topw + (size_t)row * 4) = (f32x4){inv, e1 * inv, e2 * inv, e3 * inv}; *(i32x4*)(C.tope + (size_t)row * 4) = (i32x4){ti[0], ti[1], ti[2], ti[3]}; }
                if (e < 4) { const int ex = e == 0 ? ti[0] : (e == 1 ? ti[1] : (e == 2 ? ti[2] : ti[3]));
                    const int slot = atomicAdd((int*)(lcnt + ex), 1); pend[(it * 16 + r) * 4 + e] = (ex << 16) | slot; }
            }
            LDS_WAIT(); __syncthreads();
            {
                const float rstd = rs[fr];
#pragma unroll
                for (int ks = 0; ks < 4; ++ks) { const int k0 = 128 * wid + 32 * ks + 8 * fq;
                    const f32x4 ga = *(const LAS f32x4*)(GS + k0), gb = *(const LAS f32x4*)(GS + k0 + 4), sa = *(const LAS f32x4*)(SH + k0), sb = *(const LAS f32x4*)(SH + k0 + 4);
                    float hv[8];
#pragma unroll
                    for (int j = 0; j < 8; ++j) hv[j] = __builtin_amdgcn_fmed3f((x1[ks][j] * rstd * (j < 4 ? ga[j] : gb[j - 4]) + (j < 4 ? sa[j] : sb[j - 4])) * F8_ASCALE, -440.f, 440.f);
                    *(u32x2*)((unsigned char*)C.H2 + (size_t)(row0 + fr) * DM + k0) = (u32x2){pk4_fp8(hv[0], hv[1], hv[2], hv[3]), pk4_fp8(hv[4], hv[5], hv[6], hv[7])}; }
            }
            if (it < 7) {
#pragma unroll
                for (int ks = 0; ks < 4; ++ks)
#pragma unroll
                    for (int j = 0; j < 8; ++j) x1[ks][j] = xn[ks][j]; }
        }
#undef RT_LOAD
        __syncthreads();
        if (C.tid < 32) lbase[C.tid] = (int)__hip_atomic_fetch_add(C.ctl + CW_CNT + 64 * C.tid, (unsigned)lcnt[C.tid], RLX_AGENT);
        __syncthreads();
        { const int pv = pend[C.tid]; if (pv >= 0) { const int e = pv >> 16, slot = pv & 0xffff; C.list[e * NTOK + lbase[e] + slot] = (blk * 128 + (C.tid >> 2)) * 4 + (C.tid & 3); } }
    }
}

__device__ __forceinline__ void phase_final(const Ctx& C) {
    const int gw = C.bid * NWAVES + C.wid, NGW = C.G * NWAVES;
    for (int row = gw; row < NTOK; row += NGW) {
        const int b = row >> 11; const float* gt2 = C.mod + b * 6144 + 5120;
        const f32x4 w = *(const f32x4*)(C.topw + (size_t)row * 4);
        f32x4 v[4]; float ss = 0.f;
#pragma unroll
        for (int j = 0; j < 4; ++j) { const int c0 = 4 * C.lane + 256 * j;
            f32x4 y = (f32x4){0.f, 0.f, 0.f, 0.f};
#pragma unroll
            for (int k = 0; k < 4; ++k) { const int yw = *(const int*)((const unsigned char*)C.YB + (size_t)(row * 4 + k) * DM + c0);
                y = y + (f32x4){__builtin_amdgcn_cvt_f32_fp8(yw, 0), __builtin_amdgcn_cvt_f32_fp8(yw, 1), __builtin_amdgcn_cvt_f32_fp8(yw, 2), __builtin_amdgcn_cvt_f32_fp8(yw, 3)} * (w[k] * (1.f / F8_YSCALE)); }
            const u32x2 y1w = *(const u32x2*)(C.Y1 + (size_t)row * DM + c0);
            v[j] = *(const f32x4*)(C.x + (size_t)row * DM + c0) + (f32x4){bflo(y1w.x), bfhi(y1w.x), bflo(y1w.y), bfhi(y1w.y)} + *(const f32x4*)(gt2 + c0) * y;
            ss += (v[j][0] * v[j][0] + v[j][1] * v[j][1]) + (v[j][2] * v[j][2] + v[j][3] * v[j][3]); }
        const float rstd = rsqrtf(wave_sum(ss) * (1.f / DM) + EPS);
#pragma unroll
        for (int j = 0; j < 4; ++j) { const int c0 = 4 * C.lane + 256 * j; *(f32x4*)(C.out + (size_t)row * DM + c0) = v[j] * rstd * *(const f32x4*)(C.final_g + c0); }
    }
}

#ifndef PROBE_A
#define PROBE_A -1
#endif
#ifndef PROBE_B
#define PROBE_B -1
#endif
constexpr int CW_TS = 3072;
#define STAMP(k) do { if (PROBE_A >= 0 && blockIdx.x == 0 && threadIdx.x == 0) { const Ctx Cs = make_ctx(lds); ((unsigned long long*)(Cs.ctl + CW_TS))[k] = __builtin_amdgcn_s_memrealtime(); } } while (0)
struct Args { const float* in[25]; float* out; unsigned char* ws; };
typedef const Args __attribute__((address_space(4)))* KArgs;
__device__ __forceinline__ Ctx make_ctx(LAS unsigned char* lds) {
    KArgs a = (KArgs)__builtin_amdgcn_kernarg_segment_ptr();
    asm volatile("" : "+s"(a));
    Ctx C;
    C.lds = lds;
    C.tid = tid_fresh(); C.lane = C.tid & 63; C.wid = __builtin_amdgcn_readfirstlane(C.tid >> 6); C.G = gridDim.x; C.bid = blockIdx.x;
    C.x = a->in[0]; C.c = a->in[1]; C.w_ada = a->in[2]; C.b_ada = a->in[3]; C.norm1_g = a->in[4]; C.w_in = a->in[5];
    C.lq1 = a->in[6]; C.lk1 = a->in[7]; C.lq2 = a->in[8]; C.lk2 = a->in[9]; C.diff_g = a->in[10]; C.w_alpha_up = a->in[11]; C.b_alpha = a->in[12];
    C.gla_g = a->in[13]; C.w_bd = a->in[14]; C.w_bg = a->in[15]; C.w_out = a->in[16]; C.norm2_g = a->in[17]; C.w_router = a->in[18]; C.b_router = a->in[19];
    C.w_gu = a->in[20]; C.b_gu = a->in[21]; C.w_dn = a->in[22]; C.b_dn = a->in[23]; C.final_g = a->in[24];
    C.out = a->out;
    unsigned char* ws = a->ws;
    C.ctl = (unsigned*)(ws + WS_CTL); C.mod = (float*)(ws + WS_MOD); C.tope = (int*)(ws + WS_TOPE); C.topw = (float*)(ws + WS_TOPW); C.list = (int*)(ws + WS_LIST);
    C.WinT = (bf16*)(ws + WS_WIN); C.WbdT = (bf16*)(ws + WS_WBD); C.WbgT = (bf16*)(ws + WS_WBG); C.WoutT = (bf16*)(ws + WS_WOUT); C.WguT = (bf16*)(ws + WS_WGU); C.WdT = (bf16*)(ws + WS_WD);
    C.H = (bf16*)(ws + WS_H); C.H2 = (bf16*)(ws + WS_H2); C.OA = (bf16*)(ws + WS_OA); C.OB = (bf16*)(ws + WS_OB); C.MG = (bf16*)(ws + WS_MG); C.YB = (bf16*)(ws + WS_YB);
    C.PROJ = (bf16*)(ws + WS_PROJ); C.ACT = (bf16*)(ws + WS_ACT); C.Y1 = (bf16*)(ws + WS_Y1); C.cb = (float*)(ws + WS_CB); C.wrf = (u32x4*)(ws + WS_WRF);
    return C;
}
__global__ void __launch_bounds__(NTHREADS, 2) fwd_kernel(Args args) {
    extern __shared__ __attribute__((aligned(16))) unsigned char lds_raw[];
    LAS unsigned char* lds = (LAS unsigned char*)lds_raw;
    for (int u = threadIdx.x; u < (LDS_BYTES - LDSCTL_OFF) / 4; u += NTHREADS) ((LAS unsigned*)(lds + LDSCTL_OFF))[u] = 0u;
    __syncthreads();
    volatile LAS unsigned* MISC = (volatile LAS unsigned*)(lds + MISC_OFF);
    XcdBarrier bar;
    { const Ctx C = make_ctx(lds); bar = xcd_barrier_post(C.ctl + CW_BAR, MISC + 8); }
#define GRID_BAR() xcd_barrier(bar)
    STAMP(0);
#if PROBE_A >= 100
    if (blockIdx.x == 0 && threadIdx.x == 0) ((volatile LAS unsigned*)(lds + MISC_OFF))[15] = (unsigned)__builtin_amdgcn_s_memrealtime();
#endif

    { const Ctx C = make_ctx(lds); phase_mod(C); }
    GRID_BAR(); STAMP(1);
    { const Ctx C = make_ctx(lds); phase_prep(C); }
    GRID_BAR(); STAMP(2);
    { const Ctx C = make_ctx(lds); DenseDesc g{C.H, DM, C.WinT, DM}; TileOrder S; S.init(NTOK / 256, NPROJ / 256, C.G, C.bid); EpiProj E{C.PROJ, C.b_alpha}; gemm_phase<DenseDesc, TileOrder, EpiProj, true, false, 1>(C.lds, g, S, E); }
    GRID_BAR(); STAMP(3);
    { const Ctx C = make_ctx(lds); for (int s = C.bid; s < 64; s += C.G) gla_chunked(C, s >> 2, s & 3); }
    __syncthreads(); STAMP(12);
    { const Ctx C = make_ctx(lds); attn_phase(C); }
    GRID_BAR(); STAMP(4);
    { const Ctx C = make_ctx(lds); DenseDesc g{C.OA, DM, C.WbdT, DM}; TileOrder S; S.init(NTOK / 256, DM / 256, C.G, C.bid); EpiBranch E{C.MG, C.PROJ}; gemm_phase<DenseDesc, TileOrder, EpiBranch, true>(C.lds, g, S, E); }
    GRID_BAR(); STAMP(5);
    STAMP(6);
    { const Ctx C = make_ctx(lds); DenseDesc g{C.MG, DM, C.WoutT, DM}; TileOrder S; S.init(NTOK / 256, DM / 256, C.G, C.bid); EpiOut E{C.Y1, C.mod}; gemm_phase<DenseDesc, TileOrder, EpiOut, true>(C.lds, g, S, E); }
    GRID_BAR(); STAMP(7);
    { const Ctx C = make_ctx(lds); phase_router(C); }
    GRID_BAR(); STAMP(8);
    LAS int* tab = (LAS int*)(lds + STAGE_BYTES);
    __syncthreads();
    if (threadIdx.x == 0) { const Ctx C = make_ctx(lds); int ts = 0; for (int e = 0; e < NE; ++e) { const int cnt = (int)__hip_atomic_load(C.ctl + CW_CNT + 64 * e, RLX_AGENT); tab[e] = cnt; tab[32 + e] = ts; ts += (cnt + 255) >> 8; } tab[64] = ts; }
    __syncthreads();
    for (int tr = threadIdx.x; tr < tab[64]; tr += NTHREADS) { int e = 0; for (int k = 1; k < NE; ++k) if (tab[32 + k] <= tr) e = k; tab[65 + tr] = e; }
    __syncthreads();
    { const Ctx C = make_ctx(lds); const int T = tab[64]; MoeUpDesc g{(const unsigned char*)C.H2, C.list, (const unsigned char*)C.WguT, DM}; MoeOrder S; S.t.init(T, 8, C.G, C.bid, 4); S.tab = tab; EpiUp E{(unsigned char*)C.ACT, C.b_gu}; gemm_phase<MoeUpDesc, MoeOrder, EpiUp, true, true, 4>(C.lds, g, S, E); }
    GRID_BAR(); STAMP(9);
    { const Ctx C = make_ctx(lds); const int T = tab[64]; MoeDownDesc g{(const unsigned char*)C.ACT, (const unsigned char*)C.WdT, FF}; MoeOrder S; S.t.init(T, 4, C.G, C.bid); S.tab = tab; EpiDown E{(unsigned char*)C.YB, C.b_dn, C.list}; gemm_phase<MoeDownDesc, MoeOrder, EpiDown, true, true, 5>(C.lds, g, S, E); }
    GRID_BAR(); STAMP(10);
    { const Ctx C = make_ctx(lds); phase_final(C); }
#if PROBE_A >= 0
    GRID_BAR(); STAMP(11);
    if (blockIdx.x == 0 && threadIdx.x == 0) {
        const Ctx C = make_ctx(lds); const unsigned long long* ts = (const unsigned long long*)(C.ctl + CW_TS);
        asm volatile("s_waitcnt vmcnt(0)" ::: "memory");
        const unsigned long long dt = (PROBE_A >= 100) ? (unsigned long long)((volatile LAS unsigned*)(lds + MISC_OFF))[16 + (PROBE_A >= 100 ? PROBE_A - 100 : 0)] : ((PROBE_A == 12) ? ts[12] - ts[3] : ts[(PROBE_A < 12 ? PROBE_A : 0) + 1] - ts[PROBE_A < 12 ? PROBE_A : 0]), t0 = __builtin_amdgcn_s_memrealtime();
        while (__builtin_amdgcn_s_memrealtime() - t0 < 4ull * dt) __builtin_amdgcn_s_sleep(8);
    }
#endif
}

extern "C" void kernel_launch(void* const* d_in, const int* in_sizes, int n_in, void* d_out, int out_size, void* d_ws, size_t ws_size, hipStream_t stream) {
    static int grid = 0;
    if (grid == 0) {
        if (n_in != 25 || in_sizes[0] != NTOK * DM || out_size != NTOK * DM || ws_size < WS_END) {
            fprintf(stderr, "kernel_launch: unexpected shapes (n_in %d, in0 %d, out %d, ws %zu < %zu)\n", n_in, n_in > 0 ? in_sizes[0] : -1, out_size, ws_size, (size_t)WS_END); grid = -1; return; }
        int dev = 0, cus = 0;
        if (hipGetDevice(&dev) != hipSuccess || hipDeviceGetAttribute(&cus, hipDeviceAttributeMultiprocessorCount, dev) != hipSuccess) { grid = -1; return; }
        if (hipFuncSetAttribute((const void*)fwd_kernel, hipFuncAttributeMaxDynamicSharedMemorySize, LDS_BYTES) != hipSuccess) { fprintf(stderr, "kernel_launch: hipFuncSetAttribute failed\n"); grid = -1; return; }
        (void)hipGetLastError();
        grid = cus;
    }
    if (grid < 0) return;
    if (hipMemsetAsync((char*)d_ws + WS_CTL, 0, CTL_ZERO_BYTES, stream) != hipSuccess) { fprintf(stderr, "kernel_launch: memset failed\n"); return; }
    Args a{};
    for (int i = 0; i < 25; ++i) a.in[i] = (const float*)d_in[i];
    a.out = (float*)d_out; a.ws = (unsigned char*)d_ws;
    hipLaunchKernelGGL(fwd_kernel, dim3(grid), dim3(NTHREADS), LDS_BYTES, stream, a);
}
```

```cpp
#include <hip/hip_runtime.h>
#include <cstdio>
#include <cstdint>

#define GAS __attribute__((address_space(1)))
#define LAS __attribute__((address_space(3)))
typedef unsigned short bf16;
typedef short bf16x8 __attribute__((ext_vector_type(8)));
typedef float f32x4 __attribute__((ext_vector_type(4)));
typedef unsigned u32x4 __attribute__((ext_vector_type(4)));
typedef unsigned u32x2 __attribute__((ext_vector_type(2)));
typedef int i32x4 __attribute__((ext_vector_type(4)));
typedef GAS unsigned gu32;

constexpr int NB = 16, SEQ = 2048, DM = 1024, NTOK = NB * SEQ, NE = 32, FF = 1024;
constexpr int NPROJ = 5376;
constexpr int C_DQ = 0, C_DK = 512, C_DV = 1024, C_GQ = 1536, C_GK = 1792, C_GV = 2048, C_GR = 2560, C_GA = 3072, C_GB = 4096, C_AL = 5120;
constexpr int W_IN_N = 5136;
constexpr float LOG2E = 1.4426950408889634f;
constexpr float QSCALE = 0.125f * LOG2E;
constexpr float EPS = 1e-6f;
constexpr int NWAVES = 8, NTHREADS = 512;

constexpr size_t MiB = 1u << 20;
constexpr size_t WS_CTL = 0, CTL_ZERO_BYTES = 1 * MiB;
constexpr size_t WS_MOD = 1 * MiB;
constexpr size_t WS_TOPE = 2 * MiB;
constexpr size_t WS_TOPW = 3 * MiB;
constexpr size_t WS_LIST = 4 * MiB;
constexpr size_t WS_WIN = 8 * MiB;
constexpr size_t WS_WBD = 19 * MiB;
constexpr size_t WS_WBG = 20 * MiB;
constexpr size_t WS_WOUT = 21 * MiB;
constexpr size_t WS_WGU = 24 * MiB;
constexpr size_t WS_WD = 152 * MiB;
constexpr size_t WS_H2 = 216 * MiB;
constexpr size_t WS_RB = 280 * MiB;
constexpr size_t WS_H = WS_RB, WS_OA = WS_RB + 64 * MiB, WS_OB = WS_RB + 96 * MiB, WS_MG = WS_RB + 128 * MiB, WS_YB = WS_RB;
constexpr size_t WS_RA = 536 * MiB;
constexpr size_t WS_PROJ = WS_RA, WS_ACT = WS_RA;
constexpr size_t WS_Y1 = WS_RA + 272 * MiB;
constexpr size_t WS_CB = WS_MOD + 512 * 1024;
constexpr size_t WS_WRF = WS_MOD + 768 * 1024;
constexpr size_t WS_END = 872 * MiB;
constexpr int MAX_TILES = 544;
static_assert((size_t)MAX_TILES * 256 * 1024 * 2 <= 336 * MiB, "act fits region A");
constexpr int CW_CNT = 64;
constexpr int CW_BAR = 4096;
constexpr int CW_QUEUE = 2304;

constexpr int SCR_BYTES = 159744;
constexpr int LDSCTL_OFF = SCR_BYTES, MISC_OFF = LDSCTL_OFF + 320;
constexpr int LDS_BYTES = SCR_BYTES + 1024;

#define RLX_AGENT __ATOMIC_RELAXED, __HIP_MEMORY_SCOPE_AGENT
#define LDS_WAIT() asm volatile("s_waitcnt lgkmcnt(0)" ::: "memory")

__device__ __forceinline__ unsigned f2bf(float f) { unsigned u = __builtin_bit_cast(unsigned, f); return (u + 0x7fffu + ((u >> 16) & 1u)) >> 16; }
typedef __bf16 bf16n2 __attribute__((ext_vector_type(2)));
typedef float f32x2 __attribute__((ext_vector_type(2)));
__device__ __forceinline__ unsigned pk2(float lo, float hi) { return __builtin_bit_cast(unsigned, __builtin_convertvector((f32x2){lo, hi}, bf16n2)); }
__device__ __forceinline__ unsigned pk4_fp8(float a, float b, float c, float d) { int w = 0; w = __builtin_amdgcn_cvt_pk_fp8_f32(a, b, w, false); w = __builtin_amdgcn_cvt_pk_fp8_f32(c, d, w, true); return (unsigned)w; }
constexpr float F8_ASCALE = 4.f, F8_WSCALE = 512.f;
constexpr int F8_SA = 0x7d7d7d7d, F8_SW = 0x76767676;
__device__ __forceinline__ float bf2f(unsigned b) { return __uint_as_float(b << 16); }
__device__ __forceinline__ float bflo(unsigned w) { return __uint_as_float(w << 16); }
__device__ __forceinline__ float bfhi(unsigned w) { return __uint_as_float(w & 0xffff0000u); }
__device__ __forceinline__ float wave_sum(float v) {
#pragma unroll
    for (int o = 1; o < 64; o <<= 1) v += __shfl_xor(v, o);
    return v;
}
__device__ __forceinline__ int tid_fresh() { int t = threadIdx.x; asm volatile("" : "+v"(t)); return t; }
__device__ __forceinline__ float sigmoidf_(float x) { return 1.f / (1.f + __expf(-x)); }

#define XB_TMO      128
#define XB_XCNT(j)  (256  + 64 * (j))
#define XB_XSUB(j)  (1280 + 64 * (j))
#define XB_XGEN(j)  (2304 + 64 * (j))
#define XB_TOP      3328
#define XB_TOPGEN   3392
#define XCD_BAR_WORDS 3456
#define XB_SPIN_CAP (1u << 22)
__device__ __forceinline__ unsigned xb_ld(unsigned* p)              { return __hip_atomic_load(p, __ATOMIC_RELAXED, __HIP_MEMORY_SCOPE_AGENT); }
__device__ __forceinline__ unsigned xb_add(unsigned* p, unsigned v) { return __hip_atomic_fetch_add(p, v, __ATOMIC_RELAXED, __HIP_MEMORY_SCOPE_AGENT); }
__device__ __forceinline__ unsigned xb_xcc_id() { return (unsigned)__builtin_amdgcn_s_getreg((3 << 11) | 20) & 0xFu; }
#define XB_SPIN(cond, bar) do { unsigned _sp = 0; while (cond) { __builtin_amdgcn_s_sleep(1); \
    if ((++_sp & 255u) == 0u) { if (xb_ld(&(bar)[XB_TMO])) break; if (_sp > XB_SPIN_CAP) { atomicAdd(&(bar)[XB_TMO], 1u); break; } } } } while (0)
struct XcdBarrier { unsigned* bar; unsigned x; volatile LAS unsigned* st; };
__device__ __forceinline__ XcdBarrier xcd_barrier_post(unsigned* bar, volatile LAS unsigned* st) {
    XcdBarrier b; b.bar = bar; b.x = xb_xcc_id(); b.st = st;
    if (threadIdx.x == 0) (void)xb_add(&bar[XB_XCNT(b.x)], 1u);
    return b;
}
__device__ __forceinline__ void xcd_barrier_complete(unsigned* bar, unsigned x, unsigned& nloc, unsigned& nx) {
    const unsigned G = gridDim.x * gridDim.y * gridDim.z;
    unsigned sum, cnt, mine, sp = 0u;
    for (;;) {
        sum = 0u; cnt = 0u; mine = 0u;
#pragma unroll
        for (unsigned j = 0; j < 16; ++j) { const unsigned c = xb_ld(&bar[XB_XCNT(j)]); sum += c; cnt += (c > 0u) ? 1u : 0u; mine = (j == x) ? c : mine; }
        if (sum == G) break;
        __builtin_amdgcn_s_sleep(1);
        if ((++sp & 255u) == 0u) { if (xb_ld(&bar[XB_TMO])) break; if (sp > XB_SPIN_CAP) { atomicAdd(&bar[XB_TMO], 1u); break; } }
    }
    nloc = mine > 0u ? mine : 1u; nx = cnt > 0u ? cnt : 1u;
}
__device__ __forceinline__ void xcd_barrier(const XcdBarrier& b) {
    asm volatile("s_waitcnt vmcnt(0)" ::: "memory");
    __syncthreads();
    if (threadIdx.x == 0) {
        unsigned* bar = b.bar;
        __builtin_amdgcn_s_waitcnt(0);
        unsigned nloc = b.st[0], nx = b.st[1];
        if (nloc == 0u) { xcd_barrier_complete(bar, b.x, nloc, nx); b.st[0] = nloc; b.st[1] = nx; }
        const unsigned old = xb_add(&bar[XB_XSUB(b.x)], 1u);
        const unsigned gen = old / nloc;
        if (old + 1u == (gen + 1u) * nloc) {
            __builtin_amdgcn_fence(__ATOMIC_RELEASE, "agent");
            asm volatile("s_waitcnt vmcnt(0)" ::: "memory");
            const unsigned og = xb_add(&bar[XB_TOP], 1u);
            const unsigned tg = og / nx;
            if (og + 1u == (tg + 1u) * nx) xb_add(&bar[XB_TOPGEN], 1u);
            else XB_SPIN(xb_ld(&bar[XB_TOPGEN]) == tg, bar);
            __builtin_amdgcn_fence(__ATOMIC_ACQUIRE, "agent");
            xb_add(&bar[XB_XGEN(b.x)], 1u);
            asm volatile("s_waitcnt vmcnt(0)" ::: "memory");
        } else {
            XB_SPIN(xb_ld(&bar[XB_XGEN(b.x)]) == gen, bar);
            __builtin_amdgcn_fence(__ATOMIC_ACQUIRE, "agent");
            asm volatile("s_waitcnt vmcnt(0)" ::: "memory");
        }
    }
    __syncthreads();
}

struct Ctx {
    LAS unsigned char* lds;
    int tid, lane, wid, G, bid;
    const float *x, *c, *w_ada, *b_ada, *norm1_g, *w_in, *lq1, *lk1, *lq2, *lk2, *diff_g, *w_alpha_up, *b_alpha, *gla_g,
                *w_bd, *w_bg, *w_out, *norm2_g, *w_router, *b_router, *w_gu, *b_gu, *w_dn, *b_dn, *final_g;
    float* out;
    unsigned* ctl; float* mod; int* tope; float* topw; int* list;
    bf16 *WinT, *WbdT, *WbgT, *WoutT, *WguT, *WdT, *H, *H2, *OA, *OB, *MG, *YB, *PROJ, *ACT, *Y1; float* cb; u32x4* wrf;
};

constexpr int NXCD = 8, WGM = 8;
__host__ __device__ __forceinline__ int perm32(int rho) { const int n = rho >> 4, i = rho & 15; return 8 * (i >> 2) + 4 * n + (i & 3); }
struct Unit { int pm, pn, e, row0, cnt; };
struct TileOrder {
    int nM, nN, nwg, G, c, wgm;
    __device__ __forceinline__ void init(int nM_, int nN_, int G_, int c_, int wgm_ = WGM) { nM = nM_; nN = nN_; nwg = nM * nN; G = G_; c = c_; wgm = wgm_; }
    __device__ __forceinline__ bool next(int i, Unit& u) const {
        const long L = (long)i * G + c; if (L >= nwg) return false;
        int wgid = (int)L; { const int q = nwg / NXCD, r = nwg % NXCD, xcd = wgid % NXCD, off = wgid / NXCD; wgid = (xcd < r ? xcd * (q + 1) : r * (q + 1) + (xcd - r) * q) + off; }
        const int nig = wgm * nN, gid = wgid / nig, fm = gid * wgm, gsz = (nM - fm) < wgm ? (nM - fm) : wgm;
        u.pm = fm + ((wgid % nig) % gsz); u.pn = (wgid % nig) / gsz; u.e = 0; u.row0 = 0; u.cnt = 0; return true;
    }
};
struct MoeOrder {
    TileOrder t; LAS const int* tab;
    __device__ __forceinline__ bool next(int i, Unit& u) const {
        if (!t.next(i, u)) return false;
        const int e = tab[65 + u.pm];
        u.e = e; u.row0 = (u.pm - tab[32 + e]) * 256; u.cnt = tab[e]; return true;
    }
};
struct DenseDesc {
    static constexpr bool GATHER = false;
    const bf16* A; int lda; const bf16* Bt; int K;
    __device__ __forceinline__ unsigned a_off(const Unit& u, int r) const { return (unsigned)((u.pm * 256 + r) * lda) * 2u; }
    __device__ __forceinline__ const char* a_base(const Unit&) const { return (const char*)A; }
    __device__ __forceinline__ const char* b_base(const Unit& u) const { return (const char*)Bt + (size_t)u.pn * 256 * K * 2; }
};
struct MoeUpDesc {
    static constexpr bool GATHER = true;
    const unsigned char* H2; const int* list; const unsigned char* WguT; int K;
    __device__ __forceinline__ const int* id_src(const Unit& u, int j) const { const int s = u.row0 + j; return list + (size_t)u.e * NTOK + (s < NTOK ? s : NTOK - 1); }
    __device__ __forceinline__ unsigned a_off(const Unit& u, int r) const { const int slot = u.row0 + r; int tok = 0; if (slot < u.cnt) tok = list[u.e * NTOK + slot] >> 2; return (unsigned)tok * 1024u; }
    __device__ __forceinline__ const char* a_base(const Unit&) const { return (const char*)H2; }
    __device__ __forceinline__ const char* b_base(const Unit& u) const { return (const char*)WguT + ((size_t)u.e * 2048 + (size_t)u.pn * 256) * 1024; }
};
struct MoeDownDesc {
    static constexpr bool GATHER = false;
    const unsigned char* ACT; const unsigned char* WdT; int K;
    __device__ __forceinline__ unsigned a_off(const Unit& u, int r) const { return (unsigned)(u.pm * 256 + r) * 1024u; }
    __device__ __forceinline__ const char* a_base(const Unit&) const { return (const char*)ACT; }
    __device__ __forceinline__ const char* b_base(const Unit& u) const { return (const char*)WdT + ((size_t)u.e * 1024 + (size_t)u.pn * 256) * 1024; }
};

template <class Desc, class Order, class Epi>
__device__ __forceinline__ void gemm_simple(const Desc& g, const Order& S, const Epi& E) {
    const int tid = threadIdx.x, wid = __builtin_amdgcn_readfirstlane(tid >> 6), lane = tid & 63, wr = wid >> 2, wc = wid & 3, fr = lane & 15, fq = lane >> 4;
    const int K = g.K;
    Unit u;
    for (int i = 0; S.next(i, u); ++i) {
        f32x4 acc[2][2][4][2];
#pragma unroll
        for (int a = 0; a < 2; ++a)
#pragma unroll
            for (int b = 0; b < 2; ++b)
#pragma unroll
                for (int m = 0; m < 4; ++m)
#pragma unroll
                    for (int n = 0; n < 2; ++n) acc[a][b][m][n] = (f32x4){0.f, 0.f, 0.f, 0.f};
        unsigned aoff[2][4], boff[2][2];
#pragma unroll
        for (int a = 0; a < 2; ++a)
#pragma unroll
            for (int m = 0; m < 4; ++m) aoff[a][m] = g.a_off(u, a * 128 + wr * 64 + m * 16 + fr) + fq * 16;
#pragma unroll
        for (int b = 0; b < 2; ++b)
#pragma unroll
            for (int n = 0; n < 2; ++n) { const int nc = b * 128 + wc * 32 + (Epi::PERM ? perm32(n * 16 + fr) : (n * 16 + fr)); boff[b][n] = (unsigned)(nc * K) * 2u + fq * 16; }
        const char* ab = g.a_base(u); const char* bb = g.b_base(u);
#pragma unroll 1
        for (int ks = 0; ks < K / 32; ++ks) {
            bf16x8 af[2][4], bfr[2][2];
#pragma unroll
            for (int a = 0; a < 2; ++a)
#pragma unroll
                for (int m = 0; m < 4; ++m) af[a][m] = *(const bf16x8*)(ab + aoff[a][m] + ks * 64);
#pragma unroll
            for (int b = 0; b < 2; ++b)
#pragma unroll
                for (int n = 0; n < 2; ++n) bfr[b][n] = *(const bf16x8*)(bb + boff[b][n] + ks * 64);
#pragma unroll
            for (int a = 0; a < 2; ++a)
#pragma unroll
                for (int b = 0; b < 2; ++b)
#pragma unroll
                    for (int m = 0; m < 4; ++m)
#pragma unroll
                        for (int n = 0; n < 2; ++n) acc[a][b][m][n] = __builtin_amdgcn_mfma_f32_16x16x32_bf16(bfr[b][n], af[a][m], acc[a][b][m][n], 0, 0, 0);
        }
        E(acc, u, wr, wc, fr, fq);
    }
}


#ifndef PROBE_A
#define PROBE_A -1
#endif
#if PROBE_A >= 100
#define PSTAMP(ldsp, idx) do { if (blockIdx.x == 0 && threadIdx.x == 0) { volatile LAS unsigned* pm_ = (volatile LAS unsigned*)((ldsp) + MISC_OFF); const unsigned now_ = (unsigned)__builtin_amdgcn_s_memrealtime(); pm_[16 + (idx)] += now_ - pm_[15]; pm_[15] = now_; } } while (0)
#else
#define PSTAMP(ldsp, idx) do {} while (0)
#endif
constexpr int BK = 64, HALF = 128, HTB = HALF * BK * 2, STAGE_BYTES = 8 * HTB;
__host__ __device__ __forceinline__ int lds_byte(int r, int c) { const int st = (r >> 4) * 2 + (c >> 5), rr = r & 15, cc = c & 31, ob = rr * 64 + cc * 2; return st * 1024 + (ob ^ (((ob >> 9) & 1) << 5)); }
__host__ __device__ __forceinline__ void stage_rc(int b, int& R, int& C) { const int st = b / 1024, sb = b % 1024, swz = sb ^ (((sb >> 9) & 1) << 5); R = (st >> 1) * 16 + swz / 64; C = (st & 1) * 32 + (swz % 64) / 2; }

typedef int v8i32 __attribute__((ext_vector_type(8)));
__device__ __forceinline__ v8i32 cat88(bf16x8 lo, bf16x8 hi) { const i32x4 a = __builtin_bit_cast(i32x4, lo), b = __builtin_bit_cast(i32x4, hi); return (v8i32){a[0], a[1], a[2], a[3], b[0], b[1], b[2], b[3]}; }
template <class Desc, class Order, class Epi, bool ALIGN_EPI, bool FP8 = false, int PID = 0>
__device__ __forceinline__ void gemm_phase(LAS unsigned char* lds, const Desc& g, const Order& S, const Epi& E) {
    const int tid = tid_fresh(), wid = __builtin_amdgcn_readfirstlane(tid >> 6), lane = tid & 63, wr = wid >> 2, wc = wid & 3, fr = lane & 15, fq = lane >> 4;
    const int KBy = FP8 ? g.K : 2 * g.K, nt = KBy / 128;
    int Rs[2], Cs[2]; unsigned voffB[2];
#pragma unroll
    for (int i = 0; i < 2; ++i) { stage_rc(tid * 16 + i * 8192, Rs[i], Cs[i]); const int Rb = 64 * (Rs[i] >> 5) + perm32(Rs[i] & 31); voffB[i] = (unsigned)(Rb * KBy + Cs[i] * 2); }
    unsigned vA[2][2];
    LAS u32x4* const vslot = (LAS u32x4*)(lds + STAGE_BYTES + 4096) + tid;
    const size_t kstep = (size_t)(BK * 2);
    const size_t hstepB = (size_t)32 * KBy;
    const unsigned ldsw = (unsigned)wid * 1024u;
    const int aoff = FP8 ? lds_byte(wr * 64 + fr, fq * 16) : lds_byte(wr * 64 + fr, fq * 8), boff = FP8 ? lds_byte(wc * 32 + fr, fq * 16) : lds_byte(wc * 32 + fr, fq * 8);
    constexpr int KSTR = FP8 ? 16 : 1024;
#define PG8_SA(b, h) (((b) * 2 + (h)) * HTB)
#define PG8_SB(b, h) ((4 + (b) * 2 + (h)) * HTB)
#define PG8_STAGE(bufoff, gbase, voff) do { _Pragma("unroll") for (int _i = 0; _i < 2; ++_i) \
        __builtin_amdgcn_global_load_lds((const unsigned*)((const char*)(gbase) + (voff)[_i]), (LAS unsigned*)(lds + (bufoff) + ldsw + _i * 8192), 16, 0, 0); } while (0)
#define PG8_STAGE_A(bufoff, gbase, h) do { _Pragma("unroll") for (int _i = 0; _i < 2; ++_i) \
        __builtin_amdgcn_global_load_lds((const unsigned*)((const char*)(gbase) + vA[h][_i]), (LAS unsigned*)(lds + (bufoff) + ldsw + _i * 8192), 16, 0, 0); } while (0)
#define PG8_LDA(dst, b, h) do { _Pragma("unroll") for (int m = 0; m < 4; ++m) _Pragma("unroll") for (int k = 0; k < 2; ++k) dst[m][k] = *(const LAS bf16x8*)(lds + PG8_SA(b, h) + aoff + m * 2048 + k * KSTR); } while (0)
#define PG8_LDB(dst, b, h) do { _Pragma("unroll") for (int n = 0; n < 2; ++n) _Pragma("unroll") for (int k = 0; k < 2; ++k) dst[n][k] = *(const LAS bf16x8*)(lds + PG8_SB(b, h) + boff + n * 2048 + k * KSTR); } while (0)
#define PG8_MMA(ai, bj, At, Bt) do { __builtin_amdgcn_s_setprio(1); _Pragma("unroll") for (int m = 0; m < 4; ++m) _Pragma("unroll") for (int n = 0; n < 2; ++n) { \
        if constexpr (FP8) { acc[ai][bj][m][n] = __builtin_amdgcn_mfma_scale_f32_16x16x128_f8f6f4(cat88(Bt[n][0], Bt[n][1]), cat88(At[m][0], At[m][1]), acc[ai][bj][m][n], 0, 0, 0, F8_SW, 0, F8_SA); } \
        else { _Pragma("unroll") for (int k = 0; k < 2; ++k) acc[ai][bj][m][n] = __builtin_amdgcn_mfma_f32_16x16x32_bf16(Bt[n][k], At[m][k], acc[ai][bj][m][n], 0, 0, 0); } } \
        __builtin_amdgcn_s_setprio(0); } while (0)
#define PG8_WAIT_V(n) asm volatile("s_waitcnt vmcnt(" #n ")" ::: "memory")
#define PG8_WAIT_L(n) asm volatile("s_waitcnt lgkmcnt(" #n ")" ::: "memory")
#define PG8_BAR __builtin_amdgcn_s_barrier()
#define PG8_SCHED __builtin_amdgcn_sched_barrier(0)
#define PG8_KBODY(t) do { \
            const bool last = (t == nt - 2); \
            const char* a1 = Ab + (size_t)(t + 1) * kstep; \
            const char* a2 = last ? Ab : Ab + (size_t)(t + 2) * kstep; const char* b2 = last ? nB : cB + (size_t)(t + 2) * kstep; \
            const char* a3 = a2 + kstep; const char* b3 = b2 + kstep; \
              \
            PG8_LDB(B0, 0, 0); PG8_LDB(B1, 0, 1); PG8_SCHED; PG8_LDA(At, 0, 0); PG8_STAGE_A(PG8_SA(1, 1), a1, 1); \
            if (last && has_next) { if constexpr (Desc::GATHER) { _Pragma("unroll") for (int _h = 0; _h < 2; ++_h) _Pragma("unroll") for (int _i = 0; _i < 2; ++_i) { const int _j = _h * HALF + Rs[_i]; const int _id = idbuf[((ui + 1) & 1) * 256 + _j]; vA[_h][_i] = ((nxt.row0 + _j < nxt.cnt) ? (unsigned)(_id >> 2) * 1024u : 0u) + (unsigned)Cs[_i] * 2u; } } else { const u32x4 vn = *vslot; vA[0][0] = vn.x; vA[0][1] = vn.y; vA[1][0] = vn.z; vA[1][1] = vn.w; } }     \
            PG8_WAIT_V(8); PG8_WAIT_L(0); PG8_BAR; PG8_MMA(0, 0, At, B0); PG8_MMA(0, 1, At, B1); PG8_BAR; PG8_SCHED; \
              \
            PG8_LDA(At, 0, 1); PG8_STAGE(PG8_SB(0, 0), b2, voffB); PG8_STAGE(PG8_SB(0, 1), b2 + hstepB, voffB); PG8_STAGE_A(PG8_SA(0, 0), a2, 0); \
            PG8_WAIT_V(8); PG8_WAIT_L(0); PG8_BAR; PG8_MMA(1, 0, At, B0); PG8_MMA(1, 1, At, B1); PG8_BAR; PG8_SCHED; \
              \
            PG8_LDB(B0, 1, 0); PG8_LDB(B1, 1, 1); PG8_SCHED; PG8_LDA(At, 1, 0); PG8_STAGE_A(PG8_SA(0, 1), a2, 1); \
            PG8_WAIT_V(8); PG8_WAIT_L(0); PG8_BAR; PG8_MMA(0, 0, At, B0); PG8_MMA(0, 1, At, B1); PG8_BAR; PG8_SCHED; \
              \
            PG8_LDA(At, 1, 1); PG8_STAGE(PG8_SB(1, 0), b3, voffB); PG8_STAGE(PG8_SB(1, 1), b3 + hstepB, voffB); PG8_STAGE_A(PG8_SA(1, 0), a3, 0); \
            PG8_WAIT_V(8); PG8_WAIT_L(0); PG8_BAR; PG8_MMA(1, 0, At, B0); PG8_MMA(1, 1, At, B1); PG8_BAR; PG8_SCHED; \
        } while (0)
#define PG8_AOFFS(dst, un) do { _Pragma("unroll") for (int _h = 0; _h < 2; ++_h) _Pragma("unroll") for (int _i = 0; _i < 2; ++_i) dst[_h][_i] = g.a_off(un, _h * HALF + Rs[_i]) + (unsigned)Cs[_i] * 2u; } while (0)
    Unit cur, nxt; int ui = 0;
    if (!S.next(0, cur)) return;
    LAS int* const idbuf = (LAS int*)(lds + STAGE_BYTES + 4096);
#define PG8_IDDMA(un, b) do { if (wid < 4) __builtin_amdgcn_global_load_lds((const unsigned*)g.id_src(un, 64 * wid + lane), (LAS unsigned*)(idbuf + (b) * 256 + 64 * wid), 4, 0, 0); } while (0)
    if constexpr (Desc::GATHER) { Unit u1; if (S.next(1, u1)) PG8_IDDMA(u1, 1); }
    f32x4 acc[2][2][4][2];
#pragma unroll
    for (int a = 0; a < 2; ++a)
#pragma unroll
        for (int b = 0; b < 2; ++b)
#pragma unroll
            for (int m = 0; m < 4; ++m)
#pragma unroll
                for (int n = 0; n < 2; ++n) acc[a][b][m][n] = (f32x4){0.f, 0.f, 0.f, 0.f};
    bf16x8 At[4][2], B0[2][2], B1[2][2];
    const char* const Ab = g.a_base(cur);
    const char* cB = g.b_base(cur);
    PG8_AOFFS(vA, cur);
    PG8_STAGE(PG8_SB(0, 0), cB, voffB); PG8_STAGE(PG8_SB(0, 1), cB + hstepB, voffB); PG8_STAGE_A(PG8_SA(0, 0), Ab, 0); PG8_STAGE_A(PG8_SA(0, 1), Ab, 1);
    if (wr == 1) PG8_BAR;
    PG8_WAIT_V(2); PG8_BAR;
    PG8_STAGE(PG8_SB(1, 0), cB + kstep, voffB); PG8_STAGE_A(PG8_SA(1, 0), Ab + kstep, 0); PG8_STAGE(PG8_SB(1, 1), cB + hstepB + kstep, voffB);
    PG8_WAIT_V(6); PG8_BAR;
    for (;;) {
        const bool has_next = S.next(ui + 1, nxt);
        const char* nB = has_next ? g.b_base(nxt) : cB;
        if constexpr (Desc::GATHER) { Unit u2; if (S.next(ui + 2, u2)) PG8_IDDMA(u2, ui & 1); }
        else if (has_next) { unsigned vn[2][2]; PG8_AOFFS(vn, nxt); *vslot = (u32x4){vn[0][0], vn[0][1], vn[1][0], vn[1][1]}; }
        PSTAMP(lds, 40 + PID);
        if constexpr (Epi::MIDK) {
            for (int t = 0; t < nt / 2; t += 2) PG8_KBODY(t);
            E.mid(acc, cur, wr, wc, fr, fq);
            for (int t = nt / 2; t < nt; t += 2) PG8_KBODY(t);
        } else {
            for (int t = 0; t < nt; t += 2) PG8_KBODY(t);
        }
        PSTAMP(lds, 20 + PID);
        if constexpr (ALIGN_EPI) { if (wr == 0) PG8_BAR; }
        E(acc, cur, wr, wc, fr, fq);
        PSTAMP(lds, 30 + PID);
        if (!has_next) break;
#pragma unroll
        for (int a = 0; a < 2; ++a)
#pragma unroll
            for (int b = 0; b < 2; ++b)
#pragma unroll
                for (int m = 0; m < 4; ++m)
#pragma unroll
                    for (int n = 0; n < 2; ++n) acc[a][b][m][n] = (f32x4){0.f, 0.f, 0.f, 0.f};
        cur = nxt; cB = nB; ++ui;
        if constexpr (ALIGN_EPI) { if (wr == 1) PG8_BAR; }
    }
    PG8_WAIT_V(0);
    if constexpr (!ALIGN_EPI) { if (wr == 0) PG8_BAR; }
    PG8_BAR;
#undef PG8_SA
#undef PG8_SB
#undef PG8_STAGE
#undef PG8_STAGE_A
#undef PG8_LDA
#undef PG8_LDB
#undef PG8_MMA
#undef PG8_WAIT_V
#undef PG8_WAIT_L
#undef PG8_BAR
#undef PG8_SCHED
#undef PG8_AOFFS
#undef PG8_KBODY
#undef PG8_IDDMA
}

__device__ __forceinline__ u32x4 pack8(const f32x4& v0, const f32x4& v1) { u32x4 w; w.x = pk2(v0[0], v0[1]); w.y = pk2(v0[2], v0[3]); w.z = pk2(v1[0], v1[1]); w.w = pk2(v1[2], v1[3]); return w; }
__device__ __forceinline__ void unpack8(const u32x4& w, f32x4& v0, f32x4& v1) { v0 = (f32x4){bflo(w.x), bfhi(w.x), bflo(w.y), bfhi(w.y)}; v1 = (f32x4){bflo(w.z), bfhi(w.z), bflo(w.w), bfhi(w.w)}; }
__device__ __forceinline__ float logsig16(float x) { return (fminf(x, 0.f) - log1pf(__expf(-fabsf(x)))) * (1.f / 16.f); }

__device__ __forceinline__ unsigned rot8(unsigned v) { return (unsigned)__builtin_amdgcn_update_dpp(0, (int)v, 0x128, 0xf, 0xf, false); }
__device__ __forceinline__ void pair_exchange(u32x4& a, u32x4& b, bool lo) {
    const u32x4 ra = (u32x4){rot8(a.x), rot8(a.y), rot8(a.z), rot8(a.w)}, rb = (u32x4){rot8(b.x), rot8(b.y), rot8(b.z), rot8(b.w)};
    const u32x4 na = lo ? a : rb, nb = lo ? ra : b; a = na; b = nb;
}
struct EpiProj {
    static constexpr bool PERM = true, MIDK = false;
    bf16* P; const float* b_alpha;
    __device__ __forceinline__ void operator()(const f32x4 (&acc)[2][2][4][2], const Unit& u, int wr, int wc, int fr, int fq) const {
        const int pn = u.pn; const int mode = (pn < 2) ? 1 : (pn == 6 ? 2 : (pn == 20 ? 3 : 0));
        const int cw = pn * 256 + wc * 64 + 8 * fq; const bool lo = fr < 8;
        f32x4 bb[2][2];
#pragma unroll
        for (int bj = 0; bj < 2; ++bj) { bb[bj][0] = (f32x4){0.f, 0.f, 0.f, 0.f}; bb[bj][1] = bb[bj][0];
            if (mode == 3) { bb[bj][0] = *(const f32x4*)(b_alpha + (cw + 32 * bj - C_AL)); bb[bj][1] = *(const f32x4*)(b_alpha + (cw + 32 * bj - C_AL) + 4); } }
#pragma unroll
        for (int ai = 0; ai < 2; ++ai)
#pragma unroll
            for (int m = 0; m < 4; ++m) {
                u32x4 w[2];
#pragma unroll
                for (int bj = 0; bj < 2; ++bj) {
                    f32x4 v0 = acc[ai][bj][m][0], v1 = acc[ai][bj][m][1];
                    if (mode == 1) { v0 = v0 * QSCALE; v1 = v1 * QSCALE; }
                    else if (mode == 2) { v0 = v0 * 0.125f; v1 = v1 * 0.125f; }
                    else if (mode == 3) {
#pragma unroll
                        for (int j = 0; j < 4; ++j) { v0[j] = logsig16(v0[j] + bb[bj][0][j]); v1[j] = logsig16(v1[j] + bb[bj][1][j]); } }
                    w[bj] = pack8(v0, v1);
                }
                pair_exchange(w[0], w[1], lo);
                const int rowA = u.pm * 256 + ai * 128 + wr * 64 + m * 16 + (fr & 7); const int cc = cw + 32 * (fr >> 3);
                *(u32x4*)(P + (size_t)rowA * NPROJ + cc) = w[0];
                *(u32x4*)(P + (size_t)(rowA + 8) * NPROJ + cc) = w[1];
            }
    }
};
struct EpiBranch {
    static constexpr bool PERM = true, MIDK = true;
    bf16* MG; const bf16* P;
    __device__ __forceinline__ void mid(f32x4 (&acc)[2][2][4][2], const Unit& u, int wr, int wc, int fr, int fq) const {
        const int cw = u.pn * 256 + wc * 64 + 8 * fq;
#pragma unroll
        for (int ai = 0; ai < 2; ++ai)
#pragma unroll
            for (int m = 0; m < 4; ++m) {
                const bf16* pr = P + (size_t)(u.pm * 256 + ai * 128 + wr * 64 + m * 16 + fr) * NPROJ + cw;
#pragma unroll
                for (int bj = 0; bj < 2; ++bj) {
                    const u32x4 gaw = *(const u32x4*)(pr + C_GA + 32 * bj), gbw = *(const u32x4*)(pr + C_GB + 32 * bj);
                    f32x4 a0, a1, b0, b1; unpack8(gaw, a0, a1); unpack8(gbw, b0, b1);
#pragma unroll
                    for (int j = 0; j < 4; ++j) {
                        acc[ai][bj][m][0][j] *= (1.f + __expf(-__builtin_amdgcn_fmed3f(b0[j], -30.f, 30.f))) * __builtin_amdgcn_rcpf(1.f + __expf(-a0[j]));
                        acc[ai][bj][m][1][j] *= (1.f + __expf(-__builtin_amdgcn_fmed3f(b1[j], -30.f, 30.f))) * __builtin_amdgcn_rcpf(1.f + __expf(-a1[j])); }
                }
                if (m & 1) asm volatile("" ::: "memory");
            }
    }
    __device__ __forceinline__ void operator()(const f32x4 (&acc)[2][2][4][2], const Unit& u, int wr, int wc, int fr, int fq) const {
        const int cw = u.pn * 256 + wc * 64 + 8 * fq; const bool lo = fr < 8;
#pragma unroll
        for (int ai = 0; ai < 2; ++ai)
#pragma unroll
            for (int m = 0; m < 4; ++m) {
                const int row = u.pm * 256 + ai * 128 + wr * 64 + m * 16 + fr;
                u32x4 w[2];
#pragma unroll
                for (int bj = 0; bj < 2; ++bj) {
                    const u32x4 gbw = *(const u32x4*)(P + (size_t)row * NPROJ + C_GB + cw + 32 * bj);
                    f32x4 b0, b1; unpack8(gbw, b0, b1);
                    f32x4 v0 = acc[ai][bj][m][0], v1 = acc[ai][bj][m][1];
#pragma unroll
                    for (int j = 0; j < 4; ++j) { v0[j] *= __builtin_amdgcn_rcpf(1.f + __expf(-__builtin_amdgcn_fmed3f(b0[j], -30.f, 30.f))); v1[j] *= __builtin_amdgcn_rcpf(1.f + __expf(-__builtin_amdgcn_fmed3f(b1[j], -30.f, 30.f))); }
                    w[bj] = pack8(v0, v1);
                }
                pair_exchange(w[0], w[1], lo);
                const int rowA = u.pm * 256 + ai * 128 + wr * 64 + m * 16 + (fr & 7); const int cc = cw + 32 * (fr >> 3);
                *(u32x4*)(MG + (size_t)rowA * DM + cc) = w[0];
                *(u32x4*)(MG + (size_t)(rowA + 8) * DM + cc) = w[1];
            }
    }
};
struct EpiOut {
    static constexpr bool PERM = true, MIDK = false;
    bf16* Y1; const float* mod;
    __device__ __forceinline__ void operator()(const f32x4 (&acc)[2][2][4][2], const Unit& u, int wr, int wc, int fr, int fq) const {
        const int b = u.pm >> 3; const float* gt1 = mod + b * 6144 + 2048;
        const int cw = u.pn * 256 + wc * 64 + 8 * fq; const bool lo = fr < 8;
        f32x4 g[2][2];
#pragma unroll
        for (int bj = 0; bj < 2; ++bj) { g[bj][0] = *(const f32x4*)(gt1 + cw + 32 * bj); g[bj][1] = *(const f32x4*)(gt1 + cw + 32 * bj + 4); }
#pragma unroll
        for (int ai = 0; ai < 2; ++ai)
#pragma unroll
            for (int m = 0; m < 4; ++m) {
                u32x4 wa = pack8(acc[ai][0][m][0] * g[0][0], acc[ai][0][m][1] * g[0][1]), wb = pack8(acc[ai][1][m][0] * g[1][0], acc[ai][1][m][1] * g[1][1]);
                pair_exchange(wa, wb, lo);
                const int rowA = u.pm * 256 + ai * 128 + wr * 64 + m * 16 + (fr & 7); const int cc = cw + 32 * (fr >> 3);
                *(u32x4*)(Y1 + (size_t)rowA * DM + cc) = wa;
                *(u32x4*)(Y1 + (size_t)(rowA + 8) * DM + cc) = wb;
            }
    }
};
struct EpiUp {
    static constexpr bool PERM = true, MIDK = false;
    unsigned char* ACT; const float* b_gu;
    __device__ __forceinline__ void operator()(const f32x4 (&acc)[2][2][4][2], const Unit& u, int wr, int wc, int fr, int fq) const {
        const int f0 = u.pn * 128 + wc * 32 + 8 * fq;
        const float* bg = b_gu + (size_t)u.e * 2048 + f0; const float* bu = bg + 1024;
        const f32x4 bg0 = *(const f32x4*)bg, bg1 = *(const f32x4*)(bg + 4), bu0 = *(const f32x4*)bu, bu1 = *(const f32x4*)(bu + 4);
#pragma unroll
        for (int ai = 0; ai < 2; ++ai)
#pragma unroll
            for (int m = 0; m < 4; ++m) {
                const int r = ai * 128 + wr * 64 + m * 16 + fr;
                f32x4 g0 = acc[ai][0][m][0] + bg0, g1 = acc[ai][0][m][1] + bg1, u0 = acc[ai][1][m][0] + bu0, u1 = acc[ai][1][m][1] + bu1, a0, a1;
#pragma unroll
                for (int j = 0; j < 4; ++j) {
                    float gg = fminf(g0[j], 7.f), uu = fminf(fmaxf(u0[j], -7.f), 7.f); a0[j] = (uu + 1.f) * gg * sigmoidf_(1.702f * gg);
                    gg = fminf(g1[j], 7.f); uu = fminf(fmaxf(u1[j], -7.f), 7.f); a1[j] = (uu + 1.f) * gg * sigmoidf_(1.702f * gg); }
                *(u32x2*)(ACT + (size_t)(u.pm * 256 + r) * FF + f0) = (u32x2){pk4_fp8(a0[0] * F8_ASCALE, a0[1] * F8_ASCALE, a0[2] * F8_ASCALE, a0[3] * F8_ASCALE), pk4_fp8(a1[0] * F8_ASCALE, a1[1] * F8_ASCALE, a1[2] * F8_ASCALE, a1[3] * F8_ASCALE)};
            }
    }
};
constexpr float F8_YSCALE = 16.f;
__device__ __forceinline__ void pair_exchange2(u32x2& a, u32x2& b, bool lo) {
    const u32x2 ra = (u32x2){rot8(a.x), rot8(a.y)}, rb = (u32x2){rot8(b.x), rot8(b.y)};
    const u32x2 na = lo ? a : rb, nb = lo ? ra : b; a = na; b = nb;
}
struct EpiDown {
    static constexpr bool PERM = true, MIDK = false;
    unsigned char* YB; const float* b_dn; const int* list;
    __device__ __forceinline__ void operator()(const f32x4 (&acc)[2][2][4][2], const Unit& u, int wr, int wc, int fr, int fq) const {
        const int cw = u.pn * 256 + wc * 64 + 8 * fq; const bool lo = fr < 8;
        f32x4 bb[2][2];
#pragma unroll
        for (int bj = 0; bj < 2; ++bj) { const float* bp = b_dn + (size_t)u.e * DM + cw + 32 * bj; bb[bj][0] = *(const f32x4*)bp; bb[bj][1] = *(const f32x4*)(bp + 4); }
#pragma unroll
        for (int ai = 0; ai < 2; ++ai)
#pragma unroll
            for (int m = 0; m < 4; ++m) {
                const int slot = u.row0 + ai * 128 + wr * 64 + m * 16 + fr;
                const int aid = slot < u.cnt ? list[u.e * NTOK + slot] : -1;
                const int aidx = (int)rot8((unsigned)aid);
                u32x2 w[2];
#pragma unroll
                for (int bj = 0; bj < 2; ++bj) { f32x4 v0 = (acc[ai][bj][m][0] + bb[bj][0]) * F8_YSCALE, v1 = (acc[ai][bj][m][1] + bb[bj][1]) * F8_YSCALE;
#pragma unroll
                    for (int j = 0; j < 4; ++j) { v0[j] = __builtin_amdgcn_fmed3f(v0[j], -440.f, 440.f); v1[j] = __builtin_amdgcn_fmed3f(v1[j], -440.f, 440.f); }
                    w[bj] = (u32x2){pk4_fp8(v0[0], v0[1], v0[2], v0[3]), pk4_fp8(v1[0], v1[1], v1[2], v1[3])}; }
                pair_exchange2(w[0], w[1], lo);
                const int aidA = lo ? aid : aidx, aidB = lo ? aidx : aid;
                const int cc = cw + 32 * (fr >> 3);
                if (aidA >= 0) *(u32x2*)(YB + (size_t)aidA * DM + cc) = w[0];
                if (aidB >= 0) *(u32x2*)(YB + (size_t)aidB * DM + cc) = w[1];
            }
    }
};

__device__ __forceinline__ void split_bf16(const float (&v)[8], bf16x8& hi, bf16x8& lo) {
    const unsigned h0 = pk2(v[0], v[1]), h1 = pk2(v[2], v[3]), h2 = pk2(v[4], v[5]), h3 = pk2(v[6], v[7]);
    const u32x4 h = (u32x4){h0, h1, h2, h3};
    const u32x4 l = (u32x4){pk2(v[0] - bflo(h0), v[1] - bfhi(h0)), pk2(v[2] - bflo(h1), v[3] - bfhi(h1)), pk2(v[4] - bflo(h2), v[5] - bfhi(h2)), pk2(v[6] - bflo(h3), v[7] - bfhi(h3))};
    hi = __builtin_bit_cast(bf16x8, h); lo = __builtin_bit_cast(bf16x8, l);
}
constexpr int T_NITEMS = 16 * 80 + 2 * 8 * 16 + 16 * 16 + 32 * 16 * 32 + 32 * 16 * 16;
__device__ __forceinline__ void transposes(const Ctx& C, int i0, int i1, int w, int nw);
__device__ __forceinline__ void phase_mod(const Ctx& C) {
    LAS float* sc = (LAS float*)C.lds;
    LAS float* red = sc + 16 * 1024;
    for (int cb = C.bid; cb < 96; cb += C.G) {
        __syncthreads();
        for (int i = C.tid; i < 16 * 1024; i += NTHREADS) { const float v = C.c[i]; sc[i] = v / (1.f + __expf(-v)); }
        __syncthreads();
        const int cl = C.tid & 63, ks = C.tid >> 6, col = cb * 64 + cl;
        float acc[16];
#pragma unroll
        for (int b = 0; b < 16; ++b) acc[b] = 0.f;
#pragma unroll 2
        for (int k = ks * 128; k < ks * 128 + 128; k += 4) {
            const float w0 = C.w_ada[(size_t)k * 6144 + col], w1 = C.w_ada[(size_t)(k + 1) * 6144 + col], w2 = C.w_ada[(size_t)(k + 2) * 6144 + col], w3 = C.w_ada[(size_t)(k + 3) * 6144 + col];
#pragma unroll
            for (int b = 0; b < 16; ++b) { const f32x4 s4 = *(const LAS f32x4*)(sc + b * 1024 + k); acc[b] += (s4[0] * w0 + s4[1] * w1) + (s4[2] * w2 + s4[3] * w3); }
        }
#pragma unroll
        for (int b = 0; b < 16; ++b) red[(ks * 16 + b) * 64 + cl] = acc[b];
        __syncthreads();
        for (int o = C.tid; o < 1024; o += NTHREADS) {
            const int b = o >> 6, c2 = o & 63; float s = 0.f;
#pragma unroll
            for (int k2 = 0; k2 < 8; ++k2) s += red[(k2 * 16 + b) * 64 + c2];
            C.mod[b * 6144 + cb * 64 + c2] = s + C.b_ada[cb * 64 + c2];
        }
    }
    __syncthreads();
    { const int gw = C.bid * NWAVES + C.wid, NGW = C.G * NWAVES;
      if (C.G == 256) { constexpr int N1 = 11 * 2048; transposes(C, 0, N1, gw, NGW); if (C.bid >= 96) transposes(C, N1, T_NITEMS, gw - 96 * NWAVES, NGW - 96 * NWAVES); }
      else transposes(C, 0, T_NITEMS, gw, NGW); }
    for (int idx = C.bid * NTHREADS + C.tid; idx < 4096; idx += C.G * NTHREADS) {
        const int l2 = idx & 63, nt = (idx >> 6) & 1, ks = (idx >> 7) & 3, w2 = idx >> 9; float wv[8];
#pragma unroll
        for (int j = 0; j < 8; ++j) wv[j] = C.w_router[(size_t)(128 * w2 + 32 * ks + 8 * (l2 >> 4) + j) * NE + 16 * nt + (l2 & 15)];
        bf16x8 h8, l8; split_bf16(wv, h8, l8); C.wrf[idx] = __builtin_bit_cast(u32x4, h8); C.wrf[4096 + idx] = __builtin_bit_cast(u32x4, l8); }
    for (int gt = C.bid * NTHREADS + C.tid; gt < 256 * 512; gt += C.G * NTHREADS) {
        const int j = gt >> 9, k = (gt & 511) * 2;
        float s0 = 0.f, s1 = 0.f;
#pragma unroll
        for (int r = 0; r < 16; ++r) { const float wa = C.w_alpha_up[r * 256 + j]; s0 += C.w_in[(size_t)k * W_IN_N + 3072 + r] * wa; s1 += C.w_in[(size_t)(k + 1) * W_IN_N + 3072 + r] * wa; }
        *(unsigned*)(C.WinT + (size_t)(C_AL + j) * DM + k) = pk2(s0, s1);
    }
}

struct TItem { const float* src; unsigned char* dst; int srcN, pitch, hop, fp8; };
__device__ __forceinline__ TItem titem_decode(const Ctx& C, int it) {
    constexpr int I_IN = 16 * 80, I_BD = 8 * 16, I_OUT = 16 * 16, I_GU = 32 * 16 * 32;
    TItem t; t.hop = 0; t.fp8 = 0; int r = it;
    if (r < I_IN) { const int kb = r / 80, n0 = (r % 80) * 64; t.srcN = W_IN_N; t.pitch = DM * 2; t.src = C.w_in + (size_t)(kb * 64) * W_IN_N + (n0 < 3072 ? n0 : n0 + 16); t.dst = (unsigned char*)(C.WinT + (size_t)n0 * DM + kb * 64); return t; } r -= I_IN;
    if (r < I_BD) { t.srcN = DM; t.pitch = 2048; t.src = C.w_bd + (size_t)((r >> 4) * 64) * DM + (r & 15) * 64; t.dst = (unsigned char*)(C.WbdT + (size_t)((r & 15) * 64) * 1024 + (r >> 4) * 64); return t; } r -= I_BD;
    if (r < I_BD) { t.srcN = DM; t.pitch = 2048; t.src = C.w_bg + (size_t)((r >> 4) * 64) * DM + (r & 15) * 64; t.dst = (unsigned char*)(C.WbdT + (size_t)((r & 15) * 64) * 1024 + 512 + (r >> 4) * 64); return t; } r -= I_BD;
    if (r < I_OUT) { t.srcN = DM; t.pitch = DM * 2; t.src = C.w_out + (size_t)((r >> 4) * 64) * DM + (r & 15) * 64; t.dst = (unsigned char*)(C.WoutT + (size_t)((r & 15) * 64) * DM + (r >> 4) * 64); return t; } r -= I_OUT;
    if (r < I_GU) { const int e = r >> 9, rr = r & 511, kb = rr >> 5, n0 = (rr & 31) * 64; const int pn = n0 >> 8, wc = (n0 >> 6) & 3;
        t.srcN = 2048; t.pitch = 1024; t.fp8 = 1; t.hop = 1024 - 32; t.src = C.w_gu + (size_t)e * DM * 2048 + (size_t)(kb * 64) * 2048 + pn * 128 + wc * 32; t.dst = (unsigned char*)C.WguT + (size_t)e * 2048 * 1024 + (size_t)n0 * 1024 + kb * 64; return t; } r -= I_GU;
    { const int e = r >> 8, rr = r & 255, kb = rr >> 4, n0 = (rr & 15) * 64;
        t.srcN = DM; t.pitch = 1024; t.fp8 = 1; t.src = C.w_dn + (size_t)e * FF * DM + (size_t)(kb * 64) * DM + n0; t.dst = (unsigned char*)C.WdT + (size_t)e * DM * 1024 + (size_t)n0 * 1024 + kb * 64; return t; }
}
__device__ __forceinline__ void titem_load(const TItem& t, int lane, f32x4 (&v)[16]) {
#pragma unroll
    for (int i = 0; i < 16; ++i) v[i] = *(const f32x4*)(t.src + (size_t)(4 * i + (lane >> 4)) * t.srcN + 4 * (lane & 15) + ((lane & 8) ? t.hop : 0));
}
__device__ __forceinline__ void titem_store(const TItem& t, int lane, const f32x4 (&v)[16], LAS float* scr) {
#pragma unroll
    for (int i = 0; i < 16; ++i) { LAS float* p = scr + (4 * i + (lane >> 4)) * 65 + 4 * (lane & 15); p[0] = v[i][0]; p[1] = v[i][1]; p[2] = v[i][2]; p[3] = v[i][3]; }
    LDS_WAIT(); asm volatile("" ::: "memory");
    const int c = lane & 7;
#pragma unroll
    for (int j = 0; j < 8; ++j) { const int n = (lane >> 3) + 8 * j; const LAS float* s = scr + (8 * c) * 65 + n;
        if (t.fp8) { float w[8];
#pragma unroll
            for (int q = 0; q < 8; ++q) w[q] = __builtin_amdgcn_fmed3f(s[q * 65] * F8_WSCALE, -440.f, 440.f);
            *(u32x2*)(t.dst + (size_t)n * t.pitch + 8 * c) = (u32x2){pk4_fp8(w[0], w[1], w[2], w[3]), pk4_fp8(w[4], w[5], w[6], w[7])}; }
        else { u32x4 o; o.x = pk2(s[0 * 65], s[1 * 65]); o.y = pk2(s[2 * 65], s[3 * 65]); o.z = pk2(s[4 * 65], s[5 * 65]); o.w = pk2(s[6 * 65], s[7 * 65]);
            *(u32x4*)(t.dst + (size_t)n * t.pitch + 16 * c) = o; } }
    LDS_WAIT(); asm volatile("" ::: "memory");
}
__device__ __forceinline__ void transposes(const Ctx& C, int i0, int i1, int w, int nw) {
    LAS float* scr = (LAS float*)(C.lds + C.wid * 16896);
    int it = i0 + w; if (it >= i1) return;
    TItem cur = titem_decode(C, it); f32x4 v[16]; titem_load(cur, C.lane, v);
    for (;;) {
        const int nit = it + nw; const bool more = nit < i1;
        TItem nxt = cur; f32x4 vn[16];
        if (more) { nxt = titem_decode(C, nit); titem_load(nxt, C.lane, vn); }
        titem_store(cur, C.lane, v, scr);
        if (!more) break;
        cur = nxt; it = nit;
#pragma unroll
        for (int i = 0; i < 16; ++i) v[i] = vn[i];
    }
}
__device__ __forceinline__ void phase_prep(const Ctx& C) {
    const int gw = C.bid * NWAVES + C.wid, NGW = C.G * NWAVES;
    for (int r0 = gw * 16; r0 < NTOK; r0 += NGW * 16) {
        const int b = r0 >> 11; const float* md = C.mod + b * 6144;
        f32x4 gs[4], sh[4];
#pragma unroll
        for (int j = 0; j < 4; ++j) { const int c0 = 4 * C.lane + 256 * j; gs[j] = *(const f32x4*)(C.norm1_g + c0) * (*(const f32x4*)(md + 1024 + c0) + 1.f); sh[j] = *(const f32x4*)(md + c0); }
#pragma unroll 1
        for (int rr = 0; rr < 16; rr += 2) {
            f32x4 v[2][4]; float ss[2] = {0.f, 0.f};
#pragma unroll
            for (int r = 0; r < 2; ++r)
#pragma unroll
                for (int j = 0; j < 4; ++j) v[r][j] = *(const f32x4*)(C.x + (size_t)(r0 + rr + r) * DM + 4 * C.lane + 256 * j);
#pragma unroll
            for (int r = 0; r < 2; ++r)
#pragma unroll
                for (int j = 0; j < 4; ++j) ss[r] += (v[r][j][0] * v[r][j][0] + v[r][j][1] * v[r][j][1]) + (v[r][j][2] * v[r][j][2] + v[r][j][3] * v[r][j][3]);
#pragma unroll
            for (int r = 0; r < 2; ++r) { const float rstd = rsqrtf(wave_sum(ss[r]) * (1.f / DM) + EPS);
#pragma unroll
                for (int j = 0; j < 4; ++j) { const f32x4 y = v[r][j] * rstd * gs[j] + sh[j];
                    u32x2 o; o.x = pk2(y[0], y[1]); o.y = pk2(y[2], y[3]);
                    *(u32x2*)(C.H + (size_t)(r0 + rr + r) * DM + 4 * C.lane + 256 * j) = o; } }
        }
    }
}

__device__ __forceinline__ void gla_scan(const Ctx& C, int b, int h) {
    LAS float* qs = (LAS float*)C.lds;
    LAS float* ks = qs + 2048;
    LAS float* al = ks + 2048;
    LAS float* vs = al + 2048;
    LAS float* part = vs + 4096;
    const int dv = C.tid & 127, dkg = C.tid >> 7;
    float S[16];
#pragma unroll
    for (int j = 0; j < 16; ++j) S[j] = 0.f;
    const float gdv0 = C.gla_g[2 * C.lane], gdv1 = C.gla_g[2 * C.lane + 1];
    for (int ch = 0; ch < SEQ / 32; ++ch) {
        const int row0 = b * SEQ + ch * 32;
        __syncthreads();
        for (int i = C.tid; i < 32 * 64; i += NTHREADS) { const int t = i >> 6, d = i & 63; const bf16* pr = C.PROJ + (size_t)(row0 + t) * NPROJ;
            qs[i] = bf2f(pr[C_GQ + h * 64 + d]); ks[i] = bf2f(pr[C_GK + h * 64 + d]); al[i] = __expf(bf2f(pr[C_AL + h * 64 + d])); }
        for (int i = C.tid; i < 32 * 128; i += NTHREADS) { const int t = i >> 7, d = i & 127; vs[i] = bf2f(C.PROJ[(size_t)(row0 + t) * NPROJ + C_GV + h * 128 + d]); }
        __syncthreads();
#pragma unroll 2
        for (int t = 0; t < 32; ++t) {
            const float v = vs[t * 128 + dv]; float o = 0.f;
#pragma unroll
            for (int j4 = 0; j4 < 4; ++j4) {
                const f32x4 a4 = *(const LAS f32x4*)(al + t * 64 + dkg * 16 + j4 * 4), k4 = *(const LAS f32x4*)(ks + t * 64 + dkg * 16 + j4 * 4), q4 = *(const LAS f32x4*)(qs + t * 64 + dkg * 16 + j4 * 4);
#pragma unroll
                for (int jj = 0; jj < 4; ++jj) { const int j = j4 * 4 + jj; S[j] = a4[jj] * S[j] + k4[jj] * v; o += q4[jj] * S[j]; }
            }
            part[(dkg * 32 + t) * 128 + dv] = o;
        }
        __syncthreads();
#pragma unroll
        for (int tt = 0; tt < 4; ++tt) {
            const int t = 4 * C.wid + tt; float o0 = 0.f, o1 = 0.f;
#pragma unroll
            for (int g = 0; g < 4; ++g) { o0 += part[(g * 32 + t) * 128 + 2 * C.lane]; o1 += part[(g * 32 + t) * 128 + 2 * C.lane + 1]; }
            const float rstd = rsqrtf(wave_sum(o0 * o0 + o1 * o1) * (1.f / 128.f) + EPS);
            const unsigned grw = *(const unsigned*)(C.PROJ + (size_t)(row0 + t) * NPROJ + C_GR + h * 128 + 2 * C.lane);
            const float g0 = bflo(grw), g1 = bfhi(grw);
            const float y0 = o0 * rstd * gdv0 * (g0 * sigmoidf_(g0)), y1 = o1 * rstd * gdv1 * (g1 * sigmoidf_(g1));
            *(unsigned*)(C.OB + (size_t)(row0 + t) * 512 + h * 128 + 2 * C.lane) = pk2(y0, y1);
        }
    }
}

__device__ __forceinline__ void attn_simple(const Ctx& C) {
    LAS float* Kt = (LAS float*)C.lds;
    LAS float* Vt = Kt + 8192;
    LAS float* Ss = Vt + 8192;
    LAS float* ssq = Ss + 2 * 64 * 68;
    LAS float* lamp = ssq + 256;
    if (C.tid < 64) {
        const float a = wave_sum(C.lq1[C.lane] * C.lk1[C.lane]), b2 = wave_sum(C.lq2[C.lane] * C.lk2[C.lane]);
        if (C.tid == 0) lamp[0] = __expf(a) - __expf(b2) + 0.2f;
    }
    __syncthreads();
    const float lam = lamp[0];
    const int q = C.tid & 63, p = (C.tid >> 6) & 1, dq = C.tid >> 7;
    for (int uix = C.bid; uix < 2048; uix += C.G) {
        const int bh = uix & 63, g = (uix >> 6) & 3, i2 = uix >> 8; const int b = bh >> 2, h = bh & 3;
        const int qc = (i2 & 1) ? (31 - (4 * g + (i2 >> 1))) : (4 * g + (i2 >> 1));
        const float sl2 = exp2f(-2.f * (float)(h + 1)) * LOG2E;
        const int qrow = b * SEQ + qc * 64 + q;
        float qv[64];
#pragma unroll
        for (int d8 = 0; d8 < 8; ++d8) { const u32x4 w = *(const u32x4*)(C.PROJ + (size_t)qrow * NPROJ + C_DQ + h * 128 + p * 64 + d8 * 8);
            qv[d8 * 8 + 0] = bflo(w.x); qv[d8 * 8 + 1] = bfhi(w.x); qv[d8 * 8 + 2] = bflo(w.y); qv[d8 * 8 + 3] = bfhi(w.y);
            qv[d8 * 8 + 4] = bflo(w.z); qv[d8 * 8 + 5] = bfhi(w.z); qv[d8 * 8 + 6] = bflo(w.w); qv[d8 * 8 + 7] = bfhi(w.w); }
        float m = -1e30f, l = 0.f, acc[32];
#pragma unroll
        for (int d = 0; d < 32; ++d) acc[d] = 0.f;
        for (int kc = 0; kc <= qc; ++kc) {
            __syncthreads();
            for (int pi = C.tid; pi < 1024; pi += NTHREADS) { const int r = pi >> 4, cc = pi & 15; const bf16* pr = C.PROJ + (size_t)(b * SEQ + kc * 64 + r) * NPROJ + h * 128 + cc * 8;
                const u32x4 kw = *(const u32x4*)(pr + C_DK), vw = *(const u32x4*)(pr + C_DV); f32x4 a0, a1;
                unpack8(kw, a0, a1); *(LAS f32x4*)(Kt + r * 128 + cc * 8) = a0; *(LAS f32x4*)(Kt + r * 128 + cc * 8 + 4) = a1;
                unpack8(vw, a0, a1); *(LAS f32x4*)(Vt + r * 128 + cc * 8) = a0; *(LAS f32x4*)(Vt + r * 128 + cc * 8 + 4) = a1; }
            __syncthreads();
#pragma unroll 1
            for (int kk = 0; kk < 16; ++kk) {
                const int key = dq * 16 + kk; float s = 0.f;
#pragma unroll
                for (int d4 = 0; d4 < 16; ++d4) { const f32x4 kv = *(const LAS f32x4*)(Kt + key * 128 + p * 64 + d4 * 4);
                    s += qv[d4 * 4] * kv[0]; s += qv[d4 * 4 + 1] * kv[1]; s += qv[d4 * 4 + 2] * kv[2]; s += qv[d4 * 4 + 3] * kv[3]; }
                const int kpos = kc * 64 + key, qpos = qc * 64 + q; const int mn = kpos < 2 * qpos - kpos ? kpos : 2 * qpos - kpos;
                Ss[(p * 64 + q) * 68 + key] = s + sl2 * (float)mn;
            }
            __syncthreads();
            const LAS float* srow = Ss + (p * 64 + q) * 68;
            float cm = -1e30f;
#pragma unroll
            for (int k4 = 0; k4 < 16; ++k4) { const f32x4 sv = *(const LAS f32x4*)(srow + k4 * 4); cm = fmaxf(cm, fmaxf(fmaxf(sv[0], sv[1]), fmaxf(sv[2], sv[3]))); }
            const float mnew = fmaxf(m, cm), alpha = exp2f(m - mnew); m = mnew; l *= alpha;
#pragma unroll
            for (int d = 0; d < 32; ++d) acc[d] *= alpha;
#pragma unroll 2
            for (int key = 0; key < 64; ++key) {
                const float pk = exp2f(srow[key] - m); l += pk;
#pragma unroll
                for (int d4 = 0; d4 < 8; ++d4) { const f32x4 vv = *(const LAS f32x4*)(Vt + key * 128 + dq * 32 + d4 * 4);
                    acc[d4 * 4] += pk * vv[0]; acc[d4 * 4 + 1] += pk * vv[1]; acc[d4 * 4 + 2] += pk * vv[2]; acc[d4 * 4 + 3] += pk * vv[3]; }
            }
        }
        const float inv = 1.f / l;
        __syncthreads();
        LAS float* O2 = Ss;
        if (p == 1) {
#pragma unroll
            for (int d = 0; d < 32; ++d) O2[q * 128 + dq * 32 + d] = lam * acc[d] * inv;
        }
        __syncthreads();
        float ss = 0.f;
        if (p == 0) {
#pragma unroll
            for (int d = 0; d < 32; ++d) { acc[d] = acc[d] * inv - O2[q * 128 + dq * 32 + d]; ss += acc[d] * acc[d]; }
            ssq[q * 4 + dq] = ss;
        }
        __syncthreads();
        if (p == 0) {
            const float tot = (ssq[q * 4] + ssq[q * 4 + 1]) + (ssq[q * 4 + 2] + ssq[q * 4 + 3]);
            const float rstd = rsqrtf(tot * (1.f / 128.f) + EPS) * 0.8f;
            bf16* dst = C.OA + (size_t)qrow * 512 + h * 128 + dq * 32;
#pragma unroll
            for (int d8 = 0; d8 < 4; ++d8) { u32x4 w; const float* gg = C.diff_g + dq * 32 + d8 * 8;
                w.x = pk2(acc[d8 * 8] * rstd * gg[0], acc[d8 * 8 + 1] * rstd * gg[1]); w.y = pk2(acc[d8 * 8 + 2] * rstd * gg[2], acc[d8 * 8 + 3] * rstd * gg[3]);
                w.z = pk2(acc[d8 * 8 + 4] * rstd * gg[4], acc[d8 * 8 + 5] * rstd * gg[5]); w.w = pk2(acc[d8 * 8 + 6] * rstd * gg[6], acc[d8 * 8 + 7] * rstd * gg[7]);
                *(u32x4*)(dst + d8 * 8) = w; }
        }
    }
}


typedef float f32x16 __attribute__((ext_vector_type(16)));
typedef short s16x4 __attribute__((ext_vector_type(4)));
typedef short v4i16_t __attribute__((ext_vector_type(4)));
__device__ __forceinline__ s16x4 vtr(const LAS unsigned char* p) { return __builtin_bit_cast(s16x4, __builtin_amdgcn_ds_read_tr16_b64_v4i16((LAS v4i16_t*)p)); }
template <int OFF> __device__ __forceinline__ void glds16(const void* sbase, unsigned voff, unsigned lds_dst) {
    unsigned sv; asm volatile("s_mov_b32 %0, m0\n\ts_mov_b32 m0, %3\n\ts_nop 0\n\tglobal_load_lds_dwordx4 %1, %2 offset:%4\n\ts_mov_b32 m0, %0" : "=&s"(sv) : "v"(voff), "s"(sbase), "s"(lds_dst), "i"(OFF) : "memory"); }
__device__ __forceinline__ unsigned lds_addr(const LAS unsigned char* p) { return (unsigned)__builtin_amdgcn_readfirstlane((int)(unsigned)(size_t)p); }
#define MFMA16(a, b, c) __builtin_amdgcn_mfma_f32_16x16x32_bf16(a, b, c, 0, 0, 0)
__device__ __forceinline__ bf16x8 cat44(s16x4 lo, s16x4 hi) { return (bf16x8){lo[0], lo[1], lo[2], lo[3], hi[0], hi[1], hi[2], hi[3]}; }
__device__ __forceinline__ void gla_chunked(const Ctx& C, int b, int h) {
    const int lane = C.lane, wid = C.wid, fr = lane & 15, fq = lane >> 4;
    LAS unsigned char* lds = C.lds;
    constexpr int RAW_Q = 0, RAW_K = 8192, RAW_LA = 16384, VB0 = 24576, QS = 57344, KS = 66560, KD = 75776, AM = 84992, ST = 94208, OO = 112640, GTL = 146432, SSQ = 146688;
    constexpr int P = 144, PO = 528;
    const char* pbase = (const char*)(C.PROJ + (size_t)(b * SEQ) * NPROJ);
    const unsigned oq = (unsigned)(((8 * wid + (lane >> 3)) * NPROJ + C_GQ + h * 64 + (lane & 7) * 8) * 2);
    const unsigned okk = oq + (unsigned)((C_GK - C_GQ) * 2), ol = oq + (unsigned)((C_AL - C_GQ) * 2);
    const unsigned ov0 = (unsigned)(((4 * wid + (lane >> 4)) * NPROJ + C_GV + h * 128 + (lane & 15) * 8) * 2), ov1 = ov0 + (unsigned)(32 * NPROJ * 2);
#define GL_DMA(n) do { const char* _cb = pbase + (size_t)(n) * 64 * NPROJ * 2; const unsigned _vb = VB0 + ((n) & 1) * 16384; \
        glds16<0>(_cb, oq, lds_addr(lds + RAW_Q + wid * 1024)); glds16<0>(_cb, okk, lds_addr(lds + RAW_K + wid * 1024)); glds16<0>(_cb, ol, lds_addr(lds + RAW_LA + wid * 1024)); \
        glds16<0>(_cb, ov0, lds_addr(lds + _vb + wid * 1024)); glds16<0>(_cb, ov1, lds_addr(lds + _vb + (wid + 8) * 1024)); } while (0)
    __syncthreads();
    GL_DMA(0);
    for (int i = lane; i < 16 * P / 4; i += 64) ((LAS unsigned*)(lds + ST + wid * 16 * P))[i] = 0u;
    f32x4 accS[4];
#pragma unroll
    for (int t = 0; t < 4; ++t) accS[t] = (f32x4){0.f, 0.f, 0.f, 0.f};
    const int t1 = wid >> 1, ca = 2 * (wid & 1);
    bf16x8 ym[2][2];
#pragma unroll
    for (int ci = 0; ci < 2; ++ci)
#pragma unroll
        for (int ks = 0; ks < 2; ++ks)
#pragma unroll
            for (int jj = 0; jj < 8; ++jj) ym[ci][ks][jj] = (short)(((32 * ks + 8 * fq + jj) <= (16 * (ca + ci) + fr)) ? 0x3F80 : 0);
    const bf16x8 ones = (bf16x8){0x3F80, 0x3F80, 0x3F80, 0x3F80, 0x3F80, 0x3F80, 0x3F80, 0x3F80};
    const int qp = (lane & 15) >> 2, pp = lane & 3;
    const float g0 = C.gla_g[2 * lane], g1 = C.gla_g[2 * lane + 1];
    unsigned grw[8];
#pragma unroll
    for (int cc = 0; cc < 8; ++cc) grw[cc] = 0u;
#define GL_ROWPASS(n) do { _Pragma("unroll") for (int cc = 0; cc < 8; ++cc) { const int c_ = 8 * wid + cc; \
        const float o0 = *(const LAS float*)(lds + OO + c_ * PO + lane * 8), o1 = *(const LAS float*)(lds + OO + c_ * PO + lane * 8 + 4); \
        const f32x4 qa = *(const LAS f32x4*)(lds + SSQ + c_ * 32), qb = *(const LAS f32x4*)(lds + SSQ + c_ * 32 + 16); \
        const float rstd = rsqrtf((((qa[0] + qa[1]) + (qa[2] + qa[3])) + ((qb[0] + qb[1]) + (qb[2] + qb[3]))) * (1.f / 128.f) + EPS); const float gr0 = bflo(grw[cc]), gr1 = bfhi(grw[cc]); \
        *(unsigned*)(C.OA + (size_t)(b * SEQ + (n) * 64 + c_) * 1024 + 512 + h * 128 + 2 * lane) = pk2(o0 * rstd * g0 * (gr0 * sigmoidf_(gr0)), o1 * rstd * g1 * (gr1 * sigmoidf_(gr1))); } } while (0)
#pragma unroll 1
    for (int n = 0; n < SEQ / 64; ++n) {
        asm volatile("s_waitcnt vmcnt(0) lgkmcnt(0)" ::: "memory"); __syncthreads();
        if (n > 0) GL_ROWPASS(n - 1);
#pragma unroll
        for (int cc = 0; cc < 8; ++cc) grw[cc] = *(const unsigned*)(pbase + ((size_t)(n * 64 + 8 * wid + cc) * NPROJ + C_GR + h * 128 + 2 * lane) * 2);
        {
            bf16x8 xla[2];
#pragma unroll
            for (int ks = 0; ks < 2; ++ks) { const LAS unsigned char* a = lds + RAW_LA + (32 * ks + 8 * fq + qp) * 128 + (16 * t1 + 4 * pp) * 2; xla[ks] = cat44(vtr(a), vtr(a + 4 * 128)); }
            f32x4 Ga = (f32x4){0.f, 0.f, 0.f, 0.f}, Gb = Ga, GT = Ga;
#pragma unroll
            for (int ks = 0; ks < 2; ++ks) { Ga = MFMA16(xla[ks], ym[0][ks], Ga); Gb = MFMA16(xla[ks], ym[1][ks], Gb); GT = MFMA16(xla[ks], ones, GT); }
#pragma unroll
            for (int ci = 0; ci < 2; ++ci) {
                const int c_ = 16 * (ca + ci) + fr, dk0 = 16 * t1 + 4 * fq; const f32x4 G = ci ? Gb : Ga;
                const u32x2 qw = *(const LAS u32x2*)(lds + RAW_Q + c_ * 128 + dk0 * 2), kw = *(const LAS u32x2*)(lds + RAW_K + c_ * 128 + dk0 * 2);
                const float q4[4] = {bflo(qw.x), bfhi(qw.x), bflo(qw.y), bfhi(qw.y)}, k4[4] = {bflo(kw.x), bfhi(kw.x), bflo(kw.y), bfhi(kw.y)};
                float qs4[4], ks4[4], kd4[4];
#pragma unroll
                for (int r = 0; r < 4; ++r) { qs4[r] = q4[r] * __expf(G[r]); ks4[r] = k4[r] * __expf(-G[r]); kd4[r] = k4[r] * __expf(GT[r] - G[r]); }
                *(LAS u32x2*)(lds + QS + c_ * P + dk0 * 2) = (u32x2){pk2(qs4[0], qs4[1]), pk2(qs4[2], qs4[3])};
                *(LAS u32x2*)(lds + KS + c_ * P + dk0 * 2) = (u32x2){pk2(ks4[0], ks4[1]), pk2(ks4[2], ks4[3])};
                *(LAS u32x2*)(lds + KD + c_ * P + dk0 * 2) = (u32x2){pk2(kd4[0], kd4[1]), pk2(kd4[2], kd4[3])};
            }
            if (fr == 0 && (wid & 1) == 0) *(LAS f32x4*)(lds + GTL + (16 * t1 + 4 * fq) * 4) = GT;
        }
        LDS_WAIT(); __syncthreads();
        if (n + 1 < SEQ / 64) GL_DMA(n + 1);
        {
            const int ct = wid >> 1;
#pragma unroll
            for (int si = 0; si < 2; ++si) {
                const int st = 2 * (wid & 1) + si; f32x4 D = (f32x4){0.f, 0.f, 0.f, 0.f};
                if (st <= ct) {
#pragma unroll
                    for (int ks = 0; ks < 2; ++ks) { const bf16x8 X = *(const LAS bf16x8*)(lds + KS + (16 * st + fr) * P + (32 * ks + 8 * fq) * 2), Y = *(const LAS bf16x8*)(lds + QS + (16 * ct + fr) * P + (32 * ks + 8 * fq) * 2); D = MFMA16(X, Y, D); }
#pragma unroll
                    for (int r = 0; r < 4; ++r) if (16 * st + 4 * fq + r > 16 * ct + fr) D[r] = 0.f;
                }
                *(LAS u32x2*)(lds + AM + (16 * ct + fr) * P + (16 * st + 4 * fq) * 2) = (u32x2){pk2(D[0], D[1]), pk2(D[2], D[3])};
            }
        }
        LDS_WAIT(); __builtin_amdgcn_s_barrier(); asm volatile("" ::: "memory");
        {
            const unsigned vb = VB0 + (n & 1) * 16384;
            bf16x8 X1[2], X2[2];
#pragma unroll
            for (int ks = 0; ks < 2; ++ks) { X1[ks] = *(const LAS bf16x8*)(lds + ST + (16 * wid + fr) * P + (32 * ks + 8 * fq) * 2);
                const LAS unsigned char* a = lds + vb + (32 * ks + 8 * fq + qp) * 256 + (16 * wid + 4 * pp) * 2; X2[ks] = cat44(vtr(a), vtr(a + 4 * 256)); }
#pragma unroll
            for (int ct = 0; ct < 4; ++ct) { f32x4 o = (f32x4){0.f, 0.f, 0.f, 0.f};
#pragma unroll
                for (int ks = 0; ks < 2; ++ks) { const bf16x8 Y1 = *(const LAS bf16x8*)(lds + QS + (16 * ct + fr) * P + (32 * ks + 8 * fq) * 2), Y2 = *(const LAS bf16x8*)(lds + AM + (16 * ct + fr) * P + (32 * ks + 8 * fq) * 2);
                    o = MFMA16(X1[ks], Y1, o); o = MFMA16(X2[ks], Y2, o); }
                *(LAS f32x4*)(lds + OO + (16 * ct + fr) * PO + (16 * wid + 4 * fq) * 4) = o;
                float ss = (o[0] * o[0] + o[1] * o[1]) + (o[2] * o[2] + o[3] * o[3]); ss += __shfl_xor(ss, 16); ss += __shfl_xor(ss, 32);
                if (fq == 0) *(LAS float*)(lds + SSQ + (16 * ct + fr) * 32 + wid * 4) = ss; }
#pragma unroll
            for (int tt = 0; tt < 4; ++tt) { const f32x4 dl = *(const LAS f32x4*)(lds + GTL + (16 * tt + 4 * fq) * 4);
#pragma unroll
                for (int r = 0; r < 4; ++r) accS[tt][r] *= __expf(dl[r]);
#pragma unroll
                for (int ks = 0; ks < 2; ++ks) { const LAS unsigned char* a = lds + KD + (32 * ks + 8 * fq + qp) * P + (16 * tt + 4 * pp) * 2; accS[tt] = MFMA16(cat44(vtr(a), vtr(a + 4 * P)), X2[ks], accS[tt]); }
                *(LAS u32x2*)(lds + ST + (16 * wid + fr) * P + (16 * tt + 4 * fq) * 2) = (u32x2){pk2(accS[tt][0], accS[tt][1]), pk2(accS[tt][2], accS[tt][3])}; }
        }
    }
    asm volatile("s_waitcnt vmcnt(0) lgkmcnt(0)" ::: "memory"); __syncthreads();
    GL_ROWPASS(SEQ / 64 - 1);
    __syncthreads();
#undef GL_DMA
#undef GL_ROWPASS
}

__device__ __forceinline__ int crow(int r, int hi) { return (r & 3) + 8 * (r >> 2) + 4 * hi; }
#define MFMA32(a, b, c) __builtin_amdgcn_mfma_f32_32x32x16_bf16(a, b, c, 0, 0, 0)
constexpr int AT_BUF = 32768, AT_WSF = 3 * 32768, AT_Q = 3 * 32768 + 2048;
constexpr float AT_THR = 8.f;

__device__ __forceinline__ void attn_unit(const Ctx& C, int b, int h, int cp, float lam) {
    const int lane = C.lane, r32 = lane & 31, hi = lane >> 5, wid = C.wid, p = wid >> 2, sub = wid & 3;
    const int NT = 2 * cp + 2, qch = 2 * cp + (sub >> 1), my_nt = qch + 1;
    const int row0 = b * SEQ + cp * 128;
    const int qpos = cp * 128 + sub * 32 + r32;
    const float sl2 = exp2f(-2.f * (float)(h + 1)) * LOG2E;
    LAS unsigned char* lds = C.lds;
    LAS float* wsf = (LAS float*)(lds + AT_WSF) + wid * 64;
    const char* kbase = (const char*)(C.PROJ + (size_t)(b * SEQ) * NPROJ + h * 128);
    const unsigned koff = (unsigned)((lane * NPROJ + C_DK + wid * 8) * 2);
    const unsigned voff = (unsigned)(((16 * (wid & 3) + (lane >> 2)) * NPROJ + C_DV + (wid >> 2) * 32 + (lane & 3) * 8) * 2);
#define AT_DMA(t, bufo) do { const char* _tb = kbase + (size_t)(t) * 64 * NPROJ * 2; \
        glds16<0>(_tb, koff, lds_addr(lds + (bufo) + wid * 1024)); glds16<0>(_tb, koff + 128u, lds_addr(lds + (bufo) + 8192 + wid * 1024)); \
        glds16<0>(_tb, voff, lds_addr(lds + (bufo) + 16384 + (wid >> 2) * 4096 + (wid & 3) * 1024)); glds16<0>(_tb, voff + 128u, lds_addr(lds + (bufo) + 16384 + ((wid >> 2) + 2) * 4096 + (wid & 3) * 1024)); } while (0)
    bf16x8 qr[4];
    { const bf16* qp = C.PROJ + (size_t)(row0 + sub * 32 + r32) * NPROJ + C_DQ + h * 128 + p * 64 + hi * 8;
#pragma unroll
      for (int d0 = 0; d0 < 4; ++d0) qr[d0] = *(const bf16x8*)(qp + d0 * 16); }
    AT_DMA(0, 0); AT_DMA(1, AT_BUF);
    f32x16 o[4];
#pragma unroll
    for (int d0 = 0; d0 < 4; ++d0)
#pragma unroll
        for (int i = 0; i < 16; ++i) o[d0][i] = 0.f;
    float mhat = 0.f, lsum = 0.f;
    const unsigned kofs = (unsigned)(p * 8192 + hi * 1024 + r32 * 16);
    const unsigned vofs = (unsigned)(16384 + ((lane >> 4) & 1) * 32 + (lane & 3) * 8 + (4 * hi + ((lane & 15) >> 2)) * 64);
    asm volatile("s_waitcnt vmcnt(4)" ::: "memory"); __syncthreads();
    unsigned bufo = 0, bufn1 = AT_BUF, bufn2 = 2 * AT_BUF;
#pragma unroll 1
    for (int t = 0; t < NT; ++t) {
        PSTAMP(lds, 0);
        if (t + 2 < NT) AT_DMA(t + 2, bufn2);
        PSTAMP(lds, 1);
        if (t < my_nt) {
            const LAS unsigned char* kp = lds + bufo + kofs;
            const LAS unsigned char* vp = lds + bufo + vofs;
            bf16x8 kf[8];
#pragma unroll
            for (int d0 = 0; d0 < 4; ++d0) { kf[2 * d0] = *(const LAS bf16x8*)(kp + d0 * 2048); kf[2 * d0 + 1] = *(const LAS bf16x8*)(kp + d0 * 2048 + 512); }
            s16x4 va[8], vb[8];
#define AT_VRD(dst, k) do { _Pragma("unroll") for (int d0 = 0; d0 < 4; ++d0) { dst[2 * d0] = vtr(vp + d0 * 4096 + (k) * 1024); dst[2 * d0 + 1] = vtr(vp + d0 * 4096 + (k) * 1024 + 512); } } while (0)
#define AT_PV(src_, k) do { const bf16x8 pa_ = __builtin_bit_cast(bf16x8, pw[k]); __builtin_amdgcn_s_setprio(1); _Pragma("unroll") for (int d0 = 0; d0 < 4; ++d0) o[d0] = MFMA32(pa_, cat44(src_[2 * d0], src_[2 * d0 + 1]), o[d0]); __builtin_amdgcn_s_setprio(0); } while (0)
            AT_VRD(va, 0);
            __builtin_amdgcn_sched_barrier(0);
            f32x16 s0, s1;
            if (t == qch) {
#pragma unroll
                for (int i = 0; i < 16; ++i) { const int k0p = 64 * t + crow(i, hi), k1p = k0p + 32;
                    s0[i] = fmaf(sl2, (float)min(k0p, 2 * qpos - k0p), -mhat); s1[i] = fmaf(sl2, (float)min(k1p, 2 * qpos - k1p), -mhat); }
            } else {
                const float bsm = sl2 * (float)(64 * t + 4 * hi) - mhat;
#pragma unroll
                for (int i = 0; i < 16; ++i) { const float ci = (float)((i & 3) + 8 * (i >> 2)); s0[i] = fmaf(sl2, ci, bsm); s1[i] = fmaf(sl2, ci + 32.f, bsm); }
            }
            __builtin_amdgcn_s_setprio(1);
#pragma unroll
            for (int d0 = 0; d0 < 4; ++d0) { s0 = MFMA32(kf[2 * d0], qr[d0], s0); s1 = MFMA32(kf[2 * d0 + 1], qr[d0], s1); }
            __builtin_amdgcn_s_setprio(0);
            __builtin_amdgcn_sched_barrier(0);
            float rm = fmaxf(s0[0], s1[0]);
#pragma unroll
            for (int i = 1; i < 16; ++i) rm = fmaxf(rm, fmaxf(s0[i], s1[i]));
            { auto rr = __builtin_amdgcn_permlane32_swap(__float_as_uint(rm), __float_as_uint(rm), false, false); rm = fmaxf(__uint_as_float(rr[0]), __uint_as_float(rr[1])); }
            if (t == 0 || __any(rm > AT_THR)) {
                const float dl = (t == 0) ? rm : fmaxf(rm, 0.f); mhat += dl;
                if (t != 0) {
                    const float f = __builtin_amdgcn_exp2f(-dl); lsum *= f;
                    if (hi == 0) wsf[r32] = f;
                    LDS_WAIT();
#pragma unroll
                    for (int i = 0; i < 16; ++i) { const float fi = wsf[crow(i, hi)];
#pragma unroll
                        for (int d0 = 0; d0 < 4; ++d0) o[d0][i] *= fi; }
                }
#pragma unroll
                for (int i = 0; i < 16; ++i) { s0[i] -= dl; s1[i] -= dl; }
            }
            float ps = 0.f;
#pragma unroll
            for (int i = 0; i < 16; ++i) { s0[i] = __builtin_amdgcn_exp2f(s0[i]); s1[i] = __builtin_amdgcn_exp2f(s1[i]); ps += s0[i] + s1[i]; }
            lsum += ps;
            PSTAMP(lds, 2);
            u32x4 pw[4];
            pw[0] = (u32x4){pk2(s0[0], s0[1]), pk2(s0[2], s0[3]), pk2(s0[4], s0[5]), pk2(s0[6], s0[7])};
            pw[1] = (u32x4){pk2(s0[8], s0[9]), pk2(s0[10], s0[11]), pk2(s0[12], s0[13]), pk2(s0[14], s0[15])};
            pw[2] = (u32x4){pk2(s1[0], s1[1]), pk2(s1[2], s1[3]), pk2(s1[4], s1[5]), pk2(s1[6], s1[7])};
            pw[3] = (u32x4){pk2(s1[8], s1[9]), pk2(s1[10], s1[11]), pk2(s1[12], s1[13]), pk2(s1[14], s1[15])};
            __builtin_amdgcn_sched_barrier(0);
            AT_VRD(vb, 1); AT_PV(va, 0); __builtin_amdgcn_sched_barrier(0);
            AT_VRD(va, 2); AT_PV(vb, 1); __builtin_amdgcn_sched_barrier(0);
            AT_VRD(vb, 3); AT_PV(va, 2); __builtin_amdgcn_sched_barrier(0);
            AT_PV(vb, 3);
#undef AT_VRD
#undef AT_PV
        }
        PSTAMP(lds, 3);
        if (t + 2 < NT) asm volatile("s_waitcnt vmcnt(4) lgkmcnt(0)" ::: "memory"); else asm volatile("s_waitcnt vmcnt(0) lgkmcnt(0)" ::: "memory");
        PSTAMP(lds, 4);
        __builtin_amdgcn_s_barrier(); asm volatile("" ::: "memory");
        PSTAMP(lds, 5);
        { const unsigned tb = bufo; bufo = bufn1; bufn1 = bufn2; bufn2 = tb; }
    }
#undef AT_DMA
    lsum += __shfl_xor(lsum, 32);
    if (hi == 0) wsf[32 + r32] = lsum;
    LDS_WAIT();
    LAS float* X = (LAS float*)lds;
    if (p == 1) {
#pragma unroll
        for (int i = 0; i < 16; ++i) { const float sc = lam / wsf[32 + crow(i, hi)];
#pragma unroll
            for (int d0 = 0; d0 < 4; ++d0) X[(sub * 32 + crow(i, hi)) * 128 + d0 * 32 + r32] = o[d0][i] * sc; }
    }
    __syncthreads();
    if (p == 0) {
#pragma unroll
        for (int i = 0; i < 16; ++i) { const float sc = 1.f / wsf[32 + crow(i, hi)];
#pragma unroll
            for (int d0 = 0; d0 < 4; ++d0) { LAS float* xp = X + (sub * 32 + crow(i, hi)) * 128 + d0 * 32 + r32; *xp = o[d0][i] * sc - *xp; } }
    }
    __syncthreads();
    { const float g0 = C.diff_g[2 * lane], g1 = C.diff_g[2 * lane + 1];
#pragma unroll 4
      for (int qq = 0; qq < 16; ++qq) { const int q = wid * 16 + qq; const float y0 = X[q * 128 + 2 * lane], y1 = X[q * 128 + 2 * lane + 1];
          const float rstd = rsqrtf(wave_sum(y0 * y0 + y1 * y1) * (1.f / 128.f) + EPS) * 0.8f;
          *(unsigned*)(C.OA + (size_t)(row0 + q) * 1024 + h * 128 + 2 * lane) = pk2(y0 * rstd * g0, y1 * rstd * g1); } }
    __syncthreads();
}

__device__ __forceinline__ void attn_phase(const Ctx& C) {
    LAS float* lamp = (LAS float*)(C.lds + AT_Q) + 4;
    LAS int* qw = (LAS int*)(C.lds + AT_Q);
    if (C.tid < 64) {
        const float a = wave_sum(C.lq1[C.lane] * C.lk1[C.lane]), b2 = wave_sum(C.lq2[C.lane] * C.lk2[C.lane]);
        if (C.tid == 0) lamp[0] = __expf(a) - __expf(b2) + 0.2f;
    }
    __syncthreads();
    const float lam = lamp[0];
    for (;;) {
        if (C.tid == 0) qw[0] = (int)__hip_atomic_fetch_add(C.ctl + CW_QUEUE, 1u, RLX_AGENT);
        __syncthreads();
        const int item = __builtin_amdgcn_readfirstlane(qw[0]);
        __syncthreads();
        if (item >= 1024) break;
        const int bh = item & 63, cp = 15 - (item >> 6);
        attn_unit(C, bh >> 2, bh & 3, cp, lam);
    }
}

__device__ __forceinline__ void phase_router(const Ctx& C) {
    const int lane = C.lane, wid = C.wid, fr = lane & 15, fq = lane >> 4;
    LAS u32x4* WH = (LAS u32x4*)C.lds;
    LAS u32x4* WL = WH + 4096;
    LAS float* GS = (LAS float*)(C.lds + 131072);
    LAS float* SH = GS + 1024;
    LAS float* red = SH + 1024;
    LAS float* ssw = red + 8 * 16 * 32;
    LAS int* lcnt = (LAS int*)(ssw + 128);
    LAS int* lbase = lcnt + 32;
    LAS int* pend = lbase + 32;
    LAS float* cbl = (LAS float*)(pend + 512);
    for (int blk = C.bid; blk < NTOK / 128; blk += C.G) {
        const int b = blk >> 4; const float* md = C.mod + b * 6144;
        __syncthreads();
        for (int k = C.tid; k < DM; k += NTHREADS) { GS[k] = C.norm2_g[k] * (1.f + md[4096 + k]); SH[k] = md[3072 + k]; }
        if (C.tid < 32) lcnt[C.tid] = 0;
        pend[C.tid] = -1;
#pragma unroll 4
        for (int idx = C.tid; idx < 4096; idx += NTHREADS) { WH[idx] = C.wrf[idx]; WL[idx] = C.wrf[4096 + idx]; }
        f32x4 xaA[4], xbA[4]; u32x4 ywA[4];
#define RT_ISSUE(XA, XB, YW, row) do { _Pragma("unroll") for (int ks = 0; ks < 4; ++ks) { const size_t o_ = (size_t)(row) * DM + 128 * wid + 32 * ks + 8 * fq; \
            XA[ks] = *(const f32x4*)(C.x + o_); XB[ks] = *(const f32x4*)(C.x + o_ + 4); YW[ks] = *(const u32x4*)(C.Y1 + o_); } } while (0)
        RT_ISSUE(xaA, xbA, ywA, blk * 128 + fr);
        __syncthreads();
#define RT_MMA(av, ks) do { bf16x8 ah_, al_; split_bf16(av, ah_, al_); const int fi_ = ((wid * 4 + (ks)) * 2) * 64 + lane; \
            const bf16x8 wh0 = __builtin_bit_cast(bf16x8, WH[fi_]), wh1 = __builtin_bit_cast(bf16x8, WH[fi_ + 64]), wl0 = __builtin_bit_cast(bf16x8, WL[fi_]), wl1 = __builtin_bit_cast(bf16x8, WL[fi_ + 64]); \
            acc0 = MFMA16(ah_, wh0, acc0); acc0 = MFMA16(al_, wh0, acc0); acc0 = MFMA16(ah_, wl0, acc0); \
            acc1 = MFMA16(ah_, wh1, acc1); acc1 = MFMA16(al_, wh1, acc1); acc1 = MFMA16(ah_, wl1, acc1); } while (0)
        {
            f32x4 acc0 = (f32x4){0.f, 0.f, 0.f, 0.f}, acc1 = acc0;
#pragma unroll
            for (int ks = 0; ks < 4; ++ks) { const f32x4 sa = *(const LAS f32x4*)(SH + 128 * wid + 32 * ks + 8 * fq), sb = *(const LAS f32x4*)(SH + 128 * wid + 32 * ks + 8 * fq + 4);
                float av[8] = {sa[0], sa[1], sa[2], sa[3], sb[0], sb[1], sb[2], sb[3]}; RT_MMA(av, ks); }
            if (fq == 0) { red[(wid * 16) * 32 + fr] = acc0[0]; red[(wid * 16) * 32 + 16 + fr] = acc1[0]; }
            LDS_WAIT(); __syncthreads();
            if (C.tid < 32) { float t = C.b_router[C.tid];
#pragma unroll
                for (int w2 = 0; w2 < 8; ++w2) t += red[(w2 * 16) * 32 + C.tid];
                cbl[C.tid] = t; }
            LDS_WAIT(); __syncthreads();
        }
#define RT_TILE(XA, XB, YW, it) do { \
            int lane = C.lane; asm volatile("" : "+v"(lane)); const int fr = lane & 15, fq = lane >> 4;     \
            const int row0 = blk * 128 + (it) * 16; float x1[4][8]; \
            _Pragma("unroll") for (int ks = 0; ks < 4; ++ks) { \
                x1[ks][0] = XA[ks][0] + bflo(YW[ks].x); x1[ks][1] = XA[ks][1] + bfhi(YW[ks].x); x1[ks][2] = XA[ks][2] + bflo(YW[ks].y); x1[ks][3] = XA[ks][3] + bfhi(YW[ks].y); \
                x1[ks][4] = XB[ks][0] + bflo(YW[ks].z); x1[ks][5] = XB[ks][1] + bfhi(YW[ks].z); x1[ks][6] = XB[ks][2] + bflo(YW[ks].w); x1[ks][7] = XB[ks][3] + bfhi(YW[ks].w); } \
            __builtin_amdgcn_sched_barrier(0); if ((it) + 1 < 8) RT_ISSUE(XA, XB, YW, row0 + 16 + fr); __builtin_amdgcn_sched_barrier(0);                                     \
            f32x4 acc0 = (f32x4){0.f, 0.f, 0.f, 0.f}, acc1 = acc0; float ss = 0.f; \
            _Pragma("unroll") for (int ks = 0; ks < 4; ++ks) { \
                const f32x4 ga = *(const LAS f32x4*)(GS + 128 * wid + 32 * ks + 8 * fq), gb = *(const LAS f32x4*)(GS + 128 * wid + 32 * ks + 8 * fq + 4); float av[8]; \
                _Pragma("unroll") for (int j = 0; j < 8; ++j) { const float xv = x1[ks][j]; ss += xv * xv; av[j] = xv * (j < 4 ? ga[j] : gb[j - 4]); } \
                RT_MMA(av, ks); __builtin_amdgcn_sched_barrier(0); } \
            ss += __shfl_xor(ss, 16); ss += __shfl_xor(ss, 32); \
            if (fq == 0) ssw[wid * 16 + fr] = ss; \
            _Pragma("unroll") for (int r = 0; r < 4; ++r) { red[(wid * 16 + 4 * fq + r) * 32 + fr] = acc0[r]; red[(wid * 16 + 4 * fq + r) * 32 + 16 + fr] = acc1[r]; } \
            LDS_WAIT(); __syncthreads(); __builtin_amdgcn_sched_barrier(0); \
            {     \
                const int r = 2 * wid + (lane >> 5), e = lane & 31; float sum = 0.f, sq = 0.f; \
                _Pragma("unroll") for (int w2 = 0; w2 < 8; ++w2) { sum += red[(w2 * 16 + r) * 32 + e]; sq += ssw[w2 * 16 + r]; } \
                const float val = rsqrtf(sq * (1.f / DM) + EPS) * sum + cbl[e]; \
                LAS float* lgr = red + (2 * wid + (lane >> 5)) * 32; lgr[e] = val; LDS_WAIT();            \
                int rank = 0; \
                _Pragma("unroll") for (int e4 = 0; e4 < 8; ++e4) { const f32x4 o4 = *(const LAS f32x4*)(lgr + 4 * e4); \
                    _Pragma("unroll") for (int j = 0; j < 4; ++j) rank += (o4[j] > val || (o4[j] == val && (4 * e4 + j) < e)) ? 1 : 0; } \
                LAS float* slr = red + (16 + 2 * wid + (lane >> 5)) * 32;                                   \
                if (rank < 4) slr[rank] = val; \
                LDS_WAIT(); \
                const f32x4 tv = *(const LAS f32x4*)slr; \
                const float e1 = __expf(tv[1] - tv[0]), e2 = __expf(tv[2] - tv[0]), e3 = __expf(tv[3] - tv[0]); const float inv = 1.f / (1.f + e1 + e2 + e3); \
                if (rank < 4) { const int row = row0 + r; const float wgt = (rank == 0 ? 1.f : (rank == 1 ? e1 : (rank == 2 ? e2 : e3))) * inv; \
                    C.topw[(size_t)row * 4 + rank] = wgt; C.tope[(size_t)row * 4 + rank] = e; \
                    const int slot = atomicAdd((int*)(lcnt + e), 1); pend[((it) * 16 + r) * 4 + rank] = (e << 16) | slot; } \
            } \
            __builtin_amdgcn_sched_barrier(0); \
            {     \
                float sq = 0.f; _Pragma("unroll") for (int w2 = 0; w2 < 8; ++w2) sq += ssw[w2 * 16 + fr]; \
                const float rstd = rsqrtf(sq * (1.f / DM) + EPS); \
                _Pragma("unroll") for (int ks = 0; ks < 4; ++ks) { const int k0 = 128 * wid + 32 * ks + 8 * fq; \
                    const f32x4 ga = *(const LAS f32x4*)(GS + k0), gb = *(const LAS f32x4*)(GS + k0 + 4), sa = *(const LAS f32x4*)(SH + k0), sb = *(const LAS f32x4*)(SH + k0 + 4); float hv[8]; \
                    _Pragma("unroll") for (int j = 0; j < 8; ++j) hv[j] = __builtin_amdgcn_fmed3f((x1[ks][j] * rstd * (j < 4 ? ga[j] : gb[j - 4]) + (j < 4 ? sa[j] : sb[j - 4])) * F8_ASCALE, -440.f, 440.f); \
                    *(u32x2*)((unsigned char*)C.H2 + (size_t)(row0 + fr) * DM + k0) = (u32x2){pk4_fp8(hv[0], hv[1], hv[2], hv[3]), pk4_fp8(hv[4], hv[5], hv[6], hv[7])}; __builtin_amdgcn_sched_barrier(0); } \
            } \
            LDS_WAIT(); __syncthreads(); } while (0)
#pragma unroll 1
        for (int it = 0; it < 8; ++it) { RT_TILE(xaA, xbA, ywA, it); }
#undef RT_TILE
#undef RT_MMA
#undef RT_ISSUE
        if (C.tid < 32) lbase[C.tid] = (int)__hip_atomic_fetch_add(C.ctl + CW_CNT + 64 * C.tid, (unsigned)lcnt[C.tid], RLX_AGENT);
        __syncthreads();
        { const int pv = pend[C.tid]; if (pv >= 0) { const int e = pv >> 16, slot = pv & 0xffff; C.list[e * NTOK + lbase[e] + slot] = (blk * 128 + (C.tid >> 2)) * 4 + (C.tid & 3); } }
    }
}

__device__ __forceinline__ void phase_final(const Ctx& C) {
    const int gw = C.bid * NWAVES + C.wid, NGW = C.G * NWAVES;
    for (int r0 = gw * 16; r0 < NTOK; r0 += NGW * 16) {
        const int b = r0 >> 11; const float* gt2p = C.mod + b * 6144 + 5120;
        f32x4 gt2[4], fg[4];
#pragma unroll
        for (int j = 0; j < 4; ++j) { const int c0 = 4 * C.lane + 256 * j; gt2[j] = *(const f32x4*)(gt2p + c0); fg[j] = *(const f32x4*)(C.final_g + c0); }
#pragma unroll 1
        for (int rr = 0; rr < 16; ++rr) {
            const int row = r0 + rr;
            const f32x4 w = *(const f32x4*)(C.topw + (size_t)row * 4) * (1.f / F8_YSCALE);
            f32x4 v[4]; float ss = 0.f;
#pragma unroll
            for (int j = 0; j < 4; ++j) { const int c0 = 4 * C.lane + 256 * j;
                f32x4 y = (f32x4){0.f, 0.f, 0.f, 0.f};
#pragma unroll
                for (int k = 0; k < 4; ++k) { const int yw = *(const int*)((const unsigned char*)C.YB + (size_t)(row * 4 + k) * DM + c0);
                    y = y + (f32x4){__builtin_amdgcn_cvt_f32_fp8(yw, 0), __builtin_amdgcn_cvt_f32_fp8(yw, 1), __builtin_amdgcn_cvt_f32_fp8(yw, 2), __builtin_amdgcn_cvt_f32_fp8(yw, 3)} * w[k]; }
                const u32x2 y1w = *(const u32x2*)(C.Y1 + (size_t)row * DM + c0);
                v[j] = *(const f32x4*)(C.x + (size_t)row * DM + c0) + (f32x4){bflo(y1w.x), bfhi(y1w.x), bflo(y1w.y), bfhi(y1w.y)} + gt2[j] * y;
                ss += (v[j][0] * v[j][0] + v[j][1] * v[j][1]) + (v[j][2] * v[j][2] + v[j][3] * v[j][3]); }
            const float rstd = rsqrtf(wave_sum(ss) * (1.f / DM) + EPS);
#pragma unroll
            for (int j = 0; j < 4; ++j) *(f32x4*)(C.out + (size_t)row * DM + 4 * C.lane + 256 * j) = v[j] * rstd * fg[j];
        }
    }
}

#ifndef PROBE_A
#define PROBE_A -1
#endif
#ifndef PROBE_B
#define PROBE_B -1
#endif
constexpr int CW_TS = 3072;
#define STAMP(k) do { if (PROBE_A >= 0 && blockIdx.x == 0 && threadIdx.x == 0) { const Ctx Cs = make_ctx(lds); ((unsigned long long*)(Cs.ctl + CW_TS))[k] = __builtin_amdgcn_s_memrealtime(); } } while (0)
struct Args { const float* in[25]; float* out; unsigned char* ws; };
typedef const Args __attribute__((address_space(4)))* KArgs;
__device__ __forceinline__ Ctx make_ctx(LAS unsigned char* lds) {
    KArgs a = (KArgs)__builtin_amdgcn_kernarg_segment_ptr();
    asm volatile("" : "+s"(a));
    Ctx C;
    C.lds = lds;
    C.tid = tid_fresh(); C.lane = C.tid & 63; C.wid = __builtin_amdgcn_readfirstlane(C.tid >> 6); C.G = gridDim.x; C.bid = blockIdx.x;
    C.x = a->in[0]; C.c = a->in[1]; C.w_ada = a->in[2]; C.b_ada = a->in[3]; C.norm1_g = a->in[4]; C.w_in = a->in[5];
    C.lq1 = a->in[6]; C.lk1 = a->in[7]; C.lq2 = a->in[8]; C.lk2 = a->in[9]; C.diff_g = a->in[10]; C.w_alpha_up = a->in[11]; C.b_alpha = a->in[12];
    C.gla_g = a->in[13]; C.w_bd = a->in[14]; C.w_bg = a->in[15]; C.w_out = a->in[16]; C.norm2_g = a->in[17]; C.w_router = a->in[18]; C.b_router = a->in[19];
    C.w_gu = a->in[20]; C.b_gu = a->in[21]; C.w_dn = a->in[22]; C.b_dn = a->in[23]; C.final_g = a->in[24];
    C.out = a->out;
    unsigned char* ws = a->ws;
    C.ctl = (unsigned*)(ws + WS_CTL); C.mod = (float*)(ws + WS_MOD); C.tope = (int*)(ws + WS_TOPE); C.topw = (float*)(ws + WS_TOPW); C.list = (int*)(ws + WS_LIST);
    C.WinT = (bf16*)(ws + WS_WIN); C.WbdT = (bf16*)(ws + WS_WBD); C.WbgT = (bf16*)(ws + WS_WBG); C.WoutT = (bf16*)(ws + WS_WOUT); C.WguT = (bf16*)(ws + WS_WGU); C.WdT = (bf16*)(ws + WS_WD);
    C.H = (bf16*)(ws + WS_H); C.H2 = (bf16*)(ws + WS_H2); C.OA = (bf16*)(ws + WS_OA); C.OB = (bf16*)(ws + WS_OB); C.MG = (bf16*)(ws + WS_MG); C.YB = (bf16*)(ws + WS_YB);
    C.PROJ = (bf16*)(ws + WS_PROJ); C.ACT = (bf16*)(ws + WS_ACT); C.Y1 = (bf16*)(ws + WS_Y1); C.cb = (float*)(ws + WS_CB); C.wrf = (u32x4*)(ws + WS_WRF);
    return C;
}
__global__ void __launch_bounds__(NTHREADS, 2) fwd_kernel(Args args) {
    extern __shared__ __attribute__((aligned(16))) unsigned char lds_raw[];
    LAS unsigned char* lds = (LAS unsigned char*)lds_raw;
    for (int u = threadIdx.x; u < (LDS_BYTES - LDSCTL_OFF) / 4; u += NTHREADS) ((LAS unsigned*)(lds + LDSCTL_OFF))[u] = 0u;
    __syncthreads();
    volatile LAS unsigned* MISC = (volatile LAS unsigned*)(lds + MISC_OFF);
    XcdBarrier bar;
    { const Ctx C = make_ctx(lds); bar = xcd_barrier_post(C.ctl + CW_BAR, MISC + 8); }
#define GRID_BAR() xcd_barrier(bar)
    STAMP(0);
#if PROBE_A >= 100
    if (blockIdx.x == 0 && threadIdx.x == 0) ((volatile LAS unsigned*)(lds + MISC_OFF))[15] = (unsigned)__builtin_amdgcn_s_memrealtime();
#endif

    { const Ctx C = make_ctx(lds); phase_mod(C); }
    GRID_BAR(); STAMP(1);
    { const Ctx C = make_ctx(lds); phase_prep(C); }
    GRID_BAR(); STAMP(2);
    { const Ctx C = make_ctx(lds); DenseDesc g{C.H, DM, C.WinT, DM}; TileOrder S; S.init(NTOK / 256, NPROJ / 256, C.G, C.bid); EpiProj E{C.PROJ, C.b_alpha}; gemm_phase<DenseDesc, TileOrder, EpiProj, true, false, 1>(C.lds, g, S, E); }
    GRID_BAR(); STAMP(3);
    { const Ctx C = make_ctx(lds); for (int s = C.bid; s < 64; s += C.G) gla_chunked(C, s >> 2, s & 3); }
    __syncthreads(); STAMP(12);
    { const Ctx C = make_ctx(lds); attn_phase(C); }
    GRID_BAR(); STAMP(4);
    { const Ctx C = make_ctx(lds); DenseDesc g{C.OA, DM, C.WbdT, DM}; TileOrder S; S.init(NTOK / 256, DM / 256, C.G, C.bid); EpiBranch E{C.MG, C.PROJ}; gemm_phase<DenseDesc, TileOrder, EpiBranch, true>(C.lds, g, S, E); }
    GRID_BAR(); STAMP(5);
    STAMP(6);
    { const Ctx C = make_ctx(lds); DenseDesc g{C.MG, DM, C.WoutT, DM}; TileOrder S; S.init(NTOK / 256, DM / 256, C.G, C.bid); EpiOut E{C.Y1, C.mod}; gemm_phase<DenseDesc, TileOrder, EpiOut, true>(C.lds, g, S, E); }
    GRID_BAR(); STAMP(7);
    { const Ctx C = make_ctx(lds); phase_router(C); }
    GRID_BAR(); STAMP(8);
    LAS int* tab = (LAS int*)(lds + STAGE_BYTES);
    __syncthreads();
    if (threadIdx.x == 0) { const Ctx C = make_ctx(lds); int ts = 0; for (int e = 0; e < NE; ++e) { const int cnt = (int)__hip_atomic_load(C.ctl + CW_CNT + 64 * e, RLX_AGENT); tab[e] = cnt; tab[32 + e] = ts; ts += (cnt + 255) >> 8; } tab[64] = ts; }
    __syncthreads();
    for (int tr = threadIdx.x; tr < tab[64]; tr += NTHREADS) { int e = 0; for (int k = 1; k < NE; ++k) if (tab[32 + k] <= tr) e = k; tab[65 + tr] = e; }
    __syncthreads();
    { const Ctx C = make_ctx(lds); const int T = tab[64]; MoeUpDesc g{(const unsigned char*)C.H2, C.list, (const unsigned char*)C.WguT, DM}; MoeOrder S; S.t.init(T, 8, C.G, C.bid, 4); S.tab = tab; EpiUp E{(unsigned char*)C.ACT, C.b_gu}; gemm_phase<MoeUpDesc, MoeOrder, EpiUp, true, true, 4>(C.lds, g, S, E); }
    GRID_BAR(); STAMP(9);
    { const Ctx C = make_ctx(lds); const int T = tab[64]; MoeDownDesc g{(const unsigned char*)C.ACT, (const unsigned char*)C.WdT, FF}; MoeOrder S; S.t.init(T, 4, C.G, C.bid); S.tab = tab; EpiDown E{(unsigned char*)C.YB, C.b_dn, C.list}; gemm_phase<MoeDownDesc, MoeOrder, EpiDown, true, true, 5>(C.lds, g, S, E); }
    GRID_BAR(); STAMP(10);
    { const Ctx C = make_ctx(lds); phase_final(C); }
#if PROBE_A >= 0
    GRID_BAR(); STAMP(11);
    if (blockIdx.x == 0 && threadIdx.x == 0) {
        const Ctx C = make_ctx(lds); const unsigned long long* ts = (const unsigned long long*)(C.ctl + CW_TS);
        asm volatile("s_waitcnt vmcnt(0)" ::: "memory");
        const unsigned long long dt = (PROBE_A >= 100) ? (unsigned long long)((volatile LAS unsigned*)(lds + MISC_OFF))[16 + (PROBE_A >= 100 ? PROBE_A - 100 : 0)] : ((PROBE_A == 12) ? ts[12] - ts[3] : ts[(PROBE_A < 12 ? PROBE_A : 0) + 1] - ts[PROBE_A < 12 ? PROBE_A : 0]), t0 = __builtin_amdgcn_s_memrealtime();
        while (__builtin_amdgcn_s_memrealtime() - t0 < 4ull * dt) __builtin_amdgcn_s_sleep(8);
    }
#endif
}

extern "C" void kernel_launch(void* const* d_in, const int* in_sizes, int n_in, void* d_out, int out_size, void* d_ws, size_t ws_size, hipStream_t stream) {
    static int grid = 0;
    if (grid == 0) {
        if (n_in != 25 || in_sizes[0] != NTOK * DM || out_size != NTOK * DM || ws_size < WS_END) {
            fprintf(stderr, "kernel_launch: unexpected shapes (n_in %d, in0 %d, out %d, ws %zu < %zu)\n", n_in, n_in > 0 ? in_sizes[0] : -1, out_size, ws_size, (size_t)WS_END); grid = -1; return; }
        int dev = 0, cus = 0;
        if (hipGetDevice(&dev) != hipSuccess || hipDeviceGetAttribute(&cus, hipDeviceAttributeMultiprocessorCount, dev) != hipSuccess) { grid = -1; return; }
        if (hipFuncSetAttribute((const void*)fwd_kernel, hipFuncAttributeMaxDynamicSharedMemorySize, LDS_BYTES) != hipSuccess) { fprintf(stderr, "kernel_launch: hipFuncSetAttribute failed\n"); grid = -1; return; }
        (void)hipGetLastError();
        grid = cus;
    }
    if (grid < 0) return;
    if (hipMemsetAsync((char*)d_ws + WS_CTL, 0, CTL_ZERO_BYTES, stream) != hipSuccess) { fprintf(stderr, "kernel_launch: memset failed\n"); return; }
    Args a{};
    for (int i = 0; i < 25; ++i) a.in[i] = (const float*)d_in[i];
    a.out = (float*)d_out; a.ws = (unsigned char*)d_ws;
    hipLaunchKernelGGL(fwd_kernel, dim3(grid), dim3(NTHREADS), LDS_BYTES, stream, a);
}
```

```cpp
#include <hip/hip_runtime.h>
#include <cstdio>
#include <cstdint>

#define GAS __attribute__((address_space(1)))
#define LAS __attribute__((address_space(3)))
typedef unsigned short bf16;
typedef short bf16x8 __attribute__((ext_vector_type(8)));
typedef float f32x4 __attribute__((ext_vector_type(4)));
typedef unsigned u32x4 __attribute__((ext_vector_type(4)));
typedef unsigned u32x2 __attribute__((ext_vector_type(2)));
typedef int i32x4 __attribute__((ext_vector_type(4)));
typedef GAS unsigned gu32;

constexpr int NB = 16, SEQ = 2048, DM = 1024, NTOK = NB * SEQ, NE = 32, FF = 1024;
constexpr int NPROJ = 5376;
constexpr int C_DQ = 0, C_DK = 512, C_DV = 1024, C_GQ = 1536, C_GK = 1792, C_GV = 2048, C_GR = 2560, C_GA = 3072, C_GB = 4096, C_AL = 5120;
constexpr int W_IN_N = 5136;
constexpr float LOG2E = 1.4426950408889634f;
constexpr float QSCALE = 0.125f * LOG2E;
constexpr float EPS = 1e-6f;
constexpr int NWAVES = 8, NTHREADS = 512;

constexpr size_t MiB = 1u << 20;
constexpr size_t WS_CTL = 0, CTL_ZERO_BYTES = 1 * MiB;
constexpr size_t WS_MOD = 1 * MiB;
constexpr size_t WS_TOPE = 2 * MiB;
constexpr size_t WS_TOPW = 3 * MiB;
constexpr size_t WS_LIST = 4 * MiB;
constexpr size_t WS_WIN = 8 * MiB;
constexpr size_t WS_WBD = 19 * MiB;
constexpr size_t WS_WBG = 20 * MiB;
constexpr size_t WS_WOUT = 21 * MiB;
constexpr size_t WS_WGU = 24 * MiB;
constexpr size_t WS_WD = 152 * MiB;
constexpr size_t WS_H2 = 216 * MiB;
constexpr size_t WS_RB = 280 * MiB;
constexpr size_t WS_H = WS_RB, WS_OA = WS_RB + 64 * MiB, WS_OB = WS_RB + 96 * MiB, WS_MG = WS_RB + 128 * MiB, WS_YB = WS_RB;
constexpr size_t WS_RA = 536 * MiB;
constexpr size_t WS_PROJ = WS_RA, WS_ACT = WS_RA;
constexpr size_t WS_Y1 = WS_RA + 272 * MiB;
constexpr size_t WS_CB = WS_MOD + 512 * 1024;
constexpr size_t WS_WRF = WS_MOD + 768 * 1024;
constexpr size_t WS_END = 872 * MiB;
constexpr int MAX_TILES = 544;
static_assert((size_t)MAX_TILES * 256 * 1024 * 2 <= 336 * MiB, "act fits region A");
constexpr int CW_CNT = 64;
constexpr int CW_BAR = 4096;
constexpr int CW_QUEUE = 2304;

constexpr int SCR_BYTES = 159744;
constexpr int LDSCTL_OFF = SCR_BYTES, MISC_OFF = LDSCTL_OFF + 320;
constexpr int LDS_BYTES = SCR_BYTES + 1024;

#define RLX_AGENT __ATOMIC_RELAXED, __HIP_MEMORY_SCOPE_AGENT
#define LDS_WAIT() asm volatile("s_waitcnt lgkmcnt(0)" ::: "memory")

__device__ __forceinline__ unsigned f2bf(float f) { unsigned u = __builtin_bit_cast(unsigned, f); return (u + 0x7fffu + ((u >> 16) & 1u)) >> 16; }
typedef __bf16 bf16n2 __attribute__((ext_vector_type(2)));
typedef float f32x2 __attribute__((ext_vector_type(2)));
__device__ __forceinline__ unsigned pk2(float lo, float hi) { return __builtin_bit_cast(unsigned, __builtin_convertvector((f32x2){lo, hi}, bf16n2)); }
__device__ __forceinline__ unsigned pk4_fp8(float a, float b, float c, float d) { int w = 0; w = __builtin_amdgcn_cvt_pk_fp8_f32(a, b, w, false); w = __builtin_amdgcn_cvt_pk_fp8_f32(c, d, w, true); return (unsigned)w; }
constexpr float F8_ASCALE = 4.f, F8_WSCALE = 512.f;
constexpr int F8_SA = 0x7d7d7d7d, F8_SW = 0x76767676;
__device__ __forceinline__ float bf2f(unsigned b) { return __uint_as_float(b << 16); }
__device__ __forceinline__ float bflo(unsigned w) { return __uint_as_float(w << 16); }
__device__ __forceinline__ float bfhi(unsigned w) { return __uint_as_float(w & 0xffff0000u); }
__device__ __forceinline__ float wave_sum(float v) {
#pragma unroll
    for (int o = 1; o < 64; o <<= 1) v += __shfl_xor(v, o);
    return v;
}
__device__ __forceinline__ int tid_fresh() { int t = threadIdx.x; asm volatile("" : "+v"(t)); return t; }
__device__ __forceinline__ float fexp(float x) { return __builtin_amdgcn_exp2f(x * 1.4426950408889634f); }
__device__ __forceinline__ float sigmoidf_(float x) { return __builtin_amdgcn_rcpf(1.f + fexp(-x)); }

#define XB_TMO      128
#define XB_XCNT(j)  (256  + 64 * (j))
#define XB_XSUB(j)  (1280 + 64 * (j))
#define XB_XGEN(j)  (2304 + 64 * (j))
#define XB_TOP      3328
#define XB_TOPGEN   3392
#define XCD_BAR_WORDS 3456
#define XB_SPIN_CAP (1u << 22)
__device__ __forceinline__ unsigned xb_ld(unsigned* p)              { return __hip_atomic_load(p, __ATOMIC_RELAXED, __HIP_MEMORY_SCOPE_AGENT); }
__device__ __forceinline__ unsigned xb_add(unsigned* p, unsigned v) { return __hip_atomic_fetch_add(p, v, __ATOMIC_RELAXED, __HIP_MEMORY_SCOPE_AGENT); }
__device__ __forceinline__ unsigned xb_xcc_id() { return (unsigned)__builtin_amdgcn_s_getreg((3 << 11) | 20) & 0xFu; }
#define XB_SPIN(cond, bar) do { unsigned _sp = 0; while (cond) { __builtin_amdgcn_s_sleep(1); \
    if ((++_sp & 255u) == 0u) { if (xb_ld(&(bar)[XB_TMO])) break; if (_sp > XB_SPIN_CAP) { atomicAdd(&(bar)[XB_TMO], 1u); break; } } } } while (0)
struct XcdBarrier { unsigned* bar; unsigned x; volatile LAS unsigned* st; };
__device__ __forceinline__ XcdBarrier xcd_barrier_post(unsigned* bar, volatile LAS unsigned* st) {
    XcdBarrier b; b.bar = bar; b.x = xb_xcc_id(); b.st = st;
    if (threadIdx.x == 0) (void)xb_add(&bar[XB_XCNT(b.x)], 1u);
    return b;
}
__device__ __forceinline__ void xcd_barrier_complete(unsigned* bar, unsigned x, unsigned& nloc, unsigned& nx) {
    const unsigned G = gridDim.x * gridDim.y * gridDim.z;
    unsigned sum, cnt, mine, sp = 0u;
    for (;;) {
        sum = 0u; cnt = 0u; mine = 0u;
#pragma unroll
        for (unsigned j = 0; j < 16; ++j) { const unsigned c = xb_ld(&bar[XB_XCNT(j)]); sum += c; cnt += (c > 0u) ? 1u : 0u; mine = (j == x) ? c : mine; }
        if (sum == G) break;
        __builtin_amdgcn_s_sleep(1);
        if ((++sp & 255u) == 0u) { if (xb_ld(&bar[XB_TMO])) break; if (sp > XB_SPIN_CAP) { atomicAdd(&bar[XB_TMO], 1u); break; } }
    }
    nloc = mine > 0u ? mine : 1u; nx = cnt > 0u ? cnt : 1u;
}
__device__ __forceinline__ void xcd_barrier(const XcdBarrier& b) {
    asm volatile("s_waitcnt vmcnt(0)" ::: "memory");
    __syncthreads();
    if (threadIdx.x == 0) {
        unsigned* bar = b.bar;
        __builtin_amdgcn_s_waitcnt(0);
        unsigned nloc = b.st[0], nx = b.st[1];
        if (nloc == 0u) { xcd_barrier_complete(bar, b.x, nloc, nx); b.st[0] = nloc; b.st[1] = nx; }
        const unsigned old = xb_add(&bar[XB_XSUB(b.x)], 1u);
        const unsigned gen = old / nloc;
        if (old + 1u == (gen + 1u) * nloc) {
            __builtin_amdgcn_fence(__ATOMIC_RELEASE, "agent");
            asm volatile("s_waitcnt vmcnt(0)" ::: "memory");
            const unsigned og = xb_add(&bar[XB_TOP], 1u);
            const unsigned tg = og / nx;
            if (og + 1u == (tg + 1u) * nx) xb_add(&bar[XB_TOPGEN], 1u);
            else XB_SPIN(xb_ld(&bar[XB_TOPGEN]) == tg, bar);
            __builtin_amdgcn_fence(__ATOMIC_ACQUIRE, "agent");
            xb_add(&bar[XB_XGEN(b.x)], 1u);
            asm volatile("s_waitcnt vmcnt(0)" ::: "memory");
        } else {
            XB_SPIN(xb_ld(&bar[XB_XGEN(b.x)]) == gen, bar);
            __builtin_amdgcn_fence(__ATOMIC_ACQUIRE, "agent");
            asm volatile("s_waitcnt vmcnt(0)" ::: "memory");
        }
    }
    __syncthreads();
}

struct Ctx {
    LAS unsigned char* lds;
    int tid, lane, wid, G, bid;
    const float *x, *c, *w_ada, *b_ada, *norm1_g, *w_in, *lq1, *lk1, *lq2, *lk2, *diff_g, *w_alpha_up, *b_alpha, *gla_g,
                *w_bd, *w_bg, *w_out, *norm2_g, *w_router, *b_router, *w_gu, *b_gu, *w_dn, *b_dn, *final_g;
    float* out;
    unsigned* ctl; float* mod; int* tope; float* topw; int* list;
    bf16 *WinT, *WbdT, *WbgT, *WoutT, *WguT, *WdT, *H, *H2, *OA, *OB, *MG, *YB, *PROJ, *ACT, *Y1; float* cb; u32x4* wrf;
};

constexpr int NXCD = 8, WGM = 8;
__host__ __device__ __forceinline__ int perm32(int rho) { const int n = rho >> 4, i = rho & 15; return 8 * (i >> 2) + 4 * n + (i & 3); }
struct Unit { int pm, pn, e, row0, cnt; };
struct TileOrder {
    int nM, nN, nwg, G, c, wgm;
    __device__ __forceinline__ void init(int nM_, int nN_, int G_, int c_, int wgm_ = WGM) { nM = nM_; nN = nN_; nwg = nM * nN; G = G_; c = c_; wgm = wgm_; }
    __device__ __forceinline__ bool next(int i, Unit& u) const {
        const long L = (long)i * G + c; if (L >= nwg) return false;
        int wgid = (int)L; { const int q = nwg / NXCD, r = nwg % NXCD, xcd = wgid % NXCD, off = wgid / NXCD; wgid = (xcd < r ? xcd * (q + 1) : r * (q + 1) + (xcd - r) * q) + off; }
        const int nig = wgm * nN, gid = wgid / nig, fm = gid * wgm, gsz = (nM - fm) < wgm ? (nM - fm) : wgm;
        u.pm = fm + ((wgid % nig) % gsz); u.pn = (wgid % nig) / gsz; u.e = 0; u.row0 = 0; u.cnt = 0; return true;
    }
};
struct MoeOrder {
    TileOrder t; LAS const int* tab;
    __device__ __forceinline__ bool next(int i, Unit& u) const {
        if (!t.next(i, u)) return false;
        const int e = tab[65 + u.pm];
        u.e = e; u.row0 = (u.pm - tab[32 + e]) * 256; u.cnt = tab[e]; return true;
    }
};
struct DenseDesc {
    static constexpr bool GATHER = false;
    const bf16* A; int lda; const bf16* Bt; int K;
    __device__ __forceinline__ unsigned a_off(const Unit& u, int r) const { return (unsigned)((u.pm * 256 + r) * lda) * 2u; }
    __device__ __forceinline__ const char* a_base(const Unit&) const { return (const char*)A; }
    __device__ __forceinline__ const char* b_base(const Unit& u) const { return (const char*)Bt + (size_t)u.pn * 256 * K * 2; }
};
struct MoeUpDesc {
    static constexpr bool GATHER = true;
    const unsigned char* H2; const int* list; const unsigned char* WguT; int K;
    __device__ __forceinline__ const int* id_src(const Unit& u, int j) const { const int s = u.row0 + j; return list + (size_t)u.e * NTOK + (s < NTOK ? s : NTOK - 1); }
    __device__ __forceinline__ unsigned a_off(const Unit& u, int r) const { const int slot = u.row0 + r; int tok = 0; if (slot < u.cnt) tok = list[u.e * NTOK + slot] >> 2; return (unsigned)tok * 1024u; }
    __device__ __forceinline__ const char* a_base(const Unit&) const { return (const char*)H2; }
    __device__ __forceinline__ const char* b_base(const Unit& u) const { return (const char*)WguT + ((size_t)u.e * 2048 + (size_t)u.pn * 256) * 1024; }
};
struct MoeDownDesc {
    static constexpr bool GATHER = false;
    const unsigned char* ACT; const unsigned char* WdT; int K;
    __device__ __forceinline__ unsigned a_off(const Unit& u, int r) const { return (unsigned)(u.pm * 256 + r) * 1024u; }
    __device__ __forceinline__ const char* a_base(const Unit&) const { return (const char*)ACT; }
    __device__ __forceinline__ const char* b_base(const Unit& u) const { return (const char*)WdT + ((size_t)u.e * 1024 + (size_t)u.pn * 256) * 1024; }
};

template <class Desc, class Order, class Epi>
__device__ __forceinline__ void gemm_simple(const Desc& g, const Order& S, const Epi& E) {
    const int tid = threadIdx.x, wid = __builtin_amdgcn_readfirstlane(tid >> 6), lane = tid & 63, wr = wid >> 2, wc = wid & 3, fr = lane & 15, fq = lane >> 4;
    const int K = g.K;
    Unit u;
    for (int i = 0; S.next(i, u); ++i) {
        f32x4 acc[2][2][4][2];
#pragma unroll
        for (int a = 0; a < 2; ++a)
#pragma unroll
            for (int b = 0; b < 2; ++b)
#pragma unroll
                for (int m = 0; m < 4; ++m)
#pragma unroll
                    for (int n = 0; n < 2; ++n) acc[a][b][m][n] = (f32x4){0.f, 0.f, 0.f, 0.f};
        unsigned aoff[2][4], boff[2][2];
#pragma unroll
        for (int a = 0; a < 2; ++a)
#pragma unroll
            for (int m = 0; m < 4; ++m) aoff[a][m] = g.a_off(u, a * 128 + wr * 64 + m * 16 + fr) + fq * 16;
#pragma unroll
        for (int b = 0; b < 2; ++b)
#pragma unroll
            for (int n = 0; n < 2; ++n) { const int nc = b * 128 + wc * 32 + (Epi::PERM ? perm32(n * 16 + fr) : (n * 16 + fr)); boff[b][n] = (unsigned)(nc * K) * 2u + fq * 16; }
        const char* ab = g.a_base(u); const char* bb = g.b_base(u);
#pragma unroll 1
        for (int ks = 0; ks < K / 32; ++ks) {
            bf16x8 af[2][4], bfr[2][2];
#pragma unroll
            for (int a = 0; a < 2; ++a)
#pragma unroll
                for (int m = 0; m < 4; ++m) af[a][m] = *(const bf16x8*)(ab + aoff[a][m] + ks * 64);
#pragma unroll
            for (int b = 0; b < 2; ++b)
#pragma unroll
                for (int n = 0; n < 2; ++n) bfr[b][n] = *(const bf16x8*)(bb + boff[b][n] + ks * 64);
#pragma unroll
            for (int a = 0; a < 2; ++a)
#pragma unroll
                for (int b = 0; b < 2; ++b)
#pragma unroll
                    for (int m = 0; m < 4; ++m)
#pragma unroll
                        for (int n = 0; n < 2; ++n) acc[a][b][m][n] = __builtin_amdgcn_mfma_f32_16x16x32_bf16(bfr[b][n], af[a][m], acc[a][b][m][n], 0, 0, 0);
        }
        E(acc, u, wr, wc, fr, fq);
    }
}


#ifndef PROBE_A
#define PROBE_A -1
#endif
#if PROBE_A >= 100
#define PSTAMP(ldsp, idx) do { if (blockIdx.x == 0 && threadIdx.x == 0) { volatile LAS unsigned* pm_ = (volatile LAS unsigned*)((ldsp) + MISC_OFF); const unsigned now_ = (unsigned)__builtin_amdgcn_s_memrealtime(); pm_[16 + (idx)] += now_ - pm_[15]; pm_[15] = now_; } } while (0)
#else
#define PSTAMP(ldsp, idx) do {} while (0)
#endif
constexpr int BK = 64, HALF = 128, HTB = HALF * BK * 2, STAGE_BYTES = 8 * HTB;
__host__ __device__ __forceinline__ int lds_byte(int r, int c) { const int st = (r >> 4) * 2 + (c >> 5), rr = r & 15, cc = c & 31, ob = rr * 64 + cc * 2; return st * 1024 + (ob ^ (((ob >> 9) & 1) << 5)); }
__host__ __device__ __forceinline__ void stage_rc(int b, int& R, int& C) { const int st = b / 1024, sb = b % 1024, swz = sb ^ (((sb >> 9) & 1) << 5); R = (st >> 1) * 16 + swz / 64; C = (st & 1) * 32 + (swz % 64) / 2; }

typedef int v8i32 __attribute__((ext_vector_type(8)));
__device__ __forceinline__ v8i32 cat88(bf16x8 lo, bf16x8 hi) { const i32x4 a = __builtin_bit_cast(i32x4, lo), b = __builtin_bit_cast(i32x4, hi); return (v8i32){a[0], a[1], a[2], a[3], b[0], b[1], b[2], b[3]}; }
template <class Desc, class Order, class Epi, bool ALIGN_EPI, bool FP8 = false, int PID = 0>
__device__ __forceinline__ void gemm_phase(LAS unsigned char* lds, const Desc& g, const Order& S, const Epi& E) {
    const int tid = tid_fresh(), wid = __builtin_amdgcn_readfirstlane(tid >> 6), lane = tid & 63, wr = wid >> 2, wc = wid & 3, fr = lane & 15, fq = lane >> 4;
    const int KBy = FP8 ? g.K : 2 * g.K, nt = KBy / 128;
    int Rs[2], Cs[2]; unsigned voffB[2];
#pragma unroll
    for (int i = 0; i < 2; ++i) { stage_rc(tid * 16 + i * 8192, Rs[i], Cs[i]); const int Rb = 64 * (Rs[i] >> 5) + perm32(Rs[i] & 31); voffB[i] = (unsigned)(Rb * KBy + Cs[i] * 2); }
    unsigned vA[2][2];
    LAS u32x4* const vslot = (LAS u32x4*)(lds + STAGE_BYTES + 4096) + tid;
    const size_t kstep = (size_t)(BK * 2);
    const size_t hstepB = (size_t)32 * KBy;
    const unsigned ldsw = (unsigned)wid * 1024u;
    const int aoff = FP8 ? lds_byte(wr * 64 + fr, fq * 16) : lds_byte(wr * 64 + fr, fq * 8), boff = FP8 ? lds_byte(wc * 32 + fr, fq * 16) : lds_byte(wc * 32 + fr, fq * 8);
    constexpr int KSTR = FP8 ? 16 : 1024;
#define PG8_SA(b, h) (((b) * 2 + (h)) * HTB)
#define PG8_SB(b, h) ((4 + (b) * 2 + (h)) * HTB)
#define PG8_STAGE(bufoff, gbase, voff) do { _Pragma("unroll") for (int _i = 0; _i < 2; ++_i) \
        __builtin_amdgcn_global_load_lds((const unsigned*)((const char*)(gbase) + (voff)[_i]), (LAS unsigned*)(lds + (bufoff) + ldsw + _i * 8192), 16, 0, 0); } while (0)
#define PG8_STAGE_A(bufoff, gbase, h) do { _Pragma("unroll") for (int _i = 0; _i < 2; ++_i) \
        __builtin_amdgcn_global_load_lds((const unsigned*)((const char*)(gbase) + vA[h][_i]), (LAS unsigned*)(lds + (bufoff) + ldsw + _i * 8192), 16, 0, 0); } while (0)
#define PG8_LDA(dst, b, h) do { _Pragma("unroll") for (int m = 0; m < 4; ++m) _Pragma("unroll") for (int k = 0; k < 2; ++k) dst[m][k] = *(const LAS bf16x8*)(lds + PG8_SA(b, h) + aoff + m * 2048 + k * KSTR); } while (0)
#define PG8_LDB(dst, b, h) do { _Pragma("unroll") for (int n = 0; n < 2; ++n) _Pragma("unroll") for (int k = 0; k < 2; ++k) dst[n][k] = *(const LAS bf16x8*)(lds + PG8_SB(b, h) + boff + n * 2048 + k * KSTR); } while (0)
#define PG8_MMA(ai, bj, At, Bt) do { __builtin_amdgcn_s_setprio(1); _Pragma("unroll") for (int m = 0; m < 4; ++m) _Pragma("unroll") for (int n = 0; n < 2; ++n) { \
        if constexpr (FP8) { acc[ai][bj][m][n] = __builtin_amdgcn_mfma_scale_f32_16x16x128_f8f6f4(cat88(Bt[n][0], Bt[n][1]), cat88(At[m][0], At[m][1]), acc[ai][bj][m][n], 0, 0, 0, F8_SW, 0, F8_SA); } \
        else { _Pragma("unroll") for (int k = 0; k < 2; ++k) acc[ai][bj][m][n] = __builtin_amdgcn_mfma_f32_16x16x32_bf16(Bt[n][k], At[m][k], acc[ai][bj][m][n], 0, 0, 0); } } \
        __builtin_amdgcn_s_setprio(0); } while (0)
#define PG8_WAIT_V(n) asm volatile("s_waitcnt vmcnt(" #n ")" ::: "memory")
#define PG8_WAIT_L(n) asm volatile("s_waitcnt lgkmcnt(" #n ")" ::: "memory")
#define PG8_BAR __builtin_amdgcn_s_barrier()
#define PG8_SCHED __builtin_amdgcn_sched_barrier(0)
#define PG8_KBODY(t) do { \
            const bool last = (t == nt - 2); \
            const char* a1 = Ab + (size_t)(t + 1) * kstep; \
            const char* a2 = last ? Ab : Ab + (size_t)(t + 2) * kstep; const char* b2 = last ? nB : cB + (size_t)(t + 2) * kstep; \
            const char* a3 = a2 + kstep; const char* b3 = b2 + kstep; \
              \
            PG8_LDB(B0, 0, 0); PG8_LDB(B1, 0, 1); PG8_SCHED; PG8_LDA(At, 0, 0); PG8_STAGE_A(PG8_SA(1, 1), a1, 1); \
            if (last && has_next) { if constexpr (Desc::GATHER) { _Pragma("unroll") for (int _h = 0; _h < 2; ++_h) _Pragma("unroll") for (int _i = 0; _i < 2; ++_i) { const int _j = _h * HALF + Rs[_i]; const int _id = idbuf[((ui + 1) & 1) * 256 + _j]; vA[_h][_i] = ((nxt.row0 + _j < nxt.cnt) ? (unsigned)(_id >> 2) * 1024u : 0u) + (unsigned)Cs[_i] * 2u; } } else { const u32x4 vn = *vslot; vA[0][0] = vn.x; vA[0][1] = vn.y; vA[1][0] = vn.z; vA[1][1] = vn.w; } }     \
            PG8_WAIT_V(8); PG8_WAIT_L(0); PG8_BAR; PG8_MMA(0, 0, At, B0); PG8_MMA(0, 1, At, B1); PG8_BAR; PG8_SCHED; \
              \
            PG8_LDA(At, 0, 1); PG8_STAGE(PG8_SB(0, 0), b2, voffB); PG8_STAGE(PG8_SB(0, 1), b2 + hstepB, voffB); PG8_STAGE_A(PG8_SA(0, 0), a2, 0); \
            PG8_WAIT_V(8); PG8_WAIT_L(0); PG8_BAR; PG8_MMA(1, 0, At, B0); PG8_MMA(1, 1, At, B1); PG8_BAR; PG8_SCHED; \
              \
            PG8_LDB(B0, 1, 0); PG8_LDB(B1, 1, 1); PG8_SCHED; PG8_LDA(At, 1, 0); PG8_STAGE_A(PG8_SA(0, 1), a2, 1); \
            PG8_WAIT_V(8); PG8_WAIT_L(0); PG8_BAR; PG8_MMA(0, 0, At, B0); PG8_MMA(0, 1, At, B1); PG8_BAR; PG8_SCHED; \
              \
            PG8_LDA(At, 1, 1); PG8_STAGE(PG8_SB(1, 0), b3, voffB); PG8_STAGE(PG8_SB(1, 1), b3 + hstepB, voffB); PG8_STAGE_A(PG8_SA(1, 0), a3, 0); \
            PG8_WAIT_V(8); PG8_WAIT_L(0); PG8_BAR; PG8_MMA(1, 0, At, B0); PG8_MMA(1, 1, At, B1); PG8_BAR; PG8_SCHED; \
        } while (0)
#define PG8_AOFFS(dst, un) do { _Pragma("unroll") for (int _h = 0; _h < 2; ++_h) _Pragma("unroll") for (int _i = 0; _i < 2; ++_i) dst[_h][_i] = g.a_off(un, _h * HALF + Rs[_i]) + (unsigned)Cs[_i] * 2u; } while (0)
    Unit cur, nxt; int ui = 0;
    if (!S.next(0, cur)) return;
    LAS int* const idbuf = (LAS int*)(lds + STAGE_BYTES + 4096);
#define PG8_IDDMA(un, b) do { if (wid < 4) __builtin_amdgcn_global_load_lds((const unsigned*)g.id_src(un, 64 * wid + lane), (LAS unsigned*)(idbuf + (b) * 256 + 64 * wid), 4, 0, 0); } while (0)
    if constexpr (Desc::GATHER) { Unit u1; if (S.next(1, u1)) PG8_IDDMA(u1, 1); }
    f32x4 acc[2][2][4][2];
#pragma unroll
    for (int a = 0; a < 2; ++a)
#pragma unroll
        for (int b = 0; b < 2; ++b)
#pragma unroll
            for (int m = 0; m < 4; ++m)
#pragma unroll
                for (int n = 0; n < 2; ++n) acc[a][b][m][n] = (f32x4){0.f, 0.f, 0.f, 0.f};
    bf16x8 At[4][2], B0[2][2], B1[2][2];
    const char* const Ab = g.a_base(cur);
    const char* cB = g.b_base(cur);
    PG8_AOFFS(vA, cur);
    PG8_STAGE(PG8_SB(0, 0), cB, voffB); PG8_STAGE(PG8_SB(0, 1), cB + hstepB, voffB); PG8_STAGE_A(PG8_SA(0, 0), Ab, 0); PG8_STAGE_A(PG8_SA(0, 1), Ab, 1);
    if (wr == 1) PG8_BAR;
    PG8_WAIT_V(2); PG8_BAR;
    PG8_STAGE(PG8_SB(1, 0), cB + kstep, voffB); PG8_STAGE_A(PG8_SA(1, 0), Ab + kstep, 0); PG8_STAGE(PG8_SB(1, 1), cB + hstepB + kstep, voffB);
    PG8_WAIT_V(6); PG8_BAR;
    for (;;) {
        const bool has_next = S.next(ui + 1, nxt);
        const char* nB = has_next ? g.b_base(nxt) : cB;
        if constexpr (Desc::GATHER) { Unit u2; if (S.next(ui + 2, u2)) PG8_IDDMA(u2, ui & 1); }
        else if (has_next) { unsigned vn[2][2]; PG8_AOFFS(vn, nxt); *vslot = (u32x4){vn[0][0], vn[0][1], vn[1][0], vn[1][1]}; }
        PSTAMP(lds, 40 + PID);
        if constexpr (Epi::MIDK) {
            for (int t = 0; t < nt / 2; t += 2) PG8_KBODY(t);
            E.mid(acc, cur, wr, wc, fr, fq);
            for (int t = nt / 2; t < nt; t += 2) PG8_KBODY(t);
        } else {
            for (int t = 0; t < nt; t += 2) PG8_KBODY(t);
        }
        PSTAMP(lds, 20 + PID);
        if constexpr (ALIGN_EPI) { if (wr == 0) PG8_BAR; }
        E(acc, cur, wr, wc, fr, fq);
        PSTAMP(lds, 30 + PID);
        if (!has_next) break;
#pragma unroll
        for (int a = 0; a < 2; ++a)
#pragma unroll
            for (int b = 0; b < 2; ++b)
#pragma unroll
                for (int m = 0; m < 4; ++m)
#pragma unroll
                    for (int n = 0; n < 2; ++n) acc[a][b][m][n] = (f32x4){0.f, 0.f, 0.f, 0.f};
        cur = nxt; cB = nB; ++ui;
        if constexpr (ALIGN_EPI) { if (wr == 1) PG8_BAR; }
    }
    PG8_WAIT_V(0);
    if constexpr (!ALIGN_EPI) { if (wr == 0) PG8_BAR; }
    PG8_BAR;
#undef PG8_SA
#undef PG8_SB
#undef PG8_STAGE
#undef PG8_STAGE_A
#undef PG8_LDA
#undef PG8_LDB
#undef PG8_MMA
#undef PG8_WAIT_V
#undef PG8_WAIT_L
#undef PG8_BAR
#undef PG8_SCHED
#undef PG8_AOFFS
#undef PG8_KBODY
#undef PG8_IDDMA
}

__device__ __forceinline__ u32x4 pack8(const f32x4& v0, const f32x4& v1) { u32x4 w; w.x = pk2(v0[0], v0[1]); w.y = pk2(v0[2], v0[3]); w.z = pk2(v1[0], v1[1]); w.w = pk2(v1[2], v1[3]); return w; }
__device__ __forceinline__ void unpack8(const u32x4& w, f32x4& v0, f32x4& v1) { v0 = (f32x4){bflo(w.x), bfhi(w.x), bflo(w.y), bfhi(w.y)}; v1 = (f32x4){bflo(w.z), bfhi(w.z), bflo(w.w), bfhi(w.w)}; }
__device__ __forceinline__ float logsig16(float x) { return (fminf(x, 0.f) - log1pf(fexp(-fabsf(x)))) * (1.f / 16.f); }

__device__ __forceinline__ unsigned rot8(unsigned v) { return (unsigned)__builtin_amdgcn_update_dpp(0, (int)v, 0x128, 0xf, 0xf, false); }
__device__ __forceinline__ void pair_exchange(u32x4& a, u32x4& b, bool lo) {
    const u32x4 ra = (u32x4){rot8(a.x), rot8(a.y), rot8(a.z), rot8(a.w)}, rb = (u32x4){rot8(b.x), rot8(b.y), rot8(b.z), rot8(b.w)};
    const u32x4 na = lo ? a : rb, nb = lo ? ra : b; a = na; b = nb;
}
struct EpiProj {
    static constexpr bool PERM = true, MIDK = false;
    bf16* P; const float* b_alpha;
    __device__ __forceinline__ void operator()(const f32x4 (&acc)[2][2][4][2], const Unit& u, int wr, int wc, int fr, int fq) const {
        const int pn = u.pn; const int mode = (pn < 2) ? 1 : (pn == 6 ? 2 : (pn == 20 ? 3 : 0));
        const int cw = pn * 256 + wc * 64 + 8 * fq; const bool lo = fr < 8;
        f32x4 bb[2][2];
#pragma unroll
        for (int bj = 0; bj < 2; ++bj) { bb[bj][0] = (f32x4){0.f, 0.f, 0.f, 0.f}; bb[bj][1] = bb[bj][0];
            if (mode == 3) { bb[bj][0] = *(const f32x4*)(b_alpha + (cw + 32 * bj - C_AL)); bb[bj][1] = *(const f32x4*)(b_alpha + (cw + 32 * bj - C_AL) + 4); } }
#pragma unroll
        for (int ai = 0; ai < 2; ++ai)
#pragma unroll
            for (int m = 0; m < 4; ++m) {
                u32x4 w[2];
#pragma unroll
                for (int bj = 0; bj < 2; ++bj) {
                    f32x4 v0 = acc[ai][bj][m][0], v1 = acc[ai][bj][m][1];
                    if (mode == 1) { v0 = v0 * QSCALE; v1 = v1 * QSCALE; }
                    else if (mode == 2) { v0 = v0 * 0.125f; v1 = v1 * 0.125f; }
                    else if (mode == 3) {
#pragma unroll
                        for (int j = 0; j < 4; ++j) { v0[j] = logsig16(v0[j] + bb[bj][0][j]); v1[j] = logsig16(v1[j] + bb[bj][1][j]); } }
                    w[bj] = pack8(v0, v1);
                }
                pair_exchange(w[0], w[1], lo);
                const int rowA = u.pm * 256 + ai * 128 + wr * 64 + m * 16 + (fr & 7); const int cc = cw + 32 * (fr >> 3);
                __builtin_nontemporal_store(w[0], (u32x4*)(P + (size_t)rowA * NPROJ + cc));
                __builtin_nontemporal_store(w[1], (u32x4*)(P + (size_t)(rowA + 8) * NPROJ + cc));
            }
    }
};
struct EpiBranch {
    static constexpr bool PERM = true, MIDK = true;
    bf16* MG; const bf16* P;
    __device__ __forceinline__ void mid(f32x4 (&acc)[2][2][4][2], const Unit& u, int wr, int wc, int fr, int fq) const {
        const int cw = u.pn * 256 + wc * 64 + 8 * fq;
#pragma unroll
        for (int ai = 0; ai < 2; ++ai)
#pragma unroll
            for (int m = 0; m < 4; ++m) {
                const bf16* pr = P + (size_t)(u.pm * 256 + ai * 128 + wr * 64 + m * 16 + fr) * NPROJ + cw;
#pragma unroll
                for (int bj = 0; bj < 2; ++bj) {
                    const u32x4 gaw = __builtin_nontemporal_load((const u32x4*)(pr + C_GA + 32 * bj)), gbw = *(const u32x4*)(pr + C_GB + 32 * bj);
                    f32x4 a0, a1, b0, b1; unpack8(gaw, a0, a1); unpack8(gbw, b0, b1);
#pragma unroll
                    for (int j = 0; j < 4; ++j) {
                        acc[ai][bj][m][0][j] *= (1.f + fexp(-__builtin_amdgcn_fmed3f(b0[j], -30.f, 30.f))) * __builtin_amdgcn_rcpf(1.f + fexp(-a0[j]));
                        acc[ai][bj][m][1][j] *= (1.f + fexp(-__builtin_amdgcn_fmed3f(b1[j], -30.f, 30.f))) * __builtin_amdgcn_rcpf(1.f + fexp(-a1[j])); }
                }
                if (m & 1) asm volatile("" ::: "memory");
            }
    }
    __device__ __forceinline__ void operator()(const f32x4 (&acc)[2][2][4][2], const Unit& u, int wr, int wc, int fr, int fq) const {
        const int cw = u.pn * 256 + wc * 64 + 8 * fq; const bool lo = fr < 8;
#pragma unroll
        for (int ai = 0; ai < 2; ++ai)
#pragma unroll
            for (int m = 0; m < 4; ++m) {
                const int row = u.pm * 256 + ai * 128 + wr * 64 + m * 16 + fr;
                u32x4 w[2];
#pragma unroll
                for (int bj = 0; bj < 2; ++bj) {
                    const u32x4 gbw = __builtin_nontemporal_load((const u32x4*)(P + (size_t)row * NPROJ + C_GB + cw + 32 * bj));
                    f32x4 b0, b1; unpack8(gbw, b0, b1);
                    f32x4 v0 = acc[ai][bj][m][0], v1 = acc[ai][bj][m][1];
#pragma unroll
                    for (int j = 0; j < 4; ++j) { v0[j] *= __builtin_amdgcn_rcpf(1.f + fexp(-__builtin_amdgcn_fmed3f(b0[j], -30.f, 30.f))); v1[j] *= __builtin_amdgcn_rcpf(1.f + fexp(-__builtin_amdgcn_fmed3f(b1[j], -30.f, 30.f))); }
                    w[bj] = pack8(v0, v1);
                }
                pair_exchange(w[0], w[1], lo);
                const int rowA = u.pm * 256 + ai * 128 + wr * 64 + m * 16 + (fr & 7); const int cc = cw + 32 * (fr >> 3);
                *(u32x4*)(MG + (size_t)rowA * DM + cc) = w[0];
                *(u32x4*)(MG + (size_t)(rowA + 8) * DM + cc) = w[1];
            }
    }
};
struct EpiOut {
    static constexpr bool PERM = true, MIDK = false;
    bf16* Y1; const float* mod;
    __device__ __forceinline__ void operator()(const f32x4 (&acc)[2][2][4][2], const Unit& u, int wr, int wc, int fr, int fq) const {
        const int b = u.pm >> 3; const float* gt1 = mod + b * 6144 + 2048;
        const int cw = u.pn * 256 + wc * 64 + 8 * fq; const bool lo = fr < 8;
        f32x4 g[2][2];
#pragma unroll
        for (int bj = 0; bj < 2; ++bj) { g[bj][0] = *(const f32x4*)(gt1 + cw + 32 * bj); g[bj][1] = *(const f32x4*)(gt1 + cw + 32 * bj + 4); }
#pragma unroll
        for (int ai = 0; ai < 2; ++ai)
#pragma unroll
            for (int m = 0; m < 4; ++m) {
                u32x4 wa = pack8(acc[ai][0][m][0] * g[0][0], acc[ai][0][m][1] * g[0][1]), wb = pack8(acc[ai][1][m][0] * g[1][0], acc[ai][1][m][1] * g[1][1]);
                pair_exchange(wa, wb, lo);
                const int rowA = u.pm * 256 + ai * 128 + wr * 64 + m * 16 + (fr & 7); const int cc = cw + 32 * (fr >> 3);
                *(u32x4*)(Y1 + (size_t)rowA * DM + cc) = wa;
                *(u32x4*)(Y1 + (size_t)(rowA + 8) * DM + cc) = wb;
            }
    }
};
struct EpiUp {
    static constexpr bool PERM = true, MIDK = false;
    unsigned char* ACT; const float* b_gu;
    __device__ __forceinline__ void operator()(const f32x4 (&acc)[2][2][4][2], const Unit& u, int wr, int wc, int fr, int fq) const {
        const int f0 = u.pn * 128 + wc * 32 + 8 * fq;
        const float* bg = b_gu + (size_t)u.e * 2048 + f0; const float* bu = bg + 1024;
        const f32x4 bg0 = *(const f32x4*)bg, bg1 = *(const f32x4*)(bg + 4), bu0 = *(const f32x4*)bu, bu1 = *(const f32x4*)(bu + 4);
#pragma unroll
        for (int ai = 0; ai < 2; ++ai)
#pragma unroll
            for (int m = 0; m < 4; ++m) {
                const int r = ai * 128 + wr * 64 + m * 16 + fr;
                f32x4 g0 = acc[ai][0][m][0] + bg0, g1 = acc[ai][0][m][1] + bg1, u0 = acc[ai][1][m][0] + bu0, u1 = acc[ai][1][m][1] + bu1, a0, a1;
#pragma unroll
                for (int j = 0; j < 4; ++j) {
                    float gg = fminf(g0[j], 7.f), uu = fminf(fmaxf(u0[j], -7.f), 7.f); a0[j] = (uu + 1.f) * gg * sigmoidf_(1.702f * gg);
                    gg = fminf(g1[j], 7.f); uu = fminf(fmaxf(u1[j], -7.f), 7.f); a1[j] = (uu + 1.f) * gg * sigmoidf_(1.702f * gg); }
                *(u32x2*)(ACT + (size_t)(u.pm * 256 + r) * FF + f0) = (u32x2){pk4_fp8(a0[0] * F8_ASCALE, a0[1] * F8_ASCALE, a0[2] * F8_ASCALE, a0[3] * F8_ASCALE), pk4_fp8(a1[0] * F8_ASCALE, a1[1] * F8_ASCALE, a1[2] * F8_ASCALE, a1[3] * F8_ASCALE)};
            }
    }
};
constexpr float F8_YSCALE = 16.f;
__device__ __forceinline__ void pair_exchange2(u32x2& a, u32x2& b, bool lo) {
    const u32x2 ra = (u32x2){rot8(a.x), rot8(a.y)}, rb = (u32x2){rot8(b.x), rot8(b.y)};
    const u32x2 na = lo ? a : rb, nb = lo ? ra : b; a = na; b = nb;
}
struct EpiDown {
    static constexpr bool PERM = true, MIDK = false;
    unsigned char* YB; const float* b_dn; const int* list;
    __device__ __forceinline__ void operator()(const f32x4 (&acc)[2][2][4][2], const Unit& u, int wr, int wc, int fr, int fq) const {
        const int cw = u.pn * 256 + wc * 64 + 8 * fq; const bool lo = fr < 8;
        f32x4 bb[2][2];
#pragma unroll
        for (int bj = 0; bj < 2; ++bj) { const float* bp = b_dn + (size_t)u.e * DM + cw + 32 * bj; bb[bj][0] = *(const f32x4*)bp; bb[bj][1] = *(const f32x4*)(bp + 4); }
#pragma unroll
        for (int ai = 0; ai < 2; ++ai)
#pragma unroll
            for (int m = 0; m < 4; ++m) {
                const int slot = u.row0 + ai * 128 + wr * 64 + m * 16 + fr;
                const int aid = slot < u.cnt ? list[u.e * NTOK + slot] : -1;
                const int aidx = (int)rot8((unsigned)aid);
                u32x2 w[2];
#pragma unroll
                for (int bj = 0; bj < 2; ++bj) { f32x4 v0 = (acc[ai][bj][m][0] + bb[bj][0]) * F8_YSCALE, v1 = (acc[ai][bj][m][1] + bb[bj][1]) * F8_YSCALE;
#pragma unroll
                    for (int j = 0; j < 4; ++j) { v0[j] = __builtin_amdgcn_fmed3f(v0[j], -440.f, 440.f); v1[j] = __builtin_amdgcn_fmed3f(v1[j], -440.f, 440.f); }
                    w[bj] = (u32x2){pk4_fp8(v0[0], v0[1], v0[2], v0[3]), pk4_fp8(v1[0], v1[1], v1[2], v1[3])}; }
                pair_exchange2(w[0], w[1], lo);
                const int aidA = lo ? aid : aidx, aidB = lo ? aidx : aid;
                const int cc = cw + 32 * (fr >> 3);
                if (aidA >= 0) *(u32x2*)(YB + (size_t)aidA * DM + cc) = w[0];
                if (aidB >= 0) *(u32x2*)(YB + (size_t)aidB * DM + cc) = w[1];
            }
    }
};

__device__ __forceinline__ void split_bf16(const float (&v)[8], bf16x8& hi, bf16x8& lo) {
    const unsigned h0 = pk2(v[0], v[1]), h1 = pk2(v[2], v[3]), h2 = pk2(v[4], v[5]), h3 = pk2(v[6], v[7]);
    const u32x4 h = (u32x4){h0, h1, h2, h3};
    const u32x4 l = (u32x4){pk2(v[0] - bflo(h0), v[1] - bfhi(h0)), pk2(v[2] - bflo(h1), v[3] - bfhi(h1)), pk2(v[4] - bflo(h2), v[5] - bfhi(h2)), pk2(v[6] - bflo(h3), v[7] - bfhi(h3))};
    hi = __builtin_bit_cast(bf16x8, h); lo = __builtin_bit_cast(bf16x8, l);
}
constexpr int T_NITEMS = 16 * 80 + 2 * 8 * 16 + 16 * 16 + 32 * 16 * 32 + 32 * 16 * 16;
__device__ __forceinline__ void transposes(const Ctx& C, int i0, int i1, int w, int nw);
__device__ __forceinline__ void phase_mod(const Ctx& C) {
    LAS float* sc = (LAS float*)C.lds;
    LAS float* red = sc + 16 * 1024;
    for (int cb = C.bid; cb < 96; cb += C.G) {
        __syncthreads();
        for (int i = C.tid; i < 16 * 1024; i += NTHREADS) { const float v = C.c[i]; sc[i] = v / (1.f + fexp(-v)); }
        __syncthreads();
        const int cl = C.tid & 63, ks = C.tid >> 6, col = cb * 64 + cl;
        float acc[16];
#pragma unroll
        for (int b = 0; b < 16; ++b) acc[b] = 0.f;
#pragma unroll 2
        for (int k = ks * 128; k < ks * 128 + 128; k += 4) {
            const float w0 = __builtin_nontemporal_load(C.w_ada + (size_t)k * 6144 + col), w1 = __builtin_nontemporal_load(C.w_ada + (size_t)(k + 1) * 6144 + col), w2 = __builtin_nontemporal_load(C.w_ada + (size_t)(k + 2) * 6144 + col), w3 = __builtin_nontemporal_load(C.w_ada + (size_t)(k + 3) * 6144 + col);
#pragma unroll
            for (int b = 0; b < 16; ++b) { const f32x4 s4 = *(const LAS f32x4*)(sc + b * 1024 + k); acc[b] += (s4[0] * w0 + s4[1] * w1) + (s4[2] * w2 + s4[3] * w3); }
        }
#pragma unroll
        for (int b = 0; b < 16; ++b) red[(ks * 16 + b) * 64 + cl] = acc[b];
        __syncthreads();
        for (int o = C.tid; o < 1024; o += NTHREADS) {
            const int b = o >> 6, c2 = o & 63; float s = 0.f;
#pragma unroll
            for (int k2 = 0; k2 < 8; ++k2) s += red[(k2 * 16 + b) * 64 + c2];
            C.mod[b * 6144 + cb * 64 + c2] = s + C.b_ada[cb * 64 + c2];
        }
    }
    __syncthreads();
    { const int gw = C.bid * NWAVES + C.wid, NGW = C.G * NWAVES;
      if (C.G == 256) { constexpr int N1 = 11 * 2048; transposes(C, 0, N1, gw, NGW); if (C.bid >= 96) transposes(C, N1, T_NITEMS, gw - 96 * NWAVES, NGW - 96 * NWAVES); }
      else transposes(C, 0, T_NITEMS, gw, NGW); }
    for (int idx = C.bid * NTHREADS + C.tid; idx < 4096; idx += C.G * NTHREADS) {
        const int l2 = idx & 63, nt = (idx >> 6) & 1, ks = (idx >> 7) & 3, w2 = idx >> 9; float wv[8];
#pragma unroll
        for (int j = 0; j < 8; ++j) wv[j] = C.w_router[(size_t)(128 * w2 + 32 * ks + 8 * (l2 >> 4) + j) * NE + 16 * nt + (l2 & 15)];
        bf16x8 h8, l8; split_bf16(wv, h8, l8); C.wrf[idx] = __builtin_bit_cast(u32x4, h8); C.wrf[4096 + idx] = __builtin_bit_cast(u32x4, l8); }
    for (int gt = C.bid * NTHREADS + C.tid; gt < 256 * 512; gt += C.G * NTHREADS) {
        const int j = gt >> 9, k = (gt & 511) * 2;
        float s0 = 0.f, s1 = 0.f;
#pragma unroll
        for (int r = 0; r < 16; ++r) { const float wa = C.w_alpha_up[r * 256 + j]; s0 += C.w_in[(size_t)k * W_IN_N + 3072 + r] * wa; s1 += C.w_in[(size_t)(k + 1) * W_IN_N + 3072 + r] * wa; }
        *(unsigned*)(C.WinT + (size_t)(C_AL + j) * DM + k) = pk2(s0, s1);
    }
}

struct TItem { const float* src; unsigned char* dst; int srcN, pitch, hop, fp8; };
__device__ __forceinline__ TItem titem_decode(const Ctx& C, int it) {
    constexpr int I_IN = 16 * 80, I_BD = 8 * 16, I_OUT = 16 * 16, I_GU = 32 * 16 * 32;
    TItem t; t.hop = 0; t.fp8 = 0; int r = it;
    if (r < I_IN) { const int kb = r / 80, n0 = (r % 80) * 64; t.srcN = W_IN_N; t.pitch = DM * 2; t.src = C.w_in + (size_t)(kb * 64) * W_IN_N + (n0 < 3072 ? n0 : n0 + 16); t.dst = (unsigned char*)(C.WinT + (size_t)n0 * DM + kb * 64); return t; } r -= I_IN;
    if (r < I_BD) { t.srcN = DM; t.pitch = 2048; t.src = C.w_bd + (size_t)((r >> 4) * 64) * DM + (r & 15) * 64; t.dst = (unsigned char*)(C.WbdT + (size_t)((r & 15) * 64) * 1024 + (r >> 4) * 64); return t; } r -= I_BD;
    if (r < I_BD) { t.srcN = DM; t.pitch = 2048; t.src = C.w_bg + (size_t)((r >> 4) * 64) * DM + (r & 15) * 64; t.dst = (unsigned char*)(C.WbdT + (size_t)((r & 15) * 64) * 1024 + 512 + (r >> 4) * 64); return t; } r -= I_BD;
    if (r < I_OUT) { t.srcN = DM; t.pitch = DM * 2; t.src = C.w_out + (size_t)((r >> 4) * 64) * DM + (r & 15) * 64; t.dst = (unsigned char*)(C.WoutT + (size_t)((r & 15) * 64) * DM + (r >> 4) * 64); return t; } r -= I_OUT;
    if (r < I_GU) { const int e = r >> 9, rr = r & 511, kb = rr >> 5, n0 = (rr & 31) * 64; const int pn = n0 >> 8, wc = (n0 >> 6) & 3;
        t.srcN = 2048; t.pitch = 1024; t.fp8 = 1; t.hop = 1024 - 32; t.src = C.w_gu + (size_t)e * DM * 2048 + (size_t)(kb * 64) * 2048 + pn * 128 + wc * 32; t.dst = (unsigned char*)C.WguT + (size_t)e * 2048 * 1024 + (size_t)n0 * 1024 + kb * 64; return t; } r -= I_GU;
    { const int e = r >> 8, rr = r & 255, kb = rr >> 4, n0 = (rr & 15) * 64;
        t.srcN = DM; t.pitch = 1024; t.fp8 = 1; t.src = C.w_dn + (size_t)e * FF * DM + (size_t)(kb * 64) * DM + n0; t.dst = (unsigned char*)C.WdT + (size_t)e * DM * 1024 + (size_t)n0 * 1024 + kb * 64; return t; }
}
__device__ __forceinline__ void titem_load(const TItem& t, int lane, f32x4 (&v)[16]) {
#pragma unroll
    for (int i = 0; i < 16; ++i) v[i] = __builtin_nontemporal_load((const f32x4*)(t.src + (size_t)(4 * i + (lane >> 4)) * t.srcN + 4 * (lane & 15) + ((lane & 8) ? t.hop : 0)));
}
__device__ __forceinline__ void titem_store(const TItem& t, int lane, const f32x4 (&v)[16], LAS float* scr) {
#pragma unroll
    for (int i = 0; i < 16; ++i) { LAS float* p = scr + (4 * i + (lane >> 4)) * 65 + 4 * (lane & 15); p[0] = v[i][0]; p[1] = v[i][1]; p[2] = v[i][2]; p[3] = v[i][3]; }
    LDS_WAIT(); asm volatile("" ::: "memory");
    const int c = lane & 7;
#pragma unroll
    for (int j = 0; j < 8; ++j) { const int n = (lane >> 3) + 8 * j; const LAS float* s = scr + (8 * c) * 65 + n;
        if (t.fp8) { float w[8];
#pragma unroll
            for (int q = 0; q < 8; ++q) w[q] = __builtin_amdgcn_fmed3f(s[q * 65] * F8_WSCALE, -440.f, 440.f);
            __builtin_nontemporal_store((u32x2){pk4_fp8(w[0], w[1], w[2], w[3]), pk4_fp8(w[4], w[5], w[6], w[7])}, (u32x2*)(t.dst + (size_t)n * t.pitch + 8 * c)); }
        else { u32x4 o; o.x = pk2(s[0 * 65], s[1 * 65]); o.y = pk2(s[2 * 65], s[3 * 65]); o.z = pk2(s[4 * 65], s[5 * 65]); o.w = pk2(s[6 * 65], s[7 * 65]);
            *(u32x4*)(t.dst + (size_t)n * t.pitch + 16 * c) = o; } }
    LDS_WAIT(); asm volatile("" ::: "memory");
}
__device__ __forceinline__ void transposes(const Ctx& C, int i0, int i1, int w, int nw) {
    LAS float* scr = (LAS float*)(C.lds + C.wid * 16896);
    int it = i0 + w; if (it >= i1) return;
    TItem cur = titem_decode(C, it); f32x4 v[16]; titem_load(cur, C.lane, v);
    for (;;) {
        const int nit = it + nw; const bool more = nit < i1;
        TItem nxt = cur; f32x4 vn[16];
        if (more) { nxt = titem_decode(C, nit); titem_load(nxt, C.lane, vn); }
        titem_store(cur, C.lane, v, scr);
        if (!more) break;
        cur = nxt; it = nit;
#pragma unroll
        for (int i = 0; i < 16; ++i) v[i] = vn[i];
    }
}
__device__ __forceinline__ void phase_prep(const Ctx& C) {
    const int gw = C.bid * NWAVES + C.wid, NGW = C.G * NWAVES;
    for (int r0 = gw * 16; r0 < NTOK; r0 += NGW * 16) {
        const int b = r0 >> 11; const float* md = C.mod + b * 6144;
        f32x4 gs[4], sh[4];
#pragma unroll
        for (int j = 0; j < 4; ++j) { const int c0 = 4 * C.lane + 256 * j; gs[j] = *(const f32x4*)(C.norm1_g + c0) * (*(const f32x4*)(md + 1024 + c0) + 1.f); sh[j] = *(const f32x4*)(md + c0); }
#pragma unroll 1
        for (int rr = 0; rr < 16; rr += 2) {
            f32x4 v[2][4]; float ss[2] = {0.f, 0.f};
#pragma unroll
            for (int r = 0; r < 2; ++r)
#pragma unroll
                for (int j = 0; j < 4; ++j) v[r][j] = __builtin_nontemporal_load((const f32x4*)(C.x + (size_t)(r0 + rr + r) * DM + 4 * C.lane + 256 * j));
#pragma unroll
            for (int r = 0; r < 2; ++r)
#pragma unroll
                for (int j = 0; j < 4; ++j) ss[r] += (v[r][j][0] * v[r][j][0] + v[r][j][1] * v[r][j][1]) + (v[r][j][2] * v[r][j][2] + v[r][j][3] * v[r][j][3]);
#pragma unroll
            for (int r = 0; r < 2; ++r) { const float rstd = rsqrtf(wave_sum(ss[r]) * (1.f / DM) + EPS);
#pragma unroll
                for (int j = 0; j < 4; ++j) { const f32x4 y = v[r][j] * rstd * gs[j] + sh[j];
                    u32x2 o; o.x = pk2(y[0], y[1]); o.y = pk2(y[2], y[3]);
                    *(u32x2*)(C.H + (size_t)(r0 + rr + r) * DM + 4 * C.lane + 256 * j) = o; } }
        }
    }
}

__device__ __forceinline__ void gla_scan(const Ctx& C, int b, int h) {
    LAS float* qs = (LAS float*)C.lds;
    LAS float* ks = qs + 2048;
    LAS float* al = ks + 2048;
    LAS float* vs = al + 2048;
    LAS float* part = vs + 4096;
    const int dv = C.tid & 127, dkg = C.tid >> 7;
    float S[16];
#pragma unroll
    for (int j = 0; j < 16; ++j) S[j] = 0.f;
    const float gdv0 = C.gla_g[2 * C.lane], gdv1 = C.gla_g[2 * C.lane + 1];
    for (int ch = 0; ch < SEQ / 32; ++ch) {
        const int row0 = b * SEQ + ch * 32;
        __syncthreads();
        for (int i = C.tid; i < 32 * 64; i += NTHREADS) { const int t = i >> 6, d = i & 63; const bf16* pr = C.PROJ + (size_t)(row0 + t) * NPROJ;
            qs[i] = bf2f(pr[C_GQ + h * 64 + d]); ks[i] = bf2f(pr[C_GK + h * 64 + d]); al[i] = fexp(bf2f(pr[C_AL + h * 64 + d])); }
        for (int i = C.tid; i < 32 * 128; i += NTHREADS) { const int t = i >> 7, d = i & 127; vs[i] = bf2f(C.PROJ[(size_t)(row0 + t) * NPROJ + C_GV + h * 128 + d]); }
        __syncthreads();
#pragma unroll 2
        for (int t = 0; t < 32; ++t) {
            const float v = vs[t * 128 + dv]; float o = 0.f;
#pragma unroll
            for (int j4 = 0; j4 < 4; ++j4) {
                const f32x4 a4 = *(const LAS f32x4*)(al + t * 64 + dkg * 16 + j4 * 4), k4 = *(const LAS f32x4*)(ks + t * 64 + dkg * 16 + j4 * 4), q4 = *(const LAS f32x4*)(qs + t * 64 + dkg * 16 + j4 * 4);
#pragma unroll
                for (int jj = 0; jj < 4; ++jj) { const int j = j4 * 4 + jj; S[j] = a4[jj] * S[j] + k4[jj] * v; o += q4[jj] * S[j]; }
            }
            part[(dkg * 32 + t) * 128 + dv] = o;
        }
        __syncthreads();
#pragma unroll
        for (int tt = 0; tt < 4; ++tt) {
            const int t = 4 * C.wid + tt; float o0 = 0.f, o1 = 0.f;
#pragma unroll
            for (int g = 0; g < 4; ++g) { o0 += part[(g * 32 + t) * 128 + 2 * C.lane]; o1 += part[(g * 32 + t) * 128 + 2 * C.lane + 1]; }
            const float rstd = rsqrtf(wave_sum(o0 * o0 + o1 * o1) * (1.f / 128.f) + EPS);
            const unsigned grw = *(const unsigned*)(C.PROJ + (size_t)(row0 + t) * NPROJ + C_GR + h * 128 + 2 * C.lane);
            const float g0 = bflo(grw), g1 = bfhi(grw);
            const float y0 = o0 * rstd * gdv0 * (g0 * sigmoidf_(g0)), y1 = o1 * rstd * gdv1 * (g1 * sigmoidf_(g1));
            *(unsigned*)(C.OB + (size_t)(row0 + t) * 512 + h * 128 + 2 * C.lane) = pk2(y0, y1);
        }
    }
}

__device__ __forceinline__ void attn_simple(const Ctx& C) {
    LAS float* Kt = (LAS float*)C.lds;
    LAS float* Vt = Kt + 8192;
    LAS float* Ss = Vt + 8192;
    LAS float* ssq = Ss + 2 * 64 * 68;
    LAS float* lamp = ssq + 256;
    if (C.tid < 64) {
        const float a = wave_sum(C.lq1[C.lane] * C.lk1[C.lane]), b2 = wave_sum(C.lq2[C.lane] * C.lk2[C.lane]);
        if (C.tid == 0) lamp[0] = fexp(a) - fexp(b2) + 0.2f;
    }
    __syncthreads();
    const float lam = lamp[0];
    const int q = C.tid & 63, p = (C.tid >> 6) & 1, dq = C.tid >> 7;
    for (int uix = C.bid; uix < 2048; uix += C.G) {
        const int bh = uix & 63, g = (uix >> 6) & 3, i2 = uix >> 8; const int b = bh >> 2, h = bh & 3;
        const int qc = (i2 & 1) ? (31 - (4 * g + (i2 >> 1))) : (4 * g + (i2 >> 1));
        const float sl2 = exp2f(-2.f * (float)(h + 1)) * LOG2E;
        const int qrow = b * SEQ + qc * 64 + q;
        float qv[64];
#pragma unroll
        for (int d8 = 0; d8 < 8; ++d8) { const u32x4 w = *(const u32x4*)(C.PROJ + (size_t)qrow * NPROJ + C_DQ + h * 128 + p * 64 + d8 * 8);
            qv[d8 * 8 + 0] = bflo(w.x); qv[d8 * 8 + 1] = bfhi(w.x); qv[d8 * 8 + 2] = bflo(w.y); qv[d8 * 8 + 3] = bfhi(w.y);
            qv[d8 * 8 + 4] = bflo(w.z); qv[d8 * 8 + 5] = bfhi(w.z); qv[d8 * 8 + 6] = bflo(w.w); qv[d8 * 8 + 7] = bfhi(w.w); }
        float m = -1e30f, l = 0.f, acc[32];
#pragma unroll
        for (int d = 0; d < 32; ++d) acc[d] = 0.f;
        for (int kc = 0; kc <= qc; ++kc) {
            __syncthreads();
            for (int pi = C.tid; pi < 1024; pi += NTHREADS) { const int r = pi >> 4, cc = pi & 15; const bf16* pr = C.PROJ + (size_t)(b * SEQ + kc * 64 + r) * NPROJ + h * 128 + cc * 8;
                const u32x4 kw = *(const u32x4*)(pr + C_DK), vw = *(const u32x4*)(pr + C_DV); f32x4 a0, a1;
                unpack8(kw, a0, a1); *(LAS f32x4*)(Kt + r * 128 + cc * 8) = a0; *(LAS f32x4*)(Kt + r * 128 + cc * 8 + 4) = a1;
                unpack8(vw, a0, a1); *(LAS f32x4*)(Vt + r * 128 + cc * 8) = a0; *(LAS f32x4*)(Vt + r * 128 + cc * 8 + 4) = a1; }
            __syncthreads();
#pragma unroll 1
            for (int kk = 0; kk < 16; ++kk) {
                const int key = dq * 16 + kk; float s = 0.f;
#pragma unroll
                for (int d4 = 0; d4 < 16; ++d4) { const f32x4 kv = *(const LAS f32x4*)(Kt + key * 128 + p * 64 + d4 * 4);
                    s += qv[d4 * 4] * kv[0]; s += qv[d4 * 4 + 1] * kv[1]; s += qv[d4 * 4 + 2] * kv[2]; s += qv[d4 * 4 + 3] * kv[3]; }
                const int kpos = kc * 64 + key, qpos = qc * 64 + q; const int mn = kpos < 2 * qpos - kpos ? kpos : 2 * qpos - kpos;
                Ss[(p * 64 + q) * 68 + key] = s + sl2 * (float)mn;
            }
            __syncthreads();
            const LAS float* srow = Ss + (p * 64 + q) * 68;
            float cm = -1e30f;
#pragma unroll
            for (int k4 = 0; k4 < 16; ++k4) { const f32x4 sv = *(const LAS f32x4*)(srow + k4 * 4); cm = fmaxf(cm, fmaxf(fmaxf(sv[0], sv[1]), fmaxf(sv[2], sv[3]))); }
            const float mnew = fmaxf(m, cm), alpha = exp2f(m - mnew); m = mnew; l *= alpha;
#pragma unroll
            for (int d = 0; d < 32; ++d) acc[d] *= alpha;
#pragma unroll 2
            for (int key = 0; key < 64; ++key) {
                const float pk = exp2f(srow[key] - m); l += pk;
#pragma unroll
                for (int d4 = 0; d4 < 8; ++d4) { const f32x4 vv = *(const LAS f32x4*)(Vt + key * 128 + dq * 32 + d4 * 4);
                    acc[d4 * 4] += pk * vv[0]; acc[d4 * 4 + 1] += pk * vv[1]; acc[d4 * 4 + 2] += pk * vv[2]; acc[d4 * 4 + 3] += pk * vv[3]; }
            }
        }
        const float inv = 1.f / l;
        __syncthreads();
        LAS float* O2 = Ss;
        if (p == 1) {
#pragma unroll
            for (int d = 0; d < 32; ++d) O2[q * 128 + dq * 32 + d] = lam * acc[d] * inv;
        }
        __syncthreads();
        float ss = 0.f;
        if (p == 0) {
#pragma unroll
            for (int d = 0; d < 32; ++d) { acc[d] = acc[d] * inv - O2[q * 128 + dq * 32 + d]; ss += acc[d] * acc[d]; }
            ssq[q * 4 + dq] = ss;
        }
        __syncthreads();
        if (p == 0) {
            const float tot = (ssq[q * 4] + ssq[q * 4 + 1]) + (ssq[q * 4 + 2] + ssq[q * 4 + 3]);
            const float rstd = rsqrtf(tot * (1.f / 128.f) + EPS) * 0.8f;
            bf16* dst = C.OA + (size_t)qrow * 512 + h * 128 + dq * 32;
#pragma unroll
            for (int d8 = 0; d8 < 4; ++d8) { u32x4 w; const float* gg = C.diff_g + dq * 32 + d8 * 8;
                w.x = pk2(acc[d8 * 8] * rstd * gg[0], acc[d8 * 8 + 1] * rstd * gg[1]); w.y = pk2(acc[d8 * 8 + 2] * rstd * gg[2], acc[d8 * 8 + 3] * rstd * gg[3]);
                w.z = pk2(acc[d8 * 8 + 4] * rstd * gg[4], acc[d8 * 8 + 5] * rstd * gg[5]); w.w = pk2(acc[d8 * 8 + 6] * rstd * gg[6], acc[d8 * 8 + 7] * rstd * gg[7]);
                *(u32x4*)(dst + d8 * 8) = w; }
        }
    }
}


typedef float f32x16 __attribute__((ext_vector_type(16)));
typedef short s16x4 __attribute__((ext_vector_type(4)));
typedef short v4i16_t __attribute__((ext_vector_type(4)));
__device__ __forceinline__ s16x4 vtr(const LAS unsigned char* p) { return __builtin_bit_cast(s16x4, __builtin_amdgcn_ds_read_tr16_b64_v4i16((LAS v4i16_t*)p)); }
template <int OFF> __device__ __forceinline__ void glds16(const void* sbase, unsigned voff, unsigned lds_dst) {
    unsigned sv; asm volatile("s_mov_b32 %0, m0\n\ts_mov_b32 m0, %3\n\ts_nop 0\n\tglobal_load_lds_dwordx4 %1, %2 offset:%4\n\ts_mov_b32 m0, %0" : "=&s"(sv) : "v"(voff), "s"(sbase), "s"(lds_dst), "i"(OFF) : "memory"); }
__device__ __forceinline__ unsigned lds_addr(const LAS unsigned char* p) { return (unsigned)__builtin_amdgcn_readfirstlane((int)(unsigned)(size_t)p); }
#define MFMA16(a, b, c) __builtin_amdgcn_mfma_f32_16x16x32_bf16(a, b, c, 0, 0, 0)
__device__ __forceinline__ bf16x8 cat44(s16x4 lo, s16x4 hi) { return (bf16x8){lo[0], lo[1], lo[2], lo[3], hi[0], hi[1], hi[2], hi[3]}; }
__device__ __forceinline__ void gla_chunked(const Ctx& C, int b, int h) {
    const int lane = C.lane, wid = C.wid, fr = lane & 15, fq = lane >> 4;
    LAS unsigned char* lds = C.lds;
    constexpr int RAW_Q = 0, RAW_K = 8192, RAW_LA = 16384, VB0 = 24576, QS = 57344, KS = 66560, KD = 75776, AM = 84992, ST = 94208, OO = 112640, GTL = 146432, SSQ = 146688;
    constexpr int P = 144, PO = 528;
    const char* pbase = (const char*)(C.PROJ + (size_t)(b * SEQ) * NPROJ);
    const unsigned oq = (unsigned)(((8 * wid + (lane >> 3)) * NPROJ + C_GQ + h * 64 + (lane & 7) * 8) * 2);
    const unsigned okk = oq + (unsigned)((C_GK - C_GQ) * 2), ol = oq + (unsigned)((C_AL - C_GQ) * 2);
    const unsigned ov0 = (unsigned)(((4 * wid + (lane >> 4)) * NPROJ + C_GV + h * 128 + (lane & 15) * 8) * 2), ov1 = ov0 + (unsigned)(32 * NPROJ * 2);
#define GL_DMA(n) do { const char* _cb = pbase + (size_t)(n) * 64 * NPROJ * 2; const unsigned _vb = VB0 + ((n) & 1) * 16384; \
        glds16<0>(_cb, oq, lds_addr(lds + RAW_Q + wid * 1024)); glds16<0>(_cb, okk, lds_addr(lds + RAW_K + wid * 1024)); glds16<0>(_cb, ol, lds_addr(lds + RAW_LA + wid * 1024)); \
        glds16<0>(_cb, ov0, lds_addr(lds + _vb + wid * 1024)); glds16<0>(_cb, ov1, lds_addr(lds + _vb + (wid + 8) * 1024)); } while (0)
    __syncthreads();
    GL_DMA(0);
    for (int i = lane; i < 16 * P / 4; i += 64) ((LAS unsigned*)(lds + ST + wid * 16 * P))[i] = 0u;
    f32x4 accS[4];
#pragma unroll
    for (int t = 0; t < 4; ++t) accS[t] = (f32x4){0.f, 0.f, 0.f, 0.f};
    const int t1 = wid >> 1, ca = 2 * (wid & 1);
    bf16x8 ym[2][2];
#pragma unroll
    for (int ci = 0; ci < 2; ++ci)
#pragma unroll
        for (int ks = 0; ks < 2; ++ks)
#pragma unroll
            for (int jj = 0; jj < 8; ++jj) ym[ci][ks][jj] = (short)(((32 * ks + 8 * fq + jj) <= (16 * (ca + ci) + fr)) ? 0x3F80 : 0);
    const bf16x8 ones = (bf16x8){0x3F80, 0x3F80, 0x3F80, 0x3F80, 0x3F80, 0x3F80, 0x3F80, 0x3F80};
    const int qp = (lane & 15) >> 2, pp = lane & 3;
    const float g0 = C.gla_g[2 * lane], g1 = C.gla_g[2 * lane + 1];
    unsigned grw[8];
#pragma unroll
    for (int cc = 0; cc < 8; ++cc) grw[cc] = 0u;
#define GL_ROWPASS(n) do { _Pragma("unroll") for (int cc = 0; cc < 8; ++cc) { const int c_ = 8 * wid + cc; \
        const float o0 = *(const LAS float*)(lds + OO + c_ * PO + lane * 8), o1 = *(const LAS float*)(lds + OO + c_ * PO + lane * 8 + 4); \
        const f32x4 qa = *(const LAS f32x4*)(lds + SSQ + c_ * 32), qb = *(const LAS f32x4*)(lds + SSQ + c_ * 32 + 16); \
        const float rstd = rsqrtf((((qa[0] + qa[1]) + (qa[2] + qa[3])) + ((qb[0] + qb[1]) + (qb[2] + qb[3]))) * (1.f / 128.f) + EPS); const float gr0 = bflo(grw[cc]), gr1 = bfhi(grw[cc]); \
        *(unsigned*)(C.OA + (size_t)(b * SEQ + (n) * 64 + c_) * 1024 + 512 + h * 128 + 2 * lane) = pk2(o0 * rstd * g0 * (gr0 * sigmoidf_(gr0)), o1 * rstd * g1 * (gr1 * sigmoidf_(gr1))); } } while (0)
#pragma unroll 1
    for (int n = 0; n < SEQ / 64; ++n) {
        asm volatile("s_waitcnt vmcnt(0) lgkmcnt(0)" ::: "memory"); __syncthreads();
        if (n > 0) GL_ROWPASS(n - 1);
#pragma unroll
        for (int cc = 0; cc < 8; ++cc) grw[cc] = *(const unsigned*)(pbase + ((size_t)(n * 64 + 8 * wid + cc) * NPROJ + C_GR + h * 128 + 2 * lane) * 2);
        {
            bf16x8 xla[2];
#pragma unroll
            for (int ks = 0; ks < 2; ++ks) { const LAS unsigned char* a = lds + RAW_LA + (32 * ks + 8 * fq + qp) * 128 + (16 * t1 + 4 * pp) * 2; xla[ks] = cat44(vtr(a), vtr(a + 4 * 128)); }
            f32x4 Ga = (f32x4){0.f, 0.f, 0.f, 0.f}, Gb = Ga, GT = Ga;
#pragma unroll
            for (int ks = 0; ks < 2; ++ks) { Ga = MFMA16(xla[ks], ym[0][ks], Ga); Gb = MFMA16(xla[ks], ym[1][ks], Gb); GT = MFMA16(xla[ks], ones, GT); }
#pragma unroll
            for (int ci = 0; ci < 2; ++ci) {
                const int c_ = 16 * (ca + ci) + fr, dk0 = 16 * t1 + 4 * fq; const f32x4 G = ci ? Gb : Ga;
                const u32x2 qw = *(const LAS u32x2*)(lds + RAW_Q + c_ * 128 + dk0 * 2), kw = *(const LAS u32x2*)(lds + RAW_K + c_ * 128 + dk0 * 2);
                const float q4[4] = {bflo(qw.x), bfhi(qw.x), bflo(qw.y), bfhi(qw.y)}, k4[4] = {bflo(kw.x), bfhi(kw.x), bflo(kw.y), bfhi(kw.y)};
                float qs4[4], ks4[4], kd4[4];
#pragma unroll
                for (int r = 0; r < 4; ++r) { qs4[r] = q4[r] * fexp(G[r]); ks4[r] = k4[r] * fexp(-G[r]); kd4[r] = k4[r] * fexp(GT[r] - G[r]); }
                *(LAS u32x2*)(lds + QS + c_ * P + dk0 * 2) = (u32x2){pk2(qs4[0], qs4[1]), pk2(qs4[2], qs4[3])};
                *(LAS u32x2*)(lds + KS + c_ * P + dk0 * 2) = (u32x2){pk2(ks4[0], ks4[1]), pk2(ks4[2], ks4[3])};
                *(LAS u32x2*)(lds + KD + c_ * P + dk0 * 2) = (u32x2){pk2(kd4[0], kd4[1]), pk2(kd4[2], kd4[3])};
            }
            if (fr == 0 && (wid & 1) == 0) *(LAS f32x4*)(lds + GTL + (16 * t1 + 4 * fq) * 4) = GT;
        }
        LDS_WAIT(); __syncthreads();
        if (n + 1 < SEQ / 64) GL_DMA(n + 1);
        {
            const int ct = wid >> 1;
#pragma unroll
            for (int si = 0; si < 2; ++si) {
                const int st = 2 * (wid & 1) + si; f32x4 D = (f32x4){0.f, 0.f, 0.f, 0.f};
                if (st <= ct) {
#pragma unroll
                    for (int ks = 0; ks < 2; ++ks) { const bf16x8 X = *(const LAS bf16x8*)(lds + KS + (16 * st + fr) * P + (32 * ks + 8 * fq) * 2), Y = *(const LAS bf16x8*)(lds + QS + (16 * ct + fr) * P + (32 * ks + 8 * fq) * 2); D = MFMA16(X, Y, D); }
#pragma unroll
                    for (int r = 0; r < 4; ++r) if (16 * st + 4 * fq + r > 16 * ct + fr) D[r] = 0.f;
                }
                *(LAS u32x2*)(lds + AM + (16 * ct + fr) * P + (16 * st + 4 * fq) * 2) = (u32x2){pk2(D[0], D[1]), pk2(D[2], D[3])};
            }
        }
        LDS_WAIT(); __builtin_amdgcn_s_barrier(); asm volatile("" ::: "memory");
        {
            const unsigned vb = VB0 + (n & 1) * 16384;
            bf16x8 X1[2], X2[2];
#pragma unroll
            for (int ks = 0; ks < 2; ++ks) { X1[ks] = *(const LAS bf16x8*)(lds + ST + (16 * wid + fr) * P + (32 * ks + 8 * fq) * 2);
                const LAS unsigned char* a = lds + vb + (32 * ks + 8 * fq + qp) * 256 + (16 * wid + 4 * pp) * 2; X2[ks] = cat44(vtr(a), vtr(a + 4 * 256)); }
#pragma unroll
            for (int ct = 0; ct < 4; ++ct) { f32x4 o = (f32x4){0.f, 0.f, 0.f, 0.f};
#pragma unroll
                for (int ks = 0; ks < 2; ++ks) { const bf16x8 Y1 = *(const LAS bf16x8*)(lds + QS + (16 * ct + fr) * P + (32 * ks + 8 * fq) * 2), Y2 = *(const LAS bf16x8*)(lds + AM + (16 * ct + fr) * P + (32 * ks + 8 * fq) * 2);
                    o = MFMA16(X1[ks], Y1, o); o = MFMA16(X2[ks], Y2, o); }
                *(LAS f32x4*)(lds + OO + (16 * ct + fr) * PO + (16 * wid + 4 * fq) * 4) = o;
                float ss = (o[0] * o[0] + o[1] * o[1]) + (o[2] * o[2] + o[3] * o[3]); ss += __shfl_xor(ss, 16); ss += __shfl_xor(ss, 32);
                if (fq == 0) *(LAS float*)(lds + SSQ + (16 * ct + fr) * 32 + wid * 4) = ss; }
#pragma unroll
            for (int tt = 0; tt < 4; ++tt) { const f32x4 dl = *(const LAS f32x4*)(lds + GTL + (16 * tt + 4 * fq) * 4);
#pragma unroll
                for (int r = 0; r < 4; ++r) accS[tt][r] *= fexp(dl[r]);
#pragma unroll
                for (int ks = 0; ks < 2; ++ks) { const LAS unsigned char* a = lds + KD + (32 * ks + 8 * fq + qp) * P + (16 * tt + 4 * pp) * 2; accS[tt] = MFMA16(cat44(vtr(a), vtr(a + 4 * P)), X2[ks], accS[tt]); }
                *(LAS u32x2*)(lds + ST + (16 * wid + fr) * P + (16 * tt + 4 * fq) * 2) = (u32x2){pk2(accS[tt][0], accS[tt][1]), pk2(accS[tt][2], accS[tt][3])}; }
        }
    }
    asm volatile("s_waitcnt vmcnt(0) lgkmcnt(0)" ::: "memory"); __syncthreads();
    GL_ROWPASS(SEQ / 64 - 1);
    __syncthreads();
#undef GL_DMA
#undef GL_ROWPASS
}

__device__ __forceinline__ int crow(int r, int hi) { return (r & 3) + 8 * (r >> 2) + 4 * hi; }
#define MFMA32(a, b, c) __builtin_amdgcn_mfma_f32_32x32x16_bf16(a, b, c, 0, 0, 0)
constexpr int AT_BUF = 32768, AT_WSF = 3 * 32768, AT_Q = 3 * 32768 + 2048;
constexpr float AT_THR = 8.f;

__device__ __forceinline__ void attn_unit(const Ctx& C, int b, int h, int cp, float lam) {
    const int lane = C.lane, r32 = lane & 31, hi = lane >> 5, wid = C.wid, p = wid >> 2, sub = wid & 3;
    const int NT = 2 * cp + 2, qch = 2 * cp + (sub >> 1), my_nt = qch + 1;
    const int row0 = b * SEQ + cp * 128;
    const int qpos = cp * 128 + sub * 32 + r32;
    const float sl2 = exp2f(-2.f * (float)(h + 1)) * LOG2E;
    LAS unsigned char* lds = C.lds;
    LAS float* wsf = (LAS float*)(lds + AT_WSF) + wid * 64;
    const char* kbase = (const char*)(C.PROJ + (size_t)(b * SEQ) * NPROJ + h * 128);
    const unsigned koff = (unsigned)((lane * NPROJ + C_DK + wid * 8) * 2);
    const unsigned voff = (unsigned)(((16 * (wid & 3) + (lane >> 2)) * NPROJ + C_DV + (wid >> 2) * 32 + (lane & 3) * 8) * 2);
#define AT_DMA(t, bufo) do { const char* _tb = kbase + (size_t)(t) * 64 * NPROJ * 2; \
        glds16<0>(_tb, koff, lds_addr(lds + (bufo) + wid * 1024)); glds16<0>(_tb, koff + 128u, lds_addr(lds + (bufo) + 8192 + wid * 1024)); \
        glds16<0>(_tb, voff, lds_addr(lds + (bufo) + 16384 + (wid >> 2) * 4096 + (wid & 3) * 1024)); glds16<0>(_tb, voff + 128u, lds_addr(lds + (bufo) + 16384 + ((wid >> 2) + 2) * 4096 + (wid & 3) * 1024)); } while (0)
    bf16x8 qr[4];
    { const bf16* qp = C.PROJ + (size_t)(row0 + sub * 32 + r32) * NPROJ + C_DQ + h * 128 + p * 64 + hi * 8;
#pragma unroll
      for (int d0 = 0; d0 < 4; ++d0) qr[d0] = *(const bf16x8*)(qp + d0 * 16); }
    AT_DMA(0, 0); AT_DMA(1, AT_BUF);
    f32x16 o[4];
#pragma unroll
    for (int d0 = 0; d0 < 4; ++d0)
#pragma unroll
        for (int i = 0; i < 16; ++i) o[d0][i] = 0.f;
    float mhat = 0.f, lsum = 0.f;
    const unsigned kofs = (unsigned)(p * 8192 + hi * 1024 + r32 * 16);
    const unsigned vofs = (unsigned)(16384 + ((lane >> 4) & 1) * 32 + (lane & 3) * 8 + (4 * hi + ((lane & 15) >> 2)) * 64);
    asm volatile("s_waitcnt vmcnt(4)" ::: "memory"); __syncthreads();
    unsigned bufo = 0, bufn1 = AT_BUF, bufn2 = 2 * AT_BUF;
#pragma unroll 1
    for (int t = 0; t < NT; ++t) {
        PSTAMP(lds, 0);
        if (t + 2 < NT) AT_DMA(t + 2, bufn2);
        PSTAMP(lds, 1);
        if (t < my_nt) {
            const LAS unsigned char* kp = lds + bufo + kofs;
            const LAS unsigned char* vp = lds + bufo + vofs;
            bf16x8 kf[8];
#pragma unroll
            for (int d0 = 0; d0 < 4; ++d0) { kf[2 * d0] = *(const LAS bf16x8*)(kp + d0 * 2048); kf[2 * d0 + 1] = *(const LAS bf16x8*)(kp + d0 * 2048 + 512); }
            s16x4 va[8], vb[8];
#define AT_VRD(dst, k) do { _Pragma("unroll") for (int d0 = 0; d0 < 4; ++d0) { dst[2 * d0] = vtr(vp + d0 * 4096 + (k) * 1024); dst[2 * d0 + 1] = vtr(vp + d0 * 4096 + (k) * 1024 + 512); } } while (0)
#define AT_PV(src_, k) do { const bf16x8 pa_ = __builtin_bit_cast(bf16x8, pw[k]); __builtin_amdgcn_s_setprio(1); _Pragma("unroll") for (int d0 = 0; d0 < 4; ++d0) o[d0] = MFMA32(pa_, cat44(src_[2 * d0], src_[2 * d0 + 1]), o[d0]); __builtin_amdgcn_s_setprio(0); } while (0)
            AT_VRD(va, 0);
            __builtin_amdgcn_sched_barrier(0);
            f32x16 s0, s1;
            if (t == qch) {
#pragma unroll
                for (int i = 0; i < 16; ++i) { const int k0p = 64 * t + crow(i, hi), k1p = k0p + 32;
                    s0[i] = fmaf(sl2, (float)min(k0p, 2 * qpos - k0p), -mhat); s1[i] = fmaf(sl2, (float)min(k1p, 2 * qpos - k1p), -mhat); }
            } else {
                const float bsm = sl2 * (float)(64 * t + 4 * hi) - mhat;
#pragma unroll
                for (int i = 0; i < 16; ++i) { const float ci = (float)((i & 3) + 8 * (i >> 2)); s0[i] = fmaf(sl2, ci, bsm); s1[i] = fmaf(sl2, ci + 32.f, bsm); }
            }
            __builtin_amdgcn_s_setprio(1);
#pragma unroll
            for (int d0 = 0; d0 < 4; ++d0) { s0 = MFMA32(kf[2 * d0], qr[d0], s0); s1 = MFMA32(kf[2 * d0 + 1], qr[d0], s1); }
            __builtin_amdgcn_s_setprio(0);
            __builtin_amdgcn_sched_barrier(0);
            float rm = fmaxf(s0[0], s1[0]);
#pragma unroll
            for (int i = 1; i < 16; ++i) rm = fmaxf(rm, fmaxf(s0[i], s1[i]));
            { auto rr = __builtin_amdgcn_permlane32_swap(__float_as_uint(rm), __float_as_uint(rm), false, false); rm = fmaxf(__uint_as_float(rr[0]), __uint_as_float(rr[1])); }
            if (t == 0 || __any(rm > AT_THR)) {
                const float dl = (t == 0) ? rm : fmaxf(rm, 0.f); mhat += dl;
                if (t != 0) {
                    const float f = __builtin_amdgcn_exp2f(-dl); lsum *= f;
                    if (hi == 0) wsf[r32] = f;
                    LDS_WAIT();
#pragma unroll
                    for (int i = 0; i < 16; ++i) { const float fi = wsf[crow(i, hi)];
#pragma unroll
                        for (int d0 = 0; d0 < 4; ++d0) o[d0][i] *= fi; }
                }
#pragma unroll
                for (int i = 0; i < 16; ++i) { s0[i] -= dl; s1[i] -= dl; }
            }
            float ps = 0.f;
#pragma unroll
            for (int i = 0; i < 16; ++i) { s0[i] = __builtin_amdgcn_exp2f(s0[i]); s1[i] = __builtin_amdgcn_exp2f(s1[i]); ps += s0[i] + s1[i]; }
            lsum += ps;
            PSTAMP(lds, 2);
            u32x4 pw[4];
            pw[0] = (u32x4){pk2(s0[0], s0[1]), pk2(s0[2], s0[3]), pk2(s0[4], s0[5]), pk2(s0[6], s0[7])};
            pw[1] = (u32x4){pk2(s0[8], s0[9]), pk2(s0[10], s0[11]), pk2(s0[12], s0[13]), pk2(s0[14], s0[15])};
            pw[2] = (u32x4){pk2(s1[0], s1[1]), pk2(s1[2], s1[3]), pk2(s1[4], s1[5]), pk2(s1[6], s1[7])};
            pw[3] = (u32x4){pk2(s1[8], s1[9]), pk2(s1[10], s1[11]), pk2(s1[12], s1[13]), pk2(s1[14], s1[15])};
            __builtin_amdgcn_sched_barrier(0);
            AT_VRD(vb, 1); AT_PV(va, 0); __builtin_amdgcn_sched_barrier(0);
            AT_VRD(va, 2); AT_PV(vb, 1); __builtin_amdgcn_sched_barrier(0);
            AT_VRD(vb, 3); AT_PV(va, 2); __builtin_amdgcn_sched_barrier(0);
            AT_PV(vb, 3);
#undef AT_VRD
#undef AT_PV
        }
        PSTAMP(lds, 3);
        if (t + 2 < NT) asm volatile("s_waitcnt vmcnt(4) lgkmcnt(0)" ::: "memory"); else asm volatile("s_waitcnt vmcnt(0) lgkmcnt(0)" ::: "memory");
        PSTAMP(lds, 4);
        __builtin_amdgcn_s_barrier(); asm volatile("" ::: "memory");
        PSTAMP(lds, 5);
        { const unsigned tb = bufo; bufo = bufn1; bufn1 = bufn2; bufn2 = tb; }
    }
#undef AT_DMA
    lsum += __shfl_xor(lsum, 32);
    if (hi == 0) wsf[32 + r32] = lsum;
    LDS_WAIT();
    LAS float* X = (LAS float*)lds;
    if (p == 1) {
#pragma unroll
        for (int i = 0; i < 16; ++i) { const float sc = lam * __builtin_amdgcn_rcpf(wsf[32 + crow(i, hi)]);
#pragma unroll
            for (int d0 = 0; d0 < 4; ++d0) X[(sub * 32 + crow(i, hi)) * 128 + d0 * 32 + r32] = o[d0][i] * sc; }
    }
    __syncthreads();
    if (p == 0) {
#pragma unroll
        for (int i = 0; i < 16; ++i) { const float sc = __builtin_amdgcn_rcpf(wsf[32 + crow(i, hi)]);
#pragma unroll
            for (int d0 = 0; d0 < 4; ++d0) { LAS float* xp = X + (sub * 32 + crow(i, hi)) * 128 + d0 * 32 + r32; *xp = o[d0][i] * sc - *xp; } }
    }
    __syncthreads();
    { const float g0 = C.diff_g[2 * lane], g1 = C.diff_g[2 * lane + 1];
#pragma unroll 4
      for (int qq = 0; qq < 16; ++qq) { const int q = wid * 16 + qq; const float y0 = X[q * 128 + 2 * lane], y1 = X[q * 128 + 2 * lane + 1];
          const float rstd = rsqrtf(wave_sum(y0 * y0 + y1 * y1) * (1.f / 128.f) + EPS) * 0.8f;
          *(unsigned*)(C.OA + (size_t)(row0 + q) * 1024 + h * 128 + 2 * lane) = pk2(y0 * rstd * g0, y1 * rstd * g1); } }
    __syncthreads();
}

__device__ __forceinline__ void attn_phase(const Ctx& C) {
    LAS float* lamp = (LAS float*)(C.lds + AT_Q) + 4;
    LAS int* qw = (LAS int*)(C.lds + AT_Q);
    if (C.tid < 64) {
        const float a = wave_sum(C.lq1[C.lane] * C.lk1[C.lane]), b2 = wave_sum(C.lq2[C.lane] * C.lk2[C.lane]);
        if (C.tid == 0) lamp[0] = fexp(a) - fexp(b2) + 0.2f;
    }
    __syncthreads();
    const float lam = lamp[0];
    for (;;) {
        if (C.tid == 0) qw[0] = (int)__hip_atomic_fetch_add(C.ctl + CW_QUEUE, 1u, RLX_AGENT);
        __syncthreads();
        const int item = __builtin_amdgcn_readfirstlane(qw[0]);
        __syncthreads();
        if (item >= 1024) break;
        const int bh = item & 63, cp = 15 - (item >> 6);
        attn_unit(C, bh >> 2, bh & 3, cp, lam);
    }
}

__device__ __forceinline__ void phase_router(const Ctx& C) {
    const int lane = C.lane, wid = C.wid, fr = lane & 15, fq = lane >> 4;
    LAS u32x4* WH = (LAS u32x4*)C.lds;
    LAS u32x4* WL = WH + 4096;
    LAS float* GS = (LAS float*)(C.lds + 131072);
    LAS float* SH = GS + 1024;
    LAS float* red = SH + 1024;
    LAS float* ssw = red + 8 * 16 * 32;
    LAS int* lcnt = (LAS int*)(ssw + 128);
    LAS int* lbase = lcnt + 32;
    LAS int* pend = lbase + 32;
    LAS float* cbl = (LAS float*)(pend + 512);
    for (int blk = C.bid; blk < NTOK / 128; blk += C.G) {
        const int b = blk >> 4; const float* md = C.mod + b * 6144;
        __syncthreads();
        for (int k = C.tid; k < DM; k += NTHREADS) { GS[k] = C.norm2_g[k] * (1.f + md[4096 + k]); SH[k] = md[3072 + k]; }
        if (C.tid < 32) lcnt[C.tid] = 0;
        pend[C.tid] = -1;
#pragma unroll 4
        for (int idx = C.tid; idx < 4096; idx += NTHREADS) { WH[idx] = C.wrf[idx]; WL[idx] = C.wrf[4096 + idx]; }
        f32x4 xaA[4], xbA[4]; u32x4 ywA[4];
#define RT_ISSUE(XA, XB, YW, row) do { _Pragma("unroll") for (int ks = 0; ks < 4; ++ks) { const size_t o_ = (size_t)(row) * DM + 128 * wid + 32 * ks + 8 * fq; \
            XA[ks] = __builtin_nontemporal_load((const f32x4*)(C.x + o_)); XB[ks] = __builtin_nontemporal_load((const f32x4*)(C.x + o_ + 4)); YW[ks] = __builtin_nontemporal_load((const u32x4*)(C.Y1 + o_)); } } while (0)
        RT_ISSUE(xaA, xbA, ywA, blk * 128 + fr);
        __syncthreads();
#define RT_MMA(av, ks) do { bf16x8 ah_, al_; split_bf16(av, ah_, al_); const int fi_ = ((wid * 4 + (ks)) * 2) * 64 + lane; \
            const bf16x8 wh0 = __builtin_bit_cast(bf16x8, WH[fi_]), wh1 = __builtin_bit_cast(bf16x8, WH[fi_ + 64]), wl0 = __builtin_bit_cast(bf16x8, WL[fi_]), wl1 = __builtin_bit_cast(bf16x8, WL[fi_ + 64]); \
            acc0 = MFMA16(ah_, wh0, acc0); acc0 = MFMA16(al_, wh0, acc0); acc0 = MFMA16(ah_, wl0, acc0); \
            acc1 = MFMA16(ah_, wh1, acc1); acc1 = MFMA16(al_, wh1, acc1); acc1 = MFMA16(ah_, wl1, acc1); } while (0)
        {
            f32x4 acc0 = (f32x4){0.f, 0.f, 0.f, 0.f}, acc1 = acc0;
#pragma unroll
            for (int ks = 0; ks < 4; ++ks) { const f32x4 sa = *(const LAS f32x4*)(SH + 128 * wid + 32 * ks + 8 * fq), sb = *(const LAS f32x4*)(SH + 128 * wid + 32 * ks + 8 * fq + 4);
                float av[8] = {sa[0], sa[1], sa[2], sa[3], sb[0], sb[1], sb[2], sb[3]}; RT_MMA(av, ks); }
            if (fq == 0) { red[(wid * 16) * 32 + fr] = acc0[0]; red[(wid * 16) * 32 + 16 + fr] = acc1[0]; }
            LDS_WAIT(); __syncthreads();
            if (C.tid < 32) { float t = C.b_router[C.tid];
#pragma unroll
                for (int w2 = 0; w2 < 8; ++w2) t += red[(w2 * 16) * 32 + C.tid];
                cbl[C.tid] = t; }
            LDS_WAIT(); __syncthreads();
        }
#define RT_TILE(XA, XB, YW, it) do { \
            int lane = C.lane; asm volatile("" : "+v"(lane)); const int fr = lane & 15, fq = lane >> 4;     \
            const int row0 = blk * 128 + (it) * 16; float x1[4][8]; \
            _Pragma("unroll") for (int ks = 0; ks < 4; ++ks) { \
                x1[ks][0] = XA[ks][0] + bflo(YW[ks].x); x1[ks][1] = XA[ks][1] + bfhi(YW[ks].x); x1[ks][2] = XA[ks][2] + bflo(YW[ks].y); x1[ks][3] = XA[ks][3] + bfhi(YW[ks].y); \
                x1[ks][4] = XB[ks][0] + bflo(YW[ks].z); x1[ks][5] = XB[ks][1] + bfhi(YW[ks].z); x1[ks][6] = XB[ks][2] + bflo(YW[ks].w); x1[ks][7] = XB[ks][3] + bfhi(YW[ks].w); } \
            __builtin_amdgcn_sched_barrier(0); if ((it) + 1 < 8) RT_ISSUE(XA, XB, YW, row0 + 16 + fr); __builtin_amdgcn_sched_barrier(0);                                     \
            f32x4 acc0 = (f32x4){0.f, 0.f, 0.f, 0.f}, acc1 = acc0; float ss = 0.f; \
            _Pragma("unroll") for (int ks = 0; ks < 4; ++ks) { \
                const f32x4 ga = *(const LAS f32x4*)(GS + 128 * wid + 32 * ks + 8 * fq), gb = *(const LAS f32x4*)(GS + 128 * wid + 32 * ks + 8 * fq + 4); float av[8]; \
                _Pragma("unroll") for (int j = 0; j < 8; ++j) { const float xv = x1[ks][j]; ss += xv * xv; av[j] = xv * (j < 4 ? ga[j] : gb[j - 4]); } \
                RT_MMA(av, ks); __builtin_amdgcn_sched_barrier(0); } \
            ss += __shfl_xor(ss, 16); ss += __shfl_xor(ss, 32); \
            if (fq == 0) ssw[wid * 16 + fr] = ss; \
            _Pragma("unroll") for (int r = 0; r < 4; ++r) { red[(wid * 16 + 4 * fq + r) * 32 + fr] = acc0[r]; red[(wid * 16 + 4 * fq + r) * 32 + 16 + fr] = acc1[r]; } \
            LDS_WAIT(); __syncthreads(); __builtin_amdgcn_sched_barrier(0); \
            {     \
                const int r = 2 * wid + (lane >> 5), e = lane & 31; float sum = 0.f, sq = 0.f; \
                _Pragma("unroll") for (int w2 = 0; w2 < 8; ++w2) { sum += red[(w2 * 16 + r) * 32 + e]; sq += ssw[w2 * 16 + r]; } \
                const float val = rsqrtf(sq * (1.f / DM) + EPS) * sum + cbl[e]; \
                LAS float* lgr = red + (2 * wid + (lane >> 5)) * 32; lgr[e] = val; LDS_WAIT();            \
                int rank = 0; \
                _Pragma("unroll") for (int e4 = 0; e4 < 8; ++e4) { const f32x4 o4 = *(const LAS f32x4*)(lgr + 4 * e4); \
                    _Pragma("unroll") for (int j = 0; j < 4; ++j) rank += (o4[j] > val || (o4[j] == val && (4 * e4 + j) < e)) ? 1 : 0; } \
                LAS float* slr = red + (16 + 2 * wid + (lane >> 5)) * 32;                                   \
                if (rank < 4) slr[rank] = val; \
                LDS_WAIT(); \
                const f32x4 tv = *(const LAS f32x4*)slr; \
                const float e1 = fexp(tv[1] - tv[0]), e2 = fexp(tv[2] - tv[0]), e3 = fexp(tv[3] - tv[0]); const float inv = 1.f / (1.f + e1 + e2 + e3); \
                if (rank < 4) { const int row = row0 + r; const float wgt = (rank == 0 ? 1.f : (rank == 1 ? e1 : (rank == 2 ? e2 : e3))) * inv; \
                    C.topw[(size_t)row * 4 + rank] = wgt; C.tope[(size_t)row * 4 + rank] = e; \
                    const int slot = atomicAdd((int*)(lcnt + e), 1); pend[((it) * 16 + r) * 4 + rank] = (e << 16) | slot; } \
            } \
            __builtin_amdgcn_sched_barrier(0); \
            {     \
                float sq = 0.f; _Pragma("unroll") for (int w2 = 0; w2 < 8; ++w2) sq += ssw[w2 * 16 + fr]; \
                const float rstd = rsqrtf(sq * (1.f / DM) + EPS); \
                _Pragma("unroll") for (int ks = 0; ks < 4; ++ks) { const int k0 = 128 * wid + 32 * ks + 8 * fq; \
                    const f32x4 ga = *(const LAS f32x4*)(GS + k0), gb = *(const LAS f32x4*)(GS + k0 + 4), sa = *(const LAS f32x4*)(SH + k0), sb = *(const LAS f32x4*)(SH + k0 + 4); float hv[8]; \
                    _Pragma("unroll") for (int j = 0; j < 8; ++j) hv[j] = __builtin_amdgcn_fmed3f((x1[ks][j] * rstd * (j < 4 ? ga[j] : gb[j - 4]) + (j < 4 ? sa[j] : sb[j - 4])) * F8_ASCALE, -440.f, 440.f); \
                    *(u32x2*)((unsigned char*)C.H2 + (size_t)(row0 + fr) * DM + k0) = (u32x2){pk4_fp8(hv[0], hv[1], hv[2], hv[3]), pk4_fp8(hv[4], hv[5], hv[6], hv[7])}; __builtin_amdgcn_sched_barrier(0); } \
            } \
            LDS_WAIT(); __syncthreads(); } while (0)
#pragma unroll 1
        for (int it = 0; it < 8; ++it) { RT_TILE(xaA, xbA, ywA, it); }
#undef RT_TILE
#undef RT_MMA
#undef RT_ISSUE
        if (C.tid < 32) lbase[C.tid] = (int)__hip_atomic_fetch_add(C.ctl + CW_CNT + 64 * C.tid, (unsigned)lcnt[C.tid], RLX_AGENT);
        __syncthreads();
        { const int pv = pend[C.tid]; if (pv >= 0) { const int e = pv >> 16, slot = pv & 0xffff; C.list[e * NTOK + lbase[e] + slot] = (blk * 128 + (C.tid >> 2)) * 4 + (C.tid & 3); } }
    }
}

__device__ __forceinline__ void phase_final(const Ctx& C) {
    const int gw = C.bid * NWAVES + C.wid, NGW = C.G * NWAVES;
    for (int r0 = gw * 16; r0 < NTOK; r0 += NGW * 16) {
        const int b = r0 >> 11; const float* gt2p = C.mod + b * 6144 + 5120;
        f32x4 gt2[4], fg[4];
#pragma unroll
        for (int j = 0; j < 4; ++j) { const int c0 = 4 * C.lane + 256 * j; gt2[j] = *(const f32x4*)(gt2p + c0); fg[j] = *(const f32x4*)(C.final_g + c0); }
#pragma unroll 1
        for (int rr = 0; rr < 16; ++rr) {
            const int row = r0 + rr;
            const f32x4 w = *(const f32x4*)(C.topw + (size_t)row * 4) * (1.f / F8_YSCALE);
            f32x4 v[4]; float ss = 0.f;
#pragma unroll
            for (int j = 0; j < 4; ++j) { const int c0 = 4 * C.lane + 256 * j;
                f32x4 y = (f32x4){0.f, 0.f, 0.f, 0.f};
#pragma unroll
                for (int k = 0; k < 4; ++k) { const int yw = __builtin_nontemporal_load((const int*)((const unsigned char*)C.YB + (size_t)(row * 4 + k) * DM + c0));
                    y = y + (f32x4){__builtin_amdgcn_cvt_f32_fp8(yw, 0), __builtin_amdgcn_cvt_f32_fp8(yw, 1), __builtin_amdgcn_cvt_f32_fp8(yw, 2), __builtin_amdgcn_cvt_f32_fp8(yw, 3)} * w[k]; }
                const u32x2 y1w = __builtin_nontemporal_load((const u32x2*)(C.Y1 + (size_t)row * DM + c0));
                v[j] = __builtin_nontemporal_load((const f32x4*)(C.x + (size_t)row * DM + c0)) + (f32x4){bflo(y1w.x), bfhi(y1w.x), bflo(y1w.y), bfhi(y1w.y)} + gt2[j] * y;
                ss += (v[j][0] * v[j][0] + v[j][1] * v[j][1]) + (v[j][2] * v[j][2] + v[j][3] * v[j][3]); }
            const float rstd = rsqrtf(wave_sum(ss) * (1.f / DM) + EPS);
#pragma unroll
            for (int j = 0; j < 4; ++j) __builtin_nontemporal_store(v[j] * rstd * fg[j], (f32x4*)(C.out + (size_t)row * DM + 4 * C.lane + 256 * j));
        }
    }
}

#ifndef PROBE_A
#define PROBE_A -1
#endif
#ifndef PROBE_B
#define PROBE_B -1
#endif
constexpr int CW_TS = 3072;
#define STAMP(k) do { if (PROBE_A >= 0 && blockIdx.x == 0 && threadIdx.x == 0) { const Ctx Cs = make_ctx(lds); ((unsigned long long*)(Cs.ctl + CW_TS))[k] = __builtin_amdgcn_s_memrealtime(); } } while (0)
struct Args { const float* in[25]; float* out; unsigned char* ws; };
typedef const Args __attribute__((address_space(4)))* KArgs;
__device__ __forceinline__ Ctx make_ctx(LAS unsigned char* lds) {
    KArgs a = (KArgs)__builtin_amdgcn_kernarg_segment_ptr();
    asm volatile("" : "+s"(a));
    Ctx C;
    C.lds = lds;
    C.tid = tid_fresh(); C.lane = C.tid & 63; C.wid = __builtin_amdgcn_readfirstlane(C.tid >> 6); C.G = gridDim.x; C.bid = blockIdx.x;
    C.x = a->in[0]; C.c = a->in[1]; C.w_ada = a->in[2]; C.b_ada = a->in[3]; C.norm1_g = a->in[4]; C.w_in = a->in[5];
    C.lq1 = a->in[6]; C.lk1 = a->in[7]; C.lq2 = a->in[8]; C.lk2 = a->in[9]; C.diff_g = a->in[10]; C.w_alpha_up = a->in[11]; C.b_alpha = a->in[12];
    C.gla_g = a->in[13]; C.w_bd = a->in[14]; C.w_bg = a->in[15]; C.w_out = a->in[16]; C.norm2_g = a->in[17]; C.w_router = a->in[18]; C.b_router = a->in[19];
    C.w_gu = a->in[20]; C.b_gu = a->in[21]; C.w_dn = a->in[22]; C.b_dn = a->in[23]; C.final_g = a->in[24];
    C.out = a->out;
    unsigned char* ws = a->ws;
    C.ctl = (unsigned*)(ws + WS_CTL); C.mod = (float*)(ws + WS_MOD); C.tope = (int*)(ws + WS_TOPE); C.topw = (float*)(ws + WS_TOPW); C.list = (int*)(ws + WS_LIST);
    C.WinT = (bf16*)(ws + WS_WIN); C.WbdT = (bf16*)(ws + WS_WBD); C.WbgT = (bf16*)(ws + WS_WBG); C.WoutT = (bf16*)(ws + WS_WOUT); C.WguT = (bf16*)(ws + WS_WGU); C.WdT = (bf16*)(ws + WS_WD);
    C.H = (bf16*)(ws + WS_H); C.H2 = (bf16*)(ws + WS_H2); C.OA = (bf16*)(ws + WS_OA); C.OB = (bf16*)(ws + WS_OB); C.MG = (bf16*)(ws + WS_MG); C.YB = (bf16*)(ws + WS_YB);
    C.PROJ = (bf16*)(ws + WS_PROJ); C.ACT = (bf16*)(ws + WS_ACT); C.Y1 = (bf16*)(ws + WS_Y1); C.cb = (float*)(ws + WS_CB); C.wrf = (u32x4*)(ws + WS_WRF);
    return C;
}
__global__ void __launch_bounds__(NTHREADS, 2) fwd_kernel(Args args) {
    extern __shared__ __attribute__((aligned(16))) unsigned char lds_raw[];
    LAS unsigned char* lds = (LAS unsigned char*)lds_raw;
    for (int u = threadIdx.x; u < (LDS_BYTES - LDSCTL_OFF) / 4; u += NTHREADS) ((LAS unsigned*)(lds + LDSCTL_OFF))[u] = 0u;
    __syncthreads();
    volatile LAS unsigned* MISC = (volatile LAS unsigned*)(lds + MISC_OFF);
    XcdBarrier bar;
    { const Ctx C = make_ctx(lds); bar = xcd_barrier_post(C.ctl + CW_BAR, MISC + 8); }
#define GRID_BAR() xcd_barrier(bar)
    STAMP(0);
#if PROBE_A >= 100
    if (blockIdx.x == 0 && threadIdx.x == 0) ((volatile LAS unsigned*)(lds + MISC_OFF))[15] = (unsigned)__builtin_amdgcn_s_memrealtime();
#endif

    { const Ctx C = make_ctx(lds); phase_mod(C); }
    GRID_BAR(); STAMP(1);
    { const Ctx C = make_ctx(lds); phase_prep(C); }
    GRID_BAR(); STAMP(2);
    { const Ctx C = make_ctx(lds); DenseDesc g{C.H, DM, C.WinT, DM}; TileOrder S; S.init(NTOK / 256, NPROJ / 256, C.G, C.bid); EpiProj E{C.PROJ, C.b_alpha}; gemm_phase<DenseDesc, TileOrder, EpiProj, true, false, 1>(C.lds, g, S, E); }
    GRID_BAR(); STAMP(3);
    { const Ctx C = make_ctx(lds); for (int s = C.bid; s < 64; s += C.G) gla_chunked(C, s >> 2, s & 3); }
    __syncthreads(); STAMP(12);
    { const Ctx C = make_ctx(lds); attn_phase(C); }
    GRID_BAR(); STAMP(4);
    { const Ctx C = make_ctx(lds); DenseDesc g{C.OA, DM, C.WbdT, DM}; TileOrder S; S.init(NTOK / 256, DM / 256, C.G, C.bid); EpiBranch E{C.MG, C.PROJ}; gemm_phase<DenseDesc, TileOrder, EpiBranch, true>(C.lds, g, S, E); }
    GRID_BAR(); STAMP(5);
    STAMP(6);
    { const Ctx C = make_ctx(lds); DenseDesc g{C.MG, DM, C.WoutT, DM}; TileOrder S; S.init(NTOK / 256, DM / 256, C.G, C.bid); EpiOut E{C.Y1, C.mod}; gemm_phase<DenseDesc, TileOrder, EpiOut, true>(C.lds, g, S, E); }
    GRID_BAR(); STAMP(7);
    { const Ctx C = make_ctx(lds); phase_router(C); }
    GRID_BAR(); STAMP(8);
    LAS int* tab = (LAS int*)(lds + STAGE_BYTES);
    __syncthreads();
    if (threadIdx.x == 0) { const Ctx C = make_ctx(lds); int ts = 0; for (int e = 0; e < NE; ++e) { const int cnt = (int)__hip_atomic_load(C.ctl + CW_CNT + 64 * e, RLX_AGENT); tab[e] = cnt; tab[32 + e] = ts; ts += (cnt + 255) >> 8; } tab[64] = ts; }
    __syncthreads();
    for (int tr = threadIdx.x; tr < tab[64]; tr += NTHREADS) { int e = 0; for (int k = 1; k < NE; ++k) if (tab[32 + k] <= tr) e = k; tab[65 + tr] = e; }
    __syncthreads();
    { const Ctx C = make_ctx(lds); const int T = tab[64]; MoeUpDesc g{(const unsigned char*)C.H2, C.list, (const unsigned char*)C.WguT, DM}; MoeOrder S; S.t.init(T, 8, C.G, C.bid, 4); S.tab = tab; EpiUp E{(unsigned char*)C.ACT, C.b_gu}; gemm_phase<MoeUpDesc, MoeOrder, EpiUp, true, true, 4>(C.lds, g, S, E); }
    GRID_BAR(); STAMP(9);
    { const Ctx C = make_ctx(lds); const int T = tab[64]; MoeDownDesc g{(const unsigned char*)C.ACT, (const unsigned char*)C.WdT, FF}; MoeOrder S; S.t.init(T, 4, C.G, C.bid); S.tab = tab; EpiDown E{(unsigned char*)C.YB, C.b_dn, C.list}; gemm_phase<MoeDownDesc, MoeOrder, EpiDown, true, true, 5>(C.lds, g, S, E); }
    GRID_BAR(); STAMP(10);
    { const Ctx C = make_ctx(lds); phase_final(C); }
#if PROBE_A >= 0
    GRID_BAR(); STAMP(11);
    if (blockIdx.x == 0 && threadIdx.x == 0) {
        const Ctx C = make_ctx(lds); const unsigned long long* ts = (const unsigned long long*)(C.ctl + CW_TS);
        asm volatile("s_waitcnt vmcnt(0)" ::: "memory");
        const unsigned long long dt = (PROBE_A >= 100) ? (unsigned long long)((volatile LAS unsigned*)(lds + MISC_OFF))[16 + (PROBE_A >= 100 ? PROBE_A - 100 : 0)] : ((PROBE_A == 12) ? ts[12] - ts[3] : ts[(PROBE_A < 12 ? PROBE_A : 0) + 1] - ts[PROBE_A < 12 ? PROBE_A : 0]), t0 = __builtin_amdgcn_s_memrealtime();
        while (__builtin_amdgcn_s_memrealtime() - t0 < 4ull * dt) __builtin_amdgcn_s_sleep(8);
    }
#endif
}

extern "C" void kernel_launch(void* const* d_in, const int* in_sizes, int n_in, void* d_out, int out_size, void* d_ws, size_t ws_size, hipStream_t stream) {
    static int grid = 0;
    if (grid == 0) {
        if (n_in != 25 || in_sizes[0] != NTOK * DM || out_size != NTOK * DM || ws_size < WS_END) {
            fprintf(stderr, "kernel_launch: unexpected shapes (n_in %d, in0 %d, out %d, ws %zu < %zu)\n", n_in, n_in > 0 ? in_sizes[0] : -1, out_size, ws_size, (size_t)WS_END); grid = -1; return; }
        int dev = 0, cus = 0;
        if (hipGetDevice(&dev) != hipSuccess || hipDeviceGetAttribute(&cus, hipDeviceAttributeMultiprocessorCount, dev) != hipSuccess) { grid = -1; return; }
        if (hipFuncSetAttribute((const void*)fwd_kernel, hipFuncAttributeMaxDynamicSharedMemorySize, LDS_BYTES) != hipSuccess) { fprintf(stderr, "kernel_launch: hipFuncSetAttribute failed\n"); grid = -1; return; }
        (void)hipGetLastError();
        grid = cus;
    }
    if (grid < 0) return;
    if (hipMemsetAsync((char*)d_ws + WS_CTL, 0, CTL_ZERO_BYTES, stream) != hipSuccess) { fprintf(stderr, "kernel_launch: memset failed\n"); return; }
    Args a{};
    for (int i = 0; i < 25; ++i) a.in[i] = (const float*)d_in[i];
    a.out = (float*)d_out; a.ws = (unsigned char*)d_ws;
    hipLaunchKernelGGL(fwd_kernel, dim3(grid), dim3(NTHREADS), LDS_BYTES, stream, a);
}
```

```cpp
#include <hip/hip_runtime.h>
#include <cstdio>
#include <cstdint>

#define GAS __attribute__((address_space(1)))
#define LAS __attribute__((address_space(3)))
typedef unsigned short bf16;
typedef short bf16x8 __attribute__((ext_vector_type(8)));
typedef float f32x4 __attribute__((ext_vector_type(4)));
typedef unsigned u32x4 __attribute__((ext_vector_type(4)));
typedef unsigned u32x2 __attribute__((ext_vector_type(2)));
typedef int i32x4 __attribute__((ext_vector_type(4)));
typedef GAS unsigned gu32;

constexpr int NB = 16, SEQ = 2048, DM = 1024, NTOK = NB * SEQ, NE = 32, FF = 1024;
constexpr int NPROJ = 5376;
constexpr int C_DQ = 0, C_DK = 512, C_DV = 1024, C_GQ = 1536, C_GK = 1792, C_GV = 2048, C_GR = 2560, C_GA = 3072, C_GB = 4096, C_AL = 5120;
constexpr int W_IN_N = 5136;
constexpr float LOG2E = 1.4426950408889634f;
constexpr float QSCALE = 0.125f * LOG2E;
constexpr float EPS = 1e-6f;
constexpr int NWAVES = 8, NTHREADS = 512;

constexpr size_t MiB = 1u << 20;
constexpr size_t WS_CTL = 0, CTL_ZERO_BYTES = 1 * MiB;
constexpr size_t WS_MOD = 1 * MiB;
constexpr size_t WS_TOPE = 2 * MiB;
constexpr size_t WS_TOPW = 3 * MiB;
constexpr size_t WS_LIST = 4 * MiB;
constexpr size_t WS_WIN = 8 * MiB;
constexpr size_t WS_WBD = 19 * MiB;
constexpr size_t WS_WBG = 20 * MiB;
constexpr size_t WS_WOUT = 21 * MiB;
constexpr size_t WS_WGU = 24 * MiB;
constexpr size_t WS_WD = 152 * MiB;
constexpr size_t WS_H2 = 216 * MiB;
constexpr size_t WS_RB = 280 * MiB;
constexpr size_t WS_H = WS_RB, WS_OA = WS_RB + 64 * MiB, WS_OB = WS_RB + 96 * MiB, WS_MG = WS_RB + 128 * MiB, WS_YB = WS_RB;
constexpr size_t WS_RA = 536 * MiB;
constexpr size_t WS_PROJ = WS_RA, WS_ACT = WS_RA;
constexpr size_t WS_Y1 = WS_RA + 272 * MiB;
constexpr size_t WS_CB = WS_MOD + 512 * 1024;
constexpr size_t WS_WRF = WS_MOD + 768 * 1024;
constexpr size_t WS_END = 872 * MiB;
constexpr int MAX_TILES = 544;
static_assert((size_t)MAX_TILES * 256 * 1024 * 2 <= 336 * MiB, "act fits region A");
constexpr int CW_CNT = 64;
constexpr int CW_BAR = 4096;
constexpr int CW_QUEUE = 2304;

constexpr int SCR_BYTES = 159744;
constexpr int LDSCTL_OFF = SCR_BYTES, MISC_OFF = LDSCTL_OFF + 320;
constexpr int LDS_BYTES = SCR_BYTES + 1024;

#define RLX_AGENT __ATOMIC_RELAXED, __HIP_MEMORY_SCOPE_AGENT
#define LDS_WAIT() asm volatile("s_waitcnt lgkmcnt(0)" ::: "memory")

__device__ __forceinline__ unsigned f2bf(float f) { unsigned u = __builtin_bit_cast(unsigned, f); return (u + 0x7fffu + ((u >> 16) & 1u)) >> 16; }
typedef __bf16 bf16n2 __attribute__((ext_vector_type(2)));
typedef float f32x2 __attribute__((ext_vector_type(2)));
__device__ __forceinline__ unsigned pk2(float lo, float hi) { return __builtin_bit_cast(unsigned, __builtin_convertvector((f32x2){lo, hi}, bf16n2)); }
__device__ __forceinline__ unsigned pk4_fp8(float a, float b, float c, float d) { int w = 0; w = __builtin_amdgcn_cvt_pk_fp8_f32(a, b, w, false); w = __builtin_amdgcn_cvt_pk_fp8_f32(c, d, w, true); return (unsigned)w; }
constexpr float F8_ASCALE = 4.f, F8_WSCALE = 512.f;
constexpr int F8_SA = 0x7d7d7d7d, F8_SW = 0x76767676;
__device__ __forceinline__ float bf2f(unsigned b) { return __uint_as_float(b << 16); }
__device__ __forceinline__ float bflo(unsigned w) { return __uint_as_float(w << 16); }
__device__ __forceinline__ float bfhi(unsigned w) { return __uint_as_float(w & 0xffff0000u); }
__device__ __forceinline__ float wave_sum(float v) {
#pragma unroll
    for (int o = 1; o < 64; o <<= 1) v += __shfl_xor(v, o);
    return v;
}
__device__ __forceinline__ int tid_fresh() { int t = threadIdx.x; asm volatile("" : "+v"(t)); return t; }
__device__ __forceinline__ float fexp(float x) { return __builtin_amdgcn_exp2f(x * 1.4426950408889634f); }
__device__ __forceinline__ float sigmoidf_(float x) { return __builtin_amdgcn_rcpf(1.f + fexp(-x)); }

#define XB_TMO      128
#define XB_XCNT(j)  (256  + 64 * (j))
#define XB_XSUB(j)  (1280 + 64 * (j))
#define XB_XGEN(j)  (2304 + 64 * (j))
#define XB_TOP      3328
#define XB_TOPGEN   3392
#define XCD_BAR_WORDS 3456
#define XB_SPIN_CAP (1u << 22)
__device__ __forceinline__ unsigned xb_ld(unsigned* p)              { return __hip_atomic_load(p, __ATOMIC_RELAXED, __HIP_MEMORY_SCOPE_AGENT); }
__device__ __forceinline__ unsigned xb_add(unsigned* p, unsigned v) { return __hip_atomic_fetch_add(p, v, __ATOMIC_RELAXED, __HIP_MEMORY_SCOPE_AGENT); }
__device__ __forceinline__ unsigned xb_xcc_id() { return (unsigned)__builtin_amdgcn_s_getreg((3 << 11) | 20) & 0xFu; }
#define XB_SPIN(cond, bar) do { unsigned _sp = 0; while (cond) { __builtin_amdgcn_s_sleep(1); \
    if ((++_sp & 255u) == 0u) { if (xb_ld(&(bar)[XB_TMO])) break; if (_sp > XB_SPIN_CAP) { atomicAdd(&(bar)[XB_TMO], 1u); break; } } } } while (0)
struct XcdBarrier { unsigned* bar; unsigned x; volatile LAS unsigned* st; };
__device__ __forceinline__ XcdBarrier xcd_barrier_post(unsigned* bar, volatile LAS unsigned* st) {
    XcdBarrier b; b.bar = bar; b.x = xb_xcc_id(); b.st = st;
    if (threadIdx.x == 0) (void)xb_add(&bar[XB_XCNT(b.x)], 1u);
    return b;
}
__device__ __forceinline__ void xcd_barrier_complete(unsigned* bar, unsigned x, unsigned& nloc, unsigned& nx) {
    const unsigned G = gridDim.x * gridDim.y * gridDim.z;
    unsigned sum, cnt, mine, sp = 0u;
    for (;;) {
        sum = 0u; cnt = 0u; mine = 0u;
#pragma unroll
        for (unsigned j = 0; j < 16; ++j) { const unsigned c = xb_ld(&bar[XB_XCNT(j)]); sum += c; cnt += (c > 0u) ? 1u : 0u; mine = (j == x) ? c : mine; }
        if (sum == G) break;
        __builtin_amdgcn_s_sleep(1);
        if ((++sp & 255u) == 0u) { if (xb_ld(&bar[XB_TMO])) break; if (sp > XB_SPIN_CAP) { atomicAdd(&bar[XB_TMO], 1u); break; } }
    }
    nloc = mine > 0u ? mine : 1u; nx = cnt > 0u ? cnt : 1u;
}
__device__ __forceinline__ void xcd_barrier(const XcdBarrier& b) {
    asm volatile("s_waitcnt vmcnt(0)" ::: "memory");
    __syncthreads();
    if (threadIdx.x == 0) {
        unsigned* bar = b.bar;
        __builtin_amdgcn_s_waitcnt(0);
        unsigned nloc = b.st[0], nx = b.st[1];
        if (nloc == 0u) { xcd_barrier_complete(bar, b.x, nloc, nx); b.st[0] = nloc; b.st[1] = nx; }
        const unsigned old = xb_add(&bar[XB_XSUB(b.x)], 1u);
        const unsigned gen = old / nloc;
        if (old + 1u == (gen + 1u) * nloc) {
            __builtin_amdgcn_fence(__ATOMIC_RELEASE, "agent");
            asm volatile("s_waitcnt vmcnt(0)" ::: "memory");
            const unsigned og = xb_add(&bar[XB_TOP], 1u);
            const unsigned tg = og / nx;
            if (og + 1u == (tg + 1u) * nx) xb_add(&bar[XB_TOPGEN], 1u);
            else XB_SPIN(xb_ld(&bar[XB_TOPGEN]) == tg, bar);
            __builtin_amdgcn_fence(__ATOMIC_ACQUIRE, "agent");
            xb_add(&bar[XB_XGEN(b.x)], 1u);
            asm volatile("s_waitcnt vmcnt(0)" ::: "memory");
        } else {
            XB_SPIN(xb_ld(&bar[XB_XGEN(b.x)]) == gen, bar);
            __builtin_amdgcn_fence(__ATOMIC_ACQUIRE, "agent");
            asm volatile("s_waitcnt vmcnt(0)" ::: "memory");
        }
    }
    __syncthreads();
}

struct Ctx {
    LAS unsigned char* lds;
    int tid, lane, wid, G, bid;
    const float *x, *c, *w_ada, *b_ada, *norm1_g, *w_in, *lq1, *lk1, *lq2, *lk2, *diff_g, *w_alpha_up, *b_alpha, *gla_g,
                *w_bd, *w_bg, *w_out, *norm2_g, *w_router, *b_router, *w_gu, *b_gu, *w_dn, *b_dn, *final_g;
    float* out;
    unsigned* ctl; float* mod; int* tope; float* topw; int* list;
    bf16 *WinT, *WbdT, *WbgT, *WoutT, *WguT, *WdT, *H, *H2, *OA, *OB, *MG, *YB, *PROJ, *ACT, *Y1; float* cb; u32x4* wrf;
};

constexpr int NXCD = 8, WGM = 8;
__host__ __device__ __forceinline__ int perm32(int rho) { const int n = rho >> 4, i = rho & 15; return 8 * (i >> 2) + 4 * n + (i & 3); }
struct Unit { int pm, pn, e, row0, cnt; };
struct TileOrder {
    int nM, nN, nwg, G, c, wgm;
    __device__ __forceinline__ void init(int nM_, int nN_, int G_, int c_, int wgm_ = WGM) { nM = nM_; nN = nN_; nwg = nM * nN; G = G_; c = c_; wgm = wgm_; }
    __device__ __forceinline__ bool next(int i, Unit& u) const {
        const long L = (long)i * G + c; if (L >= nwg) return false;
        int wgid = (int)L; { const int q = nwg / NXCD, r = nwg % NXCD, xcd = wgid % NXCD, off = wgid / NXCD; wgid = (xcd < r ? xcd * (q + 1) : r * (q + 1) + (xcd - r) * q) + off; }
        const int nig = wgm * nN, gid = wgid / nig, fm = gid * wgm, gsz = (nM - fm) < wgm ? (nM - fm) : wgm;
        u.pm = fm + ((wgid % nig) % gsz); u.pn = (wgid % nig) / gsz; u.e = 0; u.row0 = 0; u.cnt = 0; return true;
    }
};
struct MoeOrder {
    TileOrder t; LAS const int* tab;
    __device__ __forceinline__ bool next(int i, Unit& u) const {
        if (!t.next(i, u)) return false;
        const int e = tab[65 + u.pm];
        u.e = e; u.row0 = (u.pm - tab[32 + e]) * 256; u.cnt = tab[e]; return true;
    }
};
struct DenseDesc {
    static constexpr bool GATHER = false;
    const bf16* A; int lda; const bf16* Bt; int K;
    __device__ __forceinline__ unsigned a_off(const Unit& u, int r) const { return (unsigned)((u.pm * 256 + r) * lda) * 2u; }
    __device__ __forceinline__ const char* a_base(const Unit&) const { return (const char*)A; }
    __device__ __forceinline__ const char* b_base(const Unit& u) const { return (const char*)Bt + (size_t)u.pn * 256 * K * 2; }
};
struct MoeUpDesc {
    static constexpr bool GATHER = true;
    const unsigned char* H2; const int* list; const unsigned char* WguT; int K;
    __device__ __forceinline__ const int* id_src(const Unit& u, int j) const { const int s = u.row0 + j; return list + (size_t)u.e * NTOK + (s < NTOK ? s : NTOK - 1); }
    __device__ __forceinline__ unsigned a_off(const Unit& u, int r) const { const int slot = u.row0 + r; int tok = 0; if (slot < u.cnt) tok = list[u.e * NTOK + slot] >> 2; return (unsigned)tok * 1024u; }
    __device__ __forceinline__ const char* a_base(const Unit&) const { return (const char*)H2; }
    __device__ __forceinline__ const char* b_base(const Unit& u) const { return (const char*)WguT + ((size_t)u.e * 2048 + (size_t)u.pn * 256) * 1024; }
};
struct MoeDownDesc {
    static constexpr bool GATHER = false;
    const unsigned char* ACT; const unsigned char* WdT; int K;
    __device__ __forceinline__ unsigned a_off(const Unit& u, int r) const { return (unsigned)(u.pm * 256 + r) * 1024u; }
    __device__ __forceinline__ const char* a_base(const Unit&) const { return (const char*)ACT; }
    __device__ __forceinline__ const char* b_base(const Unit& u) const { return (const char*)WdT + ((size_t)u.e * 1024 + (size_t)u.pn * 256) * 1024; }
};

template <class Desc, class Order, class Epi>
__device__ __forceinline__ void gemm_simple(const Desc& g, const Order& S, const Epi& E) {
    const int tid = threadIdx.x, wid = __builtin_amdgcn_readfirstlane(tid >> 6), lane = tid & 63, wr = wid >> 2, wc = wid & 3, fr = lane & 15, fq = lane >> 4;
    const int K = g.K;
    Unit u;
    for (int i = 0; S.next(i, u); ++i) {
        f32x4 acc[2][2][4][2];
#pragma unroll
        for (int a = 0; a < 2; ++a)
#pragma unroll
            for (int b = 0; b < 2; ++b)
#pragma unroll
                for (int m = 0; m < 4; ++m)
#pragma unroll
                    for (int n = 0; n < 2; ++n) acc[a][b][m][n] = (f32x4){0.f, 0.f, 0.f, 0.f};
        unsigned aoff[2][4], boff[2][2];
#pragma unroll
        for (int a = 0; a < 2; ++a)
#pragma unroll
            for (int m = 0; m < 4; ++m) aoff[a][m] = g.a_off(u, a * 128 + wr * 64 + m * 16 + fr) + fq * 16;
#pragma unroll
        for (int b = 0; b < 2; ++b)
#pragma unroll
            for (int n = 0; n < 2; ++n) { const int nc = b * 128 + wc * 32 + (Epi::PERM ? perm32(n * 16 + fr) : (n * 16 + fr)); boff[b][n] = (unsigned)(nc * K) * 2u + fq * 16; }
        const char* ab = g.a_base(u); const char* bb = g.b_base(u);
#pragma unroll 1
        for (int ks = 0; ks < K / 32; ++ks) {
            bf16x8 af[2][4], bfr[2][2];
#pragma unroll
            for (int a = 0; a < 2; ++a)
#pragma unroll
                for (int m = 0; m < 4; ++m) af[a][m] = *(const bf16x8*)(ab + aoff[a][m] + ks * 64);
#pragma unroll
            for (int b = 0; b < 2; ++b)
#pragma unroll
                for (int n = 0; n < 2; ++n) bfr[b][n] = *(const bf16x8*)(bb + boff[b][n] + ks * 64);
#pragma unroll
            for (int a = 0; a < 2; ++a)
#pragma unroll
                for (int b = 0; b < 2; ++b)
#pragma unroll
                    for (int m = 0; m < 4; ++m)
#pragma unroll
                        for (int n = 0; n < 2; ++n) acc[a][b][m][n] = __builtin_amdgcn_mfma_f32_16x16x32_bf16(bfr[b][n], af[a][m], acc[a][b][m][n], 0, 0, 0);
        }
        E(acc, u, wr, wc, fr, fq);
    }
}


#ifndef PROBE_A
#define PROBE_A -1
#endif
#if PROBE_A >= 100
#define PSTAMP(ldsp, idx) do { if (blockIdx.x == 0 && threadIdx.x == 0) { volatile LAS unsigned* pm_ = (volatile LAS unsigned*)((ldsp) + MISC_OFF); const unsigned now_ = (unsigned)__builtin_amdgcn_s_memrealtime(); pm_[16 + (idx)] += now_ - pm_[15]; pm_[15] = now_; } } while (0)
#else
#define PSTAMP(ldsp, idx) do {} while (0)
#endif
constexpr int BK = 64, HALF = 128, HTB = HALF * BK * 2, STAGE_BYTES = 8 * HTB;
__host__ __device__ __forceinline__ int lds_byte(int r, int c) { const int st = (r >> 4) * 2 + (c >> 5), rr = r & 15, cc = c & 31, ob = rr * 64 + cc * 2; return st * 1024 + (ob ^ (((ob >> 9) & 1) << 5)); }
__host__ __device__ __forceinline__ void stage_rc(int b, int& R, int& C) { const int st = b / 1024, sb = b % 1024, swz = sb ^ (((sb >> 9) & 1) << 5); R = (st >> 1) * 16 + swz / 64; C = (st & 1) * 32 + (swz % 64) / 2; }

typedef int v8i32 __attribute__((ext_vector_type(8)));
__device__ __forceinline__ v8i32 cat88(bf16x8 lo, bf16x8 hi) { const i32x4 a = __builtin_bit_cast(i32x4, lo), b = __builtin_bit_cast(i32x4, hi); return (v8i32){a[0], a[1], a[2], a[3], b[0], b[1], b[2], b[3]}; }
template <class Desc, class Order, class Epi, bool ALIGN_EPI, bool FP8 = false, int PID = 0>
__device__ __forceinline__ void gemm_phase(LAS unsigned char* lds, const Desc& g, const Order& S, const Epi& E) {
    const int tid = tid_fresh(), wid = __builtin_amdgcn_readfirstlane(tid >> 6), lane = tid & 63, wr = wid >> 2, wc = wid & 3, fr = lane & 15, fq = lane >> 4;
    const int KBy = FP8 ? g.K : 2 * g.K, nt = KBy / 128;
    int Rs[2], Cs[2]; unsigned voffB[2];
#pragma unroll
    for (int i = 0; i < 2; ++i) { stage_rc(tid * 16 + i * 8192, Rs[i], Cs[i]); const int Rb = 64 * (Rs[i] >> 5) + perm32(Rs[i] & 31); voffB[i] = (unsigned)(Rb * KBy + Cs[i] * 2); }
    unsigned vA[2][2];
    LAS u32x4* const vslot = (LAS u32x4*)(lds + STAGE_BYTES + 4096) + tid;
    const size_t kstep = (size_t)(BK * 2);
    const size_t hstepB = (size_t)32 * KBy;
    const unsigned ldsw = (unsigned)wid * 1024u;
    const int aoff = FP8 ? lds_byte(wr * 64 + fr, fq * 16) : lds_byte(wr * 64 + fr, fq * 8), boff = FP8 ? lds_byte(wc * 32 + fr, fq * 16) : lds_byte(wc * 32 + fr, fq * 8);
    constexpr int KSTR = FP8 ? 16 : 1024;
#define PG8_SA(b, h) (((b) * 2 + (h)) * HTB)
#define PG8_SB(b, h) ((4 + (b) * 2 + (h)) * HTB)
#define PG8_STAGE(bufoff, gbase, voff) do { _Pragma("unroll") for (int _i = 0; _i < 2; ++_i) \
        __builtin_amdgcn_global_load_lds((const unsigned*)((const char*)(gbase) + (voff)[_i]), (LAS unsigned*)(lds + (bufoff) + ldsw + _i * 8192), 16, 0, 0); } while (0)
#define PG8_STAGE_A(bufoff, gbase, h) do { _Pragma("unroll") for (int _i = 0; _i < 2; ++_i) \
        __builtin_amdgcn_global_load_lds((const unsigned*)((const char*)(gbase) + vA[h][_i]), (LAS unsigned*)(lds + (bufoff) + ldsw + _i * 8192), 16, 0, 0); } while (0)
#define PG8_LDA(dst, b, h) do { _Pragma("unroll") for (int m = 0; m < 4; ++m) _Pragma("unroll") for (int k = 0; k < 2; ++k) dst[m][k] = *(const LAS bf16x8*)(lds + PG8_SA(b, h) + aoff + m * 2048 + k * KSTR); } while (0)
#define PG8_LDB(dst, b, h) do { _Pragma("unroll") for (int n = 0; n < 2; ++n) _Pragma("unroll") for (int k = 0; k < 2; ++k) dst[n][k] = *(const LAS bf16x8*)(lds + PG8_SB(b, h) + boff + n * 2048 + k * KSTR); } while (0)
#define PG8_MMA(ai, bj, At, Bt) do { __builtin_amdgcn_s_setprio(1); _Pragma("unroll") for (int m = 0; m < 4; ++m) _Pragma("unroll") for (int n = 0; n < 2; ++n) { \
        if constexpr (FP8) { acc[ai][bj][m][n] = __builtin_amdgcn_mfma_scale_f32_16x16x128_f8f6f4(cat88(Bt[n][0], Bt[n][1]), cat88(At[m][0], At[m][1]), acc[ai][bj][m][n], 0, 0, 0, F8_SW, 0, F8_SA); } \
        else { _Pragma("unroll") for (int k = 0; k < 2; ++k) acc[ai][bj][m][n] = __builtin_amdgcn_mfma_f32_16x16x32_bf16(Bt[n][k], At[m][k], acc[ai][bj][m][n], 0, 0, 0); } } \
        __builtin_amdgcn_s_setprio(0); } while (0)
#define PG8_WAIT_V(n) asm volatile("s_waitcnt vmcnt(" #n ")" ::: "memory")
#define PG8_WAIT_L(n) asm volatile("s_waitcnt lgkmcnt(" #n ")" ::: "memory")
#define PG8_BAR __builtin_amdgcn_s_barrier()
#define PG8_SCHED __builtin_amdgcn_sched_barrier(0)
#define PG8_KBODY(t) do { \
            const bool last = (t == nt - 2); \
            const char* a1 = Ab + (size_t)(t + 1) * kstep; \
            const char* a2 = last ? Ab : Ab + (size_t)(t + 2) * kstep; const char* b2 = last ? nB : cB + (size_t)(t + 2) * kstep; \
            const char* a3 = a2 + kstep; const char* b3 = b2 + kstep; \
              \
            PG8_LDB(B0, 0, 0); PG8_LDB(B1, 0, 1); PG8_SCHED; PG8_LDA(At, 0, 0); PG8_STAGE_A(PG8_SA(1, 1), a1, 1); \
            if (last && has_next) { if constexpr (Desc::GATHER) { _Pragma("unroll") for (int _h = 0; _h < 2; ++_h) _Pragma("unroll") for (int _i = 0; _i < 2; ++_i) { const int _j = _h * HALF + Rs[_i]; const int _id = idbuf[((ui + 1) & 1) * 256 + _j]; vA[_h][_i] = ((nxt.row0 + _j < nxt.cnt) ? (unsigned)(_id >> 2) * 1024u : 0u) + (unsigned)Cs[_i] * 2u; } } else { const u32x4 vn = *vslot; vA[0][0] = vn.x; vA[0][1] = vn.y; vA[1][0] = vn.z; vA[1][1] = vn.w; } }     \
            PG8_WAIT_V(8); PG8_WAIT_L(0); PG8_BAR; PG8_MMA(0, 0, At, B0); PG8_MMA(0, 1, At, B1); PG8_BAR; PG8_SCHED; \
              \
            PG8_LDA(At, 0, 1); PG8_STAGE(PG8_SB(0, 0), b2, voffB); PG8_STAGE(PG8_SB(0, 1), b2 + hstepB, voffB); PG8_STAGE_A(PG8_SA(0, 0), a2, 0); \
            PG8_WAIT_V(8); PG8_WAIT_L(0); PG8_BAR; PG8_MMA(1, 0, At, B0); PG8_MMA(1, 1, At, B1); PG8_BAR; PG8_SCHED; \
              \
            PG8_LDB(B0, 1, 0); PG8_LDB(B1, 1, 1); PG8_SCHED; PG8_LDA(At, 1, 0); PG8_STAGE_A(PG8_SA(0, 1), a2, 1); \
            PG8_WAIT_V(8); PG8_WAIT_L(0); PG8_BAR; PG8_MMA(0, 0, At, B0); PG8_MMA(0, 1, At, B1); PG8_BAR; PG8_SCHED; \
              \
            PG8_LDA(At, 1, 1); PG8_STAGE(PG8_SB(1, 0), b3, voffB); PG8_STAGE(PG8_SB(1, 1), b3 + hstepB, voffB); PG8_STAGE_A(PG8_SA(1, 0), a3, 0); \
            PG8_WAIT_V(8); PG8_WAIT_L(0); PG8_BAR; PG8_MMA(1, 0, At, B0); PG8_MMA(1, 1, At, B1); PG8_BAR; PG8_SCHED; \
        } while (0)
#define PG8_AOFFS(dst, un) do { _Pragma("unroll") for (int _h = 0; _h < 2; ++_h) _Pragma("unroll") for (int _i = 0; _i < 2; ++_i) dst[_h][_i] = g.a_off(un, _h * HALF + Rs[_i]) + (unsigned)Cs[_i] * 2u; } while (0)
    Unit cur, nxt; int ui = 0;
    if (!S.next(0, cur)) return;
    LAS int* const idbuf = (LAS int*)(lds + STAGE_BYTES + 4096);
#define PG8_IDDMA(un, b) do { if (wid < 4) __builtin_amdgcn_global_load_lds((const unsigned*)g.id_src(un, 64 * wid + lane), (LAS unsigned*)(idbuf + (b) * 256 + 64 * wid), 4, 0, 0); } while (0)
    if constexpr (Desc::GATHER) { Unit u1; if (S.next(1, u1)) PG8_IDDMA(u1, 1); }
    f32x4 acc[2][2][4][2];
#pragma unroll
    for (int a = 0; a < 2; ++a)
#pragma unroll
        for (int b = 0; b < 2; ++b)
#pragma unroll
            for (int m = 0; m < 4; ++m)
#pragma unroll
                for (int n = 0; n < 2; ++n) acc[a][b][m][n] = (f32x4){0.f, 0.f, 0.f, 0.f};
    bf16x8 At[4][2], B0[2][2], B1[2][2];
    const char* const Ab = g.a_base(cur);
    const char* cB = g.b_base(cur);
    PG8_AOFFS(vA, cur);
    PG8_STAGE(PG8_SB(0, 0), cB, voffB); PG8_STAGE(PG8_SB(0, 1), cB + hstepB, voffB); PG8_STAGE_A(PG8_SA(0, 0), Ab, 0); PG8_STAGE_A(PG8_SA(0, 1), Ab, 1);
    if (wr == 1) PG8_BAR;
    PG8_WAIT_V(2); PG8_BAR;
    PG8_STAGE(PG8_SB(1, 0), cB + kstep, voffB); PG8_STAGE_A(PG8_SA(1, 0), Ab + kstep, 0); PG8_STAGE(PG8_SB(1, 1), cB + hstepB + kstep, voffB);
    PG8_WAIT_V(6); PG8_BAR;
    for (;;) {
        const bool has_next = S.next(ui + 1, nxt);
        const char* nB = has_next ? g.b_base(nxt) : cB;
        if constexpr (Desc::GATHER) { Unit u2; if (S.next(ui + 2, u2)) PG8_IDDMA(u2, ui & 1); }
        else if (has_next) { unsigned vn[2][2]; PG8_AOFFS(vn, nxt); *vslot = (u32x4){vn[0][0], vn[0][1], vn[1][0], vn[1][1]}; }
        PSTAMP(lds, 40 + PID);
        if constexpr (Epi::MIDK) {
            for (int t = 0; t < nt / 2; t += 2) PG8_KBODY(t);
            E.mid(acc, cur, wr, wc, fr, fq);
            for (int t = nt / 2; t < nt; t += 2) PG8_KBODY(t);
        } else {
            for (int t = 0; t < nt; t += 2) PG8_KBODY(t);
        }
        PSTAMP(lds, 20 + PID);
        if constexpr (ALIGN_EPI) { if (wr == 0) PG8_BAR; }
        E(acc, cur, wr, wc, fr, fq);
        PSTAMP(lds, 30 + PID);
        if (!has_next) break;
#pragma unroll
        for (int a = 0; a < 2; ++a)
#pragma unroll
            for (int b = 0; b < 2; ++b)
#pragma unroll
                for (int m = 0; m < 4; ++m)
#pragma unroll
                    for (int n = 0; n < 2; ++n) acc[a][b][m][n] = (f32x4){0.f, 0.f, 0.f, 0.f};
        cur = nxt; cB = nB; ++ui;
        if constexpr (ALIGN_EPI) { if (wr == 1) PG8_BAR; }
    }
    PG8_WAIT_V(0);
    if constexpr (!ALIGN_EPI) { if (wr == 0) PG8_BAR; }
    PG8_BAR;
#undef PG8_SA
#undef PG8_SB
#undef PG8_STAGE
#undef PG8_STAGE_A
#undef PG8_LDA
#undef PG8_LDB
#undef PG8_MMA
#undef PG8_WAIT_V
#undef PG8_WAIT_L
#undef PG8_BAR
#undef PG8_SCHED
#undef PG8_AOFFS
#undef PG8_KBODY
#undef PG8_IDDMA
}

__device__ __forceinline__ u32x4 pack8(const f32x4& v0, const f32x4& v1) { u32x4 w; w.x = pk2(v0[0], v0[1]); w.y = pk2(v0[2], v0[3]); w.z = pk2(v1[0], v1[1]); w.w = pk2(v1[2], v1[3]); return w; }
__device__ __forceinline__ void unpack8(const u32x4& w, f32x4& v0, f32x4& v1) { v0 = (f32x4){bflo(w.x), bfhi(w.x), bflo(w.y), bfhi(w.y)}; v1 = (f32x4){bflo(w.z), bfhi(w.z), bflo(w.w), bfhi(w.w)}; }
__device__ __forceinline__ float logsig16(float x) { return (fminf(x, 0.f) - log1pf(fexp(-fabsf(x)))) * (1.f / 16.f); }

__device__ __forceinline__ unsigned rot8(unsigned v) { return (unsigned)__builtin_amdgcn_update_dpp(0, (int)v, 0x128, 0xf, 0xf, false); }
__device__ __forceinline__ void pair_exchange(u32x4& a, u32x4& b, bool lo) {
    const u32x4 ra = (u32x4){rot8(a.x), rot8(a.y), rot8(a.z), rot8(a.w)}, rb = (u32x4){rot8(b.x), rot8(b.y), rot8(b.z), rot8(b.w)};
    const u32x4 na = lo ? a : rb, nb = lo ? ra : b; a = na; b = nb;
}
struct EpiProj {
    static constexpr bool PERM = true, MIDK = false;
    bf16* P; const float* b_alpha;
    __device__ __forceinline__ void operator()(const f32x4 (&acc)[2][2][4][2], const Unit& u, int wr, int wc, int fr, int fq) const {
        const int pn = u.pn; const int mode = (pn < 2) ? 1 : (pn == 6 ? 2 : (pn == 20 ? 3 : 0));
        const int cw = pn * 256 + wc * 64 + 8 * fq; const bool lo = fr < 8;
        f32x4 bb[2][2];
#pragma unroll
        for (int bj = 0; bj < 2; ++bj) { bb[bj][0] = (f32x4){0.f, 0.f, 0.f, 0.f}; bb[bj][1] = bb[bj][0];
            if (mode == 3) { bb[bj][0] = *(const f32x4*)(b_alpha + (cw + 32 * bj - C_AL)); bb[bj][1] = *(const f32x4*)(b_alpha + (cw + 32 * bj - C_AL) + 4); } }
#pragma unroll
        for (int ai = 0; ai < 2; ++ai)
#pragma unroll
            for (int m = 0; m < 4; ++m) {
                u32x4 w[2];
#pragma unroll
                for (int bj = 0; bj < 2; ++bj) {
                    f32x4 v0 = acc[ai][bj][m][0], v1 = acc[ai][bj][m][1];
                    if (mode == 1) { v0 = v0 * QSCALE; v1 = v1 * QSCALE; }
                    else if (mode == 2) { v0 = v0 * 0.125f; v1 = v1 * 0.125f; }
                    else if (mode == 3) {
#pragma unroll
                        for (int j = 0; j < 4; ++j) { v0[j] = logsig16(v0[j] + bb[bj][0][j]); v1[j] = logsig16(v1[j] + bb[bj][1][j]); } }
                    w[bj] = pack8(v0, v1);
                }
                pair_exchange(w[0], w[1], lo);
                const int rowA = u.pm * 256 + ai * 128 + wr * 64 + m * 16 + (fr & 7); const int cc = cw + 32 * (fr >> 3);
                __builtin_nontemporal_store(w[0], (u32x4*)(P + (size_t)rowA * NPROJ + cc));
                __builtin_nontemporal_store(w[1], (u32x4*)(P + (size_t)(rowA + 8) * NPROJ + cc));
            }
    }
};
struct EpiBranch {
    static constexpr bool PERM = true, MIDK = true;
    bf16* MG; const bf16* P;
    __device__ __forceinline__ void mid(f32x4 (&acc)[2][2][4][2], const Unit& u, int wr, int wc, int fr, int fq) const {
        const int cw = u.pn * 256 + wc * 64 + 8 * fq;
#pragma unroll
        for (int ai = 0; ai < 2; ++ai)
#pragma unroll
            for (int m = 0; m < 4; ++m) {
                const bf16* pr = P + (size_t)(u.pm * 256 + ai * 128 + wr * 64 + m * 16 + fr) * NPROJ + cw;
#pragma unroll
                for (int bj = 0; bj < 2; ++bj) {
                    const u32x4 gaw = __builtin_nontemporal_load((const u32x4*)(pr + C_GA + 32 * bj)), gbw = *(const u32x4*)(pr + C_GB + 32 * bj);
                    f32x4 a0, a1, b0, b1; unpack8(gaw, a0, a1); unpack8(gbw, b0, b1);
#pragma unroll
                    for (int j = 0; j < 4; ++j) {
                        acc[ai][bj][m][0][j] *= (1.f + fexp(-__builtin_amdgcn_fmed3f(b0[j], -30.f, 30.f))) * __builtin_amdgcn_rcpf(1.f + fexp(-a0[j]));
                        acc[ai][bj][m][1][j] *= (1.f + fexp(-__builtin_amdgcn_fmed3f(b1[j], -30.f, 30.f))) * __builtin_amdgcn_rcpf(1.f + fexp(-a1[j])); }
                }
                if (m & 1) asm volatile("" ::: "memory");
            }
    }
    __device__ __forceinline__ void operator()(const f32x4 (&acc)[2][2][4][2], const Unit& u, int wr, int wc, int fr, int fq) const {
        const int cw = u.pn * 256 + wc * 64 + 8 * fq; const bool lo = fr < 8;
#pragma unroll
        for (int ai = 0; ai < 2; ++ai)
#pragma unroll
            for (int m = 0; m < 4; ++m) {
                const int row = u.pm * 256 + ai * 128 + wr * 64 + m * 16 + fr;
                u32x4 w[2];
#pragma unroll
                for (int bj = 0; bj < 2; ++bj) {
                    const u32x4 gbw = __builtin_nontemporal_load((const u32x4*)(P + (size_t)row * NPROJ + C_GB + cw + 32 * bj));
                    f32x4 b0, b1; unpack8(gbw, b0, b1);
                    f32x4 v0 = acc[ai][bj][m][0], v1 = acc[ai][bj][m][1];
#pragma unroll
                    for (int j = 0; j < 4; ++j) { v0[j] *= __builtin_amdgcn_rcpf(1.f + fexp(-__builtin_amdgcn_fmed3f(b0[j], -30.f, 30.f))); v1[j] *= __builtin_amdgcn_rcpf(1.f + fexp(-__builtin_amdgcn_fmed3f(b1[j], -30.f, 30.f))); }
                    w[bj] = pack8(v0, v1);
                }
                pair_exchange(w[0], w[1], lo);
                const int rowA = u.pm * 256 + ai * 128 + wr * 64 + m * 16 + (fr & 7); const int cc = cw + 32 * (fr >> 3);
                *(u32x4*)(MG + (size_t)rowA * DM + cc) = w[0];
                *(u32x4*)(MG + (size_t)(rowA + 8) * DM + cc) = w[1];
            }
    }
};
struct EpiOut {
    static constexpr bool PERM = true, MIDK = false;
    bf16* Y1; const float* mod;
    __device__ __forceinline__ void operator()(const f32x4 (&acc)[2][2][4][2], const Unit& u, int wr, int wc, int fr, int fq) const {
        const int b = u.pm >> 3; const float* gt1 = mod + b * 6144 + 2048;
        const int cw = u.pn * 256 + wc * 64 + 8 * fq; const bool lo = fr < 8;
        f32x4 g[2][2];
#pragma unroll
        for (int bj = 0; bj < 2; ++bj) { g[bj][0] = *(const f32x4*)(gt1 + cw + 32 * bj); g[bj][1] = *(const f32x4*)(gt1 + cw + 32 * bj + 4); }
#pragma unroll
        for (int ai = 0; ai < 2; ++ai)
#pragma unroll
            for (int m = 0; m < 4; ++m) {
                u32x4 wa = pack8(acc[ai][0][m][0] * g[0][0], acc[ai][0][m][1] * g[0][1]), wb = pack8(acc[ai][1][m][0] * g[1][0], acc[ai][1][m][1] * g[1][1]);
                pair_exchange(wa, wb, lo);
                const int rowA = u.pm * 256 + ai * 128 + wr * 64 + m * 16 + (fr & 7); const int cc = cw + 32 * (fr >> 3);
                *(u32x4*)(Y1 + (size_t)rowA * DM + cc) = wa;
                *(u32x4*)(Y1 + (size_t)(rowA + 8) * DM + cc) = wb;
            }
    }
};
struct EpiUp {
    static constexpr bool PERM = true, MIDK = false;
    unsigned char* ACT; const float* b_gu;
    __device__ __forceinline__ void operator()(const f32x4 (&acc)[2][2][4][2], const Unit& u, int wr, int wc, int fr, int fq) const {
        const int f0 = u.pn * 128 + wc * 32 + 8 * fq;
        const float* bg = b_gu + (size_t)u.e * 2048 + f0; const float* bu = bg + 1024;
        const f32x4 bg0 = *(const f32x4*)bg, bg1 = *(const f32x4*)(bg + 4), bu0 = *(const f32x4*)bu, bu1 = *(const f32x4*)(bu + 4);
#pragma unroll
        for (int ai = 0; ai < 2; ++ai)
#pragma unroll
            for (int m = 0; m < 4; ++m) {
                const int r = ai * 128 + wr * 64 + m * 16 + fr;
                f32x4 g0 = acc[ai][0][m][0] + bg0, g1 = acc[ai][0][m][1] + bg1, u0 = acc[ai][1][m][0] + bu0, u1 = acc[ai][1][m][1] + bu1, a0, a1;
#pragma unroll
                for (int j = 0; j < 4; ++j) {
                    float gg = fminf(g0[j], 7.f), uu = fminf(fmaxf(u0[j], -7.f), 7.f); a0[j] = (uu + 1.f) * gg * sigmoidf_(1.702f * gg);
                    gg = fminf(g1[j], 7.f); uu = fminf(fmaxf(u1[j], -7.f), 7.f); a1[j] = (uu + 1.f) * gg * sigmoidf_(1.702f * gg); }
                *(u32x2*)(ACT + (size_t)(u.pm * 256 + r) * FF + f0) = (u32x2){pk4_fp8(a0[0] * F8_ASCALE, a0[1] * F8_ASCALE, a0[2] * F8_ASCALE, a0[3] * F8_ASCALE), pk4_fp8(a1[0] * F8_ASCALE, a1[1] * F8_ASCALE, a1[2] * F8_ASCALE, a1[3] * F8_ASCALE)};
            }
    }
};
constexpr float F8_YSCALE = 16.f;
__device__ __forceinline__ void pair_exchange2(u32x2& a, u32x2& b, bool lo) {
    const u32x2 ra = (u32x2){rot8(a.x), rot8(a.y)}, rb = (u32x2){rot8(b.x), rot8(b.y)};
    const u32x2 na = lo ? a : rb, nb = lo ? ra : b; a = na; b = nb;
}
struct EpiDown {
    static constexpr bool PERM = true, MIDK = false;
    unsigned char* YB; const float* b_dn; const int* list;
    __device__ __forceinline__ void operator()(const f32x4 (&acc)[2][2][4][2], const Unit& u, int wr, int wc, int fr, int fq) const {
        const int cw = u.pn * 256 + wc * 64 + 8 * fq; const bool lo = fr < 8;
        f32x4 bb[2][2];
#pragma unroll
        for (int bj = 0; bj < 2; ++bj) { const float* bp = b_dn + (size_t)u.e * DM + cw + 32 * bj; bb[bj][0] = *(const f32x4*)bp; bb[bj][1] = *(const f32x4*)(bp + 4); }
#pragma unroll
        for (int ai = 0; ai < 2; ++ai)
#pragma unroll
            for (int m = 0; m < 4; ++m) {
                const int slot = u.row0 + ai * 128 + wr * 64 + m * 16 + fr;
                const int aid = slot < u.cnt ? list[u.e * NTOK + slot] : -1;
                const int aidx = (int)rot8((unsigned)aid);
                u32x2 w[2];
#pragma unroll
                for (int bj = 0; bj < 2; ++bj) { f32x4 v0 = (acc[ai][bj][m][0] + bb[bj][0]) * F8_YSCALE, v1 = (acc[ai][bj][m][1] + bb[bj][1]) * F8_YSCALE;
#pragma unroll
                    for (int j = 0; j < 4; ++j) { v0[j] = __builtin_amdgcn_fmed3f(v0[j], -440.f, 440.f); v1[j] = __builtin_amdgcn_fmed3f(v1[j], -440.f, 440.f); }
                    w[bj] = (u32x2){pk4_fp8(v0[0], v0[1], v0[2], v0[3]), pk4_fp8(v1[0], v1[1], v1[2], v1[3])}; }
                pair_exchange2(w[0], w[1], lo);
                const int aidA = lo ? aid : aidx, aidB = lo ? aidx : aid;
                const int cc = cw + 32 * (fr >> 3);
                if (aidA >= 0) *(u32x2*)(YB + (size_t)aidA * DM + cc) = w[0];
                if (aidB >= 0) *(u32x2*)(YB + (size_t)aidB * DM + cc) = w[1];
            }
    }
};

__device__ __forceinline__ void split_bf16(const float (&v)[8], bf16x8& hi, bf16x8& lo) {
    const unsigned h0 = pk2(v[0], v[1]), h1 = pk2(v[2], v[3]), h2 = pk2(v[4], v[5]), h3 = pk2(v[6], v[7]);
    const u32x4 h = (u32x4){h0, h1, h2, h3};
    const u32x4 l = (u32x4){pk2(v[0] - bflo(h0), v[1] - bfhi(h0)), pk2(v[2] - bflo(h1), v[3] - bfhi(h1)), pk2(v[4] - bflo(h2), v[5] - bfhi(h2)), pk2(v[6] - bflo(h3), v[7] - bfhi(h3))};
    hi = __builtin_bit_cast(bf16x8, h); lo = __builtin_bit_cast(bf16x8, l);
}
constexpr int T_NITEMS = 16 * 80 + 2 * 8 * 16 + 16 * 16 + 32 * 16 * 32 + 32 * 16 * 16;
__device__ __forceinline__ void transposes(const Ctx& C, int i0, int i1, int w, int nw);
__device__ __forceinline__ void phase_mod(const Ctx& C) {
    LAS float* sc = (LAS float*)C.lds;
    LAS float* red = sc + 16 * 1024;
    for (int cb = C.bid; cb < 96; cb += C.G) {
        __syncthreads();
        for (int i = C.tid; i < 16 * 1024; i += NTHREADS) { const float v = C.c[i]; sc[i] = v / (1.f + fexp(-v)); }
        __syncthreads();
        const int cl = C.tid & 63, ks = C.tid >> 6, col = cb * 64 + cl;
        float acc[16];
#pragma unroll
        for (int b = 0; b < 16; ++b) acc[b] = 0.f;
#pragma unroll 2
        for (int k = ks * 128; k < ks * 128 + 128; k += 4) {
            const float w0 = __builtin_nontemporal_load(C.w_ada + (size_t)k * 6144 + col), w1 = __builtin_nontemporal_load(C.w_ada + (size_t)(k + 1) * 6144 + col), w2 = __builtin_nontemporal_load(C.w_ada + (size_t)(k + 2) * 6144 + col), w3 = __builtin_nontemporal_load(C.w_ada + (size_t)(k + 3) * 6144 + col);
#pragma unroll
            for (int b = 0; b < 16; ++b) { const f32x4 s4 = *(const LAS f32x4*)(sc + b * 1024 + k); acc[b] += (s4[0] * w0 + s4[1] * w1) + (s4[2] * w2 + s4[3] * w3); }
        }
#pragma unroll
        for (int b = 0; b < 16; ++b) red[(ks * 16 + b) * 64 + cl] = acc[b];
        __syncthreads();
        for (int o = C.tid; o < 1024; o += NTHREADS) {
            const int b = o >> 6, c2 = o & 63; float s = 0.f;
#pragma unroll
            for (int k2 = 0; k2 < 8; ++k2) s += red[(k2 * 16 + b) * 64 + c2];
            C.mod[b * 6144 + cb * 64 + c2] = s + C.b_ada[cb * 64 + c2];
        }
    }
    __syncthreads();
    { const int gw = C.bid * NWAVES + C.wid, NGW = C.G * NWAVES;
      if (C.G == 256) { constexpr int N1 = 11 * 2048; transposes(C, 0, N1, gw, NGW); if (C.bid >= 96) transposes(C, N1, T_NITEMS, gw - 96 * NWAVES, NGW - 96 * NWAVES); }
      else transposes(C, 0, T_NITEMS, gw, NGW); }
    for (int idx = C.bid * NTHREADS + C.tid; idx < 4096; idx += C.G * NTHREADS) {
        const int l2 = idx & 63, nt = (idx >> 6) & 1, ks = (idx >> 7) & 3, w2 = idx >> 9; float wv[8];
#pragma unroll
        for (int j = 0; j < 8; ++j) wv[j] = C.w_router[(size_t)(128 * w2 + 32 * ks + 8 * (l2 >> 4) + j) * NE + 16 * nt + (l2 & 15)];
        bf16x8 h8, l8; split_bf16(wv, h8, l8); C.wrf[idx] = __builtin_bit_cast(u32x4, h8); C.wrf[4096 + idx] = __builtin_bit_cast(u32x4, l8); }
    for (int gt = C.bid * NTHREADS + C.tid; gt < 256 * 512; gt += C.G * NTHREADS) {
        const int j = gt >> 9, k = (gt & 511) * 2;
        float s0 = 0.f, s1 = 0.f;
#pragma unroll
        for (int r = 0; r < 16; ++r) { const float wa = C.w_alpha_up[r * 256 + j]; s0 += C.w_in[(size_t)k * W_IN_N + 3072 + r] * wa; s1 += C.w_in[(size_t)(k + 1) * W_IN_N + 3072 + r] * wa; }
        *(unsigned*)(C.WinT + (size_t)(C_AL + j) * DM + k) = pk2(s0, s1);
    }
}

struct TItem { const float* src; unsigned char* dst; int srcN, pitch, hop, fp8; };
__device__ __forceinline__ TItem titem_decode(const Ctx& C, int it) {
    constexpr int I_IN = 16 * 80, I_BD = 8 * 16, I_OUT = 16 * 16, I_GU = 32 * 16 * 32;
    TItem t; t.hop = 0; t.fp8 = 0; int r = it;
    if (r < I_IN) { const int kb = r / 80, n0 = (r % 80) * 64; t.srcN = W_IN_N; t.pitch = DM * 2; t.src = C.w_in + (size_t)(kb * 64) * W_IN_N + (n0 < 3072 ? n0 : n0 + 16); t.dst = (unsigned char*)(C.WinT + (size_t)n0 * DM + kb * 64); return t; } r -= I_IN;
    if (r < I_BD) { t.srcN = DM; t.pitch = 2048; t.src = C.w_bd + (size_t)((r >> 4) * 64) * DM + (r & 15) * 64; t.dst = (unsigned char*)(C.WbdT + (size_t)((r & 15) * 64) * 1024 + (r >> 4) * 64); return t; } r -= I_BD;
    if (r < I_BD) { t.srcN = DM; t.pitch = 2048; t.src = C.w_bg + (size_t)((r >> 4) * 64) * DM + (r & 15) * 64; t.dst = (unsigned char*)(C.WbdT + (size_t)((r & 15) * 64) * 1024 + 512 + (r >> 4) * 64); return t; } r -= I_BD;
    if (r < I_OUT) { t.srcN = DM; t.pitch = DM * 2; t.src = C.w_out + (size_t)((r >> 4) * 64) * DM + (r & 15) * 64; t.dst = (unsigned char*)(C.WoutT + (size_t)((r & 15) * 64) * DM + (r >> 4) * 64); return t; } r -= I_OUT;
    if (r < I_GU) { const int e = r >> 9, rr = r & 511, kb = rr >> 5, n0 = (rr & 31) * 64; const int pn = n0 >> 8, wc = (n0 >> 6) & 3;
        t.srcN = 2048; t.pitch = 1024; t.fp8 = 1; t.hop = 1024 - 32; t.src = C.w_gu + (size_t)e * DM * 2048 + (size_t)(kb * 64) * 2048 + pn * 128 + wc * 32; t.dst = (unsigned char*)C.WguT + (size_t)e * 2048 * 1024 + (size_t)n0 * 1024 + kb * 64; return t; } r -= I_GU;
    { const int e = r >> 8, rr = r & 255, kb = rr >> 4, n0 = (rr & 15) * 64;
        t.srcN = DM; t.pitch = 1024; t.fp8 = 1; t.src = C.w_dn + (size_t)e * FF * DM + (size_t)(kb * 64) * DM + n0; t.dst = (unsigned char*)C.WdT + (size_t)e * DM * 1024 + (size_t)n0 * 1024 + kb * 64; return t; }
}
__device__ __forceinline__ void titem_load(const TItem& t, int lane, f32x4 (&v)[16]) {
#pragma unroll
    for (int i = 0; i < 16; ++i) v[i] = __builtin_nontemporal_load((const f32x4*)(t.src + (size_t)(4 * i + (lane >> 4)) * t.srcN + 4 * (lane & 15) + ((lane & 8) ? t.hop : 0)));
}
__device__ __forceinline__ void titem_store(const TItem& t, int lane, const f32x4 (&v)[16], LAS float* scr) {
#pragma unroll
    for (int i = 0; i < 16; ++i) { LAS float* p = scr + (4 * i + (lane >> 4)) * 65 + 4 * (lane & 15); p[0] = v[i][0]; p[1] = v[i][1]; p[2] = v[i][2]; p[3] = v[i][3]; }
    LDS_WAIT(); asm volatile("" ::: "memory");
    const int c = lane & 7;
#pragma unroll
    for (int j = 0; j < 8; ++j) { const int n = (lane >> 3) + 8 * j; const LAS float* s = scr + (8 * c) * 65 + n;
        if (t.fp8) { float w[8];
#pragma unroll
            for (int q = 0; q < 8; ++q) w[q] = __builtin_amdgcn_fmed3f(s[q * 65] * F8_WSCALE, -440.f, 440.f);
            __builtin_nontemporal_store((u32x2){pk4_fp8(w[0], w[1], w[2], w[3]), pk4_fp8(w[4], w[5], w[6], w[7])}, (u32x2*)(t.dst + (size_t)n * t.pitch + 8 * c)); }
        else { u32x4 o; o.x = pk2(s[0 * 65], s[1 * 65]); o.y = pk2(s[2 * 65], s[3 * 65]); o.z = pk2(s[4 * 65], s[5 * 65]); o.w = pk2(s[6 * 65], s[7 * 65]);
            *(u32x4*)(t.dst + (size_t)n * t.pitch + 16 * c) = o; } }
    LDS_WAIT(); asm volatile("" ::: "memory");
}
__device__ __forceinline__ void transposes(const Ctx& C, int i0, int i1, int w, int nw) {
    LAS float* scr = (LAS float*)(C.lds + C.wid * 16896);
    int it = i0 + w; if (it >= i1) return;
    TItem cur = titem_decode(C, it); f32x4 v[16]; titem_load(cur, C.lane, v);
    for (;;) {
        const int nit = it + nw; const bool more = nit < i1;
        TItem nxt = cur; f32x4 vn[16];
        if (more) { nxt = titem_decode(C, nit); titem_load(nxt, C.lane, vn); }
        titem_store(cur, C.lane, v, scr);
        if (!more) break;
        cur = nxt; it = nit;
#pragma unroll
        for (int i = 0; i < 16; ++i) v[i] = vn[i];
    }
}
__device__ __forceinline__ void phase_prep(const Ctx& C) {
    const int gw = C.bid * NWAVES + C.wid, NGW = C.G * NWAVES;
    for (int r0 = gw * 16; r0 < NTOK; r0 += NGW * 16) {
        const int b = r0 >> 11; const float* md = C.mod + b * 6144;
        f32x4 gs[4], sh[4];
#pragma unroll
        for (int j = 0; j < 4; ++j) { const int c0 = 4 * C.lane + 256 * j; gs[j] = *(const f32x4*)(C.norm1_g + c0) * (*(const f32x4*)(md + 1024 + c0) + 1.f); sh[j] = *(const f32x4*)(md + c0); }
#pragma unroll 1
        for (int rr = 0; rr < 16; rr += 2) {
            f32x4 v[2][4]; float ss[2] = {0.f, 0.f};
#pragma unroll
            for (int r = 0; r < 2; ++r)
#pragma unroll
                for (int j = 0; j < 4; ++j) v[r][j] = __builtin_nontemporal_load((const f32x4*)(C.x + (size_t)(r0 + rr + r) * DM + 4 * C.lane + 256 * j));
#pragma unroll
            for (int r = 0; r < 2; ++r)
#pragma unroll
                for (int j = 0; j < 4; ++j) ss[r] += (v[r][j][0] * v[r][j][0] + v[r][j][1] * v[r][j][1]) + (v[r][j][2] * v[r][j][2] + v[r][j][3] * v[r][j][3]);
#pragma unroll
            for (int r = 0; r < 2; ++r) { const float rstd = rsqrtf(wave_sum(ss[r]) * (1.f / DM) + EPS);
#pragma unroll
                for (int j = 0; j < 4; ++j) { const f32x4 y = v[r][j] * rstd * gs[j] + sh[j];
                    u32x2 o; o.x = pk2(y[0], y[1]); o.y = pk2(y[2], y[3]);
                    *(u32x2*)(C.H + (size_t)(r0 + rr + r) * DM + 4 * C.lane + 256 * j) = o; } }
        }
    }
}

__device__ __forceinline__ void gla_scan(const Ctx& C, int b, int h) {
    LAS float* qs = (LAS float*)C.lds;
    LAS float* ks = qs + 2048;
    LAS float* al = ks + 2048;
    LAS float* vs = al + 2048;
    LAS float* part = vs + 4096;
    const int dv = C.tid & 127, dkg = C.tid >> 7;
    float S[16];
#pragma unroll
    for (int j = 0; j < 16; ++j) S[j] = 0.f;
    const float gdv0 = C.gla_g[2 * C.lane], gdv1 = C.gla_g[2 * C.lane + 1];
    for (int ch = 0; ch < SEQ / 32; ++ch) {
        const int row0 = b * SEQ + ch * 32;
        __syncthreads();
        for (int i = C.tid; i < 32 * 64; i += NTHREADS) { const int t = i >> 6, d = i & 63; const bf16* pr = C.PROJ + (size_t)(row0 + t) * NPROJ;
            qs[i] = bf2f(pr[C_GQ + h * 64 + d]); ks[i] = bf2f(pr[C_GK + h * 64 + d]); al[i] = fexp(bf2f(pr[C_AL + h * 64 + d])); }
        for (int i = C.tid; i < 32 * 128; i += NTHREADS) { const int t = i >> 7, d = i & 127; vs[i] = bf2f(C.PROJ[(size_t)(row0 + t) * NPROJ + C_GV + h * 128 + d]); }
        __syncthreads();
#pragma unroll 2
        for (int t = 0; t < 32; ++t) {
            const float v = vs[t * 128 + dv]; float o = 0.f;
#pragma unroll
            for (int j4 = 0; j4 < 4; ++j4) {
                const f32x4 a4 = *(const LAS f32x4*)(al + t * 64 + dkg * 16 + j4 * 4), k4 = *(const LAS f32x4*)(ks + t * 64 + dkg * 16 + j4 * 4), q4 = *(const LAS f32x4*)(qs + t * 64 + dkg * 16 + j4 * 4);
#pragma unroll
                for (int jj = 0; jj < 4; ++jj) { const int j = j4 * 4 + jj; S[j] = a4[jj] * S[j] + k4[jj] * v; o += q4[jj] * S[j]; }
            }
            part[(dkg * 32 + t) * 128 + dv] = o;
        }
        __syncthreads();
#pragma unroll
        for (int tt = 0; tt < 4; ++tt) {
            const int t = 4 * C.wid + tt; float o0 = 0.f, o1 = 0.f;
#pragma unroll
            for (int g = 0; g < 4; ++g) { o0 += part[(g * 32 + t) * 128 + 2 * C.lane]; o1 += part[(g * 32 + t) * 128 + 2 * C.lane + 1]; }
            const float rstd = rsqrtf(wave_sum(o0 * o0 + o1 * o1) * (1.f / 128.f) + EPS);
            const unsigned grw = *(const unsigned*)(C.PROJ + (size_t)(row0 + t) * NPROJ + C_GR + h * 128 + 2 * C.lane);
            const float g0 = bflo(grw), g1 = bfhi(grw);
            const float y0 = o0 * rstd * gdv0 * (g0 * sigmoidf_(g0)), y1 = o1 * rstd * gdv1 * (g1 * sigmoidf_(g1));
            *(unsigned*)(C.OB + (size_t)(row0 + t) * 512 + h * 128 + 2 * C.lane) = pk2(y0, y1);
        }
    }
}

__device__ __forceinline__ void attn_simple(const Ctx& C) {
    LAS float* Kt = (LAS float*)C.lds;
    LAS float* Vt = Kt + 8192;
    LAS float* Ss = Vt + 8192;
    LAS float* ssq = Ss + 2 * 64 * 68;
    LAS float* lamp = ssq + 256;
    if (C.tid < 64) {
        const float a = wave_sum(C.lq1[C.lane] * C.lk1[C.lane]), b2 = wave_sum(C.lq2[C.lane] * C.lk2[C.lane]);
        if (C.tid == 0) lamp[0] = fexp(a) - fexp(b2) + 0.2f;
    }
    __syncthreads();
    const float lam = lamp[0];
    const int q = C.tid & 63, p = (C.tid >> 6) & 1, dq = C.tid >> 7;
    for (int uix = C.bid; uix < 2048; uix += C.G) {
        const int bh = uix & 63, g = (uix >> 6) & 3, i2 = uix >> 8; const int b = bh >> 2, h = bh & 3;
        const int qc = (i2 & 1) ? (31 - (4 * g + (i2 >> 1))) : (4 * g + (i2 >> 1));
        const float sl2 = exp2f(-2.f * (float)(h + 1)) * LOG2E;
        const int qrow = b * SEQ + qc * 64 + q;
        float qv[64];
#pragma unroll
        for (int d8 = 0; d8 < 8; ++d8) { const u32x4 w = *(const u32x4*)(C.PROJ + (size_t)qrow * NPROJ + C_DQ + h * 128 + p * 64 + d8 * 8);
            qv[d8 * 8 + 0] = bflo(w.x); qv[d8 * 8 + 1] = bfhi(w.x); qv[d8 * 8 + 2] = bflo(w.y); qv[d8 * 8 + 3] = bfhi(w.y);
            qv[d8 * 8 + 4] = bflo(w.z); qv[d8 * 8 + 5] = bfhi(w.z); qv[d8 * 8 + 6] = bflo(w.w); qv[d8 * 8 + 7] = bfhi(w.w); }
        float m = -1e30f, l = 0.f, acc[32];
#pragma unroll
        for (int d = 0; d < 32; ++d) acc[d] = 0.f;
        for (int kc = 0; kc <= qc; ++kc) {
            __syncthreads();
            for (int pi = C.tid; pi < 1024; pi += NTHREADS) { const int r = pi >> 4, cc = pi & 15; const bf16* pr = C.PROJ + (size_t)(b * SEQ + kc * 64 + r) * NPROJ + h * 128 + cc * 8;
                const u32x4 kw = *(const u32x4*)(pr + C_DK), vw = *(const u32x4*)(pr + C_DV); f32x4 a0, a1;
                unpack8(kw, a0, a1); *(LAS f32x4*)(Kt + r * 128 + cc * 8) = a0; *(LAS f32x4*)(Kt + r * 128 + cc * 8 + 4) = a1;
                unpack8(vw, a0, a1); *(LAS f32x4*)(Vt + r * 128 + cc * 8) = a0; *(LAS f32x4*)(Vt + r * 128 + cc * 8 + 4) = a1; }
            __syncthreads();
#pragma unroll 1
            for (int kk = 0; kk < 16; ++kk) {
                const int key = dq * 16 + kk; float s = 0.f;
#pragma unroll
                for (int d4 = 0; d4 < 16; ++d4) { const f32x4 kv = *(const LAS f32x4*)(Kt + key * 128 + p * 64 + d4 * 4);
                    s += qv[d4 * 4] * kv[0]; s += qv[d4 * 4 + 1] * kv[1]; s += qv[d4 * 4 + 2] * kv[2]; s += qv[d4 * 4 + 3] * kv[3]; }
                const int kpos = kc * 64 + key, qpos = qc * 64 + q; const int mn = kpos < 2 * qpos - kpos ? kpos : 2 * qpos - kpos;
                Ss[(p * 64 + q) * 68 + key] = s + sl2 * (float)mn;
            }
            __syncthreads();
            const LAS float* srow = Ss + (p * 64 + q) * 68;
            float cm = -1e30f;
#pragma unroll
            for (int k4 = 0; k4 < 16; ++k4) { const f32x4 sv = *(const LAS f32x4*)(srow + k4 * 4); cm = fmaxf(cm, fmaxf(fmaxf(sv[0], sv[1]), fmaxf(sv[2], sv[3]))); }
            const float mnew = fmaxf(m, cm), alpha = exp2f(m - mnew); m = mnew; l *= alpha;
#pragma unroll
            for (int d = 0; d < 32; ++d) acc[d] *= alpha;
#pragma unroll 2
            for (int key = 0; key < 64; ++key) {
                const float pk = exp2f(srow[key] - m); l += pk;
#pragma unroll
                for (int d4 = 0; d4 < 8; ++d4) { const f32x4 vv = *(const LAS f32x4*)(Vt + key * 128 + dq * 32 + d4 * 4);
                    acc[d4 * 4] += pk * vv[0]; acc[d4 * 4 + 1] += pk * vv[1]; acc[d4 * 4 + 2] += pk * vv[2]; acc[d4 * 4 + 3] += pk * vv[3]; }
            }
        }
        const float inv = 1.f / l;
        __syncthreads();
        LAS float* O2 = Ss;
        if (p == 1) {
#pragma unroll
            for (int d = 0; d < 32; ++d) O2[q * 128 + dq * 32 + d] = lam * acc[d] * inv;
        }
        __syncthreads();
        float ss = 0.f;
        if (p == 0) {
#pragma unroll
            for (int d = 0; d < 32; ++d) { acc[d] = acc[d] * inv - O2[q * 128 + dq * 32 + d]; ss += acc[d] * acc[d]; }
            ssq[q * 4 + dq] = ss;
        }
        __syncthreads();
        if (p == 0) {
            const float tot = (ssq[q * 4] + ssq[q * 4 + 1]) + (ssq[q * 4 + 2] + ssq[q * 4 + 3]);
            const float rstd = rsqrtf(tot * (1.f / 128.f) + EPS) * 0.8f;
            bf16* dst = C.OA + (size_t)qrow * 512 + h * 128 + dq * 32;
#pragma unroll
            for (int d8 = 0; d8 < 4; ++d8) { u32x4 w; const float* gg = C.diff_g + dq * 32 + d8 * 8;
                w.x = pk2(acc[d8 * 8] * rstd * gg[0], acc[d8 * 8 + 1] * rstd * gg[1]); w.y = pk2(acc[d8 * 8 + 2] * rstd * gg[2], acc[d8 * 8 + 3] * rstd * gg[3]);
                w.z = pk2(acc[d8 * 8 + 4] * rstd * gg[4], acc[d8 * 8 + 5] * rstd * gg[5]); w.w = pk2(acc[d8 * 8 + 6] * rstd * gg[6], acc[d8 * 8 + 7] * rstd * gg[7]);
                *(u32x4*)(dst + d8 * 8) = w; }
        }
    }
}


typedef float f32x16 __attribute__((ext_vector_type(16)));
typedef short s16x4 __attribute__((ext_vector_type(4)));
typedef short v4i16_t __attribute__((ext_vector_type(4)));
__device__ __forceinline__ s16x4 vtr(const LAS unsigned char* p) { return __builtin_bit_cast(s16x4, __builtin_amdgcn_ds_read_tr16_b64_v4i16((LAS v4i16_t*)p)); }
template <int OFF> __device__ __forceinline__ void glds16(const void* sbase, unsigned voff, unsigned lds_dst) {
    unsigned sv; asm volatile("s_mov_b32 %0, m0\n\ts_mov_b32 m0, %3\n\ts_nop 0\n\tglobal_load_lds_dwordx4 %1, %2 offset:%4\n\ts_mov_b32 m0, %0" : "=&s"(sv) : "v"(voff), "s"(sbase), "s"(lds_dst), "i"(OFF) : "memory"); }
__device__ __forceinline__ unsigned lds_addr(const LAS unsigned char* p) { return (unsigned)__builtin_amdgcn_readfirstlane((int)(unsigned)(size_t)p); }
#define MFMA16(a, b, c) __builtin_amdgcn_mfma_f32_16x16x32_bf16(a, b, c, 0, 0, 0)
__device__ __forceinline__ bf16x8 cat44(s16x4 lo, s16x4 hi) { return (bf16x8){lo[0], lo[1], lo[2], lo[3], hi[0], hi[1], hi[2], hi[3]}; }
__device__ __forceinline__ void gla_chunked(const Ctx& C, int b, int h) {
    const int lane = C.lane, wid = C.wid, fr = lane & 15, fq = lane >> 4;
    LAS unsigned char* lds = C.lds;
    constexpr int RAW_Q = 0, RAW_K = 8192, RAW_LA = 16384, VB0 = 24576, QS = 57344, KS = 66560, KD = 75776, AM = 84992, ST = 94208, OO = 112640, GTL = 146432, SSQ = 146688;
    constexpr int P = 144, PO = 528;
    const char* pbase = (const char*)(C.PROJ + (size_t)(b * SEQ) * NPROJ);
    const unsigned oq = (unsigned)(((8 * wid + (lane >> 3)) * NPROJ + C_GQ + h * 64 + (lane & 7) * 8) * 2);
    const unsigned okk = oq + (unsigned)((C_GK - C_GQ) * 2), ol = oq + (unsigned)((C_AL - C_GQ) * 2);
    const unsigned ov0 = (unsigned)(((4 * wid + (lane >> 4)) * NPROJ + C_GV + h * 128 + (lane & 15) * 8) * 2), ov1 = ov0 + (unsigned)(32 * NPROJ * 2);
#define GL_DMA(n) do { const char* _cb = pbase + (size_t)(n) * 64 * NPROJ * 2; const unsigned _vb = VB0 + ((n) & 1) * 16384; \
        glds16<0>(_cb, oq, lds_addr(lds + RAW_Q + wid * 1024)); glds16<0>(_cb, okk, lds_addr(lds + RAW_K + wid * 1024)); glds16<0>(_cb, ol, lds_addr(lds + RAW_LA + wid * 1024)); \
        glds16<0>(_cb, ov0, lds_addr(lds + _vb + wid * 1024)); glds16<0>(_cb, ov1, lds_addr(lds + _vb + (wid + 8) * 1024)); } while (0)
    __syncthreads();
    GL_DMA(0);
    for (int i = lane; i < 16 * P / 4; i += 64) ((LAS unsigned*)(lds + ST + wid * 16 * P))[i] = 0u;
    f32x4 accS[4];
#pragma unroll
    for (int t = 0; t < 4; ++t) accS[t] = (f32x4){0.f, 0.f, 0.f, 0.f};
    const int t1 = wid >> 1, ca = 2 * (wid & 1);
    bf16x8 ym[2][2];
#pragma unroll
    for (int ci = 0; ci < 2; ++ci)
#pragma unroll
        for (int ks = 0; ks < 2; ++ks)
#pragma unroll
            for (int jj = 0; jj < 8; ++jj) ym[ci][ks][jj] = (short)(((32 * ks + 8 * fq + jj) <= (16 * (ca + ci) + fr)) ? 0x3F80 : 0);
    const bf16x8 ones = (bf16x8){0x3F80, 0x3F80, 0x3F80, 0x3F80, 0x3F80, 0x3F80, 0x3F80, 0x3F80};
    const int qp = (lane & 15) >> 2, pp = lane & 3;
    const float g0 = C.gla_g[2 * lane], g1 = C.gla_g[2 * lane + 1];
    unsigned grw[8];
#pragma unroll
    for (int cc = 0; cc < 8; ++cc) grw[cc] = 0u;
#define GL_ROWPASS(n) do { _Pragma("unroll") for (int cc = 0; cc < 8; ++cc) { const int c_ = 8 * wid + cc; \
        const float o0 = *(const LAS float*)(lds + OO + c_ * PO + lane * 8), o1 = *(const LAS float*)(lds + OO + c_ * PO + lane * 8 + 4); \
        const f32x4 qa = *(const LAS f32x4*)(lds + SSQ + c_ * 32), qb = *(const LAS f32x4*)(lds + SSQ + c_ * 32 + 16); \
        const float rstd = rsqrtf((((qa[0] + qa[1]) + (qa[2] + qa[3])) + ((qb[0] + qb[1]) + (qb[2] + qb[3]))) * (1.f / 128.f) + EPS); const float gr0 = bflo(grw[cc]), gr1 = bfhi(grw[cc]); \
        *(unsigned*)(C.OA + (size_t)(b * SEQ + (n) * 64 + c_) * 1024 + 512 + h * 128 + 2 * lane) = pk2(o0 * rstd * g0 * (gr0 * sigmoidf_(gr0)), o1 * rstd * g1 * (gr1 * sigmoidf_(gr1))); } } while (0)
#pragma unroll 1
    for (int n = 0; n < SEQ / 64; ++n) {
        asm volatile("s_waitcnt vmcnt(0) lgkmcnt(0)" ::: "memory"); __syncthreads();
        if (n > 0) GL_ROWPASS(n - 1);
#pragma unroll
        for (int cc = 0; cc < 8; ++cc) grw[cc] = *(const unsigned*)(pbase + ((size_t)(n * 64 + 8 * wid + cc) * NPROJ + C_GR + h * 128 + 2 * lane) * 2);
        {
            bf16x8 xla[2];
#pragma unroll
            for (int ks = 0; ks < 2; ++ks) { const LAS unsigned char* a = lds + RAW_LA + (32 * ks + 8 * fq + qp) * 128 + (16 * t1 + 4 * pp) * 2; xla[ks] = cat44(vtr(a), vtr(a + 4 * 128)); }
            f32x4 Ga = (f32x4){0.f, 0.f, 0.f, 0.f}, Gb = Ga, GT = Ga;
#pragma unroll
            for (int ks = 0; ks < 2; ++ks) { Ga = MFMA16(xla[ks], ym[0][ks], Ga); Gb = MFMA16(xla[ks], ym[1][ks], Gb); GT = MFMA16(xla[ks], ones, GT); }
#pragma unroll
            for (int ci = 0; ci < 2; ++ci) {
                const int c_ = 16 * (ca + ci) + fr, dk0 = 16 * t1 + 4 * fq; const f32x4 G = ci ? Gb : Ga;
                const u32x2 qw = *(const LAS u32x2*)(lds + RAW_Q + c_ * 128 + dk0 * 2), kw = *(const LAS u32x2*)(lds + RAW_K + c_ * 128 + dk0 * 2);
                const float q4[4] = {bflo(qw.x), bfhi(qw.x), bflo(qw.y), bfhi(qw.y)}, k4[4] = {bflo(kw.x), bfhi(kw.x), bflo(kw.y), bfhi(kw.y)};
                float qs4[4], ks4[4], kd4[4];
#pragma unroll
                for (int r = 0; r < 4; ++r) { qs4[r] = q4[r] * fexp(G[r]); ks4[r] = k4[r] * fexp(-G[r]); kd4[r] = k4[r] * fexp(GT[r] - G[r]); }
                *(LAS u32x2*)(lds + QS + c_ * P + dk0 * 2) = (u32x2){pk2(qs4[0], qs4[1]), pk2(qs4[2], qs4[3])};
                *(LAS u32x2*)(lds + KS + c_ * P + dk0 * 2) = (u32x2){pk2(ks4[0], ks4[1]), pk2(ks4[2], ks4[3])};
                *(LAS u32x2*)(lds + KD + c_ * P + dk0 * 2) = (u32x2){pk2(kd4[0], kd4[1]), pk2(kd4[2], kd4[3])};
            }
            if (fr == 0 && (wid & 1) == 0) *(LAS f32x4*)(lds + GTL + (16 * t1 + 4 * fq) * 4) = GT;
        }
        LDS_WAIT(); __syncthreads();
        if (n + 1 < SEQ / 64) GL_DMA(n + 1);
        {
            const int ct = wid >> 1;
#pragma unroll
            for (int si = 0; si < 2; ++si) {
                const int st = 2 * (wid & 1) + si; f32x4 D = (f32x4){0.f, 0.f, 0.f, 0.f};
                if (st <= ct) {
#pragma unroll
                    for (int ks = 0; ks < 2; ++ks) { const bf16x8 X = *(const LAS bf16x8*)(lds + KS + (16 * st + fr) * P + (32 * ks + 8 * fq) * 2), Y = *(const LAS bf16x8*)(lds + QS + (16 * ct + fr) * P + (32 * ks + 8 * fq) * 2); D = MFMA16(X, Y, D); }
#pragma unroll
                    for (int r = 0; r < 4; ++r) if (16 * st + 4 * fq + r > 16 * ct + fr) D[r] = 0.f;
                }
                *(LAS u32x2*)(lds + AM + (16 * ct + fr) * P + (16 * st + 4 * fq) * 2) = (u32x2){pk2(D[0], D[1]), pk2(D[2], D[3])};
            }
        }
        LDS_WAIT(); __builtin_amdgcn_s_barrier(); asm volatile("" ::: "memory");
        {
            const unsigned vb = VB0 + (n & 1) * 16384;
            bf16x8 X1[2], X2[2];
#pragma unroll
            for (int ks = 0; ks < 2; ++ks) { X1[ks] = *(const LAS bf16x8*)(lds + ST + (16 * wid + fr) * P + (32 * ks + 8 * fq) * 2);
                const LAS unsigned char* a = lds + vb + (32 * ks + 8 * fq + qp) * 256 + (16 * wid + 4 * pp) * 2; X2[ks] = cat44(vtr(a), vtr(a + 4 * 256)); }
#pragma unroll
            for (int ct = 0; ct < 4; ++ct) { f32x4 o = (f32x4){0.f, 0.f, 0.f, 0.f};
#pragma unroll
                for (int ks = 0; ks < 2; ++ks) { const bf16x8 Y1 = *(const LAS bf16x8*)(lds + QS + (16 * ct + fr) * P + (32 * ks + 8 * fq) * 2), Y2 = *(const LAS bf16x8*)(lds + AM + (16 * ct + fr) * P + (32 * ks + 8 * fq) * 2);
                    o = MFMA16(X1[ks], Y1, o); o = MFMA16(X2[ks], Y2, o); }
                *(LAS f32x4*)(lds + OO + (16 * ct + fr) * PO + (16 * wid + 4 * fq) * 4) = o;
                float ss = (o[0] * o[0] + o[1] * o[1]) + (o[2] * o[2] + o[3] * o[3]); ss += __shfl_xor(ss, 16); ss += __shfl_xor(ss, 32);
                if (fq == 0) *(LAS float*)(lds + SSQ + (16 * ct + fr) * 32 + wid * 4) = ss; }
#pragma unroll
            for (int tt = 0; tt < 4; ++tt) { const f32x4 dl = *(const LAS f32x4*)(lds + GTL + (16 * tt + 4 * fq) * 4);
#pragma unroll
                for (int r = 0; r < 4; ++r) accS[tt][r] *= fexp(dl[r]);
#pragma unroll
                for (int ks = 0; ks < 2; ++ks) { const LAS unsigned char* a = lds + KD + (32 * ks + 8 * fq + qp) * P + (16 * tt + 4 * pp) * 2; accS[tt] = MFMA16(cat44(vtr(a), vtr(a + 4 * P)), X2[ks], accS[tt]); }
                *(LAS u32x2*)(lds + ST + (16 * wid + fr) * P + (16 * tt + 4 * fq) * 2) = (u32x2){pk2(accS[tt][0], accS[tt][1]), pk2(accS[tt][2], accS[tt][3])}; }
        }
    }
    asm volatile("s_waitcnt vmcnt(0) lgkmcnt(0)" ::: "memory"); __syncthreads();
    GL_ROWPASS(SEQ / 64 - 1);
    __syncthreads();
#undef GL_DMA
#undef GL_ROWPASS
}

__device__ __forceinline__ int crow(int r, int hi) { return (r & 3) + 8 * (r >> 2) + 4 * hi; }
#define MFMA32(a, b, c) __builtin_amdgcn_mfma_f32_32x32x16_bf16(a, b, c, 0, 0, 0)
constexpr int AT_BUF = 32768, AT_WSF = 3 * 32768, AT_Q = 3 * 32768 + 2048;
constexpr float AT_THR = 8.f;

__device__ __forceinline__ void attn_unit(const Ctx& C, int b, int h, int cp, float lam) {
    const int lane = C.lane, r32 = lane & 31, hi = lane >> 5, wid = C.wid, p = wid >> 2, sub = wid & 3;
    const int NT = 2 * cp + 2, qch = 2 * cp + (sub >> 1), my_nt = qch + 1;
    const int row0 = b * SEQ + cp * 128;
    const int qpos = cp * 128 + sub * 32 + r32;
    const float sl2 = exp2f(-2.f * (float)(h + 1)) * LOG2E;
    LAS unsigned char* lds = C.lds;
    LAS float* wsf = (LAS float*)(lds + AT_WSF) + wid * 64;
    const char* kbase = (const char*)(C.PROJ + (size_t)(b * SEQ) * NPROJ + h * 128);
    const unsigned koff = (unsigned)((lane * NPROJ + C_DK + wid * 8) * 2);
    const unsigned voff = (unsigned)(((16 * (wid & 3) + (lane >> 2)) * NPROJ + C_DV + (wid >> 2) * 32 + (lane & 3) * 8) * 2);
#define AT_DMA(t, bufo) do { const char* _tb = kbase + (size_t)(t) * 64 * NPROJ * 2; \
        glds16<0>(_tb, koff, lds_addr(lds + (bufo) + wid * 1024)); glds16<0>(_tb, koff + 128u, lds_addr(lds + (bufo) + 8192 + wid * 1024)); \
        glds16<0>(_tb, voff, lds_addr(lds + (bufo) + 16384 + (wid >> 2) * 4096 + (wid & 3) * 1024)); glds16<0>(_tb, voff + 128u, lds_addr(lds + (bufo) + 16384 + ((wid >> 2) + 2) * 4096 + (wid & 3) * 1024)); } while (0)
    bf16x8 qr[4];
    { const bf16* qp = C.PROJ + (size_t)(row0 + sub * 32 + r32) * NPROJ + C_DQ + h * 128 + p * 64 + hi * 8;
#pragma unroll
      for (int d0 = 0; d0 < 4; ++d0) qr[d0] = *(const bf16x8*)(qp + d0 * 16); }
    AT_DMA(0, 0); AT_DMA(1, AT_BUF);
    f32x16 o[4];
#pragma unroll
    for (int d0 = 0; d0 < 4; ++d0)
#pragma unroll
        for (int i = 0; i < 16; ++i) o[d0][i] = 0.f;
    float mhat = 0.f, lsum = 0.f;
    const unsigned kofs = (unsigned)(p * 8192 + hi * 1024 + r32 * 16);
    const unsigned vofs = (unsigned)(16384 + ((lane >> 4) & 1) * 32 + (lane & 3) * 8 + (4 * hi + ((lane & 15) >> 2)) * 64);
    asm volatile("s_waitcnt vmcnt(4)" ::: "memory"); __syncthreads();
    asm volatile("" : "+v"(qr[0]), "+v"(qr[1]), "+v"(qr[2]), "+v"(qr[3]));
    unsigned bufo = 0, bufn1 = AT_BUF, bufn2 = 2 * AT_BUF;
#pragma unroll 1
    for (int t = 0; t < NT; ++t) {
        PSTAMP(lds, 0);
        if (t + 2 < NT) AT_DMA(t + 2, bufn2);
        PSTAMP(lds, 1);
        if (t < my_nt) {
            const LAS unsigned char* kp = lds + bufo + kofs;
            const LAS unsigned char* vp = lds + bufo + vofs;
            bf16x8 kf[8];
#pragma unroll
            for (int d0 = 0; d0 < 4; ++d0) { kf[2 * d0] = *(const LAS bf16x8*)(kp + d0 * 2048); kf[2 * d0 + 1] = *(const LAS bf16x8*)(kp + d0 * 2048 + 512); }
            s16x4 va[8], vb[8];
#define AT_VRD(dst, k) do { _Pragma("unroll") for (int d0 = 0; d0 < 4; ++d0) { dst[2 * d0] = vtr(vp + d0 * 4096 + (k) * 1024); dst[2 * d0 + 1] = vtr(vp + d0 * 4096 + (k) * 1024 + 512); } } while (0)
#define AT_PV(src_, k) do { const bf16x8 pa_ = __builtin_bit_cast(bf16x8, pw[k]); __builtin_amdgcn_s_setprio(1); _Pragma("unroll") for (int d0 = 0; d0 < 4; ++d0) o[d0] = MFMA32(pa_, cat44(src_[2 * d0], src_[2 * d0 + 1]), o[d0]); __builtin_amdgcn_s_setprio(0); } while (0)
            AT_VRD(va, 0);
            __builtin_amdgcn_sched_barrier(0);
            f32x16 s0, s1;
            if (t == qch) {
#pragma unroll
                for (int i = 0; i < 16; ++i) { const int k0p = 64 * t + crow(i, hi), k1p = k0p + 32;
                    s0[i] = fmaf(sl2, (float)min(k0p, 2 * qpos - k0p), -mhat); s1[i] = fmaf(sl2, (float)min(k1p, 2 * qpos - k1p), -mhat); }
            } else {
                const float bsm = sl2 * (float)(64 * t + 4 * hi) - mhat;
#pragma unroll
                for (int i = 0; i < 16; ++i) { const float ci = (float)((i & 3) + 8 * (i >> 2)); s0[i] = fmaf(sl2, ci, bsm); s1[i] = fmaf(sl2, ci + 32.f, bsm); }
            }
            __builtin_amdgcn_s_setprio(1);
#pragma unroll
            for (int d0 = 0; d0 < 4; ++d0) { s0 = MFMA32(kf[2 * d0], qr[d0], s0); s1 = MFMA32(kf[2 * d0 + 1], qr[d0], s1); }
            __builtin_amdgcn_s_setprio(0);
            __builtin_amdgcn_sched_barrier(0);
            float rm = fmaxf(s0[0], s1[0]);
#pragma unroll
            for (int i = 1; i < 16; ++i) rm = fmaxf(rm, fmaxf(s0[i], s1[i]));
            { auto rr = __builtin_amdgcn_permlane32_swap(__float_as_uint(rm), __float_as_uint(rm), false, false); rm = fmaxf(__uint_as_float(rr[0]), __uint_as_float(rr[1])); }
            if (t == 0 || __any(rm > AT_THR)) {
                const float dl = (t == 0) ? rm : fmaxf(rm, 0.f); mhat += dl;
                if (t != 0) {
                    const float f = __builtin_amdgcn_exp2f(-dl); lsum *= f;
                    if (hi == 0) wsf[r32] = f;
                    LDS_WAIT();
#pragma unroll
                    for (int i = 0; i < 16; ++i) { const float fi = wsf[crow(i, hi)];
#pragma unroll
                        for (int d0 = 0; d0 < 4; ++d0) o[d0][i] *= fi; }
                }
#pragma unroll
                for (int i = 0; i < 16; ++i) { s0[i] -= dl; s1[i] -= dl; }
            }
            float ps = 0.f;
#pragma unroll
            for (int i = 0; i < 16; ++i) { s0[i] = __builtin_amdgcn_exp2f(s0[i]); s1[i] = __builtin_amdgcn_exp2f(s1[i]); ps += s0[i] + s1[i]; }
            lsum += ps;
            PSTAMP(lds, 2);
            u32x4 pw[4];
            pw[0] = (u32x4){pk2(s0[0], s0[1]), pk2(s0[2], s0[3]), pk2(s0[4], s0[5]), pk2(s0[6], s0[7])};
            pw[1] = (u32x4){pk2(s0[8], s0[9]), pk2(s0[10], s0[11]), pk2(s0[12], s0[13]), pk2(s0[14], s0[15])};
            pw[2] = (u32x4){pk2(s1[0], s1[1]), pk2(s1[2], s1[3]), pk2(s1[4], s1[5]), pk2(s1[6], s1[7])};
            pw[3] = (u32x4){pk2(s1[8], s1[9]), pk2(s1[10], s1[11]), pk2(s1[12], s1[13]), pk2(s1[14], s1[15])};
            __builtin_amdgcn_sched_barrier(0);
            AT_VRD(vb, 1); AT_PV(va, 0); __builtin_amdgcn_sched_barrier(0);
            AT_VRD(va, 2); AT_PV(vb, 1); __builtin_amdgcn_sched_barrier(0);
            AT_VRD(vb, 3); AT_PV(va, 2); __builtin_amdgcn_sched_barrier(0);
            AT_PV(vb, 3);
#undef AT_VRD
#undef AT_PV
        }
        PSTAMP(lds, 3);
        if (t + 2 < NT) asm volatile("s_waitcnt vmcnt(4) lgkmcnt(0)" ::: "memory"); else asm volatile("s_waitcnt vmcnt(0) lgkmcnt(0)" ::: "memory");
        PSTAMP(lds, 4);
        __builtin_amdgcn_s_barrier(); asm volatile("" ::: "memory");
        PSTAMP(lds, 5);
        { const unsigned tb = bufo; bufo = bufn1; bufn1 = bufn2; bufn2 = tb; }
    }
#undef AT_DMA
    lsum += __shfl_xor(lsum, 32);
    if (hi == 0) wsf[32 + r32] = lsum;
    LDS_WAIT();
    LAS float* X = (LAS float*)lds;
    if (p == 1) {
#pragma unroll
        for (int i = 0; i < 16; ++i) { const float sc = lam * __builtin_amdgcn_rcpf(wsf[32 + crow(i, hi)]);
#pragma unroll
            for (int d0 = 0; d0 < 4; ++d0) X[(sub * 32 + crow(i, hi)) * 128 + d0 * 32 + r32] = o[d0][i] * sc; }
    }
    __syncthreads();
    if (p == 0) {
#pragma unroll
        for (int i = 0; i < 16; ++i) { const float sc = __builtin_amdgcn_rcpf(wsf[32 + crow(i, hi)]);
#pragma unroll
            for (int d0 = 0; d0 < 4; ++d0) { LAS float* xp = X + (sub * 32 + crow(i, hi)) * 128 + d0 * 32 + r32; *xp = o[d0][i] * sc - *xp; } }
    }
    __syncthreads();
    { const float g0 = C.diff_g[2 * lane], g1 = C.diff_g[2 * lane + 1];
#pragma unroll 4
      for (int qq = 0; qq < 16; ++qq) { const int q = wid * 16 + qq; const float y0 = X[q * 128 + 2 * lane], y1 = X[q * 128 + 2 * lane + 1];
          const float rstd = rsqrtf(wave_sum(y0 * y0 + y1 * y1) * (1.f / 128.f) + EPS) * 0.8f;
          *(unsigned*)(C.OA + (size_t)(row0 + q) * 1024 + h * 128 + 2 * lane) = pk2(y0 * rstd * g0, y1 * rstd * g1); } }
    __syncthreads();
}

__device__ __forceinline__ void attn_phase(const Ctx& C) {
    LAS float* lamp = (LAS float*)(C.lds + AT_Q) + 4;
    LAS int* qw = (LAS int*)(C.lds + AT_Q);
    if (C.tid < 64) {
        const float a = wave_sum(C.lq1[C.lane] * C.lk1[C.lane]), b2 = wave_sum(C.lq2[C.lane] * C.lk2[C.lane]);
        if (C.tid == 0) lamp[0] = fexp(a) - fexp(b2) + 0.2f;
    }
    __syncthreads();
    const float lam = lamp[0];
    for (;;) {
        if (C.tid == 0) qw[0] = (int)__hip_atomic_fetch_add(C.ctl + CW_QUEUE, 1u, RLX_AGENT);
        __syncthreads();
        const int item = __builtin_amdgcn_readfirstlane(qw[0]);
        __syncthreads();
        if (item >= 1024) break;
        const int bh = item & 63, cp = 15 - (item >> 6);
        attn_unit(C, bh >> 2, bh & 3, cp, lam);
    }
}

__device__ __forceinline__ void phase_router(const Ctx& C) {
    const int lane = C.lane, wid = C.wid, fr = lane & 15, fq = lane >> 4;
    LAS u32x4* WH = (LAS u32x4*)C.lds;
    LAS u32x4* WL = WH + 4096;
    LAS float* GS = (LAS float*)(C.lds + 131072);
    LAS float* SH = GS + 1024;
    LAS float* red = SH + 1024;
    LAS float* ssw = red + 8 * 16 * 32;
    LAS int* lcnt = (LAS int*)(ssw + 128);
    LAS int* lbase = lcnt + 32;
    LAS int* pend = lbase + 32;
    LAS float* cbl = (LAS float*)(pend + 512);
    for (int blk = C.bid; blk < NTOK / 128; blk += C.G) {
        const int b = blk >> 4; const float* md = C.mod + b * 6144;
        __syncthreads();
        for (int k = C.tid; k < DM; k += NTHREADS) { GS[k] = C.norm2_g[k] * (1.f + md[4096 + k]); SH[k] = md[3072 + k]; }
        if (C.tid < 32) lcnt[C.tid] = 0;
        pend[C.tid] = -1;
#pragma unroll 4
        for (int idx = C.tid; idx < 4096; idx += NTHREADS) { WH[idx] = C.wrf[idx]; WL[idx] = C.wrf[4096 + idx]; }
        f32x4 xaA[4], xbA[4]; u32x4 ywA[4];
#define RT_ISSUE(XA, XB, YW, row) do { _Pragma("unroll") for (int ks = 0; ks < 4; ++ks) { const size_t o_ = (size_t)(row) * DM + 128 * wid + 32 * ks + 8 * fq; \
            XA[ks] = __builtin_nontemporal_load((const f32x4*)(C.x + o_)); XB[ks] = __builtin_nontemporal_load((const f32x4*)(C.x + o_ + 4)); YW[ks] = __builtin_nontemporal_load((const u32x4*)(C.Y1 + o_)); } } while (0)
        RT_ISSUE(xaA, xbA, ywA, blk * 128 + fr);
        __syncthreads();
#define RT_MMA(av, ks) do { bf16x8 ah_, al_; split_bf16(av, ah_, al_); const int fi_ = ((wid * 4 + (ks)) * 2) * 64 + lane; \
            const bf16x8 wh0 = __builtin_bit_cast(bf16x8, WH[fi_]), wh1 = __builtin_bit_cast(bf16x8, WH[fi_ + 64]), wl0 = __builtin_bit_cast(bf16x8, WL[fi_]), wl1 = __builtin_bit_cast(bf16x8, WL[fi_ + 64]); \
            acc0 = MFMA16(ah_, wh0, acc0); acc0 = MFMA16(al_, wh0, acc0); acc0 = MFMA16(ah_, wl0, acc0); \
            acc1 = MFMA16(ah_, wh1, acc1); acc1 = MFMA16(al_, wh1, acc1); acc1 = MFMA16(ah_, wl1, acc1); } while (0)
        {
            f32x4 acc0 = (f32x4){0.f, 0.f, 0.f, 0.f}, acc1 = acc0;
#pragma unroll
            for (int ks = 0; ks < 4; ++ks) { const f32x4 sa = *(const LAS f32x4*)(SH + 128 * wid + 32 * ks + 8 * fq), sb = *(const LAS f32x4*)(SH + 128 * wid + 32 * ks + 8 * fq + 4);
                float av[8] = {sa[0], sa[1], sa[2], sa[3], sb[0], sb[1], sb[2], sb[3]}; RT_MMA(av, ks); }
            if (fq == 0) { red[(wid * 16) * 32 + fr] = acc0[0]; red[(wid * 16) * 32 + 16 + fr] = acc1[0]; }
            LDS_WAIT(); __syncthreads();
            if (C.tid < 32) { float t = C.b_router[C.tid];
#pragma unroll
                for (int w2 = 0; w2 < 8; ++w2) t += red[(w2 * 16) * 32 + C.tid];
                cbl[C.tid] = t; }
            LDS_WAIT(); __syncthreads();
        }
#define RT_TILE(XA, XB, YW, it) do { \
            int lane = C.lane; asm volatile("" : "+v"(lane)); const int fr = lane & 15, fq = lane >> 4;     \
            const int row0 = blk * 128 + (it) * 16; float x1[4][8]; \
            _Pragma("unroll") for (int ks = 0; ks < 4; ++ks) { \
                x1[ks][0] = XA[ks][0] + bflo(YW[ks].x); x1[ks][1] = XA[ks][1] + bfhi(YW[ks].x); x1[ks][2] = XA[ks][2] + bflo(YW[ks].y); x1[ks][3] = XA[ks][3] + bfhi(YW[ks].y); \
                x1[ks][4] = XB[ks][0] + bflo(YW[ks].z); x1[ks][5] = XB[ks][1] + bfhi(YW[ks].z); x1[ks][6] = XB[ks][2] + bflo(YW[ks].w); x1[ks][7] = XB[ks][3] + bfhi(YW[ks].w); } \
            __builtin_amdgcn_sched_barrier(0); if ((it) + 1 < 8) RT_ISSUE(XA, XB, YW, row0 + 16 + fr); __builtin_amdgcn_sched_barrier(0);                                     \
            f32x4 acc0 = (f32x4){0.f, 0.f, 0.f, 0.f}, acc1 = acc0; float ss = 0.f; \
            _Pragma("unroll") for (int ks = 0; ks < 4; ++ks) { \
                const f32x4 ga = *(const LAS f32x4*)(GS + 128 * wid + 32 * ks + 8 * fq), gb = *(const LAS f32x4*)(GS + 128 * wid + 32 * ks + 8 * fq + 4); float av[8]; \
                _Pragma("unroll") for (int j = 0; j < 8; ++j) { const float xv = x1[ks][j]; ss += xv * xv; av[j] = xv * (j < 4 ? ga[j] : gb[j - 4]); } \
                RT_MMA(av, ks); __builtin_amdgcn_sched_barrier(0); } \
            ss += __shfl_xor(ss, 16); ss += __shfl_xor(ss, 32); \
            if (fq == 0) ssw[wid * 16 + fr] = ss; \
            _Pragma("unroll") for (int r = 0; r < 4; ++r) { red[(wid * 16 + 4 * fq + r) * 32 + fr] = acc0[r]; red[(wid * 16 + 4 * fq + r) * 32 + 16 + fr] = acc1[r]; } \
            LDS_WAIT(); __syncthreads(); __builtin_amdgcn_sched_barrier(0); \
            {     \
                const int r = 2 * wid + (lane >> 5), e = lane & 31; float sum = 0.f, sq = 0.f; \
                _Pragma("unroll") for (int w2 = 0; w2 < 8; ++w2) { sum += red[(w2 * 16 + r) * 32 + e]; sq += ssw[w2 * 16 + r]; } \
                const float val = rsqrtf(sq * (1.f / DM) + EPS) * sum + cbl[e]; \
                LAS float* lgr = red + (2 * wid + (lane >> 5)) * 32; lgr[e] = val; LDS_WAIT();            \
                int rank = 0; \
                _Pragma("unroll") for (int e4 = 0; e4 < 8; ++e4) { const f32x4 o4 = *(const LAS f32x4*)(lgr + 4 * e4); \
                    _Pragma("unroll") for (int j = 0; j < 4; ++j) rank += (o4[j] > val || (o4[j] == val && (4 * e4 + j) < e)) ? 1 : 0; } \
                LAS float* slr = red + (16 + 2 * wid + (lane >> 5)) * 32;                                   \
                if (rank < 4) slr[rank] = val; \
                LDS_WAIT(); \
                const f32x4 tv = *(const LAS f32x4*)slr; \
                const float e1 = fexp(tv[1] - tv[0]), e2 = fexp(tv[2] - tv[0]), e3 = fexp(tv[3] - tv[0]); const float inv = 1.f / (1.f + e1 + e2 + e3); \
                if (rank < 4) { const int row = row0 + r; const float wgt = (rank == 0 ? 1.f : (rank == 1 ? e1 : (rank == 2 ? e2 : e3))) * inv; \
                    C.topw[(size_t)row * 4 + rank] = wgt; C.tope[(size_t)row * 4 + rank] = e; \
                    const int slot = atomicAdd((int*)(lcnt + e), 1); pend[((it) * 16 + r) * 4 + rank] = (e << 16) | slot; } \
            } \
            __builtin_amdgcn_sched_barrier(0); \
            {     \
                float sq = 0.f; _Pragma("unroll") for (int w2 = 0; w2 < 8; ++w2) sq += ssw[w2 * 16 + fr]; \
                const float rstd = rsqrtf(sq * (1.f / DM) + EPS); \
                _Pragma("unroll") for (int ks = 0; ks < 4; ++ks) { const int k0 = 128 * wid + 32 * ks + 8 * fq; \
                    const f32x4 ga = *(const LAS f32x4*)(GS + k0), gb = *(const LAS f32x4*)(GS + k0 + 4), sa = *(const LAS f32x4*)(SH + k0), sb = *(const LAS f32x4*)(SH + k0 + 4); float hv[8]; \
                    _Pragma("unroll") for (int j = 0; j < 8; ++j) hv[j] = __builtin_amdgcn_fmed3f((x1[ks][j] * rstd * (j < 4 ? ga[j] : gb[j - 4]) + (j < 4 ? sa[j] : sb[j - 4])) * F8_ASCALE, -440.f, 440.f); \
                    *(u32x2*)((unsigned char*)C.H2 + (size_t)(row0 + fr) * DM + k0) = (u32x2){pk4_fp8(hv[0], hv[1], hv[2], hv[3]), pk4_fp8(hv[4], hv[5], hv[6], hv[7])}; __builtin_amdgcn_sched_barrier(0); } \
            } \
            LDS_WAIT(); __syncthreads(); } while (0)
#pragma unroll 1
        for (int it = 0; it < 8; ++it) { RT_TILE(xaA, xbA, ywA, it); }
#undef RT_TILE
#undef RT_MMA
#undef RT_ISSUE
        if (C.tid < 32) lbase[C.tid] = (int)__hip_atomic_fetch_add(C.ctl + CW_CNT + 64 * C.tid, (unsigned)lcnt[C.tid], RLX_AGENT);
        __syncthreads();
        { const int pv = pend[C.tid]; if (pv >= 0) { const int e = pv >> 16, slot = pv & 0xffff; C.list[e * NTOK + lbase[e] + slot] = (blk * 128 + (C.tid >> 2)) * 4 + (C.tid & 3); } }
    }
}

__device__ __forceinline__ void phase_final(const Ctx& C) {
    const int gw = C.bid * NWAVES + C.wid, NGW = C.G * NWAVES;
    for (int r0 = gw * 16; r0 < NTOK; r0 += NGW * 16) {
        const int b = r0 >> 11; const float* gt2p = C.mod + b * 6144 + 5120;
        f32x4 gt2[4], fg[4];
#pragma unroll
        for (int j = 0; j < 4; ++j) { const int c0 = 4 * C.lane + 256 * j; gt2[j] = *(const f32x4*)(gt2p + c0); fg[j] = *(const f32x4*)(C.final_g + c0); }
#pragma unroll 1
        for (int rr = 0; rr < 16; ++rr) {
            const int row = r0 + rr;
            const f32x4 w = *(const f32x4*)(C.topw + (size_t)row * 4) * (1.f / F8_YSCALE);
            f32x4 v[4]; float ss = 0.f;
#pragma unroll
            for (int j = 0; j < 4; ++j) { const int c0 = 4 * C.lane + 256 * j;
                f32x4 y = (f32x4){0.f, 0.f, 0.f, 0.f};
#pragma unroll
                for (int k = 0; k < 4; ++k) { const int yw = __builtin_nontemporal_load((const int*)((const unsigned char*)C.YB + (size_t)(row * 4 + k) * DM + c0));
                    y = y + (f32x4){__builtin_amdgcn_cvt_f32_fp8(yw, 0), __builtin_amdgcn_cvt_f32_fp8(yw, 1), __builtin_amdgcn_cvt_f32_fp8(yw, 2), __builtin_amdgcn_cvt_f32_fp8(yw, 3)} * w[k]; }
                const u32x2 y1w = __builtin_nontemporal_load((const u32x2*)(C.Y1 + (size_t)row * DM + c0));
                v[j] = __builtin_nontemporal_load((const f32x4*)(C.x + (size_t)row * DM + c0)) + (f32x4){bflo(y1w.x), bfhi(y1w.x), bflo(y1w.y), bfhi(y1w.y)} + gt2[j] * y;
                ss += (v[j][0] * v[j][0] + v[j][1] * v[j][1]) + (v[j][2] * v[j][2] + v[j][3] * v[j][3]); }
            const float rstd = rsqrtf(wave_sum(ss) * (1.f / DM) + EPS);
#pragma unroll
            for (int j = 0; j < 4; ++j) __builtin_nontemporal_store(v[j] * rstd * fg[j], (f32x4*)(C.out + (size_t)row * DM + 4 * C.lane + 256 * j));
        }
    }
}

#ifndef PROBE_A
#define PROBE_A -1
#endif
#ifndef PROBE_B
#define PROBE_B -1
#endif
constexpr int CW_TS = 3072;
#define STAMP(k) do { if (PROBE_A >= 0 && blockIdx.x == 0 && threadIdx.x == 0) { const Ctx Cs = make_ctx(lds); ((unsigned long long*)(Cs.ctl + CW_TS))[k] = __builtin_amdgcn_s_memrealtime(); } } while (0)
struct Args { const float* in[25]; float* out; unsigned char* ws; };
typedef const Args __attribute__((address_space(4)))* KArgs;
__device__ __forceinline__ Ctx make_ctx(LAS unsigned char* lds) {
    KArgs a = (KArgs)__builtin_amdgcn_kernarg_segment_ptr();
    asm volatile("" : "+s"(a));
    Ctx C;
    C.lds = lds;
    C.tid = tid_fresh(); C.lane = C.tid & 63; C.wid = __builtin_amdgcn_readfirstlane(C.tid >> 6); C.G = gridDim.x; C.bid = blockIdx.x;
    C.x = a->in[0]; C.c = a->in[1]; C.w_ada = a->in[2]; C.b_ada = a->in[3]; C.norm1_g = a->in[4]; C.w_in = a->in[5];
    C.lq1 = a->in[6]; C.lk1 = a->in[7]; C.lq2 = a->in[8]; C.lk2 = a->in[9]; C.diff_g = a->in[10]; C.w_alpha_up = a->in[11]; C.b_alpha = a->in[12];
    C.gla_g = a->in[13]; C.w_bd = a->in[14]; C.w_bg = a->in[15]; C.w_out = a->in[16]; C.norm2_g = a->in[17]; C.w_router = a->in[18]; C.b_router = a->in[19];
    C.w_gu = a->in[20]; C.b_gu = a->in[21]; C.w_dn = a->in[22]; C.b_dn = a->in[23]; C.final_g = a->in[24];
    C.out = a->out;
    unsigned char* ws = a->ws;
    C.ctl = (unsigned*)(ws + WS_CTL); C.mod = (float*)(ws + WS_MOD); C.tope = (int*)(ws + WS_TOPE); C.topw = (float*)(ws + WS_TOPW); C.list = (int*)(ws + WS_LIST);
    C.WinT = (bf16*)(ws + WS_WIN); C.WbdT = (bf16*)(ws + WS_WBD); C.WbgT = (bf16*)(ws + WS_WBG); C.WoutT = (bf16*)(ws + WS_WOUT); C.WguT = (bf16*)(ws + WS_WGU); C.WdT = (bf16*)(ws + WS_WD);
    C.H = (bf16*)(ws + WS_H); C.H2 = (bf16*)(ws + WS_H2); C.OA = (bf16*)(ws + WS_OA); C.OB = (bf16*)(ws + WS_OB); C.MG = (bf16*)(ws + WS_MG); C.YB = (bf16*)(ws + WS_YB);
    C.PROJ = (bf16*)(ws + WS_PROJ); C.ACT = (bf16*)(ws + WS_ACT); C.Y1 = (bf16*)(ws + WS_Y1); C.cb = (float*)(ws + WS_CB); C.wrf = (u32x4*)(ws + WS_WRF);
    return C;
}
__global__ void __launch_bounds__(NTHREADS, 2) fwd_kernel(Args args) {
    extern __shared__ __attribute__((aligned(16))) unsigned char lds_raw[];
    LAS unsigned char* lds = (LAS unsigned char*)lds_raw;
    for (int u = threadIdx.x; u < (LDS_BYTES - LDSCTL_OFF) / 4; u += NTHREADS) ((LAS unsigned*)(lds + LDSCTL_OFF))[u] = 0u;
    __syncthreads();
    volatile LAS unsigned* MISC = (volatile LAS unsigned*)(lds + MISC_OFF);
    XcdBarrier bar;
    { const Ctx C = make_ctx(lds); bar = xcd_barrier_post(C.ctl + CW_BAR, MISC + 8); }
#define GRID_BAR() xcd_barrier(bar)
    STAMP(0);
#if PROBE_A >= 100
    if (blockIdx.x == 0 && threadIdx.x == 0) ((volatile LAS unsigned*)(lds + MISC_OFF))[15] = (unsigned)__builtin_amdgcn_s_memrealtime();
#endif

    { const Ctx C = make_ctx(lds); phase_mod(C); }
    GRID_BAR(); STAMP(1);
    { const Ctx C = make_ctx(lds); phase_prep(C); }
    GRID_BAR(); STAMP(2);
    { const Ctx C = make_ctx(lds); DenseDesc g{C.H, DM, C.WinT, DM}; TileOrder S; S.init(NTOK / 256, NPROJ / 256, C.G, C.bid); EpiProj E{C.PROJ, C.b_alpha}; gemm_phase<DenseDesc, TileOrder, EpiProj, true, false, 1>(C.lds, g, S, E); }
    GRID_BAR(); STAMP(3);
    { const Ctx C = make_ctx(lds); for (int s = C.bid; s < 64; s += C.G) gla_chunked(C, s >> 2, s & 3); }
    __syncthreads(); STAMP(12);
    { const Ctx C = make_ctx(lds); attn_phase(C); }
    GRID_BAR(); STAMP(4);
    { const Ctx C = make_ctx(lds); DenseDesc g{C.OA, DM, C.WbdT, DM}; TileOrder S; S.init(NTOK / 256, DM / 256, C.G, C.bid); EpiBranch E{C.MG, C.PROJ}; gemm_phase<DenseDesc, TileOrder, EpiBranch, true>(C.lds, g, S, E); }
    GRID_BAR(); STAMP(5);
    STAMP(6);
    { const Ctx C = make_ctx(lds); DenseDesc g{C.MG, DM, C.WoutT, DM}; TileOrder S; S.init(NTOK / 256, DM / 256, C.G, C.bid); EpiOut E{C.Y1, C.mod}; gemm_phase<DenseDesc, TileOrder, EpiOut, true>(C.lds, g, S, E); }
    GRID_BAR(); STAMP(7);
    { const Ctx C = make_ctx(lds); phase_router(C); }
    GRID_BAR(); STAMP(8);
    LAS int* tab = (LAS int*)(lds + STAGE_BYTES);
    __syncthreads();
    if (threadIdx.x == 0) { const Ctx C = make_ctx(lds); int ts = 0; for (int e = 0; e < NE; ++e) { const int cnt = (int)__hip_atomic_load(C.ctl + CW_CNT + 64 * e, RLX_AGENT); tab[e] = cnt; tab[32 + e] = ts; ts += (cnt + 255) >> 8; } tab[64] = ts; }
    __syncthreads();
    for (int tr = threadIdx.x; tr < tab[64]; tr += NTHREADS) { int e = 0; for (int k = 1; k < NE; ++k) if (tab[32 + k] <= tr) e = k; tab[65 + tr] = e; }
    __syncthreads();
    { const Ctx C = make_ctx(lds); const int T = tab[64]; MoeUpDesc g{(const unsigned char*)C.H2, C.list, (const unsigned char*)C.WguT, DM}; MoeOrder S; S.t.init(T, 8, C.G, C.bid, 4); S.tab = tab; EpiUp E{(unsigned char*)C.ACT, C.b_gu}; gemm_phase<MoeUpDesc, MoeOrder, EpiUp, true, true, 4>(C.lds, g, S, E); }
    GRID_BAR(); STAMP(9);
    { const Ctx C = make_ctx(lds); const int T = tab[64]; MoeDownDesc g{(const unsigned char*)C.ACT, (const unsigned char*)C.WdT, FF}; MoeOrder S; S.t.init(T, 4, C.G, C.bid); S.tab = tab; EpiDown E{(unsigned char*)C.YB, C.b_dn, C.list}; gemm_phase<MoeDownDesc, MoeOrder, EpiDown, true, true, 5>(C.lds, g, S, E); }
    GRID_BAR(); STAMP(10);
    { const Ctx C = make_ctx(lds); phase_final(C); }
#if PROBE_A >= 0
    GRID_BAR(); STAMP(11);
    if (blockIdx.x == 0 && threadIdx.x == 0) {
        const Ctx C = make_ctx(lds); const unsigned long long* ts = (const unsigned long long*)(C.ctl + CW_TS);
        asm volatile("s_waitcnt vmcnt(0)" ::: "memory");
        const unsigned long long dt = (PROBE_A >= 100) ? (unsigned long long)((volatile LAS unsigned*)(lds + MISC_OFF))[16 + (PROBE_A >= 100 ? PROBE_A - 100 : 0)] : ((PROBE_A == 12) ? ts[12] - ts[3] : ts[(PROBE_A < 12 ? PROBE_A : 0) + 1] - ts[PROBE_A < 12 ? PROBE_A : 0]), t0 = __builtin_amdgcn_s_memrealtime();
        while (__builtin_amdgcn_s_memrealtime() - t0 < 4ull * dt) __builtin_amdgcn_s_sleep(8);
    }
#endif
}

extern "C" void kernel_launch(void* const* d_in, const int* in_sizes, int n_in, void* d_out, int out_size, void* d_ws, size_t ws_size, hipStream_t stream) {
    static int grid = 0;
    if (grid == 0) {
        if (n_in != 25 || in_sizes[0] != NTOK * DM || out_size != NTOK * DM || ws_size < WS_END) {
            fprintf(stderr, "kernel_launch: unexpected shapes (n_in %d, in0 %d, out %d, ws %zu < %zu)\n", n_in, n_in > 0 ? in_sizes[0] : -1, out_size, ws_size, (size_t)WS_END); grid = -1; return; }
        int dev = 0, cus = 0;
        if (hipGetDevice(&dev) != hipSuccess || hipDeviceGetAttribute(&cus, hipDeviceAttributeMultiprocessorCount, dev) != hipSuccess) { grid = -1; return; }
        if (hipFuncSetAttribute((const void*)fwd_kernel, hipFuncAttributeMaxDynamicSharedMemorySize, LDS_BYTES) != hipSuccess) { fprintf(stderr, "kernel_launch: hipFuncSetAttribute failed\n"); grid = -1; return; }
        (void)hipGetLastError();
        grid = cus;
    }
    if (grid < 0) return;
    if (hipMemsetAsync((char*)d_ws + WS_CTL, 0, CTL_ZERO_BYTES, stream) != hipSuccess) { fprintf(stderr, "kernel_launch: memset failed\n"); return; }
    Args a{};
    for (int i = 0; i < 25; ++i) a.in[i] = (const float*)d_in[i];
    a.out = (float*)d_out; a.ws = (unsigned char*)d_ws;
    hipLaunchKernelGGL(fwd_kernel, dim3(grid), dim3(NTHREADS), LDS_BYTES, stream, a);
}
```

```cpp
#include <hip/hip_runtime.h>
#include <cstdio>
#include <cstdint>

#define GAS __attribute__((address_space(1)))
#define LAS __attribute__((address_space(3)))
typedef unsigned short bf16;
typedef short bf16x8 __attribute__((ext_vector_type(8)));
typedef float f32x4 __attribute__((ext_vector_type(4)));
typedef unsigned u32x4 __attribute__((ext_vector_type(4)));
typedef unsigned u32x2 __attribute__((ext_vector_type(2)));
typedef int i32x4 __attribute__((ext_vector_type(4)));
typedef GAS unsigned gu32;

constexpr int NB = 16, SEQ = 2048, DM = 1024, NTOK = NB * SEQ, NE = 32, FF = 1024;
constexpr int NPROJ = 5376;
constexpr int C_DQ = 0, C_DK = 512, C_DV = 1024, C_GQ = 1536, C_GK = 1792, C_GV = 2048, C_GR = 2560, C_GA = 3072, C_GB = 4096, C_AL = 5120;
constexpr int W_IN_N = 5136;
constexpr float LOG2E = 1.4426950408889634f;
constexpr float QSCALE = 0.125f * LOG2E;
constexpr float EPS = 1e-6f;
constexpr int NWAVES = 8, NTHREADS = 512;

constexpr size_t MiB = 1u << 20;
constexpr size_t WS_CTL = 0, CTL_ZERO_BYTES = 1 * MiB;
constexpr size_t WS_MOD = 1 * MiB;
constexpr size_t WS_TOPE = 2 * MiB;
constexpr size_t WS_TOPW = 3 * MiB;
constexpr size_t WS_LIST = 4 * MiB;
constexpr size_t WS_WIN = 8 * MiB;
constexpr size_t WS_WBD = 19 * MiB;
constexpr size_t WS_WBG = 20 * MiB;
constexpr size_t WS_WOUT = 21 * MiB;
constexpr size_t WS_WGU = 24 * MiB;
constexpr size_t WS_WD = 152 * MiB;
constexpr size_t WS_H2 = 216 * MiB;
constexpr size_t WS_RB = 280 * MiB;
constexpr size_t WS_H = WS_RB, WS_OA = WS_RB + 64 * MiB, WS_OB = WS_RB + 96 * MiB, WS_MG = WS_RB + 128 * MiB, WS_YB = WS_RB;
constexpr size_t WS_RA = 536 * MiB;
constexpr size_t WS_PROJ = WS_RA, WS_ACT = WS_RA;
constexpr size_t WS_Y1 = WS_RA + 272 * MiB;
constexpr size_t WS_CB = WS_MOD + 512 * 1024;
constexpr size_t WS_WRF = WS_MOD + 768 * 1024;
constexpr size_t WS_END = 872 * MiB;
constexpr int MAX_TILES = 544;
static_assert((size_t)MAX_TILES * 256 * 1024 * 2 <= 336 * MiB, "act fits region A");
constexpr int CW_CNT = 64;
constexpr int CW_BAR = 4096;
constexpr int CW_QUEUE = 2304;

constexpr int SCR_BYTES = 159744;
constexpr int LDSCTL_OFF = SCR_BYTES, MISC_OFF = LDSCTL_OFF + 320;
constexpr int LDS_BYTES = SCR_BYTES + 1024;

#define RLX_AGENT __ATOMIC_RELAXED, __HIP_MEMORY_SCOPE_AGENT
#define LDS_WAIT() asm volatile("s_waitcnt lgkmcnt(0)" ::: "memory")

__device__ __forceinline__ unsigned f2bf(float f) { unsigned u = __builtin_bit_cast(unsigned, f); return (u + 0x7fffu + ((u >> 16) & 1u)) >> 16; }
typedef __bf16 bf16n2 __attribute__((ext_vector_type(2)));
typedef float f32x2 __attribute__((ext_vector_type(2)));
__device__ __forceinline__ unsigned pk2(float lo, float hi) { return __builtin_bit_cast(unsigned, __builtin_convertvector((f32x2){lo, hi}, bf16n2)); }
__device__ __forceinline__ unsigned pk4_fp8(float a, float b, float c, float d) { int w = 0; w = __builtin_amdgcn_cvt_pk_fp8_f32(a, b, w, false); w = __builtin_amdgcn_cvt_pk_fp8_f32(c, d, w, true); return (unsigned)w; }
constexpr float F8_ASCALE = 4.f, F8_WSCALE = 512.f;
constexpr int F8_SA = 0x7d7d7d7d, F8_SW = 0x76767676;
__device__ __forceinline__ float bf2f(unsigned b) { return __uint_as_float(b << 16); }
__device__ __forceinline__ float bflo(unsigned w) { return __uint_as_float(w << 16); }
__device__ __forceinline__ float bfhi(unsigned w) { return __uint_as_float(w & 0xffff0000u); }
__device__ __forceinline__ float wave_sum(float v) {
#pragma unroll
    for (int o = 1; o < 64; o <<= 1) v += __shfl_xor(v, o);
    return v;
}
__device__ __forceinline__ int tid_fresh() { int t = threadIdx.x; asm volatile("" : "+v"(t)); return t; }
__device__ __forceinline__ float fexp(float x) { return __builtin_amdgcn_exp2f(x * 1.4426950408889634f); }
__device__ __forceinline__ float sigmoidf_(float x) { return __builtin_amdgcn_rcpf(1.f + fexp(-x)); }

#define XB_TMO      128
#define XB_XCNT(j)  (256  + 64 * (j))
#define XB_XSUB(j)  (1280 + 64 * (j))
#define XB_XGEN(j)  (2304 + 64 * (j))
#define XB_TOP      3328
#define XB_TOPGEN   3392
#define XCD_BAR_WORDS 3456
#define XB_SPIN_CAP (1u << 22)
__device__ __forceinline__ unsigned xb_ld(unsigned* p)              { return __hip_atomic_load(p, __ATOMIC_RELAXED, __HIP_MEMORY_SCOPE_AGENT); }
__device__ __forceinline__ unsigned xb_add(unsigned* p, unsigned v) { return __hip_atomic_fetch_add(p, v, __ATOMIC_RELAXED, __HIP_MEMORY_SCOPE_AGENT); }
__device__ __forceinline__ unsigned xb_xcc_id() { return (unsigned)__builtin_amdgcn_s_getreg((3 << 11) | 20) & 0xFu; }
#define XB_SPIN(cond, bar) do { unsigned _sp = 0; while (cond) { __builtin_amdgcn_s_sleep(1); \
    if ((++_sp & 255u) == 0u) { if (xb_ld(&(bar)[XB_TMO])) break; if (_sp > XB_SPIN_CAP) { atomicAdd(&(bar)[XB_TMO], 1u); break; } } } } while (0)
struct XcdBarrier { unsigned* bar; unsigned x; volatile LAS unsigned* st; };
__device__ __forceinline__ XcdBarrier xcd_barrier_post(unsigned* bar, volatile LAS unsigned* st) {
    XcdBarrier b; b.bar = bar; b.x = xb_xcc_id(); b.st = st;
    if (threadIdx.x == 0) (void)xb_add(&bar[XB_XCNT(b.x)], 1u);
    return b;
}
__device__ __forceinline__ void xcd_barrier_complete(unsigned* bar, unsigned x, unsigned& nloc, unsigned& nx) {
    const unsigned G = gridDim.x * gridDim.y * gridDim.z;
    unsigned sum, cnt, mine, sp = 0u;
    for (;;) {
        sum = 0u; cnt = 0u; mine = 0u;
#pragma unroll
        for (unsigned j = 0; j < 16; ++j) { const unsigned c = xb_ld(&bar[XB_XCNT(j)]); sum += c; cnt += (c > 0u) ? 1u : 0u; mine = (j == x) ? c : mine; }
        if (sum == G) break;
        __builtin_amdgcn_s_sleep(1);
        if ((++sp & 255u) == 0u) { if (xb_ld(&bar[XB_TMO])) break; if (sp > XB_SPIN_CAP) { atomicAdd(&bar[XB_TMO], 1u); break; } }
    }
    nloc = mine > 0u ? mine : 1u; nx = cnt > 0u ? cnt : 1u;
}
__device__ __forceinline__ void xcd_barrier(const XcdBarrier& b) {
    asm volatile("s_waitcnt vmcnt(0)" ::: "memory");
    __syncthreads();
    if (threadIdx.x == 0) {
        unsigned* bar = b.bar;
        __builtin_amdgcn_s_waitcnt(0);
        unsigned nloc = b.st[0], nx = b.st[1];
        if (nloc == 0u) { xcd_barrier_complete(bar, b.x, nloc, nx); b.st[0] = nloc; b.st[1] = nx; }
        const unsigned old = xb_add(&bar[XB_XSUB(b.x)], 1u);
        const unsigned gen = old / nloc;
        if (old + 1u == (gen + 1u) * nloc) {
            __builtin_amdgcn_fence(__ATOMIC_RELEASE, "agent");
            asm volatile("s_waitcnt vmcnt(0)" ::: "memory");
            const unsigned og = xb_add(&bar[XB_TOP], 1u);
            const unsigned tg = og / nx;
            if (og + 1u == (tg + 1u) * nx) xb_add(&bar[XB_TOPGEN], 1u);
            else XB_SPIN(xb_ld(&bar[XB_TOPGEN]) == tg, bar);
            __builtin_amdgcn_fence(__ATOMIC_ACQUIRE, "agent");
            xb_add(&bar[XB_XGEN(b.x)], 1u);
            asm volatile("s_waitcnt vmcnt(0)" ::: "memory");
        } else {
            XB_SPIN(xb_ld(&bar[XB_XGEN(b.x)]) == gen, bar);
            __builtin_amdgcn_fence(__ATOMIC_ACQUIRE, "agent");
            asm volatile("s_waitcnt vmcnt(0)" ::: "memory");
        }
    }
    __syncthreads();
}

struct Ctx {
    LAS unsigned char* lds;
    int tid, lane, wid, G, bid;
    const float *x, *c, *w_ada, *b_ada, *norm1_g, *w_in, *lq1, *lk1, *lq2, *lk2, *diff_g, *w_alpha_up, *b_alpha, *gla_g,
                *w_bd, *w_bg, *w_out, *norm2_g, *w_router, *b_router, *w_gu, *b_gu, *w_dn, *b_dn, *final_g;
    float* out;
    unsigned* ctl; float* mod; int* tope; float* topw; int* list;
    bf16 *WinT, *WbdT, *WbgT, *WoutT, *WguT, *WdT, *H, *H2, *OA, *OB, *MG, *YB, *PROJ, *ACT, *Y1; float* cb; u32x4* wrf;
};

constexpr int NXCD = 8, WGM = 8;
__host__ __device__ __forceinline__ int perm32(int rho) { const int n = rho >> 4, i = rho & 15; return 8 * (i >> 2) + 4 * n + (i & 3); }
struct Unit { int pm, pn, e, row0, cnt; };
struct TileOrder {
    int nM, nN, nwg, G, c, wgm;
    __device__ __forceinline__ void init(int nM_, int nN_, int G_, int c_, int wgm_ = WGM) { nM = nM_; nN = nN_; nwg = nM * nN; G = G_; c = c_; wgm = wgm_; }
    __device__ __forceinline__ bool next(int i, Unit& u) const {
        const long L = (long)i * G + c; if (L >= nwg) return false;
        int wgid = (int)L; { const int q = nwg / NXCD, r = nwg % NXCD, xcd = wgid % NXCD, off = wgid / NXCD; wgid = (xcd < r ? xcd * (q + 1) : r * (q + 1) + (xcd - r) * q) + off; }
        const int nig = wgm * nN, gid = wgid / nig, fm = gid * wgm, gsz = (nM - fm) < wgm ? (nM - fm) : wgm;
        u.pm = fm + ((wgid % nig) % gsz); u.pn = (wgid % nig) / gsz; u.e = 0; u.row0 = 0; u.cnt = 0; return true;
    }
};
struct MoeOrder {
    TileOrder t; LAS const int* tab;
    __device__ __forceinline__ bool next(int i, Unit& u) const {
        if (!t.next(i, u)) return false;
        const int e = tab[65 + u.pm];
        u.e = e; u.row0 = (u.pm - tab[32 + e]) * 256; u.cnt = tab[e]; return true;
    }
};
struct DenseDesc {
    static constexpr bool GATHER = false;
    const bf16* A; int lda; const bf16* Bt; int K;
    __device__ __forceinline__ unsigned a_off(const Unit& u, int r) const { return (unsigned)((u.pm * 256 + r) * lda) * 2u; }
    __device__ __forceinline__ const char* a_base(const Unit&) const { return (const char*)A; }
    __device__ __forceinline__ const char* b_base(const Unit& u) const { return (const char*)Bt + (size_t)u.pn * 256 * K * 2; }
};
struct MoeUpDesc {
    static constexpr bool GATHER = true;
    const unsigned char* H2; const int* list; const unsigned char* WguT; int K;
    __device__ __forceinline__ const int* id_src(const Unit& u, int j) const { const int s = u.row0 + j; return list + (size_t)u.e * NTOK + (s < NTOK ? s : NTOK - 1); }
    __device__ __forceinline__ unsigned a_off(const Unit& u, int r) const { const int slot = u.row0 + r; int tok = 0; if (slot < u.cnt) tok = list[u.e * NTOK + slot] >> 2; return (unsigned)tok * 1024u; }
    __device__ __forceinline__ const char* a_base(const Unit&) const { return (const char*)H2; }
    __device__ __forceinline__ const char* b_base(const Unit& u) const { return (const char*)WguT + ((size_t)u.e * 2048 + (size_t)u.pn * 256) * 1024; }
};
struct MoeDownDesc {
    static constexpr bool GATHER = false;
    const unsigned char* ACT; const unsigned char* WdT; int K;
    __device__ __forceinline__ unsigned a_off(const Unit& u, int r) const { return (unsigned)(u.pm * 256 + r) * 1024u; }
    __device__ __forceinline__ const char* a_base(const Unit&) const { return (const char*)ACT; }
    __device__ __forceinline__ const char* b_base(const Unit& u) const { return (const char*)WdT + ((size_t)u.e * 1024 + (size_t)u.pn * 256) * 1024; }
};

template <class Desc, class Order, class Epi>
__device__ __forceinline__ void gemm_simple(const Desc& g, const Order& S, const Epi& E) {
    const int tid = threadIdx.x, wid = __builtin_amdgcn_readfirstlane(tid >> 6), lane = tid & 63, wr = wid >> 2, wc = wid & 3, fr = lane & 15, fq = lane >> 4;
    const int K = g.K;
    Unit u;
    for (int i = 0; S.next(i, u); ++i) {
        f32x4 acc[2][2][4][2];
#pragma unroll
        for (int a = 0; a < 2; ++a)
#pragma unroll
            for (int b = 0; b < 2; ++b)
#pragma unroll
                for (int m = 0; m < 4; ++m)
#pragma unroll
                    for (int n = 0; n < 2; ++n) acc[a][b][m][n] = (f32x4){0.f, 0.f, 0.f, 0.f};
        unsigned aoff[2][4], boff[2][2];
#pragma unroll
        for (int a = 0; a < 2; ++a)
#pragma unroll
            for (int m = 0; m < 4; ++m) aoff[a][m] = g.a_off(u, a * 128 + wr * 64 + m * 16 + fr) + fq * 16;
#pragma unroll
        for (int b = 0; b < 2; ++b)
#pragma unroll
            for (int n = 0; n < 2; ++n) { const int nc = b * 128 + wc * 32 + (Epi::PERM ? perm32(n * 16 + fr) : (n * 16 + fr)); boff[b][n] = (unsigned)(nc * K) * 2u + fq * 16; }
        const char* ab = g.a_base(u); const char* bb = g.b_base(u);
#pragma unroll 1
        for (int ks = 0; ks < K / 32; ++ks) {
            bf16x8 af[2][4], bfr[2][2];
#pragma unroll
            for (int a = 0; a < 2; ++a)
#pragma unroll
                for (int m = 0; m < 4; ++m) af[a][m] = *(const bf16x8*)(ab + aoff[a][m] + ks * 64);
#pragma unroll
            for (int b = 0; b < 2; ++b)
#pragma unroll
                for (int n = 0; n < 2; ++n) bfr[b][n] = *(const bf16x8*)(bb + boff[b][n] + ks * 64);
#pragma unroll
            for (int a = 0; a < 2; ++a)
#pragma unroll
                for (int b = 0; b < 2; ++b)
#pragma unroll
                    for (int m = 0; m < 4; ++m)
#pragma unroll
                        for (int n = 0; n < 2; ++n) acc[a][b][m][n] = __builtin_amdgcn_mfma_f32_16x16x32_bf16(bfr[b][n], af[a][m], acc[a][b][m][n], 0, 0, 0);
        }
        E(acc, u, wr, wc, fr, fq);
    }
}


#ifndef PROBE_A
#define PROBE_A -1
#endif
#if PROBE_A >= 100
#define PSTAMP(ldsp, idx) do { if (blockIdx.x == 0 && threadIdx.x == 0) { volatile LAS unsigned* pm_ = (volatile LAS unsigned*)((ldsp) + MISC_OFF); const unsigned now_ = (unsigned)__builtin_amdgcn_s_memrealtime(); pm_[16 + (idx)] += now_ - pm_[15]; pm_[15] = now_; } } while (0)
#else
#define PSTAMP(ldsp, idx) do {} while (0)
#endif
constexpr int BK = 64, HALF = 128, HTB = HALF * BK * 2, STAGE_BYTES = 8 * HTB;
__host__ __device__ __forceinline__ int lds_byte(int r, int c) { const int st = (r >> 4) * 2 + (c >> 5), rr = r & 15, cc = c & 31, ob = rr * 64 + cc * 2; return st * 1024 + (ob ^ (((ob >> 9) & 1) << 5)); }
__host__ __device__ __forceinline__ void stage_rc(int b, int& R, int& C) { const int st = b / 1024, sb = b % 1024, swz = sb ^ (((sb >> 9) & 1) << 5); R = (st >> 1) * 16 + swz / 64; C = (st & 1) * 32 + (swz % 64) / 2; }

typedef int v8i32 __attribute__((ext_vector_type(8)));
__device__ __forceinline__ v8i32 cat88(bf16x8 lo, bf16x8 hi) { const i32x4 a = __builtin_bit_cast(i32x4, lo), b = __builtin_bit_cast(i32x4, hi); return (v8i32){a[0], a[1], a[2], a[3], b[0], b[1], b[2], b[3]}; }
template <class Desc, class Order, class Epi, bool ALIGN_EPI, bool FP8 = false, int PID = 0>
__device__ __forceinline__ void gemm_phase(LAS unsigned char* lds, const Desc& g, const Order& S, const Epi& E) {
    const int tid = tid_fresh(), wid = __builtin_amdgcn_readfirstlane(tid >> 6), lane = tid & 63, wr = wid >> 2, wc = wid & 3, fr = lane & 15, fq = lane >> 4;
    const int KBy = FP8 ? g.K : 2 * g.K, nt = KBy / 128;
    int Rs[2], Cs[2]; unsigned voffB[2];
#pragma unroll
    for (int i = 0; i < 2; ++i) { stage_rc(tid * 16 + i * 8192, Rs[i], Cs[i]); const int Rb = 64 * (Rs[i] >> 5) + perm32(Rs[i] & 31); voffB[i] = (unsigned)(Rb * KBy + Cs[i] * 2); }
    unsigned vA[2][2];
    LAS u32x4* const vslot = (LAS u32x4*)(lds + STAGE_BYTES + 4096) + tid;
    const size_t kstep = (size_t)(BK * 2);
    const size_t hstepB = (size_t)32 * KBy;
    const unsigned ldsw = (unsigned)wid * 1024u;
    const int aoff = FP8 ? lds_byte(wr * 64 + fr, fq * 16) : lds_byte(wr * 64 + fr, fq * 8), boff = FP8 ? lds_byte(wc * 32 + fr, fq * 16) : lds_byte(wc * 32 + fr, fq * 8);
    constexpr int KSTR = FP8 ? 16 : 1024;
#define PG8_SA(b, h) (((b) * 2 + (h)) * HTB)
#define PG8_SB(b, h) ((4 + (b) * 2 + (h)) * HTB)
#define PG8_STAGE(bufoff, gbase, voff) do { _Pragma("unroll") for (int _i = 0; _i < 2; ++_i) \
        __builtin_amdgcn_global_load_lds((const unsigned*)((const char*)(gbase) + (voff)[_i]), (LAS unsigned*)(lds + (bufoff) + ldsw + _i * 8192), 16, 0, 0); } while (0)
#define PG8_STAGE_A(bufoff, gbase, h) do { _Pragma("unroll") for (int _i = 0; _i < 2; ++_i) \
        __builtin_amdgcn_global_load_lds((const unsigned*)((const char*)(gbase) + vA[h][_i]), (LAS unsigned*)(lds + (bufoff) + ldsw + _i * 8192), 16, 0, 0); } while (0)
#define PG8_LDA(dst, b, h) do { _Pragma("unroll") for (int m = 0; m < 4; ++m) _Pragma("unroll") for (int k = 0; k < 2; ++k) dst[m][k] = *(const LAS bf16x8*)(lds + PG8_SA(b, h) + aoff + m * 2048 + k * KSTR); } while (0)
#define PG8_LDB(dst, b, h) do { _Pragma("unroll") for (int n = 0; n < 2; ++n) _Pragma("unroll") for (int k = 0; k < 2; ++k) dst[n][k] = *(const LAS bf16x8*)(lds + PG8_SB(b, h) + boff + n * 2048 + k * KSTR); } while (0)
#define PG8_MMA(ai, bj, At, Bt) do { __builtin_amdgcn_s_setprio(1); _Pragma("unroll") for (int m = 0; m < 4; ++m) _Pragma("unroll") for (int n = 0; n < 2; ++n) { \
        if constexpr (FP8) { acc[ai][bj][m][n] = __builtin_amdgcn_mfma_scale_f32_16x16x128_f8f6f4(cat88(Bt[n][0], Bt[n][1]), cat88(At[m][0], At[m][1]), acc[ai][bj][m][n], 0, 0, 0, F8_SW, 0, F8_SA); } \
        else { _Pragma("unroll") for (int k = 0; k < 2; ++k) acc[ai][bj][m][n] = __builtin_amdgcn_mfma_f32_16x16x32_bf16(Bt[n][k], At[m][k], acc[ai][bj][m][n], 0, 0, 0); } } \
        __builtin_amdgcn_s_setprio(0); } while (0)
#define PG8_WAIT_V(n) asm volatile("s_waitcnt vmcnt(" #n ")" ::: "memory")
#define PG8_WAIT_L(n) asm volatile("s_waitcnt lgkmcnt(" #n ")" ::: "memory")
#define PG8_BAR __builtin_amdgcn_s_barrier()
#define PG8_SCHED __builtin_amdgcn_sched_barrier(0)
#define PG8_KBODY(t) do { \
            const bool last = (t == nt - 2); \
            const char* a1 = Ab + (size_t)(t + 1) * kstep; \
            const char* a2 = last ? Ab : Ab + (size_t)(t + 2) * kstep; const char* b2 = last ? nB : cB + (size_t)(t + 2) * kstep; \
            const char* a3 = a2 + kstep; const char* b3 = b2 + kstep; \
              \
            PG8_LDB(B0, 0, 0); PG8_LDB(B1, 0, 1); PG8_SCHED; PG8_LDA(At, 0, 0); PG8_STAGE_A(PG8_SA(1, 1), a1, 1); \
            if (last && has_next) { if constexpr (Desc::GATHER) { _Pragma("unroll") for (int _h = 0; _h < 2; ++_h) _Pragma("unroll") for (int _i = 0; _i < 2; ++_i) { const int _j = _h * HALF + Rs[_i]; const int _id = idbuf[((ui + 1) & 1) * 256 + _j]; vA[_h][_i] = ((nxt.row0 + _j < nxt.cnt) ? (unsigned)(_id >> 2) * 1024u : 0u) + (unsigned)Cs[_i] * 2u; } } else { const u32x4 vn = *vslot; vA[0][0] = vn.x; vA[0][1] = vn.y; vA[1][0] = vn.z; vA[1][1] = vn.w; } }     \
            PG8_WAIT_V(8); PG8_WAIT_L(0); PG8_BAR; PG8_MMA(0, 0, At, B0); PG8_MMA(0, 1, At, B1); PG8_BAR; PG8_SCHED; \
              \
            PG8_LDA(At, 0, 1); PG8_STAGE(PG8_SB(0, 0), b2, voffB); PG8_STAGE(PG8_SB(0, 1), b2 + hstepB, voffB); PG8_STAGE_A(PG8_SA(0, 0), a2, 0); \
            PG8_WAIT_V(8); PG8_WAIT_L(0); PG8_BAR; PG8_MMA(1, 0, At, B0); PG8_MMA(1, 1, At, B1); PG8_BAR; PG8_SCHED; \
              \
            PG8_LDB(B0, 1, 0); PG8_LDB(B1, 1, 1); PG8_SCHED; PG8_LDA(At, 1, 0); PG8_STAGE_A(PG8_SA(0, 1), a2, 1); \
            PG8_WAIT_V(8); PG8_WAIT_L(0); PG8_BAR; PG8_MMA(0, 0, At, B0); PG8_MMA(0, 1, At, B1); PG8_BAR; PG8_SCHED; \
              \
            PG8_LDA(At, 1, 1); PG8_STAGE(PG8_SB(1, 0), b3, voffB); PG8_STAGE(PG8_SB(1, 1), b3 + hstepB, voffB); PG8_STAGE_A(PG8_SA(1, 0), a3, 0); \
            PG8_WAIT_V(8); PG8_WAIT_L(0); PG8_BAR; PG8_MMA(1, 0, At, B0); PG8_MMA(1, 1, At, B1); PG8_BAR; PG8_SCHED; \
        } while (0)
#define PG8_AOFFS(dst, un) do { _Pragma("unroll") for (int _h = 0; _h < 2; ++_h) _Pragma("unroll") for (int _i = 0; _i < 2; ++_i) dst[_h][_i] = g.a_off(un, _h * HALF + Rs[_i]) + (unsigned)Cs[_i] * 2u; } while (0)
    Unit cur, nxt; int ui = 0;
    if (!S.next(0, cur)) return;
    LAS int* const idbuf = (LAS int*)(lds + STAGE_BYTES + 4096);
#define PG8_IDDMA(un, b) do { if (wid < 4) __builtin_amdgcn_global_load_lds((const unsigned*)g.id_src(un, 64 * wid + lane), (LAS unsigned*)(idbuf + (b) * 256 + 64 * wid), 4, 0, 0); } while (0)
    if constexpr (Desc::GATHER) { Unit u1; if (S.next(1, u1)) PG8_IDDMA(u1, 1); }
    f32x4 acc[2][2][4][2];
#pragma unroll
    for (int a = 0; a < 2; ++a)
#pragma unroll
        for (int b = 0; b < 2; ++b)
#pragma unroll
            for (int m = 0; m < 4; ++m)
#pragma unroll
                for (int n = 0; n < 2; ++n) acc[a][b][m][n] = (f32x4){0.f, 0.f, 0.f, 0.f};
    bf16x8 At[4][2], B0[2][2], B1[2][2];
    const char* const Ab = g.a_base(cur);
    const char* cB = g.b_base(cur);
    PG8_AOFFS(vA, cur);
    PG8_STAGE(PG8_SB(0, 0), cB, voffB); PG8_STAGE(PG8_SB(0, 1), cB + hstepB, voffB); PG8_STAGE_A(PG8_SA(0, 0), Ab, 0); PG8_STAGE_A(PG8_SA(0, 1), Ab, 1);
    if (wr == 1) PG8_BAR;
    PG8_WAIT_V(2); PG8_BAR;
    PG8_STAGE(PG8_SB(1, 0), cB + kstep, voffB); PG8_STAGE_A(PG8_SA(1, 0), Ab + kstep, 0); PG8_STAGE(PG8_SB(1, 1), cB + hstepB + kstep, voffB);
    PG8_WAIT_V(6); PG8_BAR;
    for (;;) {
        const bool has_next = S.next(ui + 1, nxt);
        const char* nB = has_next ? g.b_base(nxt) : cB;
        if constexpr (Desc::GATHER) { Unit u2; if (S.next(ui + 2, u2)) PG8_IDDMA(u2, ui & 1); }
        else if (has_next) { unsigned vn[2][2]; PG8_AOFFS(vn, nxt); *vslot = (u32x4){vn[0][0], vn[0][1], vn[1][0], vn[1][1]}; }
        PSTAMP(lds, 40 + PID);
        if constexpr (Epi::MIDK) {
            for (int t = 0; t < nt / 2; t += 2) PG8_KBODY(t);
            E.mid(acc, cur, wr, wc, fr, fq);
            for (int t = nt / 2; t < nt; t += 2) PG8_KBODY(t);
        } else {
            for (int t = 0; t < nt; t += 2) PG8_KBODY(t);
        }
        PSTAMP(lds, 20 + PID);
        if constexpr (ALIGN_EPI) { if (wr == 0) PG8_BAR; }
        E(acc, cur, wr, wc, fr, fq);
        PSTAMP(lds, 30 + PID);
        if (!has_next) break;
#pragma unroll
        for (int a = 0; a < 2; ++a)
#pragma unroll
            for (int b = 0; b < 2; ++b)
#pragma unroll
                for (int m = 0; m < 4; ++m)
#pragma unroll
                    for (int n = 0; n < 2; ++n) acc[a][b][m][n] = (f32x4){0.f, 0.f, 0.f, 0.f};
        cur = nxt; cB = nB; ++ui;
        if constexpr (ALIGN_EPI) { if (wr == 1) PG8_BAR; }
    }
    PG8_WAIT_V(0);
    if constexpr (!ALIGN_EPI) { if (wr == 0) PG8_BAR; }
    PG8_BAR;
#undef PG8_SA
#undef PG8_SB
#undef PG8_STAGE
#undef PG8_STAGE_A
#undef PG8_LDA
#undef PG8_LDB
#undef PG8_MMA
#undef PG8_WAIT_V
#undef PG8_WAIT_L
#undef PG8_BAR
#undef PG8_SCHED
#undef PG8_AOFFS
#undef PG8_KBODY
#undef PG8_IDDMA
}

__device__ __forceinline__ u32x4 pack8(const f32x4& v0, const f32x4& v1) { u32x4 w; w.x = pk2(v0[0], v0[1]); w.y = pk2(v0[2], v0[3]); w.z = pk2(v1[0], v1[1]); w.w = pk2(v1[2], v1[3]); return w; }
__device__ __forceinline__ void unpack8(const u32x4& w, f32x4& v0, f32x4& v1) { v0 = (f32x4){bflo(w.x), bfhi(w.x), bflo(w.y), bfhi(w.y)}; v1 = (f32x4){bflo(w.z), bfhi(w.z), bflo(w.w), bfhi(w.w)}; }
__device__ __forceinline__ float logsig16(float x) { return (fminf(x, 0.f) - log1pf(fexp(-fabsf(x)))) * (1.f / 16.f); }

__device__ __forceinline__ unsigned rot8(unsigned v) { return (unsigned)__builtin_amdgcn_update_dpp(0, (int)v, 0x128, 0xf, 0xf, false); }
__device__ __forceinline__ void pair_exchange(u32x4& a, u32x4& b, bool lo) {
    const u32x4 ra = (u32x4){rot8(a.x), rot8(a.y), rot8(a.z), rot8(a.w)}, rb = (u32x4){rot8(b.x), rot8(b.y), rot8(b.z), rot8(b.w)};
    const u32x4 na = lo ? a : rb, nb = lo ? ra : b; a = na; b = nb;
}
struct EpiProj {
    static constexpr bool PERM = true, MIDK = false;
    bf16* P; const float* b_alpha;
    __device__ __forceinline__ void operator()(const f32x4 (&acc)[2][2][4][2], const Unit& u, int wr, int wc, int fr, int fq) const {
        const int pn = u.pn; const int mode = (pn < 2) ? 1 : (pn == 6 ? 2 : (pn == 20 ? 3 : 0));
        const int cw = pn * 256 + wc * 64 + 8 * fq; const bool lo = fr < 8;
        f32x4 bb[2][2];
#pragma unroll
        for (int bj = 0; bj < 2; ++bj) { bb[bj][0] = (f32x4){0.f, 0.f, 0.f, 0.f}; bb[bj][1] = bb[bj][0];
            if (mode == 3) { bb[bj][0] = *(const f32x4*)(b_alpha + (cw + 32 * bj - C_AL)); bb[bj][1] = *(const f32x4*)(b_alpha + (cw + 32 * bj - C_AL) + 4); } }
#pragma unroll
        for (int ai = 0; ai < 2; ++ai)
#pragma unroll
            for (int m = 0; m < 4; ++m) {
                u32x4 w[2];
#pragma unroll
                for (int bj = 0; bj < 2; ++bj) {
                    f32x4 v0 = acc[ai][bj][m][0], v1 = acc[ai][bj][m][1];
                    if (mode == 1) { v0 = v0 * QSCALE; v1 = v1 * QSCALE; }
                    else if (mode == 2) { v0 = v0 * 0.125f; v1 = v1 * 0.125f; }
                    else if (mode == 3) {
#pragma unroll
                        for (int j = 0; j < 4; ++j) { v0[j] = logsig16(v0[j] + bb[bj][0][j]); v1[j] = logsig16(v1[j] + bb[bj][1][j]); } }
                    w[bj] = pack8(v0, v1);
                }
                pair_exchange(w[0], w[1], lo);
                const int rowA = u.pm * 256 + ai * 128 + wr * 64 + m * 16 + (fr & 7); const int cc = cw + 32 * (fr >> 3);
                __builtin_nontemporal_store(w[0], (u32x4*)(P + (size_t)rowA * NPROJ + cc));
                __builtin_nontemporal_store(w[1], (u32x4*)(P + (size_t)(rowA + 8) * NPROJ + cc));
            }
    }
};
struct EpiBranch {
    static constexpr bool PERM = true, MIDK = true;
    bf16* MG; const bf16* P;
    __device__ __forceinline__ void mid(f32x4 (&acc)[2][2][4][2], const Unit& u, int wr, int wc, int fr, int fq) const {
        const int cw = u.pn * 256 + wc * 64 + 8 * fq;
#pragma unroll
        for (int ai = 0; ai < 2; ++ai)
#pragma unroll
            for (int m = 0; m < 4; ++m) {
                const bf16* pr = P + (size_t)(u.pm * 256 + ai * 128 + wr * 64 + m * 16 + fr) * NPROJ + cw;
#pragma unroll
                for (int bj = 0; bj < 2; ++bj) {
                    const u32x4 gaw = __builtin_nontemporal_load((const u32x4*)(pr + C_GA + 32 * bj)), gbw = *(const u32x4*)(pr + C_GB + 32 * bj);
                    f32x4 a0, a1, b0, b1; unpack8(gaw, a0, a1); unpack8(gbw, b0, b1);
#pragma unroll
                    for (int j = 0; j < 4; ++j) {
                        acc[ai][bj][m][0][j] *= (1.f + fexp(-__builtin_amdgcn_fmed3f(b0[j], -30.f, 30.f))) * __builtin_amdgcn_rcpf(1.f + fexp(-a0[j]));
                        acc[ai][bj][m][1][j] *= (1.f + fexp(-__builtin_amdgcn_fmed3f(b1[j], -30.f, 30.f))) * __builtin_amdgcn_rcpf(1.f + fexp(-a1[j])); }
                }
                if (m == 3) asm volatile("" ::: "memory");
            }
    }
    __device__ __forceinline__ void operator()(const f32x4 (&acc)[2][2][4][2], const Unit& u, int wr, int wc, int fr, int fq) const {
        const int cw = u.pn * 256 + wc * 64 + 8 * fq; const bool lo = fr < 8;
#pragma unroll
        for (int ai = 0; ai < 2; ++ai)
#pragma unroll
            for (int m = 0; m < 4; ++m) {
                const int row = u.pm * 256 + ai * 128 + wr * 64 + m * 16 + fr;
                u32x4 w[2];
#pragma unroll
                for (int bj = 0; bj < 2; ++bj) {
                    const u32x4 gbw = __builtin_nontemporal_load((const u32x4*)(P + (size_t)row * NPROJ + C_GB + cw + 32 * bj));
                    f32x4 b0, b1; unpack8(gbw, b0, b1);
                    f32x4 v0 = acc[ai][bj][m][0], v1 = acc[ai][bj][m][1];
#pragma unroll
                    for (int j = 0; j < 4; ++j) { v0[j] *= __builtin_amdgcn_rcpf(1.f + fexp(-__builtin_amdgcn_fmed3f(b0[j], -30.f, 30.f))); v1[j] *= __builtin_amdgcn_rcpf(1.f + fexp(-__builtin_amdgcn_fmed3f(b1[j], -30.f, 30.f))); }
                    w[bj] = pack8(v0, v1);
                }
                pair_exchange(w[0], w[1], lo);
                const int rowA = u.pm * 256 + ai * 128 + wr * 64 + m * 16 + (fr & 7); const int cc = cw + 32 * (fr >> 3);
                *(u32x4*)(MG + (size_t)rowA * DM + cc) = w[0];
                *(u32x4*)(MG + (size_t)(rowA + 8) * DM + cc) = w[1];
            }
    }
};
struct EpiOut {
    static constexpr bool PERM = true, MIDK = false;
    bf16* Y1; const float* mod;
    __device__ __forceinline__ void operator()(const f32x4 (&acc)[2][2][4][2], const Unit& u, int wr, int wc, int fr, int fq) const {
        const int b = u.pm >> 3; const float* gt1 = mod + b * 6144 + 2048;
        const int cw = u.pn * 256 + wc * 64 + 8 * fq; const bool lo = fr < 8;
        f32x4 g[2][2];
#pragma unroll
        for (int bj = 0; bj < 2; ++bj) { g[bj][0] = *(const f32x4*)(gt1 + cw + 32 * bj); g[bj][1] = *(const f32x4*)(gt1 + cw + 32 * bj + 4); }
#pragma unroll
        for (int ai = 0; ai < 2; ++ai)
#pragma unroll
            for (int m = 0; m < 4; ++m) {
                u32x4 wa = pack8(acc[ai][0][m][0] * g[0][0], acc[ai][0][m][1] * g[0][1]), wb = pack8(acc[ai][1][m][0] * g[1][0], acc[ai][1][m][1] * g[1][1]);
                pair_exchange(wa, wb, lo);
                const int rowA = u.pm * 256 + ai * 128 + wr * 64 + m * 16 + (fr & 7); const int cc = cw + 32 * (fr >> 3);
                *(u32x4*)(Y1 + (size_t)rowA * DM + cc) = wa;
                *(u32x4*)(Y1 + (size_t)(rowA + 8) * DM + cc) = wb;
            }
    }
};
struct EpiUp {
    static constexpr bool PERM = true, MIDK = false;
    unsigned char* ACT; const float* b_gu;
    __device__ __forceinline__ void operator()(const f32x4 (&acc)[2][2][4][2], const Unit& u, int wr, int wc, int fr, int fq) const {
        const int f0 = u.pn * 128 + wc * 32 + 8 * fq;
        const float* bg = b_gu + (size_t)u.e * 2048 + f0; const float* bu = bg + 1024;
        const f32x4 bg0 = *(const f32x4*)bg, bg1 = *(const f32x4*)(bg + 4), bu0 = *(const f32x4*)bu, bu1 = *(const f32x4*)(bu + 4);
#pragma unroll
        for (int ai = 0; ai < 2; ++ai)
#pragma unroll
            for (int m = 0; m < 4; ++m) {
                const int r = ai * 128 + wr * 64 + m * 16 + fr;
                f32x4 g0 = acc[ai][0][m][0] + bg0, g1 = acc[ai][0][m][1] + bg1, u0 = acc[ai][1][m][0] + bu0, u1 = acc[ai][1][m][1] + bu1, a0, a1;
#pragma unroll
                for (int j = 0; j < 4; ++j) {
                    float gg = fminf(g0[j], 7.f), uu = fminf(fmaxf(u0[j], -7.f), 7.f); a0[j] = (uu + 1.f) * gg * sigmoidf_(1.702f * gg);
                    gg = fminf(g1[j], 7.f); uu = fminf(fmaxf(u1[j], -7.f), 7.f); a1[j] = (uu + 1.f) * gg * sigmoidf_(1.702f * gg); }
                *(u32x2*)(ACT + (size_t)(u.pm * 256 + r) * FF + f0) = (u32x2){pk4_fp8(a0[0] * F8_ASCALE, a0[1] * F8_ASCALE, a0[2] * F8_ASCALE, a0[3] * F8_ASCALE), pk4_fp8(a1[0] * F8_ASCALE, a1[1] * F8_ASCALE, a1[2] * F8_ASCALE, a1[3] * F8_ASCALE)};
            }
    }
};
constexpr float F8_YSCALE = 16.f;
__device__ __forceinline__ void pair_exchange2(u32x2& a, u32x2& b, bool lo) {
    const u32x2 ra = (u32x2){rot8(a.x), rot8(a.y)}, rb = (u32x2){rot8(b.x), rot8(b.y)};
    const u32x2 na = lo ? a : rb, nb = lo ? ra : b; a = na; b = nb;
}
struct EpiDown {
    static constexpr bool PERM = true, MIDK = false;
    unsigned char* YB; const float* b_dn; const int* list;
    __device__ __forceinline__ void operator()(const f32x4 (&acc)[2][2][4][2], const Unit& u, int wr, int wc, int fr, int fq) const {
        const int cw = u.pn * 256 + wc * 64 + 8 * fq; const bool lo = fr < 8;
        f32x4 bb[2][2];
#pragma unroll
        for (int bj = 0; bj < 2; ++bj) { const float* bp = b_dn + (size_t)u.e * DM + cw + 32 * bj; bb[bj][0] = *(const f32x4*)bp; bb[bj][1] = *(const f32x4*)(bp + 4); }
#pragma unroll
        for (int ai = 0; ai < 2; ++ai)
#pragma unroll
            for (int m = 0; m < 4; ++m) {
                const int slot = u.row0 + ai * 128 + wr * 64 + m * 16 + fr;
                const int aid = slot < u.cnt ? list[u.e * NTOK + slot] : -1;
                const int aidx = (int)rot8((unsigned)aid);
                u32x2 w[2];
#pragma unroll
                for (int bj = 0; bj < 2; ++bj) { f32x4 v0 = (acc[ai][bj][m][0] + bb[bj][0]) * F8_YSCALE, v1 = (acc[ai][bj][m][1] + bb[bj][1]) * F8_YSCALE;
#pragma unroll
                    for (int j = 0; j < 4; ++j) { v0[j] = __builtin_amdgcn_fmed3f(v0[j], -440.f, 440.f); v1[j] = __builtin_amdgcn_fmed3f(v1[j], -440.f, 440.f); }
                    w[bj] = (u32x2){pk4_fp8(v0[0], v0[1], v0[2], v0[3]), pk4_fp8(v1[0], v1[1], v1[2], v1[3])}; }
                pair_exchange2(w[0], w[1], lo);
                const int aidA = lo ? aid : aidx, aidB = lo ? aidx : aid;
                const int cc = cw + 32 * (fr >> 3);
                if (aidA >= 0) *(u32x2*)(YB + (size_t)aidA * DM + cc) = w[0];
                if (aidB >= 0) *(u32x2*)(YB + (size_t)aidB * DM + cc) = w[1];
            }
    }
};

__device__ __forceinline__ void split_bf16(const float (&v)[8], bf16x8& hi, bf16x8& lo) {
    const unsigned h0 = pk2(v[0], v[1]), h1 = pk2(v[2], v[3]), h2 = pk2(v[4], v[5]), h3 = pk2(v[6], v[7]);
    const u32x4 h = (u32x4){h0, h1, h2, h3};
    const u32x4 l = (u32x4){pk2(v[0] - bflo(h0), v[1] - bfhi(h0)), pk2(v[2] - bflo(h1), v[3] - bfhi(h1)), pk2(v[4] - bflo(h2), v[5] - bfhi(h2)), pk2(v[6] - bflo(h3), v[7] - bfhi(h3))};
    hi = __builtin_bit_cast(bf16x8, h); lo = __builtin_bit_cast(bf16x8, l);
}
constexpr int T_NITEMS = 16 * 80 + 2 * 8 * 16 + 16 * 16 + 32 * 16 * 32 + 32 * 16 * 16;
__device__ __forceinline__ void transposes(const Ctx& C, int i0, int i1, int w, int nw);
__device__ __forceinline__ void phase_mod(const Ctx& C) {
    LAS float* sc = (LAS float*)C.lds;
    LAS float* red = sc + 16 * 1024;
    for (int cb = C.bid; cb < 96; cb += C.G) {
        __syncthreads();
        for (int i = C.tid; i < 16 * 1024; i += NTHREADS) { const float v = C.c[i]; sc[i] = v / (1.f + fexp(-v)); }
        __syncthreads();
        const int cl = C.tid & 63, ks = C.tid >> 6, col = cb * 64 + cl;
        float acc[16];
#pragma unroll
        for (int b = 0; b < 16; ++b) acc[b] = 0.f;
#pragma unroll 2
        for (int k = ks * 128; k < ks * 128 + 128; k += 4) {
            const float w0 = __builtin_nontemporal_load(C.w_ada + (size_t)k * 6144 + col), w1 = __builtin_nontemporal_load(C.w_ada + (size_t)(k + 1) * 6144 + col), w2 = __builtin_nontemporal_load(C.w_ada + (size_t)(k + 2) * 6144 + col), w3 = __builtin_nontemporal_load(C.w_ada + (size_t)(k + 3) * 6144 + col);
#pragma unroll
            for (int b = 0; b < 16; ++b) { const f32x4 s4 = *(const LAS f32x4*)(sc + b * 1024 + k); acc[b] += (s4[0] * w0 + s4[1] * w1) + (s4[2] * w2 + s4[3] * w3); }
        }
#pragma unroll
        for (int b = 0; b < 16; ++b) red[(ks * 16 + b) * 64 + cl] = acc[b];
        __syncthreads();
        for (int o = C.tid; o < 1024; o += NTHREADS) {
            const int b = o >> 6, c2 = o & 63; float s = 0.f;
#pragma unroll
            for (int k2 = 0; k2 < 8; ++k2) s += red[(k2 * 16 + b) * 64 + c2];
            C.mod[b * 6144 + cb * 64 + c2] = s + C.b_ada[cb * 64 + c2];
        }
    }
    __syncthreads();
    { const int gw = C.bid * NWAVES + C.wid, NGW = C.G * NWAVES;
      if (C.G == 256) { constexpr int N1 = 11 * 2048; transposes(C, 0, N1, gw, NGW); if (C.bid >= 96) transposes(C, N1, T_NITEMS, gw - 96 * NWAVES, NGW - 96 * NWAVES); }
      else transposes(C, 0, T_NITEMS, gw, NGW); }
    for (int idx = C.bid * NTHREADS + C.tid; idx < 4096; idx += C.G * NTHREADS) {
        const int l2 = idx & 63, nt = (idx >> 6) & 1, ks = (idx >> 7) & 3, w2 = idx >> 9; float wv[8];
#pragma unroll
        for (int j = 0; j < 8; ++j) wv[j] = C.w_router[(size_t)(128 * w2 + 32 * ks + 8 * (l2 >> 4) + j) * NE + 16 * nt + (l2 & 15)];
        bf16x8 h8, l8; split_bf16(wv, h8, l8); C.wrf[idx] = __builtin_bit_cast(u32x4, h8); C.wrf[4096 + idx] = __builtin_bit_cast(u32x4, l8); }
    for (int gt = C.bid * NTHREADS + C.tid; gt < 256 * 512; gt += C.G * NTHREADS) {
        const int j = gt >> 9, k = (gt & 511) * 2;
        float s0 = 0.f, s1 = 0.f;
#pragma unroll
        for (int r = 0; r < 16; ++r) { const float wa = C.w_alpha_up[r * 256 + j]; s0 += C.w_in[(size_t)k * W_IN_N + 3072 + r] * wa; s1 += C.w_in[(size_t)(k + 1) * W_IN_N + 3072 + r] * wa; }
        *(unsigned*)(C.WinT + (size_t)(C_AL + j) * DM + k) = pk2(s0, s1);
    }
}

struct TItem { const float* src; unsigned char* dst; int srcN, pitch, hop, fp8; };
__device__ __forceinline__ TItem titem_decode(const Ctx& C, int it) {
    constexpr int I_IN = 16 * 80, I_BD = 8 * 16, I_OUT = 16 * 16, I_GU = 32 * 16 * 32;
    TItem t; t.hop = 0; t.fp8 = 0; int r = it;
    if (r < I_IN) { const int kb = r / 80, n0 = (r % 80) * 64; t.srcN = W_IN_N; t.pitch = DM * 2; t.src = C.w_in + (size_t)(kb * 64) * W_IN_N + (n0 < 3072 ? n0 : n0 + 16); t.dst = (unsigned char*)(C.WinT + (size_t)n0 * DM + kb * 64); return t; } r -= I_IN;
    if (r < I_BD) { t.srcN = DM; t.pitch = 2048; t.src = C.w_bd + (size_t)((r >> 4) * 64) * DM + (r & 15) * 64; t.dst = (unsigned char*)(C.WbdT + (size_t)((r & 15) * 64) * 1024 + (r >> 4) * 64); return t; } r -= I_BD;
    if (r < I_BD) { t.srcN = DM; t.pitch = 2048; t.src = C.w_bg + (size_t)((r >> 4) * 64) * DM + (r & 15) * 64; t.dst = (unsigned char*)(C.WbdT + (size_t)((r & 15) * 64) * 1024 + 512 + (r >> 4) * 64); return t; } r -= I_BD;
    if (r < I_OUT) { t.srcN = DM; t.pitch = DM * 2; t.src = C.w_out + (size_t)((r >> 4) * 64) * DM + (r & 15) * 64; t.dst = (unsigned char*)(C.WoutT + (size_t)((r & 15) * 64) * DM + (r >> 4) * 64); return t; } r -= I_OUT;
    if (r < I_GU) { const int e = r >> 9, rr = r & 511, kb = rr >> 5, n0 = (rr & 31) * 64; const int pn = n0 >> 8, wc = (n0 >> 6) & 3;
        t.srcN = 2048; t.pitch = 1024; t.fp8 = 1; t.hop = 1024 - 32; t.src = C.w_gu + (size_t)e * DM * 2048 + (size_t)(kb * 64) * 2048 + pn * 128 + wc * 32; t.dst = (unsigned char*)C.WguT + (size_t)e * 2048 * 1024 + (size_t)n0 * 1024 + kb * 64; return t; } r -= I_GU;
    { const int e = r >> 8, rr = r & 255, kb = rr >> 4, n0 = (rr & 15) * 64;
        t.srcN = DM; t.pitch = 1024; t.fp8 = 1; t.src = C.w_dn + (size_t)e * FF * DM + (size_t)(kb * 64) * DM + n0; t.dst = (unsigned char*)C.WdT + (size_t)e * DM * 1024 + (size_t)n0 * 1024 + kb * 64; return t; }
}
__device__ __forceinline__ void titem_load(const TItem& t, int lane, f32x4 (&v)[16]) {
#pragma unroll
    for (int i = 0; i < 16; ++i) v[i] = __builtin_nontemporal_load((const f32x4*)(t.src + (size_t)(4 * i + (lane >> 4)) * t.srcN + 4 * (lane & 15) + ((lane & 8) ? t.hop : 0)));
}
__device__ __forceinline__ void titem_store(const TItem& t, int lane, const f32x4 (&v)[16], LAS float* scr) {
#pragma unroll
    for (int i = 0; i < 16; ++i) { LAS float* p = scr + (4 * i + (lane >> 4)) * 65 + 4 * (lane & 15); p[0] = v[i][0]; p[1] = v[i][1]; p[2] = v[i][2]; p[3] = v[i][3]; }
    LDS_WAIT(); asm volatile("" ::: "memory");
    const int c = lane & 7;
#pragma unroll
    for (int j = 0; j < 8; ++j) { const int n = (lane >> 3) + 8 * j; const LAS float* s = scr + (8 * c) * 65 + n;
        if (t.fp8) { float w[8];
#pragma unroll
            for (int q = 0; q < 8; ++q) w[q] = __builtin_amdgcn_fmed3f(s[q * 65] * F8_WSCALE, -440.f, 440.f);
            __builtin_nontemporal_store((u32x2){pk4_fp8(w[0], w[1], w[2], w[3]), pk4_fp8(w[4], w[5], w[6], w[7])}, (u32x2*)(t.dst + (size_t)n * t.pitch + 8 * c)); }
        else { u32x4 o; o.x = pk2(s[0 * 65], s[1 * 65]); o.y = pk2(s[2 * 65], s[3 * 65]); o.z = pk2(s[4 * 65], s[5 * 65]); o.w = pk2(s[6 * 65], s[7 * 65]);
            *(u32x4*)(t.dst + (size_t)n * t.pitch + 16 * c) = o; } }
    LDS_WAIT(); asm volatile("" ::: "memory");
}
__device__ __forceinline__ void transposes(const Ctx& C, int i0, int i1, int w, int nw) {
    LAS float* scr = (LAS float*)(C.lds + C.wid * 16896);
    int it = i0 + w; if (it >= i1) return;
    TItem cur = titem_decode(C, it); f32x4 v[16]; titem_load(cur, C.lane, v);
    for (;;) {
        const int nit = it + nw; const bool more = nit < i1;
        TItem nxt = cur; f32x4 vn[16];
        if (more) { nxt = titem_decode(C, nit); titem_load(nxt, C.lane, vn); }
        titem_store(cur, C.lane, v, scr);
        if (!more) break;
        cur = nxt; it = nit;
#pragma unroll
        for (int i = 0; i < 16; ++i) v[i] = vn[i];
    }
}
__device__ __forceinline__ void phase_prep(const Ctx& C) {
    const int gw = C.bid * NWAVES + C.wid, NGW = C.G * NWAVES;
    for (int r0 = gw * 16; r0 < NTOK; r0 += NGW * 16) {
        const int b = r0 >> 11; const float* md = C.mod + b * 6144;
        f32x4 gs[4], sh[4];
#pragma unroll
        for (int j = 0; j < 4; ++j) { const int c0 = 4 * C.lane + 256 * j; gs[j] = *(const f32x4*)(C.norm1_g + c0) * (*(const f32x4*)(md + 1024 + c0) + 1.f); sh[j] = *(const f32x4*)(md + c0); }
#pragma unroll 1
        for (int rr = 0; rr < 16; rr += 2) {
            f32x4 v[2][4]; float ss[2] = {0.f, 0.f};
#pragma unroll
            for (int r = 0; r < 2; ++r)
#pragma unroll
                for (int j = 0; j < 4; ++j) v[r][j] = __builtin_nontemporal_load((const f32x4*)(C.x + (size_t)(r0 + rr + r) * DM + 4 * C.lane + 256 * j));
#pragma unroll
            for (int r = 0; r < 2; ++r)
#pragma unroll
                for (int j = 0; j < 4; ++j) ss[r] += (v[r][j][0] * v[r][j][0] + v[r][j][1] * v[r][j][1]) + (v[r][j][2] * v[r][j][2] + v[r][j][3] * v[r][j][3]);
#pragma unroll
            for (int r = 0; r < 2; ++r) { const float rstd = rsqrtf(wave_sum(ss[r]) * (1.f / DM) + EPS);
#pragma unroll
                for (int j = 0; j < 4; ++j) { const f32x4 y = v[r][j] * rstd * gs[j] + sh[j];
                    u32x2 o; o.x = pk2(y[0], y[1]); o.y = pk2(y[2], y[3]);
                    *(u32x2*)(C.H + (size_t)(r0 + rr + r) * DM + 4 * C.lane + 256 * j) = o; } }
        }
    }
}

__device__ __forceinline__ void gla_scan(const Ctx& C, int b, int h) {
    LAS float* qs = (LAS float*)C.lds;
    LAS float* ks = qs + 2048;
    LAS float* al = ks + 2048;
    LAS float* vs = al + 2048;
    LAS float* part = vs + 4096;
    const int dv = C.tid & 127, dkg = C.tid >> 7;
    float S[16];
#pragma unroll
    for (int j = 0; j < 16; ++j) S[j] = 0.f;
    const float gdv0 = C.gla_g[2 * C.lane], gdv1 = C.gla_g[2 * C.lane + 1];
    for (int ch = 0; ch < SEQ / 32; ++ch) {
        const int row0 = b * SEQ + ch * 32;
        __syncthreads();
        for (int i = C.tid; i < 32 * 64; i += NTHREADS) { const int t = i >> 6, d = i & 63; const bf16* pr = C.PROJ + (size_t)(row0 + t) * NPROJ;
            qs[i] = bf2f(pr[C_GQ + h * 64 + d]); ks[i] = bf2f(pr[C_GK + h * 64 + d]); al[i] = fexp(bf2f(pr[C_AL + h * 64 + d])); }
        for (int i = C.tid; i < 32 * 128; i += NTHREADS) { const int t = i >> 7, d = i & 127; vs[i] = bf2f(C.PROJ[(size_t)(row0 + t) * NPROJ + C_GV + h * 128 + d]); }
        __syncthreads();
#pragma unroll 2
        for (int t = 0; t < 32; ++t) {
            const float v = vs[t * 128 + dv]; float o = 0.f;
#pragma unroll
            for (int j4 = 0; j4 < 4; ++j4) {
                const f32x4 a4 = *(const LAS f32x4*)(al + t * 64 + dkg * 16 + j4 * 4), k4 = *(const LAS f32x4*)(ks + t * 64 + dkg * 16 + j4 * 4), q4 = *(const LAS f32x4*)(qs + t * 64 + dkg * 16 + j4 * 4);
#pragma unroll
                for (int jj = 0; jj < 4; ++jj) { const int j = j4 * 4 + jj; S[j] = a4[jj] * S[j] + k4[jj] * v; o += q4[jj] * S[j]; }
            }
            part[(dkg * 32 + t) * 128 + dv] = o;
        }
        __syncthreads();
#pragma unroll
        for (int tt = 0; tt < 4; ++tt) {
            const int t = 4 * C.wid + tt; float o0 = 0.f, o1 = 0.f;
#pragma unroll
            for (int g = 0; g < 4; ++g) { o0 += part[(g * 32 + t) * 128 + 2 * C.lane]; o1 += part[(g * 32 + t) * 128 + 2 * C.lane + 1]; }
            const float rstd = rsqrtf(wave_sum(o0 * o0 + o1 * o1) * (1.f / 128.f) + EPS);
            const unsigned grw = *(const unsigned*)(C.PROJ + (size_t)(row0 + t) * NPROJ + C_GR + h * 128 + 2 * C.lane);
            const float g0 = bflo(grw), g1 = bfhi(grw);
            const float y0 = o0 * rstd * gdv0 * (g0 * sigmoidf_(g0)), y1 = o1 * rstd * gdv1 * (g1 * sigmoidf_(g1));
            *(unsigned*)(C.OB + (size_t)(row0 + t) * 512 + h * 128 + 2 * C.lane) = pk2(y0, y1);
        }
    }
}

__device__ __forceinline__ void attn_simple(const Ctx& C) {
    LAS float* Kt = (LAS float*)C.lds;
    LAS float* Vt = Kt + 8192;
    LAS float* Ss = Vt + 8192;
    LAS float* ssq = Ss + 2 * 64 * 68;
    LAS float* lamp = ssq + 256;
    if (C.tid < 64) {
        const float a = wave_sum(C.lq1[C.lane] * C.lk1[C.lane]), b2 = wave_sum(C.lq2[C.lane] * C.lk2[C.lane]);
        if (C.tid == 0) lamp[0] = fexp(a) - fexp(b2) + 0.2f;
    }
    __syncthreads();
    const float lam = lamp[0];
    const int q = C.tid & 63, p = (C.tid >> 6) & 1, dq = C.tid >> 7;
    for (int uix = C.bid; uix < 2048; uix += C.G) {
        const int bh = uix & 63, g = (uix >> 6) & 3, i2 = uix >> 8; const int b = bh >> 2, h = bh & 3;
        const int qc = (i2 & 1) ? (31 - (4 * g + (i2 >> 1))) : (4 * g + (i2 >> 1));
        const float sl2 = exp2f(-2.f * (float)(h + 1)) * LOG2E;
        const int qrow = b * SEQ + qc * 64 + q;
        float qv[64];
#pragma unroll
        for (int d8 = 0; d8 < 8; ++d8) { const u32x4 w = *(const u32x4*)(C.PROJ + (size_t)qrow * NPROJ + C_DQ + h * 128 + p * 64 + d8 * 8);
            qv[d8 * 8 + 0] = bflo(w.x); qv[d8 * 8 + 1] = bfhi(w.x); qv[d8 * 8 + 2] = bflo(w.y); qv[d8 * 8 + 3] = bfhi(w.y);
            qv[d8 * 8 + 4] = bflo(w.z); qv[d8 * 8 + 5] = bfhi(w.z); qv[d8 * 8 + 6] = bflo(w.w); qv[d8 * 8 + 7] = bfhi(w.w); }
        float m = -1e30f, l = 0.f, acc[32];
#pragma unroll
        for (int d = 0; d < 32; ++d) acc[d] = 0.f;
        for (int kc = 0; kc <= qc; ++kc) {
            __syncthreads();
            for (int pi = C.tid; pi < 1024; pi += NTHREADS) { const int r = pi >> 4, cc = pi & 15; const bf16* pr = C.PROJ + (size_t)(b * SEQ + kc * 64 + r) * NPROJ + h * 128 + cc * 8;
                const u32x4 kw = *(const u32x4*)(pr + C_DK), vw = *(const u32x4*)(pr + C_DV); f32x4 a0, a1;
                unpack8(kw, a0, a1); *(LAS f32x4*)(Kt + r * 128 + cc * 8) = a0; *(LAS f32x4*)(Kt + r * 128 + cc * 8 + 4) = a1;
                unpack8(vw, a0, a1); *(LAS f32x4*)(Vt + r * 128 + cc * 8) = a0; *(LAS f32x4*)(Vt + r * 128 + cc * 8 + 4) = a1; }
            __syncthreads();
#pragma unroll 1
            for (int kk = 0; kk < 16; ++kk) {
                const int key = dq * 16 + kk; float s = 0.f;
#pragma unroll
                for (int d4 = 0; d4 < 16; ++d4) { const f32x4 kv = *(const LAS f32x4*)(Kt + key * 128 + p * 64 + d4 * 4);
                    s += qv[d4 * 4] * kv[0]; s += qv[d4 * 4 + 1] * kv[1]; s += qv[d4 * 4 + 2] * kv[2]; s += qv[d4 * 4 + 3] * kv[3]; }
                const int kpos = kc * 64 + key, qpos = qc * 64 + q; const int mn = kpos < 2 * qpos - kpos ? kpos : 2 * qpos - kpos;
                Ss[(p * 64 + q) * 68 + key] = s + sl2 * (float)mn;
            }
            __syncthreads();
            const LAS float* srow = Ss + (p * 64 + q) * 68;
            float cm = -1e30f;
#pragma unroll
            for (int k4 = 0; k4 < 16; ++k4) { const f32x4 sv = *(const LAS f32x4*)(srow + k4 * 4); cm = fmaxf(cm, fmaxf(fmaxf(sv[0], sv[1]), fmaxf(sv[2], sv[3]))); }
            const float mnew = fmaxf(m, cm), alpha = exp2f(m - mnew); m = mnew; l *= alpha;
#pragma unroll
            for (int d = 0; d < 32; ++d) acc[d] *= alpha;
#pragma unroll 2
            for (int key = 0; key < 64; ++key) {
                const float pk = exp2f(srow[key] - m); l += pk;
#pragma unroll
                for (int d4 = 0; d4 < 8; ++d4) { const f32x4 vv = *(const LAS f32x4*)(Vt + key * 128 + dq * 32 + d4 * 4);
                    acc[d4 * 4] += pk * vv[0]; acc[d4 * 4 + 1] += pk * vv[1]; acc[d4 * 4 + 2] += pk * vv[2]; acc[d4 * 4 + 3] += pk * vv[3]; }
            }
        }
        const float inv = 1.f / l;
        __syncthreads();
        LAS float* O2 = Ss;
        if (p == 1) {
#pragma unroll
            for (int d = 0; d < 32; ++d) O2[q * 128 + dq * 32 + d] = lam * acc[d] * inv;
        }
        __syncthreads();
        float ss = 0.f;
        if (p == 0) {
#pragma unroll
            for (int d = 0; d < 32; ++d) { acc[d] = acc[d] * inv - O2[q * 128 + dq * 32 + d]; ss += acc[d] * acc[d]; }
            ssq[q * 4 + dq] = ss;
        }
        __syncthreads();
        if (p == 0) {
            const float tot = (ssq[q * 4] + ssq[q * 4 + 1]) + (ssq[q * 4 + 2] + ssq[q * 4 + 3]);
            const float rstd = rsqrtf(tot * (1.f / 128.f) + EPS) * 0.8f;
            bf16* dst = C.OA + (size_t)qrow * 512 + h * 128 + dq * 32;
#pragma unroll
            for (int d8 = 0; d8 < 4; ++d8) { u32x4 w; const float* gg = C.diff_g + dq * 32 + d8 * 8;
                w.x = pk2(acc[d8 * 8] * rstd * gg[0], acc[d8 * 8 + 1] * rstd * gg[1]); w.y = pk2(acc[d8 * 8 + 2] * rstd * gg[2], acc[d8 * 8 + 3] * rstd * gg[3]);
                w.z = pk2(acc[d8 * 8 + 4] * rstd * gg[4], acc[d8 * 8 + 5] * rstd * gg[5]); w.w = pk2(acc[d8 * 8 + 6] * rstd * gg[6], acc[d8 * 8 + 7] * rstd * gg[7]);
                *(u32x4*)(dst + d8 * 8) = w; }
        }
    }
}


typedef float f32x16 __attribute__((ext_vector_type(16)));
typedef short s16x4 __attribute__((ext_vector_type(4)));
typedef short v4i16_t __attribute__((ext_vector_type(4)));
__device__ __forceinline__ s16x4 vtr(const LAS unsigned char* p) { return __builtin_bit_cast(s16x4, __builtin_amdgcn_ds_read_tr16_b64_v4i16((LAS v4i16_t*)p)); }
template <int OFF> __device__ __forceinline__ void glds16(const void* sbase, unsigned voff, unsigned lds_dst) {
    unsigned sv; asm volatile("s_mov_b32 %0, m0\n\ts_mov_b32 m0, %3\n\ts_nop 0\n\tglobal_load_lds_dwordx4 %1, %2 offset:%4\n\ts_mov_b32 m0, %0" : "=&s"(sv) : "v"(voff), "s"(sbase), "s"(lds_dst), "i"(OFF) : "memory"); }
__device__ __forceinline__ unsigned lds_addr(const LAS unsigned char* p) { return (unsigned)__builtin_amdgcn_readfirstlane((int)(unsigned)(size_t)p); }
#define MFMA16(a, b, c) __builtin_amdgcn_mfma_f32_16x16x32_bf16(a, b, c, 0, 0, 0)
__device__ __forceinline__ bf16x8 cat44(s16x4 lo, s16x4 hi) { return (bf16x8){lo[0], lo[1], lo[2], lo[3], hi[0], hi[1], hi[2], hi[3]}; }
__device__ __forceinline__ void gla_chunked(const Ctx& C, int b, int h) {
    const int lane = C.lane, wid = C.wid, fr = lane & 15, fq = lane >> 4;
    LAS unsigned char* lds = C.lds;
    constexpr int RAW_Q = 0, RAW_K = 8192, RAW_LA = 16384, VB0 = 24576, QS = 57344, KS = 66560, KD = 75776, AM = 84992, ST = 94208, OO = 112640, GTL = 146432, SSQ = 146688;
    constexpr int P = 144, PO = 528;
    const char* pbase = (const char*)(C.PROJ + (size_t)(b * SEQ) * NPROJ);
    const unsigned oq = (unsigned)(((8 * wid + (lane >> 3)) * NPROJ + C_GQ + h * 64 + (lane & 7) * 8) * 2);
    const unsigned okk = oq + (unsigned)((C_GK - C_GQ) * 2), ol = oq + (unsigned)((C_AL - C_GQ) * 2);
    const unsigned ov0 = (unsigned)(((4 * wid + (lane >> 4)) * NPROJ + C_GV + h * 128 + (lane & 15) * 8) * 2), ov1 = ov0 + (unsigned)(32 * NPROJ * 2);
#define GL_DMA(n) do { const char* _cb = pbase + (size_t)(n) * 64 * NPROJ * 2; const unsigned _vb = VB0 + ((n) & 1) * 16384; \
        glds16<0>(_cb, oq, lds_addr(lds + RAW_Q + wid * 1024)); glds16<0>(_cb, okk, lds_addr(lds + RAW_K + wid * 1024)); glds16<0>(_cb, ol, lds_addr(lds + RAW_LA + wid * 1024)); \
        glds16<0>(_cb, ov0, lds_addr(lds + _vb + wid * 1024)); glds16<0>(_cb, ov1, lds_addr(lds + _vb + (wid + 8) * 1024)); } while (0)
    __syncthreads();
    GL_DMA(0);
    for (int i = lane; i < 16 * P / 4; i += 64) ((LAS unsigned*)(lds + ST + wid * 16 * P))[i] = 0u;
    f32x4 accS[4];
#pragma unroll
    for (int t = 0; t < 4; ++t) accS[t] = (f32x4){0.f, 0.f, 0.f, 0.f};
    const int t1 = wid >> 1, ca = 2 * (wid & 1);
    bf16x8 ym[2][2];
#pragma unroll
    for (int ci = 0; ci < 2; ++ci)
#pragma unroll
        for (int ks = 0; ks < 2; ++ks)
#pragma unroll
            for (int jj = 0; jj < 8; ++jj) ym[ci][ks][jj] = (short)(((32 * ks + 8 * fq + jj) <= (16 * (ca + ci) + fr)) ? 0x3F80 : 0);
    const bf16x8 ones = (bf16x8){0x3F80, 0x3F80, 0x3F80, 0x3F80, 0x3F80, 0x3F80, 0x3F80, 0x3F80};
    const int qp = (lane & 15) >> 2, pp = lane & 3;
    const float g0 = C.gla_g[2 * lane], g1 = C.gla_g[2 * lane + 1];
    unsigned grw[8];
#pragma unroll
    for (int cc = 0; cc < 8; ++cc) grw[cc] = 0u;
#define GL_ROWPASS(n) do { _Pragma("unroll") for (int cc = 0; cc < 8; ++cc) { const int c_ = 8 * wid + cc; \
        const float o0 = *(const LAS float*)(lds + OO + c_ * PO + lane * 8), o1 = *(const LAS float*)(lds + OO + c_ * PO + lane * 8 + 4); \
        const f32x4 qa = *(const LAS f32x4*)(lds + SSQ + c_ * 32), qb = *(const LAS f32x4*)(lds + SSQ + c_ * 32 + 16); \
        const float rstd = rsqrtf((((qa[0] + qa[1]) + (qa[2] + qa[3])) + ((qb[0] + qb[1]) + (qb[2] + qb[3]))) * (1.f / 128.f) + EPS); const float gr0 = bflo(grw[cc]), gr1 = bfhi(grw[cc]); \
        *(unsigned*)(C.OA + (size_t)(b * SEQ + (n) * 64 + c_) * 1024 + 512 + h * 128 + 2 * lane) = pk2(o0 * rstd * g0 * (gr0 * sigmoidf_(gr0)), o1 * rstd * g1 * (gr1 * sigmoidf_(gr1))); } } while (0)
#pragma unroll 1
    for (int n = 0; n < SEQ / 64; ++n) {
        asm volatile("s_waitcnt vmcnt(0) lgkmcnt(0)" ::: "memory"); __syncthreads();
        if (n > 0) GL_ROWPASS(n - 1);
#pragma unroll
        for (int cc = 0; cc < 8; ++cc) grw[cc] = *(const unsigned*)(pbase + ((size_t)(n * 64 + 8 * wid + cc) * NPROJ + C_GR + h * 128 + 2 * lane) * 2);
        {
            bf16x8 xla[2];
#pragma unroll
            for (int ks = 0; ks < 2; ++ks) { const LAS unsigned char* a = lds + RAW_LA + (32 * ks + 8 * fq + qp) * 128 + (16 * t1 + 4 * pp) * 2; xla[ks] = cat44(vtr(a), vtr(a + 4 * 128)); }
            f32x4 Ga = (f32x4){0.f, 0.f, 0.f, 0.f}, Gb = Ga, GT = Ga;
#pragma unroll
            for (int ks = 0; ks < 2; ++ks) { Ga = MFMA16(xla[ks], ym[0][ks], Ga); Gb = MFMA16(xla[ks], ym[1][ks], Gb); GT = MFMA16(xla[ks], ones, GT); }
#pragma unroll
            for (int ci = 0; ci < 2; ++ci) {
                const int c_ = 16 * (ca + ci) + fr, dk0 = 16 * t1 + 4 * fq; const f32x4 G = ci ? Gb : Ga;
                const u32x2 qw = *(const LAS u32x2*)(lds + RAW_Q + c_ * 128 + dk0 * 2), kw = *(const LAS u32x2*)(lds + RAW_K + c_ * 128 + dk0 * 2);
                const float q4[4] = {bflo(qw.x), bfhi(qw.x), bflo(qw.y), bfhi(qw.y)}, k4[4] = {bflo(kw.x), bfhi(kw.x), bflo(kw.y), bfhi(kw.y)};
                float qs4[4], ks4[4], kd4[4];
#pragma unroll
                for (int r = 0; r < 4; ++r) { qs4[r] = q4[r] * fexp(G[r]); ks4[r] = k4[r] * fexp(-G[r]); kd4[r] = k4[r] * fexp(GT[r] - G[r]); }
                *(LAS u32x2*)(lds + QS + c_ * P + dk0 * 2) = (u32x2){pk2(qs4[0], qs4[1]), pk2(qs4[2], qs4[3])};
                *(LAS u32x2*)(lds + KS + c_ * P + dk0 * 2) = (u32x2){pk2(ks4[0], ks4[1]), pk2(ks4[2], ks4[3])};
                *(LAS u32x2*)(lds + KD + c_ * P + dk0 * 2) = (u32x2){pk2(kd4[0], kd4[1]), pk2(kd4[2], kd4[3])};
            }
            if (fr == 0 && (wid & 1) == 0) *(LAS f32x4*)(lds + GTL + (16 * t1 + 4 * fq) * 4) = GT;
        }
        LDS_WAIT(); __syncthreads();
        if (n + 1 < SEQ / 64) GL_DMA(n + 1);
        {
            const int ct = wid >> 1;
#pragma unroll
            for (int si = 0; si < 2; ++si) {
                const int st = 2 * (wid & 1) + si; f32x4 D = (f32x4){0.f, 0.f, 0.f, 0.f};
                if (st <= ct) {
#pragma unroll
                    for (int ks = 0; ks < 2; ++ks) { const bf16x8 X = *(const LAS bf16x8*)(lds + KS + (16 * st + fr) * P + (32 * ks + 8 * fq) * 2), Y = *(const LAS bf16x8*)(lds + QS + (16 * ct + fr) * P + (32 * ks + 8 * fq) * 2); D = MFMA16(X, Y, D); }
#pragma unroll
                    for (int r = 0; r < 4; ++r) if (16 * st + 4 * fq + r > 16 * ct + fr) D[r] = 0.f;
                }
                *(LAS u32x2*)(lds + AM + (16 * ct + fr) * P + (16 * st + 4 * fq) * 2) = (u32x2){pk2(D[0], D[1]), pk2(D[2], D[3])};
            }
        }
        LDS_WAIT(); __builtin_amdgcn_s_barrier(); asm volatile("" ::: "memory");
        {
            const unsigned vb = VB0 + (n & 1) * 16384;
            bf16x8 X1[2], X2[2];
#pragma unroll
            for (int ks = 0; ks < 2; ++ks) { X1[ks] = *(const LAS bf16x8*)(lds + ST + (16 * wid + fr) * P + (32 * ks + 8 * fq) * 2);
                const LAS unsigned char* a = lds + vb + (32 * ks + 8 * fq + qp) * 256 + (16 * wid + 4 * pp) * 2; X2[ks] = cat44(vtr(a), vtr(a + 4 * 256)); }
#pragma unroll
            for (int ct = 0; ct < 4; ++ct) { f32x4 o = (f32x4){0.f, 0.f, 0.f, 0.f};
#pragma unroll
                for (int ks = 0; ks < 2; ++ks) { const bf16x8 Y1 = *(const LAS bf16x8*)(lds + QS + (16 * ct + fr) * P + (32 * ks + 8 * fq) * 2), Y2 = *(const LAS bf16x8*)(lds + AM + (16 * ct + fr) * P + (32 * ks + 8 * fq) * 2);
                    o = MFMA16(X1[ks], Y1, o); o = MFMA16(X2[ks], Y2, o); }
                *(LAS f32x4*)(lds + OO + (16 * ct + fr) * PO + (16 * wid + 4 * fq) * 4) = o;
                float ss = (o[0] * o[0] + o[1] * o[1]) + (o[2] * o[2] + o[3] * o[3]); ss += __shfl_xor(ss, 16); ss += __shfl_xor(ss, 32);
                if (fq == 0) *(LAS float*)(lds + SSQ + (16 * ct + fr) * 32 + wid * 4) = ss; }
#pragma unroll
            for (int tt = 0; tt < 4; ++tt) { const f32x4 dl = *(const LAS f32x4*)(lds + GTL + (16 * tt + 4 * fq) * 4);
#pragma unroll
                for (int r = 0; r < 4; ++r) accS[tt][r] *= fexp(dl[r]);
#pragma unroll
                for (int ks = 0; ks < 2; ++ks) { const LAS unsigned char* a = lds + KD + (32 * ks + 8 * fq + qp) * P + (16 * tt + 4 * pp) * 2; accS[tt] = MFMA16(cat44(vtr(a), vtr(a + 4 * P)), X2[ks], accS[tt]); }
                *(LAS u32x2*)(lds + ST + (16 * wid + fr) * P + (16 * tt + 4 * fq) * 2) = (u32x2){pk2(accS[tt][0], accS[tt][1]), pk2(accS[tt][2], accS[tt][3])}; }
        }
    }
    asm volatile("s_waitcnt vmcnt(0) lgkmcnt(0)" ::: "memory"); __syncthreads();
    GL_ROWPASS(SEQ / 64 - 1);
    __syncthreads();
#undef GL_DMA
#undef GL_ROWPASS
}

__device__ __forceinline__ int crow(int r, int hi) { return (r & 3) + 8 * (r >> 2) + 4 * hi; }
#define MFMA32(a, b, c) __builtin_amdgcn_mfma_f32_32x32x16_bf16(a, b, c, 0, 0, 0)
constexpr int AT_BUF = 32768, AT_WSF = 3 * 32768, AT_Q = 3 * 32768 + 2048;
constexpr float AT_THR = 8.f;

__device__ __forceinline__ void attn_unit(const Ctx& C, int b, int h, int cp, float lam) {
    const int lane = C.lane, r32 = lane & 31, hi = lane >> 5, wid = C.wid, p = wid >> 2, sub = wid & 3;
    const int NT = 2 * cp + 2, qch = 2 * cp + (sub >> 1), my_nt = qch + 1;
    const int row0 = b * SEQ + cp * 128;
    const int qpos = cp * 128 + sub * 32 + r32;
    const float sl2 = exp2f(-2.f * (float)(h + 1)) * LOG2E;
    LAS unsigned char* lds = C.lds;
    LAS float* wsf = (LAS float*)(lds + AT_WSF) + wid * 64;
    const char* kbase = (const char*)(C.PROJ + (size_t)(b * SEQ) * NPROJ + h * 128);
    const unsigned koff = (unsigned)((lane * NPROJ + C_DK + wid * 8) * 2);
    const unsigned voff = (unsigned)(((16 * (wid & 3) + (lane >> 2)) * NPROJ + C_DV + (wid >> 2) * 32 + (lane & 3) * 8) * 2);
#define AT_DMA(t, bufo) do { const char* _tb = kbase + (size_t)(t) * 64 * NPROJ * 2; \
        glds16<0>(_tb, koff, lds_addr(lds + (bufo) + wid * 1024)); glds16<0>(_tb, koff + 128u, lds_addr(lds + (bufo) + 8192 + wid * 1024)); \
        glds16<0>(_tb, voff, lds_addr(lds + (bufo) + 16384 + (wid >> 2) * 4096 + (wid & 3) * 1024)); glds16<0>(_tb, voff + 128u, lds_addr(lds + (bufo) + 16384 + ((wid >> 2) + 2) * 4096 + (wid & 3) * 1024)); } while (0)
    bf16x8 qr[4];
    { const bf16* qp = C.PROJ + (size_t)(row0 + sub * 32 + r32) * NPROJ + C_DQ + h * 128 + p * 64 + hi * 8;
#pragma unroll
      for (int d0 = 0; d0 < 4; ++d0) qr[d0] = *(const bf16x8*)(qp + d0 * 16); }
    AT_DMA(0, 0); AT_DMA(1, AT_BUF);
    f32x16 o[4];
#pragma unroll
    for (int d0 = 0; d0 < 4; ++d0)
#pragma unroll
        for (int i = 0; i < 16; ++i) o[d0][i] = 0.f;
    float mhat = 0.f, lsum = 0.f;
    const unsigned kofs = (unsigned)(p * 8192 + hi * 1024 + r32 * 16);
    const unsigned vofs = (unsigned)(16384 + ((lane >> 4) & 1) * 32 + (lane & 3) * 8 + (4 * hi + ((lane & 15) >> 2)) * 64);
    asm volatile("s_waitcnt vmcnt(4)" ::: "memory"); __syncthreads();
    asm volatile("" : "+v"(qr[0]), "+v"(qr[1]), "+v"(qr[2]), "+v"(qr[3]));
    unsigned bufo = 0, bufn1 = AT_BUF, bufn2 = 2 * AT_BUF;
#pragma unroll 1
    for (int t = 0; t < NT; ++t) {
        PSTAMP(lds, 0);
        if (t + 2 < NT) AT_DMA(t + 2, bufn2);
        PSTAMP(lds, 1);
        if (t < my_nt) {
            const LAS unsigned char* kp = lds + bufo + kofs;
            const LAS unsigned char* vp = lds + bufo + vofs;
            bf16x8 kf[8];
#pragma unroll
            for (int d0 = 0; d0 < 4; ++d0) { kf[2 * d0] = *(const LAS bf16x8*)(kp + d0 * 2048); kf[2 * d0 + 1] = *(const LAS bf16x8*)(kp + d0 * 2048 + 512); }
            s16x4 va[8], vb[8];
#define AT_VRD(dst, k) do { _Pragma("unroll") for (int d0 = 0; d0 < 4; ++d0) { dst[2 * d0] = vtr(vp + d0 * 4096 + (k) * 1024); dst[2 * d0 + 1] = vtr(vp + d0 * 4096 + (k) * 1024 + 512); } } while (0)
#define AT_PV(src_, k) do { const bf16x8 pa_ = __builtin_bit_cast(bf16x8, pw[k]); __builtin_amdgcn_s_setprio(1); _Pragma("unroll") for (int d0 = 0; d0 < 4; ++d0) o[d0] = MFMA32(pa_, cat44(src_[2 * d0], src_[2 * d0 + 1]), o[d0]); __builtin_amdgcn_s_setprio(0); } while (0)
            AT_VRD(va, 0);
            __builtin_amdgcn_sched_barrier(0);
            f32x16 s0, s1;
            if (t == qch) {
#pragma unroll
                for (int i = 0; i < 16; ++i) { const int k0p = 64 * t + crow(i, hi), k1p = k0p + 32;
                    s0[i] = fmaf(sl2, (float)min(k0p, 2 * qpos - k0p), -mhat); s1[i] = fmaf(sl2, (float)min(k1p, 2 * qpos - k1p), -mhat); }
            } else {
                const float bsm = sl2 * (float)(64 * t + 4 * hi) - mhat;
#pragma unroll
                for (int i = 0; i < 16; ++i) { const float ci = (float)((i & 3) + 8 * (i >> 2)); s0[i] = fmaf(sl2, ci, bsm); s1[i] = fmaf(sl2, ci + 32.f, bsm); }
            }
            __builtin_amdgcn_s_setprio(1);
#pragma unroll
            for (int d0 = 0; d0 < 4; ++d0) { s0 = MFMA32(kf[2 * d0], qr[d0], s0); s1 = MFMA32(kf[2 * d0 + 1], qr[d0], s1); }
            __builtin_amdgcn_s_setprio(0);
            __builtin_amdgcn_sched_barrier(0);
            float rm = fmaxf(s0[0], s1[0]);
#pragma unroll
            for (int i = 1; i < 16; ++i) rm = fmaxf(rm, fmaxf(s0[i], s1[i]));
            { auto rr = __builtin_amdgcn_permlane32_swap(__float_as_uint(rm), __float_as_uint(rm), false, false); rm = fmaxf(__uint_as_float(rr[0]), __uint_as_float(rr[1])); }
            if (t == 0 || __any(rm > AT_THR)) {
                const float dl = (t == 0) ? rm : fmaxf(rm, 0.f); mhat += dl;
                if (t != 0) {
                    const float f = __builtin_amdgcn_exp2f(-dl); lsum *= f;
                    if (hi == 0) wsf[r32] = f;
                    LDS_WAIT();
#pragma unroll
                    for (int i = 0; i < 16; ++i) { const float fi = wsf[crow(i, hi)];
#pragma unroll
                        for (int d0 = 0; d0 < 4; ++d0) o[d0][i] *= fi; }
                }
#pragma unroll
                for (int i = 0; i < 16; ++i) { s0[i] -= dl; s1[i] -= dl; }
            }
            float ps = 0.f;
#pragma unroll
            for (int i = 0; i < 16; ++i) { s0[i] = __builtin_amdgcn_exp2f(s0[i]); s1[i] = __builtin_amdgcn_exp2f(s1[i]); ps += s0[i] + s1[i]; }
            lsum += ps;
            PSTAMP(lds, 2);
            u32x4 pw[4];
            pw[0] = (u32x4){pk2(s0[0], s0[1]), pk2(s0[2], s0[3]), pk2(s0[4], s0[5]), pk2(s0[6], s0[7])};
            pw[1] = (u32x4){pk2(s0[8], s0[9]), pk2(s0[10], s0[11]), pk2(s0[12], s0[13]), pk2(s0[14], s0[15])};
            pw[2] = (u32x4){pk2(s1[0], s1[1]), pk2(s1[2], s1[3]), pk2(s1[4], s1[5]), pk2(s1[6], s1[7])};
            pw[3] = (u32x4){pk2(s1[8], s1[9]), pk2(s1[10], s1[11]), pk2(s1[12], s1[13]), pk2(s1[14], s1[15])};
            __builtin_amdgcn_sched_barrier(0);
            AT_VRD(vb, 1); AT_PV(va, 0); __builtin_amdgcn_sched_barrier(0);
            AT_VRD(va, 2); AT_PV(vb, 1); __builtin_amdgcn_sched_barrier(0);
            AT_VRD(vb, 3); AT_PV(va, 2); __builtin_amdgcn_sched_barrier(0);
            AT_PV(vb, 3);
#undef AT_VRD
#undef AT_PV
        }
        PSTAMP(lds, 3);
        if (t + 2 < NT) asm volatile("s_waitcnt vmcnt(4) lgkmcnt(0)" ::: "memory"); else asm volatile("s_waitcnt vmcnt(0) lgkmcnt(0)" ::: "memory");
        PSTAMP(lds, 4);
        __builtin_amdgcn_s_barrier(); asm volatile("" ::: "memory");
        PSTAMP(lds, 5);
        { const unsigned tb = bufo; bufo = bufn1; bufn1 = bufn2; bufn2 = tb; }
    }
#undef AT_DMA
    lsum += __shfl_xor(lsum, 32);
    if (hi == 0) wsf[32 + r32] = lsum;
    LDS_WAIT();
    LAS float* X = (LAS float*)lds;
    if (p == 1) {
#pragma unroll
        for (int i = 0; i < 16; ++i) { const float sc = lam * __builtin_amdgcn_rcpf(wsf[32 + crow(i, hi)]);
#pragma unroll
            for (int d0 = 0; d0 < 4; ++d0) X[(sub * 32 + crow(i, hi)) * 128 + d0 * 32 + r32] = o[d0][i] * sc; }
    }
    __syncthreads();
    if (p == 0) {
#pragma unroll
        for (int i = 0; i < 16; ++i) { const float sc = __builtin_amdgcn_rcpf(wsf[32 + crow(i, hi)]);
#pragma unroll
            for (int d0 = 0; d0 < 4; ++d0) { LAS float* xp = X + (sub * 32 + crow(i, hi)) * 128 + d0 * 32 + r32; *xp = o[d0][i] * sc - *xp; } }
    }
    __syncthreads();
    { const float g0 = C.diff_g[2 * lane], g1 = C.diff_g[2 * lane + 1];
#pragma unroll 4
      for (int qq = 0; qq < 16; ++qq) { const int q = wid * 16 + qq; const float y0 = X[q * 128 + 2 * lane], y1 = X[q * 128 + 2 * lane + 1];
          const float rstd = rsqrtf(wave_sum(y0 * y0 + y1 * y1) * (1.f / 128.f) + EPS) * 0.8f;
          *(unsigned*)(C.OA + (size_t)(row0 + q) * 1024 + h * 128 + 2 * lane) = pk2(y0 * rstd * g0, y1 * rstd * g1); } }
    __syncthreads();
}

__device__ __forceinline__ void attn_phase(const Ctx& C) {
    LAS float* lamp = (LAS float*)(C.lds + AT_Q) + 4;
    LAS int* qw = (LAS int*)(C.lds + AT_Q);
    if (C.tid < 64) {
        const float a = wave_sum(C.lq1[C.lane] * C.lk1[C.lane]), b2 = wave_sum(C.lq2[C.lane] * C.lk2[C.lane]);
        if (C.tid == 0) lamp[0] = fexp(a) - fexp(b2) + 0.2f;
    }
    __syncthreads();
    const float lam = lamp[0];
    for (;;) {
        if (C.tid == 0) qw[0] = (int)__hip_atomic_fetch_add(C.ctl + CW_QUEUE, 1u, RLX_AGENT);
        __syncthreads();
        const int item = __builtin_amdgcn_readfirstlane(qw[0]);
        __syncthreads();
        if (item >= 1024) break;
        const int bh = item & 63, cp = 15 - (item >> 6);
        attn_unit(C, bh >> 2, bh & 3, cp, lam);
    }
}

__device__ __forceinline__ void phase_router(const Ctx& C) {
    const int lane = C.lane, wid = C.wid, fr = lane & 15, fq = lane >> 4;
    LAS u32x4* WH = (LAS u32x4*)C.lds;
    LAS u32x4* WL = WH + 4096;
    LAS float* GS = (LAS float*)(C.lds + 131072);
    LAS float* SH = GS + 1024;
    LAS float* red = SH + 1024;
    LAS float* ssw = red + 8 * 16 * 32;
    LAS int* lcnt = (LAS int*)(ssw + 128);
    LAS int* lbase = lcnt + 32;
    LAS int* pend = lbase + 32;
    LAS float* cbl = (LAS float*)(pend + 512);
    for (int blk = C.bid; blk < NTOK / 128; blk += C.G) {
        const int b = blk >> 4; const float* md = C.mod + b * 6144;
        __syncthreads();
        for (int k = C.tid; k < DM; k += NTHREADS) { GS[k] = C.norm2_g[k] * (1.f + md[4096 + k]); SH[k] = md[3072 + k]; }
        if (C.tid < 32) lcnt[C.tid] = 0;
        pend[C.tid] = -1;
#pragma unroll 4
        for (int idx = C.tid; idx < 4096; idx += NTHREADS) { WH[idx] = C.wrf[idx]; WL[idx] = C.wrf[4096 + idx]; }
        f32x4 xaA[4], xbA[4]; u32x4 ywA[4];
#define RT_ISSUE(XA, XB, YW, row) do { _Pragma("unroll") for (int ks = 0; ks < 4; ++ks) { const size_t o_ = (size_t)(row) * DM + 128 * wid + 32 * ks + 8 * fq; \
            XA[ks] = __builtin_nontemporal_load((const f32x4*)(C.x + o_)); XB[ks] = __builtin_nontemporal_load((const f32x4*)(C.x + o_ + 4)); YW[ks] = __builtin_nontemporal_load((const u32x4*)(C.Y1 + o_)); } } while (0)
        RT_ISSUE(xaA, xbA, ywA, blk * 128 + fr);
        __syncthreads();
#define RT_MMA(av, ks) do { bf16x8 ah_, al_; split_bf16(av, ah_, al_); const int fi_ = ((wid * 4 + (ks)) * 2) * 64 + lane; \
            const bf16x8 wh0 = __builtin_bit_cast(bf16x8, WH[fi_]), wh1 = __builtin_bit_cast(bf16x8, WH[fi_ + 64]), wl0 = __builtin_bit_cast(bf16x8, WL[fi_]), wl1 = __builtin_bit_cast(bf16x8, WL[fi_ + 64]); \
            acc0 = MFMA16(ah_, wh0, acc0); acc0 = MFMA16(al_, wh0, acc0); acc0 = MFMA16(ah_, wl0, acc0); \
            acc1 = MFMA16(ah_, wh1, acc1); acc1 = MFMA16(al_, wh1, acc1); acc1 = MFMA16(ah_, wl1, acc1); } while (0)
        {
            f32x4 acc0 = (f32x4){0.f, 0.f, 0.f, 0.f}, acc1 = acc0;
#pragma unroll
            for (int ks = 0; ks < 4; ++ks) { const f32x4 sa = *(const LAS f32x4*)(SH + 128 * wid + 32 * ks + 8 * fq), sb = *(const LAS f32x4*)(SH + 128 * wid + 32 * ks + 8 * fq + 4);
                float av[8] = {sa[0], sa[1], sa[2], sa[3], sb[0], sb[1], sb[2], sb[3]}; RT_MMA(av, ks); }
            if (fq == 0) { red[(wid * 16) * 32 + fr] = acc0[0]; red[(wid * 16) * 32 + 16 + fr] = acc1[0]; }
            LDS_WAIT(); __syncthreads();
            if (C.tid < 32) { float t = C.b_router[C.tid];
#pragma unroll
                for (int w2 = 0; w2 < 8; ++w2) t += red[(w2 * 16) * 32 + C.tid];
                cbl[C.tid] = t; }
            LDS_WAIT(); __syncthreads();
        }
#define RT_TILE(XA, XB, YW, it) do { \
            int lane = C.lane; asm volatile("" : "+v"(lane)); const int fr = lane & 15, fq = lane >> 4;     \
            const int row0 = blk * 128 + (it) * 16; float x1[4][8]; \
            _Pragma("unroll") for (int ks = 0; ks < 4; ++ks) { \
                x1[ks][0] = XA[ks][0] + bflo(YW[ks].x); x1[ks][1] = XA[ks][1] + bfhi(YW[ks].x); x1[ks][2] = XA[ks][2] + bflo(YW[ks].y); x1[ks][3] = XA[ks][3] + bfhi(YW[ks].y); \
                x1[ks][4] = XB[ks][0] + bflo(YW[ks].z); x1[ks][5] = XB[ks][1] + bfhi(YW[ks].z); x1[ks][6] = XB[ks][2] + bflo(YW[ks].w); x1[ks][7] = XB[ks][3] + bfhi(YW[ks].w); } \
            __builtin_amdgcn_sched_barrier(0); if ((it) + 1 < 8) RT_ISSUE(XA, XB, YW, row0 + 16 + fr); __builtin_amdgcn_sched_barrier(0);                                     \
            f32x4 acc0 = (f32x4){0.f, 0.f, 0.f, 0.f}, acc1 = acc0; float ss = 0.f; \
            _Pragma("unroll") for (int ks = 0; ks < 4; ++ks) { \
                const f32x4 ga = *(const LAS f32x4*)(GS + 128 * wid + 32 * ks + 8 * fq), gb = *(const LAS f32x4*)(GS + 128 * wid + 32 * ks + 8 * fq + 4); float av[8]; \
                _Pragma("unroll") for (int j = 0; j < 8; ++j) { const float xv = x1[ks][j]; ss += xv * xv; av[j] = xv * (j < 4 ? ga[j] : gb[j - 4]); } \
                RT_MMA(av, ks); __builtin_amdgcn_sched_barrier(0); } \
            ss += __shfl_xor(ss, 16); ss += __shfl_xor(ss, 32); \
            if (fq == 0) ssw[wid * 16 + fr] = ss; \
            _Pragma("unroll") for (int r = 0; r < 4; ++r) { red[(wid * 16 + 4 * fq + r) * 32 + fr] = acc0[r]; red[(wid * 16 + 4 * fq + r) * 32 + 16 + fr] = acc1[r]; } \
            LDS_WAIT(); __syncthreads(); __builtin_amdgcn_sched_barrier(0); \
            {     \
                const int r = 2 * wid + (lane >> 5), e = lane & 31; float sum = 0.f, sq = 0.f; \
                _Pragma("unroll") for (int w2 = 0; w2 < 8; ++w2) { sum += red[(w2 * 16 + r) * 32 + e]; sq += ssw[w2 * 16 + r]; } \
                const float val = rsqrtf(sq * (1.f / DM) + EPS) * sum + cbl[e]; \
                LAS float* lgr = red + (2 * wid + (lane >> 5)) * 32; lgr[e] = val; LDS_WAIT();            \
                int rank = 0; \
                _Pragma("unroll") for (int e4 = 0; e4 < 8; ++e4) { const f32x4 o4 = *(const LAS f32x4*)(lgr + 4 * e4); \
                    _Pragma("unroll") for (int j = 0; j < 4; ++j) rank += (o4[j] > val || (o4[j] == val && (4 * e4 + j) < e)) ? 1 : 0; } \
                LAS float* slr = red + (16 + 2 * wid + (lane >> 5)) * 32;                                   \
                if (rank < 4) slr[rank] = val; \
                LDS_WAIT(); \
                const f32x4 tv = *(const LAS f32x4*)slr; \
                const float e1 = fexp(tv[1] - tv[0]), e2 = fexp(tv[2] - tv[0]), e3 = fexp(tv[3] - tv[0]); const float inv = 1.f / (1.f + e1 + e2 + e3); \
                if (rank < 4) { const int row = row0 + r; const float wgt = (rank == 0 ? 1.f : (rank == 1 ? e1 : (rank == 2 ? e2 : e3))) * inv; \
                    C.topw[(size_t)row * 4 + rank] = wgt; C.tope[(size_t)row * 4 + rank] = e; \
                    const int slot = atomicAdd((int*)(lcnt + e), 1); pend[((it) * 16 + r) * 4 + rank] = (e << 16) | slot; } \
            } \
            __builtin_amdgcn_sched_barrier(0); \
            {     \
                float sq = 0.f; _Pragma("unroll") for (int w2 = 0; w2 < 8; ++w2) sq += ssw[w2 * 16 + fr]; \
                const float rstd = rsqrtf(sq * (1.f / DM) + EPS); \
                _Pragma("unroll") for (int ks = 0; ks < 4; ++ks) { const int k0 = 128 * wid + 32 * ks + 8 * fq; \
                    const f32x4 ga = *(const LAS f32x4*)(GS + k0), gb = *(const LAS f32x4*)(GS + k0 + 4), sa = *(const LAS f32x4*)(SH + k0), sb = *(const LAS f32x4*)(SH + k0 + 4); float hv[8]; \
                    _Pragma("unroll") for (int j = 0; j < 8; ++j) hv[j] = __builtin_amdgcn_fmed3f((x1[ks][j] * rstd * (j < 4 ? ga[j] : gb[j - 4]) + (j < 4 ? sa[j] : sb[j - 4])) * F8_ASCALE, -440.f, 440.f); \
                    *(u32x2*)((unsigned char*)C.H2 + (size_t)(row0 + fr) * DM + k0) = (u32x2){pk4_fp8(hv[0], hv[1], hv[2], hv[3]), pk4_fp8(hv[4], hv[5], hv[6], hv[7])}; __builtin_amdgcn_sched_barrier(0); } \
            } \
            LDS_WAIT(); __syncthreads(); } while (0)
#pragma unroll 1
        for (int it = 0; it < 8; ++it) { RT_TILE(xaA, xbA, ywA, it); }
#undef RT_TILE
#undef RT_MMA
#undef RT_ISSUE
        if (C.tid < 32) lbase[C.tid] = (int)__hip_atomic_fetch_add(C.ctl + CW_CNT + 64 * C.tid, (unsigned)lcnt[C.tid], RLX_AGENT);
        __syncthreads();
        { const int pv = pend[C.tid]; if (pv >= 0) { const int e = pv >> 16, slot = pv & 0xffff; C.list[e * NTOK + lbase[e] + slot] = (blk * 128 + (C.tid >> 2)) * 4 + (C.tid & 3); } }
    }
}

__device__ __forceinline__ void phase_final(const Ctx& C) {
    const int gw = C.bid * NWAVES + C.wid, NGW = C.G * NWAVES;
    for (int r0 = gw * 16; r0 < NTOK; r0 += NGW * 16) {
        const int b = r0 >> 11; const float* gt2p = C.mod + b * 6144 + 5120;
        f32x4 gt2[4], fg[4];
#pragma unroll
        for (int j = 0; j < 4; ++j) { const int c0 = 4 * C.lane + 256 * j; gt2[j] = *(const f32x4*)(gt2p + c0); fg[j] = *(const f32x4*)(C.final_g + c0); }
#pragma unroll 1
        for (int rr = 0; rr < 16; ++rr) {
            const int row = r0 + rr;
            const f32x4 w = *(const f32x4*)(C.topw + (size_t)row * 4) * (1.f / F8_YSCALE);
            f32x4 v[4]; float ss = 0.f;
#pragma unroll
            for (int j = 0; j < 4; ++j) { const int c0 = 4 * C.lane + 256 * j;
                f32x4 y = (f32x4){0.f, 0.f, 0.f, 0.f};
#pragma unroll
                for (int k = 0; k < 4; ++k) { const int yw = __builtin_nontemporal_load((const int*)((const unsigned char*)C.YB + (size_t)(row * 4 + k) * DM + c0));
                    y = y + (f32x4){__builtin_amdgcn_cvt_f32_fp8(yw, 0), __builtin_amdgcn_cvt_f32_fp8(yw, 1), __builtin_amdgcn_cvt_f32_fp8(yw, 2), __builtin_amdgcn_cvt_f32_fp8(yw, 3)} * w[k]; }
                const u32x2 y1w = __builtin_nontemporal_load((const u32x2*)(C.Y1 + (size_t)row * DM + c0));
                v[j] = __builtin_nontemporal_load((const f32x4*)(C.x + (size_t)row * DM + c0)) + (f32x4){bflo(y1w.x), bfhi(y1w.x), bflo(y1w.y), bfhi(y1w.y)} + gt2[j] * y;
                ss += (v[j][0] * v[j][0] + v[j][1] * v[j][1]) + (v[j][2] * v[j][2] + v[j][3] * v[j][3]); }
            const float rstd = rsqrtf(wave_sum(ss) * (1.f / DM) + EPS);
#pragma unroll
            for (int j = 0; j < 4; ++j) __builtin_nontemporal_store(v[j] * rstd * fg[j], (f32x4*)(C.out + (size_t)row * DM + 4 * C.lane + 256 * j));
        }
    }
}

#ifndef PROBE_A
#define PROBE_A -1
#endif
#ifndef PROBE_B
#define PROBE_B -1
#endif
constexpr int CW_TS = 3072;
#define STAMP(k) do { if (PROBE_A >= 0 && blockIdx.x == 0 && threadIdx.x == 0) { const Ctx Cs = make_ctx(lds); ((unsigned long long*)(Cs.ctl + CW_TS))[k] = __builtin_amdgcn_s_memrealtime(); } } while (0)
struct Args { const float* in[25]; float* out; unsigned char* ws; };
typedef const Args __attribute__((address_space(4)))* KArgs;
__device__ __forceinline__ Ctx make_ctx(LAS unsigned char* lds) {
    KArgs a = (KArgs)__builtin_amdgcn_kernarg_segment_ptr();
    asm volatile("" : "+s"(a));
    Ctx C;
    C.lds = lds;
    C.tid = tid_fresh(); C.lane = C.tid & 63; C.wid = __builtin_amdgcn_readfirstlane(C.tid >> 6); C.G = gridDim.x; C.bid = blockIdx.x;
    C.x = a->in[0]; C.c = a->in[1]; C.w_ada = a->in[2]; C.b_ada = a->in[3]; C.norm1_g = a->in[4]; C.w_in = a->in[5];
    C.lq1 = a->in[6]; C.lk1 = a->in[7]; C.lq2 = a->in[8]; C.lk2 = a->in[9]; C.diff_g = a->in[10]; C.w_alpha_up = a->in[11]; C.b_alpha = a->in[12];
    C.gla_g = a->in[13]; C.w_bd = a->in[14]; C.w_bg = a->in[15]; C.w_out = a->in[16]; C.norm2_g = a->in[17]; C.w_router = a->in[18]; C.b_router = a->in[19];
    C.w_gu = a->in[20]; C.b_gu = a->in[21]; C.w_dn = a->in[22]; C.b_dn = a->in[23]; C.final_g = a->in[24];
    C.out = a->out;
    unsigned char* ws = a->ws;
    C.ctl = (unsigned*)(ws + WS_CTL); C.mod = (float*)(ws + WS_MOD); C.tope = (int*)(ws + WS_TOPE); C.topw = (float*)(ws + WS_TOPW); C.list = (int*)(ws + WS_LIST);
    C.WinT = (bf16*)(ws + WS_WIN); C.WbdT = (bf16*)(ws + WS_WBD); C.WbgT = (bf16*)(ws + WS_WBG); C.WoutT = (bf16*)(ws + WS_WOUT); C.WguT = (bf16*)(ws + WS_WGU); C.WdT = (bf16*)(ws + WS_WD);
    C.H = (bf16*)(ws + WS_H); C.H2 = (bf16*)(ws + WS_H2); C.OA = (bf16*)(ws + WS_OA); C.OB = (bf16*)(ws + WS_OB); C.MG = (bf16*)(ws + WS_MG); C.YB = (bf16*)(ws + WS_YB);
    C.PROJ = (bf16*)(ws + WS_PROJ); C.ACT = (bf16*)(ws + WS_ACT); C.Y1 = (bf16*)(ws + WS_Y1); C.cb = (float*)(ws + WS_CB); C.wrf = (u32x4*)(ws + WS_WRF);
    return C;
}
__global__ void __launch_bounds__(NTHREADS, 2) fwd_kernel(Args args) {
    extern __shared__ __attribute__((aligned(16))) unsigned char lds_raw[];
    LAS unsigned char* lds = (LAS unsigned char*)lds_raw;
    for (int u = threadIdx.x; u < (LDS_BYTES - LDSCTL_OFF) / 4; u += NTHREADS) ((LAS unsigned*)(lds + LDSCTL_OFF))[u] = 0u;
    __syncthreads();
    volatile LAS unsigned* MISC = (volatile LAS unsigned*)(lds + MISC_OFF);
    XcdBarrier bar;
    { const Ctx C = make_ctx(lds); bar = xcd_barrier_post(C.ctl + CW_BAR, MISC + 8); }
#define GRID_BAR() xcd_barrier(bar)
    STAMP(0);
#if PROBE_A >= 100
    if (blockIdx.x == 0 && threadIdx.x == 0) ((volatile LAS unsigned*)(lds + MISC_OFF))[15] = (unsigned)__builtin_amdgcn_s_memrealtime();
#endif

    { const Ctx C = make_ctx(lds); phase_mod(C); }
    GRID_BAR(); STAMP(1);
    { const Ctx C = make_ctx(lds); phase_prep(C); }
    GRID_BAR(); STAMP(2);
    { const Ctx C = make_ctx(lds); DenseDesc g{C.H, DM, C.WinT, DM}; TileOrder S; S.init(NTOK / 256, NPROJ / 256, C.G, C.bid, 4); EpiProj E{C.PROJ, C.b_alpha}; gemm_phase<DenseDesc, TileOrder, EpiProj, true, false, 1>(C.lds, g, S, E); }
    GRID_BAR(); STAMP(3);
    { const Ctx C = make_ctx(lds); for (int s = C.bid; s < 64; s += C.G) gla_chunked(C, s >> 2, s & 3); }
    __syncthreads(); STAMP(12);
    { const Ctx C = make_ctx(lds); attn_phase(C); }
    GRID_BAR(); STAMP(4);
    { const Ctx C = make_ctx(lds); DenseDesc g{C.OA, DM, C.WbdT, DM}; TileOrder S; S.init(NTOK / 256, DM / 256, C.G, C.bid); EpiBranch E{C.MG, C.PROJ}; gemm_phase<DenseDesc, TileOrder, EpiBranch, true>(C.lds, g, S, E); }
    GRID_BAR(); STAMP(5);
    STAMP(6);
    { const Ctx C = make_ctx(lds); DenseDesc g{C.MG, DM, C.WoutT, DM}; TileOrder S; S.init(NTOK / 256, DM / 256, C.G, C.bid); EpiOut E{C.Y1, C.mod}; gemm_phase<DenseDesc, TileOrder, EpiOut, true>(C.lds, g, S, E); }
    GRID_BAR(); STAMP(7);
    { const Ctx C = make_ctx(lds); phase_router(C); }
    GRID_BAR(); STAMP(8);
    LAS int* tab = (LAS int*)(lds + STAGE_BYTES);
    __syncthreads();
    if (threadIdx.x == 0) { const Ctx C = make_ctx(lds); int ts = 0; for (int e = 0; e < NE; ++e) { const int cnt = (int)__hip_atomic_load(C.ctl + CW_CNT + 64 * e, RLX_AGENT); tab[e] = cnt; tab[32 + e] = ts; ts += (cnt + 255) >> 8; } tab[64] = ts; }
    __syncthreads();
    for (int tr = threadIdx.x; tr < tab[64]; tr += NTHREADS) { int e = 0; for (int k = 1; k < NE; ++k) if (tab[32 + k] <= tr) e = k; tab[65 + tr] = e; }
    __syncthreads();
    { const Ctx C = make_ctx(lds); const int T = tab[64]; MoeUpDesc g{(const unsigned char*)C.H2, C.list, (const unsigned char*)C.WguT, DM}; MoeOrder S; S.t.init(T, 8, C.G, C.bid, 4); S.tab = tab; EpiUp E{(unsigned char*)C.ACT, C.b_gu}; gemm_phase<MoeUpDesc, MoeOrder, EpiUp, true, true, 4>(C.lds, g, S, E); }
    GRID_BAR(); STAMP(9);
    { const Ctx C = make_ctx(lds); const int T = tab[64]; MoeDownDesc g{(const unsigned char*)C.ACT, (const unsigned char*)C.WdT, FF}; MoeOrder S; S.t.init(T, 4, C.G, C.bid); S.tab = tab; EpiDown E{(unsigned char*)C.YB, C.b_dn, C.list}; gemm_phase<MoeDownDesc, MoeOrder, EpiDown, true, true, 5>(C.lds, g, S, E); }
    GRID_BAR(); STAMP(10);
    { const Ctx C = make_ctx(lds); phase_final(C); }
#if PROBE_A >= 0
    GRID_BAR(); STAMP(11);
    if (blockIdx.x == 0 && threadIdx.x == 0) {
        const Ctx C = make_ctx(lds); const unsigned long long* ts = (const unsigned long long*)(C.ctl + CW_TS);
        asm volatile("s_waitcnt vmcnt(0)" ::: "memory");
        const unsigned long long dt = (PROBE_A >= 100) ? (unsigned long long)((volatile LAS unsigned*)(lds + MISC_OFF))[16 + (PROBE_A >= 100 ? PROBE_A - 100 : 0)] : ((PROBE_A == 12) ? ts[12] - ts[3] : ts[(PROBE_A < 12 ? PROBE_A : 0) + 1] - ts[PROBE_A < 12 ? PROBE_A : 0]), t0 = __builtin_amdgcn_s_memrealtime();
        while (__builtin_amdgcn_s_memrealtime() - t0 < 4ull * dt) __builtin_amdgcn_s_sleep(8);
    }
#endif
}

extern "C" void kernel_launch(void* const* d_in, const int* in_sizes, int n_in, void* d_out, int out_size, void* d_ws, size_t ws_size, hipStream_t stream) {
    static int grid = 0;
    if (grid == 0) {
        if (n_in != 25 || in_sizes[0] != NTOK * DM || out_size != NTOK * DM || ws_size < WS_END) {
            fprintf(stderr, "kernel_launch: unexpected shapes (n_in %d, in0 %d, out %d, ws %zu < %zu)\n", n_in, n_in > 0 ? in_sizes[0] : -1, out_size, ws_size, (size_t)WS_END); grid = -1; return; }
        int dev = 0, cus = 0;
        if (hipGetDevice(&dev) != hipSuccess || hipDeviceGetAttribute(&cus, hipDeviceAttributeMultiprocessorCount, dev) != hipSuccess) { grid = -1; return; }
        if (hipFuncSetAttribute((const void*)fwd_kernel, hipFuncAttributeMaxDynamicSharedMemorySize, LDS_BYTES) != hipSuccess) { fprintf(stderr, "kernel_launch: hipFuncSetAttribute failed\n"); grid = -1; return; }
        (void)hipGetLastError();
        grid = cus;
    }
    if (grid < 0) return;
    if (hipMemsetAsync((char*)d_ws + WS_CTL, 0, CTL_ZERO_BYTES, stream) != hipSuccess) { fprintf(stderr, "kernel_launch: memset failed\n"); return; }
    Args a{};
    for (int i = 0; i < 25; ++i) a.in[i] = (const float*)d_in[i];
    a.out = (float*)d_out; a.ws = (unsigned char*)d_ws;
    hipLaunchKernelGGL(fwd_kernel, dim3(grid), dim3(NTHREADS), LDS_BYTES, stream, a);
}
```

```cpp
#include <hip/hip_runtime.h>
#include <cstdio>
#include <cstdint>

#define GAS __attribute__((address_space(1)))
#define LAS __attribute__((address_space(3)))
typedef unsigned short bf16;
typedef short bf16x8 __attribute__((ext_vector_type(8)));
typedef float f32x4 __attribute__((ext_vector_type(4)));
typedef unsigned u32x4 __attribute__((ext_vector_type(4)));
typedef unsigned u32x2 __attribute__((ext_vector_type(2)));
typedef int i32x4 __attribute__((ext_vector_type(4)));
typedef GAS unsigned gu32;

constexpr int NB = 16, SEQ = 2048, DM = 1024, NTOK = NB * SEQ, NE = 32, FF = 1024;
constexpr int NPROJ = 5376;
constexpr int C_DQ = 0, C_DK = 512, C_DV = 1024, C_GQ = 1536, C_GK = 1792, C_GV = 2048, C_GR = 2560, C_GA = 3072, C_GB = 4096, C_AL = 5120;
constexpr int W_IN_N = 5136;
constexpr float LOG2E = 1.4426950408889634f;
constexpr float QSCALE = 0.125f * LOG2E;
constexpr float EPS = 1e-6f;
constexpr int NWAVES = 8, NTHREADS = 512;

constexpr size_t MiB = 1u << 20;
constexpr size_t WS_CTL = 0, CTL_ZERO_BYTES = 64 * 1024;
constexpr size_t WS_MOD = 1 * MiB;
constexpr size_t WS_TOPE = 2 * MiB;
constexpr size_t WS_TOPW = 3 * MiB;
constexpr size_t WS_LIST = 4 * MiB;
constexpr size_t WS_WIN = 8 * MiB;
constexpr size_t WS_WBD = 19 * MiB;
constexpr size_t WS_WBG = 20 * MiB;
constexpr size_t WS_WOUT = 21 * MiB;
constexpr size_t WS_WGU = 24 * MiB;
constexpr size_t WS_WD = 152 * MiB;
constexpr size_t WS_H2 = 216 * MiB;
constexpr size_t WS_RB = 280 * MiB;
constexpr size_t WS_H = WS_RB, WS_OA = WS_RB + 64 * MiB, WS_OB = WS_RB + 96 * MiB, WS_MG = WS_RB + 128 * MiB, WS_YB = WS_RB;
constexpr size_t WS_RA = 536 * MiB;
constexpr size_t WS_PROJ = WS_RA, WS_ACT = WS_RA;
constexpr size_t WS_Y1 = WS_RA + 272 * MiB;
constexpr size_t WS_CB = WS_MOD + 512 * 1024;
constexpr size_t WS_WRF = WS_MOD + 768 * 1024;
constexpr size_t WS_END = 872 * MiB;
constexpr int MAX_TILES = 544;
static_assert((size_t)MAX_TILES * 256 * 1024 * 2 <= 336 * MiB, "act fits region A");
constexpr int CW_CNT = 64;
constexpr int CW_BAR = 4096;
constexpr int CW_QUEUE = 2304;
constexpr int CW_MODRDY = 2432;

constexpr int SCR_BYTES = 159744;
constexpr int LDSCTL_OFF = SCR_BYTES, MISC_OFF = LDSCTL_OFF + 320;
constexpr int LDS_BYTES = SCR_BYTES + 1024;

#define RLX_AGENT __ATOMIC_RELAXED, __HIP_MEMORY_SCOPE_AGENT
#define LDS_WAIT() asm volatile("s_waitcnt lgkmcnt(0)" ::: "memory")

__device__ __forceinline__ unsigned f2bf(float f) { unsigned u = __builtin_bit_cast(unsigned, f); return (u + 0x7fffu + ((u >> 16) & 1u)) >> 16; }
typedef __bf16 bf16n2 __attribute__((ext_vector_type(2)));
typedef float f32x2 __attribute__((ext_vector_type(2)));
__device__ __forceinline__ unsigned pk2(float lo, float hi) { return __builtin_bit_cast(unsigned, __builtin_convertvector((f32x2){lo, hi}, bf16n2)); }
__device__ __forceinline__ unsigned pk4_fp8(float a, float b, float c, float d) { int w = 0; w = __builtin_amdgcn_cvt_pk_fp8_f32(a, b, w, false); w = __builtin_amdgcn_cvt_pk_fp8_f32(c, d, w, true); return (unsigned)w; }
constexpr float F8_ASCALE = 4.f, F8_WSCALE = 512.f;
constexpr int F8_SA = 0x7d7d7d7d, F8_SW = 0x76767676;
__device__ __forceinline__ float bf2f(unsigned b) { return __uint_as_float(b << 16); }
__device__ __forceinline__ float bflo(unsigned w) { return __uint_as_float(w << 16); }
__device__ __forceinline__ float bfhi(unsigned w) { return __uint_as_float(w & 0xffff0000u); }
template <int CTRL> __device__ __forceinline__ float dpp_mov(float v) { return __uint_as_float((unsigned)__builtin_amdgcn_update_dpp(0, (int)__float_as_uint(v), CTRL, 0xf, 0xf, false)); }
__device__ __forceinline__ float sum_x32(float v) {
    auto r = __builtin_amdgcn_permlane32_swap(__float_as_uint(v), __float_as_uint(v), false, false); return __uint_as_float(r[0]) + __uint_as_float(r[1]); }
__device__ __forceinline__ float sum_rows(float v) {
    auto r = __builtin_amdgcn_permlane16_swap(__float_as_uint(v), __float_as_uint(v), false, false); return sum_x32(__uint_as_float(r[0]) + __uint_as_float(r[1])); }
__device__ __forceinline__ float wave_sum(float v) {
    v += dpp_mov<0x128>(v); v += dpp_mov<0x124>(v); v += dpp_mov<0x122>(v); v += dpp_mov<0x121>(v);
    return sum_rows(v);
}
__device__ __forceinline__ int tid_fresh() { int t = threadIdx.x; asm volatile("" : "+v"(t)); return t; }
__device__ __forceinline__ float fexp(float x) { return __builtin_amdgcn_exp2f(x * 1.4426950408889634f); }
__device__ __forceinline__ float sigmoidf_(float x) { return __builtin_amdgcn_rcpf(1.f + fexp(-x)); }

#define XB_TMO      128
#define XB_XCNT(j)  (256  + 64 * (j))
#define XB_XSUB(j)  (1280 + 64 * (j))
#define XB_XGEN(j)  (2304 + 64 * (j))
#define XB_TOP      3328
#define XB_TOPGEN   3392
#define XCD_BAR_WORDS 3456
#define XB_SPIN_CAP (1u << 22)
__device__ __forceinline__ unsigned xb_ld(unsigned* p)              { return __hip_atomic_load(p, __ATOMIC_RELAXED, __HIP_MEMORY_SCOPE_AGENT); }
__device__ __forceinline__ unsigned xb_add(unsigned* p, unsigned v) { return __hip_atomic_fetch_add(p, v, __ATOMIC_RELAXED, __HIP_MEMORY_SCOPE_AGENT); }
__device__ __forceinline__ unsigned xb_xcc_id() { return (unsigned)__builtin_amdgcn_s_getreg((3 << 11) | 20) & 0xFu; }
#define XB_SPIN(cond, bar) do { unsigned _sp = 0; while (cond) { __builtin_amdgcn_s_sleep(1); \
    if ((++_sp & 255u) == 0u) { if (xb_ld(&(bar)[XB_TMO])) break; if (_sp > XB_SPIN_CAP) { atomicAdd(&(bar)[XB_TMO], 1u); break; } } } } while (0)
struct XcdBarrier { unsigned* bar; unsigned x; volatile LAS unsigned* st; };
__device__ __forceinline__ XcdBarrier xcd_barrier_post(unsigned* bar, volatile LAS unsigned* st) {
    XcdBarrier b; b.bar = bar; b.x = xb_xcc_id(); b.st = st;
    if (threadIdx.x == 0) (void)xb_add(&bar[XB_XCNT(b.x)], 1u);
    return b;
}
__device__ __forceinline__ void xcd_barrier_complete(unsigned* bar, unsigned x, unsigned& nloc, unsigned& nx) {
    const unsigned G = gridDim.x * gridDim.y * gridDim.z;
    unsigned sum, cnt, mine, sp = 0u;
    for (;;) {
        sum = 0u; cnt = 0u; mine = 0u;
#pragma unroll
        for (unsigned j = 0; j < 16; ++j) { const unsigned c = xb_ld(&bar[XB_XCNT(j)]); sum += c; cnt += (c > 0u) ? 1u : 0u; mine = (j == x) ? c : mine; }
        if (sum == G) break;
        __builtin_amdgcn_s_sleep(1);
        if ((++sp & 255u) == 0u) { if (xb_ld(&bar[XB_TMO])) break; if (sp > XB_SPIN_CAP) { atomicAdd(&bar[XB_TMO], 1u); break; } }
    }
    nloc = mine > 0u ? mine : 1u; nx = cnt > 0u ? cnt : 1u;
}
__device__ __forceinline__ void xcd_barrier(const XcdBarrier& b) {
    asm volatile("s_waitcnt vmcnt(0)" ::: "memory");
    __syncthreads();
    if (threadIdx.x == 0) {
        unsigned* bar = b.bar;
        __builtin_amdgcn_s_waitcnt(0);
        unsigned nloc = b.st[0], nx = b.st[1];
        if (nloc == 0u) { xcd_barrier_complete(bar, b.x, nloc, nx); b.st[0] = nloc; b.st[1] = nx; }
        const unsigned old = xb_add(&bar[XB_XSUB(b.x)], 1u);
        const unsigned gen = old / nloc;
        if (old + 1u == (gen + 1u) * nloc) {
            __builtin_amdgcn_fence(__ATOMIC_RELEASE, "agent");
            asm volatile("s_waitcnt vmcnt(0)" ::: "memory");
            const unsigned og = xb_add(&bar[XB_TOP], 1u);
            const unsigned tg = og / nx;
            if (og + 1u == (tg + 1u) * nx) xb_add(&bar[XB_TOPGEN], 1u);
            else XB_SPIN(xb_ld(&bar[XB_TOPGEN]) == tg, bar);
            __builtin_amdgcn_fence(__ATOMIC_ACQUIRE, "agent");
            xb_add(&bar[XB_XGEN(b.x)], 1u);
            asm volatile("s_waitcnt vmcnt(0)" ::: "memory");
        } else {
            XB_SPIN(xb_ld(&bar[XB_XGEN(b.x)]) == gen, bar);
            __builtin_amdgcn_fence(__ATOMIC_ACQUIRE, "agent");
            asm volatile("s_waitcnt vmcnt(0)" ::: "memory");
        }
    }
    __syncthreads();
}

struct Ctx {
    LAS unsigned char* lds;
    int tid, lane, wid, G, bid;
    const float *x, *c, *w_ada, *b_ada, *norm1_g, *w_in, *lq1, *lk1, *lq2, *lk2, *diff_g, *w_alpha_up, *b_alpha, *gla_g,
                *w_bd, *w_bg, *w_out, *norm2_g, *w_router, *b_router, *w_gu, *b_gu, *w_dn, *b_dn, *final_g;
    float* out;
    unsigned* ctl; float* mod; int* tope; float* topw; int* list;
    bf16 *WinT, *WbdT, *WbgT, *WoutT, *WguT, *WdT, *H, *H2, *OA, *OB, *MG, *YB, *PROJ, *ACT, *Y1; float* cb; u32x4* wrf;
};

constexpr int NXCD = 8, WGM = 8;
__host__ __device__ __forceinline__ int perm32(int rho) { const int n = rho >> 4, i = rho & 15; return 8 * (i >> 2) + 4 * n + (i & 3); }
struct Unit { int pm, pn, e, row0, cnt; };
struct TileOrder {
    int nM, nN, nwg, G, c, wgm;
    __device__ __forceinline__ void init(int nM_, int nN_, int G_, int c_, int wgm_ = WGM) { nM = nM_; nN = nN_; nwg = nM * nN; G = G_; c = c_; wgm = wgm_; }
    __device__ __forceinline__ bool next(int i, Unit& u) const {
        const long L = (long)i * G + c; if (L >= nwg) return false;
        int wgid = (int)L; { const int q = nwg / NXCD, r = nwg % NXCD, xcd = wgid % NXCD, off = wgid / NXCD; wgid = (xcd < r ? xcd * (q + 1) : r * (q + 1) + (xcd - r) * q) + off; }
        const int nig = wgm * nN, gid = wgid / nig, fm = gid * wgm, gsz = (nM - fm) < wgm ? (nM - fm) : wgm;
        u.pm = fm + ((wgid % nig) % gsz); u.pn = (wgid % nig) / gsz; u.e = 0; u.row0 = 0; u.cnt = 0; return true;
    }
};
struct MoeOrder {
    TileOrder t; LAS const int* tab;
    __device__ __forceinline__ bool next(int i, Unit& u) const {
        if (!t.next(i, u)) return false;
        const int e = tab[65 + u.pm];
        u.e = e; u.row0 = (u.pm - tab[32 + e]) * 256; u.cnt = tab[e]; return true;
    }
};
struct DenseDesc {
    static constexpr bool GATHER = false;
    const bf16* A; int lda; const bf16* Bt; int K;
    __device__ __forceinline__ unsigned a_off(const Unit& u, int r) const { return (unsigned)((u.pm * 256 + r) * lda) * 2u; }
    __device__ __forceinline__ const char* a_base(const Unit&) const { return (const char*)A; }
    __device__ __forceinline__ const char* b_base(const Unit& u) const { return (const char*)Bt + (size_t)u.pn * 256 * K * 2; }
};
struct MoeUpDesc {
    static constexpr bool GATHER = true;
    const unsigned char* H2; const int* list; const unsigned char* WguT; int K;
    __device__ __forceinline__ const int* id_src(const Unit& u, int j) const { const int s = u.row0 + j; return list + (size_t)u.e * NTOK + (s < NTOK ? s : NTOK - 1); }
    __device__ __forceinline__ unsigned a_off(const Unit& u, int r) const { const int slot = u.row0 + r; int tok = 0; if (slot < u.cnt) tok = list[u.e * NTOK + slot] >> 2; return (unsigned)tok * 1024u; }
    __device__ __forceinline__ const char* a_base(const Unit&) const { return (const char*)H2; }
    __device__ __forceinline__ const char* b_base(const Unit& u) const { return (const char*)WguT + ((size_t)u.e * 2048 + (size_t)u.pn * 256) * 1024; }
};
struct MoeDownDesc {
    static constexpr bool GATHER = false;
    const unsigned char* ACT; const unsigned char* WdT; int K;
    __device__ __forceinline__ unsigned a_off(const Unit& u, int r) const { return (unsigned)(u.pm * 256 + r) * 1024u; }
    __device__ __forceinline__ const char* a_base(const Unit&) const { return (const char*)ACT; }
    __device__ __forceinline__ const char* b_base(const Unit& u) const { return (const char*)WdT + ((size_t)u.e * 1024 + (size_t)u.pn * 256) * 1024; }
};

template <class Desc, class Order, class Epi>
__device__ __forceinline__ void gemm_simple(const Desc& g, const Order& S, const Epi& E) {
    const int tid = threadIdx.x, wid = __builtin_amdgcn_readfirstlane(tid >> 6), lane = tid & 63, wr = wid >> 2, wc = wid & 3, fr = lane & 15, fq = lane >> 4;
    const int K = g.K;
    Unit u;
    for (int i = 0; S.next(i, u); ++i) {
        f32x4 acc[2][2][4][2];
#pragma unroll
        for (int a = 0; a < 2; ++a)
#pragma unroll
            for (int b = 0; b < 2; ++b)
#pragma unroll
                for (int m = 0; m < 4; ++m)
#pragma unroll
                    for (int n = 0; n < 2; ++n) acc[a][b][m][n] = (f32x4){0.f, 0.f, 0.f, 0.f};
        unsigned aoff[2][4], boff[2][2];
#pragma unroll
        for (int a = 0; a < 2; ++a)
#pragma unroll
            for (int m = 0; m < 4; ++m) aoff[a][m] = g.a_off(u, a * 128 + wr * 64 + m * 16 + fr) + fq * 16;
#pragma unroll
        for (int b = 0; b < 2; ++b)
#pragma unroll
            for (int n = 0; n < 2; ++n) { const int nc = b * 128 + wc * 32 + (Epi::PERM ? perm32(n * 16 + fr) : (n * 16 + fr)); boff[b][n] = (unsigned)(nc * K) * 2u + fq * 16; }
        const char* ab = g.a_base(u); const char* bb = g.b_base(u);
#pragma unroll 1
        for (int ks = 0; ks < K / 32; ++ks) {
            bf16x8 af[2][4], bfr[2][2];
#pragma unroll
            for (int a = 0; a < 2; ++a)
#pragma unroll
                for (int m = 0; m < 4; ++m) af[a][m] = *(const bf16x8*)(ab + aoff[a][m] + ks * 64);
#pragma unroll
            for (int b = 0; b < 2; ++b)
#pragma unroll
                for (int n = 0; n < 2; ++n) bfr[b][n] = *(const bf16x8*)(bb + boff[b][n] + ks * 64);
#pragma unroll
            for (int a = 0; a < 2; ++a)
#pragma unroll
                for (int b = 0; b < 2; ++b)
#pragma unroll
                    for (int m = 0; m < 4; ++m)
#pragma unroll
                        for (int n = 0; n < 2; ++n) acc[a][b][m][n] = __builtin_amdgcn_mfma_f32_16x16x32_bf16(bfr[b][n], af[a][m], acc[a][b][m][n], 0, 0, 0);
        }
        E(acc, u, wr, wc, fr, fq);
    }
}


#ifndef PROBE_A
#define PROBE_A -1
#endif
#if PROBE_A >= 100
#define PSTAMP(ldsp, idx) do { if (blockIdx.x == 0 && threadIdx.x == 0) { volatile LAS unsigned* pm_ = (volatile LAS unsigned*)((ldsp) + MISC_OFF); const unsigned now_ = (unsigned)__builtin_amdgcn_s_memrealtime(); pm_[16 + (idx)] += now_ - pm_[15]; pm_[15] = now_; } } while (0)
#else
#define PSTAMP(ldsp, idx) do {} while (0)
#endif
constexpr int BK = 64, HALF = 128, HTB = HALF * BK * 2, STAGE_BYTES = 8 * HTB;
__host__ __device__ __forceinline__ int lds_byte(int r, int c) { const int st = (r >> 4) * 2 + (c >> 5), rr = r & 15, cc = c & 31, ob = rr * 64 + cc * 2; return st * 1024 + (ob ^ (((ob >> 9) & 1) << 5)); }
__host__ __device__ __forceinline__ void stage_rc(int b, int& R, int& C) { const int st = b / 1024, sb = b % 1024, swz = sb ^ (((sb >> 9) & 1) << 5); R = (st >> 1) * 16 + swz / 64; C = (st & 1) * 32 + (swz % 64) / 2; }

typedef int v8i32 __attribute__((ext_vector_type(8)));
__device__ __forceinline__ v8i32 cat88(bf16x8 lo, bf16x8 hi) { const i32x4 a = __builtin_bit_cast(i32x4, lo), b = __builtin_bit_cast(i32x4, hi); return (v8i32){a[0], a[1], a[2], a[3], b[0], b[1], b[2], b[3]}; }
template <class Desc, class Order, class Epi, bool ALIGN_EPI, bool FP8 = false, int PID = 0>
__device__ __forceinline__ void gemm_phase(LAS unsigned char* lds, const Desc& g, const Order& S, const Epi& E) {
    const int tid = tid_fresh(), wid = __builtin_amdgcn_readfirstlane(tid >> 6), lane = tid & 63, wr = wid >> 2, wc = wid & 3, fr = lane & 15, fq = lane >> 4;
    const int KBy = FP8 ? g.K : 2 * g.K, nt = KBy / 128;
    int Rs[2], Cs[2]; unsigned voffB[2];
#pragma unroll
    for (int i = 0; i < 2; ++i) { stage_rc(tid * 16 + i * 8192, Rs[i], Cs[i]); const int Rb = 64 * (Rs[i] >> 5) + perm32(Rs[i] & 31); voffB[i] = (unsigned)(Rb * KBy + Cs[i] * 2); }
    unsigned vA[2][2];
    LAS u32x4* const vslot = (LAS u32x4*)(lds + STAGE_BYTES + 4096) + tid;
    const size_t kstep = (size_t)(BK * 2);
    const size_t hstepB = (size_t)32 * KBy;
    const unsigned ldsw = (unsigned)wid * 1024u;
    const int aoff = FP8 ? lds_byte(wr * 64 + fr, fq * 16) : lds_byte(wr * 64 + fr, fq * 8), boff = FP8 ? lds_byte(wc * 32 + fr, fq * 16) : lds_byte(wc * 32 + fr, fq * 8);
    constexpr int KSTR = FP8 ? 16 : 1024;
#define PG8_SA(b, h) (((b) * 2 + (h)) * HTB)
#define PG8_SB(b, h) ((4 + (b) * 2 + (h)) * HTB)
#define PG8_STAGE(bufoff, gbase, voff) do { _Pragma("unroll") for (int _i = 0; _i < 2; ++_i) \
        __builtin_amdgcn_global_load_lds((const unsigned*)((const char*)(gbase) + (voff)[_i]), (LAS unsigned*)(lds + (bufoff) + ldsw + _i * 8192), 16, 0, 0); } while (0)
#define PG8_STAGE_A(bufoff, gbase, h) do { _Pragma("unroll") for (int _i = 0; _i < 2; ++_i) \
        __builtin_amdgcn_global_load_lds((const unsigned*)((const char*)(gbase) + vA[h][_i]), (LAS unsigned*)(lds + (bufoff) + ldsw + _i * 8192), 16, 0, 0); } while (0)
#define PG8_LDA(dst, b, h) do { _Pragma("unroll") for (int m = 0; m < 4; ++m) _Pragma("unroll") for (int k = 0; k < 2; ++k) dst[m][k] = *(const LAS bf16x8*)(lds + PG8_SA(b, h) + aoff + m * 2048 + k * KSTR); } while (0)
#define PG8_LDB(dst, b, h) do { _Pragma("unroll") for (int n = 0; n < 2; ++n) _Pragma("unroll") for (int k = 0; k < 2; ++k) dst[n][k] = *(const LAS bf16x8*)(lds + PG8_SB(b, h) + boff + n * 2048 + k * KSTR); } while (0)
#define PG8_MMA(ai, bj, At, Bt) do { __builtin_amdgcn_s_setprio(1); _Pragma("unroll") for (int m = 0; m < 4; ++m) _Pragma("unroll") for (int n = 0; n < 2; ++n) { \
        if constexpr (FP8) { acc[ai][bj][m][n] = __builtin_amdgcn_mfma_scale_f32_16x16x128_f8f6f4(cat88(Bt[n][0], Bt[n][1]), cat88(At[m][0], At[m][1]), acc[ai][bj][m][n], 0, 0, 0, F8_SW, 0, F8_SA); } \
        else { _Pragma("unroll") for (int k = 0; k < 2; ++k) acc[ai][bj][m][n] = __builtin_amdgcn_mfma_f32_16x16x32_bf16(Bt[n][k], At[m][k], acc[ai][bj][m][n], 0, 0, 0); } } \
        __builtin_amdgcn_s_setprio(0); } while (0)
#define PG8_WAIT_V(n) asm volatile("s_waitcnt vmcnt(" #n ")" ::: "memory")
#define PG8_WAIT_L(n) asm volatile("s_waitcnt lgkmcnt(" #n ")" ::: "memory")
#define PG8_BAR __builtin_amdgcn_s_barrier()
#define PG8_SCHED __builtin_amdgcn_sched_barrier(0)
#define PG8_KBODY(t) do { \
            const bool last = (t == nt - 2); \
            const char* a1 = Ab + (size_t)(t + 1) * kstep; \
            const char* a2 = last ? Ab : Ab + (size_t)(t + 2) * kstep; const char* b2 = last ? nB : cB + (size_t)(t + 2) * kstep; \
            const char* a3 = a2 + kstep; const char* b3 = b2 + kstep; \
              \
            PG8_LDB(B0, 0, 0); PG8_LDB(B1, 0, 1); PG8_SCHED; PG8_LDA(At, 0, 0); PG8_STAGE_A(PG8_SA(1, 1), a1, 1); \
            if (last && has_next) { if constexpr (Desc::GATHER) { _Pragma("unroll") for (int _h = 0; _h < 2; ++_h) _Pragma("unroll") for (int _i = 0; _i < 2; ++_i) { const int _j = _h * HALF + Rs[_i]; const int _id = idbuf[((ui + 1) & 1) * 256 + _j]; vA[_h][_i] = ((nxt.row0 + _j < nxt.cnt) ? (unsigned)(_id >> 2) * 1024u : 0u) + (unsigned)Cs[_i] * 2u; } } else { const u32x4 vn = *vslot; vA[0][0] = vn.x; vA[0][1] = vn.y; vA[1][0] = vn.z; vA[1][1] = vn.w; } }     \
            PG8_WAIT_V(8); PG8_WAIT_L(0); PG8_BAR; PG8_MMA(0, 0, At, B0); PG8_MMA(0, 1, At, B1); PG8_BAR; PG8_SCHED; \
              \
            PG8_LDA(At, 0, 1); PG8_STAGE(PG8_SB(0, 0), b2, voffB); PG8_STAGE(PG8_SB(0, 1), b2 + hstepB, voffB); PG8_STAGE_A(PG8_SA(0, 0), a2, 0); \
            PG8_WAIT_V(8); PG8_WAIT_L(0); PG8_BAR; PG8_MMA(1, 0, At, B0); PG8_MMA(1, 1, At, B1); PG8_BAR; PG8_SCHED; \
              \
            PG8_LDB(B0, 1, 0); PG8_LDB(B1, 1, 1); PG8_SCHED; PG8_LDA(At, 1, 0); PG8_STAGE_A(PG8_SA(0, 1), a2, 1); \
            PG8_WAIT_V(8); PG8_WAIT_L(0); PG8_BAR; PG8_MMA(0, 0, At, B0); PG8_MMA(0, 1, At, B1); PG8_BAR; PG8_SCHED; \
              \
            PG8_LDA(At, 1, 1); PG8_STAGE(PG8_SB(1, 0), b3, voffB); PG8_STAGE(PG8_SB(1, 1), b3 + hstepB, voffB); PG8_STAGE_A(PG8_SA(1, 0), a3, 0); \
            PG8_WAIT_V(8); PG8_WAIT_L(0); PG8_BAR; PG8_MMA(1, 0, At, B0); PG8_MMA(1, 1, At, B1); PG8_BAR; PG8_SCHED; \
        } while (0)
#define PG8_AOFFS(dst, un) do { _Pragma("unroll") for (int _h = 0; _h < 2; ++_h) _Pragma("unroll") for (int _i = 0; _i < 2; ++_i) dst[_h][_i] = g.a_off(un, _h * HALF + Rs[_i]) + (unsigned)Cs[_i] * 2u; } while (0)
    Unit cur, nxt; int ui = 0;
    if (!S.next(0, cur)) return;
    LAS int* const idbuf = (LAS int*)(lds + STAGE_BYTES + 4096);
#define PG8_IDDMA(un, b) do { if (wid < 4) __builtin_amdgcn_global_load_lds((const unsigned*)g.id_src(un, 64 * wid + lane), (LAS unsigned*)(idbuf + (b) * 256 + 64 * wid), 4, 0, 0); } while (0)
    if constexpr (Desc::GATHER) { Unit u1; if (S.next(1, u1)) PG8_IDDMA(u1, 1); }
    LAS unsigned char* const epb = lds + STAGE_BYTES + 12288 + wid * 1536;
    if constexpr (Epi::PREF) E.prefetch(epb, cur, wr, wc, lane);
    f32x4 acc[2][2][4][2];
#pragma unroll
    for (int a = 0; a < 2; ++a)
#pragma unroll
        for (int b = 0; b < 2; ++b)
#pragma unroll
            for (int m = 0; m < 4; ++m)
#pragma unroll
                for (int n = 0; n < 2; ++n) acc[a][b][m][n] = (f32x4){0.f, 0.f, 0.f, 0.f};
    bf16x8 At[4][2], B0[2][2], B1[2][2];
    const char* const Ab = g.a_base(cur);
    const char* cB = g.b_base(cur);
    PG8_AOFFS(vA, cur);
    PG8_STAGE(PG8_SB(0, 0), cB, voffB); PG8_STAGE(PG8_SB(0, 1), cB + hstepB, voffB); PG8_STAGE_A(PG8_SA(0, 0), Ab, 0); PG8_STAGE_A(PG8_SA(0, 1), Ab, 1);
    if (wr == 1) PG8_BAR;
    PG8_WAIT_V(2); PG8_BAR;
    PG8_STAGE(PG8_SB(1, 0), cB + kstep, voffB); PG8_STAGE_A(PG8_SA(1, 0), Ab + kstep, 0); PG8_STAGE(PG8_SB(1, 1), cB + hstepB + kstep, voffB);
    PG8_WAIT_V(6); PG8_BAR;
    if constexpr (Epi::BINIT) E.init(acc, epb, fq);
    for (;;) {
        const bool has_next = S.next(ui + 1, nxt);
        const char* nB = has_next ? g.b_base(nxt) : cB;
        if constexpr (Desc::GATHER) { Unit u2; if (S.next(ui + 2, u2)) PG8_IDDMA(u2, ui & 1); }
        else if (has_next) { unsigned vn[2][2]; PG8_AOFFS(vn, nxt); *vslot = (u32x4){vn[0][0], vn[0][1], vn[1][0], vn[1][1]}; }
        if constexpr (Epi::PREF) { if (has_next) E.prefetch(epb + ((ui + 1) & 1) * 768, nxt, wr, wc, lane); }
        PSTAMP(lds, 40 + PID);
        if constexpr (Epi::MIDK) {
            for (int t = 0; t < nt / 2; t += 2) PG8_KBODY(t);
            E.mid(acc, cur, wr, wc, fr, fq);
            for (int t = nt / 2; t < nt; t += 2) PG8_KBODY(t);
        } else {
            for (int t = 0; t < nt; t += 2) PG8_KBODY(t);
        }
        PSTAMP(lds, 20 + PID);
        if constexpr (ALIGN_EPI) { if (wr == 0) PG8_BAR; }
        if constexpr (Epi::PREF) E(acc, cur, wr, wc, fr, fq, epb + (ui & 1) * 768); else E(acc, cur, wr, wc, fr, fq);
        PSTAMP(lds, 30 + PID);
        if (!has_next) break;
        if constexpr (Epi::BINIT) E.init(acc, epb + ((ui + 1) & 1) * 768, fq);
        else {
#pragma unroll
        for (int a = 0; a < 2; ++a)
#pragma unroll
            for (int b = 0; b < 2; ++b)
#pragma unroll
                for (int m = 0; m < 4; ++m)
#pragma unroll
                    for (int n = 0; n < 2; ++n) acc[a][b][m][n] = (f32x4){0.f, 0.f, 0.f, 0.f};
        }
        cur = nxt; cB = nB; ++ui;
        if constexpr (ALIGN_EPI) { if (wr == 1) PG8_BAR; }
    }
    PG8_WAIT_V(0);
    if constexpr (!ALIGN_EPI) { if (wr == 0) PG8_BAR; }
    PG8_BAR;
#undef PG8_SA
#undef PG8_SB
#undef PG8_STAGE
#undef PG8_STAGE_A
#undef PG8_LDA
#undef PG8_LDB
#undef PG8_MMA
#undef PG8_WAIT_V
#undef PG8_WAIT_L
#undef PG8_BAR
#undef PG8_SCHED
#undef PG8_AOFFS
#undef PG8_KBODY
#undef PG8_IDDMA
}

__device__ __forceinline__ u32x4 pack8(const f32x4& v0, const f32x4& v1) { u32x4 w; w.x = pk2(v0[0], v0[1]); w.y = pk2(v0[2], v0[3]); w.z = pk2(v1[0], v1[1]); w.w = pk2(v1[2], v1[3]); return w; }
__device__ __forceinline__ void unpack8(const u32x4& w, f32x4& v0, f32x4& v1) { v0 = (f32x4){bflo(w.x), bfhi(w.x), bflo(w.y), bfhi(w.y)}; v1 = (f32x4){bflo(w.z), bfhi(w.z), bflo(w.w), bfhi(w.w)}; }
__device__ __forceinline__ float logsig16(float x) { return (fminf(x, 0.f) - 0.6931471805599453f * __builtin_amdgcn_logf(1.f + fexp(-fabsf(x)))) * (1.f / 16.f); }

__device__ __forceinline__ unsigned rot8(unsigned v) { return (unsigned)__builtin_amdgcn_update_dpp(0, (int)v, 0x128, 0xf, 0xf, false); }
__device__ __forceinline__ void pair_exchange(u32x4& a, u32x4& b, bool lo) {
    const u32x4 ra = (u32x4){rot8(a.x), rot8(a.y), rot8(a.z), rot8(a.w)}, rb = (u32x4){rot8(b.x), rot8(b.y), rot8(b.z), rot8(b.w)};
    const u32x4 na = lo ? a : rb, nb = lo ? ra : b; a = na; b = nb;
}
struct EpiProj {
    static constexpr bool PERM = true, MIDK = false, PREF = true, BINIT = false;
    bf16* P; const float* b_alpha;
    __device__ __forceinline__ void prefetch(LAS unsigned char* slot, const Unit& un, int wr, int wc, int lane) const {
        if (un.pn == 20) __builtin_amdgcn_global_load_lds((const unsigned*)(b_alpha + wc * 64 + lane), (LAS unsigned*)slot, 4, 0, 0);
    }
    __device__ __forceinline__ void operator()(const f32x4 (&acc)[2][2][4][2], const Unit& u, int wr, int wc, int fr, int fq, const LAS unsigned char* slot) const {
        const int pn = u.pn; const int mode = (pn < 2) ? 1 : (pn == 6 ? 2 : (pn == 20 ? 3 : 0));
        const int cw = pn * 256 + wc * 64 + 8 * fq; const bool lo = fr < 8;
        f32x4 bb[2][2];
#pragma unroll
        for (int bj = 0; bj < 2; ++bj) { bb[bj][0] = (f32x4){0.f, 0.f, 0.f, 0.f}; bb[bj][1] = bb[bj][0];
            if (mode == 3) { const LAS f32x4* sb = (const LAS f32x4*)slot + 2 * fq + 8 * bj; bb[bj][0] = sb[0]; bb[bj][1] = sb[1]; } }
#pragma unroll
        for (int ai = 0; ai < 2; ++ai)
#pragma unroll
            for (int m = 0; m < 4; ++m) {
                u32x4 w[2];
#pragma unroll
                for (int bj = 0; bj < 2; ++bj) {
                    f32x4 v0 = acc[ai][bj][m][0], v1 = acc[ai][bj][m][1];
                    if (mode == 1) { v0 = v0 * QSCALE; v1 = v1 * QSCALE; }
                    else if (mode == 2) { v0 = v0 * 0.125f; v1 = v1 * 0.125f; }
                    else if (mode == 3) {
#pragma unroll
                        for (int j = 0; j < 4; ++j) { v0[j] = logsig16(v0[j] + bb[bj][0][j]); v1[j] = logsig16(v1[j] + bb[bj][1][j]); } }
                    w[bj] = pack8(v0, v1);
                }
                pair_exchange(w[0], w[1], lo);
                const int rowA = u.pm * 256 + ai * 128 + wr * 64 + m * 16 + (fr & 7); const int cc = cw + 32 * (fr >> 3);
                __builtin_nontemporal_store(w[0], (u32x4*)(P + (size_t)rowA * NPROJ + cc));
                __builtin_nontemporal_store(w[1], (u32x4*)(P + (size_t)(rowA + 8) * NPROJ + cc));
            }
    }
};
struct EpiBranch {
    static constexpr bool PERM = true, MIDK = true, PREF = false, BINIT = false;
    bf16* MG; const bf16* P;
    __device__ __forceinline__ void mid(f32x4 (&acc)[2][2][4][2], const Unit& u, int wr, int wc, int fr, int fq) const {
        const int cw = u.pn * 256 + wc * 64 + 8 * fq;
#pragma unroll
        for (int ai = 0; ai < 2; ++ai) {
            u32x4 gaw[4][2], gbw[4][2];
#pragma unroll
            for (int m = 0; m < 4; ++m) { const bf16* pr = P + (size_t)(u.pm * 256 + ai * 128 + wr * 64 + m * 16 + fr) * NPROJ + cw;
#pragma unroll
                for (int bj = 0; bj < 2; ++bj) { gaw[m][bj] = __builtin_nontemporal_load((const u32x4*)(pr + C_GA + 32 * bj)); gbw[m][bj] = *(const u32x4*)(pr + C_GB + 32 * bj); } }
            __builtin_amdgcn_sched_barrier(0);
#pragma unroll
            for (int m = 0; m < 4; ++m)
#pragma unroll
                for (int bj = 0; bj < 2; ++bj) {
                    f32x4 a0, a1, b0, b1; unpack8(gaw[m][bj], a0, a1); unpack8(gbw[m][bj], b0, b1);
#pragma unroll
                    for (int j = 0; j < 4; ++j) {
                        acc[ai][bj][m][0][j] *= (1.f + fexp(-__builtin_amdgcn_fmed3f(b0[j], -30.f, 30.f))) * __builtin_amdgcn_rcpf(1.f + fexp(-a0[j]));
                        acc[ai][bj][m][1][j] *= (1.f + fexp(-__builtin_amdgcn_fmed3f(b1[j], -30.f, 30.f))) * __builtin_amdgcn_rcpf(1.f + fexp(-a1[j])); }
                }
            asm volatile("" ::: "memory");
        }
    }
    __device__ __forceinline__ void operator()(const f32x4 (&acc)[2][2][4][2], const Unit& u, int wr, int wc, int fr, int fq) const {
        const int cw = u.pn * 256 + wc * 64 + 8 * fq; const bool lo = fr < 8;
        u32x4 gbw[2][4][2];
#pragma unroll
        for (int ai = 0; ai < 2; ++ai)
#pragma unroll
            for (int m = 0; m < 4; ++m) { const int row = u.pm * 256 + ai * 128 + wr * 64 + m * 16 + fr;
#pragma unroll
                for (int bj = 0; bj < 2; ++bj) gbw[ai][m][bj] = __builtin_nontemporal_load((const u32x4*)(P + (size_t)row * NPROJ + C_GB + cw + 32 * bj)); }
        __builtin_amdgcn_sched_barrier(0);
#pragma unroll
        for (int ai = 0; ai < 2; ++ai)
#pragma unroll
            for (int m = 0; m < 4; ++m) {
                u32x4 w[2];
#pragma unroll
                for (int bj = 0; bj < 2; ++bj) {
                    f32x4 b0, b1; unpack8(gbw[ai][m][bj], b0, b1);
                    f32x4 v0 = acc[ai][bj][m][0], v1 = acc[ai][bj][m][1];
#pragma unroll
                    for (int j = 0; j < 4; ++j) { v0[j] *= __builtin_amdgcn_rcpf(1.f + fexp(-__builtin_amdgcn_fmed3f(b0[j], -30.f, 30.f))); v1[j] *= __builtin_amdgcn_rcpf(1.f + fexp(-__builtin_amdgcn_fmed3f(b1[j], -30.f, 30.f))); }
                    w[bj] = pack8(v0, v1);
                }
                pair_exchange(w[0], w[1], lo);
                const int rowA = u.pm * 256 + ai * 128 + wr * 64 + m * 16 + (fr & 7); const int cc = cw + 32 * (fr >> 3);
                *(GAS u32x4*)(MG + (size_t)rowA * DM + cc) = w[0];
                *(GAS u32x4*)(MG + (size_t)(rowA + 8) * DM + cc) = w[1];
            }
    }
};
struct EpiOut {
    static constexpr bool PERM = true, MIDK = false, PREF = true, BINIT = false;
    bf16* Y1; const float* mod;
    __device__ __forceinline__ void prefetch(LAS unsigned char* slot, const Unit& un, int wr, int wc, int lane) const {
        __builtin_amdgcn_global_load_lds((const unsigned*)(mod + (un.pm >> 3) * 6144 + 2048 + un.pn * 256 + wc * 64 + lane), (LAS unsigned*)slot, 4, 0, 0);
    }
    __device__ __forceinline__ void operator()(const f32x4 (&acc)[2][2][4][2], const Unit& u, int wr, int wc, int fr, int fq, const LAS unsigned char* slot) const {
        const int cw = u.pn * 256 + wc * 64 + 8 * fq; const bool lo = fr < 8;
        const LAS f32x4* sb = (const LAS f32x4*)slot + 2 * fq;
        f32x4 g[2][2];
#pragma unroll
        for (int bj = 0; bj < 2; ++bj) { g[bj][0] = sb[8 * bj]; g[bj][1] = sb[8 * bj + 1]; }
#pragma unroll
        for (int ai = 0; ai < 2; ++ai)
#pragma unroll
            for (int m = 0; m < 4; ++m) {
                u32x4 wa = pack8(acc[ai][0][m][0] * g[0][0], acc[ai][0][m][1] * g[0][1]), wb = pack8(acc[ai][1][m][0] * g[1][0], acc[ai][1][m][1] * g[1][1]);
                pair_exchange(wa, wb, lo);
                const int rowA = u.pm * 256 + ai * 128 + wr * 64 + m * 16 + (fr & 7); const int cc = cw + 32 * (fr >> 3);
                *(u32x4*)(Y1 + (size_t)rowA * DM + cc) = wa;
                *(u32x4*)(Y1 + (size_t)(rowA + 8) * DM + cc) = wb;
            }
    }
};
struct EpiUp {
    static constexpr bool PERM = true, MIDK = false, PREF = true, BINIT = true;
    unsigned char* ACT; const float* b_gu;
    __device__ __forceinline__ void prefetch(LAS unsigned char* slot, const Unit& un, int wr, int wc, int lane) const {
        __builtin_amdgcn_global_load_lds((const unsigned*)(b_gu + (size_t)un.e * 2048 + un.pn * 128 + wc * 32 + (lane & 31) + (lane >> 5) * 1024), (LAS unsigned*)slot, 4, 0, 0);
    }
    __device__ __forceinline__ void init(f32x4 (&acc)[2][2][4][2], const LAS unsigned char* slot, int fq) const {
        const LAS f32x4* sb = (const LAS f32x4*)slot + 2 * fq;
        const f32x4 bg0 = sb[0], bg1 = sb[1], bu0 = sb[8], bu1 = sb[9];
#pragma unroll
        for (int ai = 0; ai < 2; ++ai)
#pragma unroll
            for (int m = 0; m < 4; ++m) { acc[ai][0][m][0] = bg0; acc[ai][0][m][1] = bg1; acc[ai][1][m][0] = bu0; acc[ai][1][m][1] = bu1; }
    }
    __device__ __forceinline__ void operator()(const f32x4 (&acc)[2][2][4][2], const Unit& u, int wr, int wc, int fr, int fq, const LAS unsigned char* slot) const {
        const int f0 = u.pn * 128 + wc * 32 + 8 * fq;
#pragma unroll
        for (int ai = 0; ai < 2; ++ai)
#pragma unroll
            for (int m = 0; m < 4; ++m) {
                const int r = ai * 128 + wr * 64 + m * 16 + fr;
                const f32x4 g0 = acc[ai][0][m][0], g1 = acc[ai][0][m][1], u0 = acc[ai][1][m][0], u1 = acc[ai][1][m][1]; f32x4 a0, a1;
#pragma unroll
                for (int j = 0; j < 4; ++j) {
                    float gg = __builtin_amdgcn_fmed3f(g0[j], -3.0e38f, 7.f), uu = __builtin_amdgcn_fmed3f(u0[j], -7.f, 7.f); a0[j] = __builtin_fmaf(uu, gg, gg) * __builtin_amdgcn_rcpf(0.25f + __builtin_amdgcn_exp2f(__builtin_fmaf(gg, -2.4554669596f, -2.f)));
                    gg = __builtin_amdgcn_fmed3f(g1[j], -3.0e38f, 7.f); uu = __builtin_amdgcn_fmed3f(u1[j], -7.f, 7.f); a1[j] = __builtin_fmaf(uu, gg, gg) * __builtin_amdgcn_rcpf(0.25f + __builtin_amdgcn_exp2f(__builtin_fmaf(gg, -2.4554669596f, -2.f))); }
                *(u32x2*)(ACT + (size_t)(u.pm * 256 + r) * FF + f0) = (u32x2){pk4_fp8(a0[0], a0[1], a0[2], a0[3]), pk4_fp8(a1[0], a1[1], a1[2], a1[3])};
            }
    }
};
constexpr float F8_YSCALE = 16.f;
__device__ __forceinline__ void pair_exchange2(u32x2& a, u32x2& b, bool lo) {
    const u32x2 ra = (u32x2){rot8(a.x), rot8(a.y)}, rb = (u32x2){rot8(b.x), rot8(b.y)};
    const u32x2 na = lo ? a : rb, nb = lo ? ra : b; a = na; b = nb;
}
struct EpiDown {
    static constexpr bool PERM = true, MIDK = false, PREF = true, BINIT = false;
    unsigned char* YB; const float* b_dn; const int* list;
    __device__ __forceinline__ void prefetch(LAS unsigned char* slot, const Unit& un, int wr, int wc, int lane) const {
        __builtin_amdgcn_global_load_lds((const unsigned*)(b_dn + (size_t)un.e * DM + un.pn * 256 + wc * 64 + lane), (LAS unsigned*)slot, 4, 0, 0);
#pragma unroll
        for (int ai = 0; ai < 2; ++ai) __builtin_amdgcn_global_load_lds((const unsigned*)(list + (size_t)un.e * NTOK + un.row0 + ai * 128 + wr * 64 + lane), (LAS unsigned*)(slot + 256 + ai * 256), 4, 0, 0);
    }
    __device__ __forceinline__ void operator()(const f32x4 (&acc)[2][2][4][2], const Unit& u, int wr, int wc, int fr, int fq, const LAS unsigned char* slot) const {
        const int cw = u.pn * 256 + wc * 64 + 8 * fq; const bool lo = fr < 8;
        const LAS f32x4* sb = (const LAS f32x4*)slot + 2 * fq; const LAS int* sid = (const LAS int*)(slot + 256);
        f32x4 bb[2][2];
#pragma unroll
        for (int bj = 0; bj < 2; ++bj) { bb[bj][0] = sb[8 * bj] * F8_YSCALE; bb[bj][1] = sb[8 * bj + 1] * F8_YSCALE; }
#pragma unroll
        for (int ai = 0; ai < 2; ++ai)
#pragma unroll
            for (int m = 0; m < 4; ++m) {
                const int slot_r = u.row0 + ai * 128 + wr * 64 + m * 16 + fr;
                const int aid = slot_r < u.cnt ? sid[ai * 64 + m * 16 + fr] : -1;
                const int aidx = (int)rot8((unsigned)aid);
                u32x2 w[2];
#pragma unroll
                for (int bj = 0; bj < 2; ++bj) { f32x4 v0, v1;
#pragma unroll
                    for (int j = 0; j < 4; ++j) { v0[j] = __builtin_amdgcn_fmed3f(__builtin_fmaf(acc[ai][bj][m][0][j], F8_YSCALE, bb[bj][0][j]), -440.f, 440.f); v1[j] = __builtin_amdgcn_fmed3f(__builtin_fmaf(acc[ai][bj][m][1][j], F8_YSCALE, bb[bj][1][j]), -440.f, 440.f); }
                    w[bj] = (u32x2){pk4_fp8(v0[0], v0[1], v0[2], v0[3]), pk4_fp8(v1[0], v1[1], v1[2], v1[3])}; }
                pair_exchange2(w[0], w[1], lo);
                const int aidA = lo ? aid : aidx, aidB = lo ? aidx : aid;
                const int cc = cw + 32 * (fr >> 3);
                if (aidA >= 0) *(u32x2*)(YB + (size_t)aidA * DM + cc) = w[0];
                if (aidB >= 0) *(u32x2*)(YB + (size_t)aidB * DM + cc) = w[1];
            }
    }
};

__device__ __forceinline__ void split_bf16(const float (&v)[8], bf16x8& hi, bf16x8& lo) {
    const unsigned h0 = pk2(v[0], v[1]), h1 = pk2(v[2], v[3]), h2 = pk2(v[4], v[5]), h3 = pk2(v[6], v[7]);
    const u32x4 h = (u32x4){h0, h1, h2, h3};
    const u32x4 l = (u32x4){pk2(v[0] - bflo(h0), v[1] - bfhi(h0)), pk2(v[2] - bflo(h1), v[3] - bfhi(h1)), pk2(v[4] - bflo(h2), v[5] - bfhi(h2)), pk2(v[6] - bflo(h3), v[7] - bfhi(h3))};
    hi = __builtin_bit_cast(bf16x8, h); lo = __builtin_bit_cast(bf16x8, l);
}
constexpr int T_NITEMS = 16 * 80 + 2 * 8 * 16 + 16 * 16 + 32 * 16 * 32 + 32 * 16 * 16;
constexpr int T_LATE = 4096;
__device__ __forceinline__ void transposes(const Ctx& C, int i0, int i1, int w, int nw);
__device__ __forceinline__ void phase_mod(const Ctx& C) {
    LAS float* sc = (LAS float*)C.lds;
    LAS float* red = sc + 16 * 1024;
    for (int cb = C.bid; cb < 96; cb += C.G) {
        __syncthreads();
        for (int i = C.tid; i < 16 * 1024; i += NTHREADS) { const float v = C.c[i]; sc[i] = v / (1.f + fexp(-v)); }
        __syncthreads();
        const int cl = C.tid & 63, ks = C.tid >> 6, col = cb * 64 + cl;
        float acc[16];
#pragma unroll
        for (int b = 0; b < 16; ++b) acc[b] = 0.f;
#pragma unroll 1
        for (int kc = ks * 128; kc < ks * 128 + 128; kc += 16) {
            float wv[16];
#pragma unroll
            for (int j = 0; j < 16; ++j) wv[j] = __builtin_nontemporal_load(C.w_ada + (size_t)(kc + j) * 6144 + col);
            asm volatile("" : "+v"(wv[0]), "+v"(wv[1]), "+v"(wv[2]), "+v"(wv[3]), "+v"(wv[4]), "+v"(wv[5]), "+v"(wv[6]), "+v"(wv[7]));
            asm volatile("" : "+v"(wv[8]), "+v"(wv[9]), "+v"(wv[10]), "+v"(wv[11]), "+v"(wv[12]), "+v"(wv[13]), "+v"(wv[14]), "+v"(wv[15]));
#pragma unroll 1
            for (int j4 = 0; j4 < 4; ++j4) {
                const float w0 = j4 == 0 ? wv[0] : j4 == 1 ? wv[4] : j4 == 2 ? wv[8] : wv[12], w1 = j4 == 0 ? wv[1] : j4 == 1 ? wv[5] : j4 == 2 ? wv[9] : wv[13];
                const float w2 = j4 == 0 ? wv[2] : j4 == 1 ? wv[6] : j4 == 2 ? wv[10] : wv[14], w3 = j4 == 0 ? wv[3] : j4 == 1 ? wv[7] : j4 == 2 ? wv[11] : wv[15];
#pragma unroll
                for (int b = 0; b < 16; ++b) { const f32x4 s4 = *(const LAS f32x4*)(sc + b * 1024 + kc + 4 * j4); acc[b] += (s4[0] * w0 + s4[1] * w1) + (s4[2] * w2 + s4[3] * w3); } }
        }
#pragma unroll
        for (int b = 0; b < 16; ++b) red[(ks * 16 + b) * 64 + cl] = acc[b];
        __syncthreads();
        for (int o = C.tid; o < 1024; o += NTHREADS) {
            const int b = o >> 6, c2 = o & 63; float s = 0.f;
#pragma unroll
            for (int k2 = 0; k2 < 8; ++k2) s += red[(k2 * 16 + b) * 64 + c2];
            C.mod[b * 6144 + cb * 64 + c2] = s + C.b_ada[cb * 64 + c2];
        }
        asm volatile("s_waitcnt vmcnt(0)" ::: "memory"); __syncthreads();
        if (C.tid == 0) { __builtin_amdgcn_fence(__ATOMIC_RELEASE, "agent"); __hip_atomic_fetch_add(C.ctl + CW_MODRDY, 1u, RLX_AGENT); }
    }
    __syncthreads();
    { const int gw = C.bid * NWAVES + C.wid, NGW = C.G * NWAVES;
      if (C.G == 256) { constexpr int N1 = 9 * 2048; transposes(C, 0, N1, gw, NGW); if (C.bid >= 96) transposes(C, N1, T_NITEMS - T_LATE, gw - 96 * NWAVES, NGW - 96 * NWAVES); }
      else transposes(C, 0, T_NITEMS, gw, NGW); }
    for (int idx = C.bid * NTHREADS + C.tid; idx < 4096; idx += C.G * NTHREADS) {
        const int l2 = idx & 63, nt = (idx >> 6) & 1, ks = (idx >> 7) & 3, w2 = idx >> 9; float wv[8];
#pragma unroll
        for (int j = 0; j < 8; ++j) wv[j] = C.w_router[(size_t)(128 * w2 + 32 * ks + 8 * (l2 >> 4) + j) * NE + 16 * nt + (l2 & 15)];
        bf16x8 h8, l8; split_bf16(wv, h8, l8); C.wrf[idx] = __builtin_bit_cast(u32x4, h8); C.wrf[4096 + idx] = __builtin_bit_cast(u32x4, l8); }
    for (int gt = C.bid * NTHREADS + C.tid; gt < 256 * 512; gt += C.G * NTHREADS) {
        const int j = gt >> 9, k = (gt & 511) * 2;
        float s0 = 0.f, s1 = 0.f;
#pragma unroll
        for (int r = 0; r < 16; ++r) { const float wa = C.w_alpha_up[r * 256 + j]; s0 += C.w_in[(size_t)k * W_IN_N + 3072 + r] * wa; s1 += C.w_in[(size_t)(k + 1) * W_IN_N + 3072 + r] * wa; }
        *(unsigned*)(C.WinT + (size_t)(C_AL + j) * DM + k) = pk2(s0, s1);
    }
}

struct TItem { const float* src; unsigned char* dst; int srcN, pitch, fp8; };
__device__ __forceinline__ TItem titem_decode(const Ctx& C, int it) {
    constexpr int I_IN = 16 * 80, I_BD = 8 * 16, I_OUT = 16 * 16, I_GU = 32 * 16 * 32;
    TItem t; t.fp8 = 0; int r = it;
    if (r < I_IN) { const int kb = r / 80, n0 = (r % 80) * 64; t.srcN = W_IN_N; t.pitch = DM * 2; t.src = C.w_in + (size_t)(kb * 64) * W_IN_N + (n0 < 3072 ? n0 : n0 + 16); t.dst = (unsigned char*)(C.WinT + (size_t)n0 * DM + kb * 64); return t; } r -= I_IN;
    if (r < I_BD) { t.srcN = DM; t.pitch = 2048; t.src = C.w_bd + (size_t)((r >> 4) * 64) * DM + (r & 15) * 64; t.dst = (unsigned char*)(C.WbdT + (size_t)((r & 15) * 64) * 1024 + (r >> 4) * 64); return t; } r -= I_BD;
    if (r < I_BD) { t.srcN = DM; t.pitch = 2048; t.src = C.w_bg + (size_t)((r >> 4) * 64) * DM + (r & 15) * 64; t.dst = (unsigned char*)(C.WbdT + (size_t)((r & 15) * 64) * 1024 + 512 + (r >> 4) * 64); return t; } r -= I_BD;
    if (r < I_OUT) { t.srcN = DM; t.pitch = DM * 2; t.src = C.w_out + (size_t)((r >> 4) * 64) * DM + (r & 15) * 64; t.dst = (unsigned char*)(C.WoutT + (size_t)((r & 15) * 64) * DM + (r >> 4) * 64); return t; } r -= I_OUT;
    if (r < I_GU) { const int e = r >> 9, rr = r & 511, kb = rr >> 6, b32 = rr & 63, pn = b32 >> 3, wc = (b32 >> 1) & 3;
        t.srcN = 2048; t.pitch = 1024; t.fp8 = 1; t.src = C.w_gu + (size_t)e * DM * 2048 + (size_t)(kb * 128) * 2048 + (b32 & 1) * 1024 + pn * 128 + wc * 32; t.dst = (unsigned char*)C.WguT + (size_t)e * 2048 * 1024 + (size_t)(b32 * 32) * 1024 + kb * 128; return t; } r -= I_GU;
    { const int e = r >> 8, rr = r & 255, kb = rr >> 5, b32 = rr & 31;
        t.srcN = DM; t.pitch = 1024; t.fp8 = 1; t.src = C.w_dn + (size_t)e * FF * DM + (size_t)(kb * 128) * DM + b32 * 32; t.dst = (unsigned char*)C.WdT + (size_t)e * DM * 1024 + (size_t)(b32 * 32) * 1024 + kb * 128; return t; }
}
__device__ __forceinline__ void titem_load(const TItem& t, int lane, f32x4 (&v)[16]) {
    const int r0 = t.fp8 ? (lane >> 3) : (lane >> 4), rs = t.fp8 ? 8 : 4, c0 = t.fp8 ? 4 * (lane & 7) : 4 * (lane & 15);
#pragma unroll
    for (int i = 0; i < 16; ++i) v[i] = __builtin_nontemporal_load((const f32x4*)(t.src + (size_t)(rs * i + r0) * t.srcN + c0));
}
__device__ __forceinline__ void titem_store(const TItem& t, int lane, const f32x4 (&v)[16], LAS float* scr) {
    if (t.fp8) {
#pragma unroll
        for (int i = 0; i < 16; ++i) { LAS float* p = scr + (8 * i + (lane >> 3)) * 33 + 4 * (lane & 7); p[0] = v[i][0]; p[1] = v[i][1]; p[2] = v[i][2]; p[3] = v[i][3]; }
        LDS_WAIT(); asm volatile("" ::: "memory");
        const int c = lane & 15;
#pragma unroll
        for (int j = 0; j < 8; ++j) { const int n = (lane >> 4) + 4 * j; const LAS float* s = scr + (8 * c) * 33 + n; float w[8];
#pragma unroll
            for (int q = 0; q < 8; ++q) w[q] = __builtin_amdgcn_fmed3f(s[q * 33] * F8_WSCALE, -440.f, 440.f);
            __builtin_nontemporal_store((u32x2){pk4_fp8(w[0], w[1], w[2], w[3]), pk4_fp8(w[4], w[5], w[6], w[7])}, (u32x2*)(t.dst + (size_t)n * t.pitch + 8 * c)); }
    } else {
#pragma unroll
        for (int i = 0; i < 16; ++i) { LAS float* p = scr + (4 * i + (lane >> 4)) * 65 + 4 * (lane & 15); p[0] = v[i][0]; p[1] = v[i][1]; p[2] = v[i][2]; p[3] = v[i][3]; }
        LDS_WAIT(); asm volatile("" ::: "memory");
        const int c = lane & 7;
#pragma unroll
        for (int j = 0; j < 8; ++j) { const int n = (lane >> 3) + 8 * j; const LAS float* s = scr + (8 * c) * 65 + n;
            u32x4 o; o.x = pk2(s[0 * 65], s[1 * 65]); o.y = pk2(s[2 * 65], s[3 * 65]); o.z = pk2(s[4 * 65], s[5 * 65]); o.w = pk2(s[6 * 65], s[7 * 65]);
            *(u32x4*)(t.dst + (size_t)n * t.pitch + 16 * c) = o; }
    }
    LDS_WAIT(); asm volatile("" ::: "memory");
}
__device__ __forceinline__ void transposes(const Ctx& C, int i0, int i1, int w, int nw) {
    LAS float* scr = (LAS float*)(C.lds + C.wid * 16896);
    int it = i0 + w; if (it >= i1) return;
    TItem cur = titem_decode(C, it); f32x4 v[16]; titem_load(cur, C.lane, v);
    for (;;) {
        const int nit = it + nw; const bool more = nit < i1;
        TItem nxt = cur; f32x4 vn[16];
        if (more) { nxt = titem_decode(C, nit); titem_load(nxt, C.lane, vn); }
        titem_store(cur, C.lane, v, scr);
        if (!more) break;
        cur = nxt; it = nit;
#pragma unroll
        for (int i = 0; i < 16; ++i) v[i] = vn[i];
    }
}
__device__ __forceinline__ void phase_prep(const Ctx& C) {
    const int gw = C.bid * NWAVES + C.wid, NGW = C.G * NWAVES;
    for (int r0 = gw * 16; r0 < NTOK; r0 += NGW * 16) {
        const int b = r0 >> 11; const float* md = C.mod + b * 6144;
        f32x4 gs[4], sh[4];
#pragma unroll
        for (int j = 0; j < 4; ++j) { const int c0 = 4 * C.lane + 256 * j; gs[j] = *(const f32x4*)(C.norm1_g + c0) * (*(const f32x4*)(md + 1024 + c0) + 1.f); sh[j] = *(const f32x4*)(md + c0); }
        f32x4 vA[4][4], vB[4][4];
#define PP_ISSUE(V, rb) do { _Pragma("unroll") for (int r = 0; r < 4; ++r) _Pragma("unroll") for (int j = 0; j < 4; ++j) V[r][j] = __builtin_nontemporal_load((const f32x4*)(C.x + (size_t)((rb) + r) * DM + 4 * C.lane + 256 * j)); } while (0)
#define PP_GROUP(V, rb) do { float ss[4] = {0.f, 0.f, 0.f, 0.f}; \
            _Pragma("unroll") for (int r = 0; r < 4; ++r) _Pragma("unroll") for (int j = 0; j < 4; ++j) ss[r] += (V[r][j][0] * V[r][j][0] + V[r][j][1] * V[r][j][1]) + (V[r][j][2] * V[r][j][2] + V[r][j][3] * V[r][j][3]); \
            _Pragma("unroll") for (int r = 0; r < 4; ++r) { const float rstd = rsqrtf(wave_sum(ss[r]) * (1.f / DM) + EPS); \
                _Pragma("unroll") for (int j = 0; j < 4; ++j) { const f32x4 y = V[r][j] * rstd * gs[j] + sh[j]; u32x2 o; o.x = pk2(y[0], y[1]); o.y = pk2(y[2], y[3]); \
                    *(u32x2*)(C.H + (size_t)((rb) + r) * DM + 4 * C.lane + 256 * j) = o; } } } while (0)
        PP_ISSUE(vA, r0);
        PP_ISSUE(vB, r0 + 4);  PP_GROUP(vA, r0);
        PP_ISSUE(vA, r0 + 8);  PP_GROUP(vB, r0 + 4);
        PP_ISSUE(vB, r0 + 12); PP_GROUP(vA, r0 + 8);
        PP_GROUP(vB, r0 + 12);
#undef PP_ISSUE
#undef PP_GROUP
    }
}

__device__ __forceinline__ void gla_scan(const Ctx& C, int b, int h) {
    LAS float* qs = (LAS float*)C.lds;
    LAS float* ks = qs + 2048;
    LAS float* al = ks + 2048;
    LAS float* vs = al + 2048;
    LAS float* part = vs + 4096;
    const int dv = C.tid & 127, dkg = C.tid >> 7;
    float S[16];
#pragma unroll
    for (int j = 0; j < 16; ++j) S[j] = 0.f;
    const float gdv0 = C.gla_g[2 * C.lane], gdv1 = C.gla_g[2 * C.lane + 1];
    for (int ch = 0; ch < SEQ / 32; ++ch) {
        const int row0 = b * SEQ + ch * 32;
        __syncthreads();
        for (int i = C.tid; i < 32 * 64; i += NTHREADS) { const int t = i >> 6, d = i & 63; const bf16* pr = C.PROJ + (size_t)(row0 + t) * NPROJ;
            qs[i] = bf2f(pr[C_GQ + h * 64 + d]); ks[i] = bf2f(pr[C_GK + h * 64 + d]); al[i] = fexp(bf2f(pr[C_AL + h * 64 + d])); }
        for (int i = C.tid; i < 32 * 128; i += NTHREADS) { const int t = i >> 7, d = i & 127; vs[i] = bf2f(C.PROJ[(size_t)(row0 + t) * NPROJ + C_GV + h * 128 + d]); }
        __syncthreads();
#pragma unroll 2
        for (int t = 0; t < 32; ++t) {
            const float v = vs[t * 128 + dv]; float o = 0.f;
#pragma unroll
            for (int j4 = 0; j4 < 4; ++j4) {
                const f32x4 a4 = *(const LAS f32x4*)(al + t * 64 + dkg * 16 + j4 * 4), k4 = *(const LAS f32x4*)(ks + t * 64 + dkg * 16 + j4 * 4), q4 = *(const LAS f32x4*)(qs + t * 64 + dkg * 16 + j4 * 4);
#pragma unroll
                for (int jj = 0; jj < 4; ++jj) { const int j = j4 * 4 + jj; S[j] = a4[jj] * S[j] + k4[jj] * v; o += q4[jj] * S[j]; }
            }
            part[(dkg * 32 + t) * 128 + dv] = o;
        }
        __syncthreads();
#pragma unroll
        for (int tt = 0; tt < 4; ++tt) {
            const int t = 4 * C.wid + tt; float o0 = 0.f, o1 = 0.f;
#pragma unroll
            for (int g = 0; g < 4; ++g) { o0 += part[(g * 32 + t) * 128 + 2 * C.lane]; o1 += part[(g * 32 + t) * 128 + 2 * C.lane + 1]; }
            const float rstd = rsqrtf(wave_sum(o0 * o0 + o1 * o1) * (1.f / 128.f) + EPS);
            const unsigned grw = *(const unsigned*)(C.PROJ + (size_t)(row0 + t) * NPROJ + C_GR + h * 128 + 2 * C.lane);
            const float g0 = bflo(grw), g1 = bfhi(grw);
            const float y0 = o0 * rstd * gdv0 * (g0 * sigmoidf_(g0)), y1 = o1 * rstd * gdv1 * (g1 * sigmoidf_(g1));
            *(unsigned*)(C.OB + (size_t)(row0 + t) * 512 + h * 128 + 2 * C.lane) = pk2(y0, y1);
        }
    }
}

__device__ __forceinline__ void attn_simple(const Ctx& C) {
    LAS float* Kt = (LAS float*)C.lds;
    LAS float* Vt = Kt + 8192;
    LAS float* Ss = Vt + 8192;
    LAS float* ssq = Ss + 2 * 64 * 68;
    LAS float* lamp = ssq + 256;
    if (C.tid < 64) {
        const float a = wave_sum(C.lq1[C.lane] * C.lk1[C.lane]), b2 = wave_sum(C.lq2[C.lane] * C.lk2[C.lane]);
        if (C.tid == 0) lamp[0] = fexp(a) - fexp(b2) + 0.2f;
    }
    __syncthreads();
    const float lam = lamp[0];
    const int q = C.tid & 63, p = (C.tid >> 6) & 1, dq = C.tid >> 7;
    for (int uix = C.bid; uix < 2048; uix += C.G) {
        const int bh = uix & 63, g = (uix >> 6) & 3, i2 = uix >> 8; const int b = bh >> 2, h = bh & 3;
        const int qc = (i2 & 1) ? (31 - (4 * g + (i2 >> 1))) : (4 * g + (i2 >> 1));
        const float sl2 = exp2f(-2.f * (float)(h + 1)) * LOG2E;
        const int qrow = b * SEQ + qc * 64 + q;
        float qv[64];
#pragma unroll
        for (int d8 = 0; d8 < 8; ++d8) { const u32x4 w = *(const u32x4*)(C.PROJ + (size_t)qrow * NPROJ + C_DQ + h * 128 + p * 64 + d8 * 8);
            qv[d8 * 8 + 0] = bflo(w.x); qv[d8 * 8 + 1] = bfhi(w.x); qv[d8 * 8 + 2] = bflo(w.y); qv[d8 * 8 + 3] = bfhi(w.y);
            qv[d8 * 8 + 4] = bflo(w.z); qv[d8 * 8 + 5] = bfhi(w.z); qv[d8 * 8 + 6] = bflo(w.w); qv[d8 * 8 + 7] = bfhi(w.w); }
        float m = -1e30f, l = 0.f, acc[32];
#pragma unroll
        for (int d = 0; d < 32; ++d) acc[d] = 0.f;
        for (int kc = 0; kc <= qc; ++kc) {
            __syncthreads();
            for (int pi = C.tid; pi < 1024; pi += NTHREADS) { const int r = pi >> 4, cc = pi & 15; const bf16* pr = C.PROJ + (size_t)(b * SEQ + kc * 64 + r) * NPROJ + h * 128 + cc * 8;
                const u32x4 kw = *(const u32x4*)(pr + C_DK), vw = *(const u32x4*)(pr + C_DV); f32x4 a0, a1;
                unpack8(kw, a0, a1); *(LAS f32x4*)(Kt + r * 128 + cc * 8) = a0; *(LAS f32x4*)(Kt + r * 128 + cc * 8 + 4) = a1;
                unpack8(vw, a0, a1); *(LAS f32x4*)(Vt + r * 128 + cc * 8) = a0; *(LAS f32x4*)(Vt + r * 128 + cc * 8 + 4) = a1; }
            __syncthreads();
#pragma unroll 1
            for (int kk = 0; kk < 16; ++kk) {
                const int key = dq * 16 + kk; float s = 0.f;
#pragma unroll
                for (int d4 = 0; d4 < 16; ++d4) { const f32x4 kv = *(const LAS f32x4*)(Kt + key * 128 + p * 64 + d4 * 4);
                    s += qv[d4 * 4] * kv[0]; s += qv[d4 * 4 + 1] * kv[1]; s += qv[d4 * 4 + 2] * kv[2]; s += qv[d4 * 4 + 3] * kv[3]; }
                const int kpos = kc * 64 + key, qpos = qc * 64 + q; const int mn = kpos < 2 * qpos - kpos ? kpos : 2 * qpos - kpos;
                Ss[(p * 64 + q) * 68 + key] = s + sl2 * (float)mn;
            }
            __syncthreads();
            const LAS float* srow = Ss + (p * 64 + q) * 68;
            float cm = -1e30f;
#pragma unroll
            for (int k4 = 0; k4 < 16; ++k4) { const f32x4 sv = *(const LAS f32x4*)(srow + k4 * 4); cm = fmaxf(cm, fmaxf(fmaxf(sv[0], sv[1]), fmaxf(sv[2], sv[3]))); }
            const float mnew = fmaxf(m, cm), alpha = exp2f(m - mnew); m = mnew; l *= alpha;
#pragma unroll
            for (int d = 0; d < 32; ++d) acc[d] *= alpha;
#pragma unroll 2
            for (int key = 0; key < 64; ++key) {
                const float pk = exp2f(srow[key] - m); l += pk;
#pragma unroll
                for (int d4 = 0; d4 < 8; ++d4) { const f32x4 vv = *(const LAS f32x4*)(Vt + key * 128 + dq * 32 + d4 * 4);
                    acc[d4 * 4] += pk * vv[0]; acc[d4 * 4 + 1] += pk * vv[1]; acc[d4 * 4 + 2] += pk * vv[2]; acc[d4 * 4 + 3] += pk * vv[3]; }
            }
        }
        const float inv = 1.f / l;
        __syncthreads();
        LAS float* O2 = Ss;
        if (p == 1) {
#pragma unroll
            for (int d = 0; d < 32; ++d) O2[q * 128 + dq * 32 + d] = lam * acc[d] * inv;
        }
        __syncthreads();
        float ss = 0.f;
        if (p == 0) {
#pragma unroll
            for (int d = 0; d < 32; ++d) { acc[d] = acc[d] * inv - O2[q * 128 + dq * 32 + d]; ss += acc[d] * acc[d]; }
            ssq[q * 4 + dq] = ss;
        }
        __syncthreads();
        if (p == 0) {
            const float tot = (ssq[q * 4] + ssq[q * 4 + 1]) + (ssq[q * 4 + 2] + ssq[q * 4 + 3]);
            const float rstd = rsqrtf(tot * (1.f / 128.f) + EPS) * 0.8f;
            bf16* dst = C.OA + (size_t)qrow * 512 + h * 128 + dq * 32;
#pragma unroll
            for (int d8 = 0; d8 < 4; ++d8) { u32x4 w; const float* gg = C.diff_g + dq * 32 + d8 * 8;
                w.x = pk2(acc[d8 * 8] * rstd * gg[0], acc[d8 * 8 + 1] * rstd * gg[1]); w.y = pk2(acc[d8 * 8 + 2] * rstd * gg[2], acc[d8 * 8 + 3] * rstd * gg[3]);
                w.z = pk2(acc[d8 * 8 + 4] * rstd * gg[4], acc[d8 * 8 + 5] * rstd * gg[5]); w.w = pk2(acc[d8 * 8 + 6] * rstd * gg[6], acc[d8 * 8 + 7] * rstd * gg[7]);
                *(u32x4*)(dst + d8 * 8) = w; }
        }
    }
}


typedef float f32x16 __attribute__((ext_vector_type(16)));
typedef short s16x4 __attribute__((ext_vector_type(4)));
typedef short v4i16_t __attribute__((ext_vector_type(4)));
__device__ __forceinline__ s16x4 vtr(const LAS unsigned char* p) { return __builtin_bit_cast(s16x4, __builtin_amdgcn_ds_read_tr16_b64_v4i16((LAS v4i16_t*)p)); }
template <int OFF> __device__ __forceinline__ void glds16(const void* sbase, unsigned voff, unsigned lds_dst) {
    unsigned sv; asm volatile("s_mov_b32 %0, m0\n\ts_mov_b32 m0, %3\n\ts_nop 0\n\tglobal_load_lds_dwordx4 %1, %2 offset:%4\n\ts_mov_b32 m0, %0" : "=&s"(sv) : "v"(voff), "s"(sbase), "s"(lds_dst), "i"(OFF) : "memory"); }
__device__ __forceinline__ unsigned lds_addr(const LAS unsigned char* p) { return (unsigned)__builtin_amdgcn_readfirstlane((int)(unsigned)(size_t)p); }
#define MFMA16(a, b, c) __builtin_amdgcn_mfma_f32_16x16x32_bf16(a, b, c, 0, 0, 0)
__device__ __forceinline__ bf16x8 cat44(s16x4 lo, s16x4 hi) { return (bf16x8){lo[0], lo[1], lo[2], lo[3], hi[0], hi[1], hi[2], hi[3]}; }
__device__ __forceinline__ void gla_chunked(const Ctx& C, int b, int h) {
    const int lane = C.lane, wid = C.wid, fr = lane & 15, fq = lane >> 4;
    LAS unsigned char* lds = C.lds;
    constexpr int RAW_Q = 0, RAW_K = 8192, RAW_LA = 16384, VB0 = 24576, QS = 57344, KS = 66560, KD = 75776, AM = 84992, ST = 94208, OO = 112640, GTL = 146432, SSQ = 146688;
    constexpr int P = 144, PO = 528;
    const char* pbase = (const char*)(C.PROJ + (size_t)(b * SEQ) * NPROJ);
    const unsigned oq = (unsigned)(((8 * wid + (lane >> 3)) * NPROJ + C_GQ + h * 64 + (lane & 7) * 8) * 2);
    const unsigned okk = oq + (unsigned)((C_GK - C_GQ) * 2), ol = oq + (unsigned)((C_AL - C_GQ) * 2);
    const unsigned ov0 = (unsigned)(((4 * wid + (lane >> 4)) * NPROJ + C_GV + h * 128 + (lane & 15) * 8) * 2), ov1 = ov0 + (unsigned)(32 * NPROJ * 2);
#define GL_DMA(n) do { const char* _cb = pbase + (size_t)(n) * 64 * NPROJ * 2; const unsigned _vb = VB0 + ((n) & 1) * 16384; \
        glds16<0>(_cb, oq, lds_addr(lds + RAW_Q + wid * 1024)); glds16<0>(_cb, okk, lds_addr(lds + RAW_K + wid * 1024)); glds16<0>(_cb, ol, lds_addr(lds + RAW_LA + wid * 1024)); \
        glds16<0>(_cb, ov0, lds_addr(lds + _vb + wid * 1024)); glds16<0>(_cb, ov1, lds_addr(lds + _vb + (wid + 8) * 1024)); } while (0)
    __syncthreads();
    GL_DMA(0);
    for (int i = lane; i < 16 * P / 4; i += 64) ((LAS unsigned*)(lds + ST + wid * 16 * P))[i] = 0u;
    f32x4 accS[4];
#pragma unroll
    for (int t = 0; t < 4; ++t) accS[t] = (f32x4){0.f, 0.f, 0.f, 0.f};
    const int t1 = wid >> 1, ca = 2 * (wid & 1);
    bf16x8 ym[2][2];
#pragma unroll
    for (int ci = 0; ci < 2; ++ci)
#pragma unroll
        for (int ks = 0; ks < 2; ++ks)
#pragma unroll
            for (int jj = 0; jj < 8; ++jj) ym[ci][ks][jj] = (short)(((32 * ks + 8 * fq + jj) <= (16 * (ca + ci) + fr)) ? 0x3F80 : 0);
    const bf16x8 ones = (bf16x8){0x3F80, 0x3F80, 0x3F80, 0x3F80, 0x3F80, 0x3F80, 0x3F80, 0x3F80};
    const int qp = (lane & 15) >> 2, pp = lane & 3;
    const float g0 = C.gla_g[2 * lane], g1 = C.gla_g[2 * lane + 1];
    unsigned grw[8];
#pragma unroll
    for (int cc = 0; cc < 8; ++cc) grw[cc] = 0u;
#define GL_ROWPASS(n) do { _Pragma("unroll") for (int hh = 0; hh < 2; ++hh) { float o0_[4], o1_[4]; f32x4 qa_[4], qb_[4];     \
        _Pragma("unroll") for (int c4 = 0; c4 < 4; ++c4) { const int c_ = 8 * wid + 4 * hh + c4; \
            o0_[c4] = *(const LAS float*)(lds + OO + c_ * PO + lane * 8); o1_[c4] = *(const LAS float*)(lds + OO + c_ * PO + lane * 8 + 4); \
            qa_[c4] = *(const LAS f32x4*)(lds + SSQ + c_ * 32); qb_[c4] = *(const LAS f32x4*)(lds + SSQ + c_ * 32 + 16); } \
        __builtin_amdgcn_sched_barrier(0); \
        _Pragma("unroll") for (int c4 = 0; c4 < 4; ++c4) { const int cc = 4 * hh + c4, c_ = 8 * wid + cc; const f32x4 qa = qa_[c4], qb = qb_[c4]; \
            const float rstd = rsqrtf((((qa[0] + qa[1]) + (qa[2] + qa[3])) + ((qb[0] + qb[1]) + (qb[2] + qb[3]))) * (1.f / 128.f) + EPS); const float gr0 = bflo(grw[cc]), gr1 = bfhi(grw[cc]); \
            *(GAS unsigned*)(C.OA + (size_t)(b * SEQ + (n) * 64 + c_) * 1024 + 512 + h * 128 + 2 * lane) = pk2(o0_[c4] * rstd * g0 * (gr0 * sigmoidf_(gr0)), o1_[c4] * rstd * g1 * (gr1 * sigmoidf_(gr1))); } } } while (0)
#pragma unroll 1
    for (int n = 0; n < SEQ / 64; ++n) {
        asm volatile("s_waitcnt vmcnt(0) lgkmcnt(0)" ::: "memory"); __syncthreads();
        if (n > 0) GL_ROWPASS(n - 1);
#pragma unroll
        for (int cc = 0; cc < 8; ++cc) grw[cc] = *(const unsigned*)(pbase + ((size_t)(n * 64 + 8 * wid + cc) * NPROJ + C_GR + h * 128 + 2 * lane) * 2);
        {
            bf16x8 xla[2];
#pragma unroll
            for (int ks = 0; ks < 2; ++ks) { const LAS unsigned char* a = lds + RAW_LA + (32 * ks + 8 * fq + qp) * 128 + (16 * t1 + 4 * pp) * 2; xla[ks] = cat44(vtr(a), vtr(a + 4 * 128)); }
            u32x2 qwv[2], kwv[2];
#pragma unroll
            for (int ci = 0; ci < 2; ++ci) { const int c_ = 16 * (ca + ci) + fr, dk0 = 16 * t1 + 4 * fq; qwv[ci] = *(const LAS u32x2*)(lds + RAW_Q + c_ * 128 + dk0 * 2); kwv[ci] = *(const LAS u32x2*)(lds + RAW_K + c_ * 128 + dk0 * 2); }
            f32x4 Ga = (f32x4){0.f, 0.f, 0.f, 0.f}, Gb = Ga, GT = Ga;
#pragma unroll
            for (int ks = 0; ks < 2; ++ks) { Ga = MFMA16(xla[ks], ym[0][ks], Ga); Gb = MFMA16(xla[ks], ym[1][ks], Gb); GT = MFMA16(xla[ks], ones, GT); }
#pragma unroll
            for (int ci = 0; ci < 2; ++ci) {
                const int c_ = 16 * (ca + ci) + fr, dk0 = 16 * t1 + 4 * fq; const f32x4 G = ci ? Gb : Ga;
                const u32x2 qw = qwv[ci], kw = kwv[ci];
                const float q4[4] = {bflo(qw.x), bfhi(qw.x), bflo(qw.y), bfhi(qw.y)}, k4[4] = {bflo(kw.x), bfhi(kw.x), bflo(kw.y), bfhi(kw.y)};
                float qs4[4], ks4[4], kd4[4];
#pragma unroll
                for (int r = 0; r < 4; ++r) { qs4[r] = q4[r] * fexp(G[r]); ks4[r] = k4[r] * fexp(-G[r]); kd4[r] = k4[r] * fexp(GT[r] - G[r]); }
                *(LAS u32x2*)(lds + QS + c_ * P + dk0 * 2) = (u32x2){pk2(qs4[0], qs4[1]), pk2(qs4[2], qs4[3])};
                *(LAS u32x2*)(lds + KS + c_ * P + dk0 * 2) = (u32x2){pk2(ks4[0], ks4[1]), pk2(ks4[2], ks4[3])};
                *(LAS u32x2*)(lds + KD + c_ * P + dk0 * 2) = (u32x2){pk2(kd4[0], kd4[1]), pk2(kd4[2], kd4[3])};
            }
            if (fr == 0 && (wid & 1) == 0) *(LAS f32x4*)(lds + GTL + (16 * t1 + 4 * fq) * 4) = GT;
        }
        LDS_WAIT(); __syncthreads();
        if (n + 1 < SEQ / 64) GL_DMA(n + 1);
        {
            const int ct = wid >> 1;
#pragma unroll
            for (int si = 0; si < 2; ++si) {
                const int st = 2 * (wid & 1) + si; f32x4 D = (f32x4){0.f, 0.f, 0.f, 0.f};
                if (st <= ct) {
#pragma unroll
                    for (int ks = 0; ks < 2; ++ks) { const bf16x8 X = *(const LAS bf16x8*)(lds + KS + (16 * st + fr) * P + (32 * ks + 8 * fq) * 2), Y = *(const LAS bf16x8*)(lds + QS + (16 * ct + fr) * P + (32 * ks + 8 * fq) * 2); D = MFMA16(X, Y, D); }
#pragma unroll
                    for (int r = 0; r < 4; ++r) if (16 * st + 4 * fq + r > 16 * ct + fr) D[r] = 0.f;
                }
                *(LAS u32x2*)(lds + AM + (16 * ct + fr) * P + (16 * st + 4 * fq) * 2) = (u32x2){pk2(D[0], D[1]), pk2(D[2], D[3])};
            }
        }
        LDS_WAIT(); __builtin_amdgcn_s_barrier(); asm volatile("" ::: "memory");
        {
            const unsigned vb = VB0 + (n & 1) * 16384;
            bf16x8 X1[2], X2[2];
#pragma unroll
            for (int ks = 0; ks < 2; ++ks) { X1[ks] = *(const LAS bf16x8*)(lds + ST + (16 * wid + fr) * P + (32 * ks + 8 * fq) * 2);
                const LAS unsigned char* a = lds + vb + (32 * ks + 8 * fq + qp) * 256 + (16 * wid + 4 * pp) * 2; X2[ks] = cat44(vtr(a), vtr(a + 4 * 256)); }
            bf16x8 Y1[4][2], Y2[4][2], KDf[4][2]; f32x4 dlv[4];
#pragma unroll
            for (int ct = 0; ct < 4; ++ct)
#pragma unroll
                for (int ks = 0; ks < 2; ++ks) { Y1[ct][ks] = *(const LAS bf16x8*)(lds + QS + (16 * ct + fr) * P + (32 * ks + 8 * fq) * 2); Y2[ct][ks] = *(const LAS bf16x8*)(lds + AM + (16 * ct + fr) * P + (32 * ks + 8 * fq) * 2); }
#pragma unroll
            for (int tt = 0; tt < 4; ++tt) { dlv[tt] = *(const LAS f32x4*)(lds + GTL + (16 * tt + 4 * fq) * 4);
#pragma unroll
                for (int ks = 0; ks < 2; ++ks) { const LAS unsigned char* a = lds + KD + (32 * ks + 8 * fq + qp) * P + (16 * tt + 4 * pp) * 2; KDf[tt][ks] = cat44(vtr(a), vtr(a + 4 * P)); } }
            __builtin_amdgcn_sched_barrier(0);
            f32x4 o[4];
#pragma unroll
            for (int ct = 0; ct < 4; ++ct) o[ct] = (f32x4){0.f, 0.f, 0.f, 0.f};
#pragma unroll
            for (int ks = 0; ks < 2; ++ks) {
#pragma unroll
                for (int ct = 0; ct < 4; ++ct) o[ct] = MFMA16(X1[ks], Y1[ct][ks], o[ct]);
#pragma unroll
                for (int ct = 0; ct < 4; ++ct) o[ct] = MFMA16(X2[ks], Y2[ct][ks], o[ct]); }
#pragma unroll
            for (int tt = 0; tt < 4; ++tt)
#pragma unroll
                for (int r = 0; r < 4; ++r) accS[tt][r] *= fexp(dlv[tt][r]);
#pragma unroll
            for (int ks = 0; ks < 2; ++ks)
#pragma unroll
                for (int tt = 0; tt < 4; ++tt) accS[tt] = MFMA16(KDf[tt][ks], X2[ks], accS[tt]);
#pragma unroll
            for (int ct = 0; ct < 4; ++ct) {
                *(LAS f32x4*)(lds + OO + (16 * ct + fr) * PO + (16 * wid + 4 * fq) * 4) = o[ct];
                float ss = (o[ct][0] * o[ct][0] + o[ct][1] * o[ct][1]) + (o[ct][2] * o[ct][2] + o[ct][3] * o[ct][3]); ss = sum_rows(ss);
                if (fq == 0) *(LAS float*)(lds + SSQ + (16 * ct + fr) * 32 + wid * 4) = ss; }
#pragma unroll
            for (int tt = 0; tt < 4; ++tt) *(LAS u32x2*)(lds + ST + (16 * wid + fr) * P + (16 * tt + 4 * fq) * 2) = (u32x2){pk2(accS[tt][0], accS[tt][1]), pk2(accS[tt][2], accS[tt][3])};
        }
    }
    asm volatile("s_waitcnt vmcnt(0) lgkmcnt(0)" ::: "memory"); __syncthreads();
    GL_ROWPASS(SEQ / 64 - 1);
    __syncthreads();
#undef GL_DMA
#undef GL_ROWPASS
}

__device__ __forceinline__ int crow(int r, int hi) { return (r & 3) + 8 * (r >> 2) + 4 * hi; }
#define MFMA32(a, b, c) __builtin_amdgcn_mfma_f32_32x32x16_bf16(a, b, c, 0, 0, 0)
constexpr int AT_BUF = 32768, AT_WSF = 3 * 32768, AT_Q = 3 * 32768 + 2048;
constexpr float AT_THR = 8.f;

__device__ __forceinline__ void attn_unit(const Ctx& C, int b, int h, int cp, float lam) {
    const int lane = C.lane, r32 = lane & 31, hi = lane >> 5, wid = C.wid, p = wid >> 2, sub = wid & 3;
    const int NT = 2 * cp + 2, qch = 2 * cp + (sub >> 1), my_nt = qch + 1;
    const int row0 = b * SEQ + cp * 128;
    const int qpos = cp * 128 + sub * 32 + r32;
    const float sl2 = exp2f(-2.f * (float)(h + 1)) * LOG2E;
    LAS unsigned char* lds = C.lds;
    LAS float* wsf = (LAS float*)(lds + AT_WSF) + wid * 64;
    const char* kbase = (const char*)(C.PROJ + (size_t)(b * SEQ) * NPROJ + h * 128);
    const unsigned koff = (unsigned)((lane * NPROJ + C_DK + wid * 8) * 2);
    const unsigned voff = (unsigned)(((16 * (wid & 3) + (lane >> 2)) * NPROJ + C_DV + (wid >> 2) * 32 + (lane & 3) * 8) * 2);
#define AT_DMA(t, bufo) do { const char* _tb = kbase + (size_t)(t) * 64 * NPROJ * 2; \
        glds16<0>(_tb, koff, lds_addr(lds + (bufo) + wid * 1024)); glds16<0>(_tb, koff + 128u, lds_addr(lds + (bufo) + 8192 + wid * 1024)); \
        glds16<0>(_tb, voff, lds_addr(lds + (bufo) + 16384 + (wid >> 2) * 4096 + (wid & 3) * 1024)); glds16<0>(_tb, voff + 128u, lds_addr(lds + (bufo) + 16384 + ((wid >> 2) + 2) * 4096 + (wid & 3) * 1024)); } while (0)
    bf16x8 qr[4];
    { const bf16* qp = C.PROJ + (size_t)(row0 + sub * 32 + r32) * NPROJ + C_DQ + h * 128 + p * 64 + hi * 8;
#pragma unroll
      for (int d0 = 0; d0 < 4; ++d0) qr[d0] = *(const bf16x8*)(qp + d0 * 16); }
    AT_DMA(0, 0); AT_DMA(1, AT_BUF);
    f32x16 o[4];
#pragma unroll
    for (int d0 = 0; d0 < 4; ++d0)
#pragma unroll
        for (int i = 0; i < 16; ++i) o[d0][i] = 0.f;
    float mhat = 0.f, lsum = 0.f;
    const unsigned kofs = (unsigned)(p * 8192 + hi * 1024 + r32 * 16);
    const unsigned vofs = (unsigned)(16384 + ((lane >> 4) & 1) * 32 + (lane & 3) * 8 + (4 * hi + ((lane & 15) >> 2)) * 64);
    asm volatile("s_waitcnt vmcnt(4)" ::: "memory"); __syncthreads();
    asm volatile("" : "+v"(qr[0]), "+v"(qr[1]), "+v"(qr[2]), "+v"(qr[3]));
    unsigned bufo = 0, bufn1 = AT_BUF, bufn2 = 2 * AT_BUF;
#pragma unroll 1
    for (int t = 0; t < NT; ++t) {
        PSTAMP(lds, 0);
        if (t + 2 < NT) AT_DMA(t + 2, bufn2);
        PSTAMP(lds, 1);
        if (t < my_nt) {
            const LAS unsigned char* kp = lds + bufo + kofs;
            const LAS unsigned char* vp = lds + bufo + vofs;
            bf16x8 kf[8];
#pragma unroll
            for (int d0 = 0; d0 < 4; ++d0) { kf[2 * d0] = *(const LAS bf16x8*)(kp + d0 * 2048); kf[2 * d0 + 1] = *(const LAS bf16x8*)(kp + d0 * 2048 + 512); }
            s16x4 va[8], vb[8];
#define AT_VRD(dst, k) do { _Pragma("unroll") for (int d0 = 0; d0 < 4; ++d0) { dst[2 * d0] = vtr(vp + d0 * 4096 + (k) * 1024); dst[2 * d0 + 1] = vtr(vp + d0 * 4096 + (k) * 1024 + 512); } } while (0)
#define AT_PV(src_, k) do { const bf16x8 pa_ = __builtin_bit_cast(bf16x8, pw[k]); __builtin_amdgcn_s_setprio(1); _Pragma("unroll") for (int d0 = 0; d0 < 4; ++d0) o[d0] = MFMA32(pa_, cat44(src_[2 * d0], src_[2 * d0 + 1]), o[d0]); __builtin_amdgcn_s_setprio(0); } while (0)
            AT_VRD(va, 0);
            __builtin_amdgcn_sched_barrier(0);
            f32x16 s0, s1;
            if (t == qch) {
#pragma unroll
                for (int i = 0; i < 16; ++i) { const int k0p = 64 * t + crow(i, hi), k1p = k0p + 32;
                    s0[i] = fmaf(sl2, (float)min(k0p, 2 * qpos - k0p), -mhat); s1[i] = fmaf(sl2, (float)min(k1p, 2 * qpos - k1p), -mhat); }
            } else {
                const float bsm = sl2 * (float)(64 * t + 4 * hi) - mhat;
#pragma unroll
                for (int i = 0; i < 16; ++i) { const float ci = (float)((i & 3) + 8 * (i >> 2)); s0[i] = fmaf(sl2, ci, bsm); s1[i] = fmaf(sl2, ci + 32.f, bsm); }
            }
            __builtin_amdgcn_s_setprio(1);
#pragma unroll
            for (int d0 = 0; d0 < 4; ++d0) { s0 = MFMA32(kf[2 * d0], qr[d0], s0); s1 = MFMA32(kf[2 * d0 + 1], qr[d0], s1); }
            __builtin_amdgcn_s_setprio(0);
            __builtin_amdgcn_sched_barrier(0);
            float rm = fmaxf(s0[0], s1[0]);
#pragma unroll
            for (int i = 1; i < 16; ++i) rm = fmaxf(rm, fmaxf(s0[i], s1[i]));
            { auto rr = __builtin_amdgcn_permlane32_swap(__float_as_uint(rm), __float_as_uint(rm), false, false); rm = fmaxf(__uint_as_float(rr[0]), __uint_as_float(rr[1])); }
            if (t == 0 || __any(rm > AT_THR)) {
                const float dl = (t == 0) ? rm : fmaxf(rm, 0.f); mhat += dl;
                if (t != 0) {
                    const float f = __builtin_amdgcn_exp2f(-dl); lsum *= f;
                    if (hi == 0) wsf[r32] = f;
                    LDS_WAIT();
                    float fv[16];
#pragma unroll
                    for (int i = 0; i < 16; ++i) fv[i] = wsf[crow(i, hi)];
                    __builtin_amdgcn_sched_barrier(0);
#pragma unroll
                    for (int i = 0; i < 16; ++i)
#pragma unroll
                        for (int d0 = 0; d0 < 4; ++d0) o[d0][i] *= fv[i];
                }
#pragma unroll
                for (int i = 0; i < 16; ++i) { s0[i] -= dl; s1[i] -= dl; }
            }
            float ps = 0.f;
#pragma unroll
            for (int i = 0; i < 16; ++i) { s0[i] = __builtin_amdgcn_exp2f(s0[i]); s1[i] = __builtin_amdgcn_exp2f(s1[i]); ps += s0[i] + s1[i]; }
            lsum += ps;
            PSTAMP(lds, 2);
            u32x4 pw[4];
            pw[0] = (u32x4){pk2(s0[0], s0[1]), pk2(s0[2], s0[3]), pk2(s0[4], s0[5]), pk2(s0[6], s0[7])};
            pw[1] = (u32x4){pk2(s0[8], s0[9]), pk2(s0[10], s0[11]), pk2(s0[12], s0[13]), pk2(s0[14], s0[15])};
            pw[2] = (u32x4){pk2(s1[0], s1[1]), pk2(s1[2], s1[3]), pk2(s1[4], s1[5]), pk2(s1[6], s1[7])};
            pw[3] = (u32x4){pk2(s1[8], s1[9]), pk2(s1[10], s1[11]), pk2(s1[12], s1[13]), pk2(s1[14], s1[15])};
            __builtin_amdgcn_sched_barrier(0);
            AT_VRD(vb, 1); AT_PV(va, 0); __builtin_amdgcn_sched_barrier(0);
            AT_VRD(va, 2); AT_PV(vb, 1); __builtin_amdgcn_sched_barrier(0);
            AT_VRD(vb, 3); AT_PV(va, 2); __builtin_amdgcn_sched_barrier(0);
            AT_PV(vb, 3);
#undef AT_VRD
#undef AT_PV
        }
        PSTAMP(lds, 3);
        if (t + 2 < NT) asm volatile("s_waitcnt vmcnt(4) lgkmcnt(0)" ::: "memory"); else asm volatile("s_waitcnt vmcnt(0) lgkmcnt(0)" ::: "memory");
        PSTAMP(lds, 4);
        __builtin_amdgcn_s_barrier(); asm volatile("" ::: "memory");
        PSTAMP(lds, 5);
        { const unsigned tb = bufo; bufo = bufn1; bufn1 = bufn2; bufn2 = tb; }
    }
#undef AT_DMA
    lsum = sum_x32(lsum);
    if (hi == 0) wsf[32 + r32] = lsum;
    LDS_WAIT();
    LAS float* X = (LAS float*)lds;
    float lv[16];
#pragma unroll
    for (int i = 0; i < 16; ++i) lv[i] = wsf[32 + crow(i, hi)];
    __builtin_amdgcn_sched_barrier(0);
    if (p == 1) {
#pragma unroll
        for (int i = 0; i < 16; ++i) { const float sc = lam * __builtin_amdgcn_rcpf(lv[i]);
#pragma unroll
            for (int d0 = 0; d0 < 4; ++d0) X[(sub * 32 + crow(i, hi)) * 128 + d0 * 32 + r32] = o[d0][i] * sc; }
    }
    __syncthreads();
    if (p == 0) {
#pragma unroll
        for (int ih = 0; ih < 16; ih += 8) { float xv[8][4];
#pragma unroll
            for (int i = 0; i < 8; ++i)
#pragma unroll
                for (int d0 = 0; d0 < 4; ++d0) xv[i][d0] = X[(sub * 32 + crow(ih + i, hi)) * 128 + d0 * 32 + r32];
            __builtin_amdgcn_sched_barrier(0);
#pragma unroll
            for (int i = 0; i < 8; ++i) { const float sc = __builtin_amdgcn_rcpf(lv[ih + i]);
#pragma unroll
                for (int d0 = 0; d0 < 4; ++d0) X[(sub * 32 + crow(ih + i, hi)) * 128 + d0 * 32 + r32] = o[d0][ih + i] * sc - xv[i][d0]; } }
    }
    __syncthreads();
    { const float g0 = C.diff_g[2 * lane], g1 = C.diff_g[2 * lane + 1];
#pragma unroll
      for (int q8 = 0; q8 < 16; q8 += 8) {
          float y0[8], y1[8];
#pragma unroll
          for (int jj = 0; jj < 8; ++jj) { const int q = wid * 16 + q8 + jj; y0[jj] = X[q * 128 + 2 * lane]; y1[jj] = X[q * 128 + 2 * lane + 1]; }
          __builtin_amdgcn_sched_barrier(0);
#pragma unroll
          for (int jj = 0; jj < 8; ++jj) { const int q = wid * 16 + q8 + jj;
              const float rstd = rsqrtf(wave_sum(y0[jj] * y0[jj] + y1[jj] * y1[jj]) * (1.f / 128.f) + EPS) * 0.8f;
              *(GAS unsigned*)(C.OA + (size_t)(row0 + q) * 1024 + h * 128 + 2 * lane) = pk2(y0[jj] * rstd * g0, y1[jj] * rstd * g1); } } }
    __syncthreads();
}

__device__ __forceinline__ void attn_phase(const Ctx& C) {
    LAS float* lamp = (LAS float*)(C.lds + AT_Q) + 4;
    LAS int* qw = (LAS int*)(C.lds + AT_Q);
    if (C.tid < 64) {
        const float a = wave_sum(C.lq1[C.lane] * C.lk1[C.lane]), b2 = wave_sum(C.lq2[C.lane] * C.lk2[C.lane]);
        if (C.tid == 0) lamp[0] = fexp(a) - fexp(b2) + 0.2f;
    }
    __syncthreads();
    const float lam = lamp[0];
    for (;;) {
        if (C.tid == 0) qw[0] = (int)__hip_atomic_fetch_add(C.ctl + CW_QUEUE, 1u, RLX_AGENT);
        __syncthreads();
        const int item = __builtin_amdgcn_readfirstlane(qw[0]);
        __syncthreads();
        if (item >= 1024) break;
        const int bh = item & 63, cp = 15 - (item >> 6);
        attn_unit(C, bh >> 2, bh & 3, cp, lam);
    }
}

__device__ __forceinline__ void phase_router(const Ctx& C) {
    const int lane = C.lane, wid = C.wid, fr = lane & 15, fq = lane >> 4;
    LAS u32x4* WH = (LAS u32x4*)C.lds;
    LAS u32x4* WL = WH + 4096;
    LAS float* GS = (LAS float*)(C.lds + 131072);
    LAS float* SH = GS + 1024;
    LAS float* red = SH + 1024;
    LAS float* ssw = red + 8 * 16 * 32;
    LAS int* lcnt = (LAS int*)(ssw + 128);
    LAS int* lbase = lcnt + 32;
    LAS int* pend = lbase + 32;
    LAS float* cbl = (LAS float*)(pend + 512);
    for (int blk = C.bid; blk < NTOK / 128; blk += C.G) {
        const int b = blk >> 4; const float* md = C.mod + b * 6144;
        __syncthreads();
        for (int k = C.tid; k < DM; k += NTHREADS) { GS[k] = C.norm2_g[k] * (1.f + md[4096 + k]); SH[k] = md[3072 + k]; }
        if (C.tid < 32) lcnt[C.tid] = 0;
        pend[C.tid] = -1;
#pragma unroll 4
        for (int idx = C.tid; idx < 4096; idx += NTHREADS) { WH[idx] = C.wrf[idx]; WL[idx] = C.wrf[4096 + idx]; }
        f32x4 xaA[4], xbA[4]; u32x4 ywA[4];
#define RT_ISSUE(XA, XB, YW, row) do { _Pragma("unroll") for (int ks = 0; ks < 4; ++ks) { const size_t o_ = (size_t)(row) * DM + 128 * wid + 32 * ks + 8 * fq; \
            XA[ks] = *(const f32x4*)(C.x + o_); XB[ks] = __builtin_nontemporal_load((const f32x4*)(C.x + o_ + 4)); if (ks & 1) YW[ks] = __builtin_nontemporal_load((const u32x4*)(C.Y1 + o_)); else YW[ks] = *(const u32x4*)(C.Y1 + o_); } } while (0)
        RT_ISSUE(xaA, xbA, ywA, blk * 128 + fr);
        __syncthreads();
#define RT_MMA(av, ks) do { bf16x8 ah_, al_; split_bf16(av, ah_, al_); const int fi_ = ((wid * 4 + (ks)) * 2) * 64 + lane; \
            const bf16x8 wh0 = __builtin_bit_cast(bf16x8, WH[fi_]), wh1 = __builtin_bit_cast(bf16x8, WH[fi_ + 64]), wl0 = __builtin_bit_cast(bf16x8, WL[fi_]), wl1 = __builtin_bit_cast(bf16x8, WL[fi_ + 64]); \
            acc0 = MFMA16(ah_, wh0, acc0); acc0 = MFMA16(al_, wh0, acc0); acc0 = MFMA16(ah_, wl0, acc0); \
            acc1 = MFMA16(ah_, wh1, acc1); acc1 = MFMA16(al_, wh1, acc1); acc1 = MFMA16(ah_, wl1, acc1); } while (0)
        {
            f32x4 acc0 = (f32x4){0.f, 0.f, 0.f, 0.f}, acc1 = acc0;
#pragma unroll
            for (int ks = 0; ks < 4; ++ks) { const f32x4 sa = *(const LAS f32x4*)(SH + 128 * wid + 32 * ks + 8 * fq), sb = *(const LAS f32x4*)(SH + 128 * wid + 32 * ks + 8 * fq + 4);
                float av[8] = {sa[0], sa[1], sa[2], sa[3], sb[0], sb[1], sb[2], sb[3]}; RT_MMA(av, ks); }
            if (fq == 0) { red[(wid * 16) * 32 + fr] = acc0[0]; red[(wid * 16) * 32 + 16 + fr] = acc1[0]; }
            LDS_WAIT(); __syncthreads();
            if (C.tid < 32) { float t = C.b_router[C.tid];
#pragma unroll
                for (int w2 = 0; w2 < 8; ++w2) t += red[(w2 * 16) * 32 + C.tid];
                cbl[C.tid] = t; }
            LDS_WAIT(); __syncthreads();
        }
#define RT_TILE(XA, XB, YW, it) do { \
            int lane = C.lane; asm volatile("" : "+v"(lane)); const int fr = lane & 15, fq = lane >> 4;     \
            const int row0 = blk * 128 + (it) * 16; float x1[4][8]; \
            _Pragma("unroll") for (int ks = 0; ks < 4; ++ks) { \
                x1[ks][0] = XA[ks][0] + bflo(YW[ks].x); x1[ks][1] = XA[ks][1] + bfhi(YW[ks].x); x1[ks][2] = XA[ks][2] + bflo(YW[ks].y); x1[ks][3] = XA[ks][3] + bfhi(YW[ks].y); \
                x1[ks][4] = XB[ks][0] + bflo(YW[ks].z); x1[ks][5] = XB[ks][1] + bfhi(YW[ks].z); x1[ks][6] = XB[ks][2] + bflo(YW[ks].w); x1[ks][7] = XB[ks][3] + bfhi(YW[ks].w); } \
            _Pragma("unroll") for (int ks = 0; ks < 4; ++ks) __builtin_nontemporal_store((u32x4){pk2(x1[ks][0], x1[ks][1]), pk2(x1[ks][2], x1[ks][3]), pk2(x1[ks][4], x1[ks][5]), pk2(x1[ks][6], x1[ks][7])}, (u32x4*)(C.Y1 + (size_t)(row0 + fr) * DM + 128 * wid + 32 * ks + 8 * fq));     \
            __builtin_amdgcn_sched_barrier(0); if ((it) + 1 < 8) RT_ISSUE(XA, XB, YW, row0 + 16 + fr); __builtin_amdgcn_sched_barrier(0);                                     \
            f32x4 acc0 = (f32x4){0.f, 0.f, 0.f, 0.f}, acc1 = acc0; float ss = 0.f; \
            _Pragma("unroll") for (int ks = 0; ks < 4; ++ks) { \
                const f32x4 ga = *(const LAS f32x4*)(GS + 128 * wid + 32 * ks + 8 * fq), gb = *(const LAS f32x4*)(GS + 128 * wid + 32 * ks + 8 * fq + 4); float av[8]; \
                _Pragma("unroll") for (int j = 0; j < 8; ++j) { const float xv = x1[ks][j]; ss += xv * xv; av[j] = xv * (j < 4 ? ga[j] : gb[j - 4]); } \
                RT_MMA(av, ks); __builtin_amdgcn_sched_barrier(0); } \
            ss = sum_rows(ss); \
            if (fq == 0) ssw[wid * 16 + fr] = ss; \
            _Pragma("unroll") for (int r = 0; r < 4; ++r) { red[(wid * 16 + 4 * fq + r) * 32 + fr] = acc0[r]; red[(wid * 16 + 4 * fq + r) * 32 + 16 + fr] = acc1[r]; } \
            LDS_WAIT(); __syncthreads(); __builtin_amdgcn_sched_barrier(0); \
            {     \
                const int r = 2 * wid + (lane >> 5), e = lane & 31; float sum = 0.f, sq = 0.f; \
                _Pragma("unroll") for (int w2 = 0; w2 < 8; ++w2) { sum += red[(w2 * 16 + r) * 32 + e]; sq += ssw[w2 * 16 + r]; } \
                const float val = rsqrtf(sq * (1.f / DM) + EPS) * sum + cbl[e]; \
                LAS float* lgr = red + (2 * wid + (lane >> 5)) * 32; lgr[e] = val; LDS_WAIT();            \
                int rank = 0; \
                _Pragma("unroll") for (int e4 = 0; e4 < 8; ++e4) { const f32x4 o4 = *(const LAS f32x4*)(lgr + 4 * e4); \
                    _Pragma("unroll") for (int j = 0; j < 4; ++j) rank += (o4[j] > val || (o4[j] == val && (4 * e4 + j) < e)) ? 1 : 0; } \
                LAS float* slr = red + (16 + 2 * wid + (lane >> 5)) * 32;                                   \
                if (rank < 4) slr[rank] = val; \
                LDS_WAIT(); \
                const f32x4 tv = *(const LAS f32x4*)slr; \
                const float e1 = fexp(tv[1] - tv[0]), e2 = fexp(tv[2] - tv[0]), e3 = fexp(tv[3] - tv[0]); const float inv = 1.f / (1.f + e1 + e2 + e3); \
                if (rank < 4) { const int row = row0 + r; const float wgt = (rank == 0 ? 1.f : (rank == 1 ? e1 : (rank == 2 ? e2 : e3))) * inv; \
                    C.topw[(size_t)row * 4 + rank] = wgt; C.tope[(size_t)row * 4 + rank] = e; \
                    const int slot = atomicAdd((int*)(lcnt + e), 1); pend[((it) * 16 + r) * 4 + rank] = (e << 16) | slot; } \
            } \
            __builtin_amdgcn_sched_barrier(0); \
            {     \
                float sq = 0.f; _Pragma("unroll") for (int w2 = 0; w2 < 8; ++w2) sq += ssw[w2 * 16 + fr]; \
                const float rstd = rsqrtf(sq * (1.f / DM) + EPS); \
                _Pragma("unroll") for (int ks = 0; ks < 4; ++ks) { const int k0 = 128 * wid + 32 * ks + 8 * fq; \
                    const f32x4 ga = *(const LAS f32x4*)(GS + k0), gb = *(const LAS f32x4*)(GS + k0 + 4), sa = *(const LAS f32x4*)(SH + k0), sb = *(const LAS f32x4*)(SH + k0 + 4); float hv[8]; \
                    _Pragma("unroll") for (int j = 0; j < 8; ++j) hv[j] = __builtin_amdgcn_fmed3f((x1[ks][j] * rstd * (j < 4 ? ga[j] : gb[j - 4]) + (j < 4 ? sa[j] : sb[j - 4])) * F8_ASCALE, -440.f, 440.f); \
                    *(u32x2*)((unsigned char*)C.H2 + (size_t)(row0 + fr) * DM + k0) = (u32x2){pk4_fp8(hv[0], hv[1], hv[2], hv[3]), pk4_fp8(hv[4], hv[5], hv[6], hv[7])}; __builtin_amdgcn_sched_barrier(0); } \
            } \
            LDS_WAIT(); __syncthreads(); } while (0)
#pragma unroll 1
        for (int it = 0; it < 8; ++it) { RT_TILE(xaA, xbA, ywA, it); }
#undef RT_TILE
#undef RT_MMA
#undef RT_ISSUE
        if (C.tid < 32) lbase[C.tid] = (int)__hip_atomic_fetch_add(C.ctl + CW_CNT + 64 * C.tid, (unsigned)lcnt[C.tid], RLX_AGENT);
        __syncthreads();
        { const int pv = pend[C.tid]; if (pv >= 0) { const int e = pv >> 16, slot = pv & 0xffff; C.list[e * NTOK + lbase[e] + slot] = (blk * 128 + (C.tid >> 2)) * 4 + (C.tid & 3); } }
    }
}

__device__ __forceinline__ void phase_final(const Ctx& C) {
    const int gw = C.bid * NWAVES + C.wid, NGW = C.G * NWAVES;
    for (int r0 = gw * 16; r0 < NTOK; r0 += NGW * 16) {
        const int b = r0 >> 11; const float* gt2p = C.mod + b * 6144 + 5120;
        f32x4 gt2[4], fg[4];
#pragma unroll
        for (int j = 0; j < 4; ++j) { const int c0 = 4 * C.lane + 256 * j; gt2[j] = *(const f32x4*)(gt2p + c0); fg[j] = *(const f32x4*)(C.final_g + c0); }
        int ywA[16], ywB[16]; u32x2 y1A[4], y1B[4]; f32x4 wA, wB;
#define FN_ISSUE(YW, Y1W, W, row) do { W = *(const f32x4*)(C.topw + (size_t)(row) * 4); \
            _Pragma("unroll") for (int j = 0; j < 4; ++j) { const int c0 = 4 * C.lane + 256 * j; \
                _Pragma("unroll") for (int k = 0; k < 4; ++k) YW[4 * j + k] = __builtin_nontemporal_load((const int*)((const unsigned char*)C.YB + (size_t)((row) * 4 + k) * DM + c0)); \
                Y1W[j] = __builtin_nontemporal_load((const u32x2*)(C.Y1 + (size_t)(row) * DM + c0)); } } while (0)
#define FN_ROW(YW, Y1W, W, row) do { const f32x4 w = W * (1.f / F8_YSCALE); f32x4 v[4]; float ss = 0.f; \
            _Pragma("unroll") for (int j = 0; j < 4; ++j) { f32x4 y = (f32x4){0.f, 0.f, 0.f, 0.f}; \
                _Pragma("unroll") for (int k = 0; k < 4; ++k) { const int yw = YW[4 * j + k]; \
                    y = y + (f32x4){__builtin_amdgcn_cvt_f32_fp8(yw, 0), __builtin_amdgcn_cvt_f32_fp8(yw, 1), __builtin_amdgcn_cvt_f32_fp8(yw, 2), __builtin_amdgcn_cvt_f32_fp8(yw, 3)} * w[k]; } \
                v[j] = (f32x4){bflo(Y1W[j].x), bfhi(Y1W[j].x), bflo(Y1W[j].y), bfhi(Y1W[j].y)} + gt2[j] * y; \
                ss += (v[j][0] * v[j][0] + v[j][1] * v[j][1]) + (v[j][2] * v[j][2] + v[j][3] * v[j][3]); } \
            const float rstd = rsqrtf(wave_sum(ss) * (1.f / DM) + EPS); \
            _Pragma("unroll") for (int j = 0; j < 4; ++j) __builtin_nontemporal_store(v[j] * rstd * fg[j], (f32x4*)(C.out + (size_t)(row) * DM + 4 * C.lane + 256 * j)); } while (0)
        FN_ISSUE(ywA, y1A, wA, r0);
#pragma unroll 1
        for (int rr = 0; rr < 16; rr += 2) {
            FN_ISSUE(ywB, y1B, wB, r0 + rr + 1);
            FN_ROW(ywA, y1A, wA, r0 + rr);
            if (rr + 2 < 16) FN_ISSUE(ywA, y1A, wA, r0 + rr + 2);
            FN_ROW(ywB, y1B, wB, r0 + rr + 1);
        }
#undef FN_ISSUE
#undef FN_ROW
    }
}

#ifndef PROBE_A
#define PROBE_A -1
#endif
#ifndef PROBE_B
#define PROBE_B -1
#endif
constexpr int CW_TS = 3072;
#define STAMP(k) do { if (PROBE_A >= 0 && blockIdx.x == 0 && threadIdx.x == 0) { const Ctx Cs = make_ctx(lds); ((unsigned long long*)(Cs.ctl + CW_TS))[k] = __builtin_amdgcn_s_memrealtime(); } } while (0)
struct Args { const float* in[25]; float* out; unsigned char* ws; };
typedef const Args __attribute__((address_space(4)))* KArgs;
__device__ __forceinline__ Ctx make_ctx(LAS unsigned char* lds) {
    KArgs a = (KArgs)__builtin_amdgcn_kernarg_segment_ptr();
    asm volatile("" : "+s"(a));
    Ctx C;
    C.lds = lds;
    C.tid = tid_fresh(); C.lane = C.tid & 63; C.wid = __builtin_amdgcn_readfirstlane(C.tid >> 6); C.G = gridDim.x; C.bid = blockIdx.x;
    C.x = a->in[0]; C.c = a->in[1]; C.w_ada = a->in[2]; C.b_ada = a->in[3]; C.norm1_g = a->in[4]; C.w_in = a->in[5];
    C.lq1 = a->in[6]; C.lk1 = a->in[7]; C.lq2 = a->in[8]; C.lk2 = a->in[9]; C.diff_g = a->in[10]; C.w_alpha_up = a->in[11]; C.b_alpha = a->in[12];
    C.gla_g = a->in[13]; C.w_bd = a->in[14]; C.w_bg = a->in[15]; C.w_out = a->in[16]; C.norm2_g = a->in[17]; C.w_router = a->in[18]; C.b_router = a->in[19];
    C.w_gu = a->in[20]; C.b_gu = a->in[21]; C.w_dn = a->in[22]; C.b_dn = a->in[23]; C.final_g = a->in[24];
    C.out = a->out;
    unsigned char* ws = a->ws;
    C.ctl = (unsigned*)(ws + WS_CTL); C.mod = (float*)(ws + WS_MOD); C.tope = (int*)(ws + WS_TOPE); C.topw = (float*)(ws + WS_TOPW); C.list = (int*)(ws + WS_LIST);
    C.WinT = (bf16*)(ws + WS_WIN); C.WbdT = (bf16*)(ws + WS_WBD); C.WbgT = (bf16*)(ws + WS_WBG); C.WoutT = (bf16*)(ws + WS_WOUT); C.WguT = (bf16*)(ws + WS_WGU); C.WdT = (bf16*)(ws + WS_WD);
    C.H = (bf16*)(ws + WS_H); C.H2 = (bf16*)(ws + WS_H2); C.OA = (bf16*)(ws + WS_OA); C.OB = (bf16*)(ws + WS_OB); C.MG = (bf16*)(ws + WS_MG); C.YB = (bf16*)(ws + WS_YB);
    C.PROJ = (bf16*)(ws + WS_PROJ); C.ACT = (bf16*)(ws + WS_ACT); C.Y1 = (bf16*)(ws + WS_Y1); C.cb = (float*)(ws + WS_CB); C.wrf = (u32x4*)(ws + WS_WRF);
    return C;
}
__global__ void __launch_bounds__(NTHREADS, 2) fwd_kernel(Args args) {
    extern __shared__ __attribute__((aligned(16))) unsigned char lds_raw[];
    LAS unsigned char* lds = (LAS unsigned char*)lds_raw;
    for (int u = threadIdx.x; u < (LDS_BYTES - LDSCTL_OFF) / 4; u += NTHREADS) ((LAS unsigned*)(lds + LDSCTL_OFF))[u] = 0u;
    __syncthreads();
    volatile LAS unsigned* MISC = (volatile LAS unsigned*)(lds + MISC_OFF);
    XcdBarrier bar;
    { const Ctx C = make_ctx(lds); bar = xcd_barrier_post(C.ctl + CW_BAR, MISC + 8); }
#define GRID_BAR() xcd_barrier(bar)
    STAMP(0);
#if PROBE_A >= 100
    if (blockIdx.x == 0 && threadIdx.x == 0) ((volatile LAS unsigned*)(lds + MISC_OFF))[15] = (unsigned)__builtin_amdgcn_s_memrealtime();
#endif

    { const Ctx C = make_ctx(lds); phase_mod(C); }
    { __syncthreads();
      if (threadIdx.x == 0) { const Ctx C = make_ctx(lds); unsigned sp = 0u; while (__hip_atomic_load(C.ctl + CW_MODRDY, __ATOMIC_RELAXED, __HIP_MEMORY_SCOPE_AGENT) < 96u && ++sp < (1u << 24)) __builtin_amdgcn_s_sleep(2);
          __builtin_amdgcn_fence(__ATOMIC_ACQUIRE, "agent"); }
      __syncthreads(); }
    STAMP(1);
    { const Ctx C = make_ctx(lds); phase_prep(C); }
    GRID_BAR(); STAMP(2);
    { const Ctx C = make_ctx(lds); DenseDesc g{C.H, DM, C.WinT, DM}; TileOrder S; S.init(NTOK / 256, NPROJ / 256, C.G, C.bid, 4); EpiProj E{C.PROJ, C.b_alpha}; gemm_phase<DenseDesc, TileOrder, EpiProj, true, false, 1>(C.lds, g, S, E);
      if (C.G == 256 && C.bid >= 128) { __syncthreads(); transposes(C, T_NITEMS - T_LATE, T_NITEMS, (C.bid - 128) * NWAVES + C.wid, 128 * NWAVES); } }
    GRID_BAR(); STAMP(3);
    { const Ctx C = make_ctx(lds); for (int s = C.bid; s < 64; s += C.G) gla_chunked(C, s >> 2, s & 3); }
    __syncthreads(); STAMP(12);
    { const Ctx C = make_ctx(lds); attn_phase(C); }
    GRID_BAR(); STAMP(4);
    { const Ctx C = make_ctx(lds); DenseDesc g{C.OA, DM, C.WbdT, DM}; TileOrder S; S.init(NTOK / 256, DM / 256, C.G, C.bid); EpiBranch E{C.MG, C.PROJ}; gemm_phase<DenseDesc, TileOrder, EpiBranch, true>(C.lds, g, S, E); }
    GRID_BAR(); STAMP(5);
    STAMP(6);
    { const Ctx C = make_ctx(lds); DenseDesc g{C.MG, DM, C.WoutT, DM}; TileOrder S; S.init(NTOK / 256, DM / 256, C.G, C.bid); EpiOut E{C.Y1, C.mod}; gemm_phase<DenseDesc, TileOrder, EpiOut, true>(C.lds, g, S, E); }
    GRID_BAR(); STAMP(7);
    { const Ctx C = make_ctx(lds); phase_router(C); }
    GRID_BAR(); STAMP(8);
    LAS int* tab = (LAS int*)(lds + STAGE_BYTES);
    __syncthreads();
    if (threadIdx.x < NE) { const Ctx C = make_ctx(lds); tab[threadIdx.x] = (int)__hip_atomic_load(C.ctl + CW_CNT + 64 * threadIdx.x, RLX_AGENT); }
    __syncthreads();
    if (threadIdx.x == 0) { int ts = 0; for (int e = 0; e < NE; ++e) { tab[32 + e] = ts; ts += (tab[e] + 255) >> 8; } tab[64] = ts; }
    __syncthreads();
    for (int tr = threadIdx.x; tr < tab[64]; tr += NTHREADS) { int e = 0; for (int k = 1; k < NE; ++k) if (tab[32 + k] <= tr) e = k; tab[65 + tr] = e; }
    __syncthreads();
    { const Ctx C = make_ctx(lds); const int T = tab[64]; MoeUpDesc g{(const unsigned char*)C.H2, C.list, (const unsigned char*)C.WguT, DM}; MoeOrder S; S.t.init(T, 8, C.G, C.bid, 4); S.tab = tab; EpiUp E{(unsigned char*)C.ACT, C.b_gu}; gemm_phase<MoeUpDesc, MoeOrder, EpiUp, true, true, 4>(C.lds, g, S, E); }
    GRID_BAR(); STAMP(9);
    { const Ctx C = make_ctx(lds); const int T = tab[64]; MoeDownDesc g{(const unsigned char*)C.ACT, (const unsigned char*)C.WdT, FF}; MoeOrder S; S.t.init(T, 4, C.G, C.bid); S.tab = tab; EpiDown E{(unsigned char*)C.YB, C.b_dn, C.list}; gemm_phase<MoeDownDesc, MoeOrder, EpiDown, true, true, 5>(C.lds, g, S, E); }
    GRID_BAR(); STAMP(10);
    { const Ctx C = make_ctx(lds); phase_final(C); }
#if PROBE_A >= 0
    GRID_BAR(); STAMP(11);
    if (blockIdx.x == 0 && threadIdx.x == 0) {
        const Ctx C = make_ctx(lds); const unsigned long long* ts = (const unsigned long long*)(C.ctl + CW_TS);
        asm volatile("s_waitcnt vmcnt(0)" ::: "memory");
        const unsigned long long dt = (PROBE_A >= 100) ? (unsigned long long)((volatile LAS unsigned*)(lds + MISC_OFF))[16 + (PROBE_A >= 100 ? PROBE_A - 100 : 0)] : ((PROBE_A == 12) ? ts[12] - ts[3] : ts[(PROBE_A < 12 ? PROBE_A : 0) + 1] - ts[PROBE_A < 12 ? PROBE_A : 0]), t0 = __builtin_amdgcn_s_memrealtime();
        while (__builtin_amdgcn_s_memrealtime() - t0 < 4ull * dt) __builtin_amdgcn_s_sleep(8);
    }
#endif
}

extern "C" void kernel_launch(void* const* d_in, const int* in_sizes, int n_in, void* d_out, int out_size, void* d_ws, size_t ws_size, hipStream_t stream) {
    static int grid = 0;
    if (grid == 0) {
        if (n_in != 25 || in_sizes[0] != NTOK * DM || out_size != NTOK * DM || ws_size < WS_END) {
            fprintf(stderr, "kernel_launch: unexpected shapes (n_in %d, in0 %d, out %d, ws %zu < %zu)\n", n_in, n_in > 0 ? in_sizes[0] : -1, out_size, ws_size, (size_t)WS_END); grid = -1; return; }
        int dev = 0, cus = 0;
        if (hipGetDevice(&dev) != hipSuccess || hipDeviceGetAttribute(&cus, hipDeviceAttributeMultiprocessorCount, dev) != hipSuccess) { grid = -1; return; }
        if (hipFuncSetAttribute((const void*)fwd_kernel, hipFuncAttributeMaxDynamicSharedMemorySize, LDS_BYTES) != hipSuccess) { fprintf(stderr, "kernel_launch: hipFuncSetAttribute failed\n"); grid = -1; return; }
        (void)hipGetLastError();
        grid = cus;
    }
    if (grid < 0) return;
    if (hipMemsetAsync((char*)d_ws + WS_CTL, 0, CTL_ZERO_BYTES, stream) != hipSuccess) { fprintf(stderr, "kernel_launch: memset failed\n"); return; }
    Args a{};
    for (int i = 0; i < 25; ++i) a.in[i] = (const float*)d_in[i];
    a.out = (float*)d_out; a.ws = (unsigned char*)d_ws;
    hipLaunchKernelGGL(fwd_kernel, dim3(grid), dim3(NTHREADS), LDS_BYTES, stream, a);
}
```
